# Optimizing an MI355X kernel written in HIP

```python
import jax, jax.numpy as jnp
from jax import lax
import numpy as np

D_MODEL = 1024
BATCH = 8
SEQ = 2048
DEPTH = 2

ATT_HEADS = 8
ATT_HEAD_DIM = 64
ATT_WIDTH = ATT_HEADS * ATT_HEAD_DIM
MOBA_BLOCK = 256
MOBA_TOPK = 3
MOBA_Q_CHUNK = 32
RET_HEADS = 4
RET_HEAD_DIM = 128
RET_WIDTH = RET_HEADS * RET_HEAD_DIM
RET_CHUNK = 128
ROPE_BASE = 10000.0
IN_PROJ_WIDTH = 3 * ATT_WIDTH + 4 * RET_WIDTH
D_FF = 2816
N_EXPERTS = 8
TOP_K = 2
EXPERT_D_FF = 2816
MOE_GROUP = 128
EPS = 1e-6

kernel_name = "hymba_moba_retnet_moe_adaln"


def rms_norm(x, g):
    xf = x.astype(jnp.float32)
    y = xf * lax.rsqrt(jnp.mean(xf * xf, axis=-1, keepdims=True) + EPS)
    return (y * g.astype(jnp.float32)).astype(x.dtype)


def rotary(x):
    s, d = x.shape[1], x.shape[-1]
    half = d // 2
    inv_freq = ROPE_BASE ** (-jnp.arange(half, dtype=jnp.float32) / half)
    ang = jnp.arange(s, dtype=jnp.float32)[:, None] * inv_freq[None, :]
    cos = jnp.cos(ang)[None, :, None, :]
    sin = jnp.sin(ang)[None, :, None, :]
    xf = x.astype(jnp.float32)
    x1, x2 = xf[..., :half], xf[..., half:]
    return jnp.concatenate([x1 * cos - x2 * sin, x1 * sin + x2 * cos], axis=-1).astype(x.dtype)


def moba_attention(q, k, v):
    b, h, s, dh = q.shape
    nb = -(-s // MOBA_BLOCK)
    pad = nb * MOBA_BLOCK - s
    kp = jnp.pad(k, ((0, 0), (0, 0), (0, pad), (0, 0)))
    vp = jnp.pad(v, ((0, 0), (0, 0), (0, pad), (0, 0)))
    kb = kp.reshape(b, h, nb, MOBA_BLOCK, dh)
    vb = vp.reshape(b, h, nb, MOBA_BLOCK, dh)
    scale = dh ** -0.5
    n_sel = min(MOBA_TOPK, nb - 1)
    q_block = jnp.arange(s) // MOBA_BLOCK
    if n_sel > 0:
        k_mean = jnp.mean(kb.astype(jnp.float32), axis=3)
        gate = jnp.einsum('bhsd,bhnd->bhsn', q.astype(jnp.float32), k_mean)
        past = jnp.arange(nb)[None, :] < q_block[:, None]
        gate = jnp.where(past[None, None], gate, -1e30)
        _, sel = lax.top_k(gate, n_sel)
        sel_valid = sel < q_block[None, None, :, None]
    bi = jnp.arange(b)[:, None, None, None]
    hi = jnp.arange(h)[None, :, None, None]

    def chunk_fn(ci):
        start = ci * MOBA_Q_CHUNK
        qc = lax.dynamic_slice_in_dim(q, start, MOBA_Q_CHUNK, axis=2)
        pos = start + jnp.arange(MOBA_Q_CHUNK)
        own = start // MOBA_BLOCK
        k_own = lax.dynamic_index_in_dim(kb, own, axis=2, keepdims=False)
        v_own = lax.dynamic_index_in_dim(vb, own, axis=2, keepdims=False)
        key_pos = own * MOBA_BLOCK + jnp.arange(MOBA_BLOCK)
        s_own = jnp.einsum('bhqd,bhkd->bhqk', qc, k_own).astype(jnp.float32) * scale
        s_own = jnp.where(key_pos[None, :] <= pos[:, None], s_own, -jnp.inf)
        if n_sel > 0:
            sel_c = lax.dynamic_slice_in_dim(sel, start, MOBA_Q_CHUNK, axis=2)
            val_c = lax.dynamic_slice_in_dim(sel_valid, start, MOBA_Q_CHUNK, axis=2)
            k_sel = kb[bi, hi, sel_c]
            v_sel = vb[bi, hi, sel_c]
            s_sel = jnp.einsum('bhqd,bhqnkd->bhqnk', qc, k_sel).astype(jnp.float32) * scale
            s_sel = jnp.where(val_c[..., None], s_sel, -jnp.inf)
            s_sel = s_sel.reshape(b, h, MOBA_Q_CHUNK, n_sel * MOBA_BLOCK)
            p = jax.nn.softmax(jnp.concatenate([s_own, s_sel], axis=-1), axis=-1)
            p_own = p[..., :MOBA_BLOCK].astype(v.dtype)
            p_sel = p[..., MOBA_BLOCK:].reshape(b, h, MOBA_Q_CHUNK, n_sel, MOBA_BLOCK).astype(v.dtype)
            o = (jnp.einsum('bhqk,bhkd->bhqd', p_own, v_own)
                 + jnp.einsum('bhqnk,bhqnkd->bhqd', p_sel, v_sel))
        else:
            p_own = jax.nn.softmax(s_own, axis=-1).astype(v.dtype)
            o = jnp.einsum('bhqk,bhkd->bhqd', p_own, v_own)
        return o

    out = lax.map(chunk_fn, jnp.arange(s // MOBA_Q_CHUNK))
    return jnp.transpose(out, (1, 2, 0, 3, 4)).reshape(b, h, s, dh)


def retention(q, k, v):
    b, h, s, d = q.shape
    c = RET_CHUNK
    nc = s // c
    dt = v.dtype
    lg = jnp.log(1.0 - 2.0 ** (-5.0 - jnp.arange(h, dtype=jnp.float32)))
    idx = jnp.arange(c, dtype=jnp.float32)
    qf = q.astype(jnp.float32).reshape(b, h, nc, c, d)
    kf = (k.astype(jnp.float32) * d ** -0.5).reshape(b, h, nc, c, d)
    vf = v.astype(jnp.float32).reshape(b, h, nc, c, d)
    diff = idx[:, None] - idx[None, :]
    dmask = jnp.where(diff >= 0, jnp.exp(jnp.maximum(diff, 0.0)[None] * lg[:, None, None]), 0.0)
    scores = jnp.einsum('bhncd,bhnmd->bhncm', qf, kf) * dmask[None, :, None]
    inner = jnp.einsum('bhncm,bhnme->bhnce', scores, vf)
    k_dec = kf * jnp.exp((c - 1 - idx)[None, :] * lg[:, None])[None, :, None, :, None]
    kv = jnp.einsum('bhnmd,bhnme->bhnde', k_dec, vf)
    chunk_decay = jnp.exp(c * lg)[None, :, None, None]

    def step(state, kv_n):
        return state * chunk_decay + kv_n, state

    _, r_prev = lax.scan(step, jnp.zeros((b, h, d, d), jnp.float32), jnp.moveaxis(kv, 2, 0))
    r_prev = jnp.moveaxis(r_prev, 0, 2)
    q_dec = qf * jnp.exp((idx + 1.0)[None, :] * lg[:, None])[None, :, None, :, None]
    cross = jnp.einsum('bhncd,bhnde->bhnce', q_dec, r_prev)
    return (inner + cross).reshape(b, h, s, d).astype(dt)


def hybrid_mixer(h, w_in, w_out, att_out_g, ret_out_g):
    b, s, _ = h.shape
    proj = h @ w_in
    A, R = ATT_WIDTH, RET_WIDTH
    q_a, k_a, v_a, q_r, k_r, v_r, g_r = jnp.split(
        proj, [A, 2 * A, 3 * A, 3 * A + R, 3 * A + 2 * R, 3 * A + 3 * R], axis=-1)

    def att_heads(t):
        return t.reshape(b, s, ATT_HEADS, ATT_HEAD_DIM).transpose(0, 2, 1, 3)

    o_a = moba_attention(att_heads(q_a), att_heads(k_a), att_heads(v_a))
    o_a = o_a.transpose(0, 2, 1, 3).reshape(b, s, A)
    o_a = rms_norm(o_a, att_out_g)

    def ret_heads(t):
        return t.reshape(b, s, RET_HEADS, RET_HEAD_DIM)

    qr = rotary(ret_heads(q_r)).transpose(0, 2, 1, 3)
    kr = rotary(ret_heads(k_r)).transpose(0, 2, 1, 3)
    vr = ret_heads(v_r).transpose(0, 2, 1, 3)
    o_r = retention(qr, kr, vr).transpose(0, 2, 1, 3)
    o_r = rms_norm(o_r, ret_out_g.reshape(RET_HEADS, RET_HEAD_DIM)).reshape(b, s, R)
    o_r = jax.nn.silu(g_r) * o_r
    return jnp.concatenate([o_a, o_r], axis=-1) @ w_out


def swiglu(x, w_gate, w_up, w_down):
    return (jax.nn.silu(x @ w_gate) * (x @ w_up)) @ w_down


def moe_ffn(h, w_router, w_gate, w_up, w_down):
    b, s, d = h.shape
    xf = h.reshape(-1, d)
    n = xf.shape[0]
    e_count = w_gate.shape[0]
    g = MOE_GROUP
    logits = (xf @ w_router).astype(jnp.float32)
    top_logits, top_idx = lax.top_k(logits, TOP_K)
    top_w = jax.nn.softmax(top_logits, axis=-1)
    a = n * TOP_K
    e_flat = top_idx.reshape(-1)
    t_flat = jnp.repeat(jnp.arange(n, dtype=jnp.int32), TOP_K)
    w_flat = top_w.reshape(-1)
    order = jnp.argsort(e_flat, stable=True)
    e_sorted = e_flat[order]
    counts = jnp.bincount(e_flat, length=e_count)
    starts = jnp.cumsum(counts) - counts
    padded = (counts + g - 1) // g * g
    pad_ends = jnp.cumsum(padded)
    pad_starts = pad_ends - padded
    dest = pad_starts[e_sorted] + (jnp.arange(a) - starts[e_sorted])
    p_total = (-(-a // g) + e_count) * g
    tok_buf = jnp.full((p_total,), n, jnp.int32).at[dest].set(t_flat[order])
    w_buf = jnp.zeros((p_total,), jnp.float32).at[dest].set(w_flat[order])
    nblk = p_total // g
    blk_e = jnp.minimum(jnp.searchsorted(pad_ends, jnp.arange(nblk) * g, side='right'), e_count - 1)
    x_pad = jnp.concatenate([xf, jnp.zeros((1, d), xf.dtype)], axis=0)
    xb = x_pad[tok_buf].reshape(nblk, g, d)

    def expert_block(args):
        xg, e = args
        return swiglu(xg, w_gate[e], w_up[e], w_down[e])

    yb = lax.map(expert_block, (xb, blk_e)).reshape(p_total, d)
    yb = yb * w_buf[:, None].astype(yb.dtype)
    y = jax.ops.segment_sum(yb, tok_buf, num_segments=n + 1)[:n]
    return y.reshape(b, s, d)


def setup_inputs(seed: int = 0) -> dict:
    key = jax.random.key(seed)
    ks = jax.random.split(key, 20)
    n_dense = (DEPTH + 1) // 2
    n_moe = DEPTH // 2
    D = D_MODEL

    def nrm(k, shape, scale):
        return jax.random.normal(k, shape, jnp.float32) * scale

    return {
        "x": nrm(ks[0], (BATCH, SEQ, D), 1.0),
        "c": nrm(ks[1], (BATCH, D), 1.0),
        "norm_mix_g": 1.0 + nrm(ks[2], (DEPTH, D), 0.05),
        "norm_ffn_g": 1.0 + nrm(ks[3], (DEPTH, D), 0.05),
        "ada_w": nrm(ks[4], (DEPTH, D, 6 * D), 0.5 * D ** -0.5),
        "ada_b": nrm(ks[5], (DEPTH, 6 * D), 0.02),
        "w_in": nrm(ks[6], (DEPTH, D, IN_PROJ_WIDTH), D ** -0.5),
        "w_out": nrm(ks[7], (DEPTH, ATT_WIDTH + RET_WIDTH, D), (ATT_WIDTH + RET_WIDTH) ** -0.5),
        "att_out_g": 1.0 + nrm(ks[8], (DEPTH, ATT_WIDTH), 0.05),
        "ret_out_g": 1.0 + nrm(ks[9], (DEPTH, RET_WIDTH), 0.05),
        "ffn_w_gate": nrm(ks[10], (n_dense, D, D_FF), D ** -0.5),
        "ffn_w_up": nrm(ks[11], (n_dense, D, D_FF), D ** -0.5),
        "ffn_w_down": nrm(ks[12], (n_dense, D_FF, D), D_FF ** -0.5),
        "router_w": nrm(ks[13], (n_moe, D, N_EXPERTS), D ** -0.5),
        "moe_w_gate": nrm(ks[14], (n_moe, N_EXPERTS, D, EXPERT_D_FF), D ** -0.5),
        "moe_w_up": nrm(ks[15], (n_moe, N_EXPERTS, D, EXPERT_D_FF), D ** -0.5),
        "moe_w_down": nrm(ks[16], (n_moe, N_EXPERTS, EXPERT_D_FF, D), EXPERT_D_FF ** -0.5),
        "final_norm_g": 1.0 + nrm(ks[17], (D,), 0.05),
    }


def reference(x, c, norm_mix_g, norm_ffn_g, ada_w, ada_b, w_in, w_out, att_out_g, ret_out_g,
              ffn_w_gate, ffn_w_up, ffn_w_down, router_w, moe_w_gate, moe_w_up, moe_w_down,
              final_norm_g):
    cs = jax.nn.silu(c)
    for l in range(DEPTH):
        mod = cs @ ada_w[l] + ada_b[l]
        sh1, sc1, g1, sh2, sc2, g2 = jnp.split(mod, 6, axis=-1)
        h = rms_norm(x, norm_mix_g[l]) * (1.0 + sc1[:, None]) + sh1[:, None]
        x = x + g1[:, None] * hybrid_mixer(h, w_in[l], w_out[l], att_out_g[l], ret_out_g[l])
        h = rms_norm(x, norm_ffn_g[l]) * (1.0 + sc2[:, None]) + sh2[:, None]
        if l % 2 == 0:
            f = swiglu(h, ffn_w_gate[l // 2], ffn_w_up[l // 2], ffn_w_down[l // 2])
        else:
            f = moe_ffn(h, router_w[l // 2], moe_w_gate[l // 2], moe_w_up[l // 2], moe_w_down[l // 2])
        x = x + g2[:, None] * f
    return rms_norm(x, final_norm_g)
```

```cpp
#include <hip/hip_runtime.h>
#include <cstdio>
#include <cstdint>
#include <cmath>

namespace h16 {
typedef _Float16 f16x2_t __attribute__((ext_vector_type(2)));
typedef _Float16 f16x8_t __attribute__((ext_vector_type(8)));
typedef float f32x2_t __attribute__((ext_vector_type(2)));
__device__ __forceinline__ unsigned pk(float lo, float hi) { f32x2_t v = {lo, hi}; f16x2_t b = __builtin_convertvector(v, f16x2_t); return __builtin_bit_cast(unsigned, b); }
__device__ __forceinline__ float lo(unsigned u) { return (float)__builtin_bit_cast(f16x2_t, u)[0]; }
__device__ __forceinline__ float hi(unsigned u) { return (float)__builtin_bit_cast(f16x2_t, u)[1]; }
__device__ __forceinline__ float one(unsigned short s) { return (float)__builtin_bit_cast(_Float16, s); }
}
#define STEP 6

constexpr int D = 1024, BATCH = 8, SEQ = 2048, M = BATCH * SEQ;
constexpr int AH = 8, AD = 64, AW = 512, MBLK = 256, NBLK = SEQ / MBLK, TOPK = 3;
constexpr int RH = 4, RD = 128, RW = 512;
constexpr int NPROJ = 3 * AW + 4 * RW;
constexpr int FF = 2816, NE = 8;
constexpr float EPS = 1e-6f;
constexpr int ECAP = 2048;
namespace pg8 {
#define PG8_LAS __attribute__((address_space(3)))
typedef unsigned short bf16_t;
typedef short bf16x8 __attribute__((ext_vector_type(8)));
typedef float f32x4 __attribute__((ext_vector_type(4)));
typedef float f32x2 __attribute__((ext_vector_type(2)));
typedef unsigned u32x4 __attribute__((ext_vector_type(4)));
typedef unsigned u32x2 __attribute__((ext_vector_type(2)));
constexpr int BM = 256, BK = 64, HALF = 128, HTB = HALF * BK * 2  , STAGE_BYTES = 8 * HTB, NXCD = 8, WGM = 8;

__host__ __device__ __forceinline__ int lds_byte(int r, int c) { const int st = (r >> 4) * 2 + (c >> 5), rr = r & 15, cc = c & 31, ob = rr * 64 + cc * 2; return st * 1024 + (ob ^ (((ob >> 9) & 1) << 5)); }
__host__ __device__ __forceinline__ void stage_rc(int b, int& R, int& C) { const int st = b / 1024, sb = b % 1024, swz = sb ^ (((sb >> 9) & 1) << 5); R = (st >> 1) * 16 + swz / 64; C = (st & 1) * 32 + (swz % 64) / 2; }
__host__ __device__ __forceinline__ int perm32(int rho) { const int n = rho >> 4, i = rho & 15; return 8 * (i >> 2) + 4 * n + (i & 3); }

struct Unit { int pm, pn, e; };
struct Gemm { int lda, ldb, K; };

struct DenseSched {
    const char* A; const char* Bt; size_t a_tile, b_tile;
    int nM, nN, nwg, G, c;
    __device__ __forceinline__ void init(const void* A_, int lda, const void* Bt_, int ldb, int M, int N, int G_, int c_) {
        A = (const char*)A_; Bt = (const char*)Bt_; a_tile = (size_t)BM * lda * 2; b_tile = (size_t)BM * ldb * 2; nM = M / BM; nN = N / BM; nwg = nM * nN; G = G_; c = c_; }
    __device__ __forceinline__ bool next(int i, Unit& u) const {
        const long L = (long)i * G + c; if (L >= nwg) return false;
        int wgid = (int)L; { const int q = nwg / NXCD, r = nwg % NXCD, xcd = wgid % NXCD, off = wgid / NXCD; wgid = (xcd < r ? xcd * (q + 1) : r * (q + 1) + (xcd - r) * q) + off; }
        const int nig = WGM * nN, gid = wgid / nig, fm = gid * WGM, gsz = (nM - fm) < WGM ? (nM - fm) : WGM;
        u.pm = fm + ((wgid % nig) % gsz); u.pn = (wgid % nig) / gsz; u.e = 0; return true;
    }
    __device__ __forceinline__ const char* a_ptr(const Unit& u) const { return A + (size_t)u.pm * a_tile; }
    __device__ __forceinline__ const char* b_ptr(const Unit& u) const { return Bt + (size_t)u.pn * b_tile; }
};
struct MoeSched {
    const char* A; const char* Bt; size_t a_tile, b_tile, e_stride;
    int nM, nN, nwg, G, c; int seg[8];
    __device__ __forceinline__ void init(const void* A_, int lda, const void* Bt_, int ldb, size_t e_stride_bytes, const int* segp, int N, int G_, int c_) {
        A = (const char*)A_; Bt = (const char*)Bt_; a_tile = (size_t)BM * lda * 2; b_tile = (size_t)BM * ldb * 2; e_stride = e_stride_bytes;
#pragma unroll
        for (int e = 0; e < 8; ++e) seg[e] = __builtin_amdgcn_readfirstlane(segp[e]);
        nM = __builtin_amdgcn_readfirstlane(segp[8]) / BM; nN = N / BM; nwg = nM * nN; G = G_; c = c_; }
    __device__ __forceinline__ bool next(int i, Unit& u) const {
        const long L = (long)i * G + c; if (L >= nwg) return false;
        int wgid = (int)L; { const int q = nwg / NXCD, r = nwg % NXCD, xcd = wgid % NXCD, off = wgid / NXCD; wgid = (xcd < r ? xcd * (q + 1) : r * (q + 1) + (xcd - r) * q) + off; }
        const int nig = WGM * nN, gid = wgid / nig, fm = gid * WGM, gsz = (nM - fm) < WGM ? (nM - fm) : WGM;
        u.pm = fm + ((wgid % nig) % gsz); u.pn = (wgid % nig) / gsz;
        int e = 0; const int r0 = u.pm * BM;
#pragma unroll
        for (int k = 1; k < 8; ++k) e += (r0 >= seg[k]) ? 1 : 0;
        u.e = e; return true;
    }
    __device__ __forceinline__ const char* a_ptr(const Unit& u) const { return A + (size_t)u.pm * a_tile; }
    __device__ __forceinline__ const char* b_ptr(const Unit& u) const { return Bt + (size_t)u.e * e_stride + (size_t)u.pn * b_tile; }
};

__device__ __forceinline__ unsigned cvt_pk_bf16(float lo, float hi) { return h16::pk(lo, hi); }
__device__ __forceinline__ float fast_silu(float g) { return g * __builtin_amdgcn_rcpf(1.0f + __builtin_amdgcn_exp2f(-1.4426950408889634f * g)); }

typedef f32x4 Acc[2][2][4][2];

template <class Epi, class Sched>
__device__ __forceinline__ void gemm_phase(PG8_LAS unsigned char* lds, const Gemm g, const Sched& S, const Epi& E) {
    int tid_ = threadIdx.x; asm volatile("" : "+v"(tid_));
    const int tid = tid_, wid = __builtin_amdgcn_readfirstlane(tid >> 6), lane = tid & 63, wr = wid >> 2, wc = wid & 3, fr = lane & 15, fq = lane >> 4;
    const int K = g.K, nt = K / BK;
    unsigned voffA[2], voffB[2];
#pragma unroll
    for (int i = 0; i < 2; ++i) { int R, C; stage_rc(tid * 16 + i * 8192, R, C); const int Rb = Epi::PERM ? ((R & ~31) + perm32(R & 31)) : R;
        voffA[i] = (unsigned)(R * g.lda + C) * 2u; voffB[i] = (unsigned)(Rb * g.ldb + C) * 2u; }
    const size_t kstep = (size_t)(BK * 2);
    const size_t hstepA = (size_t)HALF * g.lda * 2, hstepB = (size_t)HALF * g.ldb * 2;
    const unsigned ldsw = (unsigned)wid * 1024u;
    const int aoff = lds_byte(wr * 64 + fr, fq * 8), boff = lds_byte(wc * 32 + fr, fq * 8);
#define PG8_SA(b, h) (((b) * 2 + (h)) * HTB)
#define PG8_SB(b, h) ((4 + (b) * 2 + (h)) * HTB)
#define PG8_STAGE(bufoff, gbase, voff) do { _Pragma("unroll") for (int _i = 0; _i < 2; ++_i) \
        __builtin_amdgcn_global_load_lds((const unsigned*)((const char*)(gbase) + (voff)[_i]), (PG8_LAS unsigned*)(lds + (bufoff) + ldsw + _i * 8192), 16, 0, 0); } while (0)
#define PG8_LDA(dst, b, h) do { _Pragma("unroll") for (int m = 0; m < 4; ++m) _Pragma("unroll") for (int k = 0; k < 2; ++k) dst[m][k] = *(const PG8_LAS bf16x8*)(lds + PG8_SA(b, h) + aoff + m * 2048 + k * 1024); } while (0)
#define PG8_LDB(dst, b, h) do { _Pragma("unroll") for (int n = 0; n < 2; ++n) _Pragma("unroll") for (int k = 0; k < 2; ++k) dst[n][k] = *(const PG8_LAS bf16x8*)(lds + PG8_SB(b, h) + boff + n * 2048 + k * 1024); } while (0)
#define PG8_MMA(ai, bj, At, Bt) do { __builtin_amdgcn_s_setprio(1); _Pragma("unroll") for (int m = 0; m < 4; ++m) _Pragma("unroll") for (int n = 0; n < 2; ++n) _Pragma("unroll") for (int k = 0; k < 2; ++k) \
        acc[ai][bj][m][n] = __builtin_amdgcn_mfma_f32_16x16x32_f16(__builtin_bit_cast(h16::f16x8_t, Bt[n][k]), __builtin_bit_cast(h16::f16x8_t, At[m][k]), acc[ai][bj][m][n], 0, 0, 0); __builtin_amdgcn_s_setprio(0); } while (0)
#define PG8_WAIT_V(n) asm volatile("s_waitcnt vmcnt(" #n ")" ::: "memory")
#define PG8_WAIT_L(n) asm volatile("s_waitcnt lgkmcnt(" #n ")" ::: "memory")
#define PG8_BAR __builtin_amdgcn_s_barrier()
#define PG8_SCHED __builtin_amdgcn_sched_barrier(0)
    Unit cur, nxt; int ui = 0;
    if (!S.next(0, cur)) return;
    Acc acc;
#pragma unroll
    for (int a = 0; a < 2; ++a)
#pragma unroll
        for (int b = 0; b < 2; ++b)
#pragma unroll
            for (int m = 0; m < 4; ++m)
#pragma unroll
                for (int n = 0; n < 2; ++n) acc[a][b][m][n] = (f32x4){0.f, 0.f, 0.f, 0.f};
    bf16x8 At[4][2], B0[2][2], B1[2][2];
    const char* cA = S.a_ptr(cur); const char* cB = S.b_ptr(cur);
    PG8_STAGE(PG8_SB(0, 0), cB, voffB); PG8_STAGE(PG8_SB(0, 1), cB + hstepB, voffB); PG8_STAGE(PG8_SA(0, 0), cA, voffA); PG8_STAGE(PG8_SA(0, 1), cA + hstepA, voffA);
    if (wr == 1) PG8_BAR;
    PG8_WAIT_V(2); PG8_BAR;
    PG8_STAGE(PG8_SB(1, 0), cB + kstep, voffB); PG8_STAGE(PG8_SA(1, 0), cA + kstep, voffA); PG8_STAGE(PG8_SB(1, 1), cB + hstepB + kstep, voffB);
    PG8_WAIT_V(6); PG8_BAR;
    for (;;) {
        const bool has_next = S.next(ui + 1, nxt);
        const char* nA = has_next ? S.a_ptr(nxt) : cA; const char* nB = has_next ? S.b_ptr(nxt) : cB;
        for (int t = 0; t < nt; t += 2) {
            const bool last = (t == nt - 2);
            const char* a1 = cA + (size_t)(t + 1) * kstep;
            const char* a2 = last ? nA : cA + (size_t)(t + 2) * kstep; const char* b2 = last ? nB : cB + (size_t)(t + 2) * kstep;
            const char* a3 = a2 + kstep; const char* b3 = b2 + kstep;
            PG8_LDB(B0, 0, 0); PG8_LDB(B1, 0, 1); PG8_SCHED; PG8_LDA(At, 0, 0); PG8_STAGE(PG8_SA(1, 1), a1 + hstepA, voffA);
            PG8_WAIT_V(8); PG8_WAIT_L(0); PG8_BAR; PG8_MMA(0, 0, At, B0); PG8_MMA(0, 1, At, B1); PG8_BAR; PG8_SCHED;
            PG8_LDA(At, 0, 1); PG8_STAGE(PG8_SB(0, 0), b2, voffB); PG8_STAGE(PG8_SB(0, 1), b2 + hstepB, voffB); PG8_STAGE(PG8_SA(0, 0), a2, voffA);
            PG8_WAIT_V(8); PG8_WAIT_L(0); PG8_BAR; PG8_MMA(1, 0, At, B0); PG8_MMA(1, 1, At, B1); PG8_BAR; PG8_SCHED;
            PG8_LDB(B0, 1, 0); PG8_LDB(B1, 1, 1); PG8_SCHED; PG8_LDA(At, 1, 0); PG8_STAGE(PG8_SA(0, 1), a2 + hstepA, voffA);
            PG8_WAIT_V(8); PG8_WAIT_L(0); PG8_BAR; PG8_MMA(0, 0, At, B0); PG8_MMA(0, 1, At, B1); PG8_BAR; PG8_SCHED;
            PG8_LDA(At, 1, 1); PG8_STAGE(PG8_SB(1, 0), b3, voffB); PG8_STAGE(PG8_SB(1, 1), b3 + hstepB, voffB); PG8_STAGE(PG8_SA(1, 0), a3, voffA);
            PG8_WAIT_V(8); PG8_WAIT_L(0); PG8_BAR; PG8_MMA(1, 0, At, B0); PG8_MMA(1, 1, At, B1); PG8_BAR; PG8_SCHED;
        }
        if (wr == 0) PG8_BAR;
        E(acc, cur, wr, wc, fr, fq);
        if (!has_next) break;
#pragma unroll
        for (int a = 0; a < 2; ++a)
#pragma unroll
            for (int b = 0; b < 2; ++b)
#pragma unroll
                for (int m = 0; m < 4; ++m)
#pragma unroll
                    for (int n = 0; n < 2; ++n) acc[a][b][m][n] = (f32x4){0.f, 0.f, 0.f, 0.f};
        cur = nxt; cA = nA; cB = nB; ++ui;
        if (wr == 1) PG8_BAR;
    }
    PG8_WAIT_V(0);
    PG8_BAR;
#undef PG8_SA
#undef PG8_SB
#undef PG8_STAGE
#undef PG8_LDA
#undef PG8_LDB
#undef PG8_MMA
#undef PG8_WAIT_V
#undef PG8_WAIT_L
#undef PG8_BAR
#undef PG8_SCHED
}
}
namespace epi {
using pg8::Acc; using pg8::Unit; using pg8::f32x4; using pg8::u32x4; using pg8::bf16_t; using pg8::cvt_pk_bf16; using pg8::fast_silu;
constexpr int HALF = 128;
constexpr float C2 = 0.125f * 1.4426950408889634f;
constexpr float KSC = 0.08838834764831845f;

__device__ __forceinline__ u32x4 pack8(const f32x4 v0, const f32x4 v1) { u32x4 w; w.x = cvt_pk_bf16(v0[0], v0[1]); w.y = cvt_pk_bf16(v0[2], v0[3]); w.z = cvt_pk_bf16(v1[0], v1[1]); w.w = cvt_pk_bf16(v1[2], v1[3]); return w; }

struct EpiInProj {
    static constexpr bool PERM = true;
    bf16_t* O; size_t gstride;
    float* KMP;
    const float* ROPE;
    __device__ __forceinline__ void operator()(const Acc& acc, const Unit& u, int wr, int wc, int fr, int fq) const {
        const int grp = u.pn >> 1;
        const int col0 = (u.pn & 1) * 256 + wc * 32 + 8 * fq;
        const int row0 = u.pm * 256 + wr * 64 + fr;
        bf16_t* base = O + (size_t)grp * gstride;
        f32x4 cs[2][2];
#pragma unroll
        for (int bj = 0; bj < 2; ++bj) { cs[bj][0] = (f32x4){0.f, 0.f, 0.f, 0.f}; cs[bj][1] = (f32x4){0.f, 0.f, 0.f, 0.f}; }
#pragma unroll
        for (int ai = 0; ai < 2; ++ai)
#pragma unroll
            for (int m = 0; m < 4; ++m) {
                const int row = row0 + ai * HALF + m * 16;
                bf16_t* rowp = base + (size_t)row * 512 + col0;
                f32x4 t0 = (f32x4){0.f, 0.f, 0.f, 0.f}, t1 = t0;
                if (grp == 3 || grp == 4) { const float* tp = ROPE + ((size_t)(row & 2047) * 64 + 16 * wc + 4 * fq) * 2; t0 = *(const f32x4*)tp; t1 = *(const f32x4*)(tp + 4); }
#pragma unroll
                for (int bj = 0; bj < 2; ++bj) {
                    f32x4 v0 = acc[ai][bj][m][0], v1 = acc[ai][bj][m][1];
                    if (grp == 0) { v0 = v0 * C2; v1 = v1 * C2; }
                    else if (grp == 1) { cs[bj][0] += v0; cs[bj][1] += v1; }
                    else if (grp == 3 || grp == 4) {
                        const float sc = (grp == 4) ? KSC : 1.0f;
                        f32x4 r0, r1;
                        r0[0] = (v0[0] * t0[0] - v0[1] * t0[1]) * sc; r0[1] = (v0[0] * t0[1] + v0[1] * t0[0]) * sc;
                        r0[2] = (v0[2] * t0[2] - v0[3] * t0[3]) * sc; r0[3] = (v0[2] * t0[3] + v0[3] * t0[2]) * sc;
                        r1[0] = (v1[0] * t1[0] - v1[1] * t1[1]) * sc; r1[1] = (v1[0] * t1[1] + v1[1] * t1[0]) * sc;
                        r1[2] = (v1[2] * t1[2] - v1[3] * t1[3]) * sc; r1[3] = (v1[2] * t1[3] + v1[3] * t1[2]) * sc;
                        v0 = r0; v1 = r1;
                    } else if (grp == 6) {
#pragma unroll
                        for (int j = 0; j < 4; ++j) { v0[j] = fast_silu(v0[j]); v1[j] = fast_silu(v1[j]); }
                    }
                    *(u32x4*)(rowp + bj * HALF) = pack8(v0, v1);
                }
            }
        if (grp == 1) {
#pragma unroll
            for (int bj = 0; bj < 2; ++bj)
#pragma unroll
                for (int n = 0; n < 2; ++n) {
                    f32x4 s = cs[bj][n];
#pragma unroll
                    for (int o = 1; o < 16; o <<= 1) { s[0] += __shfl_xor(s[0], o); s[1] += __shfl_xor(s[1], o); s[2] += __shfl_xor(s[2], o); s[3] += __shfl_xor(s[3], o); }
                    if (fr == 0) *(f32x4*)(KMP + (size_t)(u.pm * 2 + wr) * 512 + col0 + bj * HALF + 4 * n) = s;
                }
        }
    }
};

struct EpiOutProj {
    static constexpr bool PERM = false;
    const float* xin; float* out; const float* g1;
    const float* assq;
    bool FIRST;
    __device__ __forceinline__ void operator()(const Acc& acc, const Unit& u, int wr, int wc, int fr, int fq) const {
        const int b = u.pm >> 3;
        const int col0 = u.pn * 256 + wc * 32 + 4 * fq;
        const int row0 = u.pm * 256 + wr * 64 + fr;
        f32x4 gv[2][2];
#pragma unroll
        for (int bj = 0; bj < 2; ++bj)
#pragma unroll
            for (int n = 0; n < 2; ++n) gv[bj][n] = *(const f32x4*)(g1 + (size_t)b * 6144 + col0 + bj * HALF + n * 16);
#pragma unroll
        for (int ai = 0; ai < 2; ++ai)
#pragma unroll
            for (int m = 0; m < 4; ++m) {
                const int row = row0 + ai * HALF + m * 16;
                float rs = 1.0f;
                if (FIRST) { const f32x4 a = *(const f32x4*)(assq + (size_t)row * 8), c = *(const f32x4*)(assq + (size_t)row * 8 + 4);
                    const float ss = ((a[0] + a[1]) + (a[2] + a[3])) + ((c[0] + c[1]) + (c[2] + c[3])); rs = 1.0f / sqrtf(ss * (1.0f / 512.0f) + 1e-6f); }
                const size_t off = (size_t)row * 1024 + col0;
#pragma unroll
                for (int bj = 0; bj < 2; ++bj)
#pragma unroll
                    for (int n = 0; n < 2; ++n) {
                        const f32x4 bs = *(const f32x4*)((FIRST ? xin : (const float*)out) + off + bj * HALF + n * 16);
                        *(f32x4*)(out + off + bj * HALF + n * 16) = bs + gv[bj][n] * (acc[ai][bj][m][n] * rs);
                    }
            }
    }
};

struct EpiSwiGLU {
    static constexpr bool PERM = true;
    bf16_t* H; int ldh;
    __device__ __forceinline__ void operator()(const Acc& acc, const Unit& u, int wr, int wc, int fr, int fq) const {
        const int col0 = u.pn * 128 + wc * 32 + 8 * fq;
        const int row0 = u.pm * 256 + wr * 64 + fr;
#pragma unroll
        for (int ai = 0; ai < 2; ++ai)
#pragma unroll
            for (int m = 0; m < 4; ++m) {
                const int row = row0 + ai * HALF + m * 16;
                f32x4 v0, v1;
#pragma unroll
                for (int j = 0; j < 4; ++j) { v0[j] = fast_silu(acc[ai][0][m][0][j]) * acc[ai][1][m][0][j]; v1[j] = fast_silu(acc[ai][0][m][1][j]) * acc[ai][1][m][1][j]; }
                *(u32x4*)(H + (size_t)row * ldh + col0) = pack8(v0, v1);
            }
    }
};

struct EpiDown {
    static constexpr bool PERM = false;
    float* out; const float* g2; bf16_t* YS; const int* srow; const float* swt; bool moe;
    __device__ __forceinline__ void operator()(const Acc& acc, const Unit& u, int wr, int wc, int fr, int fq) const {
        const int col0 = u.pn * 256 + wc * 32 + 4 * fq;
        const int row0 = u.pm * 256 + wr * 64 + fr;
        if (!moe) {
            const int b = u.pm >> 3;
            f32x4 gv[2][2];
#pragma unroll
            for (int bj = 0; bj < 2; ++bj)
#pragma unroll
                for (int n = 0; n < 2; ++n) gv[bj][n] = *(const f32x4*)(g2 + (size_t)b * 6144 + col0 + bj * HALF + n * 16);
#pragma unroll
            for (int ai = 0; ai < 2; ++ai)
#pragma unroll
                for (int m = 0; m < 4; ++m) {
                    const size_t off = (size_t)(row0 + ai * HALF + m * 16) * 1024 + col0;
#pragma unroll
                    for (int bj = 0; bj < 2; ++bj)
#pragma unroll
                        for (int n = 0; n < 2; ++n) { const f32x4 bs = *(const f32x4*)(out + off + bj * HALF + n * 16); *(f32x4*)(out + off + bj * HALF + n * 16) = bs + gv[bj][n] * acc[ai][bj][m][n]; }
                }
        } else {
#pragma unroll
            for (int ai = 0; ai < 2; ++ai)
#pragma unroll
                for (int m = 0; m < 4; ++m) {
                    const int pos = row0 + ai * HALF + m * 16;
                    const int sr = srow[pos];
                    if (sr >= 0) { const float w = swt[pos]; bf16_t* rowp = YS + (size_t)sr * 1024 + col0;
#pragma unroll
                        for (int bj = 0; bj < 2; ++bj)
#pragma unroll
                            for (int n = 0; n < 2; ++n) { const f32x4 v = acc[ai][bj][m][n] * w; pg8::u32x2 o; o.x = cvt_pk_bf16(v[0], v[1]); o.y = cvt_pk_bf16(v[2], v[3]); *(pg8::u32x2*)(rowp + bj * HALF + n * 16) = o; } }
                }
        }
    }
};
}
namespace fa {
#define FA_LAS __attribute__((address_space(3)))
typedef unsigned short bf16_t;
typedef short bf16x8 __attribute__((ext_vector_type(8)));
typedef short s16x4 __attribute__((ext_vector_type(4)));
typedef float f32x16 __attribute__((ext_vector_type(16)));
typedef float f32x4 __attribute__((ext_vector_type(4)));
typedef unsigned u32x4 __attribute__((ext_vector_type(4)));
typedef float f32x2_t __attribute__((ext_vector_type(2))); typedef __bf16 bf16x2_t __attribute__((ext_vector_type(2)));
constexpr int L_K = 0, L_V = 32768, L_WSF = 65536, L_KM = 67584, L_BYTES = 69632, SLOT = 16384;
constexpr float NEG = -1.0e30f;
__device__ __forceinline__ int crow(int r, int hi) { return (r & 3) + 8 * (r >> 2) + 4 * hi; }
__device__ __forceinline__ void glds16(const void* gsrc, unsigned lds_dst) { unsigned keep;
    asm volatile("s_mov_b32 %0, m0\n\ts_mov_b32 m0, %2\n\ts_nop 0\n\tglobal_load_lds_dwordx4 %1, off\n\ts_mov_b32 m0, %0" : "=&s"(keep) : "v"(gsrc), "s"(lds_dst) : "memory"); }
__device__ __forceinline__ unsigned cvtpk_s(float lo, float hi) { return h16::pk(lo, hi); }
__device__ __forceinline__ float bf2f(short s) { return h16::one((unsigned short)s); }
typedef short v4i16_t __attribute__((ext_vector_type(4)));
__device__ __forceinline__ s16x4 vtr(FA_LAS const unsigned char* p) { return __builtin_bit_cast(s16x4, __builtin_amdgcn_ds_read_tr16_b64_v4i16((FA_LAS v4i16_t*)p)); }
#define FA_WAIT_BAR() asm volatile("s_waitcnt vmcnt(0) lgkmcnt(0)\n\ts_barrier" ::: "memory")
#define FA_LBAR() asm volatile("s_waitcnt lgkmcnt(0)\n\ts_barrier" ::: "memory")

struct Tensors {
    const bf16_t* Q; const bf16_t* K; const bf16_t* V;
    bf16_t* CAT;
    float* ASSQ;
    const float* KMP;
    const bf16_t* GR;
    const float* ret_g;
};

template <bool RET>
__device__ __forceinline__ void attn_unit(int b, int h, int qblk, const Tensors& T, FA_LAS unsigned char* shm) {
    constexpr int DH = RET ? 128 : 64, ND0 = DH / 16, NDB = DH / 32, NPC = DH / 64;
    int tid_ = threadIdx.x; asm volatile("" : "+v"(tid_));
    const int tid = tid_, lane = tid & 63, r32 = lane & 31, hi = lane >> 5; const int wid = __builtin_amdgcn_readfirstlane(tid >> 6);
    const size_t rowbase = (size_t)b * 2048; const int q0 = qblk * 256;
    const unsigned lds0 = (unsigned)(unsigned long)shm;
    FA_LAS float* wsf = (FA_LAS float*)(shm + L_WSF) + wid * 64;
    FA_LAS float* KM = (FA_LAS float*)(shm + L_KM);
    const bf16_t* Kh = T.K + rowbase * 512 + h * DH; const bf16_t* Vh = T.V + rowbase * 512 + h * DH;
    const int NT = 4 * (qblk + 1);
#define FA_KV0(i) ((((i) < 4) ? qblk : (qblk - 1 - (((i) - 4) >> 2))) * 256 + ((i) & 3) * 64)
#define FA_DMA(i) do { const int kv0_ = FA_KV0(i); const unsigned so_ = (unsigned)(((i) & 1) * SLOT); \
        _Pragma("unroll") for (int pp = 0; pp < NPC; ++pp) { const int p = wid + 8 * pp; \
            glds16(Kh + (size_t)(kv0_ + lane) * 512 + p * 8, (unsigned)__builtin_amdgcn_readfirstlane(lds0 + L_K + so_ + p * 1024)); } \
        _Pragma("unroll") for (int pp = 0; pp < NPC; ++pp) { const int p = wid + 8 * pp; \
            glds16(Vh + (size_t)(kv0_ + 16 * (p & 3) + (lane >> 2)) * 512 + (p >> 2) * 32 + (lane & 3) * 8, (unsigned)__builtin_amdgcn_readfirstlane(lds0 + L_V + so_ + p * 1024)); } } while (0)
    FA_DMA(0);
    const bf16_t* Qw = T.Q + (rowbase + q0 + wid * 32 + r32) * 512 + h * DH;
    bf16x8 qr[ND0];
#pragma unroll
    for (int d0 = 0; d0 < ND0; ++d0) qr[d0] = *(const bf16x8*)(Qw + d0 * 16 + hi * 8);
    unsigned selmask = 0xffu;
    float cfac[16]; float lg2 = 0.f;
    if (!RET) {
        { const int j = tid >> 6, d = tid & 63; const float* kp = T.KMP + ((size_t)(b * 8 + j) * 2) * 512 + h * 64 + d; KM[tid] = kp[0] + kp[512]; }
        FA_LBAR();
        float g[8];
#pragma unroll
        for (int j = 0; j < 8; ++j) g[j] = 0.f;
#pragma unroll
        for (int d0 = 0; d0 < ND0; ++d0)
#pragma unroll
            for (int jj = 0; jj < 8; ++jj) { const float qv = bf2f(qr[d0][jj]); const int d = 16 * d0 + 8 * hi + jj;
#pragma unroll
                for (int j = 0; j < 8; ++j) g[j] += qv * KM[j * 64 + d]; }
#pragma unroll
        for (int j = 0; j < 8; ++j) g[j] += __shfl_xor(g[j], 32);
        selmask = 0u;
#pragma unroll
        for (int j = 0; j < 8; ++j) { int rank = 0;
#pragma unroll
            for (int mm = 0; mm < 8; ++mm) rank += (mm < qblk && (g[mm] > g[j] || (g[mm] == g[j] && mm < j))) ? 1 : 0;
            if (j < qblk && rank < 3) selmask |= 1u << j; }
    } else {
        lg2 = log2f(1.0f - exp2f(-5.0f - (float)h));
#pragma unroll
        for (int r = 0; r < 16; ++r) cfac[r] = exp2f(-lg2 * (float)((r & 3) + 8 * (r >> 2)));
    }
    f32x16 o[NDB];
#pragma unroll
    for (int db = 0; db < NDB; ++db) o[db] = f32x16{};
    float mrow = NEG, lrow = 0.f;
    const int qrel = wid * 32 + r32;
    for (int i = 0; i < NT; ++i) {
        FA_WAIT_BAR();
        if (i + 1 < NT) FA_DMA(i + 1);
        const bool diag = i < 4; const int t = i & 3; const int j = diag ? qblk : (qblk - 1 - ((i - 4) >> 2));
        const bool mysel = RET ? true : (((selmask >> j) & 1u) != 0u);
        const bool skip = diag ? (64 * t > 32 * wid + 31) : (RET ? false : !__any(mysel));
        if (skip) continue;
        const unsigned so = (unsigned)((i & 1) * SLOT);
        f32x16 p0 = f32x16{}, p1 = f32x16{};
        { FA_LAS const unsigned char* kb = shm + L_K + so + hi * 1024 + r32 * 16;
#pragma unroll
          for (int d0 = 0; d0 < ND0; ++d0) { const bf16x8 b0 = *(FA_LAS const bf16x8*)(kb + d0 * 2048); const bf16x8 b1 = *(FA_LAS const bf16x8*)(kb + d0 * 2048 + 512);
              p0 = __builtin_amdgcn_mfma_f32_32x32x16_f16(__builtin_bit_cast(h16::f16x8_t, b0), __builtin_bit_cast(h16::f16x8_t, qr[d0]), p0, 0, 0, 0); p1 = __builtin_amdgcn_mfma_f32_32x32x16_f16(__builtin_bit_cast(h16::f16x8_t, b1), __builtin_bit_cast(h16::f16x8_t, qr[d0]), p1, 0, 0, 0); } }
        if (RET) {
            const int qpos = q0 + qrel; const int kv0 = j * 256 + t * 64;
            const float base = (float)(qpos - kv0 - 4 * hi);
            const float rf0 = exp2f(lg2 * base), rf1 = exp2f(lg2 * (base - 32.0f));
#pragma unroll
            for (int r = 0; r < 16; ++r) { p0[r] *= rf0 * cfac[r]; p1[r] *= rf1 * cfac[r]; }
            if (diag) { const int kb_ = 64 * t + 4 * hi;
#pragma unroll
                for (int r = 0; r < 16; ++r) { const int kv = kb_ + (r & 3) + 8 * (r >> 2); if (kv > qrel) p0[r] = 0.f; if (kv + 32 > qrel) p1[r] = 0.f; } }
        } else {
            if (diag) { const int kb_ = 64 * t + 4 * hi;
#pragma unroll
                for (int r = 0; r < 16; ++r) { const int kv = kb_ + (r & 3) + 8 * (r >> 2); if (kv > qrel) p0[r] = NEG; if (kv + 32 > qrel) p1[r] = NEG; } }
            else if (!mysel) {
#pragma unroll
                for (int r = 0; r < 16; ++r) { p0[r] = NEG; p1[r] = NEG; } }
            float rm = fmaxf(p0[0], p1[0]);
#pragma unroll
            for (int r = 1; r < 16; ++r) rm = fmaxf(rm, fmaxf(p0[r], p1[r]));
            rm = fmaxf(rm, __shfl_xor(rm, 32));
            const float mn = fmaxf(mrow, rm); const float f = exp2f(mrow - mn); mrow = mn;
            float s = 0.f;
#pragma unroll
            for (int r = 0; r < 16; ++r) { p0[r] = exp2f(p0[r] - mn); p1[r] = exp2f(p1[r] - mn); s += p0[r] + p1[r]; }
            lrow = lrow * f + s;
            if (__any(f != 1.0f)) {
                asm volatile("" ::: "memory");
                if (hi == 0) wsf[r32] = f;
                asm volatile("s_waitcnt lgkmcnt(0)" ::: "memory");
#pragma unroll
                for (int r = 0; r < 16; ++r) { const float fr_ = wsf[crow(r, hi)];
#pragma unroll
                    for (int db = 0; db < NDB; ++db) o[db][r] *= fr_; }
                asm volatile("s_waitcnt lgkmcnt(0)" ::: "memory");
            }
        }
        bf16x8 pa[4];
        { u32x4 w;
          w.x = cvtpk_s(p0[0], p0[1]); w.y = cvtpk_s(p0[2], p0[3]); w.z = cvtpk_s(p0[4], p0[5]); w.w = cvtpk_s(p0[6], p0[7]); pa[0] = __builtin_bit_cast(bf16x8, w);
          w.x = cvtpk_s(p0[8], p0[9]); w.y = cvtpk_s(p0[10], p0[11]); w.z = cvtpk_s(p0[12], p0[13]); w.w = cvtpk_s(p0[14], p0[15]); pa[1] = __builtin_bit_cast(bf16x8, w);
          w.x = cvtpk_s(p1[0], p1[1]); w.y = cvtpk_s(p1[2], p1[3]); w.z = cvtpk_s(p1[4], p1[5]); w.w = cvtpk_s(p1[6], p1[7]); pa[2] = __builtin_bit_cast(bf16x8, w);
          w.x = cvtpk_s(p1[8], p1[9]); w.y = cvtpk_s(p1[10], p1[11]); w.z = cvtpk_s(p1[12], p1[13]); w.w = cvtpk_s(p1[14], p1[15]); pa[3] = __builtin_bit_cast(bf16x8, w); }
        { FA_LAS const unsigned char* vb = shm + L_V + so + ((lane >> 4) & 1) * 32 + (lane & 3) * 8 + (4 * hi + ((lane & 15) >> 2)) * 64;
#pragma unroll
          for (int db = 0; db < NDB; ++db)
#pragma unroll
              for (int ks = 0; ks < 4; ++ks) { const s16x4 lo = vtr(vb + db * 4096 + ks * 1024), hh = vtr(vb + db * 4096 + ks * 1024 + 512);
                  const bf16x8 vf = (bf16x8){lo[0], lo[1], lo[2], lo[3], hh[0], hh[1], hh[2], hh[3]};
                  o[db] = __builtin_amdgcn_mfma_f32_32x32x16_f16(__builtin_bit_cast(h16::f16x8_t, pa[ks]), __builtin_bit_cast(h16::f16x8_t, vf), o[db], 0, 0, 0); } }
    }
    float rli[16];
    if (!RET) {
        const float l = lrow + __shfl_xor(lrow, 32);
        asm volatile("" ::: "memory");
        if (hi == 0) wsf[32 + r32] = 1.0f / l;
        asm volatile("s_waitcnt lgkmcnt(0)" ::: "memory");
#pragma unroll
        for (int r = 0; r < 16; ++r) rli[r] = wsf[32 + crow(r, hi)];
    } else {
#pragma unroll
        for (int r = 0; r < 16; ++r) rli[r] = 1.0f;
    }
    FA_LBAR();
    FA_LAS bf16_t* stg = (FA_LAS bf16_t*)(shm + wid * 8192);
#pragma unroll
    for (int r = 0; r < 16; ++r) { const int orow = crow(r, hi);
#pragma unroll
        for (int db = 0; db < NDB; ++db) { const unsigned pk = cvtpk_s(o[db][r] * rli[r], 0.f); stg[orow * DH + db * 32 + r32] = (bf16_t)(pk & 0xffffu); } }
    asm volatile("s_waitcnt lgkmcnt(0)" ::: "memory");
    const size_t tok0 = rowbase + q0 + wid * 32;
    if (!RET) {
#pragma unroll
        for (int i = 0; i < 4; ++i) { const int row = i * 8 + (lane >> 3), ch = lane & 7;
            const u32x4 v = *(FA_LAS const u32x4*)(stg + row * 64 + ch * 8);
            float ss = 0.f;
#pragma unroll
            for (int k = 0; k < 4; ++k) { const float a = h16::lo(v[k]), c = h16::hi(v[k]); ss += a * a + c * c; }
            ss += __shfl_xor(ss, 1); ss += __shfl_xor(ss, 2); ss += __shfl_xor(ss, 4);
            if (ch == 0) T.ASSQ[(tok0 + row) * 8 + h] = ss;
            *(u32x4*)(T.CAT + (tok0 + row) * 1024 + h * 64 + ch * 8) = v; }
    } else {
#pragma unroll
        for (int i = 0; i < 8; ++i) { const int row = i * 4 + (lane >> 4), ch = lane & 15;
            const u32x4 v = *(FA_LAS const u32x4*)(stg + row * 128 + ch * 8);
            float x[8];
#pragma unroll
            for (int k = 0; k < 4; ++k) { x[2 * k] = h16::lo(v[k]); x[2 * k + 1] = h16::hi(v[k]); }
            float ss = 0.f;
#pragma unroll
            for (int k = 0; k < 8; ++k) ss += x[k] * x[k];
            ss += __shfl_xor(ss, 1); ss += __shfl_xor(ss, 2); ss += __shfl_xor(ss, 4); ss += __shfl_xor(ss, 8);
            const float rs = 1.0f / sqrtf(ss * (1.0f / 128.0f) + 1e-6f);
            const u32x4 gv = *(const u32x4*)(T.GR + (tok0 + row) * 512 + h * 128 + ch * 8);
            const f32x4 w0 = *(const f32x4*)(T.ret_g + h * 128 + ch * 8), w1 = *(const f32x4*)(T.ret_g + h * 128 + ch * 8 + 4);
            const float wg[8] = {w0[0], w0[1], w0[2], w0[3], w1[0], w1[1], w1[2], w1[3]};
            float y[8];
#pragma unroll
            for (int k = 0; k < 4; ++k) { const float g0 = h16::lo(gv[k]), g1 = h16::hi(gv[k]);
                y[2 * k] = x[2 * k] * rs * wg[2 * k] * g0; y[2 * k + 1] = x[2 * k + 1] * rs * wg[2 * k + 1] * g1; }
            u32x4 ov; ov.x = cvtpk_s(y[0], y[1]); ov.y = cvtpk_s(y[2], y[3]); ov.z = cvtpk_s(y[4], y[5]); ov.w = cvtpk_s(y[6], y[7]);
            *(u32x4*)(T.CAT + (tok0 + row) * 1024 + 512 + h * 128 + ch * 8) = ov; }
    }
    FA_LBAR();
#undef FA_KV0
#undef FA_DMA
}
}
namespace mk {
#define GAS __attribute__((address_space(1)))
#define LAS __attribute__((address_space(3)))
typedef unsigned short bf16;
typedef unsigned v4u __attribute__((ext_vector_type(4)));
typedef unsigned v2u __attribute__((ext_vector_type(2)));
typedef float f32x4 __attribute__((ext_vector_type(4)));
typedef int i32x4 __attribute__((ext_vector_type(4)));
typedef GAS unsigned gu32;
#define RLX_AGENT __ATOMIC_RELAXED, __HIP_MEMORY_SCOPE_AGENT
#define LDS_WAIT() asm volatile("s_waitcnt lgkmcnt(0)" ::: "memory")
#define VM_WAIT() asm volatile("s_waitcnt vmcnt(0)" ::: "memory")
constexpr int NWAVES = 8;
constexpr size_t MiB = 1u << 20, KiB = 1u << 10;
constexpr size_t WS_CTL = 0;
constexpr size_t CTL_ZERO_BYTES = 64 * KiB;
constexpr size_t WS_MOD = 64 * KiB;
constexpr size_t WS_KMP = 512 * KiB;
constexpr size_t WS_EIDX = 768 * KiB;
constexpr size_t WS_EW = 896 * KiB;
constexpr size_t WS_ROPE = 1 * MiB;
constexpr size_t WS_ASSQ = 2 * MiB;
constexpr size_t WS_SROW = 2 * MiB + 512 * KiB;
constexpr size_t WS_SWT = 2 * MiB + 768 * KiB;
constexpr size_t WS_WCNT = 3 * MiB;
constexpr size_t WS_SEG = 3 * MiB + 64 * KiB;
constexpr size_t WS_SEGD = 3 * MiB + 65 * KiB;
constexpr size_t WS_MGU = 8 * MiB;
constexpr size_t WS_MDN = 96 * MiB;
constexpr size_t WS_XA = 140 * MiB;
constexpr size_t WS_XS = 172 * MiB;
constexpr size_t WS_YS = 140 * MiB;
constexpr size_t WS_WIN = 240 * MiB;
constexpr size_t WS_WOUT = 254 * MiB;
constexpr size_t WS_FGU = 258 * MiB;
constexpr size_t WS_FDN = 269 * MiB;
constexpr size_t WS_QKV = 275 * MiB;
constexpr size_t WS_CAT = 387 * MiB;
constexpr size_t WS_HD = 275 * MiB;
constexpr size_t WS_HM = 240 * MiB;
constexpr size_t WS_END = 428 * MiB;
constexpr int XS_ROWS = 34816;
constexpr int CW_BAR = 1024;

constexpr int RING_BYTES = 131072, LDSCTL_OFF = RING_BYTES, MISC_OFF = LDSCTL_OFF + 320, LDS_BYTES = 147456;

#define XB_TMO      128
#define XB_XCNT(j)  (256  + 64 * (j))
#define XB_XSUB(j)  (1280 + 64 * (j))
#define XB_XGEN(j)  (2304 + 64 * (j))
#define XB_TOP      3328
#define XB_TOPGEN   3392
#define XCD_BAR_WORDS 3456
#define XB_SPIN_CAP (1u << 18)
__device__ __forceinline__ unsigned xb_ld(unsigned* p)              { return __hip_atomic_load(p, __ATOMIC_RELAXED, __HIP_MEMORY_SCOPE_AGENT); }
__device__ __forceinline__ unsigned xb_add(unsigned* p, unsigned v) { return __hip_atomic_fetch_add(p, v, __ATOMIC_RELAXED, __HIP_MEMORY_SCOPE_AGENT); }
__device__ __forceinline__ unsigned xb_xcc_id() { return (unsigned)__builtin_amdgcn_s_getreg((3 << 11) | 20) & 0xFu; }
#define XB_SPIN(cond, bar) do { unsigned _sp = 0; while (cond) { __builtin_amdgcn_s_sleep(1); \
    if ((++_sp & 255u) == 0u) { if (xb_ld(&(bar)[XB_TMO])) break; if (_sp > XB_SPIN_CAP) { atomicAdd(&(bar)[XB_TMO], 1u); break; } } } } while (0)
struct XcdBarrier { unsigned* bar; unsigned x; volatile LAS unsigned* st; };
__device__ __forceinline__ XcdBarrier xcd_barrier_post(unsigned* bar, volatile LAS unsigned* st) {
    XcdBarrier b; b.bar = bar; b.x = xb_xcc_id(); b.st = st;
    if (threadIdx.x == 0) (void)xb_add(&bar[XB_XCNT(b.x)], 1u);
    return b;
}
__device__ __forceinline__ void xcd_barrier_complete(unsigned* bar, unsigned x, unsigned& nloc, unsigned& nx) {
    const unsigned G = gridDim.x * gridDim.y * gridDim.z;
    unsigned sum, cnt, mine, sp = 0u;
    for (;;) {
        sum = 0u; cnt = 0u; mine = 0u;
#pragma unroll
        for (unsigned j = 0; j < 16; ++j) { const unsigned c = xb_ld(&bar[XB_XCNT(j)]); sum += c; cnt += (c > 0u) ? 1u : 0u; mine = (j == x) ? c : mine; }
        if (sum == G) break;
        __builtin_amdgcn_s_sleep(1);
        if ((++sp & 255u) == 0u) { if (xb_ld(&bar[XB_TMO])) break; if (sp > XB_SPIN_CAP) { atomicAdd(&bar[XB_TMO], 1u); break; } }
    }
    nloc = mine > 0u ? mine : 1u; nx = cnt > 0u ? cnt : 1u;
}
__device__ __forceinline__ void xcd_barrier(const XcdBarrier& b) {
    asm volatile("s_waitcnt vmcnt(0)" ::: "memory");
    __syncthreads();
    if (threadIdx.x == 0) {
        unsigned* bar = b.bar;
        __builtin_amdgcn_s_waitcnt(0);
        unsigned nloc = b.st[0], nx = b.st[1];
        if (nloc == 0u) { xcd_barrier_complete(bar, b.x, nloc, nx); b.st[0] = nloc; b.st[1] = nx; }
        const unsigned old = xb_add(&bar[XB_XSUB(b.x)], 1u);
        const unsigned gen = old / nloc;
        if (old + 1u == (gen + 1u) * nloc) {
            __builtin_amdgcn_fence(__ATOMIC_RELEASE, "agent");
            asm volatile("s_waitcnt vmcnt(0)" ::: "memory");
            const unsigned og = xb_add(&bar[XB_TOP], 1u);
            const unsigned tg = og / nx;
            if (og + 1u == (tg + 1u) * nx) xb_add(&bar[XB_TOPGEN], 1u);
            else XB_SPIN(xb_ld(&bar[XB_TOPGEN]) == tg, bar);
            __builtin_amdgcn_fence(__ATOMIC_ACQUIRE, "agent");
            xb_add(&bar[XB_XGEN(b.x)], 1u);
            asm volatile("s_waitcnt vmcnt(0)" ::: "memory");
        } else {
            XB_SPIN(xb_ld(&bar[XB_XGEN(b.x)]) == gen, bar);
            __builtin_amdgcn_fence(__ATOMIC_ACQUIRE, "agent");
            asm volatile("s_waitcnt vmcnt(0)" ::: "memory");
        }
    }
    __syncthreads();
}

__device__ __forceinline__ unsigned f2bf(float f) { unsigned u = __builtin_bit_cast(unsigned, f); return (u + 0x7fffu + ((u >> 16) & 1u)) >> 16; }
__device__ __forceinline__ unsigned pk2(float lo, float hi) { return h16::pk(lo, hi); }
__device__ __forceinline__ float wave_sum(float v) {
#pragma unroll
    for (int o = 1; o < 64; o <<= 1) v += __shfl_xor(v, o);
    return v;
}
__device__ __forceinline__ int wave_sum_i(int v) {
#pragma unroll
    for (int o = 1; o < 64; o <<= 1) v += __shfl_xor(v, o);
    return v;
}

struct Inputs {
    const float *x, *c, *norm_mix_g, *norm_ffn_g, *ada_w, *ada_b, *w_in, *w_out, *att_g, *ret_g, *fw_gate, *fw_up, *fw_down, *router_w, *mw_gate, *mw_up, *mw_down, *final_g;
};

template <class SrcFn> __device__ __forceinline__ void transpose_item(SrcFn src, int K, bf16* WT, int k0, int n0, LAS float* scr, int lane) {
#pragma unroll 8
    for (int i = 0; i < 32; ++i) { const int kk = 2 * i + (lane >> 5); scr[kk * 33 + (lane & 31)] = src(k0 + kk, n0 + (lane & 31)); }
    LDS_WAIT(); asm volatile("" ::: "memory");
    const int c = lane & 7;
#pragma unroll
    for (int j = 0; j < 4; ++j) { const int n = (lane >> 3) + 8 * j; const LAS float* s = scr + (8 * c) * 33 + n;
        v4u o; o.x = pk2(s[0 * 33], s[1 * 33]); o.y = pk2(s[2 * 33], s[3 * 33]); o.z = pk2(s[4 * 33], s[5 * 33]); o.w = pk2(s[6 * 33], s[7 * 33]);
        *(GAS v4u*)(WT + (size_t)(n0 + n) * K + k0 + 8 * c) = o; }
    LDS_WAIT(); asm volatile("" ::: "memory");
}
__device__ __forceinline__ int rot_src_col(int n) {
    if (n < 1536 || n >= 2560) return n;
    const int hb = (n - 1536) & ~127, p = (n - 1536) & 127;
    return 1536 + hb + 4 * (p >> 3) + ((p & 7) >> 1) + 64 * (p & 1);
}
constexpr int IT_WIN = 16 * 112, IT_WOUT = 16 * 32, IT_GU = 16 * 176, IT_DN = 44 * 32;
constexpr int IT_TOTAL = 2 * IT_WIN + 2 * IT_WOUT + IT_GU + IT_DN + 8 * (IT_GU + IT_DN);

template <class InP> __device__ __forceinline__ void p0_prologue(InP inp, unsigned char* ws, LAS unsigned char* lds, int vcu, int G, int wave, int lane, int tid, int moe_w) {
    Inputs in; in.c = inp->c; in.ada_w = inp->ada_w; in.ada_b = inp->ada_b; in.w_in = inp->w_in; in.w_out = inp->w_out; in.att_g = inp->att_g; in.fw_gate = inp->fw_gate; in.fw_up = inp->fw_up; in.fw_down = inp->fw_down; in.mw_gate = inp->mw_gate; in.mw_up = inp->mw_up; in.mw_down = inp->mw_down;
    if (vcu < 192) {
        LAS float* cs = (LAS float*)lds;
        LAS float* part = (LAS float*)(lds + 32768);
        for (int i = tid; i < 8 * 1024; i += 512) { const float v = in.c[i]; cs[i] = v / (1.0f + __expf(-v)); }
        __syncthreads();
        const int n0 = vcu * 64, l = n0 / 6144, nn = n0 % 6144 + lane;
        const float* wp = in.ada_w + (size_t)l * 1024 * 6144 + (size_t)(wave * 128) * 6144 + nn;
        float acc[8];
#pragma unroll
        for (int b = 0; b < 8; ++b) acc[b] = 0.f;
#pragma unroll 8
        for (int k = 0; k < 128; ++k) { const float wv = wp[(size_t)k * 6144];
#pragma unroll
            for (int b = 0; b < 8; ++b) acc[b] += cs[b * 1024 + wave * 128 + k] * wv; }
#pragma unroll
        for (int b = 0; b < 8; ++b) part[(wave * 8 + b) * 64 + lane] = acc[b];
        __syncthreads();
        { const int b = tid >> 6; float s = 0.f;
#pragma unroll
          for (int w = 0; w < 8; ++w) s += part[(w * 8 + b) * 64 + lane];
          ((float*)(ws + WS_MOD))[((size_t)l * 8 + b) * 6144 + nn] = s + in.ada_b[l * 6144 + nn]; }
        __syncthreads();
    }
    { const int g = vcu * 512 + tid; if (g < 2048 * 64) { const int pos = g >> 6, i = g & 63; const float inv = powf(10000.0f, -(float)i / 64.0f); const float ang = (float)pos * inv;
        float* rp = (float*)(ws + WS_ROPE) + (size_t)g * 2; rp[0] = (float)cos((double)ang); rp[1] = (float)sin((double)ang); } }
    LAS float* scr = (LAS float*)(lds + wave * 16384);
    const int gw = vcu * NWAVES + wave, NGW = G * NWAVES;
    const int it_end = moe_w ? IT_TOTAL : (2 * IT_WIN + 2 * IT_WOUT + IT_GU + IT_DN);
    for (int it = gw; it < it_end; it += NGW) {
        int r = it;
        if (r < 2 * IT_WIN) { const int l = r / IT_WIN; r -= l * IT_WIN; const float* W = in.w_in + (size_t)l * 1024 * 3584;
            transpose_item([=](int k, int n) { return W[(size_t)k * 3584 + rot_src_col(n)]; }, 1024, (bf16*)(ws + WS_WIN) + (size_t)l * 3584 * 1024, 64 * (r / 112), 32 * (r % 112), scr, lane); continue; }
        r -= 2 * IT_WIN;
        if (r < 2 * IT_WOUT) { const int l = r / IT_WOUT; r -= l * IT_WOUT; const float* W = in.w_out + (size_t)l * 1024 * 1024; const float* ag = in.att_g + l * 512;
            transpose_item([=](int k, int n) { return W[(size_t)k * 1024 + n] * (k < 512 ? ag[k] : 1.0f); }, 1024, (bf16*)(ws + WS_WOUT) + (size_t)l * 1024 * 1024, 64 * (r / 32), 32 * (r % 32), scr, lane); continue; }
        r -= 2 * IT_WOUT;
        const float *Wg, *Wu, *Wd; bf16 *Dgu, *Ddn;
        if (r < IT_GU + IT_DN) { Wg = in.fw_gate; Wu = in.fw_up; Wd = in.fw_down; Dgu = (bf16*)(ws + WS_FGU); Ddn = (bf16*)(ws + WS_FDN); }
        else { r -= IT_GU + IT_DN; const int e = r / (IT_GU + IT_DN); r -= e * (IT_GU + IT_DN);
            Wg = in.mw_gate + (size_t)e * 1024 * 2816; Wu = in.mw_up + (size_t)e * 1024 * 2816; Wd = in.mw_down + (size_t)e * 2816 * 1024;
            Dgu = (bf16*)(ws + WS_MGU) + (size_t)e * 5632 * 1024; Ddn = (bf16*)(ws + WS_MDN) + (size_t)e * 1024 * 2816; }
        if (r < IT_GU) {
            transpose_item([=](int k, int n) { const float* W = ((n >> 7) & 1) ? Wu : Wg; return W[(size_t)k * 2816 + (n >> 8) * 128 + (n & 127)]; }, 1024, Dgu, 64 * (r / 176), 32 * (r % 176), scr, lane); continue; }
        r -= IT_GU;
        transpose_item([=](int k, int n) { return Wd[(size_t)k * 1024 + n]; }, 2816, Ddn, 64 * (r / 32), 32 * (r % 32), scr, lane);
    }
}

template <int MODE>
__device__ __forceinline__ void norm_pass(const float* xsrc, const float* gain, const float* sh, const float* sc, bf16* dst,
                                          const float* router_w, int* eidx, float* ew, int* wcnt, int gw, int lane) {
    const int m0 = gw * 8, b = m0 >> 11;
    f32x4 gv[4], scv[4], shv[4];
#pragma unroll
    for (int j = 0; j < 4; ++j) { gv[j] = ((const f32x4*)gain)[lane + 64 * j]; scv[j] = ((const f32x4*)(sc + (size_t)b * 6144))[lane + 64 * j] + 1.0f; shv[j] = ((const f32x4*)(sh + (size_t)b * 6144))[lane + 64 * j]; }
    int cnt[8];
#pragma unroll
    for (int e = 0; e < 8; ++e) cnt[e] = 0;
    for (int i = 0; i < 8; ++i) {
        const int m = m0 + i;
        const f32x4* xr = (const f32x4*)(xsrc + (size_t)m * 1024) + lane;
        f32x4 v[4]; float s = 0.f;
#pragma unroll
        for (int j = 0; j < 4; ++j) { v[j] = xr[64 * j]; s += (v[j][0] * v[j][0] + v[j][1] * v[j][1]) + (v[j][2] * v[j][2] + v[j][3] * v[j][3]); }
        const float rs = 1.0f / sqrtf(wave_sum(s) * (1.0f / 1024.0f) + 1e-6f);
        v2u* o8 = (v2u*)(dst + (size_t)m * 1024) + lane;
#pragma unroll
        for (int j = 0; j < 4; ++j) { v[j] = v[j] * rs * gv[j] * scv[j] + shv[j]; v2u w; w.x = pk2(v[j][0], v[j][1]); w.y = pk2(v[j][2], v[j][3]); o8[64 * j] = w; }
        if (MODE == 1) {
            float lg[8];
#pragma unroll
            for (int e = 0; e < 8; ++e) lg[e] = 0.f;
#pragma unroll
            for (int j = 0; j < 4; ++j)
#pragma unroll
                for (int c = 0; c < 4; ++c) { const f32x4 w0 = *(const f32x4*)(router_w + (size_t)(4 * (lane + 64 * j) + c) * 8), w1 = *(const f32x4*)(router_w + (size_t)(4 * (lane + 64 * j) + c) * 8 + 4);
                    const float hv = v[j][c];
                    lg[0] += hv * w0[0]; lg[1] += hv * w0[1]; lg[2] += hv * w0[2]; lg[3] += hv * w0[3]; lg[4] += hv * w1[0]; lg[5] += hv * w1[1]; lg[6] += hv * w1[2]; lg[7] += hv * w1[3]; }
#pragma unroll
            for (int e = 0; e < 8; ++e) lg[e] = wave_sum(lg[e]);
            int i0 = 0; float b0 = lg[0];
#pragma unroll
            for (int e = 1; e < 8; ++e) if (lg[e] > b0) { b0 = lg[e]; i0 = e; }
            int i1 = -1; float b1 = -3.0e38f;
#pragma unroll
            for (int e = 0; e < 8; ++e) if (e != i0 && lg[e] > b1) { b1 = lg[e]; i1 = e; }
            const float e1 = __expf(b1 - b0);
#pragma unroll
            for (int e = 0; e < 8; ++e) cnt[e] += ((e == i0) ? 1 : 0) + ((e == i1) ? 1 : 0);
            if (lane == 0) { eidx[m * 2] = i0; eidx[m * 2 + 1] = i1; ew[m * 2] = 1.0f / (1.0f + e1); ew[m * 2 + 1] = e1 / (1.0f + e1); }
        }
    }
    if (MODE == 1) {
        int myc = 0;
#pragma unroll
        for (int e = 0; e < 8; ++e) myc = (lane == e) ? cnt[e] : myc;
        if (lane < 8) wcnt[gw * 8 + lane] = myc;
    }
}

__device__ __forceinline__ void place_pass(const int* wcnt, const int* eidx, const float* ew, const bf16* XA, bf16* XS, int* srow, float* swt, int* segout, int gw, int NGW, int lane) {
    int tot[8], pre[8];
#pragma unroll
    for (int e = 0; e < 8; ++e) { tot[e] = 0; pre[e] = 0; }
    for (int w = lane; w < NGW; w += 64) { const i32x4 a = *(const i32x4*)(wcnt + w * 8), c = *(const i32x4*)(wcnt + w * 8 + 4); const int inc = (w < gw) ? 1 : 0;
        tot[0] += a[0]; tot[1] += a[1]; tot[2] += a[2]; tot[3] += a[3]; tot[4] += c[0]; tot[5] += c[1]; tot[6] += c[2]; tot[7] += c[3];
        pre[0] += inc * a[0]; pre[1] += inc * a[1]; pre[2] += inc * a[2]; pre[3] += inc * a[3]; pre[4] += inc * c[0]; pre[5] += inc * c[1]; pre[6] += inc * c[2]; pre[7] += inc * c[3]; }
    int base[8]; int run = 0;
#pragma unroll
    for (int e = 0; e < 8; ++e) { tot[e] = wave_sum_i(tot[e]); pre[e] = wave_sum_i(pre[e]); base[e] = run + pre[e]; if (gw == 0 && lane == 0) segout[e] = run; run += (tot[e] + 255) & ~255; }
    if (gw == 0 && lane == 0) segout[8] = run;
    for (int i = 0; i < 16; ++i) {
        const int a = gw * 16 + i; const int ev = __builtin_amdgcn_readfirstlane(eidx[a]); int pos = 0;
#pragma unroll
        for (int e = 0; e < 8; ++e) if (ev == e) { pos = base[e]; base[e] += 1; }
        if (lane == 0) { srow[pos] = a; swt[pos] = ew[a]; }
        const v4u* s = (const v4u*)(XA + (size_t)(a >> 1) * 1024); v4u* d = (v4u*)(XS + (size_t)pos * 1024);
        d[lane] = s[lane]; d[lane + 64] = s[lane + 64];
    }
}

__device__ __forceinline__ void final_pass(float* xio, const bf16* YS, const float* g2, const float* fg, int gw, int lane) {
    const int m0 = gw * 8, b = m0 >> 11;
    f32x4 gv[4], g2v[4];
#pragma unroll
    for (int j = 0; j < 4; ++j) { gv[j] = ((const f32x4*)fg)[lane + 64 * j]; g2v[j] = ((const f32x4*)(g2 + (size_t)b * 6144))[lane + 64 * j]; }
    for (int i = 0; i < 8; ++i) {
        const int m = m0 + i;
        f32x4* xr = (f32x4*)(xio + (size_t)m * 1024) + lane;
        const v2u* y0 = (const v2u*)(YS + (size_t)(2 * m) * 1024) + lane; const v2u* y1 = (const v2u*)(YS + (size_t)(2 * m + 1) * 1024) + lane;
        f32x4 v[4]; float s = 0.f;
#pragma unroll
        for (int j = 0; j < 4; ++j) { v[j] = xr[64 * j]; const v2u a = y0[64 * j], c = y1[64 * j];
            f32x4 ys; ys[0] = h16::lo(a.x) + h16::lo(c.x); ys[1] = h16::hi(a.x) + h16::hi(c.x); ys[2] = h16::lo(a.y) + h16::lo(c.y); ys[3] = h16::hi(a.y) + h16::hi(c.y);
            v[j] = v[j] + g2v[j] * ys; s += (v[j][0] * v[j][0] + v[j][1] * v[j][1]) + (v[j][2] * v[j][2] + v[j][3] * v[j][3]); }
        const float rs = 1.0f / sqrtf(wave_sum(s) * (1.0f / 1024.0f) + 1e-6f);
#pragma unroll
        for (int j = 0; j < 4; ++j) xr[64 * j] = v[j] * rs * gv[j];
    }
}

constexpr int N_PHASES = 18;
struct Args { Inputs in; float* out; unsigned char* ws; int ph_lo, ph_hi, bar_region, moe_w; };

typedef const Args __attribute__((address_space(4))) CArgs;
__device__ __forceinline__ CArgs* kargs() { unsigned long off = 0; asm volatile("" : "+s"(off)); return (CArgs*)((const char __attribute__((address_space(4)))*)__builtin_amdgcn_kernarg_segment_ptr() + off); }

__global__ void __launch_bounds__(NWAVES * 64, 2) mega(Args args_unused) {
    extern __shared__ __attribute__((aligned(16))) unsigned char lds_raw[];
    LAS unsigned char* lds = (LAS unsigned char*)lds_raw;
    volatile LAS unsigned* MISC = (volatile LAS unsigned*)(lds + MISC_OFF);
    const int G = gridDim.x;
#define PHASE_IDS int tid = threadIdx.x; asm volatile("" : "+v"(tid)); int bx = blockIdx.x; asm volatile("" : "+s"(bx)); const int lane = tid & 63, wave = __builtin_amdgcn_readfirstlane(tid >> 6); \
    const int vcu = (G % 8 == 0) ? (bx % 8) * (G / 8) + bx / 8 : bx; const int gw = vcu * NWAVES + wave; (void)lane; (void)gw; (void)vcu;
    for (int u = threadIdx.x; u < (LDS_BYTES - LDSCTL_OFF) / 4; u += NWAVES * 64) ((LAS unsigned*)(lds + LDSCTL_OFF))[u] = 0u;
    __syncthreads();
    XcdBarrier bar;
    { CArgs* ka = kargs(); unsigned* barw = (unsigned*)(ka->ws + WS_CTL) + CW_BAR + ka->bar_region * XCD_BAR_WORDS; bar = xcd_barrier_post(barw, MISC + 8); }
    int lo, hi; { CArgs* ka = kargs(); lo = ka->ph_lo; hi = ka->ph_hi; }
#ifndef PHM
#define PHM 0x3ff
#endif
#define IN(k) (lo <= (k) && (k) < hi)
#define TY(t) (((PHM) >> (t)) & 1)
#define SEAM(k) do { if (IN(k) && IN((k) + 1)) xcd_barrier(bar); } while (0)

    if (TY(0) && IN(0)) { PHASE_IDS CArgs* ka = kargs(); p0_prologue(&ka->in, ka->ws, lds, vcu, G, wave, lane, tid, ka->moe_w); }
    SEAM(0);
    for (int l = 0; l < 2; ++l) {
        const int pb = 1 + 8 * l;
        if (TY(1) && IN(pb + 0)) { PHASE_IDS CArgs* ka = kargs(); unsigned char* ws = ka->ws; const float* mod = (const float*)(ws + WS_MOD) + (size_t)l * 8 * 6144;
            const float* xin = (l == 0) ? ka->in.x : (const float*)ka->out;
            if (gw < 2048) norm_pass<0>(xin, ka->in.norm_mix_g + l * 1024, mod + 0 * 1024, mod + 1 * 1024, (bf16*)(ws + WS_XA), nullptr, nullptr, nullptr, nullptr, gw, lane); }
        SEAM(pb + 0);
        if (TY(2) && IN(pb + 1)) { PHASE_IDS CArgs* ka = kargs(); unsigned char* ws = ka->ws;
            pg8::Gemm g{1024, 1024, 1024}; pg8::DenseSched S; S.init(ws + WS_XA, 1024, (bf16*)(ws + WS_WIN) + (size_t)l * 3584 * 1024, 1024, 16384, 3584, G, bx);
            epi::EpiInProj E{(bf16*)(ws + WS_QKV), (size_t)16384 * 512, (float*)(ws + WS_KMP), (const float*)(ws + WS_ROPE)};
            pg8::gemm_phase(lds, g, S, E);
        }
        SEAM(pb + 1);
        if (TY(3) && IN(pb + 2)) { PHASE_IDS CArgs* ka = kargs(); unsigned char* ws = ka->ws; bf16* QKV = (bf16*)(ws + WS_QKV); bf16* CAT = (bf16*)(ws + WS_CAT);
            const int k = bx >> 5, i = bx & 31;
            if (G == 256) {
                { fa::Tensors TR{QKV + (size_t)3 * 16384 * 512, QKV + (size_t)4 * 16384 * 512, QKV + (size_t)5 * 16384 * 512, CAT, (float*)(ws + WS_ASSQ), (const float*)(ws + WS_KMP), QKV + (size_t)6 * 16384 * 512, ka->in.ret_g + l * 512};
                  fa::attn_unit<true>(i >> 2, i & 3, 7 - k, TR, lds); }
                fa::Tensors TA{QKV, QKV + (size_t)1 * 16384 * 512, QKV + (size_t)2 * 16384 * 512, CAT, (float*)(ws + WS_ASSQ), (const float*)(ws + WS_KMP), nullptr, nullptr};
                for (int uu = 0; uu < 2; ++uu) fa::attn_unit<false>((2 * i + uu) >> 3, (2 * i + uu) & 7, k, TA, lds);
            }
        }
        SEAM(pb + 2);
        if (TY(4) && IN(pb + 3)) {
            for (int hf = 0; hf < 2; ++hf) { PHASE_IDS CArgs* ka = kargs(); unsigned char* ws = ka->ws; const float* mod = (const float*)(ws + WS_MOD) + (size_t)l * 8 * 6144;
                const float* xin = (l == 0) ? ka->in.x : (const float*)ka->out;
                const bf16* Wo = (const bf16*)(ws + WS_WOUT) + (size_t)l * 1024 * 1024 + hf * 512; const bf16* CATh = (const bf16*)(ws + WS_CAT) + hf * 512;
                pg8::Gemm g{1024, 1024, 512}; pg8::DenseSched S; S.init(CATh, 1024, Wo, 1024, 16384, 1024, G, bx);
                epi::EpiOutProj E{xin, ka->out, mod + 2 * 1024, (const float*)(ws + WS_ASSQ), hf == 0}; pg8::gemm_phase(lds, g, S, E); }
        }
        SEAM(pb + 3);
        if (TY(5) && IN(pb + 4)) { PHASE_IDS CArgs* ka = kargs(); unsigned char* ws = ka->ws; const float* mod = (const float*)(ws + WS_MOD) + (size_t)l * 8 * 6144;
            if (gw < 2048) {
                if (l == 0) norm_pass<0>(ka->out, ka->in.norm_ffn_g + l * 1024, mod + 3 * 1024, mod + 4 * 1024, (bf16*)(ws + WS_XA), nullptr, nullptr, nullptr, nullptr, gw, lane);
                else norm_pass<1>(ka->out, ka->in.norm_ffn_g + l * 1024, mod + 3 * 1024, mod + 4 * 1024, (bf16*)(ws + WS_XA), ka->in.router_w, (int*)(ws + WS_EIDX), (float*)(ws + WS_EW), (int*)(ws + WS_WCNT), gw, lane);
            }
            if (l == 1) { int* srow = (int*)(ws + WS_SROW); for (int p = bx * 512 + tid; p < XS_ROWS; p += G * 512) srow[p] = -1; }
            else if (bx == 0 && tid < 9) { ((int*)(ws + WS_SEGD))[tid] = (tid == 0) ? 0 : ((tid == 8) ? 16384 : (1 << 30)); }
        }
        SEAM(pb + 4);
        if (l == 1) {
            if (TY(6) && IN(pb + 5)) { PHASE_IDS CArgs* ka = kargs(); unsigned char* ws = ka->ws;
                if (gw < 2048) place_pass((const int*)(ws + WS_WCNT), (const int*)(ws + WS_EIDX), (const float*)(ws + WS_EW), (const bf16*)(ws + WS_XA), (bf16*)(ws + WS_XS), (int*)(ws + WS_SROW), (float*)(ws + WS_SWT), (int*)(ws + WS_SEG), gw, 2048, lane); }
            SEAM(pb + 5);
        }
        if (TY(7) && IN(pb + 6)) { PHASE_IDS CArgs* ka = kargs(); unsigned char* ws = ka->ws;
            pg8::Gemm g{1024, 1024, 1024}; pg8::MoeSched S;
            S.init(ws + (l == 0 ? WS_XA : WS_XS), 1024, ws + (l == 0 ? WS_FGU : WS_MGU), 1024, (size_t)5632 * 1024 * 2, (const int*)(ws + (l == 0 ? WS_SEGD : WS_SEG)), 5632, G, bx);
            epi::EpiSwiGLU E{(bf16*)(ws + (l == 0 ? WS_HD : WS_HM)), 2816}; pg8::gemm_phase(lds, g, S, E);
        }
        SEAM(pb + 6);
        if (TY(8) && IN(pb + 7)) { PHASE_IDS CArgs* ka = kargs(); unsigned char* ws = ka->ws; const float* mod = (const float*)(ws + WS_MOD) + (size_t)l * 8 * 6144;
            pg8::Gemm g{2816, 2816, 2816}; pg8::MoeSched S;
            S.init(ws + (l == 0 ? WS_HD : WS_HM), 2816, ws + (l == 0 ? WS_FDN : WS_MDN), 2816, (size_t)1024 * 2816 * 2, (const int*)(ws + (l == 0 ? WS_SEGD : WS_SEG)), 1024, G, bx);
            epi::EpiDown E{ka->out, mod + 5 * 1024, (bf16*)(ws + WS_YS), (const int*)(ws + WS_SROW), (const float*)(ws + WS_SWT), l == 1}; pg8::gemm_phase(lds, g, S, E);
        }
        SEAM(pb + 7);
    }
    if (TY(9) && IN(17)) { PHASE_IDS CArgs* ka = kargs(); unsigned char* ws = ka->ws;
        if (gw < 2048) final_pass(ka->out, (const bf16*)(ws + WS_YS), (const float*)(ws + WS_MOD) + (size_t)1 * 8 * 6144 + 5 * 1024, ka->in.final_g, gw, lane); }
#undef IN
#undef TY
#undef SEAM
#undef PHASE_IDS
}
}
#ifndef STEP
#define STEP 5
#endif
namespace ad {
__device__ __forceinline__ float bf2f(unsigned short s) { return h16::one(s); }
__global__ void __launch_bounds__(256) ad_proj(const unsigned short* QKV, size_t gstride, int b, float* projb) {
    const int m = blockIdx.x; const size_t row = (size_t)b * 2048 + m;
    for (int n = threadIdx.x; n < 3584; n += 256) {
        const int grp = n / 512, c = n % 512; int sc = c;
        if (grp == 3 || grp == 4) { const int head = c >> 7, d = c & 127; sc = head * 128 + 8 * ((d & 63) >> 2) + 2 * (d & 3) + (d >> 6); }
        float v = bf2f(QKV[(size_t)grp * gstride + row * 512 + sc]);
        if (grp == 0) v *= (1.0f / epi::C2);
        if (grp == 4) v *= (1.0f / epi::KSC);
        projb[(size_t)m * 3584 + n] = v;
    }
}
__global__ void __launch_bounds__(64) ad_kmean(const float* KMP, int b, float* kmeanb) {
    const int blk = blockIdx.x, h = blockIdx.y, d = threadIdx.x;
    const float* p = KMP + ((size_t)(b * 8 + blk) * 2) * 512 + h * 64 + d;
    kmeanb[((size_t)h * 8 + blk) * 64 + d] = (p[0] + p[512]) * (1.0f / 256.0f);
}
__global__ void __launch_bounds__(256) ad_cat(const unsigned short* CAT, const float* ASSQ, const float* att_g, int b, float* catb) {
    const int m = blockIdx.x; const size_t row = (size_t)b * 2048 + m;
    float ss = 0.f;
    for (int h = 0; h < 8; ++h) ss += ASSQ[row * 8 + h];
    const float rs = 1.0f / sqrtf(ss * (1.0f / 512.0f) + 1e-6f);
    for (int c = threadIdx.x; c < 1024; c += 256) { const float v = bf2f(CAT[row * 1024 + c]); catb[(size_t)m * 1024 + c] = (c < 512) ? v * rs * att_g[c] : v; }
}
__global__ void __launch_bounds__(256) dbg_cmp(const float* a, const float* b, size_t n, float rel, float abs_, unsigned* flag, int ncols = 1, int c_lo = 0, int c_hi = 1, int silu_b = 0) {
    unsigned bad = 0;
    for (size_t i = (size_t)blockIdx.x * 256 + threadIdx.x; i < n; i += (size_t)gridDim.x * 256) { const int c = (int)(i % ncols); if (c < c_lo || c >= c_hi) continue;
        float bv = b[i]; if (silu_b) bv = bv / (1.f + expf(-bv)); const float d = fabsf(a[i] - bv); if (!(d <= rel * fabsf(bv) + abs_)) ++bad; }
    if (bad) atomicAdd(flag, bad);
}
__global__ void __launch_bounds__(256) dbg_poison(const unsigned* flag, unsigned thresh, float* out, float val) {
    if (*flag > thresh) for (int i = threadIdx.x; i < 1024 * 1024; i += 256) out[i] = val;
}
__global__ void __launch_bounds__(256) dbg_ssd(const float* a, const float* b, size_t n, int ncols, int c_lo, int c_hi, float* acc) {
    float s = 0.f;
    for (size_t i = (size_t)blockIdx.x * 256 + threadIdx.x; i < n; i += (size_t)gridDim.x * 256) { const int c = (int)(i % ncols); if (c < c_lo || c >= c_hi) continue; const float d = a[i] - b[i]; s += d * d; }
    atomicAdd(acc, s);
}
__global__ void __launch_bounds__(256) dbg_encode(const float* acc, float count, float* out) {
    const float mse = *acc / count; const float val = 4.0f / sqrtf(mse);
    for (int i = threadIdx.x; i < 1024 * 1024; i += 256) out[i] = val;
}
}

static void launch_mega(const mk::Args& a0, int lo, int hi, int region, hipStream_t stream) {
    mk::Args a = a0; a.ph_lo = lo; a.ph_hi = hi; a.bar_region = region;
    hipLaunchKernelGGL(mk::mega, dim3(256), dim3(512), mk::LDS_BYTES, stream, a);
}

extern "C" void kernel_launch(void* const* d_in, const int* in_sizes, int n_in, void* d_out, int out_size, void* d_ws, size_t ws_size, hipStream_t stream) {
    static int ready = 0;
    if (ready == 0) {
        if (n_in != 18 || out_size != M * D || ws_size < mk::WS_END) { fprintf(stderr, "kernel_launch: unexpected problem (n_in %d, out %d, ws %zu)\n", n_in, out_size, ws_size); ready = -1; return; }
        if (hipFuncSetAttribute((const void*)mk::mega, hipFuncAttributeMaxDynamicSharedMemorySize, mk::LDS_BYTES) != hipSuccess) { fprintf(stderr, "kernel_launch: hipFuncSetAttribute failed\n"); ready = -1; return; }
        ready = 1;
    }
    if (ready < 0) return;
    mk::Args a{};
    const float** ip = (const float**)&a.in;
    for (int i = 0; i < 18; ++i) ip[i] = (const float*)d_in[i];
    a.out = (float*)d_out; a.ws = (unsigned char*)d_ws; a.moe_w = (STEP >= 5) ? 1 : 0;
    const mk::Inputs& in = a.in;
    float* out = (float*)d_out; unsigned char* ws = (unsigned char*)d_ws;
    hipMemsetAsync(ws + mk::WS_CTL, 0, mk::CTL_ZERO_BYTES, stream);
#if STEP >= 6
    launch_mega(a, 0, mk::N_PHASES, 0, stream);
#else
    constexpr size_t MiB = 1u << 20;
    unsigned char* na = ws + 8 * MiB;
    float* PROJb = (float*)(na);
    float* Hb = (float*)(na + 28 * MiB);
    float* CATb = (float*)(na + 36 * MiB);
    float* OAb = (float*)(na + 44 * MiB);
    float* ORRb = (float*)(na + 48 * MiB);
    float* KMEANb = (float*)(na + 52 * MiB);
    int* EIDXb = (int*)(na + 53 * MiB); float* EWb = (float*)(na + 53 * MiB + 65536); int* POSb = (int*)(na + 53 * MiB + 131072); int* LISTb = (int*)(na + 53 * MiB + 196608);
    int* CNTb = (int*)(na + 54 * MiB); int* BASEb = CNTb + 16;
    float* Gb = (float*)(na + 56 * MiB);
    float* Ub = (float*)(na + 78 * MiB);
    float* Yb = (float*)(na + 100 * MiB);
    const float* MODp = (const float*)(ws + mk::WS_MOD);
    unsigned short* QKV = (unsigned short*)(ws + mk::WS_QKV);
    launch_mega(a, 0, 1, 1, stream);
    for (int l = 0; l < 2; ++l) {
        const int pb = 1 + 8 * l;
        const float* xin = (l == 0) ? in.x : (const float*)out;
        if (STEP >= 1) { launch_mega(a, pb, pb + 1, 1, stream); launch_mega(a, pb + 1, pb + 2, 1, stream); }
        if (STEP >= 2) launch_mega(a, pb + 2, pb + 3, 1, stream);
        if (STEP >= 3) launch_mega(a, pb + 3, pb + 4, 1, stream);
        if (STEP < 3) {
            for (int b = 0; b < BATCH; ++b) {
                const float* mod = MODp + ((size_t)l * BATCH + b) * 6 * D;
                const float* xb = xin + (size_t)b * SEQ * D; float* ob = out + (size_t)b * SEQ * D;
                if (STEP < 1) {
                    nv::k_norm<<<SEQ, 256, 0, stream>>>(xb, in.norm_mix_g + l * D, mod + 0 * D, mod + 1 * D, Hb);
                    nv::k_gemm<<<dim3(NPROJ / 64, SEQ / 64), 256, 0, stream>>>(Hb, D, nullptr, nullptr, SEQ, in.w_in + (size_t)l * D * NPROJ, NPROJ, PROJb, NPROJ, D);
                    nv::k_rotary<<<SEQ, 256, 0, stream>>>(PROJb);
                    nv::k_kmean<<<dim3(NBLK, AH, 1), 64, 0, stream>>>(PROJb, KMEANb);
                } else {
                    ad::ad_proj<<<SEQ, 256, 0, stream>>>(QKV, (size_t)M * 512, b, PROJb);
                    ad::ad_kmean<<<dim3(NBLK, AH, 1), 64, 0, stream>>>((const float*)(ws + mk::WS_KMP), b, KMEANb);
#ifdef DBG_CHECK
                    { float* PROJn = Gb; float* KMn = (float*)(na + 52 * MiB + 262144); unsigned* flag = (unsigned*)(ws + mk::WS_CTL) + 16;
                      nv::k_norm<<<SEQ, 256, 0, stream>>>(xb, in.norm_mix_g + l * D, mod + 0 * D, mod + 1 * D, Hb);
                      nv::k_gemm<<<dim3(NPROJ / 64, SEQ / 64), 256, 0, stream>>>(Hb, D, nullptr, nullptr, SEQ, in.w_in + (size_t)l * D * NPROJ, NPROJ, PROJn, NPROJ, D);
                      nv::k_rotary<<<SEQ, 256, 0, stream>>>(PROJn);
                      nv::k_kmean<<<dim3(NBLK, AH, 1), 64, 0, stream>>>(PROJn, KMn);
                      ad::dbg_cmp<<<1024, 256, 0, stream>>>(PROJb, PROJn, (size_t)SEQ * NPROJ, DBG_REL, DBG_ABS, flag, NPROJ, 0, 3072, 0);
                      ad::dbg_cmp<<<1024, 256, 0, stream>>>(PROJb, PROJn, (size_t)SEQ * NPROJ, DBG_REL, DBG_ABS, flag, NPROJ, 3072, 3584, 1);
                      ad::dbg_cmp<<<16, 256, 0, stream>>>(KMEANb, KMn, (size_t)8 * 8 * 64, 0.03f, 0.004f, flag + 1);
                      if (l == DBG_L && b == 0) ad::dbg_ssd<<<1024, 256, 0, stream>>>(PROJb, PROJn, (size_t)SEQ * NPROJ, NPROJ, DBG_CLO, DBG_CHI, (float*)(flag + 2)); }
#endif
                }
                if (STEP < 2) {
                    nv::k_moba<<<dim3(NBLK, AH, 1), 256, 0, stream>>>(PROJb, KMEANb, OAb);
                    nv::k_ret<<<dim3(SEQ / 256, RH * 4, 1), 256, 0, stream>>>(PROJb, ORRb);
                    nv::k_cat<<<SEQ, 256, 0, stream>>>(OAb, ORRb, PROJb, in.att_g + l * AW, in.ret_g + l * RW, CATb, STEP >= 1 ? 1 : 0);
                } else {
                    ad::ad_cat<<<SEQ, 256, 0, stream>>>((const unsigned short*)(ws + mk::WS_CAT), (const float*)(ws + mk::WS_ASSQ), in.att_g + l * AW, b, CATb);
                }
                nv::k_gemm<<<dim3(D / 64, SEQ / 64), 256, 0, stream>>>(CATb, D, nullptr, nullptr, SEQ, in.w_out + (size_t)l * D * D, D, Hb, D, D);
                nv::k_resid<<<SEQ, 256, 0, stream>>>(xb, mod + 2 * D, Hb, ob);
            }
        }
        const bool ffn_mega = (l == 0) ? (STEP >= 4) : (STEP >= 5);
        if (ffn_mega) {
            launch_mega(a, pb + 4, pb + 5, 1, stream);
            if (l == 1) launch_mega(a, pb + 5, pb + 6, 1, stream);
            launch_mega(a, pb + 6, pb + 7, 1, stream);
            launch_mega(a, pb + 7, pb + 8, 1, stream);
        } else {
            for (int b = 0; b < BATCH; ++b) {
                const float* mod = MODp + ((size_t)l * BATCH + b) * 6 * D;
                float* ob = out + (size_t)b * SEQ * D;
                nv::k_norm<<<SEQ, 256, 0, stream>>>(ob, in.norm_ffn_g + l * D, mod + 3 * D, mod + 4 * D, Hb);
                if (l == 0) {
                    nv::k_gemm<<<dim3(FF / 64, SEQ / 64), 256, 0, stream>>>(Hb, D, nullptr, nullptr, SEQ, in.fw_gate, FF, Gb, FF, D);
                    nv::k_gemm<<<dim3(FF / 64, SEQ / 64), 256, 0, stream>>>(Hb, D, nullptr, nullptr, SEQ, in.fw_up, FF, Ub, FF, D);
                    nv::k_silu_mul<<<SEQ, 256, 0, stream>>>(Gb, Ub, nullptr, SEQ, FF);
                    nv::k_gemm<<<dim3(D / 64, SEQ / 64), 256, 0, stream>>>(Gb, FF, nullptr, nullptr, SEQ, in.fw_down, D, Ub, D, FF);
                    nv::k_resid<<<SEQ, 256, 0, stream>>>(ob, mod + 5 * D, Ub, ob);
                } else {
                    nv::k_router<<<SEQ / 4, 256, 0, stream>>>(Hb, in.router_w, EIDXb, EWb);
                    nv::k_place<<<1, 1024, 0, stream>>>(EIDXb, LISTb, POSb, CNTb, BASEb, 4);
                    float* GE = Gb; float* UE = Ub;
                    for (int e = 0; e < NE; ++e) {
                        nv::k_gemm<<<dim3(FF / 64, ECAP / 64), 256, 0, stream>>>(Hb, D, LISTb, CNTb + e, ECAP, in.mw_gate + (size_t)e * D * FF, FF, GE, FF, D, BASEb + e, nullptr);
                        nv::k_gemm<<<dim3(FF / 64, ECAP / 64), 256, 0, stream>>>(Hb, D, LISTb, CNTb + e, ECAP, in.mw_up + (size_t)e * D * FF, FF, UE, FF, D, BASEb + e, nullptr);
                        nv::k_silu_mul<<<ECAP, 256, 0, stream>>>(GE, UE, CNTb + e, ECAP, FF);
                        nv::k_gemm<<<dim3(D / 64, ECAP / 64), 256, 0, stream>>>(GE, FF, nullptr, CNTb + e, ECAP, in.mw_down + (size_t)e * FF * D, D, Yb, D, FF, nullptr, BASEb + e);
                    }
                    nv::k_moe_combine<<<SEQ, 256, 0, stream>>>(ob, mod + 5 * D, Yb, POSb, EWb);
                }
            }
        }
    }
    if (STEP >= 5) launch_mega(a, 17, 18, 1, stream);
    else nv::k_norm<<<M, 256, 0, stream>>>(out, in.final_g, nullptr, nullptr, out);
#ifdef DBG_CHECK
#ifdef DBG_ENC
    ad::dbg_encode<<<1, 256, 0, stream>>>((const float*)((unsigned*)(ws + mk::WS_CTL) + 18), (float)SEQ * (DBG_CHI - DBG_CLO), out);
#endif
    ad::dbg_poison<<<1, 256, 0, stream>>>((unsigned*)(ws + mk::WS_CTL) + 16, DBG_T0, out, 100.0f);
    ad::dbg_poison<<<1, 256, 0, stream>>>((unsigned*)(ws + mk::WS_CTL) + 17, DBG_T1, out + (1 << 20), 300.0f);
#endif
#endif
}
```

```cpp
#include <hip/hip_runtime.h>
#include <cstdio>
#include <cstdint>
#include <cmath>

namespace h16 {
typedef _Float16 f16x2_t __attribute__((ext_vector_type(2)));
typedef _Float16 f16x8_t __attribute__((ext_vector_type(8)));
typedef float f32x2_t __attribute__((ext_vector_type(2)));
__device__ __forceinline__ unsigned pk(float lo, float hi) { f32x2_t v = {lo, hi}; f16x2_t b = __builtin_convertvector(v, f16x2_t); return __builtin_bit_cast(unsigned, b); }
__device__ __forceinline__ float lo(unsigned u) { return (float)__builtin_bit_cast(f16x2_t, u)[0]; }
__device__ __forceinline__ float hi(unsigned u) { return (float)__builtin_bit_cast(f16x2_t, u)[1]; }
__device__ __forceinline__ float one(unsigned short s) { return (float)__builtin_bit_cast(_Float16, s); }
}
#define STEP 6

constexpr int D = 1024, BATCH = 8, SEQ = 2048, M = BATCH * SEQ;
constexpr int AH = 8, AD = 64, AW = 512, MBLK = 256, NBLK = SEQ / MBLK, TOPK = 3;
constexpr int RH = 4, RD = 128, RW = 512;
constexpr int NPROJ = 3 * AW + 4 * RW;
constexpr int FF = 2816, NE = 8;
constexpr float EPS = 1e-6f;
constexpr int ECAP = 2048;
namespace pg8 {
#define PG8_LAS __attribute__((address_space(3)))
typedef unsigned short bf16_t;
typedef short bf16x8 __attribute__((ext_vector_type(8)));
typedef float f32x4 __attribute__((ext_vector_type(4)));
typedef float f32x2 __attribute__((ext_vector_type(2)));
typedef unsigned u32x4 __attribute__((ext_vector_type(4)));
typedef unsigned u32x2 __attribute__((ext_vector_type(2)));
constexpr int BM = 256, BK = 64, HALF = 128, HTB = HALF * BK * 2  , STAGE_BYTES = 8 * HTB, NXCD = 8, WGM = 8;

__host__ __device__ __forceinline__ int lds_byte(int r, int c) { const int st = (r >> 4) * 2 + (c >> 5), rr = r & 15, cc = c & 31, ob = rr * 64 + cc * 2; return st * 1024 + (ob ^ (((ob >> 9) & 1) << 5)); }
__host__ __device__ __forceinline__ void stage_rc(int b, int& R, int& C) { const int st = b / 1024, sb = b % 1024, swz = sb ^ (((sb >> 9) & 1) << 5); R = (st >> 1) * 16 + swz / 64; C = (st & 1) * 32 + (swz % 64) / 2; }
__host__ __device__ __forceinline__ int perm32(int rho) { const int n = rho >> 4, i = rho & 15; return 8 * (i >> 2) + 4 * n + (i & 3); }

struct Unit { int pm, pn, e; };
struct Gemm { int lda, ldb, K; };

struct DenseSched {
    const char* A; const char* Bt; size_t a_tile, b_tile;
    int nM, nN, nwg, G, c;
    __device__ __forceinline__ void init(const void* A_, int lda, const void* Bt_, int ldb, int M, int N, int G_, int c_) {
        A = (const char*)A_; Bt = (const char*)Bt_; a_tile = (size_t)BM * lda * 2; b_tile = (size_t)BM * ldb * 2; nM = M / BM; nN = N / BM; nwg = nM * nN; G = G_; c = c_; }
    __device__ __forceinline__ bool next(int i, Unit& u) const {
        const long L = (long)i * G + c; if (L >= nwg) return false;
        int wgid = (int)L; { const int q = nwg / NXCD, r = nwg % NXCD, xcd = wgid % NXCD, off = wgid / NXCD; wgid = (xcd < r ? xcd * (q + 1) : r * (q + 1) + (xcd - r) * q) + off; }
        const int nig = WGM * nN, gid = wgid / nig, fm = gid * WGM, gsz = (nM - fm) < WGM ? (nM - fm) : WGM;
        u.pm = fm + ((wgid % nig) % gsz); u.pn = (wgid % nig) / gsz; u.e = 0; return true;
    }
    __device__ __forceinline__ const char* a_ptr(const Unit& u) const { return A + (size_t)u.pm * a_tile; }
    __device__ __forceinline__ const char* b_ptr(const Unit& u) const { return Bt + (size_t)u.pn * b_tile; }
};
struct MoeSched {
    const char* A; const char* Bt; size_t a_tile, b_tile, e_stride;
    int nM, nN, nwg, G, c; int seg[8];
    __device__ __forceinline__ void init(const void* A_, int lda, const void* Bt_, int ldb, size_t e_stride_bytes, const int* segp_, int N, int G_, int c_) {
        A = (const char*)A_; Bt = (const char*)Bt_; a_tile = (size_t)BM * lda * 2; b_tile = (size_t)BM * ldb * 2; e_stride = e_stride_bytes;
#pragma unroll
        for (int e = 0; e < 8; ++e) seg[e] = __builtin_amdgcn_readfirstlane(segp_[e]);
        nM = __builtin_amdgcn_readfirstlane(segp_[8]) / BM; nN = N / BM; nwg = nM * nN; G = G_; c = c_; }
    __device__ __forceinline__ bool next(int i, Unit& u) const {
        const long L = (long)i * G + c; if (L >= nwg) return false;
        int wgid = (int)L; { const int q = nwg / NXCD, r = nwg % NXCD, xcd = wgid % NXCD, off = wgid / NXCD; wgid = (xcd < r ? xcd * (q + 1) : r * (q + 1) + (xcd - r) * q) + off; }
        const int nig = WGM * nN, gid = wgid / nig, fm = gid * WGM, gsz = (nM - fm) < WGM ? (nM - fm) : WGM;
        u.pm = fm + ((wgid % nig) % gsz); u.pn = (wgid % nig) / gsz;
        int e = 0; const int r0 = u.pm * BM;
#pragma unroll
        for (int k = 1; k < 8; ++k) e += (r0 >= seg[k]) ? 1 : 0;
        u.e = e; return true;
    }
    __device__ __forceinline__ const char* a_ptr(const Unit& u) const { return A + (size_t)u.pm * a_tile; }
    __device__ __forceinline__ const char* b_ptr(const Unit& u) const { return Bt + (size_t)u.e * e_stride + (size_t)u.pn * b_tile; }
};

__device__ __forceinline__ unsigned cvt_pk_bf16(float lo, float hi) { return h16::pk(lo, hi); }
__device__ __forceinline__ float fast_silu(float g) { return g * __builtin_amdgcn_rcpf(1.0f + __builtin_amdgcn_exp2f(-1.4426950408889634f * g)); }

typedef f32x4 Acc[2][2][4][2];

template <class Epi, class Sched>
__device__ __forceinline__ void gemm_phase(PG8_LAS unsigned char* lds, const Gemm g, const Sched& S, const Epi& E) {
    int tid_ = threadIdx.x; asm volatile("" : "+v"(tid_));
    const int tid = tid_, wid = __builtin_amdgcn_readfirstlane(tid >> 6), lane = tid & 63, wr = wid >> 2, wc = wid & 3, fr = lane & 15, fq = lane >> 4;
    const int K = g.K, nt = K / BK;
    unsigned voffA[2], voffB[2];
#pragma unroll
    for (int i = 0; i < 2; ++i) { int R, C; stage_rc(tid * 16 + i * 8192, R, C); const int Rb = Epi::PERM ? ((R & ~31) + perm32(R & 31)) : R;
        voffA[i] = (unsigned)(R * g.lda + C) * 2u; voffB[i] = (unsigned)(Rb * g.ldb + C) * 2u; }
    const size_t kstep = (size_t)(BK * 2);
    const size_t hstepA = (size_t)HALF * g.lda * 2, hstepB = (size_t)HALF * g.ldb * 2;
    const unsigned ldsw = (unsigned)wid * 1024u;
    const int aoff = lds_byte(wr * 64 + fr, fq * 8), boff = lds_byte(wc * 32 + fr, fq * 8);
#define PG8_SA(b, h) (((b) * 2 + (h)) * HTB)
#define PG8_SB(b, h) ((4 + (b) * 2 + (h)) * HTB)
#define PG8_STAGE(bufoff, gbase, voff) do { _Pragma("unroll") for (int _i = 0; _i < 2; ++_i) \
        __builtin_amdgcn_global_load_lds((const unsigned*)((const char*)(gbase) + (voff)[_i]), (PG8_LAS unsigned*)(lds + (bufoff) + ldsw + _i * 8192), 16, 0, 0); } while (0)
#define PG8_LDA(dst, b, h) do { _Pragma("unroll") for (int m = 0; m < 4; ++m) _Pragma("unroll") for (int k = 0; k < 2; ++k) dst[m][k] = *(const PG8_LAS bf16x8*)(lds + PG8_SA(b, h) + aoff + m * 2048 + k * 1024); } while (0)
#define PG8_LDB(dst, b, h) do { _Pragma("unroll") for (int n = 0; n < 2; ++n) _Pragma("unroll") for (int k = 0; k < 2; ++k) dst[n][k] = *(const PG8_LAS bf16x8*)(lds + PG8_SB(b, h) + boff + n * 2048 + k * 1024); } while (0)
#define PG8_MMA(ai, bj, At, Bt) do { __builtin_amdgcn_s_setprio(1); _Pragma("unroll") for (int m = 0; m < 4; ++m) _Pragma("unroll") for (int n = 0; n < 2; ++n) _Pragma("unroll") for (int k = 0; k < 2; ++k) \
        acc[ai][bj][m][n] = __builtin_amdgcn_mfma_f32_16x16x32_f16(__builtin_bit_cast(h16::f16x8_t, Bt[n][k]), __builtin_bit_cast(h16::f16x8_t, At[m][k]), acc[ai][bj][m][n], 0, 0, 0); __builtin_amdgcn_s_setprio(0); } while (0)
#define PG8_WAIT_V(n) asm volatile("s_waitcnt vmcnt(" #n ")" ::: "memory")
#define PG8_WAIT_L(n) asm volatile("s_waitcnt lgkmcnt(" #n ")" ::: "memory")
#define PG8_BAR __builtin_amdgcn_s_barrier()
#define PG8_SCHED __builtin_amdgcn_sched_barrier(0)
    Unit cur, nxt; int ui = 0;
    if (!S.next(0, cur)) return;
    Acc acc;
#pragma unroll
    for (int a = 0; a < 2; ++a)
#pragma unroll
        for (int b = 0; b < 2; ++b)
#pragma unroll
            for (int m = 0; m < 4; ++m)
#pragma unroll
                for (int n = 0; n < 2; ++n) acc[a][b][m][n] = (f32x4){0.f, 0.f, 0.f, 0.f};
    bf16x8 At[4][2], B0[2][2], B1[2][2];
    const char* cA = S.a_ptr(cur); const char* cB = S.b_ptr(cur);
    if constexpr (Epi::MID_T > 0) E.pre(cur, lds, tid);
    PG8_STAGE(PG8_SB(0, 0), cB, voffB); PG8_STAGE(PG8_SB(0, 1), cB + hstepB, voffB); PG8_STAGE(PG8_SA(0, 0), cA, voffA); PG8_STAGE(PG8_SA(0, 1), cA + hstepA, voffA);
    if (wr == 1) PG8_BAR;
    PG8_WAIT_V(2); PG8_BAR;
    PG8_STAGE(PG8_SB(1, 0), cB + kstep, voffB); PG8_STAGE(PG8_SA(1, 0), cA + kstep, voffA); PG8_STAGE(PG8_SB(1, 1), cB + hstepB + kstep, voffB);
    PG8_WAIT_V(6); PG8_BAR;
    for (;;) {
        const bool has_next = S.next(ui + 1, nxt);
        const char* nA = has_next ? S.a_ptr(nxt) : cA; const char* nB = has_next ? S.b_ptr(nxt) : cB;
        for (int t = 0; t < nt; t += 2) {
            if constexpr (Epi::MID_T > 0) { if (t == Epi::MID_T) E.mid(acc, lds, wr, fr); }
            const bool last = (t == nt - 2);
            const char* a1 = cA + (size_t)(t + 1) * kstep;
            const char* a2 = last ? nA : cA + (size_t)(t + 2) * kstep; const char* b2 = last ? nB : cB + (size_t)(t + 2) * kstep;
            const char* a3 = a2 + kstep; const char* b3 = b2 + kstep;
            PG8_LDB(B0, 0, 0); PG8_LDB(B1, 0, 1); PG8_SCHED; PG8_LDA(At, 0, 0); PG8_STAGE(PG8_SA(1, 1), a1 + hstepA, voffA);
            PG8_WAIT_V(8); PG8_WAIT_L(0); PG8_BAR; PG8_MMA(0, 0, At, B0); PG8_MMA(0, 1, At, B1); PG8_BAR; PG8_SCHED;
            PG8_LDA(At, 0, 1); PG8_STAGE(PG8_SB(0, 0), b2, voffB); PG8_STAGE(PG8_SB(0, 1), b2 + hstepB, voffB); PG8_STAGE(PG8_SA(0, 0), a2, voffA);
            PG8_WAIT_V(8); PG8_WAIT_L(0); PG8_BAR; PG8_MMA(1, 0, At, B0); PG8_MMA(1, 1, At, B1); PG8_BAR; PG8_SCHED;
            PG8_LDB(B0, 1, 0); PG8_LDB(B1, 1, 1); PG8_SCHED; PG8_LDA(At, 1, 0); PG8_STAGE(PG8_SA(0, 1), a2 + hstepA, voffA);
            PG8_WAIT_V(8); PG8_WAIT_L(0); PG8_BAR; PG8_MMA(0, 0, At, B0); PG8_MMA(0, 1, At, B1); PG8_BAR; PG8_SCHED;
            PG8_LDA(At, 1, 1); PG8_STAGE(PG8_SB(1, 0), b3, voffB); PG8_STAGE(PG8_SB(1, 1), b3 + hstepB, voffB); PG8_STAGE(PG8_SA(1, 0), a3, voffA);
            PG8_WAIT_V(8); PG8_WAIT_L(0); PG8_BAR; PG8_MMA(1, 0, At, B0); PG8_MMA(1, 1, At, B1); PG8_BAR; PG8_SCHED;
        }
        if (wr == 0) PG8_BAR;
        E(acc, cur, wr, wc, fr, fq);
        if (!has_next) break;
#pragma unroll
        for (int a = 0; a < 2; ++a)
#pragma unroll
            for (int b = 0; b < 2; ++b)
#pragma unroll
                for (int m = 0; m < 4; ++m)
#pragma unroll
                    for (int n = 0; n < 2; ++n) acc[a][b][m][n] = (f32x4){0.f, 0.f, 0.f, 0.f};
        cur = nxt; cA = nA; cB = nB; ++ui;
        if (wr == 1) PG8_BAR;
    }
    PG8_WAIT_V(0);
    PG8_BAR;
#undef PG8_SA
#undef PG8_SB
#undef PG8_STAGE
#undef PG8_LDA
#undef PG8_LDB
#undef PG8_MMA
#undef PG8_WAIT_V
#undef PG8_WAIT_L
#undef PG8_BAR
#undef PG8_SCHED
}
}
namespace epi {
#define PG8_LAS __attribute__((address_space(3)))
using pg8::Acc; using pg8::Unit; using pg8::f32x4; using pg8::u32x4; using pg8::bf16_t; using pg8::cvt_pk_bf16; using pg8::fast_silu;
constexpr int HALF = 128;
constexpr float C2 = 0.125f * 1.4426950408889634f;
constexpr float KSC = 0.08838834764831845f;

__device__ __forceinline__ u32x4 pack8(const f32x4 v0, const f32x4 v1) { u32x4 w; w.x = cvt_pk_bf16(v0[0], v0[1]); w.y = cvt_pk_bf16(v0[2], v0[3]); w.z = cvt_pk_bf16(v1[0], v1[1]); w.w = cvt_pk_bf16(v1[2], v1[3]); return w; }

struct EpiInProj {
    static constexpr bool PERM = true; static constexpr int MID_T = 0;
    bf16_t* O; size_t gstride;
    float* KMP;
    const float* ROPE;
    __device__ __forceinline__ void operator()(const Acc& acc, const Unit& u, int wr, int wc, int fr, int fq) const {
        const int grp = u.pn >> 1;
        const int col0 = (u.pn & 1) * 256 + wc * 32 + 8 * fq;
        const int row0 = u.pm * 256 + wr * 64 + fr;
        bf16_t* base = O + (size_t)grp * gstride;
        f32x4 cs[2][2];
#pragma unroll
        for (int bj = 0; bj < 2; ++bj) { cs[bj][0] = (f32x4){0.f, 0.f, 0.f, 0.f}; cs[bj][1] = (f32x4){0.f, 0.f, 0.f, 0.f}; }
#pragma unroll
        for (int ai = 0; ai < 2; ++ai)
#pragma unroll
            for (int m = 0; m < 4; ++m) {
                const int row = row0 + ai * HALF + m * 16;
                bf16_t* rowp = base + (size_t)row * 512 + col0;
                f32x4 t0 = (f32x4){0.f, 0.f, 0.f, 0.f}, t1 = t0;
                if (grp == 3 || grp == 4) { const float* tp = ROPE + ((size_t)(row & 2047) * 64 + 16 * wc + 4 * fq) * 2; t0 = *(const f32x4*)tp; t1 = *(const f32x4*)(tp + 4); }
#pragma unroll
                for (int bj = 0; bj < 2; ++bj) {
                    f32x4 v0 = acc[ai][bj][m][0], v1 = acc[ai][bj][m][1];
                    if (grp == 0) { v0 = v0 * C2; v1 = v1 * C2; }
                    else if (grp == 1) { cs[bj][0] += v0; cs[bj][1] += v1; }
                    else if (grp == 3 || grp == 4) {
                        const float sc = (grp == 4) ? KSC : 1.0f;
                        f32x4 r0, r1;
                        r0[0] = (v0[0] * t0[0] - v0[1] * t0[1]) * sc; r0[1] = (v0[0] * t0[1] + v0[1] * t0[0]) * sc;
                        r0[2] = (v0[2] * t0[2] - v0[3] * t0[3]) * sc; r0[3] = (v0[2] * t0[3] + v0[3] * t0[2]) * sc;
                        r1[0] = (v1[0] * t1[0] - v1[1] * t1[1]) * sc; r1[1] = (v1[0] * t1[1] + v1[1] * t1[0]) * sc;
                        r1[2] = (v1[2] * t1[2] - v1[3] * t1[3]) * sc; r1[3] = (v1[2] * t1[3] + v1[3] * t1[2]) * sc;
                        v0 = r0; v1 = r1;
                    } else if (grp == 6) {
#pragma unroll
                        for (int j = 0; j < 4; ++j) { v0[j] = fast_silu(v0[j]); v1[j] = fast_silu(v1[j]); }
                    }
                    *(u32x4*)(rowp + bj * HALF) = pack8(v0, v1);
                }
            }
        if (grp == 1) {
#pragma unroll
            for (int bj = 0; bj < 2; ++bj)
#pragma unroll
                for (int n = 0; n < 2; ++n) {
                    f32x4 s = cs[bj][n];
#pragma unroll
                    for (int o = 1; o < 16; o <<= 1) { s[0] += __shfl_xor(s[0], o); s[1] += __shfl_xor(s[1], o); s[2] += __shfl_xor(s[2], o); s[3] += __shfl_xor(s[3], o); }
                    if (fr == 0) *(f32x4*)(KMP + (size_t)(u.pm * 2 + wr) * 512 + col0 + bj * HALF + 4 * n) = s;
                }
        }
    }
};

struct EpiOutProj {
    static constexpr bool PERM = false; static constexpr int MID_T = 8;
    const float* xin; float* out; const float* g1;
    const float* assq;
    bool dry;
    static constexpr int RS_OFF = 131072 + 8192;
    __device__ __forceinline__ void pre(const Unit& u, PG8_LAS unsigned char* lds, int tid) const {
        if (tid < 256) { const int row = u.pm * 256 + tid;
            const f32x4 a = *(const f32x4*)(assq + (size_t)row * 8), c = *(const f32x4*)(assq + (size_t)row * 8 + 4);
            const float ss = ((a[0] + a[1]) + (a[2] + a[3])) + ((c[0] + c[1]) + (c[2] + c[3]));
            ((PG8_LAS float*)(lds + RS_OFF))[tid] = 1.0f / sqrtf(ss * (1.0f / 512.0f) + 1e-6f); }
    }
    __device__ __forceinline__ void mid(Acc& acc, PG8_LAS unsigned char* lds, int wr, int fr) const {
        const PG8_LAS float* tab = (const PG8_LAS float*)(lds + RS_OFF) + wr * 64 + fr;
#pragma unroll
        for (int ai = 0; ai < 2; ++ai)
#pragma unroll
            for (int m = 0; m < 4; ++m) {
                const float rs = tab[ai * HALF + m * 16];
#pragma unroll
                for (int bj = 0; bj < 2; ++bj)
#pragma unroll
                    for (int n = 0; n < 2; ++n) acc[ai][bj][m][n] = acc[ai][bj][m][n] * rs;
            }
    }
    __device__ __forceinline__ void operator()(const Acc& acc, const Unit& u, int wr, int wc, int fr, int fq) const {
        const int b = u.pm >> 3;
        const int col0 = u.pn * 256 + wc * 32 + 4 * fq;
        const int row0 = u.pm * 256 + wr * 64 + fr;
        f32x4 gv[2][2];
#pragma unroll
        for (int bj = 0; bj < 2; ++bj)
#pragma unroll
            for (int n = 0; n < 2; ++n) gv[bj][n] = *(const f32x4*)(g1 + (size_t)b * 6144 + col0 + bj * HALF + n * 16);
#pragma unroll
        for (int ai = 0; ai < 2; ++ai)
#pragma unroll
            for (int m = 0; m < 4; ++m) {
                const size_t off = (size_t)(row0 + ai * HALF + m * 16) * 1024 + col0;
#pragma unroll
                for (int bj = 0; bj < 2; ++bj)
#pragma unroll
                    for (int n = 0; n < 2; ++n) { const f32x4 bs = *(const f32x4*)(xin + off + bj * HALF + n * 16); const f32x4 r = bs + gv[bj][n] * acc[ai][bj][m][n]; if (!dry) *(f32x4*)(out + off + bj * HALF + n * 16) = r; else asm volatile("" :: "v"(r)); }
            }
    }
};

struct EpiSwiGLU {
    static constexpr bool PERM = true; static constexpr int MID_T = 0;
    bf16_t* H; int ldh;
    __device__ __forceinline__ void operator()(const Acc& acc, const Unit& u, int wr, int wc, int fr, int fq) const {
        const int col0 = u.pn * 128 + wc * 32 + 8 * fq;
        const int row0 = u.pm * 256 + wr * 64 + fr;
#pragma unroll
        for (int ai = 0; ai < 2; ++ai)
#pragma unroll
            for (int m = 0; m < 4; ++m) {
                const int row = row0 + ai * HALF + m * 16;
                f32x4 v0, v1;
#pragma unroll
                for (int j = 0; j < 4; ++j) { v0[j] = fast_silu(acc[ai][0][m][0][j]) * acc[ai][1][m][0][j]; v1[j] = fast_silu(acc[ai][0][m][1][j]) * acc[ai][1][m][1][j]; }
                *(u32x4*)(H + (size_t)row * ldh + col0) = pack8(v0, v1);
            }
    }
};

struct EpiDown {
    static constexpr bool PERM = false; static constexpr int MID_T = 0;
    float* out; const float* g2; bf16_t* YS; const int* srow; const float* swt; bool moe; bool dry;
    __device__ __forceinline__ void operator()(const Acc& acc, const Unit& u, int wr, int wc, int fr, int fq) const {
        const int col0 = u.pn * 256 + wc * 32 + 4 * fq;
        const int row0 = u.pm * 256 + wr * 64 + fr;
        if (!moe) {
            const int b = u.pm >> 3;
            f32x4 gv[2][2];
#pragma unroll
            for (int bj = 0; bj < 2; ++bj)
#pragma unroll
                for (int n = 0; n < 2; ++n) gv[bj][n] = *(const f32x4*)(g2 + (size_t)b * 6144 + col0 + bj * HALF + n * 16);
#pragma unroll
            for (int ai = 0; ai < 2; ++ai)
#pragma unroll
                for (int m = 0; m < 4; ++m) {
                    const size_t off = (size_t)(row0 + ai * HALF + m * 16) * 1024 + col0;
#pragma unroll
                    for (int bj = 0; bj < 2; ++bj)
#pragma unroll
                        for (int n = 0; n < 2; ++n) { const f32x4 bs = *(const f32x4*)(out + off + bj * HALF + n * 16); const f32x4 r = bs + gv[bj][n] * acc[ai][bj][m][n]; if (!dry) *(f32x4*)(out + off + bj * HALF + n * 16) = r; else asm volatile("" :: "v"(r)); }
                }
        } else {
#pragma unroll
            for (int ai = 0; ai < 2; ++ai)
#pragma unroll
                for (int m = 0; m < 4; ++m) {
                    const int pos = row0 + ai * HALF + m * 16;
                    const int sr = srow[pos];
                    if (sr >= 0) { const float w = swt[pos]; bf16_t* rowp = YS + (size_t)sr * 1024 + col0;
#pragma unroll
                        for (int bj = 0; bj < 2; ++bj)
#pragma unroll
                            for (int n = 0; n < 2; ++n) { const f32x4 v = acc[ai][bj][m][n] * w; pg8::u32x2 o; o.x = cvt_pk_bf16(v[0], v[1]); o.y = cvt_pk_bf16(v[2], v[3]); if (!dry) *(pg8::u32x2*)(rowp + bj * HALF + n * 16) = o; else asm volatile("" :: "v"(o)); } }
                }
        }
    }
};
}
namespace fa {
#define FA_LAS __attribute__((address_space(3)))
typedef unsigned short bf16_t;
typedef short bf16x8 __attribute__((ext_vector_type(8)));
typedef short s16x4 __attribute__((ext_vector_type(4)));
typedef float f32x16 __attribute__((ext_vector_type(16)));
typedef float f32x4 __attribute__((ext_vector_type(4)));
typedef unsigned u32x4 __attribute__((ext_vector_type(4)));
typedef float f32x2_t __attribute__((ext_vector_type(2))); typedef __bf16 bf16x2_t __attribute__((ext_vector_type(2)));
constexpr int L_WSF = 131072 + 1024, L_KM = L_WSF + 2048;
constexpr float NEG = -1.0e30f;
__device__ __forceinline__ int crow(int r, int hi) { return (r & 3) + 8 * (r >> 2) + 4 * hi; }
__device__ __forceinline__ void glds16(const void* gsrc, unsigned lds_dst) { unsigned keep;
    asm volatile("s_mov_b32 %0, m0\n\ts_mov_b32 m0, %2\n\ts_nop 0\n\tglobal_load_lds_dwordx4 %1, off\n\ts_mov_b32 m0, %0" : "=&s"(keep) : "v"(gsrc), "s"(lds_dst) : "memory"); }
__device__ __forceinline__ unsigned cvtpk_s(float lo, float hi) { return h16::pk(lo, hi); }
__device__ __forceinline__ float bf2f(short s) { return h16::one((unsigned short)s); }
typedef short v4i16_t __attribute__((ext_vector_type(4)));
__device__ __forceinline__ s16x4 vtr(FA_LAS const unsigned char* p) { return __builtin_bit_cast(s16x4, __builtin_amdgcn_ds_read_tr16_b64_v4i16((FA_LAS v4i16_t*)p)); }
#define FA_WAIT_BAR() asm volatile("s_waitcnt vmcnt(0) lgkmcnt(0)\n\ts_barrier" ::: "memory")
#define FA_LBAR() asm volatile("s_waitcnt lgkmcnt(0)\n\ts_barrier" ::: "memory")

struct Tensors {
    const bf16_t* Q; const bf16_t* K; const bf16_t* V;
    bf16_t* CAT;
    float* ASSQ;
    const float* KMP;
    const bf16_t* GR;
    const float* ret_g;
    const float* KVM;
};

template <bool RET>
__device__ __forceinline__ void attn_unit(int b, int h, int qblk, const Tensors& T, FA_LAS unsigned char* shm) {
    constexpr int NS = RET ? 3 : 4, DIST = NS - 1;
    constexpr int DH = RET ? 128 : 64, ND0 = DH / 16, NDB = DH / 32, NPC = DH / 64, SLOT = 64 * DH * 2, L_K = 0, L_V = NS * SLOT, PER = 2 * NPC, L_R = 98304;
    int tid_ = threadIdx.x; asm volatile("" : "+v"(tid_));
    const int tid = tid_, lane = tid & 63, r32 = lane & 31, hi = lane >> 5; const int wid = __builtin_amdgcn_readfirstlane(tid >> 6);
    const size_t rowbase = (size_t)b * 2048; const int q0 = qblk * 256;
    const unsigned lds0 = (unsigned)(unsigned long)shm;
    FA_LAS float* wsf = (FA_LAS float*)(shm + L_WSF) + wid * 64;
    FA_LAS float* KM = (FA_LAS float*)(shm + L_KM);
    const bf16_t* Kh = T.K + rowbase * 512 + h * DH; const bf16_t* Vh = T.V + rowbase * 512 + h * DH;
    const int NT = RET ? 4 : 4 * (qblk + 1);
#define FA_KV0(i) ((((i) < 4) ? qblk : (qblk - 1 - (((i) - 4) >> 2))) * 256 + ((i) & 3) * 64)
#define FA_DMA(i) do { const int kv0_ = FA_KV0(i); const unsigned so_ = (unsigned)(((i) % NS) * SLOT); \
        _Pragma("unroll") for (int pp = 0; pp < NPC; ++pp) { const int p = wid + 8 * pp; \
            glds16(Kh + (size_t)(kv0_ + lane) * 512 + p * 8, (unsigned)__builtin_amdgcn_readfirstlane(lds0 + L_K + so_ + p * 1024)); } \
        _Pragma("unroll") for (int pp = 0; pp < NPC; ++pp) { const int p = wid + 8 * pp; \
            glds16(Vh + (size_t)(kv0_ + 16 * (p & 3) + (lane >> 2)) * 512 + (p >> 2) * 32 + (lane & 3) * 8, (unsigned)__builtin_amdgcn_readfirstlane(lds0 + L_V + so_ + p * 1024)); } } while (0)
    FA_DMA(0); if (NT > 1) FA_DMA(1); if (DIST > 2 && NT > 2) FA_DMA(2);
    const bf16_t* Qw = T.Q + (rowbase + q0 + wid * 32 + r32) * 512 + h * DH;
    bf16x8 qr[ND0];
#pragma unroll
    for (int d0 = 0; d0 < ND0; ++d0) qr[d0] = *(const bf16x8*)(Qw + d0 * 16 + hi * 8);
    unsigned selmask = 0xffu;
    float cfac[16]; float lg2 = 0.f;
    if (!RET) {
        { const int j = tid >> 6, d = tid & 63; const float* kp = T.KMP + ((size_t)(b * 8 + j) * 2) * 512 + h * 64 + d; KM[tid] = kp[0] + kp[512]; }
        FA_LBAR();
        float g[8];
#pragma unroll
        for (int j = 0; j < 8; ++j) g[j] = 0.f;
#pragma unroll
        for (int d0 = 0; d0 < ND0; ++d0)
#pragma unroll
            for (int jj = 0; jj < 8; ++jj) { const float qv = bf2f(qr[d0][jj]); const int d = 16 * d0 + 8 * hi + jj;
#pragma unroll
                for (int j = 0; j < 8; ++j) g[j] += qv * KM[j * 64 + d]; }
#pragma unroll
        for (int j = 0; j < 8; ++j) g[j] += __shfl_xor(g[j], 32);
        selmask = 0u;
#pragma unroll
        for (int j = 0; j < 8; ++j) { int rank = 0;
#pragma unroll
            for (int mm = 0; mm < 8; ++mm) rank += (mm < qblk && (g[mm] > g[j] || (g[mm] == g[j] && mm < j))) ? 1 : 0;
            if (j < qblk && rank < 3) selmask |= 1u << j; }
    } else {
        lg2 = log2f(1.0f - exp2f(-5.0f - (float)h));
#pragma unroll
        for (int r = 0; r < 16; ++r) cfac[r] = exp2f(-lg2 * (float)((r & 3) + 8 * (r >> 2)));
    }
    f32x16 o[NDB];
#pragma unroll
    for (int db = 0; db < NDB; ++db) o[db] = f32x16{};
    float mhat = 0.f, lrow = 0.f; f32x16 negm = f32x16{}; constexpr float THR = 8.0f;
    if (RET && qblk > 0) {
        const float* kvb = T.KVM + ((size_t)(b * 4 + h) * 8) * 16384;
        const float g256 = exp2f(lg2 * 256.0f);
#pragma unroll 2
        for (int it = 0; it < 8; ++it) { const int idx4 = tid + 512 * it; const int d = idx4 >> 5, e0 = (idx4 & 31) * 4;
            f32x4 acc4 = (f32x4){0.f, 0.f, 0.f, 0.f};
            for (int m = 0; m < qblk; ++m) acc4 = acc4 * g256 + *(const f32x4*)(kvb + (size_t)m * 16384 + d * 128 + e0);
            const int rp = (d & ~12) | ((d & 8) >> 1) | ((d & 4) << 1);
            typedef unsigned u32x2_ __attribute__((ext_vector_type(2)));
            u32x2_ w; w.x = cvtpk_s(acc4[0], acc4[1]); w.y = cvtpk_s(acc4[2], acc4[3]);
            *(FA_LAS u32x2_*)(shm + L_R + (e0 >> 5) * 8192 + rp * 64 + (e0 & 31) * 2) = w; }
        FA_LBAR();
        { FA_LAS const unsigned char* rb = shm + L_R + ((lane >> 4) & 1) * 32 + (lane & 3) * 8 + (4 * hi + ((lane & 15) >> 2)) * 64;
#pragma unroll
          for (int db = 0; db < NDB; ++db)
#pragma unroll
              for (int d0 = 0; d0 < ND0; ++d0) { const s16x4 lo = vtr(rb + db * 8192 + d0 * 1024), hh = vtr(rb + db * 8192 + d0 * 1024 + 512);
                  const bf16x8 rf = (bf16x8){lo[0], lo[1], lo[2], lo[3], hh[0], hh[1], hh[2], hh[3]};
                  o[db] = __builtin_amdgcn_mfma_f32_32x32x16_f16(__builtin_bit_cast(h16::f16x8_t, qr[d0]), __builtin_bit_cast(h16::f16x8_t, rf), o[db], 0, 0, 0); } }
#pragma unroll
        for (int r = 0; r < 16; ++r) { const float rd = exp2f(lg2 * (float)(wid * 32 + crow(r, hi) + 1));
#pragma unroll
            for (int db = 0; db < NDB; ++db) o[db][r] *= rd; }
    }
    const int qrel = wid * 32 + r32;
    for (int i = 0; i < NT; ++i) {
        { const int ahead = (NT - 1 - i) < (DIST - 1) ? (NT - 1 - i) : (DIST - 1);
          if (ahead == 2) { if (PER == 2) asm volatile("s_waitcnt vmcnt(4) lgkmcnt(0)\n\ts_barrier" ::: "memory"); else asm volatile("s_waitcnt vmcnt(8) lgkmcnt(0)\n\ts_barrier" ::: "memory"); }
          else if (ahead == 1) { if (PER == 2) asm volatile("s_waitcnt vmcnt(2) lgkmcnt(0)\n\ts_barrier" ::: "memory"); else asm volatile("s_waitcnt vmcnt(4) lgkmcnt(0)\n\ts_barrier" ::: "memory"); }
          else FA_WAIT_BAR(); }
        if (i + DIST < NT) FA_DMA(i + DIST);
        const bool diag = i < 4; const int t = i & 3; const int j = diag ? qblk : (qblk - 1 - ((i - 4) >> 2));
        const bool mysel = RET ? true : (((selmask >> j) & 1u) != 0u);
        const bool skip = diag ? (64 * t > 32 * wid + 31) : (RET ? false : !__any(mysel));
        if (skip) continue;
        const unsigned so = (unsigned)((i % NS) * SLOT);
        f32x16 p0 = RET ? f32x16{} : negm, p1 = p0;
        { FA_LAS const unsigned char* kb = shm + L_K + so + hi * 1024 + r32 * 16;
#pragma unroll
          for (int d0 = 0; d0 < ND0; ++d0) { const bf16x8 b0 = *(FA_LAS const bf16x8*)(kb + d0 * 2048); const bf16x8 b1 = *(FA_LAS const bf16x8*)(kb + d0 * 2048 + 512);
              p0 = __builtin_amdgcn_mfma_f32_32x32x16_f16(__builtin_bit_cast(h16::f16x8_t, b0), __builtin_bit_cast(h16::f16x8_t, qr[d0]), p0, 0, 0, 0); p1 = __builtin_amdgcn_mfma_f32_32x32x16_f16(__builtin_bit_cast(h16::f16x8_t, b1), __builtin_bit_cast(h16::f16x8_t, qr[d0]), p1, 0, 0, 0); } }
        if (RET) {
            const int qpos = q0 + qrel; const int kv0 = j * 256 + t * 64;
            const float base = (float)(qpos - kv0 - 4 * hi);
            const float rf0 = exp2f(lg2 * base), rf1 = exp2f(lg2 * (base - 32.0f));
#pragma unroll
            for (int r = 0; r < 16; ++r) { p0[r] *= rf0 * cfac[r]; p1[r] *= rf1 * cfac[r]; }
            if (diag) { const int kb_ = 64 * t + 4 * hi;
#pragma unroll
                for (int r = 0; r < 16; ++r) { const int kv = kb_ + (r & 3) + 8 * (r >> 2); if (kv > qrel) p0[r] = 0.f; if (kv + 32 > qrel) p1[r] = 0.f; } }
        } else {
            if (diag) { const int kb_ = 64 * t + 4 * hi;
#pragma unroll
                for (int r = 0; r < 16; ++r) { const int kv = kb_ + (r & 3) + 8 * (r >> 2); if (kv > qrel) p0[r] = NEG; if (kv + 32 > qrel) p1[r] = NEG; } }
            else if (!mysel) {
#pragma unroll
                for (int r = 0; r < 16; ++r) { p0[r] = NEG; p1[r] = NEG; } }
            float rm = fmaxf(fmaxf(p0[0], p1[0]), p0[1]);
#pragma unroll
            for (int r = 1; r < 16; ++r) { rm = fmaxf(fmaxf(rm, p1[r]), (r < 15) ? p0[r + 1] : p1[r]); }
            rm = fmaxf(rm, __shfl_xor(rm, 32));
            if (__any(rm > THR)) {
                const float dl = fmaxf(rm, 0.f);
                mhat += dl;
#pragma unroll
                for (int r = 0; r < 16; ++r) { p0[r] -= dl; p1[r] -= dl; }
#pragma unroll
                for (int r = 0; r < 16; ++r) negm[r] = -mhat;
                const float f = __builtin_amdgcn_exp2f(-dl); lrow *= f;
                asm volatile("" ::: "memory");
                if (hi == 0) wsf[r32] = f;
                asm volatile("s_waitcnt lgkmcnt(0)" ::: "memory");
#pragma unroll
                for (int r = 0; r < 16; ++r) { const float fr_ = wsf[crow(r, hi)];
#pragma unroll
                    for (int db = 0; db < NDB; ++db) o[db][r] *= fr_; }
                asm volatile("s_waitcnt lgkmcnt(0)" ::: "memory");
            }
            float s = 0.f;
#pragma unroll
            for (int r = 0; r < 16; ++r) { p0[r] = __builtin_amdgcn_exp2f(p0[r]); p1[r] = __builtin_amdgcn_exp2f(p1[r]); s += p0[r] + p1[r]; }
            lrow += s;
        }
        bf16x8 pa[4];
        { u32x4 w;
          w.x = cvtpk_s(p0[0], p0[1]); w.y = cvtpk_s(p0[2], p0[3]); w.z = cvtpk_s(p0[4], p0[5]); w.w = cvtpk_s(p0[6], p0[7]); pa[0] = __builtin_bit_cast(bf16x8, w);
          w.x = cvtpk_s(p0[8], p0[9]); w.y = cvtpk_s(p0[10], p0[11]); w.z = cvtpk_s(p0[12], p0[13]); w.w = cvtpk_s(p0[14], p0[15]); pa[1] = __builtin_bit_cast(bf16x8, w);
          w.x = cvtpk_s(p1[0], p1[1]); w.y = cvtpk_s(p1[2], p1[3]); w.z = cvtpk_s(p1[4], p1[5]); w.w = cvtpk_s(p1[6], p1[7]); pa[2] = __builtin_bit_cast(bf16x8, w);
          w.x = cvtpk_s(p1[8], p1[9]); w.y = cvtpk_s(p1[10], p1[11]); w.z = cvtpk_s(p1[12], p1[13]); w.w = cvtpk_s(p1[14], p1[15]); pa[3] = __builtin_bit_cast(bf16x8, w); }
        { FA_LAS const unsigned char* vb = shm + L_V + so + ((lane >> 4) & 1) * 32 + (lane & 3) * 8 + (4 * hi + ((lane & 15) >> 2)) * 64;
#pragma unroll
          for (int db = 0; db < NDB; ++db)
#pragma unroll
              for (int ks = 0; ks < 4; ++ks) { const s16x4 lo = vtr(vb + db * 4096 + ks * 1024), hh = vtr(vb + db * 4096 + ks * 1024 + 512);
                  const bf16x8 vf = (bf16x8){lo[0], lo[1], lo[2], lo[3], hh[0], hh[1], hh[2], hh[3]};
                  o[db] = __builtin_amdgcn_mfma_f32_32x32x16_f16(__builtin_bit_cast(h16::f16x8_t, pa[ks]), __builtin_bit_cast(h16::f16x8_t, vf), o[db], 0, 0, 0); } }
    }
    float rli[16];
    if (!RET) {
        const float l = lrow + __shfl_xor(lrow, 32);
        asm volatile("" ::: "memory");
        if (hi == 0) wsf[32 + r32] = 1.0f / l;
        asm volatile("s_waitcnt lgkmcnt(0)" ::: "memory");
#pragma unroll
        for (int r = 0; r < 16; ++r) rli[r] = wsf[32 + crow(r, hi)];
    } else {
#pragma unroll
        for (int r = 0; r < 16; ++r) rli[r] = 1.0f;
    }
    FA_LBAR();
    FA_LAS bf16_t* stg = (FA_LAS bf16_t*)(shm + wid * 8192);
#pragma unroll
    for (int r = 0; r < 16; ++r) { const int orow = crow(r, hi);
#pragma unroll
        for (int db = 0; db < NDB; ++db) { const unsigned pk = cvtpk_s(o[db][r] * rli[r], 0.f); stg[orow * DH + db * 32 + r32] = (bf16_t)(pk & 0xffffu); } }
    asm volatile("s_waitcnt lgkmcnt(0)" ::: "memory");
    const size_t tok0 = rowbase + q0 + wid * 32;
    if (!RET) {
#pragma unroll
        for (int i = 0; i < 4; ++i) { const int row = i * 8 + (lane >> 3), ch = lane & 7;
            const u32x4 v = *(FA_LAS const u32x4*)(stg + row * 64 + ch * 8);
            float ss = 0.f;
#pragma unroll
            for (int k = 0; k < 4; ++k) { const float a = h16::lo(v[k]), c = h16::hi(v[k]); ss += a * a + c * c; }
            ss += __shfl_xor(ss, 1); ss += __shfl_xor(ss, 2); ss += __shfl_xor(ss, 4);
            if (ch == 0) T.ASSQ[(tok0 + row) * 8 + h] = ss;
            *(u32x4*)(T.CAT + (tok0 + row) * 1024 + h * 64 + ch * 8) = v; }
    } else {
#pragma unroll
        for (int i = 0; i < 8; ++i) { const int row = i * 4 + (lane >> 4), ch = lane & 15;
            const u32x4 v = *(FA_LAS const u32x4*)(stg + row * 128 + ch * 8);
            float x[8];
#pragma unroll
            for (int k = 0; k < 4; ++k) { x[2 * k] = h16::lo(v[k]); x[2 * k + 1] = h16::hi(v[k]); }
            float ss = 0.f;
#pragma unroll
            for (int k = 0; k < 8; ++k) ss += x[k] * x[k];
            ss += __shfl_xor(ss, 1); ss += __shfl_xor(ss, 2); ss += __shfl_xor(ss, 4); ss += __shfl_xor(ss, 8);
            const float rs = 1.0f / sqrtf(ss * (1.0f / 128.0f) + 1e-6f);
            const u32x4 gv = *(const u32x4*)(T.GR + (tok0 + row) * 512 + h * 128 + ch * 8);
            const f32x4 w0 = *(const f32x4*)(T.ret_g + h * 128 + ch * 8), w1 = *(const f32x4*)(T.ret_g + h * 128 + ch * 8 + 4);
            const float wg[8] = {w0[0], w0[1], w0[2], w0[3], w1[0], w1[1], w1[2], w1[3]};
            float y[8];
#pragma unroll
            for (int k = 0; k < 4; ++k) { const float g0 = h16::lo(gv[k]), g1 = h16::hi(gv[k]);
                y[2 * k] = x[2 * k] * rs * wg[2 * k] * g0; y[2 * k + 1] = x[2 * k + 1] * rs * wg[2 * k + 1] * g1; }
            u32x4 ov; ov.x = cvtpk_s(y[0], y[1]); ov.y = cvtpk_s(y[2], y[3]); ov.z = cvtpk_s(y[4], y[5]); ov.w = cvtpk_s(y[6], y[7]);
            *(u32x4*)(T.CAT + (tok0 + row) * 1024 + 512 + h * 128 + ch * 8) = ov; }
    }
    FA_LBAR();
#undef FA_KV0
#undef FA_DMA
}

__device__ __forceinline__ void kv_unit(int b, int h, int m, const bf16_t* Kg, const bf16_t* Vg, float* KVM, FA_LAS unsigned char* shm) {
    constexpr int SLOT = 16384, L_K = 0, L_V = 4 * SLOT;
    int tid_ = threadIdx.x; asm volatile("" : "+v"(tid_));
    const int tid = tid_, lane = tid & 63, r32 = lane & 31, hi = lane >> 5; const int wid = __builtin_amdgcn_readfirstlane(tid >> 6);
    const int dg = wid >> 1, eh = wid & 1;
    const size_t rowbase = (size_t)b * 2048 + (size_t)m * 256;
    const unsigned lds0 = (unsigned)(unsigned long)shm;
    const bf16_t* Kh = Kg + rowbase * 512 + h * 128; const bf16_t* Vh = Vg + rowbase * 512 + h * 128;
#pragma unroll
    for (int t = 0; t < 4; ++t)
#pragma unroll
        for (int pp = 0; pp < 2; ++pp) { const int p = wid + 8 * pp; const size_t off = (size_t)(64 * t + 16 * (p & 3) + (lane >> 2)) * 512 + (p >> 2) * 32 + (lane & 3) * 8;
            glds16(Kh + off, (unsigned)__builtin_amdgcn_readfirstlane(lds0 + L_K + t * SLOT + p * 1024));
            glds16(Vh + off, (unsigned)__builtin_amdgcn_readfirstlane(lds0 + L_V + t * SLOT + p * 1024)); }
    const float lg2 = log2f(1.0f - exp2f(-5.0f - (float)h));
    const float g64 = exp2f(lg2 * 64.0f);
    h16::f16x8_t fd[4];
#pragma unroll
    for (int ks = 0; ks < 4; ++ks)
#pragma unroll
        for (int j = 0; j < 8; ++j) fd[ks][j] = (_Float16)exp2f(lg2 * (float)(63 - (16 * ks + 8 * (j >> 2) + 4 * hi + (j & 3))));
    f32x16 acc[2]; acc[0] = f32x16{}; acc[1] = f32x16{};
    FA_WAIT_BAR();
    const int lb = ((lane >> 4) & 1) * 32 + (lane & 3) * 8 + (4 * hi + ((lane & 15) >> 2)) * 64;
#pragma unroll
    for (int t = 0; t < 4; ++t) {
        if (t > 0) {
#pragma unroll
            for (int r = 0; r < 16; ++r) { acc[0][r] *= g64; acc[1][r] *= g64; } }
        FA_LAS const unsigned char* kb = shm + L_K + t * SLOT + dg * 4096 + lb; FA_LAS const unsigned char* vb = shm + L_V + t * SLOT + (2 * eh) * 4096 + lb;
#pragma unroll
        for (int ks = 0; ks < 4; ++ks) { const s16x4 klo = vtr(kb + ks * 1024), khi = vtr(kb + ks * 1024 + 512);
            const h16::f16x8_t kf = __builtin_bit_cast(h16::f16x8_t, (bf16x8){klo[0], klo[1], klo[2], klo[3], khi[0], khi[1], khi[2], khi[3]});
#pragma unroll
            for (int eb = 0; eb < 2; ++eb) { const s16x4 vlo = vtr(vb + eb * 4096 + ks * 1024), vhi = vtr(vb + eb * 4096 + ks * 1024 + 512);
                const h16::f16x8_t vf = __builtin_bit_cast(h16::f16x8_t, (bf16x8){vlo[0], vlo[1], vlo[2], vlo[3], vhi[0], vhi[1], vhi[2], vhi[3]}) * fd[ks];
                acc[eb] = __builtin_amdgcn_mfma_f32_32x32x16_f16(kf, vf, acc[eb], 0, 0, 0); } }
    }
    float* op = KVM + ((size_t)(b * 4 + h) * 8 + m) * 16384;
#pragma unroll
    for (int eb = 0; eb < 2; ++eb)
#pragma unroll
        for (int r = 0; r < 16; ++r) op[(size_t)(32 * dg + crow(r, hi)) * 128 + 64 * eh + 32 * eb + r32] = acc[eb][r];
    FA_LBAR();
}
}
namespace mk {
#define GAS __attribute__((address_space(1)))
#define LAS __attribute__((address_space(3)))
typedef unsigned short bf16;
typedef unsigned v4u __attribute__((ext_vector_type(4)));
typedef unsigned v2u __attribute__((ext_vector_type(2)));
typedef float f32x4 __attribute__((ext_vector_type(4)));
typedef int i32x4 __attribute__((ext_vector_type(4)));
typedef GAS unsigned gu32;
#define RLX_AGENT __ATOMIC_RELAXED, __HIP_MEMORY_SCOPE_AGENT
#define LDS_WAIT() asm volatile("s_waitcnt lgkmcnt(0)" ::: "memory")
#define VM_WAIT() asm volatile("s_waitcnt vmcnt(0)" ::: "memory")
constexpr int NWAVES = 8;
constexpr size_t MiB = 1u << 20, KiB = 1u << 10;
constexpr size_t WS_CTL = 0;
constexpr size_t CTL_ZERO_BYTES = 64 * KiB;
constexpr size_t WS_MOD = 64 * KiB;
constexpr size_t WS_KMP = 512 * KiB;
constexpr size_t WS_EIDX = 768 * KiB;
constexpr size_t WS_EW = 896 * KiB;
constexpr size_t WS_ROPE = 1 * MiB;
constexpr size_t WS_ASSQ = 2 * MiB;
constexpr size_t WS_SROW = 2 * MiB + 512 * KiB;
constexpr size_t WS_SWT = 2 * MiB + 768 * KiB;
constexpr size_t WS_WCNT = 3 * MiB;
constexpr size_t WS_SEG = 3 * MiB + 64 * KiB;
constexpr size_t WS_SEGD = 3 * MiB + 65 * KiB;
constexpr size_t WS_MGU = 8 * MiB;
constexpr size_t WS_MDN = 96 * MiB;
constexpr size_t WS_XA = 140 * MiB;
constexpr size_t WS_XS = 172 * MiB;
constexpr size_t WS_KVM = 172 * MiB;
constexpr size_t WS_YS = 140 * MiB;
constexpr size_t WS_WIN = 240 * MiB;
constexpr size_t WS_WOUT = 254 * MiB;
constexpr size_t WS_FGU = 258 * MiB;
constexpr size_t WS_FDN = 269 * MiB;
constexpr size_t WS_QKV = 275 * MiB;
constexpr size_t WS_CAT = 387 * MiB;
constexpr size_t WS_HD = 275 * MiB;
constexpr size_t WS_HM = 240 * MiB;
constexpr size_t WS_END = 428 * MiB;
constexpr int XS_ROWS = 34816;
constexpr int CW_BAR = 1024;

constexpr int RING_BYTES = 131072, LDSCTL_OFF = RING_BYTES, MISC_OFF = LDSCTL_OFF + 320, LDS_BYTES = 147456;

#define XB_TMO      128
#define XB_XCNT(j)  (256  + 64 * (j))
#define XB_XSUB(j)  (1280 + 64 * (j))
#define XB_XGEN(j)  (2304 + 64 * (j))
#define XB_TOP      3328
#define XB_TOPGEN   3392
#define XCD_BAR_WORDS 3456
#define XB_SPIN_CAP (1u << 18)
__device__ __forceinline__ unsigned xb_ld(unsigned* p)              { return __hip_atomic_load(p, __ATOMIC_RELAXED, __HIP_MEMORY_SCOPE_AGENT); }
__device__ __forceinline__ unsigned xb_add(unsigned* p, unsigned v) { return __hip_atomic_fetch_add(p, v, __ATOMIC_RELAXED, __HIP_MEMORY_SCOPE_AGENT); }
__device__ __forceinline__ unsigned xb_xcc_id() { return (unsigned)__builtin_amdgcn_s_getreg((3 << 11) | 20) & 0xFu; }
#define XB_SPIN(cond, bar) do { unsigned _sp = 0; while (cond) { __builtin_amdgcn_s_sleep(1); \
    if ((++_sp & 255u) == 0u) { if (xb_ld(&(bar)[XB_TMO])) break; if (_sp > XB_SPIN_CAP) { atomicAdd(&(bar)[XB_TMO], 1u); break; } } } } while (0)
struct XcdBarrier { unsigned* bar; unsigned x; volatile LAS unsigned* st; };
__device__ __forceinline__ XcdBarrier xcd_barrier_post(unsigned* bar, volatile LAS unsigned* st) {
    XcdBarrier b; b.bar = bar; b.x = xb_xcc_id(); b.st = st;
    if (threadIdx.x == 0) (void)xb_add(&bar[XB_XCNT(b.x)], 1u);
    return b;
}
__device__ __forceinline__ void xcd_barrier_complete(unsigned* bar, unsigned x, unsigned& nloc, unsigned& nx) {
    const unsigned G = gridDim.x * gridDim.y * gridDim.z;
    unsigned sum, cnt, mine, sp = 0u;
    for (;;) {
        sum = 0u; cnt = 0u; mine = 0u;
#pragma unroll
        for (unsigned j = 0; j < 16; ++j) { const unsigned c = xb_ld(&bar[XB_XCNT(j)]); sum += c; cnt += (c > 0u) ? 1u : 0u; mine = (j == x) ? c : mine; }
        if (sum == G) break;
        __builtin_amdgcn_s_sleep(1);
        if ((++sp & 255u) == 0u) { if (xb_ld(&bar[XB_TMO])) break; if (sp > XB_SPIN_CAP) { atomicAdd(&bar[XB_TMO], 1u); break; } }
    }
    nloc = mine > 0u ? mine : 1u; nx = cnt > 0u ? cnt : 1u;
}
__device__ __forceinline__ void xcd_barrier(const XcdBarrier& b) {
    asm volatile("s_waitcnt vmcnt(0)" ::: "memory");
    __syncthreads();
    if (threadIdx.x == 0) {
        unsigned* bar = b.bar;
        __builtin_amdgcn_s_waitcnt(0);
        unsigned nloc = b.st[0], nx = b.st[1];
        if (nloc == 0u) { xcd_barrier_complete(bar, b.x, nloc, nx); b.st[0] = nloc; b.st[1] = nx; }
        const unsigned old = xb_add(&bar[XB_XSUB(b.x)], 1u);
        const unsigned gen = old / nloc;
        if (old + 1u == (gen + 1u) * nloc) {
            __builtin_amdgcn_fence(__ATOMIC_RELEASE, "agent");
            asm volatile("s_waitcnt vmcnt(0)" ::: "memory");
            const unsigned og = xb_add(&bar[XB_TOP], 1u);
            const unsigned tg = og / nx;
            if (og + 1u == (tg + 1u) * nx) xb_add(&bar[XB_TOPGEN], 1u);
            else XB_SPIN(xb_ld(&bar[XB_TOPGEN]) == tg, bar);
            __builtin_amdgcn_fence(__ATOMIC_ACQUIRE, "agent");
            xb_add(&bar[XB_XGEN(b.x)], 1u);
            asm volatile("s_waitcnt vmcnt(0)" ::: "memory");
        } else {
            XB_SPIN(xb_ld(&bar[XB_XGEN(b.x)]) == gen, bar);
            __builtin_amdgcn_fence(__ATOMIC_ACQUIRE, "agent");
            asm volatile("s_waitcnt vmcnt(0)" ::: "memory");
        }
    }
    __syncthreads();
}

__device__ __forceinline__ unsigned f2bf(float f) { unsigned u = __builtin_bit_cast(unsigned, f); return (u + 0x7fffu + ((u >> 16) & 1u)) >> 16; }
__device__ __forceinline__ unsigned pk2(float lo, float hi) { return h16::pk(lo, hi); }
__device__ __forceinline__ float wave_sum(float v) {
#pragma unroll
    for (int o = 1; o < 64; o <<= 1) v += __shfl_xor(v, o);
    return v;
}
__device__ __forceinline__ int wave_sum_i(int v) {
#pragma unroll
    for (int o = 1; o < 64; o <<= 1) v += __shfl_xor(v, o);
    return v;
}

struct Inputs {
    const float *x, *c, *norm_mix_g, *norm_ffn_g, *ada_w, *ada_b, *w_in, *w_out, *att_g, *ret_g, *fw_gate, *fw_up, *fw_down, *router_w, *mw_gate, *mw_up, *mw_down, *final_g;
};

template <class SrcFn> __device__ __forceinline__ void transpose_item(SrcFn src, int K, bf16* WT, int k0, int n0, LAS float* scr, int lane) {
#pragma unroll 8
    for (int i = 0; i < 32; ++i) { const int kk = 2 * i + (lane >> 5); scr[kk * 33 + (lane & 31)] = src(k0 + kk, n0 + (lane & 31)); }
    LDS_WAIT(); asm volatile("" ::: "memory");
    const int c = lane & 7;
#pragma unroll
    for (int j = 0; j < 4; ++j) { const int n = (lane >> 3) + 8 * j; const LAS float* s = scr + (8 * c) * 33 + n;
        v4u o; o.x = pk2(s[0 * 33], s[1 * 33]); o.y = pk2(s[2 * 33], s[3 * 33]); o.z = pk2(s[4 * 33], s[5 * 33]); o.w = pk2(s[6 * 33], s[7 * 33]);
        *(GAS v4u*)(WT + (size_t)(n0 + n) * K + k0 + 8 * c) = o; }
    LDS_WAIT(); asm volatile("" ::: "memory");
}
__device__ __forceinline__ int rot_src_col(int n) {
    if (n < 1536 || n >= 2560) return n;
    const int hb = (n - 1536) & ~127, p = (n - 1536) & 127;
    return 1536 + hb + 4 * (p >> 3) + ((p & 7) >> 1) + 64 * (p & 1);
}
constexpr int IT_WIN = 16 * 112, IT_WOUT = 16 * 32, IT_GU = 16 * 176, IT_DN = 44 * 32;
constexpr int IT_TOTAL = 2 * IT_WIN + 2 * IT_WOUT + IT_GU + IT_DN + 8 * (IT_GU + IT_DN);

template <class InP> __device__ __forceinline__ void p0_prologue(InP inp, unsigned char* ws, LAS unsigned char* lds, int vcu, int G, int wave, int lane, int tid, int moe_w) {
    Inputs in; in.c = inp->c; in.ada_w = inp->ada_w; in.ada_b = inp->ada_b; in.w_in = inp->w_in; in.w_out = inp->w_out; in.att_g = inp->att_g; in.fw_gate = inp->fw_gate; in.fw_up = inp->fw_up; in.fw_down = inp->fw_down; in.mw_gate = inp->mw_gate; in.mw_up = inp->mw_up; in.mw_down = inp->mw_down;
    if (vcu < 192) {
        LAS float* cs = (LAS float*)lds;
        LAS float* part = (LAS float*)(lds + 32768);
        for (int i = tid; i < 8 * 1024; i += 512) { const float v = in.c[i]; cs[i] = v / (1.0f + __expf(-v)); }
        __syncthreads();
        const int n0 = vcu * 64, l = n0 / 6144, nn = n0 % 6144 + lane;
        const float* wp = in.ada_w + (size_t)l * 1024 * 6144 + (size_t)(wave * 128) * 6144 + nn;
        float acc[8];
#pragma unroll
        for (int b = 0; b < 8; ++b) acc[b] = 0.f;
#pragma unroll 8
        for (int k = 0; k < 128; ++k) { const float wv = wp[(size_t)k * 6144];
#pragma unroll
            for (int b = 0; b < 8; ++b) acc[b] += cs[b * 1024 + wave * 128 + k] * wv; }
#pragma unroll
        for (int b = 0; b < 8; ++b) part[(wave * 8 + b) * 64 + lane] = acc[b];
        __syncthreads();
        { const int b = tid >> 6; float s = 0.f;
#pragma unroll
          for (int w = 0; w < 8; ++w) s += part[(w * 8 + b) * 64 + lane];
          ((float*)(ws + WS_MOD))[((size_t)l * 8 + b) * 6144 + nn] = s + in.ada_b[l * 6144 + nn]; }
        __syncthreads();
    }
    { const int g = vcu * 512 + tid; if (g < 2048 * 64) { const int pos = g >> 6, i = g & 63; const float inv = powf(10000.0f, -(float)i / 64.0f); const float ang = (float)pos * inv;
        float* rp = (float*)(ws + WS_ROPE) + (size_t)g * 2; rp[0] = (float)cos((double)ang); rp[1] = (float)sin((double)ang); } }
    LAS float* scr = (LAS float*)(lds + wave * 16384);
    const int gw = vcu * NWAVES + wave, NGW = G * NWAVES;
    const int it_end = moe_w ? IT_TOTAL : (2 * IT_WIN + 2 * IT_WOUT + IT_GU + IT_DN);
    for (int it = gw; it < it_end; it += NGW) {
        int r = it;
        if (r < 2 * IT_WIN) { const int l = r / IT_WIN; r -= l * IT_WIN; const float* W = in.w_in + (size_t)l * 1024 * 3584;
            transpose_item([=](int k, int n) { return W[(size_t)k * 3584 + rot_src_col(n)]; }, 1024, (bf16*)(ws + WS_WIN) + (size_t)l * 3584 * 1024, 64 * (r / 112), 32 * (r % 112), scr, lane); continue; }
        r -= 2 * IT_WIN;
        if (r < 2 * IT_WOUT) { const int l = r / IT_WOUT; r -= l * IT_WOUT; const float* W = in.w_out + (size_t)l * 1024 * 1024; const float* ag = in.att_g + l * 512;
            transpose_item([=](int k, int n) { return W[(size_t)k * 1024 + n] * (k < 512 ? ag[k] : 1.0f); }, 1024, (bf16*)(ws + WS_WOUT) + (size_t)l * 1024 * 1024, 64 * (r / 32), 32 * (r % 32), scr, lane); continue; }
        r -= 2 * IT_WOUT;
        const float *Wg, *Wu, *Wd; bf16 *Dgu, *Ddn;
        if (r < IT_GU + IT_DN) { Wg = in.fw_gate; Wu = in.fw_up; Wd = in.fw_down; Dgu = (bf16*)(ws + WS_FGU); Ddn = (bf16*)(ws + WS_FDN); }
        else { r -= IT_GU + IT_DN; const int e = r / (IT_GU + IT_DN); r -= e * (IT_GU + IT_DN);
            Wg = in.mw_gate + (size_t)e * 1024 * 2816; Wu = in.mw_up + (size_t)e * 1024 * 2816; Wd = in.mw_down + (size_t)e * 2816 * 1024;
            Dgu = (bf16*)(ws + WS_MGU) + (size_t)e * 5632 * 1024; Ddn = (bf16*)(ws + WS_MDN) + (size_t)e * 1024 * 2816; }
        if (r < IT_GU) {
            transpose_item([=](int k, int n) { const float* W = ((n >> 7) & 1) ? Wu : Wg; return W[(size_t)k * 2816 + (n >> 8) * 128 + (n & 127)]; }, 1024, Dgu, 64 * (r / 176), 32 * (r % 176), scr, lane); continue; }
        r -= IT_GU;
        transpose_item([=](int k, int n) { return Wd[(size_t)k * 1024 + n]; }, 2816, Ddn, 64 * (r / 32), 32 * (r % 32), scr, lane);
    }
}

template <int MODE>
__device__ __forceinline__ void norm_pass(const float* xsrc, const float* gain, const float* sh, const float* sc, bf16* dst,
                                          const float* router_w, int* eidx, float* ew, int* wcnt, int gw, int lane) {
    const int m0 = gw * 8, b = m0 >> 11;
    f32x4 gv[4], scv[4], shv[4];
#pragma unroll
    for (int j = 0; j < 4; ++j) { gv[j] = ((const f32x4*)gain)[lane + 64 * j]; scv[j] = ((const f32x4*)(sc + (size_t)b * 6144))[lane + 64 * j] + 1.0f; shv[j] = ((const f32x4*)(sh + (size_t)b * 6144))[lane + 64 * j]; }
    int cnt[8];
#pragma unroll
    for (int e = 0; e < 8; ++e) cnt[e] = 0;
    f32x4 rw[4][4][2];
    if (MODE == 1) {
#pragma unroll
        for (int j = 0; j < 4; ++j)
#pragma unroll
            for (int c = 0; c < 4; ++c) { const float* wp = router_w + (size_t)(4 * (lane + 64 * j) + c) * 8; rw[j][c][0] = *(const f32x4*)wp; rw[j][c][1] = *(const f32x4*)(wp + 4); }
    }
    for (int i = 0; i < 8; ++i) {
        const int m = m0 + i;
        const f32x4* xr = (const f32x4*)(xsrc + (size_t)m * 1024) + lane;
        f32x4 v[4]; float s = 0.f;
#pragma unroll
        for (int j = 0; j < 4; ++j) { v[j] = xr[64 * j]; s += (v[j][0] * v[j][0] + v[j][1] * v[j][1]) + (v[j][2] * v[j][2] + v[j][3] * v[j][3]); }
        const float rs = 1.0f / sqrtf(wave_sum(s) * (1.0f / 1024.0f) + 1e-6f);
        v2u* o8 = (v2u*)(dst + (size_t)m * 1024) + lane;
#pragma unroll
        for (int j = 0; j < 4; ++j) { v[j] = v[j] * rs * gv[j] * scv[j] + shv[j]; v2u w; w.x = pk2(v[j][0], v[j][1]); w.y = pk2(v[j][2], v[j][3]); o8[64 * j] = w; }
        if (MODE == 1) {
            float lg[8];
#pragma unroll
            for (int e = 0; e < 8; ++e) lg[e] = 0.f;
#pragma unroll
            for (int j = 0; j < 4; ++j)
#pragma unroll
                for (int c = 0; c < 4; ++c) { const f32x4 w0 = rw[j][c][0], w1 = rw[j][c][1];
                    const float hv = v[j][c];
                    lg[0] += hv * w0[0]; lg[1] += hv * w0[1]; lg[2] += hv * w0[2]; lg[3] += hv * w0[3]; lg[4] += hv * w1[0]; lg[5] += hv * w1[1]; lg[6] += hv * w1[2]; lg[7] += hv * w1[3]; }
#pragma unroll
            for (int e = 0; e < 8; ++e) lg[e] = wave_sum(lg[e]);
            int i0 = 0; float b0 = lg[0];
#pragma unroll
            for (int e = 1; e < 8; ++e) if (lg[e] > b0) { b0 = lg[e]; i0 = e; }
            int i1 = -1; float b1 = -3.0e38f;
#pragma unroll
            for (int e = 0; e < 8; ++e) if (e != i0 && lg[e] > b1) { b1 = lg[e]; i1 = e; }
            const float e1 = __expf(b1 - b0);
#pragma unroll
            for (int e = 0; e < 8; ++e) cnt[e] += ((e == i0) ? 1 : 0) + ((e == i1) ? 1 : 0);
            if (lane == 0) { eidx[m * 2] = i0; eidx[m * 2 + 1] = i1; ew[m * 2] = 1.0f / (1.0f + e1); ew[m * 2 + 1] = e1 / (1.0f + e1); }
        }
    }
    if (MODE == 1) {
        int myc = 0;
#pragma unroll
        for (int e = 0; e < 8; ++e) myc = (lane == e) ? cnt[e] : myc;
        if (lane < 8) wcnt[gw * 8 + lane] = myc;
    }
}

__device__ __forceinline__ void place_pass(const int* wcnt, const int* eidx, const float* ew, const bf16* XA, bf16* XS, int* srow, float* swt, int* segout, int gw, int NGW, int lane) {
    int tot[8], pre[8];
#pragma unroll
    for (int e = 0; e < 8; ++e) { tot[e] = 0; pre[e] = 0; }
    for (int w = lane; w < NGW; w += 64) { const i32x4 a = *(const i32x4*)(wcnt + w * 8), c = *(const i32x4*)(wcnt + w * 8 + 4); const int inc = (w < gw) ? 1 : 0;
        tot[0] += a[0]; tot[1] += a[1]; tot[2] += a[2]; tot[3] += a[3]; tot[4] += c[0]; tot[5] += c[1]; tot[6] += c[2]; tot[7] += c[3];
        pre[0] += inc * a[0]; pre[1] += inc * a[1]; pre[2] += inc * a[2]; pre[3] += inc * a[3]; pre[4] += inc * c[0]; pre[5] += inc * c[1]; pre[6] += inc * c[2]; pre[7] += inc * c[3]; }
    int base[8]; int run = 0;
#pragma unroll
    for (int e = 0; e < 8; ++e) { tot[e] = wave_sum_i(tot[e]); pre[e] = wave_sum_i(pre[e]); base[e] = run + pre[e]; if (gw == 0 && lane == 0) segout[e] = run; run += (tot[e] + 255) & ~255; }
    if (gw == 0 && lane == 0) segout[8] = run;
    for (int i = 0; i < 16; ++i) {
        const int a = gw * 16 + i; const int ev = __builtin_amdgcn_readfirstlane(eidx[a]); int pos = 0;
#pragma unroll
        for (int e = 0; e < 8; ++e) if (ev == e) { pos = base[e]; base[e] += 1; }
        if (lane == 0) { srow[pos] = a; swt[pos] = ew[a]; }
        const v4u* s = (const v4u*)(XA + (size_t)(a >> 1) * 1024); v4u* d = (v4u*)(XS + (size_t)pos * 1024);
        d[lane] = s[lane]; d[lane + 64] = s[lane + 64];
    }
}

__device__ __forceinline__ void final_pass(float* xio, const bf16* YS, const float* g2, const float* fg, int gw, int lane) {
    const int m0 = gw * 8, b = m0 >> 11;
    f32x4 gv[4], g2v[4];
#pragma unroll
    for (int j = 0; j < 4; ++j) { gv[j] = ((const f32x4*)fg)[lane + 64 * j]; g2v[j] = ((const f32x4*)(g2 + (size_t)b * 6144))[lane + 64 * j]; }
    for (int i = 0; i < 8; ++i) {
        const int m = m0 + i;
        f32x4* xr = (f32x4*)(xio + (size_t)m * 1024) + lane;
        const v2u* y0 = (const v2u*)(YS + (size_t)(2 * m) * 1024) + lane; const v2u* y1 = (const v2u*)(YS + (size_t)(2 * m + 1) * 1024) + lane;
        f32x4 v[4]; float s = 0.f;
#pragma unroll
        for (int j = 0; j < 4; ++j) { v[j] = xr[64 * j]; const v2u a = y0[64 * j], c = y1[64 * j];
            f32x4 ys; ys[0] = h16::lo(a.x) + h16::lo(c.x); ys[1] = h16::hi(a.x) + h16::hi(c.x); ys[2] = h16::lo(a.y) + h16::lo(c.y); ys[3] = h16::hi(a.y) + h16::hi(c.y);
            v[j] = v[j] + g2v[j] * ys; s += (v[j][0] * v[j][0] + v[j][1] * v[j][1]) + (v[j][2] * v[j][2] + v[j][3] * v[j][3]); }
        const float rs = 1.0f / sqrtf(wave_sum(s) * (1.0f / 1024.0f) + 1e-6f);
#pragma unroll
        for (int j = 0; j < 4; ++j) xr[64 * j] = v[j] * rs * gv[j];
    }
}

constexpr int N_PHASES = 18;
struct Args { Inputs in; float* out; unsigned char* ws; int ph_lo, ph_hi, bar_region, moe_w; };

typedef const Args __attribute__((address_space(4))) CArgs;
__device__ __forceinline__ CArgs* kargs() { unsigned long off = 0; asm volatile("" : "+s"(off)); return (CArgs*)((const char __attribute__((address_space(4)))*)__builtin_amdgcn_kernarg_segment_ptr() + off); }

__global__ void __launch_bounds__(NWAVES * 64, 2) mega(Args args_unused) {
    extern __shared__ __attribute__((aligned(16))) unsigned char lds_raw[];
    LAS unsigned char* lds = (LAS unsigned char*)lds_raw;
    volatile LAS unsigned* MISC = (volatile LAS unsigned*)(lds + MISC_OFF);
    const int G = gridDim.x;
#define PHASE_IDS int tid = threadIdx.x; asm volatile("" : "+v"(tid)); int bx = blockIdx.x; asm volatile("" : "+s"(bx)); const int lane = tid & 63, wave = __builtin_amdgcn_readfirstlane(tid >> 6); \
    const int vcu = (bx & 7) * (G >> 3) + (bx >> 3); const int gw = vcu * NWAVES + wave; (void)lane; (void)gw; (void)vcu;
    for (int u = threadIdx.x; u < (LDS_BYTES - LDSCTL_OFF) / 4; u += NWAVES * 64) ((LAS unsigned*)(lds + LDSCTL_OFF))[u] = 0u;
    __syncthreads();
    XcdBarrier bar;
    { CArgs* ka = kargs(); unsigned* barw = (unsigned*)(ka->ws + WS_CTL) + CW_BAR + ka->bar_region * XCD_BAR_WORDS; bar = xcd_barrier_post(barw, MISC + 8); }
    int lo, hi; { CArgs* ka = kargs(); lo = ka->ph_lo; hi = ka->ph_hi; }
#ifndef PHM
#define PHM 0x3ff
#endif
#define IN(k) (lo <= (k) && (k) < hi)
#define TY(t) (((PHM) >> (t)) & 1)
#ifndef DUP_T
#define DUP_T -1
#define DUP_N 0
#endif
#define REP(t) for (int rep_ = 0; rep_ < ((t) == DUP_T ? 1 + DUP_N : 1) && (rep_ == 0 || (__syncthreads(), true)); ++rep_)
#ifdef TPROBE
    volatile LAS unsigned long long* TS = (volatile LAS unsigned long long*)(lds + MISC_OFF + 256);
#define STAMP(k) do { if (blockIdx.x == 0 && threadIdx.x == 0) TS[(k)] = __builtin_amdgcn_s_memrealtime(); } while (0)
#else
#define STAMP(k) do {} while (0)
#endif
    STAMP(0);
#define SEAM(k) do { if (IN(k) && IN((k) + 1)) xcd_barrier(bar); STAMP((k) + 1); } while (0)

    if (TY(0) && IN(0)) REP(0) { PHASE_IDS CArgs* ka = kargs(); p0_prologue(&ka->in, ka->ws, lds, vcu, G, wave, lane, tid, ka->moe_w); }
    SEAM(0);
#ifdef PROBE_BAR
    for (int q = 0; q < PROBE_BAR; ++q) xcd_barrier(bar);
#endif
    for (int l = 0; l < 2; ++l) {
        const int pb = 1 + 8 * l;
        if (TY(1) && IN(pb + 0)) REP(1) { PHASE_IDS CArgs* ka = kargs(); unsigned char* ws = ka->ws; const float* mod = (const float*)(ws + WS_MOD) + (size_t)l * 8 * 6144;
            const float* xin = (l == 0) ? ka->in.x : (const float*)ka->out;
            if (gw < 2048) norm_pass<0>(xin, ka->in.norm_mix_g + l * 1024, mod + 0 * 1024, mod + 1 * 1024, (bf16*)(ws + WS_XA), nullptr, nullptr, nullptr, nullptr, gw, lane); }
        SEAM(pb + 0);
        if (TY(2) && IN(pb + 1)) REP(2) { PHASE_IDS CArgs* ka = kargs(); unsigned char* ws = ka->ws;
            pg8::Gemm g{1024, 1024, 1024}; pg8::DenseSched S; S.init(ws + WS_XA, 1024, (bf16*)(ws + WS_WIN) + (size_t)l * 3584 * 1024, 1024, 16384, 3584, G, bx);
            epi::EpiInProj E{(bf16*)(ws + WS_QKV), (size_t)16384 * 512, (float*)(ws + WS_KMP), (const float*)(ws + WS_ROPE)};
            pg8::gemm_phase(lds, g, S, E);
        }
        SEAM(pb + 1);
        if (TY(3) && IN(pb + 2)) REP(3) { PHASE_IDS CArgs* ka = kargs(); unsigned char* ws = ka->ws; bf16* QKV = (bf16*)(ws + WS_QKV); bf16* CAT = (bf16*)(ws + WS_CAT);
            if (G == 256) {
                if ((bx & 7) < 7) fa::kv_unit(bx >> 5, (bx >> 3) & 3, bx & 7, QKV + (size_t)4 * 16384 * 512, QKV + (size_t)5 * 16384 * 512, (float*)(ws + WS_KVM), lds);
                xcd_barrier(bar);
                { fa::Tensors TR{QKV + (size_t)3 * 16384 * 512, QKV + (size_t)4 * 16384 * 512, QKV + (size_t)5 * 16384 * 512, CAT, (float*)(ws + WS_ASSQ), (const float*)(ws + WS_KMP), QKV + (size_t)6 * 16384 * 512, ka->in.ret_g + l * 512, (const float*)(ws + WS_KVM)};
                  fa::attn_unit<true>(bx >> 5, (bx >> 3) & 3, bx & 7, TR, lds); }
                fa::Tensors TA{QKV, QKV + (size_t)1 * 16384 * 512, QKV + (size_t)2 * 16384 * 512, CAT, (float*)(ws + WS_ASSQ), (const float*)(ws + WS_KMP), nullptr, nullptr, nullptr};
                const int bh = bx >> 2, pr = bx & 3;
                for (int uu = 0; uu < 2; ++uu) fa::attn_unit<false>(bh >> 3, bh & 7, uu == 0 ? 7 - pr : pr, TA, lds);
            }
        }
        SEAM(pb + 2);
        if (TY(4) && IN(pb + 3)) REP(4) {
            { PHASE_IDS CArgs* ka = kargs(); unsigned char* ws = ka->ws; const float* mod = (const float*)(ws + WS_MOD) + (size_t)l * 8 * 6144;
                const float* xin = (l == 0) ? ka->in.x : (const float*)ka->out;
                pg8::Gemm g{1024, 1024, 1024}; pg8::DenseSched S; S.init(ws + WS_CAT, 1024, (const bf16*)(ws + WS_WOUT) + (size_t)l * 1024 * 1024, 1024, 16384, 1024, G, bx);
                epi::EpiOutProj E{xin, ka->out, mod + 2 * 1024, (const float*)(ws + WS_ASSQ), rep_ > 0}; pg8::gemm_phase(lds, g, S, E); }
        }
        SEAM(pb + 3);
        if (TY(5) && IN(pb + 4)) REP(5) { PHASE_IDS CArgs* ka = kargs(); unsigned char* ws = ka->ws; const float* mod = (const float*)(ws + WS_MOD) + (size_t)l * 8 * 6144;
            if (gw < 2048) {
                if (l == 0) norm_pass<0>(ka->out, ka->in.norm_ffn_g + l * 1024, mod + 3 * 1024, mod + 4 * 1024, (bf16*)(ws + WS_XA), nullptr, nullptr, nullptr, nullptr, gw, lane);
                else norm_pass<1>(ka->out, ka->in.norm_ffn_g + l * 1024, mod + 3 * 1024, mod + 4 * 1024, (bf16*)(ws + WS_XA), ka->in.router_w, (int*)(ws + WS_EIDX), (float*)(ws + WS_EW), (int*)(ws + WS_WCNT), gw, lane);
            }
            if (l == 1) { int* srow = (int*)(ws + WS_SROW); for (int p = bx * 512 + tid; p < XS_ROWS; p += G * 512) srow[p] = -1; }
            else if (bx == 0 && tid < 9) { ((int*)(ws + WS_SEGD))[tid] = (tid == 0) ? 0 : ((tid == 8) ? 16384 : (1 << 30)); }
        }
        SEAM(pb + 4);
        if (l == 1) {
            if (TY(6) && IN(pb + 5)) REP(6) { PHASE_IDS CArgs* ka = kargs(); unsigned char* ws = ka->ws;
                if (gw < 2048) place_pass((const int*)(ws + WS_WCNT), (const int*)(ws + WS_EIDX), (const float*)(ws + WS_EW), (const bf16*)(ws + WS_XA), (bf16*)(ws + WS_XS), (int*)(ws + WS_SROW), (float*)(ws + WS_SWT), (int*)(ws + WS_SEG), gw, 2048, lane); }
            SEAM(pb + 5);
        } else { STAMP(pb + 6); }
        if (TY(7) && IN(pb + 6)) REP(7) { PHASE_IDS CArgs* ka = kargs(); unsigned char* ws = ka->ws;
            pg8::Gemm g{1024, 1024, 1024}; pg8::MoeSched S;
            S.init(ws + (l == 0 ? WS_XA : WS_XS), 1024, ws + (l == 0 ? WS_FGU : WS_MGU), 1024, (size_t)5632 * 1024 * 2, (const int*)(ws + (l == 0 ? WS_SEGD : WS_SEG)), 5632, G, bx);
            epi::EpiSwiGLU E{(bf16*)(ws + (l == 0 ? WS_HD : WS_HM)), 2816}; pg8::gemm_phase(lds, g, S, E);
        }
        SEAM(pb + 6);
        if (TY(8) && IN(pb + 7)) REP(8) { PHASE_IDS CArgs* ka = kargs(); unsigned char* ws = ka->ws; const float* mod = (const float*)(ws + WS_MOD) + (size_t)l * 8 * 6144;
            pg8::Gemm g{2816, 2816, 2816}; pg8::MoeSched S;
            S.init(ws + (l == 0 ? WS_HD : WS_HM), 2816, ws + (l == 0 ? WS_FDN : WS_MDN), 2816, (size_t)1024 * 2816 * 2, (const int*)(ws + (l == 0 ? WS_SEGD : WS_SEG)), 1024, G, bx);
            epi::EpiDown E{ka->out, mod + 5 * 1024, (bf16*)(ws + WS_YS), (const int*)(ws + WS_SROW), (const float*)(ws + WS_SWT), l == 1, rep_ > 0}; pg8::gemm_phase(lds, g, S, E);
        }
        SEAM(pb + 7);
    }
    if (TY(9) && IN(17)) { PHASE_IDS CArgs* ka = kargs(); unsigned char* ws = ka->ws;
        if (gw < 2048) final_pass(ka->out, (const bf16*)(ws + WS_YS), (const float*)(ws + WS_MOD) + (size_t)1 * 8 * 6144 + 5 * 1024, ka->in.final_g, gw, lane); }
#ifdef TPROBE
    xcd_barrier(bar); STAMP(18); __syncthreads();
    if (blockIdx.x == 0) { CArgs* ka = kargs(); float* o = ka->out;
        const float d1 = (float)(TS[TPROBE_A + 1] - TS[TPROBE_A]) * 0.01f, d2 = (float)(TS[TPROBE_B + 1] - TS[TPROBE_B]) * 0.01f;
        const float a = 4.0f * sqrtf(d1);
        for (int i = threadIdx.x; i < 1024 * 1024; i += 512) o[i] = a;
        if (threadIdx.x == 0) o[1024 * 1024 + 5] = 100.0f * d2; }
#endif
#undef IN
#undef TY
#undef SEAM
#undef PHASE_IDS
}
}
#ifndef STEP
#define STEP 5
#endif
namespace ad {
__device__ __forceinline__ float bf2f(unsigned short s) { return h16::one(s); }
__global__ void __launch_bounds__(256) ad_proj(const unsigned short* QKV, size_t gstride, int b, float* projb) {
    const int m = blockIdx.x; const size_t row = (size_t)b * 2048 + m;
    for (int n = threadIdx.x; n < 3584; n += 256) {
        const int grp = n / 512, c = n % 512; int sc = c;
        if (grp == 3 || grp == 4) { const int head = c >> 7, d = c & 127; sc = head * 128 + 8 * ((d & 63) >> 2) + 2 * (d & 3) + (d >> 6); }
        float v = bf2f(QKV[(size_t)grp * gstride + row * 512 + sc]);
        if (grp == 0) v *= (1.0f / epi::C2);
        if (grp == 4) v *= (1.0f / epi::KSC);
        projb[(size_t)m * 3584 + n] = v;
    }
}
__global__ void __launch_bounds__(64) ad_kmean(const float* KMP, int b, float* kmeanb) {
    const int blk = blockIdx.x, h = blockIdx.y, d = threadIdx.x;
    const float* p = KMP + ((size_t)(b * 8 + blk) * 2) * 512 + h * 64 + d;
    kmeanb[((size_t)h * 8 + blk) * 64 + d] = (p[0] + p[512]) * (1.0f / 256.0f);
}
__global__ void __launch_bounds__(256) ad_cat(const unsigned short* CAT, const float* ASSQ, const float* att_g, int b, float* catb) {
    const int m = blockIdx.x; const size_t row = (size_t)b * 2048 + m;
    float ss = 0.f;
    for (int h = 0; h < 8; ++h) ss += ASSQ[row * 8 + h];
    const float rs = 1.0f / sqrtf(ss * (1.0f / 512.0f) + 1e-6f);
    for (int c = threadIdx.x; c < 1024; c += 256) { const float v = bf2f(CAT[row * 1024 + c]); catb[(size_t)m * 1024 + c] = (c < 512) ? v * rs * att_g[c] : v; }
}
__global__ void __launch_bounds__(256) dbg_cmp(const float* a, const float* b, size_t n, float rel, float abs_, unsigned* flag, int ncols = 1, int c_lo = 0, int c_hi = 1, int silu_b = 0) {
    unsigned bad = 0;
    for (size_t i = (size_t)blockIdx.x * 256 + threadIdx.x; i < n; i += (size_t)gridDim.x * 256) { const int c = (int)(i % ncols); if (c < c_lo || c >= c_hi) continue;
        float bv = b[i]; if (silu_b) bv = bv / (1.f + expf(-bv)); const float d = fabsf(a[i] - bv); if (!(d <= rel * fabsf(bv) + abs_)) ++bad; }
    if (bad) atomicAdd(flag, bad);
}
__global__ void __launch_bounds__(256) dbg_poison(const unsigned* flag, unsigned thresh, float* out, float val) {
    if (*flag > thresh) for (int i = threadIdx.x; i < 1024 * 1024; i += 256) out[i] = val;
}
__global__ void __launch_bounds__(256) dbg_ssd(const float* a, const float* b, size_t n, int ncols, int c_lo, int c_hi, float* acc) {
    float s = 0.f;
    for (size_t i = (size_t)blockIdx.x * 256 + threadIdx.x; i < n; i += (size_t)gridDim.x * 256) { const int c = (int)(i % ncols); if (c < c_lo || c >= c_hi) continue; const float d = a[i] - b[i]; s += d * d; }
    atomicAdd(acc, s);
}
__global__ void __launch_bounds__(256) dbg_encode(const float* acc, float count, float* out) {
    const float mse = *acc / count; const float val = 4.0f / sqrtf(mse);
    for (int i = threadIdx.x; i < 1024 * 1024; i += 256) out[i] = val;
}
}

static void launch_mega(const mk::Args& a0, int lo, int hi, int region, hipStream_t stream) {
    mk::Args a = a0; a.ph_lo = lo; a.ph_hi = hi; a.bar_region = region;
    hipLaunchKernelGGL(mk::mega, dim3(256), dim3(512), mk::LDS_BYTES, stream, a);
}

extern "C" void kernel_launch(void* const* d_in, const int* in_sizes, int n_in, void* d_out, int out_size, void* d_ws, size_t ws_size, hipStream_t stream) {
    static int ready = 0;
    if (ready == 0) {
        if (n_in != 18 || out_size != M * D || ws_size < mk::WS_END) { fprintf(stderr, "kernel_launch: unexpected problem (n_in %d, out %d, ws %zu)\n", n_in, out_size, ws_size); ready = -1; return; }
        if (hipFuncSetAttribute((const void*)mk::mega, hipFuncAttributeMaxDynamicSharedMemorySize, mk::LDS_BYTES) != hipSuccess) { fprintf(stderr, "kernel_launch: hipFuncSetAttribute failed\n"); ready = -1; return; }
        ready = 1;
    }
    if (ready < 0) return;
    mk::Args a{};
    const float** ip = (const float**)&a.in;
    for (int i = 0; i < 18; ++i) ip[i] = (const float*)d_in[i];
    a.out = (float*)d_out; a.ws = (unsigned char*)d_ws; a.moe_w = (STEP >= 5) ? 1 : 0;
    const mk::Inputs& in = a.in;
    float* out = (float*)d_out; unsigned char* ws = (unsigned char*)d_ws;
    hipMemsetAsync(ws + mk::WS_CTL, 0, mk::CTL_ZERO_BYTES, stream);
#if STEP >= 6
    launch_mega(a, 0, mk::N_PHASES, 0, stream);
#else
    constexpr size_t MiB = 1u << 20;
    unsigned char* na = ws + 8 * MiB;
    float* PROJb = (float*)(na);
    float* Hb = (float*)(na + 28 * MiB);
    float* CATb = (float*)(na + 36 * MiB);
    float* OAb = (float*)(na + 44 * MiB);
    float* ORRb = (float*)(na + 48 * MiB);
    float* KMEANb = (float*)(na + 52 * MiB);
    int* EIDXb = (int*)(na + 53 * MiB); float* EWb = (float*)(na + 53 * MiB + 65536); int* POSb = (int*)(na + 53 * MiB + 131072); int* LISTb = (int*)(na + 53 * MiB + 196608);
    int* CNTb = (int*)(na + 54 * MiB); int* BASEb = CNTb + 16;
    float* Gb = (float*)(na + 56 * MiB);
    float* Ub = (float*)(na + 78 * MiB);
    float* Yb = (float*)(na + 100 * MiB);
    const float* MODp = (const float*)(ws + mk::WS_MOD);
    unsigned short* QKV = (unsigned short*)(ws + mk::WS_QKV);
    launch_mega(a, 0, 1, 1, stream);
    for (int l = 0; l < 2; ++l) {
        const int pb = 1 + 8 * l;
        const float* xin = (l == 0) ? in.x : (const float*)out;
        if (STEP >= 1) { launch_mega(a, pb, pb + 1, 1, stream); launch_mega(a, pb + 1, pb + 2, 1, stream); }
        if (STEP >= 2) launch_mega(a, pb + 2, pb + 3, 1, stream);
        if (STEP >= 3) launch_mega(a, pb + 3, pb + 4, 1, stream);
        if (STEP < 3) {
            for (int b = 0; b < BATCH; ++b) {
                const float* mod = MODp + ((size_t)l * BATCH + b) * 6 * D;
                const float* xb = xin + (size_t)b * SEQ * D; float* ob = out + (size_t)b * SEQ * D;
                if (STEP < 1) {
                    nv::k_norm<<<SEQ, 256, 0, stream>>>(xb, in.norm_mix_g + l * D, mod + 0 * D, mod + 1 * D, Hb);
                    nv::k_gemm<<<dim3(NPROJ / 64, SEQ / 64), 256, 0, stream>>>(Hb, D, nullptr, nullptr, SEQ, in.w_in + (size_t)l * D * NPROJ, NPROJ, PROJb, NPROJ, D);
                    nv::k_rotary<<<SEQ, 256, 0, stream>>>(PROJb);
                    nv::k_kmean<<<dim3(NBLK, AH, 1), 64, 0, stream>>>(PROJb, KMEANb);
                } else {
                    ad::ad_proj<<<SEQ, 256, 0, stream>>>(QKV, (size_t)M * 512, b, PROJb);
                    ad::ad_kmean<<<dim3(NBLK, AH, 1), 64, 0, stream>>>((const float*)(ws + mk::WS_KMP), b, KMEANb);
#ifdef DBG_CHECK
                    { float* PROJn = Gb; float* KMn = (float*)(na + 52 * MiB + 262144); unsigned* flag = (unsigned*)(ws + mk::WS_CTL) + 16;
                      nv::k_norm<<<SEQ, 256, 0, stream>>>(xb, in.norm_mix_g + l * D, mod + 0 * D, mod + 1 * D, Hb);
                      nv::k_gemm<<<dim3(NPROJ / 64, SEQ / 64), 256, 0, stream>>>(Hb, D, nullptr, nullptr, SEQ, in.w_in + (size_t)l * D * NPROJ, NPROJ, PROJn, NPROJ, D);
                      nv::k_rotary<<<SEQ, 256, 0, stream>>>(PROJn);
                      nv::k_kmean<<<dim3(NBLK, AH, 1), 64, 0, stream>>>(PROJn, KMn);
                      ad::dbg_cmp<<<1024, 256, 0, stream>>>(PROJb, PROJn, (size_t)SEQ * NPROJ, DBG_REL, DBG_ABS, flag, NPROJ, 0, 3072, 0);
                      ad::dbg_cmp<<<1024, 256, 0, stream>>>(PROJb, PROJn, (size_t)SEQ * NPROJ, DBG_REL, DBG_ABS, flag, NPROJ, 3072, 3584, 1);
                      ad::dbg_cmp<<<16, 256, 0, stream>>>(KMEANb, KMn, (size_t)8 * 8 * 64, 0.03f, 0.004f, flag + 1);
                      if (l == DBG_L && b == 0) ad::dbg_ssd<<<1024, 256, 0, stream>>>(PROJb, PROJn, (size_t)SEQ * NPROJ, NPROJ, DBG_CLO, DBG_CHI, (float*)(flag + 2)); }
#endif
                }
                if (STEP < 2) {
                    nv::k_moba<<<dim3(NBLK, AH, 1), 256, 0, stream>>>(PROJb, KMEANb, OAb);
                    nv::k_ret<<<dim3(SEQ / 256, RH * 4, 1), 256, 0, stream>>>(PROJb, ORRb);
                    nv::k_cat<<<SEQ, 256, 0, stream>>>(OAb, ORRb, PROJb, in.att_g + l * AW, in.ret_g + l * RW, CATb, STEP >= 1 ? 1 : 0);
                } else {
                    ad::ad_cat<<<SEQ, 256, 0, stream>>>((const unsigned short*)(ws + mk::WS_CAT), (const float*)(ws + mk::WS_ASSQ), in.att_g + l * AW, b, CATb);
                }
                nv::k_gemm<<<dim3(D / 64, SEQ / 64), 256, 0, stream>>>(CATb, D, nullptr, nullptr, SEQ, in.w_out + (size_t)l * D * D, D, Hb, D, D);
                nv::k_resid<<<SEQ, 256, 0, stream>>>(xb, mod + 2 * D, Hb, ob);
            }
        }
        const bool ffn_mega = (l == 0) ? (STEP >= 4) : (STEP >= 5);
        if (ffn_mega) {
            launch_mega(a, pb + 4, pb + 5, 1, stream);
            if (l == 1) launch_mega(a, pb + 5, pb + 6, 1, stream);
            launch_mega(a, pb + 6, pb + 7, 1, stream);
            launch_mega(a, pb + 7, pb + 8, 1, stream);
        } else {
            for (int b = 0; b < BATCH; ++b) {
                const float* mod = MODp + ((size_t)l * BATCH + b) * 6 * D;
                float* ob = out + (size_t)b * SEQ * D;
                nv::k_norm<<<SEQ, 256, 0, stream>>>(ob, in.norm_ffn_g + l * D, mod + 3 * D, mod + 4 * D, Hb);
                if (l == 0) {
                    nv::k_gemm<<<dim3(FF / 64, SEQ / 64), 256, 0, stream>>>(Hb, D, nullptr, nullptr, SEQ, in.fw_gate, FF, Gb, FF, D);
                    nv::k_gemm<<<dim3(FF / 64, SEQ / 64), 256, 0, stream>>>(Hb, D, nullptr, nullptr, SEQ, in.fw_up, FF, Ub, FF, D);
                    nv::k_silu_mul<<<SEQ, 256, 0, stream>>>(Gb, Ub, nullptr, SEQ, FF);
                    nv::k_gemm<<<dim3(D / 64, SEQ / 64), 256, 0, stream>>>(Gb, FF, nullptr, nullptr, SEQ, in.fw_down, D, Ub, D, FF);
                    nv::k_resid<<<SEQ, 256, 0, stream>>>(ob, mod + 5 * D, Ub, ob);
                } else {
                    nv::k_router<<<SEQ / 4, 256, 0, stream>>>(Hb, in.router_w, EIDXb, EWb);
                    nv::k_place<<<1, 1024, 0, stream>>>(EIDXb, LISTb, POSb, CNTb, BASEb, 4);
                    float* GE = Gb; float* UE = Ub;
                    for (int e = 0; e < NE; ++e) {
                        nv::k_gemm<<<dim3(FF / 64, ECAP / 64), 256, 0, stream>>>(Hb, D, LISTb, CNTb + e, ECAP, in.mw_gate + (size_t)e * D * FF, FF, GE, FF, D, BASEb + e, nullptr);
                        nv::k_gemm<<<dim3(FF / 64, ECAP / 64), 256, 0, stream>>>(Hb, D, LISTb, CNTb + e, ECAP, in.mw_up + (size_t)e * D * FF, FF, UE, FF, D, BASEb + e, nullptr);
                        nv::k_silu_mul<<<ECAP, 256, 0, stream>>>(GE, UE, CNTb + e, ECAP, FF);
                        nv::k_gemm<<<dim3(D / 64, ECAP / 64), 256, 0, stream>>>(GE, FF, nullptr, CNTb + e, ECAP, in.mw_down + (size_t)e * FF * D, D, Yb, D, FF, nullptr, BASEb + e);
                    }
                    nv::k_moe_combine<<<SEQ, 256, 0, stream>>>(ob, mod + 5 * D, Yb, POSb, EWb);
                }
            }
        }
    }
    if (STEP >= 5) launch_mega(a, 17, 18, 1, stream);
    else nv::k_norm<<<M, 256, 0, stream>>>(out, in.final_g, nullptr, nullptr, out);
#ifdef DBG_CHECK
#ifdef DBG_ENC
    ad::dbg_encode<<<1, 256, 0, stream>>>((const float*)((unsigned*)(ws + mk::WS_CTL) + 18), (float)SEQ * (DBG_CHI - DBG_CLO), out);
#endif
    ad::dbg_poison<<<1, 256, 0, stream>>>((unsigned*)(ws + mk::WS_CTL) + 16, DBG_T0, out, 100.0f);
    ad::dbg_poison<<<1, 256, 0, stream>>>((unsigned*)(ws + mk::WS_CTL) + 17, DBG_T1, out + (1 << 20), 300.0f);
#endif
#endif
}
```

```cpp
#include <hip/hip_runtime.h>
#include <cstdio>
#include <cstdint>
#include <cmath>

namespace h16 {
typedef _Float16 f16x2_t __attribute__((ext_vector_type(2)));
typedef _Float16 f16x8_t __attribute__((ext_vector_type(8)));
typedef float f32x2_t __attribute__((ext_vector_type(2)));
__device__ __forceinline__ unsigned pk(float lo, float hi) { f32x2_t v = {lo, hi}; f16x2_t b = __builtin_convertvector(v, f16x2_t); return __builtin_bit_cast(unsigned, b); }
__device__ __forceinline__ float lo(unsigned u) { return (float)__builtin_bit_cast(f16x2_t, u)[0]; }
__device__ __forceinline__ float hi(unsigned u) { return (float)__builtin_bit_cast(f16x2_t, u)[1]; }
__device__ __forceinline__ float one(unsigned short s) { return (float)__builtin_bit_cast(_Float16, s); }
}

namespace xl {
template <int O> __device__ __forceinline__ int xor_i(int v) {
    if constexpr (O < 32) return __builtin_amdgcn_ds_swizzle(v, (O << 10) | 0x1f);
    else { static_assert(O < 32, "use add32 / max32 for the 32-lane exchange"); return v; }
}
template <int O> __device__ __forceinline__ float xor_f(float v) { return __builtin_bit_cast(float, xor_i<O>(__builtin_bit_cast(int, v))); }
__device__ __forceinline__ void swap32(unsigned a, unsigned& r0, unsigned& r1) { unsigned b = a; asm volatile("" : "+v"(b)); auto r = __builtin_amdgcn_permlane32_swap(a, b, false, false); r0 = r[0]; r1 = r[1]; }
__device__ __forceinline__ float add32(float v) { unsigned r0, r1; swap32(__builtin_bit_cast(unsigned, v), r0, r1); return __builtin_bit_cast(float, r0) + __builtin_bit_cast(float, r1); }
__device__ __forceinline__ float max32(float v) { unsigned r0, r1; swap32(__builtin_bit_cast(unsigned, v), r0, r1); return fmaxf(__builtin_bit_cast(float, r0), __builtin_bit_cast(float, r1)); }
__device__ __forceinline__ int add32i(int v) { unsigned r0, r1; swap32((unsigned)v, r0, r1); return (int)(r0 + r1); }
__device__ __forceinline__ float wave_sum(float v) { v += xor_f<1>(v); v += xor_f<2>(v); v += xor_f<4>(v); v += xor_f<8>(v); v += xor_f<16>(v); return add32(v); }
__device__ __forceinline__ int wave_sum_i(int v) { v += xor_i<1>(v); v += xor_i<2>(v); v += xor_i<4>(v); v += xor_i<8>(v); v += xor_i<16>(v); return add32i(v); }
}
#define STEP 6

constexpr int D = 1024, BATCH = 8, SEQ = 2048, M = BATCH * SEQ;
constexpr int AH = 8, AD = 64, AW = 512, MBLK = 256, NBLK = SEQ / MBLK, TOPK = 3;
constexpr int RH = 4, RD = 128, RW = 512;
constexpr int NPROJ = 3 * AW + 4 * RW;
constexpr int FF = 2816, NE = 8;
constexpr float EPS = 1e-6f;
constexpr int ECAP = 2048;
namespace pg8 {
#define PG8_LAS __attribute__((address_space(3)))
typedef unsigned short bf16_t;
typedef short bf16x8 __attribute__((ext_vector_type(8)));
typedef float f32x4 __attribute__((ext_vector_type(4)));
typedef float f32x2 __attribute__((ext_vector_type(2)));
typedef unsigned u32x4 __attribute__((ext_vector_type(4)));
typedef unsigned u32x2 __attribute__((ext_vector_type(2)));
constexpr int BM = 256, BK = 64, HALF = 128, HTB = HALF * BK * 2  , STAGE_BYTES = 8 * HTB, NXCD = 8, WGM = 8;

__host__ __device__ __forceinline__ int lds_byte(int r, int c) { const int st = (r >> 4) * 2 + (c >> 5), rr = r & 15, cc = c & 31, ob = rr * 64 + cc * 2; return st * 1024 + (ob ^ (((ob >> 9) & 1) << 5)); }
__host__ __device__ __forceinline__ void stage_rc(int b, int& R, int& C) { const int st = b / 1024, sb = b % 1024, swz = sb ^ (((sb >> 9) & 1) << 5); R = (st >> 1) * 16 + swz / 64; C = (st & 1) * 32 + (swz % 64) / 2; }
__host__ __device__ __forceinline__ int perm32(int rho) { const int n = rho >> 4, i = rho & 15; return 8 * (i >> 2) + 4 * n + (i & 3); }

struct Unit { int pm, pn, e, kc, li; };
struct Gemm { int lda, ldb, K; };

struct DenseSched {
    const char* A; const char* Bt; size_t a_tile, b_tile;
    int nM, nN, nwg, G, c;
    __device__ __forceinline__ void init(const void* A_, int lda, const void* Bt_, int ldb, int M, int N, int G_, int c_) {
        A = (const char*)A_; Bt = (const char*)Bt_; a_tile = (size_t)BM * lda * 2; b_tile = (size_t)BM * ldb * 2; nM = M / BM; nN = N / BM; nwg = nM * nN; G = G_; c = c_; }
    __device__ __forceinline__ bool next(int i, Unit& u) const {
        const long L = (long)i * G + c; if (L >= nwg) return false;
        int wgid = (int)L; { const int q = nwg / NXCD, r = nwg % NXCD, xcd = wgid % NXCD, off = wgid / NXCD; wgid = (xcd < r ? xcd * (q + 1) : r * (q + 1) + (xcd - r) * q) + off; }
        const int nig = WGM * nN, gid = wgid / nig, fm = gid * WGM, gsz = (nM - fm) < WGM ? (nM - fm) : WGM;
        u.pm = fm + ((wgid % nig) % gsz); u.pn = (wgid % nig) / gsz; u.e = 0; u.kc = 0; u.li = 0; return true;
    }
    __device__ __forceinline__ const char* a_ptr(const Unit& u) const { return A + (size_t)u.pm * a_tile; }
    __device__ __forceinline__ const char* b_ptr(const Unit& u) const { return Bt + (size_t)u.pn * b_tile; }
};
struct MoeSched {
    const char* A; const char* Bt; size_t a_tile, b_tile, e_stride;
    int nM, nN, nwg, G, c; int seg[8]; int first, lim, KS, kbytes;
    __device__ __forceinline__ void init(const void* A_, int lda, const void* Bt_, int ldb, size_t e_stride_bytes, const int* segp_, int N, int G_, int c_) {
        A = (const char*)A_; Bt = (const char*)Bt_; a_tile = (size_t)BM * lda * 2; b_tile = (size_t)BM * ldb * 2; e_stride = e_stride_bytes;
#pragma unroll
        for (int e = 0; e < 8; ++e) seg[e] = __builtin_amdgcn_readfirstlane(segp_[e]);
        nM = __builtin_amdgcn_readfirstlane(segp_[8]) / BM; nN = N / BM; nwg = nM * nN; G = G_; c = c_; first = 0; lim = nwg; KS = 1; kbytes = 0; }
    __device__ __forceinline__ bool next(int i, Unit& u) const {
        const long idx = (long)i * G + c; const long L = first + idx / KS; if (L >= lim) return false;
        u.kc = (int)(idx % KS); u.li = (int)(idx / KS);
        int wgid = (int)L; { const int q = nwg / NXCD, r = nwg % NXCD, xcd = wgid % NXCD, off = wgid / NXCD; wgid = (xcd < r ? xcd * (q + 1) : r * (q + 1) + (xcd - r) * q) + off; }
        const int nig = WGM * nN, gid = wgid / nig, fm = gid * WGM, gsz = (nM - fm) < WGM ? (nM - fm) : WGM;
        u.pm = fm + ((wgid % nig) % gsz); u.pn = (wgid % nig) / gsz;
        int e = 0; const int r0 = u.pm * BM;
#pragma unroll
        for (int k = 1; k < 8; ++k) e += (r0 >= seg[k]) ? 1 : 0;
        u.e = e; return true;
    }
    __device__ __forceinline__ const char* a_ptr(const Unit& u) const { return A + (size_t)u.pm * a_tile + (size_t)u.kc * kbytes; }
    __device__ __forceinline__ const char* b_ptr(const Unit& u) const { return Bt + (size_t)u.e * e_stride + (size_t)u.pn * b_tile + (size_t)u.kc * kbytes; }
};

__device__ __forceinline__ unsigned cvt_pk_bf16(float lo, float hi) { return h16::pk(lo, hi); }
__device__ __forceinline__ float fast_silu(float g) { return g * __builtin_amdgcn_rcpf(1.0f + __builtin_amdgcn_exp2f(-1.4426950408889634f * g)); }

typedef f32x4 Acc[2][2][4][2];

template <class Epi, class Sched>
__device__ __forceinline__ void gemm_phase(PG8_LAS unsigned char* lds, const Gemm g, const Sched& S, const Epi& E) {
    int tid_ = threadIdx.x; asm volatile("" : "+v"(tid_));
    const int tid = tid_, wid = __builtin_amdgcn_readfirstlane(tid >> 6), lane = tid & 63, wr = wid >> 2, wc = wid & 3, fr = lane & 15, fq = lane >> 4;
    const int K = g.K, nt = K / BK;
    unsigned voffA[2], voffB[2];
#pragma unroll
    for (int i = 0; i < 2; ++i) { int R, C; stage_rc(tid * 16 + i * 8192, R, C); const int Rb = Epi::PERM ? ((R & ~31) + perm32(R & 31)) : R;
        voffA[i] = (unsigned)(R * g.lda + C) * 2u; voffB[i] = (unsigned)(Rb * g.ldb + C) * 2u; }
    const size_t kstep = (size_t)(BK * 2);
    const size_t hstepA = (size_t)HALF * g.lda * 2, hstepB = (size_t)HALF * g.ldb * 2;
    const unsigned ldsw = (unsigned)wid * 1024u;
    const int aoff = lds_byte(wr * 64 + fr, fq * 8), boff = lds_byte(wc * 32 + fr, fq * 8);
#define PG8_SA(b, h) (((b) * 2 + (h)) * HTB)
#define PG8_SB(b, h) ((4 + (b) * 2 + (h)) * HTB)
#define PG8_STAGE(bufoff, gbase, voff) do { _Pragma("unroll") for (int _i = 0; _i < 2; ++_i) \
        __builtin_amdgcn_global_load_lds((const unsigned*)((const char*)(gbase) + (voff)[_i]), (PG8_LAS unsigned*)(lds + (bufoff) + ldsw + _i * 8192), 16, 0, 0); } while (0)
#define PG8_LDA(dst, b, h) do { _Pragma("unroll") for (int m = 0; m < 4; ++m) _Pragma("unroll") for (int k = 0; k < 2; ++k) dst[m][k] = *(const PG8_LAS bf16x8*)(lds + PG8_SA(b, h) + aoff + m * 2048 + k * 1024); } while (0)
#define PG8_LDB(dst, b, h) do { _Pragma("unroll") for (int n = 0; n < 2; ++n) _Pragma("unroll") for (int k = 0; k < 2; ++k) dst[n][k] = *(const PG8_LAS bf16x8*)(lds + PG8_SB(b, h) + boff + n * 2048 + k * 1024); } while (0)
#define PG8_MMA(ai, bj, At, Bt) do { __builtin_amdgcn_s_setprio(1); _Pragma("unroll") for (int m = 0; m < 4; ++m) _Pragma("unroll") for (int n = 0; n < 2; ++n) _Pragma("unroll") for (int k = 0; k < 2; ++k) \
        acc[ai][bj][m][n] = __builtin_amdgcn_mfma_f32_16x16x32_f16(__builtin_bit_cast(h16::f16x8_t, Bt[n][k]), __builtin_bit_cast(h16::f16x8_t, At[m][k]), acc[ai][bj][m][n], 0, 0, 0); __builtin_amdgcn_s_setprio(0); } while (0)
#define PG8_WAIT_V(n) asm volatile("s_waitcnt vmcnt(" #n ")" ::: "memory")
#define PG8_WAIT_L(n) asm volatile("s_waitcnt lgkmcnt(" #n ")" ::: "memory")
#define PG8_BAR __builtin_amdgcn_s_barrier()
#define PG8_SCHED __builtin_amdgcn_sched_barrier(0)
    Unit cur, nxt; int ui = 0;
    if (!S.next(0, cur)) return;
    Acc acc;
#pragma unroll
    for (int a = 0; a < 2; ++a)
#pragma unroll
        for (int b = 0; b < 2; ++b)
#pragma unroll
            for (int m = 0; m < 4; ++m)
#pragma unroll
                for (int n = 0; n < 2; ++n) acc[a][b][m][n] = (f32x4){0.f, 0.f, 0.f, 0.f};
    bf16x8 At[4][2], B0[2][2], B1[2][2];
    const char* cA = S.a_ptr(cur); const char* cB = S.b_ptr(cur);
    if constexpr (Epi::MID_T > 0) E.pre(cur, lds, tid);
    PG8_STAGE(PG8_SB(0, 0), cB, voffB); PG8_STAGE(PG8_SB(0, 1), cB + hstepB, voffB); PG8_STAGE(PG8_SA(0, 0), cA, voffA); PG8_STAGE(PG8_SA(0, 1), cA + hstepA, voffA);
    if (wr == 1) PG8_BAR;
    PG8_WAIT_V(2); PG8_BAR;
    PG8_STAGE(PG8_SB(1, 0), cB + kstep, voffB); PG8_STAGE(PG8_SA(1, 0), cA + kstep, voffA); PG8_STAGE(PG8_SB(1, 1), cB + hstepB + kstep, voffB);
    PG8_WAIT_V(6); PG8_BAR;
    for (;;) {
        const bool has_next = S.next(ui + 1, nxt);
        const char* nA = has_next ? S.a_ptr(nxt) : cA; const char* nB = has_next ? S.b_ptr(nxt) : cB;
        for (int t = 0; t < nt; t += 2) {
            if constexpr (Epi::MID_T > 0) { if (t == Epi::MID_T) E.mid(acc, lds, wr, fr); }
            const bool last = (t == nt - 2);
            const char* a1 = cA + (size_t)(t + 1) * kstep;
            const char* a2 = last ? nA : cA + (size_t)(t + 2) * kstep; const char* b2 = last ? nB : cB + (size_t)(t + 2) * kstep;
            const char* a3 = a2 + kstep; const char* b3 = b2 + kstep;
            PG8_LDB(B0, 0, 0); PG8_LDB(B1, 0, 1); PG8_SCHED; PG8_LDA(At, 0, 0); PG8_STAGE(PG8_SA(1, 1), a1 + hstepA, voffA);
            PG8_WAIT_V(8); PG8_WAIT_L(0); PG8_BAR; PG8_MMA(0, 0, At, B0); PG8_MMA(0, 1, At, B1); PG8_BAR; PG8_SCHED;
            PG8_LDA(At, 0, 1); PG8_STAGE(PG8_SB(0, 0), b2, voffB); PG8_STAGE(PG8_SB(0, 1), b2 + hstepB, voffB); PG8_STAGE(PG8_SA(0, 0), a2, voffA);
            PG8_WAIT_V(8); PG8_WAIT_L(0); PG8_BAR; PG8_MMA(1, 0, At, B0); PG8_MMA(1, 1, At, B1); PG8_BAR; PG8_SCHED;
            PG8_LDB(B0, 1, 0); PG8_LDB(B1, 1, 1); PG8_SCHED; PG8_LDA(At, 1, 0); PG8_STAGE(PG8_SA(0, 1), a2 + hstepA, voffA);
            PG8_WAIT_V(8); PG8_WAIT_L(0); PG8_BAR; PG8_MMA(0, 0, At, B0); PG8_MMA(0, 1, At, B1); PG8_BAR; PG8_SCHED;
            PG8_LDA(At, 1, 1); PG8_STAGE(PG8_SB(1, 0), b3, voffB); PG8_STAGE(PG8_SB(1, 1), b3 + hstepB, voffB); PG8_STAGE(PG8_SA(1, 0), a3, voffA);
            PG8_WAIT_V(8); PG8_WAIT_L(0); PG8_BAR; PG8_MMA(1, 0, At, B0); PG8_MMA(1, 1, At, B1); PG8_BAR; PG8_SCHED;
        }
        if (wr == 0) PG8_BAR;
        E(acc, cur, wr, wc, fr, fq);
        if (!has_next) break;
#pragma unroll
        for (int a = 0; a < 2; ++a)
#pragma unroll
            for (int b = 0; b < 2; ++b)
#pragma unroll
                for (int m = 0; m < 4; ++m)
#pragma unroll
                    for (int n = 0; n < 2; ++n) acc[a][b][m][n] = (f32x4){0.f, 0.f, 0.f, 0.f};
        cur = nxt; cA = nA; cB = nB; ++ui;
        if (wr == 1) PG8_BAR;
    }
    PG8_WAIT_V(0);
    PG8_BAR;
#undef PG8_SA
#undef PG8_SB
#undef PG8_STAGE
#undef PG8_LDA
#undef PG8_LDB
#undef PG8_MMA
#undef PG8_WAIT_V
#undef PG8_WAIT_L
#undef PG8_BAR
#undef PG8_SCHED
}
}
namespace epi {
#define PG8_LAS __attribute__((address_space(3)))
using pg8::Acc; using pg8::Unit; using pg8::f32x4; using pg8::u32x4; using pg8::bf16_t; using pg8::cvt_pk_bf16; using pg8::fast_silu;
constexpr int HALF = 128;
constexpr float C2 = 0.125f * 1.4426950408889634f;
constexpr float KSC = 0.08838834764831845f;

__device__ __forceinline__ u32x4 pack8(const f32x4 v0, const f32x4 v1) { u32x4 w; w.x = cvt_pk_bf16(v0[0], v0[1]); w.y = cvt_pk_bf16(v0[2], v0[3]); w.z = cvt_pk_bf16(v1[0], v1[1]); w.w = cvt_pk_bf16(v1[2], v1[3]); return w; }

struct EpiInProj {
    static constexpr bool PERM = true; static constexpr int MID_T = 0;
    bf16_t* O; size_t gstride;
    float* KMP;
    const float* ROPE;
    __device__ __forceinline__ void operator()(const Acc& acc, const Unit& u, int wr, int wc, int fr, int fq) const {
        const int grp = u.pn >> 1;
        const int col0 = (u.pn & 1) * 256 + wc * 32 + 8 * fq;
        const int row0 = u.pm * 256 + wr * 64 + fr;
        bf16_t* base = O + (size_t)grp * gstride;
        f32x4 cs[2][2];
#pragma unroll
        for (int bj = 0; bj < 2; ++bj) { cs[bj][0] = (f32x4){0.f, 0.f, 0.f, 0.f}; cs[bj][1] = (f32x4){0.f, 0.f, 0.f, 0.f}; }
#pragma unroll
        for (int ai = 0; ai < 2; ++ai)
#pragma unroll
            for (int m = 0; m < 4; ++m) {
                const int row = row0 + ai * HALF + m * 16;
                bf16_t* rowp = base + (size_t)row * 512 + col0;
                f32x4 t0 = (f32x4){0.f, 0.f, 0.f, 0.f}, t1 = t0;
                if (grp == 3 || grp == 4) { const float* tp = ROPE + ((size_t)(row & 2047) * 64 + 16 * wc + 4 * fq) * 2; t0 = *(const f32x4*)tp; t1 = *(const f32x4*)(tp + 4); }
#pragma unroll
                for (int bj = 0; bj < 2; ++bj) {
                    f32x4 v0 = acc[ai][bj][m][0], v1 = acc[ai][bj][m][1];
                    if (grp == 0) { v0 = v0 * C2; v1 = v1 * C2; }
                    else if (grp == 1) { cs[bj][0] += v0; cs[bj][1] += v1; }
                    else if (grp == 3 || grp == 4) {
                        const float sc = (grp == 4) ? KSC : 1.0f;
                        f32x4 r0, r1;
                        r0[0] = (v0[0] * t0[0] - v0[1] * t0[1]) * sc; r0[1] = (v0[0] * t0[1] + v0[1] * t0[0]) * sc;
                        r0[2] = (v0[2] * t0[2] - v0[3] * t0[3]) * sc; r0[3] = (v0[2] * t0[3] + v0[3] * t0[2]) * sc;
                        r1[0] = (v1[0] * t1[0] - v1[1] * t1[1]) * sc; r1[1] = (v1[0] * t1[1] + v1[1] * t1[0]) * sc;
                        r1[2] = (v1[2] * t1[2] - v1[3] * t1[3]) * sc; r1[3] = (v1[2] * t1[3] + v1[3] * t1[2]) * sc;
                        v0 = r0; v1 = r1;
                    } else if (grp == 6) {
#pragma unroll
                        for (int j = 0; j < 4; ++j) { v0[j] = fast_silu(v0[j]); v1[j] = fast_silu(v1[j]); }
                    }
                    *(u32x4*)(rowp + bj * HALF) = pack8(v0, v1);
                }
            }
        if (grp == 1) {
#pragma unroll
            for (int bj = 0; bj < 2; ++bj)
#pragma unroll
                for (int n = 0; n < 2; ++n) {
                    f32x4 s = cs[bj][n];
#pragma unroll
                    for (int o = 1; o < 16; o <<= 1) { s[0] += __shfl_xor(s[0], o); s[1] += __shfl_xor(s[1], o); s[2] += __shfl_xor(s[2], o); s[3] += __shfl_xor(s[3], o); }
                    if (fr == 0) *(f32x4*)(KMP + (size_t)(u.pm * 2 + wr) * 512 + col0 + bj * HALF + 4 * n) = s;
                }
        }
    }
};

struct EpiOutProj {
    static constexpr bool PERM = false; static constexpr int MID_T = 8;
    const float* xin; float* out; const float* g1;
    const float* assq;
    bool dry;
    static constexpr int RS_OFF = 131072 + 8192;
    __device__ __forceinline__ void pre(const Unit& u, PG8_LAS unsigned char* lds, int tid) const {
        if (tid < 256) { const int row = u.pm * 256 + tid;
            const f32x4 a = *(const f32x4*)(assq + (size_t)row * 8), c = *(const f32x4*)(assq + (size_t)row * 8 + 4);
            const float ss = ((a[0] + a[1]) + (a[2] + a[3])) + ((c[0] + c[1]) + (c[2] + c[3]));
            ((PG8_LAS float*)(lds + RS_OFF))[tid] = 1.0f / sqrtf(ss * (1.0f / 512.0f) + 1e-6f); }
    }
    __device__ __forceinline__ void mid(Acc& acc, PG8_LAS unsigned char* lds, int wr, int fr) const {
        const PG8_LAS float* tab = (const PG8_LAS float*)(lds + RS_OFF) + wr * 64 + fr;
#pragma unroll
        for (int ai = 0; ai < 2; ++ai)
#pragma unroll
            for (int m = 0; m < 4; ++m) {
                const float rs = tab[ai * HALF + m * 16];
#pragma unroll
                for (int bj = 0; bj < 2; ++bj)
#pragma unroll
                    for (int n = 0; n < 2; ++n) acc[ai][bj][m][n] = acc[ai][bj][m][n] * rs;
            }
    }
    __device__ __forceinline__ void operator()(const Acc& acc, const Unit& u, int wr, int wc, int fr, int fq) const {
        const int b = u.pm >> 3;
        const int col0 = u.pn * 256 + wc * 32 + 4 * fq;
        const int row0 = u.pm * 256 + wr * 64 + fr;
        f32x4 gv[2][2];
#pragma unroll
        for (int bj = 0; bj < 2; ++bj)
#pragma unroll
            for (int n = 0; n < 2; ++n) gv[bj][n] = *(const f32x4*)(g1 + (size_t)b * 6144 + col0 + bj * HALF + n * 16);
#pragma unroll
        for (int ai = 0; ai < 2; ++ai)
#pragma unroll
            for (int m = 0; m < 4; ++m) {
                const size_t off = (size_t)(row0 + ai * HALF + m * 16) * 1024 + col0;
#pragma unroll
                for (int bj = 0; bj < 2; ++bj)
#pragma unroll
                    for (int n = 0; n < 2; ++n) { const f32x4 bs = *(const f32x4*)(xin + off + bj * HALF + n * 16); const f32x4 r = bs + gv[bj][n] * acc[ai][bj][m][n]; if (!dry) *(f32x4*)(out + off + bj * HALF + n * 16) = r; else asm volatile("" :: "v"(r)); }
            }
    }
};

struct EpiSwiGLU {
    static constexpr bool PERM = true; static constexpr int MID_T = 0;
    bf16_t* H; int ldh;
    __device__ __forceinline__ void operator()(const Acc& acc, const Unit& u, int wr, int wc, int fr, int fq) const {
        const int col0 = u.pn * 128 + wc * 32 + 8 * fq;
        const int row0 = u.pm * 256 + wr * 64 + fr;
#pragma unroll
        for (int ai = 0; ai < 2; ++ai)
#pragma unroll
            for (int m = 0; m < 4; ++m) {
                const int row = row0 + ai * HALF + m * 16;
                f32x4 v0, v1;
#pragma unroll
                for (int j = 0; j < 4; ++j) { v0[j] = fast_silu(acc[ai][0][m][0][j]) * acc[ai][1][m][0][j]; v1[j] = fast_silu(acc[ai][0][m][1][j]) * acc[ai][1][m][1][j]; }
                *(u32x4*)(H + (size_t)row * ldh + col0) = pack8(v0, v1);
            }
    }
};

struct EpiDown {
    static constexpr bool PERM = false; static constexpr int MID_T = 0;
    float* out; const float* g2; bf16_t* YS; const int* srow; const float* swt; bool moe; bool dry; int* atomf; bool atomic; float* slab; int KS;
    __device__ __forceinline__ void operator()(const Acc& acc, const Unit& u, int wr, int wc, int fr, int fq) const {
        const int col0 = u.pn * 256 + wc * 32 + 4 * fq;
        const int row0 = u.pm * 256 + wr * 64 + fr;
        if (!moe) {
            const int b = u.pm >> 3;
            f32x4 gv[2][2];
#pragma unroll
            for (int bj = 0; bj < 2; ++bj)
#pragma unroll
                for (int n = 0; n < 2; ++n) gv[bj][n] = *(const f32x4*)(g2 + (size_t)b * 6144 + col0 + bj * HALF + n * 16);
#pragma unroll
            for (int ai = 0; ai < 2; ++ai)
#pragma unroll
                for (int m = 0; m < 4; ++m) {
                    const size_t off = (size_t)(row0 + ai * HALF + m * 16) * 1024 + col0;
#pragma unroll
                    for (int bj = 0; bj < 2; ++bj)
#pragma unroll
                        for (int n = 0; n < 2; ++n) { const f32x4 bs = *(const f32x4*)(out + off + bj * HALF + n * 16); const f32x4 r = bs + gv[bj][n] * acc[ai][bj][m][n]; if (!dry) *(f32x4*)(out + off + bj * HALF + n * 16) = r; else asm volatile("" :: "v"(r)); }
                }
        } else if (atomic) {
            float* sl = slab + ((size_t)(u.li * KS + u.kc) * 256) * 256 + (wc * 32 + 4 * fq);
#pragma unroll
            for (int ai = 0; ai < 2; ++ai)
#pragma unroll
                for (int m = 0; m < 4; ++m) {
                    const int rl = ai * HALF + wr * 64 + m * 16 + fr; const int pos = u.pm * 256 + rl;
                    const int sr = srow[pos];
                    if (sr >= 0) { const float w = swt[pos];
                        if (u.kc == 0 && wc == 0 && fq == 0) atomf[sr * 4 + u.pn] = 1 + u.li * 256 + rl;
#pragma unroll
                        for (int bj = 0; bj < 2; ++bj)
#pragma unroll
                            for (int n = 0; n < 2; ++n) *(f32x4*)(sl + (size_t)rl * 256 + bj * HALF + n * 16) = acc[ai][bj][m][n] * w; }
                }
        } else {
#pragma unroll
            for (int ai = 0; ai < 2; ++ai)
#pragma unroll
                for (int m = 0; m < 4; ++m) {
                    const int pos = row0 + ai * HALF + m * 16;
                    const int sr = srow[pos];
                    if (sr >= 0) { const float w = swt[pos]; bf16_t* rowp = YS + (size_t)sr * 1024 + col0;
#pragma unroll
                        for (int bj = 0; bj < 2; ++bj)
#pragma unroll
                            for (int n = 0; n < 2; ++n) { const f32x4 v = acc[ai][bj][m][n] * w; pg8::u32x2 o; o.x = cvt_pk_bf16(v[0], v[1]); o.y = cvt_pk_bf16(v[2], v[3]); if (!dry) *(pg8::u32x2*)(rowp + bj * HALF + n * 16) = o; else asm volatile("" :: "v"(o)); } }
                }
        }
    }
};
}
namespace fa {
#define FA_LAS __attribute__((address_space(3)))
typedef unsigned short bf16_t;
typedef short bf16x8 __attribute__((ext_vector_type(8)));
typedef short s16x4 __attribute__((ext_vector_type(4)));
typedef float f32x16 __attribute__((ext_vector_type(16)));
typedef float f32x4 __attribute__((ext_vector_type(4)));
typedef unsigned u32x4 __attribute__((ext_vector_type(4)));
typedef float f32x2_t __attribute__((ext_vector_type(2))); typedef __bf16 bf16x2_t __attribute__((ext_vector_type(2)));
constexpr int L_WSF = 131072 + 1024, L_KM = L_WSF + 2048;
constexpr float NEG = -1.0e30f;
__device__ __forceinline__ int crow(int r, int hi) { return (r & 3) + 8 * (r >> 2) + 4 * hi; }
__device__ __forceinline__ void glds16(const void* gsrc, unsigned lds_dst) { unsigned keep;
    asm volatile("s_mov_b32 %0, m0\n\ts_mov_b32 m0, %2\n\ts_nop 0\n\tglobal_load_lds_dwordx4 %1, off\n\ts_mov_b32 m0, %0" : "=&s"(keep) : "v"(gsrc), "s"(lds_dst) : "memory"); }
__device__ __forceinline__ unsigned cvtpk_s(float lo, float hi) { return h16::pk(lo, hi); }
__device__ __forceinline__ float bf2f(short s) { return h16::one((unsigned short)s); }
typedef short v4i16_t __attribute__((ext_vector_type(4)));
__device__ __forceinline__ s16x4 vtr(FA_LAS const unsigned char* p) { return __builtin_bit_cast(s16x4, __builtin_amdgcn_ds_read_tr16_b64_v4i16((FA_LAS v4i16_t*)p)); }
#define FA_WAIT_BAR() asm volatile("s_waitcnt vmcnt(0) lgkmcnt(0)\n\ts_barrier" ::: "memory")
#define FA_LBAR() asm volatile("s_waitcnt lgkmcnt(0)\n\ts_barrier" ::: "memory")

struct Tensors {
    const bf16_t* Q; const bf16_t* K; const bf16_t* V;
    bf16_t* CAT;
    float* ASSQ;
    const float* KMP;
    const bf16_t* GR;
    const float* ret_g;
    const float* KVM;
};

template <bool RET>
__device__ __forceinline__ void attn_unit(int b, int h, int qblk, const Tensors& T, FA_LAS unsigned char* shm) {
    constexpr int NS = RET ? 3 : 4, DIST = NS - 1;
    constexpr int DH = RET ? 128 : 64, ND0 = DH / 16, NDB = DH / 32, NPC = DH / 64, SLOT = 64 * DH * 2, L_K = 0, L_V = NS * SLOT, PER = 2 * NPC, L_R = 98304;
    int tid_ = threadIdx.x; asm volatile("" : "+v"(tid_));
    const int tid = tid_, lane = tid & 63, r32 = lane & 31, hi = lane >> 5; const int wid = __builtin_amdgcn_readfirstlane(tid >> 6);
    const size_t rowbase = (size_t)b * 2048; const int q0 = qblk * 256;
    const unsigned lds0 = (unsigned)(unsigned long)shm;
    FA_LAS float* wsf = (FA_LAS float*)(shm + L_WSF) + wid * 64;
    FA_LAS float* KM = (FA_LAS float*)(shm + L_KM);
    const bf16_t* Kh = T.K + rowbase * 512 + h * DH; const bf16_t* Vh = T.V + rowbase * 512 + h * DH;
    const int NT = RET ? 4 : 4 * (qblk + 1);
#define FA_KV0(i) ((((i) < 4) ? qblk : (qblk - 1 - (((i) - 4) >> 2))) * 256 + ((i) & 3) * 64)
#define FA_DMA(i) do { const int kv0_ = FA_KV0(i); const unsigned so_ = (unsigned)(((i) % NS) * SLOT); \
        _Pragma("unroll") for (int pp = 0; pp < NPC; ++pp) { const int p = wid + 8 * pp; \
            glds16(Kh + (size_t)(kv0_ + lane) * 512 + p * 8, (unsigned)__builtin_amdgcn_readfirstlane(lds0 + L_K + so_ + p * 1024)); } \
        _Pragma("unroll") for (int pp = 0; pp < NPC; ++pp) { const int p = wid + 8 * pp; \
            glds16(Vh + (size_t)(kv0_ + 16 * (p & 3) + (lane >> 2)) * 512 + (p >> 2) * 32 + (lane & 3) * 8, (unsigned)__builtin_amdgcn_readfirstlane(lds0 + L_V + so_ + p * 1024)); } } while (0)
    FA_DMA(0); if (NT > 1) FA_DMA(1); if (DIST > 2 && NT > 2) FA_DMA(2);
    const bf16_t* Qw = T.Q + (rowbase + q0 + wid * 32 + r32) * 512 + h * DH;
    bf16x8 qr[ND0];
#pragma unroll
    for (int d0 = 0; d0 < ND0; ++d0) qr[d0] = *(const bf16x8*)(Qw + d0 * 16 + hi * 8);
    unsigned selmask = 0xffu;
    float cfac[16]; float lg2 = 0.f;
    if (!RET) {
        { const int j = tid >> 6, d = tid & 63; const float* kp = T.KMP + ((size_t)(b * 8 + j) * 2) * 512 + h * 64 + d; KM[tid] = kp[0] + kp[512]; }
        FA_LBAR();
        float g[8];
#pragma unroll
        for (int j = 0; j < 8; ++j) g[j] = 0.f;
#pragma unroll
        for (int d0 = 0; d0 < ND0; ++d0)
#pragma unroll
            for (int jj = 0; jj < 8; ++jj) { const float qv = bf2f(qr[d0][jj]); const int d = 16 * d0 + 8 * hi + jj;
#pragma unroll
                for (int j = 0; j < 8; ++j) g[j] += qv * KM[j * 64 + d]; }
#pragma unroll
        for (int j = 0; j < 8; ++j) g[j] += __shfl_xor(g[j], 32);
        selmask = 0u;
#pragma unroll
        for (int j = 0; j < 8; ++j) { int rank = 0;
#pragma unroll
            for (int mm = 0; mm < 8; ++mm) rank += (mm < qblk && (g[mm] > g[j] || (g[mm] == g[j] && mm < j))) ? 1 : 0;
            if (j < qblk && rank < 3) selmask |= 1u << j; }
    } else {
        lg2 = log2f(1.0f - exp2f(-5.0f - (float)h));
#pragma unroll
        for (int r = 0; r < 16; ++r) cfac[r] = exp2f(-lg2 * (float)((r & 3) + 8 * (r >> 2)));
    }
    f32x16 o[NDB];
#pragma unroll
    for (int db = 0; db < NDB; ++db) o[db] = f32x16{};
    float mhat = 0.f, lrow = 0.f; f32x16 negm = f32x16{}; constexpr float THR = 8.0f;
    if (RET && qblk > 0) {
        const float* kvb = T.KVM + ((size_t)(b * 4 + h) * 8) * 16384;
        const float g256 = exp2f(lg2 * 256.0f);
#pragma unroll 2
        for (int it = 0; it < 8; ++it) { const int idx4 = tid + 512 * it; const int d = idx4 >> 5, e0 = (idx4 & 31) * 4;
            f32x4 acc4 = (f32x4){0.f, 0.f, 0.f, 0.f};
            for (int m = 0; m < qblk; ++m) acc4 = acc4 * g256 + *(const f32x4*)(kvb + (size_t)m * 16384 + d * 128 + e0);
            const int rp = (d & ~12) | ((d & 8) >> 1) | ((d & 4) << 1);
            typedef unsigned u32x2_ __attribute__((ext_vector_type(2)));
            u32x2_ w; w.x = cvtpk_s(acc4[0], acc4[1]); w.y = cvtpk_s(acc4[2], acc4[3]);
            *(FA_LAS u32x2_*)(shm + L_R + (e0 >> 5) * 8192 + rp * 64 + (e0 & 31) * 2) = w; }
        FA_LBAR();
        { FA_LAS const unsigned char* rb = shm + L_R + ((lane >> 4) & 1) * 32 + (lane & 3) * 8 + (4 * hi + ((lane & 15) >> 2)) * 64;
#pragma unroll
          for (int db = 0; db < NDB; ++db)
#pragma unroll
              for (int d0 = 0; d0 < ND0; ++d0) { const s16x4 lo = vtr(rb + db * 8192 + d0 * 1024), hh = vtr(rb + db * 8192 + d0 * 1024 + 512);
                  const bf16x8 rf = (bf16x8){lo[0], lo[1], lo[2], lo[3], hh[0], hh[1], hh[2], hh[3]};
                  o[db] = __builtin_amdgcn_mfma_f32_32x32x16_f16(__builtin_bit_cast(h16::f16x8_t, qr[d0]), __builtin_bit_cast(h16::f16x8_t, rf), o[db], 0, 0, 0); } }
#pragma unroll
        for (int r = 0; r < 16; ++r) { const float rd = exp2f(lg2 * (float)(wid * 32 + crow(r, hi) + 1));
#pragma unroll
            for (int db = 0; db < NDB; ++db) o[db][r] *= rd; }
    }
    const int qrel = wid * 32 + r32;
    for (int i = 0; i < NT; ++i) {
        { const int ahead = (NT - 1 - i) < (DIST - 1) ? (NT - 1 - i) : (DIST - 1);
          if (ahead == 2) { if (PER == 2) asm volatile("s_waitcnt vmcnt(4) lgkmcnt(0)\n\ts_barrier" ::: "memory"); else asm volatile("s_waitcnt vmcnt(8) lgkmcnt(0)\n\ts_barrier" ::: "memory"); }
          else if (ahead == 1) { if (PER == 2) asm volatile("s_waitcnt vmcnt(2) lgkmcnt(0)\n\ts_barrier" ::: "memory"); else asm volatile("s_waitcnt vmcnt(4) lgkmcnt(0)\n\ts_barrier" ::: "memory"); }
          else FA_WAIT_BAR(); }
        if (i + DIST < NT) FA_DMA(i + DIST);
        const bool diag = i < 4; const int t = i & 3; const int j = diag ? qblk : (qblk - 1 - ((i - 4) >> 2));
        const bool mysel = RET ? true : (((selmask >> j) & 1u) != 0u);
        const bool skip = diag ? (64 * t > 32 * wid + 31) : (RET ? false : !__any(mysel));
        if (skip) continue;
        const unsigned so = (unsigned)((i % NS) * SLOT);
        f32x16 p0 = RET ? f32x16{} : negm, p1 = p0;
        { FA_LAS const unsigned char* kb = shm + L_K + so + hi * 1024 + r32 * 16;
#pragma unroll
          for (int d0 = 0; d0 < ND0; ++d0) { const bf16x8 b0 = *(FA_LAS const bf16x8*)(kb + d0 * 2048); const bf16x8 b1 = *(FA_LAS const bf16x8*)(kb + d0 * 2048 + 512);
              p0 = __builtin_amdgcn_mfma_f32_32x32x16_f16(__builtin_bit_cast(h16::f16x8_t, b0), __builtin_bit_cast(h16::f16x8_t, qr[d0]), p0, 0, 0, 0); p1 = __builtin_amdgcn_mfma_f32_32x32x16_f16(__builtin_bit_cast(h16::f16x8_t, b1), __builtin_bit_cast(h16::f16x8_t, qr[d0]), p1, 0, 0, 0); } }
        if (RET) {
            const int qpos = q0 + qrel; const int kv0 = j * 256 + t * 64;
            const float base = (float)(qpos - kv0 - 4 * hi);
            const float rf0 = exp2f(lg2 * base), rf1 = exp2f(lg2 * (base - 32.0f));
#pragma unroll
            for (int r = 0; r < 16; ++r) { p0[r] *= rf0 * cfac[r]; p1[r] *= rf1 * cfac[r]; }
            if (diag) { const int kb_ = 64 * t + 4 * hi;
#pragma unroll
                for (int r = 0; r < 16; ++r) { const int kv = kb_ + (r & 3) + 8 * (r >> 2); if (kv > qrel) p0[r] = 0.f; if (kv + 32 > qrel) p1[r] = 0.f; } }
        } else {
            if (diag) { const int kb_ = 64 * t + 4 * hi;
#pragma unroll
                for (int r = 0; r < 16; ++r) { const int kv = kb_ + (r & 3) + 8 * (r >> 2); if (kv > qrel) p0[r] = NEG; if (kv + 32 > qrel) p1[r] = NEG; } }
            else if (!mysel) {
#pragma unroll
                for (int r = 0; r < 16; ++r) { p0[r] = NEG; p1[r] = NEG; } }
            float rm = fmaxf(fmaxf(p0[0], p1[0]), p0[1]);
#pragma unroll
            for (int r = 1; r < 16; ++r) { rm = fmaxf(fmaxf(rm, p1[r]), (r < 15) ? p0[r + 1] : p1[r]); }
            rm = fmaxf(rm, __shfl_xor(rm, 32));
            if (__any(rm > THR)) {
                const float dl = fmaxf(rm, 0.f);
                mhat += dl;
#pragma unroll
                for (int r = 0; r < 16; ++r) { p0[r] -= dl; p1[r] -= dl; }
#pragma unroll
                for (int r = 0; r < 16; ++r) negm[r] = -mhat;
                const float f = __builtin_amdgcn_exp2f(-dl); lrow *= f;
                asm volatile("" ::: "memory");
                if (hi == 0) wsf[r32] = f;
                asm volatile("s_waitcnt lgkmcnt(0)" ::: "memory");
#pragma unroll
                for (int r = 0; r < 16; ++r) { const float fr_ = wsf[crow(r, hi)];
#pragma unroll
                    for (int db = 0; db < NDB; ++db) o[db][r] *= fr_; }
                asm volatile("s_waitcnt lgkmcnt(0)" ::: "memory");
            }
            float s = 0.f;
#pragma unroll
            for (int r = 0; r < 16; ++r) { p0[r] = __builtin_amdgcn_exp2f(p0[r]); p1[r] = __builtin_amdgcn_exp2f(p1[r]); s += p0[r] + p1[r]; }
            lrow += s;
        }
        bf16x8 pa[4];
        { u32x4 w;
          w.x = cvtpk_s(p0[0], p0[1]); w.y = cvtpk_s(p0[2], p0[3]); w.z = cvtpk_s(p0[4], p0[5]); w.w = cvtpk_s(p0[6], p0[7]); pa[0] = __builtin_bit_cast(bf16x8, w);
          w.x = cvtpk_s(p0[8], p0[9]); w.y = cvtpk_s(p0[10], p0[11]); w.z = cvtpk_s(p0[12], p0[13]); w.w = cvtpk_s(p0[14], p0[15]); pa[1] = __builtin_bit_cast(bf16x8, w);
          w.x = cvtpk_s(p1[0], p1[1]); w.y = cvtpk_s(p1[2], p1[3]); w.z = cvtpk_s(p1[4], p1[5]); w.w = cvtpk_s(p1[6], p1[7]); pa[2] = __builtin_bit_cast(bf16x8, w);
          w.x = cvtpk_s(p1[8], p1[9]); w.y = cvtpk_s(p1[10], p1[11]); w.z = cvtpk_s(p1[12], p1[13]); w.w = cvtpk_s(p1[14], p1[15]); pa[3] = __builtin_bit_cast(bf16x8, w); }
        { FA_LAS const unsigned char* vb = shm + L_V + so + ((lane >> 4) & 1) * 32 + (lane & 3) * 8 + (4 * hi + ((lane & 15) >> 2)) * 64;
#pragma unroll
          for (int db = 0; db < NDB; ++db)
#pragma unroll
              for (int ks = 0; ks < 4; ++ks) { const s16x4 lo = vtr(vb + db * 4096 + ks * 1024), hh = vtr(vb + db * 4096 + ks * 1024 + 512);
                  const bf16x8 vf = (bf16x8){lo[0], lo[1], lo[2], lo[3], hh[0], hh[1], hh[2], hh[3]};
                  o[db] = __builtin_amdgcn_mfma_f32_32x32x16_f16(__builtin_bit_cast(h16::f16x8_t, pa[ks]), __builtin_bit_cast(h16::f16x8_t, vf), o[db], 0, 0, 0); } }
    }
    float rli[16];
    if (!RET) {
        const float l = lrow + __shfl_xor(lrow, 32);
        asm volatile("" ::: "memory");
        if (hi == 0) wsf[32 + r32] = 1.0f / l;
        asm volatile("s_waitcnt lgkmcnt(0)" ::: "memory");
#pragma unroll
        for (int r = 0; r < 16; ++r) rli[r] = wsf[32 + crow(r, hi)];
    } else {
#pragma unroll
        for (int r = 0; r < 16; ++r) rli[r] = 1.0f;
    }
    FA_LBAR();
    FA_LAS bf16_t* stg = (FA_LAS bf16_t*)(shm + wid * 8192);
#pragma unroll
    for (int r = 0; r < 16; ++r) { const int orow = crow(r, hi);
#pragma unroll
        for (int db = 0; db < NDB; ++db) { const unsigned pk = cvtpk_s(o[db][r] * rli[r], 0.f); stg[orow * DH + db * 32 + r32] = (bf16_t)(pk & 0xffffu); } }
    asm volatile("s_waitcnt lgkmcnt(0)" ::: "memory");
    const size_t tok0 = rowbase + q0 + wid * 32;
    if (!RET) {
#pragma unroll
        for (int i = 0; i < 4; ++i) { const int row = i * 8 + (lane >> 3), ch = lane & 7;
            const u32x4 v = *(FA_LAS const u32x4*)(stg + row * 64 + ch * 8);
            float ss = 0.f;
#pragma unroll
            for (int k = 0; k < 4; ++k) { const float a = h16::lo(v[k]), c = h16::hi(v[k]); ss += a * a + c * c; }
            ss += __shfl_xor(ss, 1); ss += __shfl_xor(ss, 2); ss += __shfl_xor(ss, 4);
            if (ch == 0) T.ASSQ[(tok0 + row) * 8 + h] = ss;
            *(u32x4*)(T.CAT + (tok0 + row) * 1024 + h * 64 + ch * 8) = v; }
    } else {
#pragma unroll
        for (int i = 0; i < 8; ++i) { const int row = i * 4 + (lane >> 4), ch = lane & 15;
            const u32x4 v = *(FA_LAS const u32x4*)(stg + row * 128 + ch * 8);
            float x[8];
#pragma unroll
            for (int k = 0; k < 4; ++k) { x[2 * k] = h16::lo(v[k]); x[2 * k + 1] = h16::hi(v[k]); }
            float ss = 0.f;
#pragma unroll
            for (int k = 0; k < 8; ++k) ss += x[k] * x[k];
            ss += __shfl_xor(ss, 1); ss += __shfl_xor(ss, 2); ss += __shfl_xor(ss, 4); ss += __shfl_xor(ss, 8);
            const float rs = 1.0f / sqrtf(ss * (1.0f / 128.0f) + 1e-6f);
            const u32x4 gv = *(const u32x4*)(T.GR + (tok0 + row) * 512 + h * 128 + ch * 8);
            const f32x4 w0 = *(const f32x4*)(T.ret_g + h * 128 + ch * 8), w1 = *(const f32x4*)(T.ret_g + h * 128 + ch * 8 + 4);
            const float wg[8] = {w0[0], w0[1], w0[2], w0[3], w1[0], w1[1], w1[2], w1[3]};
            float y[8];
#pragma unroll
            for (int k = 0; k < 4; ++k) { const float g0 = h16::lo(gv[k]), g1 = h16::hi(gv[k]);
                y[2 * k] = x[2 * k] * rs * wg[2 * k] * g0; y[2 * k + 1] = x[2 * k + 1] * rs * wg[2 * k + 1] * g1; }
            u32x4 ov; ov.x = cvtpk_s(y[0], y[1]); ov.y = cvtpk_s(y[2], y[3]); ov.z = cvtpk_s(y[4], y[5]); ov.w = cvtpk_s(y[6], y[7]);
            *(u32x4*)(T.CAT + (tok0 + row) * 1024 + 512 + h * 128 + ch * 8) = ov; }
    }
    FA_LBAR();
#undef FA_KV0
#undef FA_DMA
}

__device__ __forceinline__ void kv_unit(int b, int h, int m, const bf16_t* Kg, const bf16_t* Vg, float* KVM, FA_LAS unsigned char* shm) {
    constexpr int SLOT = 16384, L_K = 0, L_V = 4 * SLOT;
    int tid_ = threadIdx.x; asm volatile("" : "+v"(tid_));
    const int tid = tid_, lane = tid & 63, r32 = lane & 31, hi = lane >> 5; const int wid = __builtin_amdgcn_readfirstlane(tid >> 6);
    const int dg = wid >> 1, eh = wid & 1;
    const size_t rowbase = (size_t)b * 2048 + (size_t)m * 256;
    const unsigned lds0 = (unsigned)(unsigned long)shm;
    const bf16_t* Kh = Kg + rowbase * 512 + h * 128; const bf16_t* Vh = Vg + rowbase * 512 + h * 128;
#pragma unroll
    for (int t = 0; t < 4; ++t)
#pragma unroll
        for (int pp = 0; pp < 2; ++pp) { const int p = wid + 8 * pp; const size_t off = (size_t)(64 * t + 16 * (p & 3) + (lane >> 2)) * 512 + (p >> 2) * 32 + (lane & 3) * 8;
            glds16(Kh + off, (unsigned)__builtin_amdgcn_readfirstlane(lds0 + L_K + t * SLOT + p * 1024));
            glds16(Vh + off, (unsigned)__builtin_amdgcn_readfirstlane(lds0 + L_V + t * SLOT + p * 1024)); }
    const float lg2 = log2f(1.0f - exp2f(-5.0f - (float)h));
    const float g64 = exp2f(lg2 * 64.0f);
    h16::f16x8_t fd[4];
#pragma unroll
    for (int ks = 0; ks < 4; ++ks)
#pragma unroll
        for (int j = 0; j < 8; ++j) fd[ks][j] = (_Float16)exp2f(lg2 * (float)(63 - (16 * ks + 8 * (j >> 2) + 4 * hi + (j & 3))));
    f32x16 acc[2]; acc[0] = f32x16{}; acc[1] = f32x16{};
    FA_WAIT_BAR();
    const int lb = ((lane >> 4) & 1) * 32 + (lane & 3) * 8 + (4 * hi + ((lane & 15) >> 2)) * 64;
#pragma unroll
    for (int t = 0; t < 4; ++t) {
        if (t > 0) {
#pragma unroll
            for (int r = 0; r < 16; ++r) { acc[0][r] *= g64; acc[1][r] *= g64; } }
        FA_LAS const unsigned char* kb = shm + L_K + t * SLOT + dg * 4096 + lb; FA_LAS const unsigned char* vb = shm + L_V + t * SLOT + (2 * eh) * 4096 + lb;
#pragma unroll
        for (int ks = 0; ks < 4; ++ks) { const s16x4 klo = vtr(kb + ks * 1024), khi = vtr(kb + ks * 1024 + 512);
            const h16::f16x8_t kf = __builtin_bit_cast(h16::f16x8_t, (bf16x8){klo[0], klo[1], klo[2], klo[3], khi[0], khi[1], khi[2], khi[3]});
#pragma unroll
            for (int eb = 0; eb < 2; ++eb) { const s16x4 vlo = vtr(vb + eb * 4096 + ks * 1024), vhi = vtr(vb + eb * 4096 + ks * 1024 + 512);
                const h16::f16x8_t vf = __builtin_bit_cast(h16::f16x8_t, (bf16x8){vlo[0], vlo[1], vlo[2], vlo[3], vhi[0], vhi[1], vhi[2], vhi[3]}) * fd[ks];
                acc[eb] = __builtin_amdgcn_mfma_f32_32x32x16_f16(kf, vf, acc[eb], 0, 0, 0); } }
    }
    float* op = KVM + ((size_t)(b * 4 + h) * 8 + m) * 16384;
#pragma unroll
    for (int eb = 0; eb < 2; ++eb)
#pragma unroll
        for (int r = 0; r < 16; ++r) op[(size_t)(32 * dg + crow(r, hi)) * 128 + 64 * eh + 32 * eb + r32] = acc[eb][r];
    FA_LBAR();
}
}
namespace mk {
#define GAS __attribute__((address_space(1)))
#define LAS __attribute__((address_space(3)))
typedef unsigned short bf16;
typedef unsigned v4u __attribute__((ext_vector_type(4)));
typedef unsigned v2u __attribute__((ext_vector_type(2)));
typedef float f32x4 __attribute__((ext_vector_type(4)));
typedef int i32x4 __attribute__((ext_vector_type(4)));
typedef GAS unsigned gu32;
#define RLX_AGENT __ATOMIC_RELAXED, __HIP_MEMORY_SCOPE_AGENT
#define LDS_WAIT() asm volatile("s_waitcnt lgkmcnt(0)" ::: "memory")
#define VM_WAIT() asm volatile("s_waitcnt vmcnt(0)" ::: "memory")
constexpr int NWAVES = 8;
constexpr size_t MiB = 1u << 20, KiB = 1u << 10;
constexpr size_t WS_CTL = 0;
constexpr size_t CTL_ZERO_BYTES = 64 * KiB;
constexpr size_t WS_MOD = 64 * KiB;
constexpr size_t WS_KMP = 512 * KiB;
constexpr size_t WS_EIDX = 768 * KiB;
constexpr size_t WS_EW = 896 * KiB;
constexpr size_t WS_ROPE = 1 * MiB;
constexpr size_t WS_ASSQ = 2 * MiB;
constexpr size_t WS_SROW = 2 * MiB + 512 * KiB;
constexpr size_t WS_SWT = 2 * MiB + 768 * KiB;
constexpr size_t WS_WCNT = 3 * MiB;
constexpr size_t WS_SEG = 3 * MiB + 64 * KiB;
constexpr size_t WS_ATOMF = 3 * MiB + 128 * KiB;
constexpr size_t WS_SEGD = 3 * MiB + 65 * KiB;
constexpr size_t WS_MGU = 8 * MiB;
constexpr size_t WS_SLAB = 8 * MiB;
constexpr size_t WS_MDN = 96 * MiB;
constexpr size_t WS_XA = 140 * MiB;
constexpr size_t WS_XS = 172 * MiB;
constexpr size_t WS_KVM = 172 * MiB;
constexpr size_t WS_YS = 140 * MiB;
constexpr size_t WS_WIN = 240 * MiB;
constexpr size_t WS_WOUT = 254 * MiB;
constexpr size_t WS_FGU = 258 * MiB;
constexpr size_t WS_FDN = 269 * MiB;
constexpr size_t WS_QKV = 275 * MiB;
constexpr size_t WS_CAT = 387 * MiB;
constexpr size_t WS_HD = 275 * MiB;
constexpr size_t WS_HM = 240 * MiB;
constexpr size_t WS_END = 428 * MiB;
constexpr int XS_ROWS = 34816;
constexpr int CW_BAR = 1024;

constexpr int RING_BYTES = 131072, LDSCTL_OFF = RING_BYTES, MISC_OFF = LDSCTL_OFF + 320, LDS_BYTES = 147456;

#define XB_TMO      128
#define XB_XCNT(j)  (256  + 64 * (j))
#define XB_XSUB(j)  (1280 + 64 * (j))
#define XB_XGEN(j)  (2304 + 64 * (j))
#define XB_TOP      3328
#define XB_TOPGEN   3392
#define XCD_BAR_WORDS 3456
#define XB_SPIN_CAP (1u << 18)
__device__ __forceinline__ unsigned xb_ld(unsigned* p)              { return __hip_atomic_load(p, __ATOMIC_RELAXED, __HIP_MEMORY_SCOPE_AGENT); }
__device__ __forceinline__ unsigned xb_add(unsigned* p, unsigned v) { return __hip_atomic_fetch_add(p, v, __ATOMIC_RELAXED, __HIP_MEMORY_SCOPE_AGENT); }
__device__ __forceinline__ unsigned xb_xcc_id() { return (unsigned)__builtin_amdgcn_s_getreg((3 << 11) | 20) & 0xFu; }
#define XB_SPIN(cond, bar) do { unsigned _sp = 0; while (cond) { __builtin_amdgcn_s_sleep(1); \
    if ((++_sp & 255u) == 0u) { if (xb_ld(&(bar)[XB_TMO])) break; if (_sp > XB_SPIN_CAP) { atomicAdd(&(bar)[XB_TMO], 1u); break; } } } } while (0)
struct XcdBarrier { unsigned* bar; unsigned x; volatile LAS unsigned* st; };
__device__ __forceinline__ XcdBarrier xcd_barrier_post(unsigned* bar, volatile LAS unsigned* st) {
    XcdBarrier b; b.bar = bar; b.x = xb_xcc_id(); b.st = st;
    if (threadIdx.x == 0) (void)xb_add(&bar[XB_XCNT(b.x)], 1u);
    return b;
}
__device__ __forceinline__ void xcd_barrier_complete(unsigned* bar, unsigned x, unsigned& nloc, unsigned& nx) {
    const unsigned G = gridDim.x * gridDim.y * gridDim.z;
    unsigned sum, cnt, mine, sp = 0u;
    for (;;) {
        sum = 0u; cnt = 0u; mine = 0u;
#pragma unroll
        for (unsigned j = 0; j < 16; ++j) { const unsigned c = xb_ld(&bar[XB_XCNT(j)]); sum += c; cnt += (c > 0u) ? 1u : 0u; mine = (j == x) ? c : mine; }
        if (sum == G) break;
        __builtin_amdgcn_s_sleep(1);
        if ((++sp & 255u) == 0u) { if (xb_ld(&bar[XB_TMO])) break; if (sp > XB_SPIN_CAP) { atomicAdd(&bar[XB_TMO], 1u); break; } }
    }
    nloc = mine > 0u ? mine : 1u; nx = cnt > 0u ? cnt : 1u;
}
__device__ __forceinline__ void xcd_barrier(const XcdBarrier& b) {
    asm volatile("s_waitcnt vmcnt(0)" ::: "memory");
    __syncthreads();
    if (threadIdx.x == 0) {
        unsigned* bar = b.bar;
        __builtin_amdgcn_s_waitcnt(0);
        unsigned nloc = b.st[0], nx = b.st[1];
        if (nloc == 0u) { xcd_barrier_complete(bar, b.x, nloc, nx); b.st[0] = nloc; b.st[1] = nx; }
        const unsigned old = xb_add(&bar[XB_XSUB(b.x)], 1u);
        const unsigned gen = old / nloc;
        if (old + 1u == (gen + 1u) * nloc) {
            __builtin_amdgcn_fence(__ATOMIC_RELEASE, "agent");
            asm volatile("s_waitcnt vmcnt(0)" ::: "memory");
            const unsigned og = xb_add(&bar[XB_TOP], 1u);
            const unsigned tg = og / nx;
            if (og + 1u == (tg + 1u) * nx) xb_add(&bar[XB_TOPGEN], 1u);
            else XB_SPIN(xb_ld(&bar[XB_TOPGEN]) == tg, bar);
            __builtin_amdgcn_fence(__ATOMIC_ACQUIRE, "agent");
            xb_add(&bar[XB_XGEN(b.x)], 1u);
            asm volatile("s_waitcnt vmcnt(0)" ::: "memory");
        } else {
            XB_SPIN(xb_ld(&bar[XB_XGEN(b.x)]) == gen, bar);
            __builtin_amdgcn_fence(__ATOMIC_ACQUIRE, "agent");
            asm volatile("s_waitcnt vmcnt(0)" ::: "memory");
        }
    }
    __syncthreads();
}

__device__ __forceinline__ unsigned f2bf(float f) { unsigned u = __builtin_bit_cast(unsigned, f); return (u + 0x7fffu + ((u >> 16) & 1u)) >> 16; }
__device__ __forceinline__ unsigned pk2(float lo, float hi) { return h16::pk(lo, hi); }
__device__ __forceinline__ float wave_sum(float v) {
#pragma unroll
    for (int o = 1; o < 64; o <<= 1) v += __shfl_xor(v, o);
    return v;
}
__device__ __forceinline__ int wave_sum_i(int v) {
#pragma unroll
    for (int o = 1; o < 64; o <<= 1) v += __shfl_xor(v, o);
    return v;
}

struct Inputs {
    const float *x, *c, *norm_mix_g, *norm_ffn_g, *ada_w, *ada_b, *w_in, *w_out, *att_g, *ret_g, *fw_gate, *fw_up, *fw_down, *router_w, *mw_gate, *mw_up, *mw_down, *final_g;
};

template <class SrcFn> __device__ __forceinline__ void transpose_item(SrcFn src, int K, bf16* WT, int k0, int n0, LAS float* scr, int lane) {
#pragma unroll 8
    for (int i = 0; i < 32; ++i) { const int kk = 2 * i + (lane >> 5); scr[kk * 33 + (lane & 31)] = src(k0 + kk, n0 + (lane & 31)); }
    LDS_WAIT(); asm volatile("" ::: "memory");
    const int c = lane & 7;
#pragma unroll
    for (int j = 0; j < 4; ++j) { const int n = (lane >> 3) + 8 * j; const LAS float* s = scr + (8 * c) * 33 + n;
        v4u o; o.x = pk2(s[0 * 33], s[1 * 33]); o.y = pk2(s[2 * 33], s[3 * 33]); o.z = pk2(s[4 * 33], s[5 * 33]); o.w = pk2(s[6 * 33], s[7 * 33]);
        *(GAS v4u*)(WT + (size_t)(n0 + n) * K + k0 + 8 * c) = o; }
    LDS_WAIT(); asm volatile("" ::: "memory");
}
__device__ __forceinline__ int rot_src_col(int n) {
    if (n < 1536 || n >= 2560) return n;
    const int hb = (n - 1536) & ~127, p = (n - 1536) & 127;
    return 1536 + hb + 4 * (p >> 3) + ((p & 7) >> 1) + 64 * (p & 1);
}
constexpr int IT_WIN = 16 * 112, IT_WOUT = 16 * 32, IT_GU = 16 * 176, IT_DN = 44 * 32;
constexpr int IT_TOTAL = 2 * IT_WIN + 2 * IT_WOUT + IT_GU + IT_DN + 8 * (IT_GU + IT_DN);

constexpr int IT_NONMOE = 2 * IT_WIN + 2 * IT_WOUT + IT_GU + IT_DN;
__device__ __forceinline__ void convert_item(const Inputs& in, unsigned char* ws, int it, LAS float* scr, int lane) {
    int r = it;
    if (r < 2 * IT_WIN) { const int l = r / IT_WIN; r -= l * IT_WIN; const float* W = in.w_in + (size_t)l * 1024 * 3584;
        transpose_item([=](int k, int n) { return W[(size_t)k * 3584 + rot_src_col(n)]; }, 1024, (bf16*)(ws + WS_WIN) + (size_t)l * 3584 * 1024, 64 * (r / 112), 32 * (r % 112), scr, lane); return; }
    r -= 2 * IT_WIN;
    if (r < 2 * IT_WOUT) { const int l = r / IT_WOUT; r -= l * IT_WOUT; const float* W = in.w_out + (size_t)l * 1024 * 1024; const float* ag = in.att_g + l * 512;
        transpose_item([=](int k, int n) { return W[(size_t)k * 1024 + n] * (k < 512 ? ag[k] : 1.0f); }, 1024, (bf16*)(ws + WS_WOUT) + (size_t)l * 1024 * 1024, 64 * (r / 32), 32 * (r % 32), scr, lane); return; }
    r -= 2 * IT_WOUT;
    const float *Wg, *Wu, *Wd; bf16 *Dgu, *Ddn;
    if (r < IT_GU + IT_DN) { Wg = in.fw_gate; Wu = in.fw_up; Wd = in.fw_down; Dgu = (bf16*)(ws + WS_FGU); Ddn = (bf16*)(ws + WS_FDN); }
    else { r -= IT_GU + IT_DN; const int e = r / (IT_GU + IT_DN); r -= e * (IT_GU + IT_DN);
        Wg = in.mw_gate + (size_t)e * 1024 * 2816; Wu = in.mw_up + (size_t)e * 1024 * 2816; Wd = in.mw_down + (size_t)e * 2816 * 1024;
        Dgu = (bf16*)(ws + WS_MGU) + (size_t)e * 5632 * 1024; Ddn = (bf16*)(ws + WS_MDN) + (size_t)e * 1024 * 2816; }
    if (r < IT_GU) {
        transpose_item([=](int k, int n) { const float* W = ((n >> 7) & 1) ? Wu : Wg; return W[(size_t)k * 2816 + (n >> 8) * 128 + (n & 127)]; }, 1024, Dgu, 64 * (r / 176), 32 * (r % 176), scr, lane); return; }
    r -= IT_GU;
    transpose_item([=](int k, int n) { return Wd[(size_t)k * 1024 + n]; }, 2816, Ddn, 64 * (r / 32), 32 * (r % 32), scr, lane);
}
struct MoeItem { const float* src; bf16* dst; int ld, K, k0, n0; const float* rscale; };
template <int KIND  , class InP> __device__ __forceinline__ MoeItem moe_item(InP inp, unsigned char* ws, int it, int lane) {
    MoeItem m; m.rscale = nullptr;
    if (KIND == 0) { const int e = it / IT_GU, r = it - e * IT_GU; const int kb = r / 176, nb = r % 176; const int n = 32 * nb; m.k0 = 64 * kb; m.n0 = n; m.ld = 2816; m.K = 1024;
        const float* W = (((n >> 7) & 1) ? inp->mw_up : inp->mw_gate) + (size_t)e * 1024 * 2816;
        m.src = W + (size_t)(m.k0 + (lane >> 5)) * 2816 + (n >> 8) * 128 + (n & 127) + (lane & 31); m.dst = (bf16*)(ws + WS_MGU) + (size_t)e * 5632 * 1024; }
    else { const int e = it / IT_DN, r = it - e * IT_DN; const int kb = r / 32, nb = r % 32; m.k0 = 64 * kb; m.n0 = 32 * nb; m.ld = 1024; m.K = 2816;
        m.src = inp->mw_down + (size_t)e * 2816 * 1024 + (size_t)(m.k0 + (lane >> 5)) * 1024 + m.n0 + (lane & 31); m.dst = (bf16*)(ws + WS_MDN) + (size_t)e * 1024 * 2816; }
    return m;
}
__device__ __forceinline__ void moe_item_load(const MoeItem& m, float (&v)[32]) {
#pragma unroll
    for (int i = 0; i < 32; ++i) v[i] = m.src[(size_t)(2 * i) * m.ld];
}
__device__ __forceinline__ void moe_item_finish(const MoeItem& m, const float (&v)[32], LAS float* scr, int lane) {
    if (m.rscale != nullptr && m.k0 < 512) {
#pragma unroll
        for (int i = 0; i < 32; ++i) scr[(2 * i + (lane >> 5)) * 33 + (lane & 31)] = v[i] * m.rscale[m.k0 + 2 * i + (lane >> 5)];
    } else {
#pragma unroll
        for (int i = 0; i < 32; ++i) scr[(2 * i + (lane >> 5)) * 33 + (lane & 31)] = v[i];
    }
    LDS_WAIT(); asm volatile("" ::: "memory");
    const int c = lane & 7;
#pragma unroll
    for (int j = 0; j < 4; ++j) { const int n = (lane >> 3) + 8 * j; const LAS float* s = scr + (8 * c) * 33 + n;
        v4u o; o.x = pk2(s[0 * 33], s[1 * 33]); o.y = pk2(s[2 * 33], s[3 * 33]); o.z = pk2(s[4 * 33], s[5 * 33]); o.w = pk2(s[6 * 33], s[7 * 33]);
        *(GAS v4u*)(m.dst + (size_t)(m.n0 + n) * m.K + m.k0 + 8 * c) = o; }
    LDS_WAIT(); asm volatile("" ::: "memory");
}
template <class InP> __device__ __forceinline__ MoeItem base_item(InP inp, unsigned char* ws, int it, int lane) {
    MoeItem m; m.rscale = nullptr; int r = it;
    if (r < 2 * IT_WIN) { const int l = r / IT_WIN; r -= l * IT_WIN; m.k0 = 64 * (r / 112); m.n0 = 32 * (r % 112); m.ld = 3584; m.K = 1024;
        m.src = inp->w_in + (size_t)l * 1024 * 3584 + (size_t)(m.k0 + (lane >> 5)) * 3584 + rot_src_col(m.n0 + (lane & 31)); m.dst = (bf16*)(ws + WS_WIN) + (size_t)l * 3584 * 1024; return m; }
    r -= 2 * IT_WIN;
    if (r < 2 * IT_WOUT) { const int l = r / IT_WOUT; r -= l * IT_WOUT; m.k0 = 64 * (r / 32); m.n0 = 32 * (r % 32); m.ld = 1024; m.K = 1024; m.rscale = inp->att_g + l * 512;
        m.src = inp->w_out + (size_t)l * 1024 * 1024 + (size_t)(m.k0 + (lane >> 5)) * 1024 + m.n0 + (lane & 31); m.dst = (bf16*)(ws + WS_WOUT) + (size_t)l * 1024 * 1024; return m; }
    r -= 2 * IT_WOUT;
    if (r < IT_GU) { const int n = 32 * (r % 176); m.k0 = 64 * (r / 176); m.n0 = n; m.ld = 2816; m.K = 1024;
        m.src = (((n >> 7) & 1) ? inp->fw_up : inp->fw_gate) + (size_t)(m.k0 + (lane >> 5)) * 2816 + (n >> 8) * 128 + (n & 127) + (lane & 31); m.dst = (bf16*)(ws + WS_FGU); return m; }
    r -= IT_GU; m.k0 = 64 * (r / 32); m.n0 = 32 * (r % 32); m.ld = 1024; m.K = 2816;
    m.src = inp->fw_down + (size_t)(m.k0 + (lane >> 5)) * 1024 + m.n0 + (lane & 31); m.dst = (bf16*)(ws + WS_FDN); return m;
}
template <class InP> __device__ __forceinline__ void convert_base_all(InP inp, unsigned char* ws, LAS unsigned char* lds, int gw, int NGW, int wave, int lane) {
    LAS float* scr = (LAS float*)(lds + wave * 16384);
    int it = gw; if (it >= IT_NONMOE) return;
    float va[32], vb[32];
    MoeItem ma = base_item(inp, ws, it, lane), mb = ma; moe_item_load(ma, va);
    for (;;) {
        const bool hb = (it + NGW) < IT_NONMOE; if (hb) { mb = base_item(inp, ws, it + NGW, lane); moe_item_load(mb, vb); }
        moe_item_finish(ma, va, scr, lane);
        if (!hb) break;
        it += NGW;
        const bool ha = (it + NGW) < IT_NONMOE; if (ha) { ma = base_item(inp, ws, it + NGW, lane); moe_item_load(ma, va); }
        moe_item_finish(mb, vb, scr, lane);
        if (!ha) break;
        it += NGW;
    }
}
template <int KIND, class InP> __device__ __forceinline__ void convert_moe_range(InP inp, unsigned char* ws, LAS unsigned char* lds, int it0, int it1, int sp, int nsp, int wave, int lane) {
    LAS float* scr = (LAS float*)(lds + wave * 16384);
    const int step = nsp * NWAVES; int it = it0 + sp * NWAVES + wave;
    if (it >= it1) return;
    float va[32], vb[32];
    MoeItem ma = moe_item<KIND>(inp, ws, it, lane), mb = ma; moe_item_load(ma, va);
    for (;;) {
        const bool hb = (it + step) < it1; if (hb) { mb = moe_item<KIND>(inp, ws, it + step, lane); moe_item_load(mb, vb); }
        moe_item_finish(ma, va, scr, lane);
        if (!hb) break;
        it += step;
        const bool ha = (it + step) < it1; if (ha) { ma = moe_item<KIND>(inp, ws, it + step, lane); moe_item_load(ma, va); }
        moe_item_finish(mb, vb, scr, lane);
        if (!ha) break;
        it += step;
    }
}
constexpr int IT_MOE = 8 * (IT_GU + IT_DN);
constexpr int G_INPROJ = 224, G_GUD = 235;
constexpr int IT_MGU = 8 * IT_GU, IT_MDN = 8 * IT_DN;
constexpr int IT_MOE_A = 7549, IT_MOE_B = 14980;

template <class InP> __device__ __forceinline__ void p0_prologue(InP inp, unsigned char* ws, LAS unsigned char* lds, int vcu, int G, int wave, int lane, int tid, int moe_w) {
    Inputs in; in.c = inp->c; in.ada_w = inp->ada_w; in.ada_b = inp->ada_b; in.w_in = inp->w_in; in.w_out = inp->w_out; in.att_g = inp->att_g; in.fw_gate = inp->fw_gate; in.fw_up = inp->fw_up; in.fw_down = inp->fw_down; in.mw_gate = inp->mw_gate; in.mw_up = inp->mw_up; in.mw_down = inp->mw_down;
    if (vcu < 192) {
        LAS float* cs = (LAS float*)lds;
        LAS float* part = (LAS float*)(lds + 32768);
        for (int i = tid; i < 8 * 1024; i += 512) { const float v = in.c[i]; cs[i] = v / (1.0f + __expf(-v)); }
        __syncthreads();
        const int n0 = vcu * 64, l = n0 / 6144, nn = n0 % 6144 + lane;
        const float* wp = in.ada_w + (size_t)l * 1024 * 6144 + (size_t)(wave * 128) * 6144 + nn;
        float acc[8];
#pragma unroll
        for (int b = 0; b < 8; ++b) acc[b] = 0.f;
#pragma unroll 8
        for (int k = 0; k < 128; ++k) { const float wv = wp[(size_t)k * 6144];
#pragma unroll
            for (int b = 0; b < 8; ++b) acc[b] += cs[b * 1024 + wave * 128 + k] * wv; }
#pragma unroll
        for (int b = 0; b < 8; ++b) part[(wave * 8 + b) * 64 + lane] = acc[b];
        __syncthreads();
        { const int b = tid >> 6; float s = 0.f;
#pragma unroll
          for (int w = 0; w < 8; ++w) s += part[(w * 8 + b) * 64 + lane];
          ((float*)(ws + WS_MOD))[((size_t)l * 8 + b) * 6144 + nn] = s + in.ada_b[l * 6144 + nn]; }
        __syncthreads();
    }
    { const int g = vcu * 512 + tid; if (g < 2048 * 64) { const int pos = g >> 6, i = g & 63; const float inv = powf(10000.0f, -(float)i / 64.0f); const float ang = (float)pos * inv;
        float* rp = (float*)(ws + WS_ROPE) + (size_t)g * 2; rp[0] = (float)cos((double)ang); rp[1] = (float)sin((double)ang); } }
    convert_base_all(inp, ws, lds, vcu * NWAVES + wave, G * NWAVES, wave, lane);
}

template <int MODE>
__device__ __forceinline__ void norm_pass(const float* xsrc, const float* gain, const float* sh, const float* sc, bf16* dst,
                                          const float* router_w, int* eidx, float* ew, int* wcnt, int gw, int lane) {
    const int m0 = gw * 8, b = m0 >> 11;
    f32x4 gv[4], scv[4], shv[4];
#pragma unroll
    for (int j = 0; j < 4; ++j) { gv[j] = ((const f32x4*)gain)[lane + 64 * j]; scv[j] = ((const f32x4*)(sc + (size_t)b * 6144))[lane + 64 * j] + 1.0f; shv[j] = ((const f32x4*)(sh + (size_t)b * 6144))[lane + 64 * j]; }
    int cnt[8];
#pragma unroll
    for (int e = 0; e < 8; ++e) cnt[e] = 0;
    f32x4 rw[4][4][2];
    if (MODE == 1) {
#pragma unroll
        for (int j = 0; j < 4; ++j)
#pragma unroll
            for (int c = 0; c < 4; ++c) { const float* wp = router_w + (size_t)(4 * (lane + 64 * j) + c) * 8; rw[j][c][0] = *(const f32x4*)wp; rw[j][c][1] = *(const f32x4*)(wp + 4); }
    }
    for (int i = 0; i < 8; ++i) {
        const int m = m0 + i;
        const f32x4* xr = (const f32x4*)(xsrc + (size_t)m * 1024) + lane;
        f32x4 v[4]; float s = 0.f;
#pragma unroll
        for (int j = 0; j < 4; ++j) { v[j] = xr[64 * j]; s += (v[j][0] * v[j][0] + v[j][1] * v[j][1]) + (v[j][2] * v[j][2] + v[j][3] * v[j][3]); }
        const float rs = 1.0f / sqrtf(wave_sum(s) * (1.0f / 1024.0f) + 1e-6f);
        v2u* o8 = (v2u*)(dst + (size_t)m * 1024) + lane;
#pragma unroll
        for (int j = 0; j < 4; ++j) { v[j] = v[j] * rs * gv[j] * scv[j] + shv[j]; v2u w; w.x = pk2(v[j][0], v[j][1]); w.y = pk2(v[j][2], v[j][3]); o8[64 * j] = w; }
        if (MODE == 1) {
            float lg[8];
#pragma unroll
            for (int e = 0; e < 8; ++e) lg[e] = 0.f;
#pragma unroll
            for (int j = 0; j < 4; ++j)
#pragma unroll
                for (int c = 0; c < 4; ++c) { const f32x4 w0 = rw[j][c][0], w1 = rw[j][c][1];
                    const float hv = v[j][c];
                    lg[0] += hv * w0[0]; lg[1] += hv * w0[1]; lg[2] += hv * w0[2]; lg[3] += hv * w0[3]; lg[4] += hv * w1[0]; lg[5] += hv * w1[1]; lg[6] += hv * w1[2]; lg[7] += hv * w1[3]; }
            { const bool b5 = (lane & 32) != 0, b4 = (lane & 16) != 0, b3 = (lane & 8) != 0;
              float a4[4], b2[2], c1;
#pragma unroll
              for (int q = 0; q < 4; ++q) { const float keep = b5 ? lg[4 + q] : lg[q], send = b5 ? lg[q] : lg[4 + q]; a4[q] = keep + __shfl_xor(send, 32); }
#pragma unroll
              for (int q = 0; q < 2; ++q) { const float keep = b4 ? a4[2 + q] : a4[q], send = b4 ? a4[q] : a4[2 + q]; b2[q] = keep + __shfl_xor(send, 16); }
              { const float keep = b3 ? b2[1] : b2[0], send = b3 ? b2[0] : b2[1]; c1 = keep + __shfl_xor(send, 8); }
              c1 += __shfl_xor(c1, 4); c1 += __shfl_xor(c1, 2); c1 += __shfl_xor(c1, 1);
#pragma unroll
              for (int e = 0; e < 8; ++e) lg[e] = __builtin_bit_cast(float, __builtin_amdgcn_readlane(__builtin_bit_cast(int, c1), 8 * e)); }
            int i0 = 0; float b0 = lg[0];
#pragma unroll
            for (int e = 1; e < 8; ++e) if (lg[e] > b0) { b0 = lg[e]; i0 = e; }
            int i1 = -1; float b1 = -3.0e38f;
#pragma unroll
            for (int e = 0; e < 8; ++e) if (e != i0 && lg[e] > b1) { b1 = lg[e]; i1 = e; }
            const float e1 = __expf(b1 - b0);
#pragma unroll
            for (int e = 0; e < 8; ++e) cnt[e] += ((e == i0) ? 1 : 0) + ((e == i1) ? 1 : 0);
            if (lane == 0) { eidx[m * 2] = i0; eidx[m * 2 + 1] = i1; ew[m * 2] = 1.0f / (1.0f + e1); ew[m * 2 + 1] = e1 / (1.0f + e1); }
        }
    }
    if (MODE == 1) {
        int myc = 0;
#pragma unroll
        for (int e = 0; e < 8; ++e) myc = (lane == e) ? cnt[e] : myc;
        if (lane < 8) wcnt[gw * 8 + lane] = myc;
    }
}

__device__ __forceinline__ void place_pass(const int* wcnt, const int* eidx, const float* ew, const bf16* XA, bf16* XS, int* srow, float* swt, int* segout, int gw, int NGW, int lane) {
    int tot[8], pre[8];
#pragma unroll
    for (int e = 0; e < 8; ++e) { tot[e] = 0; pre[e] = 0; }
    for (int w = lane; w < NGW; w += 64) { const i32x4 a = *(const i32x4*)(wcnt + w * 8), c = *(const i32x4*)(wcnt + w * 8 + 4); const int inc = (w < gw) ? 1 : 0;
        tot[0] += a[0]; tot[1] += a[1]; tot[2] += a[2]; tot[3] += a[3]; tot[4] += c[0]; tot[5] += c[1]; tot[6] += c[2]; tot[7] += c[3];
        pre[0] += inc * a[0]; pre[1] += inc * a[1]; pre[2] += inc * a[2]; pre[3] += inc * a[3]; pre[4] += inc * c[0]; pre[5] += inc * c[1]; pre[6] += inc * c[2]; pre[7] += inc * c[3]; }
    int base[8]; int run = 0;
#pragma unroll
    for (int e = 0; e < 8; ++e) { tot[e] = wave_sum_i(tot[e]); pre[e] = wave_sum_i(pre[e]); base[e] = run + pre[e]; if (gw == 0 && lane == 0) segout[e] = run; run += (tot[e] + 255) & ~255; }
    if (gw == 0 && lane == 0) segout[8] = run;
    const int myev = (lane < 16) ? eidx[gw * 16 + lane] : 0; const float myw = (lane < 16) ? ew[gw * 16 + lane] : 0.f;
    int mypos = 0;
#pragma unroll
    for (int i = 0; i < 16; ++i) { const int ev = __builtin_amdgcn_readlane(myev, i); int pos = 0;
#pragma unroll
        for (int e = 0; e < 8; ++e) if (ev == e) { pos = base[e]; base[e] += 1; }
        mypos = (lane == i) ? pos : mypos; }
    if (lane < 16) { srow[mypos] = gw * 16 + lane; swt[mypos] = myw; }
    const v4u* __restrict__ s = (const v4u*)(XA + (size_t)(gw * 8) * 1024);
    v4u r0[8], r1[8];
#pragma unroll
    for (int t = 0; t < 8; ++t) { r0[t] = s[t * 128 + lane]; r1[t] = s[t * 128 + lane + 64]; }
#pragma unroll
    for (int i = 0; i < 16; ++i) { const int pos = __builtin_amdgcn_readlane(mypos, i); v4u* __restrict__ d = (v4u*)(XS + (size_t)pos * 1024);
        d[lane] = r0[i >> 1]; d[lane + 64] = r1[i >> 1]; }
}

__device__ __forceinline__ void final_pass(float* xio, const bf16* YS, const int* atomf, const float* slab, const float* g2, const float* fg, int gw, int lane) {
    const int m0 = gw * 8, b = m0 >> 11;
    f32x4 gv[4], g2v[4];
#pragma unroll
    for (int j = 0; j < 4; ++j) { gv[j] = ((const f32x4*)fg)[lane + 64 * j]; g2v[j] = ((const f32x4*)(g2 + (size_t)b * 6144))[lane + 64 * j]; }
    for (int i = 0; i < 8; ++i) {
        const int m = m0 + i;
        f32x4* xr = (f32x4*)(xio + (size_t)m * 1024) + lane;
        const v2u* y0 = (const v2u*)(YS + (size_t)(2 * m) * 1024) + lane; const v2u* y1 = (const v2u*)(YS + (size_t)(2 * m + 1) * 1024) + lane;
        f32x4 v[4]; float s = 0.f; const i32x4 f0 = *(const i32x4*)(atomf + (size_t)(2 * m) * 4), f1 = *(const i32x4*)(atomf + (size_t)(2 * m + 1) * 4);
#pragma unroll
        for (int j = 0; j < 4; ++j) { v[j] = xr[64 * j]; const v2u a = y0[64 * j], c = y1[64 * j];
            f32x4 ya, yc;
            if (f0[j]) { const int id = f0[j] - 1; const float* sp = slab + ((size_t)((id >> 8) * 11) * 256 + (id & 255)) * 256 + 4 * lane; ya = (f32x4){0.f, 0.f, 0.f, 0.f};
                for (int kc = 0; kc < 11; ++kc) ya += *(const f32x4*)(sp + (size_t)kc * 65536); }
            else { ya[0] = h16::lo(a.x); ya[1] = h16::hi(a.x); ya[2] = h16::lo(a.y); ya[3] = h16::hi(a.y); }
            if (f1[j]) { const int id = f1[j] - 1; const float* sp = slab + ((size_t)((id >> 8) * 11) * 256 + (id & 255)) * 256 + 4 * lane; yc = (f32x4){0.f, 0.f, 0.f, 0.f};
                for (int kc = 0; kc < 11; ++kc) yc += *(const f32x4*)(sp + (size_t)kc * 65536); }
            else { yc[0] = h16::lo(c.x); yc[1] = h16::hi(c.x); yc[2] = h16::lo(c.y); yc[3] = h16::hi(c.y); }
            const f32x4 ys = ya + yc;
            v[j] = v[j] + g2v[j] * ys; s += (v[j][0] * v[j][0] + v[j][1] * v[j][1]) + (v[j][2] * v[j][2] + v[j][3] * v[j][3]); }
        const float rs = 1.0f / sqrtf(wave_sum(s) * (1.0f / 1024.0f) + 1e-6f);
#pragma unroll
        for (int j = 0; j < 4; ++j) xr[64 * j] = v[j] * rs * gv[j];
    }
}

constexpr int N_PHASES = 18;
struct Args { Inputs in; float* out; unsigned char* ws; int ph_lo, ph_hi, bar_region, moe_w; };

typedef const Args __attribute__((address_space(4))) CArgs;
__device__ __forceinline__ CArgs* kargs() { unsigned long off = 0; asm volatile("" : "+s"(off)); return (CArgs*)((const char __attribute__((address_space(4)))*)__builtin_amdgcn_kernarg_segment_ptr() + off); }

__global__ void __launch_bounds__(NWAVES * 64, 2) mega(Args args_unused) {
    extern __shared__ __attribute__((aligned(16))) unsigned char lds_raw[];
    LAS unsigned char* lds = (LAS unsigned char*)lds_raw;
    volatile LAS unsigned* MISC = (volatile LAS unsigned*)(lds + MISC_OFF);
    const int G = gridDim.x;
#define PHASE_IDS int tid = threadIdx.x; asm volatile("" : "+v"(tid)); int bx = blockIdx.x; asm volatile("" : "+s"(bx)); const int lane = tid & 63, wave = __builtin_amdgcn_readfirstlane(tid >> 6); \
    const int vcu = (bx & 7) * (G >> 3) + (bx >> 3); const int gw = vcu * NWAVES + wave; (void)lane; (void)gw; (void)vcu;
    for (int u = threadIdx.x; u < (LDS_BYTES - LDSCTL_OFF) / 4; u += NWAVES * 64) ((LAS unsigned*)(lds + LDSCTL_OFF))[u] = 0u;
    __syncthreads();
    XcdBarrier bar;
    { CArgs* ka = kargs(); unsigned* barw = (unsigned*)(ka->ws + WS_CTL) + CW_BAR + ka->bar_region * XCD_BAR_WORDS; bar = xcd_barrier_post(barw, MISC + 8); }
    int lo, hi; { CArgs* ka = kargs(); lo = ka->ph_lo; hi = ka->ph_hi; }
#ifndef PHM
#define PHM 0x3ff
#endif
#define IN(k) (lo <= (k) && (k) < hi)
#define TY(t) (((PHM) >> (t)) & 1)
#ifndef DUP_T
#define DUP_T -1
#define DUP_N 0
#endif
#define REP(t) for (int rep_ = 0; rep_ < ((t) == DUP_T ? 1 + DUP_N : 1) && (rep_ == 0 || (__syncthreads(), true)); ++rep_)
#ifdef TPROBE
    volatile LAS unsigned long long* TS = (volatile LAS unsigned long long*)(lds + MISC_OFF + 256);
#define STAMP(k) do { if (blockIdx.x == 0 && threadIdx.x == 0) TS[(k)] = __builtin_amdgcn_s_memrealtime(); } while (0)
#else
#define STAMP(k) do {} while (0)
#endif
    STAMP(0);
#define SEAM(k) do { if (IN(k) && IN((k) + 1)) xcd_barrier(bar); STAMP((k) + 1); } while (0)

    if (TY(0) && IN(0)) REP(0) { PHASE_IDS CArgs* ka = kargs(); p0_prologue(&ka->in, ka->ws, lds, vcu, G, wave, lane, tid, 0); }
    SEAM(0);
#ifdef PROBE_BAR
    for (int q = 0; q < PROBE_BAR; ++q) xcd_barrier(bar);
#endif
    for (int l = 0; l < 2; ++l) {
        const int pb = 1 + 8 * l;
        if (TY(1) && IN(pb + 0)) REP(1) { PHASE_IDS CArgs* ka = kargs(); unsigned char* ws = ka->ws; const float* mod = (const float*)(ws + WS_MOD) + (size_t)l * 8 * 6144;
            const float* xin = (l == 0) ? ka->in.x : (const float*)ka->out;
            if (gw < 2048) norm_pass<0>(xin, ka->in.norm_mix_g + l * 1024, mod + 0 * 1024, mod + 1 * 1024, (bf16*)(ws + WS_XA), nullptr, nullptr, nullptr, nullptr, gw, lane); }
        SEAM(pb + 0);
        if (TY(2) && IN(pb + 1)) REP(2) { PHASE_IDS CArgs* ka = kargs(); unsigned char* ws = ka->ws;
            if (bx < G_INPROJ) {
                pg8::Gemm g{1024, 1024, 1024}; pg8::DenseSched S; S.init(ws + WS_XA, 1024, (bf16*)(ws + WS_WIN) + (size_t)l * 3584 * 1024, 1024, 16384, 3584, G_INPROJ, bx);
                epi::EpiInProj E{(bf16*)(ws + WS_QKV), (size_t)16384 * 512, (float*)(ws + WS_KMP), (const float*)(ws + WS_ROPE)};
                pg8::gemm_phase(lds, g, S, E);
            } else if (rep_ == 0) convert_moe_range<0>(&ka->in, ws, lds, l == 0 ? 0 : IT_MOE_B, l == 0 ? IT_MOE_A : IT_MGU, bx - G_INPROJ, G - G_INPROJ, wave, lane);
        }
        SEAM(pb + 1);
        if (TY(3) && IN(pb + 2)) REP(3) { PHASE_IDS CArgs* ka = kargs(); unsigned char* ws = ka->ws; bf16* QKV = (bf16*)(ws + WS_QKV); bf16* CAT = (bf16*)(ws + WS_CAT);
            if (G == 256) {
                if ((bx & 7) < 7) fa::kv_unit(bx >> 5, (bx >> 3) & 3, bx & 7, QKV + (size_t)4 * 16384 * 512, QKV + (size_t)5 * 16384 * 512, (float*)(ws + WS_KVM), lds);
                xcd_barrier(bar);
                { fa::Tensors TR{QKV + (size_t)3 * 16384 * 512, QKV + (size_t)4 * 16384 * 512, QKV + (size_t)5 * 16384 * 512, CAT, (float*)(ws + WS_ASSQ), (const float*)(ws + WS_KMP), QKV + (size_t)6 * 16384 * 512, ka->in.ret_g + l * 512, (const float*)(ws + WS_KVM)};
                  fa::attn_unit<true>(bx >> 5, (bx >> 3) & 3, bx & 7, TR, lds); }
                fa::Tensors TA{QKV, QKV + (size_t)1 * 16384 * 512, QKV + (size_t)2 * 16384 * 512, CAT, (float*)(ws + WS_ASSQ), (const float*)(ws + WS_KMP), nullptr, nullptr, nullptr};
                const int bh = bx >> 2, pr = bx & 3;
                for (int uu = 0; uu < 2; ++uu) fa::attn_unit<false>(bh >> 3, bh & 7, uu == 0 ? 7 - pr : pr, TA, lds);
            }
        }
        SEAM(pb + 2);
        if (TY(4) && IN(pb + 3)) REP(4) {
            { PHASE_IDS CArgs* ka = kargs(); unsigned char* ws = ka->ws; const float* mod = (const float*)(ws + WS_MOD) + (size_t)l * 8 * 6144;
                const float* xin = (l == 0) ? ka->in.x : (const float*)ka->out;
                pg8::Gemm g{1024, 1024, 1024}; pg8::DenseSched S; S.init(ws + WS_CAT, 1024, (const bf16*)(ws + WS_WOUT) + (size_t)l * 1024 * 1024, 1024, 16384, 1024, G, bx);
                epi::EpiOutProj E{xin, ka->out, mod + 2 * 1024, (const float*)(ws + WS_ASSQ), rep_ > 0}; pg8::gemm_phase(lds, g, S, E); }
        }
        SEAM(pb + 3);
        if (TY(5) && IN(pb + 4)) REP(5) { PHASE_IDS CArgs* ka = kargs(); unsigned char* ws = ka->ws; const float* mod = (const float*)(ws + WS_MOD) + (size_t)l * 8 * 6144;
            if (gw < 2048) {
                if (l == 0) norm_pass<0>(ka->out, ka->in.norm_ffn_g + l * 1024, mod + 3 * 1024, mod + 4 * 1024, (bf16*)(ws + WS_XA), nullptr, nullptr, nullptr, nullptr, gw, lane);
                else norm_pass<1>(ka->out, ka->in.norm_ffn_g + l * 1024, mod + 3 * 1024, mod + 4 * 1024, (bf16*)(ws + WS_XA), ka->in.router_w, (int*)(ws + WS_EIDX), (float*)(ws + WS_EW), (int*)(ws + WS_WCNT), gw, lane);
            }
            if (l == 1) { int* srow = (int*)(ws + WS_SROW); int* af = (int*)(ws + WS_ATOMF);
                { const int p = bx * 512 + tid; if (p < XS_ROWS) srow[p] = -1; af[p] = 0; }
            }
            else if (bx == 0 && tid < 9) { ((int*)(ws + WS_SEGD))[tid] = (tid == 0) ? 0 : ((tid == 8) ? 16384 : (1 << 30)); }
        }
        SEAM(pb + 4);
        if (l == 1) {
            if (TY(6) && IN(pb + 5)) REP(6) { PHASE_IDS CArgs* ka = kargs(); unsigned char* ws = ka->ws;
                if (gw < 2048) place_pass((const int*)(ws + WS_WCNT), (const int*)(ws + WS_EIDX), (const float*)(ws + WS_EW), (const bf16*)(ws + WS_XA), (bf16*)(ws + WS_XS), (int*)(ws + WS_SROW), (float*)(ws + WS_SWT), (int*)(ws + WS_SEG), gw, 2048, lane); }
            SEAM(pb + 5);
        } else { STAMP(pb + 6); }
        if (TY(7) && IN(pb + 6)) REP(7) { PHASE_IDS CArgs* ka = kargs(); unsigned char* ws = ka->ws;
            int Geff = G_GUD;
            if (l == 1) { const int nwg = (__builtin_amdgcn_readfirstlane(((const int*)(ws + WS_SEG))[8]) / 256) * 22; const int rounds = (nwg + G - 1) / G;
                Geff = (nwg + rounds - 1) / rounds; if (Geff > G - 4) Geff = G - 4; }
            if (bx < Geff) {
                pg8::Gemm g{1024, 1024, 1024}; pg8::MoeSched S;
                S.init(ws + (l == 0 ? WS_XA : WS_XS), 1024, ws + (l == 0 ? WS_FGU : WS_MGU), 1024, (size_t)5632 * 1024 * 2, (const int*)(ws + (l == 0 ? WS_SEGD : WS_SEG)), 5632, Geff, bx);
                epi::EpiSwiGLU E{(bf16*)(ws + (l == 0 ? WS_HD : WS_HM)), 2816}; pg8::gemm_phase(lds, g, S, E);
            } else if (rep_ == 0) { if (l == 0) convert_moe_range<0>(&ka->in, ws, lds, IT_MOE_A, IT_MOE_B, bx - Geff, G - Geff, wave, lane);
                                    else convert_moe_range<1>(&ka->in, ws, lds, 0, IT_MDN, bx - Geff, G - Geff, wave, lane); }
        }
        SEAM(pb + 6);
        if (TY(8) && IN(pb + 7)) REP(8) { PHASE_IDS CArgs* ka = kargs(); unsigned char* ws = ka->ws; const float* mod = (const float*)(ws + WS_MOD) + (size_t)l * 8 * 6144;
            pg8::MoeSched S;
            S.init(ws + (l == 0 ? WS_HD : WS_HM), 2816, ws + (l == 0 ? WS_FDN : WS_MDN), 2816, (size_t)1024 * 2816 * 2, (const int*)(ws + (l == 0 ? WS_SEGD : WS_SEG)), 1024, G, bx);
            const int left = S.nwg % G; const bool split = (l == 1) && left > 0 && left <= 32;
            if (split) S.lim = S.nwg - left;
            { pg8::Gemm g{2816, 2816, 2816};
              epi::EpiDown E{ka->out, mod + 5 * 1024, (bf16*)(ws + WS_YS), (const int*)(ws + WS_SROW), (const float*)(ws + WS_SWT), l == 1, rep_ > 0, (int*)(ws + WS_ATOMF), false, nullptr, 1}; pg8::gemm_phase(lds, g, S, E); }
            if (split && rep_ == 0) { S.first = S.nwg - left; S.lim = S.nwg; S.KS = 11; S.kbytes = 256 * 2;
              pg8::Gemm g{2816, 2816, 256};
              epi::EpiDown E{ka->out, mod + 5 * 1024, (bf16*)(ws + WS_YS), (const int*)(ws + WS_SROW), (const float*)(ws + WS_SWT), true, false, (int*)(ws + WS_ATOMF), true, (float*)(ws + WS_SLAB), 11}; pg8::gemm_phase(lds, g, S, E); }
        }
        SEAM(pb + 7);
    }
    if (TY(9) && IN(17)) { PHASE_IDS CArgs* ka = kargs(); unsigned char* ws = ka->ws;
        if (gw < 2048) final_pass(ka->out, (const bf16*)(ws + WS_YS), (const int*)(ws + WS_ATOMF), (const float*)(ws + WS_SLAB), (const float*)(ws + WS_MOD) + (size_t)1 * 8 * 6144 + 5 * 1024, ka->in.final_g, gw, lane); }
#ifdef TPROBE
    xcd_barrier(bar); STAMP(18); __syncthreads();
    if (blockIdx.x == 0) { CArgs* ka = kargs(); float* o = ka->out;
        const float d1 = (float)(TS[TPROBE_A + 1] - TS[TPROBE_A]) * 0.01f, d2 = (float)(TS[TPROBE_B + 1] - TS[TPROBE_B]) * 0.01f;
        const float a = 4.0f * sqrtf(d1);
        for (int i = threadIdx.x; i < 1024 * 1024; i += 512) o[i] = a;
        if (threadIdx.x == 0) o[1024 * 1024 + 5] = 100.0f * d2; }
#endif
#undef IN
#undef TY
#undef SEAM
#undef PHASE_IDS
}
}
#ifndef STEP
#define STEP 5
#endif
namespace ad {
__device__ __forceinline__ float bf2f(unsigned short s) { return h16::one(s); }
__global__ void __launch_bounds__(256) ad_proj(const unsigned short* QKV, size_t gstride, int b, float* projb) {
    const int m = blockIdx.x; const size_t row = (size_t)b * 2048 + m;
    for (int n = threadIdx.x; n < 3584; n += 256) {
        const int grp = n / 512, c = n % 512; int sc = c;
        if (grp == 3 || grp == 4) { const int head = c >> 7, d = c & 127; sc = head * 128 + 8 * ((d & 63) >> 2) + 2 * (d & 3) + (d >> 6); }
        float v = bf2f(QKV[(size_t)grp * gstride + row * 512 + sc]);
        if (grp == 0) v *= (1.0f / epi::C2);
        if (grp == 4) v *= (1.0f / epi::KSC);
        projb[(size_t)m * 3584 + n] = v;
    }
}
__global__ void __launch_bounds__(64) ad_kmean(const float* KMP, int b, float* kmeanb) {
    const int blk = blockIdx.x, h = blockIdx.y, d = threadIdx.x;
    const float* p = KMP + ((size_t)(b * 8 + blk) * 2) * 512 + h * 64 + d;
    kmeanb[((size_t)h * 8 + blk) * 64 + d] = (p[0] + p[512]) * (1.0f / 256.0f);
}
__global__ void __launch_bounds__(256) ad_cat(const unsigned short* CAT, const float* ASSQ, const float* att_g, int b, float* catb) {
    const int m = blockIdx.x; const size_t row = (size_t)b * 2048 + m;
    float ss = 0.f;
    for (int h = 0; h < 8; ++h) ss += ASSQ[row * 8 + h];
    const float rs = 1.0f / sqrtf(ss * (1.0f / 512.0f) + 1e-6f);
    for (int c = threadIdx.x; c < 1024; c += 256) { const float v = bf2f(CAT[row * 1024 + c]); catb[(size_t)m * 1024 + c] = (c < 512) ? v * rs * att_g[c] : v; }
}
__global__ void __launch_bounds__(256) dbg_cmp(const float* a, const float* b, size_t n, float rel, float abs_, unsigned* flag, int ncols = 1, int c_lo = 0, int c_hi = 1, int silu_b = 0) {
    unsigned bad = 0;
    for (size_t i = (size_t)blockIdx.x * 256 + threadIdx.x; i < n; i += (size_t)gridDim.x * 256) { const int c = (int)(i % ncols); if (c < c_lo || c >= c_hi) continue;
        float bv = b[i]; if (silu_b) bv = bv / (1.f + expf(-bv)); const float d = fabsf(a[i] - bv); if (!(d <= rel * fabsf(bv) + abs_)) ++bad; }
    if (bad) atomicAdd(flag, bad);
}
__global__ void __launch_bounds__(256) dbg_poison(const unsigned* flag, unsigned thresh, float* out, float val) {
    if (*flag > thresh) for (int i = threadIdx.x; i < 1024 * 1024; i += 256) out[i] = val;
}
__global__ void __launch_bounds__(256) dbg_ssd(const float* a, const float* b, size_t n, int ncols, int c_lo, int c_hi, float* acc) {
    float s = 0.f;
    for (size_t i = (size_t)blockIdx.x * 256 + threadIdx.x; i < n; i += (size_t)gridDim.x * 256) { const int c = (int)(i % ncols); if (c < c_lo || c >= c_hi) continue; const float d = a[i] - b[i]; s += d * d; }
    atomicAdd(acc, s);
}
__global__ void __launch_bounds__(256) dbg_encode(const float* acc, float count, float* out) {
    const float mse = *acc / count; const float val = 4.0f / sqrtf(mse);
    for (int i = threadIdx.x; i < 1024 * 1024; i += 256) out[i] = val;
}
}

static void launch_mega(const mk::Args& a0, int lo, int hi, int region, hipStream_t stream) {
    mk::Args a = a0; a.ph_lo = lo; a.ph_hi = hi; a.bar_region = region;
    hipLaunchKernelGGL(mk::mega, dim3(256), dim3(512), mk::LDS_BYTES, stream, a);
}

extern "C" void kernel_launch(void* const* d_in, const int* in_sizes, int n_in, void* d_out, int out_size, void* d_ws, size_t ws_size, hipStream_t stream) {
    static int ready = 0;
    if (ready == 0) {
        if (n_in != 18 || out_size != M * D || ws_size < mk::WS_END) { fprintf(stderr, "kernel_launch: unexpected problem (n_in %d, out %d, ws %zu)\n", n_in, out_size, ws_size); ready = -1; return; }
        if (hipFuncSetAttribute((const void*)mk::mega, hipFuncAttributeMaxDynamicSharedMemorySize, mk::LDS_BYTES) != hipSuccess) { fprintf(stderr, "kernel_launch: hipFuncSetAttribute failed\n"); ready = -1; return; }
        ready = 1;
    }
    if (ready < 0) return;
    mk::Args a{};
    const float** ip = (const float**)&a.in;
    for (int i = 0; i < 18; ++i) ip[i] = (const float*)d_in[i];
    a.out = (float*)d_out; a.ws = (unsigned char*)d_ws; a.moe_w = (STEP >= 5) ? 1 : 0;
    const mk::Inputs& in = a.in;
    float* out = (float*)d_out; unsigned char* ws = (unsigned char*)d_ws;
    hipMemsetAsync(ws + mk::WS_CTL, 0, mk::CTL_ZERO_BYTES, stream);
#if STEP >= 6
    launch_mega(a, 0, mk::N_PHASES, 0, stream);
#else
    constexpr size_t MiB = 1u << 20;
    unsigned char* na = ws + 8 * MiB;
    float* PROJb = (float*)(na);
    float* Hb = (float*)(na + 28 * MiB);
    float* CATb = (float*)(na + 36 * MiB);
    float* OAb = (float*)(na + 44 * MiB);
    float* ORRb = (float*)(na + 48 * MiB);
    float* KMEANb = (float*)(na + 52 * MiB);
    int* EIDXb = (int*)(na + 53 * MiB); float* EWb = (float*)(na + 53 * MiB + 65536); int* POSb = (int*)(na + 53 * MiB + 131072); int* LISTb = (int*)(na + 53 * MiB + 196608);
    int* CNTb = (int*)(na + 54 * MiB); int* BASEb = CNTb + 16;
    float* Gb = (float*)(na + 56 * MiB);
    float* Ub = (float*)(na + 78 * MiB);
    float* Yb = (float*)(na + 100 * MiB);
    const float* MODp = (const float*)(ws + mk::WS_MOD);
    unsigned short* QKV = (unsigned short*)(ws + mk::WS_QKV);
    launch_mega(a, 0, 1, 1, stream);
    for (int l = 0; l < 2; ++l) {
        const int pb = 1 + 8 * l;
        const float* xin = (l == 0) ? in.x : (const float*)out;
        if (STEP >= 1) { launch_mega(a, pb, pb + 1, 1, stream); launch_mega(a, pb + 1, pb + 2, 1, stream); }
        if (STEP >= 2) launch_mega(a, pb + 2, pb + 3, 1, stream);
        if (STEP >= 3) launch_mega(a, pb + 3, pb + 4, 1, stream);
        if (STEP < 3) {
            for (int b = 0; b < BATCH; ++b) {
                const float* mod = MODp + ((size_t)l * BATCH + b) * 6 * D;
                const float* xb = xin + (size_t)b * SEQ * D; float* ob = out + (size_t)b * SEQ * D;
                if (STEP < 1) {
                    nv::k_norm<<<SEQ, 256, 0, stream>>>(xb, in.norm_mix_g + l * D, mod + 0 * D, mod + 1 * D, Hb);
                    nv::k_gemm<<<dim3(NPROJ / 64, SEQ / 64), 256, 0, stream>>>(Hb, D, nullptr, nullptr, SEQ, in.w_in + (size_t)l * D * NPROJ, NPROJ, PROJb, NPROJ, D);
                    nv::k_rotary<<<SEQ, 256, 0, stream>>>(PROJb);
                    nv::k_kmean<<<dim3(NBLK, AH, 1), 64, 0, stream>>>(PROJb, KMEANb);
                } else {
                    ad::ad_proj<<<SEQ, 256, 0, stream>>>(QKV, (size_t)M * 512, b, PROJb);
                    ad::ad_kmean<<<dim3(NBLK, AH, 1), 64, 0, stream>>>((const float*)(ws + mk::WS_KMP), b, KMEANb);
#ifdef DBG_CHECK
                    { float* PROJn = Gb; float* KMn = (float*)(na + 52 * MiB + 262144); unsigned* flag = (unsigned*)(ws + mk::WS_CTL) + 16;
                      nv::k_norm<<<SEQ, 256, 0, stream>>>(xb, in.norm_mix_g + l * D, mod + 0 * D, mod + 1 * D, Hb);
                      nv::k_gemm<<<dim3(NPROJ / 64, SEQ / 64), 256, 0, stream>>>(Hb, D, nullptr, nullptr, SEQ, in.w_in + (size_t)l * D * NPROJ, NPROJ, PROJn, NPROJ, D);
                      nv::k_rotary<<<SEQ, 256, 0, stream>>>(PROJn);
                      nv::k_kmean<<<dim3(NBLK, AH, 1), 64, 0, stream>>>(PROJn, KMn);
                      ad::dbg_cmp<<<1024, 256, 0, stream>>>(PROJb, PROJn, (size_t)SEQ * NPROJ, DBG_REL, DBG_ABS, flag, NPROJ, 0, 3072, 0);
                      ad::dbg_cmp<<<1024, 256, 0, stream>>>(PROJb, PROJn, (size_t)SEQ * NPROJ, DBG_REL, DBG_ABS, flag, NPROJ, 3072, 3584, 1);
                      ad::dbg_cmp<<<16, 256, 0, stream>>>(KMEANb, KMn, (size_t)8 * 8 * 64, 0.03f, 0.004f, flag + 1);
                      if (l == DBG_L && b == 0) ad::dbg_ssd<<<1024, 256, 0, stream>>>(PROJb, PROJn, (size_t)SEQ * NPROJ, NPROJ, DBG_CLO, DBG_CHI, (float*)(flag + 2)); }
#endif
                }
                if (STEP < 2) {
                    nv::k_moba<<<dim3(NBLK, AH, 1), 256, 0, stream>>>(PROJb, KMEANb, OAb);
                    nv::k_ret<<<dim3(SEQ / 256, RH * 4, 1), 256, 0, stream>>>(PROJb, ORRb);
                    nv::k_cat<<<SEQ, 256, 0, stream>>>(OAb, ORRb, PROJb, in.att_g + l * AW, in.ret_g + l * RW, CATb, STEP >= 1 ? 1 : 0);
                } else {
                    ad::ad_cat<<<SEQ, 256, 0, stream>>>((const unsigned short*)(ws + mk::WS_CAT), (const float*)(ws + mk::WS_ASSQ), in.att_g + l * AW, b, CATb);
                }
                nv::k_gemm<<<dim3(D / 64, SEQ / 64), 256, 0, stream>>>(CATb, D, nullptr, nullptr, SEQ, in.w_out + (size_t)l * D * D, D, Hb, D, D);
                nv::k_resid<<<SEQ, 256, 0, stream>>>(xb, mod + 2 * D, Hb, ob);
            }
        }
        const bool ffn_mega = (l == 0) ? (STEP >= 4) : (STEP >= 5);
        if (ffn_mega) {
            launch_mega(a, pb + 4, pb + 5, 1, stream);
            if (l == 1) launch_mega(a, pb + 5, pb + 6, 1, stream);
            launch_mega(a, pb + 6, pb + 7, 1, stream);
            launch_mega(a, pb + 7, pb + 8, 1, stream);
        } else {
            for (int b = 0; b < BATCH; ++b) {
                const float* mod = MODp + ((size_t)l * BATCH + b) * 6 * D;
                float* ob = out + (size_t)b * SEQ * D;
                nv::k_norm<<<SEQ, 256, 0, stream>>>(ob, in.norm_ffn_g + l * D, mod + 3 * D, mod + 4 * D, Hb);
                if (l == 0) {
                    nv::k_gemm<<<dim3(FF / 64, SEQ / 64), 256, 0, stream>>>(Hb, D, nullptr, nullptr, SEQ, in.fw_gate, FF, Gb, FF, D);
                    nv::k_gemm<<<dim3(FF / 64, SEQ / 64), 256, 0, stream>>>(Hb, D, nullptr, nullptr, SEQ, in.fw_up, FF, Ub, FF, D);
                    nv::k_silu_mul<<<SEQ, 256, 0, stream>>>(Gb, Ub, nullptr, SEQ, FF);
                    nv::k_gemm<<<dim3(D / 64, SEQ / 64), 256, 0, stream>>>(Gb, FF, nullptr, nullptr, SEQ, in.fw_down, D, Ub, D, FF);
                    nv::k_resid<<<SEQ, 256, 0, stream>>>(ob, mod + 5 * D, Ub, ob);
                } else {
                    nv::k_router<<<SEQ / 4, 256, 0, stream>>>(Hb, in.router_w, EIDXb, EWb);
                    nv::k_place<<<1, 1024, 0, stream>>>(EIDXb, LISTb, POSb, CNTb, BASEb, 4);
                    float* GE = Gb; float* UE = Ub;
                    for (int e = 0; e < NE; ++e) {
                        nv::k_gemm<<<dim3(FF / 64, ECAP / 64), 256, 0, stream>>>(Hb, D, LISTb, CNTb + e, ECAP, in.mw_gate + (size_t)e * D * FF, FF, GE, FF, D, BASEb + e, nullptr);
                        nv::k_gemm<<<dim3(FF / 64, ECAP / 64), 256, 0, stream>>>(Hb, D, LISTb, CNTb + e, ECAP, in.mw_up + (size_t)e * D * FF, FF, UE, FF, D, BASEb + e, nullptr);
                        nv::k_silu_mul<<<ECAP, 256, 0, stream>>>(GE, UE, CNTb + e, ECAP, FF);
                        nv::k_gemm<<<dim3(D / 64, ECAP / 64), 256, 0, stream>>>(GE, FF, nullptr, CNTb + e, ECAP, in.mw_down + (size_t)e * FF * D, D, Yb, D, FF, nullptr, BASEb + e);
                    }
                    nv::k_moe_combine<<<SEQ, 256, 0, stream>>>(ob, mod + 5 * D, Yb, POSb, EWb);
                }
            }
        }
    }
    if (STEP >= 5) launch_mega(a, 17, 18, 1, stream);
    else nv::k_norm<<<M, 256, 0, stream>>>(out, in.final_g, nullptr, nullptr, out);
#ifdef DBG_CHECK
#ifdef DBG_ENC
    ad::dbg_encode<<<1, 256, 0, stream>>>((const float*)((unsigned*)(ws + mk::WS_CTL) + 18), (float)SEQ * (DBG_CHI - DBG_CLO), out);
#endif
    ad::dbg_poison<<<1, 256, 0, stream>>>((unsigned*)(ws + mk::WS_CTL) + 16, DBG_T0, out, 100.0f);
    ad::dbg_poison<<<1, 256, 0, stream>>>((unsigned*)(ws + mk::WS_CTL) + 17, DBG_T1, out + (1 << 20), 300.0f);
#endif
#endif
}
```

```cpp
#include <hip/hip_runtime.h>
#include <cstdio>
#include <cstdint>
#include <cmath>

namespace h16 {
typedef _Float16 f16x2_t __attribute__((ext_vector_type(2)));
typedef _Float16 f16x8_t __attribute__((ext_vector_type(8)));
typedef float f32x2_t __attribute__((ext_vector_type(2)));
__device__ __forceinline__ unsigned pk(float lo, float hi) { f32x2_t v = {lo, hi}; f16x2_t b = __builtin_convertvector(v, f16x2_t); return __builtin_bit_cast(unsigned, b); }
__device__ __forceinline__ float lo(unsigned u) { return (float)__builtin_bit_cast(f16x2_t, u)[0]; }
__device__ __forceinline__ float hi(unsigned u) { return (float)__builtin_bit_cast(f16x2_t, u)[1]; }
__device__ __forceinline__ float one(unsigned short s) { return (float)__builtin_bit_cast(_Float16, s); }
}

namespace xl {
template <int O> __device__ __forceinline__ int xor_i(int v) {
    if constexpr (O < 32) return __builtin_amdgcn_ds_swizzle(v, (O << 10) | 0x1f);
    else { static_assert(O < 32, "use add32 / max32 for the 32-lane exchange"); return v; }
}
template <int O> __device__ __forceinline__ float xor_f(float v) { return __builtin_bit_cast(float, xor_i<O>(__builtin_bit_cast(int, v))); }
__device__ __forceinline__ void swap32(unsigned a, unsigned& r0, unsigned& r1) { unsigned b = a; asm volatile("" : "+v"(b)); auto r = __builtin_amdgcn_permlane32_swap(a, b, false, false); r0 = r[0]; r1 = r[1]; }
__device__ __forceinline__ float add32(float v) { unsigned r0, r1; swap32(__builtin_bit_cast(unsigned, v), r0, r1); return __builtin_bit_cast(float, r0) + __builtin_bit_cast(float, r1); }
__device__ __forceinline__ float max32(float v) { unsigned r0, r1; swap32(__builtin_bit_cast(unsigned, v), r0, r1); return fmaxf(__builtin_bit_cast(float, r0), __builtin_bit_cast(float, r1)); }
__device__ __forceinline__ int add32i(int v) { unsigned r0, r1; swap32((unsigned)v, r0, r1); return (int)(r0 + r1); }
__device__ __forceinline__ float wave_sum(float v) { v += xor_f<1>(v); v += xor_f<2>(v); v += xor_f<4>(v); v += xor_f<8>(v); v += xor_f<16>(v); return add32(v); }
__device__ __forceinline__ int wave_sum_i(int v) { v += xor_i<1>(v); v += xor_i<2>(v); v += xor_i<4>(v); v += xor_i<8>(v); v += xor_i<16>(v); return add32i(v); }
}
#define STEP 6

constexpr int D = 1024, BATCH = 8, SEQ = 2048, M = BATCH * SEQ;
constexpr int AH = 8, AD = 64, AW = 512, MBLK = 256, NBLK = SEQ / MBLK, TOPK = 3;
constexpr int RH = 4, RD = 128, RW = 512;
constexpr int NPROJ = 3 * AW + 4 * RW;
constexpr int FF = 2816, NE = 8;
constexpr float EPS = 1e-6f;
constexpr int ECAP = 2048;
namespace pg8 {
#define PG8_LAS __attribute__((address_space(3)))
typedef unsigned short bf16_t;
typedef short bf16x8 __attribute__((ext_vector_type(8)));
typedef float f32x4 __attribute__((ext_vector_type(4)));
typedef float f32x2 __attribute__((ext_vector_type(2)));
typedef unsigned u32x4 __attribute__((ext_vector_type(4)));
typedef unsigned u32x2 __attribute__((ext_vector_type(2)));
constexpr int BM = 256, BK = 64, HALF = 128, HTB = HALF * BK * 2  , STAGE_BYTES = 8 * HTB, NXCD = 8, WGM = 8;

__host__ __device__ __forceinline__ int lds_byte(int r, int c) { const int st = (r >> 4) * 2 + (c >> 5), rr = r & 15, cc = c & 31, ob = rr * 64 + cc * 2; return st * 1024 + (ob ^ (((ob >> 9) & 1) << 5)); }
__host__ __device__ __forceinline__ void stage_rc(int b, int& R, int& C) { const int st = b / 1024, sb = b % 1024, swz = sb ^ (((sb >> 9) & 1) << 5); R = (st >> 1) * 16 + swz / 64; C = (st & 1) * 32 + (swz % 64) / 2; }
__host__ __device__ __forceinline__ int perm32(int rho) { const int n = rho >> 4, i = rho & 15; return 8 * (i >> 2) + 4 * n + (i & 3); }

struct Unit { int pm, pn, e, kc, li; };
struct Gemm { int lda, ldb, K; };

struct DenseSched {
    const char* A; const char* Bt; size_t a_tile, b_tile;
    int nM, nN, nwg, G, c;
    __device__ __forceinline__ void init(const void* A_, int lda, const void* Bt_, int ldb, int M, int N, int G_, int c_) {
        A = (const char*)A_; Bt = (const char*)Bt_; a_tile = (size_t)BM * lda * 2; b_tile = (size_t)BM * ldb * 2; nM = M / BM; nN = N / BM; nwg = nM * nN; G = G_; c = c_; }
    __device__ __forceinline__ bool next(int i, Unit& u) const {
        const long L = (long)i * G + c; if (L >= nwg) return false;
        int wgid = (int)L; { const int q = nwg / NXCD, r = nwg % NXCD, xcd = wgid % NXCD, off = wgid / NXCD; wgid = (xcd < r ? xcd * (q + 1) : r * (q + 1) + (xcd - r) * q) + off; }
        const int nig = WGM * nN, gid = wgid / nig, fm = gid * WGM, gsz = (nM - fm) < WGM ? (nM - fm) : WGM;
        u.pm = fm + ((wgid % nig) % gsz); u.pn = (wgid % nig) / gsz; u.e = 0; u.kc = 0; u.li = 0; return true;
    }
    __device__ __forceinline__ const char* a_ptr(const Unit& u) const { return A + (size_t)u.pm * a_tile; }
    __device__ __forceinline__ const char* b_ptr(const Unit& u) const { return Bt + (size_t)u.pn * b_tile; }
};
struct MoeSched {
    const char* A; const char* Bt; size_t a_tile, b_tile, e_stride;
    int nM, nN, nwg, G, c; int seg[8]; int first, lim, KS, kbytes;
    __device__ __forceinline__ void init(const void* A_, int lda, const void* Bt_, int ldb, size_t e_stride_bytes, const int* segp_, int N, int G_, int c_) {
        A = (const char*)A_; Bt = (const char*)Bt_; a_tile = (size_t)BM * lda * 2; b_tile = (size_t)BM * ldb * 2; e_stride = e_stride_bytes;
#pragma unroll
        for (int e = 0; e < 8; ++e) seg[e] = __builtin_amdgcn_readfirstlane(segp_[e]);
        nM = __builtin_amdgcn_readfirstlane(segp_[8]) / BM; nN = N / BM; nwg = nM * nN; G = G_; c = c_; first = 0; lim = nwg; KS = 1; kbytes = 0; }
    __device__ __forceinline__ bool next(int i, Unit& u) const {
        const long idx = (long)i * G + c; const long L = first + idx / KS; if (L >= lim) return false;
        u.kc = (int)(idx % KS); u.li = (int)(idx / KS);
        int wgid = (int)L; { const int q = nwg / NXCD, r = nwg % NXCD, xcd = wgid % NXCD, off = wgid / NXCD; wgid = (xcd < r ? xcd * (q + 1) : r * (q + 1) + (xcd - r) * q) + off; }
        const int nig = WGM * nN, gid = wgid / nig, fm = gid * WGM, gsz = (nM - fm) < WGM ? (nM - fm) : WGM;
        u.pm = fm + ((wgid % nig) % gsz); u.pn = (wgid % nig) / gsz;
        int e = 0; const int r0 = u.pm * BM;
#pragma unroll
        for (int k = 1; k < 8; ++k) e += (r0 >= seg[k]) ? 1 : 0;
        u.e = e; return true;
    }
    __device__ __forceinline__ const char* a_ptr(const Unit& u) const { return A + (size_t)u.pm * a_tile + (size_t)u.kc * kbytes; }
    __device__ __forceinline__ const char* b_ptr(const Unit& u) const { return Bt + (size_t)u.e * e_stride + (size_t)u.pn * b_tile + (size_t)u.kc * kbytes; }
};

__device__ __forceinline__ unsigned cvt_pk_bf16(float lo, float hi) { return h16::pk(lo, hi); }
__device__ __forceinline__ float fast_silu(float g) { return g * __builtin_amdgcn_rcpf(1.0f + __builtin_amdgcn_exp2f(-1.4426950408889634f * g)); }

typedef f32x4 Acc[2][2][4][2];

template <class Epi, class Sched>
__device__ __forceinline__ void gemm_phase(PG8_LAS unsigned char* lds, const Gemm g, const Sched& S, const Epi& E) {
    int tid_ = threadIdx.x; asm volatile("" : "+v"(tid_));
    const int tid = tid_, wid = __builtin_amdgcn_readfirstlane(tid >> 6), lane = tid & 63, wr = wid >> 2, wc = wid & 3, fr = lane & 15, fq = lane >> 4;
    const int K = g.K, nt = K / BK;
    unsigned voffA[2], voffB[2];
#pragma unroll
    for (int i = 0; i < 2; ++i) { int R, C; stage_rc(tid * 16 + i * 8192, R, C); const int Rb = Epi::PERM ? ((R & ~31) + perm32(R & 31)) : R;
        voffA[i] = (unsigned)(R * g.lda + C) * 2u; voffB[i] = (unsigned)(Rb * g.ldb + C) * 2u; }
    const size_t kstep = (size_t)(BK * 2);
    const size_t hstepA = (size_t)HALF * g.lda * 2, hstepB = (size_t)HALF * g.ldb * 2;
    const unsigned ldsw = (unsigned)wid * 1024u;
    const int aoff = lds_byte(wr * 64 + fr, fq * 8), boff = lds_byte(wc * 32 + fr, fq * 8);
#define PG8_SA(b, h) (((b) * 2 + (h)) * HTB)
#define PG8_SB(b, h) ((4 + (b) * 2 + (h)) * HTB)
#define PG8_STAGE(bufoff, gbase, voff) do { _Pragma("unroll") for (int _i = 0; _i < 2; ++_i) \
        __builtin_amdgcn_global_load_lds((const unsigned*)((const char*)(gbase) + (voff)[_i]), (PG8_LAS unsigned*)(lds + (bufoff) + ldsw + _i * 8192), 16, 0, 0); } while (0)
#define PG8_LDA(dst, b, h) do { _Pragma("unroll") for (int m = 0; m < 4; ++m) _Pragma("unroll") for (int k = 0; k < 2; ++k) dst[m][k] = *(const PG8_LAS bf16x8*)(lds + PG8_SA(b, h) + aoff + m * 2048 + k * 1024); } while (0)
#define PG8_LDB(dst, b, h) do { _Pragma("unroll") for (int n = 0; n < 2; ++n) _Pragma("unroll") for (int k = 0; k < 2; ++k) dst[n][k] = *(const PG8_LAS bf16x8*)(lds + PG8_SB(b, h) + boff + n * 2048 + k * 1024); } while (0)
#define PG8_MMA(ai, bj, At, Bt) do { __builtin_amdgcn_s_setprio(1); _Pragma("unroll") for (int m = 0; m < 4; ++m) _Pragma("unroll") for (int n = 0; n < 2; ++n) _Pragma("unroll") for (int k = 0; k < 2; ++k) \
        acc[ai][bj][m][n] = __builtin_amdgcn_mfma_f32_16x16x32_f16(__builtin_bit_cast(h16::f16x8_t, Bt[n][k]), __builtin_bit_cast(h16::f16x8_t, At[m][k]), acc[ai][bj][m][n], 0, 0, 0); __builtin_amdgcn_s_setprio(0); } while (0)
#define PG8_WAIT_V(n) asm volatile("s_waitcnt vmcnt(" #n ")" ::: "memory")
#define PG8_WAIT_L(n) asm volatile("s_waitcnt lgkmcnt(" #n ")" ::: "memory")
#define PG8_BAR __builtin_amdgcn_s_barrier()
#define PG8_SCHED __builtin_amdgcn_sched_barrier(0)
    Unit cur, nxt; int ui = 0;
    if (!S.next(0, cur)) return;
    Acc acc;
#pragma unroll
    for (int a = 0; a < 2; ++a)
#pragma unroll
        for (int b = 0; b < 2; ++b)
#pragma unroll
            for (int m = 0; m < 4; ++m)
#pragma unroll
                for (int n = 0; n < 2; ++n) acc[a][b][m][n] = (f32x4){0.f, 0.f, 0.f, 0.f};
    bf16x8 At[4][2], B0[2][2], B1[2][2];
    const char* cA = S.a_ptr(cur); const char* cB = S.b_ptr(cur);
    if constexpr (Epi::MID_T > 0) E.pre(cur, lds, tid);
    PG8_STAGE(PG8_SB(0, 0), cB, voffB); PG8_STAGE(PG8_SB(0, 1), cB + hstepB, voffB); PG8_STAGE(PG8_SA(0, 0), cA, voffA); PG8_STAGE(PG8_SA(0, 1), cA + hstepA, voffA);
    if (wr == 1) PG8_BAR;
    PG8_WAIT_V(2); PG8_BAR;
    PG8_STAGE(PG8_SB(1, 0), cB + kstep, voffB); PG8_STAGE(PG8_SA(1, 0), cA + kstep, voffA); PG8_STAGE(PG8_SB(1, 1), cB + hstepB + kstep, voffB);
    PG8_WAIT_V(6); PG8_BAR;
    for (;;) {
        const bool has_next = S.next(ui + 1, nxt);
        const char* nA = has_next ? S.a_ptr(nxt) : cA; const char* nB = has_next ? S.b_ptr(nxt) : cB;
        for (int t = 0; t < nt; t += 2) {
            if constexpr (Epi::MID_T > 0) { if (t == Epi::MID_T) E.mid(acc, lds, wr, fr); }
            const bool last = (t == nt - 2);
            const char* a1 = cA + (size_t)(t + 1) * kstep;
            const char* a2 = last ? nA : cA + (size_t)(t + 2) * kstep; const char* b2 = last ? nB : cB + (size_t)(t + 2) * kstep;
            const char* a3 = a2 + kstep; const char* b3 = b2 + kstep;
            PG8_LDB(B0, 0, 0); PG8_LDB(B1, 0, 1); PG8_SCHED; PG8_LDA(At, 0, 0); PG8_STAGE(PG8_SA(1, 1), a1 + hstepA, voffA);
            PG8_WAIT_V(8); PG8_WAIT_L(0); PG8_BAR; PG8_MMA(0, 0, At, B0); PG8_MMA(0, 1, At, B1); PG8_BAR; PG8_SCHED;
            PG8_LDA(At, 0, 1); PG8_STAGE(PG8_SB(0, 0), b2, voffB); PG8_STAGE(PG8_SB(0, 1), b2 + hstepB, voffB); PG8_STAGE(PG8_SA(0, 0), a2, voffA);
            PG8_WAIT_V(8); PG8_WAIT_L(0); PG8_BAR; PG8_MMA(1, 0, At, B0); PG8_MMA(1, 1, At, B1); PG8_BAR; PG8_SCHED;
            PG8_LDB(B0, 1, 0); PG8_LDB(B1, 1, 1); PG8_SCHED; PG8_LDA(At, 1, 0); PG8_STAGE(PG8_SA(0, 1), a2 + hstepA, voffA);
            PG8_WAIT_V(8); PG8_WAIT_L(0); PG8_BAR; PG8_MMA(0, 0, At, B0); PG8_MMA(0, 1, At, B1); PG8_BAR; PG8_SCHED;
            PG8_LDA(At, 1, 1); PG8_STAGE(PG8_SB(1, 0), b3, voffB); PG8_STAGE(PG8_SB(1, 1), b3 + hstepB, voffB); PG8_STAGE(PG8_SA(1, 0), a3, voffA);
            PG8_WAIT_V(8); PG8_WAIT_L(0); PG8_BAR; PG8_MMA(1, 0, At, B0); PG8_MMA(1, 1, At, B1); PG8_BAR; PG8_SCHED;
        }
        if (wr == 0) PG8_BAR;
        E(acc, cur, wr, wc, fr, fq);
        if (!has_next) break;
#pragma unroll
        for (int a = 0; a < 2; ++a)
#pragma unroll
            for (int b = 0; b < 2; ++b)
#pragma unroll
                for (int m = 0; m < 4; ++m)
#pragma unroll
                    for (int n = 0; n < 2; ++n) acc[a][b][m][n] = (f32x4){0.f, 0.f, 0.f, 0.f};
        cur = nxt; cA = nA; cB = nB; ++ui;
        if (wr == 1) PG8_BAR;
    }
    PG8_WAIT_V(0);
    PG8_BAR;
#undef PG8_SA
#undef PG8_SB
#undef PG8_STAGE
#undef PG8_LDA
#undef PG8_LDB
#undef PG8_MMA
#undef PG8_WAIT_V
#undef PG8_WAIT_L
#undef PG8_BAR
#undef PG8_SCHED
}
}
namespace epi {
#define PG8_LAS __attribute__((address_space(3)))
using pg8::Acc; using pg8::Unit; using pg8::f32x4; using pg8::u32x4; using pg8::bf16_t; using pg8::cvt_pk_bf16; using pg8::fast_silu;
constexpr int HALF = 128;
constexpr float C2 = 0.125f * 1.4426950408889634f;
constexpr float KSC = 0.08838834764831845f;

__device__ __forceinline__ u32x4 pack8(const f32x4 v0, const f32x4 v1) { u32x4 w; w.x = cvt_pk_bf16(v0[0], v0[1]); w.y = cvt_pk_bf16(v0[2], v0[3]); w.z = cvt_pk_bf16(v1[0], v1[1]); w.w = cvt_pk_bf16(v1[2], v1[3]); return w; }

struct EpiInProj {
    static constexpr bool PERM = true; static constexpr int MID_T = 0;
    bf16_t* O; size_t gstride;
    float* KMP;
    const float* ROPE;
    __device__ __forceinline__ void operator()(const Acc& acc, const Unit& u, int wr, int wc, int fr, int fq) const {
        const int grp = u.pn >> 1;
        const int col0 = (u.pn & 1) * 256 + wc * 32 + 8 * fq;
        const int row0 = u.pm * 256 + wr * 64 + fr;
        bf16_t* base = O + (size_t)grp * gstride;
        f32x4 cs[2][2];
#pragma unroll
        for (int bj = 0; bj < 2; ++bj) { cs[bj][0] = (f32x4){0.f, 0.f, 0.f, 0.f}; cs[bj][1] = (f32x4){0.f, 0.f, 0.f, 0.f}; }
#pragma unroll
        for (int ai = 0; ai < 2; ++ai)
#pragma unroll
            for (int m = 0; m < 4; ++m) {
                const int row = row0 + ai * HALF + m * 16;
                bf16_t* rowp = base + (size_t)row * 512 + col0;
                f32x4 t0 = (f32x4){0.f, 0.f, 0.f, 0.f}, t1 = t0;
                if (grp == 3 || grp == 4) { const float* tp = ROPE + ((size_t)(row & 2047) * 64 + 16 * wc + 4 * fq) * 2; t0 = *(const f32x4*)tp; t1 = *(const f32x4*)(tp + 4); }
#pragma unroll
                for (int bj = 0; bj < 2; ++bj) {
                    f32x4 v0 = acc[ai][bj][m][0], v1 = acc[ai][bj][m][1];
                    if (grp == 0) { v0 = v0 * C2; v1 = v1 * C2; }
                    else if (grp == 1) { cs[bj][0] += v0; cs[bj][1] += v1; }
                    else if (grp == 3 || grp == 4) {
                        const float sc = (grp == 4) ? KSC : 1.0f;
                        f32x4 r0, r1;
                        r0[0] = (v0[0] * t0[0] - v0[1] * t0[1]) * sc; r0[1] = (v0[0] * t0[1] + v0[1] * t0[0]) * sc;
                        r0[2] = (v0[2] * t0[2] - v0[3] * t0[3]) * sc; r0[3] = (v0[2] * t0[3] + v0[3] * t0[2]) * sc;
                        r1[0] = (v1[0] * t1[0] - v1[1] * t1[1]) * sc; r1[1] = (v1[0] * t1[1] + v1[1] * t1[0]) * sc;
                        r1[2] = (v1[2] * t1[2] - v1[3] * t1[3]) * sc; r1[3] = (v1[2] * t1[3] + v1[3] * t1[2]) * sc;
                        v0 = r0; v1 = r1;
                    } else if (grp == 6) {
#pragma unroll
                        for (int j = 0; j < 4; ++j) { v0[j] = fast_silu(v0[j]); v1[j] = fast_silu(v1[j]); }
                    }
                    *(u32x4*)(rowp + bj * HALF) = pack8(v0, v1);
                }
            }
        if (grp == 1) {
#pragma unroll
            for (int bj = 0; bj < 2; ++bj)
#pragma unroll
                for (int n = 0; n < 2; ++n) {
                    f32x4 s = cs[bj][n];
#pragma unroll
                    for (int o = 1; o < 16; o <<= 1) { s[0] += __shfl_xor(s[0], o); s[1] += __shfl_xor(s[1], o); s[2] += __shfl_xor(s[2], o); s[3] += __shfl_xor(s[3], o); }
                    if (fr == 0) *(f32x4*)(KMP + (size_t)(u.pm * 2 + wr) * 512 + col0 + bj * HALF + 4 * n) = s;
                }
        }
    }
};

struct EpiOutProj {
    static constexpr bool PERM = false; static constexpr int MID_T = 8;
    const float* xin; float* out; const float* g1;
    const float* assq;
    bool dry;
    static constexpr int RS_OFF = 131072 + 8192;
    __device__ __forceinline__ void pre(const Unit& u, PG8_LAS unsigned char* lds, int tid) const {
        if (tid < 256) { const int row = u.pm * 256 + tid;
            const f32x4 a = *(const f32x4*)(assq + (size_t)row * 8), c = *(const f32x4*)(assq + (size_t)row * 8 + 4);
            const float ss = ((a[0] + a[1]) + (a[2] + a[3])) + ((c[0] + c[1]) + (c[2] + c[3]));
            ((PG8_LAS float*)(lds + RS_OFF))[tid] = 1.0f / sqrtf(ss * (1.0f / 512.0f) + 1e-6f); }
    }
    __device__ __forceinline__ void mid(Acc& acc, PG8_LAS unsigned char* lds, int wr, int fr) const {
        const PG8_LAS float* tab = (const PG8_LAS float*)(lds + RS_OFF) + wr * 64 + fr;
#pragma unroll
        for (int ai = 0; ai < 2; ++ai)
#pragma unroll
            for (int m = 0; m < 4; ++m) {
                const float rs = tab[ai * HALF + m * 16];
#pragma unroll
                for (int bj = 0; bj < 2; ++bj)
#pragma unroll
                    for (int n = 0; n < 2; ++n) acc[ai][bj][m][n] = acc[ai][bj][m][n] * rs;
            }
    }
    __device__ __forceinline__ void operator()(const Acc& acc, const Unit& u, int wr, int wc, int fr, int fq) const {
        const int b = u.pm >> 3;
        const int col0 = u.pn * 256 + wc * 32 + 4 * fq;
        const int row0 = u.pm * 256 + wr * 64 + fr;
        f32x4 gv[2][2];
#pragma unroll
        for (int bj = 0; bj < 2; ++bj)
#pragma unroll
            for (int n = 0; n < 2; ++n) gv[bj][n] = *(const f32x4*)(g1 + (size_t)b * 6144 + col0 + bj * HALF + n * 16);
#pragma unroll
        for (int ai = 0; ai < 2; ++ai)
#pragma unroll
            for (int m = 0; m < 4; ++m) {
                const size_t off = (size_t)(row0 + ai * HALF + m * 16) * 1024 + col0;
#pragma unroll
                for (int bj = 0; bj < 2; ++bj)
#pragma unroll
                    for (int n = 0; n < 2; ++n) { const f32x4 bs = *(const f32x4*)(xin + off + bj * HALF + n * 16); const f32x4 r = bs + gv[bj][n] * acc[ai][bj][m][n]; if (!dry) *(f32x4*)(out + off + bj * HALF + n * 16) = r; else asm volatile("" :: "v"(r)); }
            }
    }
};

struct EpiSwiGLU {
    static constexpr bool PERM = true; static constexpr int MID_T = 0;
    bf16_t* H; int ldh;
    __device__ __forceinline__ void operator()(const Acc& acc, const Unit& u, int wr, int wc, int fr, int fq) const {
        const int col0 = u.pn * 128 + wc * 32 + 8 * fq;
        const int row0 = u.pm * 256 + wr * 64 + fr;
#pragma unroll
        for (int ai = 0; ai < 2; ++ai)
#pragma unroll
            for (int m = 0; m < 4; ++m) {
                const int row = row0 + ai * HALF + m * 16;
                f32x4 v0, v1;
#pragma unroll
                for (int j = 0; j < 4; ++j) { v0[j] = fast_silu(acc[ai][0][m][0][j]) * acc[ai][1][m][0][j]; v1[j] = fast_silu(acc[ai][0][m][1][j]) * acc[ai][1][m][1][j]; }
                *(u32x4*)(H + (size_t)row * ldh + col0) = pack8(v0, v1);
            }
    }
};

struct EpiDown {
    static constexpr bool PERM = false; static constexpr int MID_T = 0;
    float* out; const float* g2; bf16_t* YS; const int* srow; const float* swt; bool moe; bool dry; int* atomf; bool atomic; float* slab; int KS;
    __device__ __forceinline__ void operator()(const Acc& acc, const Unit& u, int wr, int wc, int fr, int fq) const {
        const int col0 = u.pn * 256 + wc * 32 + 4 * fq;
        const int row0 = u.pm * 256 + wr * 64 + fr;
        if (!moe) {
            const int b = u.pm >> 3;
            f32x4 gv[2][2];
#pragma unroll
            for (int bj = 0; bj < 2; ++bj)
#pragma unroll
                for (int n = 0; n < 2; ++n) gv[bj][n] = *(const f32x4*)(g2 + (size_t)b * 6144 + col0 + bj * HALF + n * 16);
#pragma unroll
            for (int ai = 0; ai < 2; ++ai)
#pragma unroll
                for (int m = 0; m < 4; ++m) {
                    const size_t off = (size_t)(row0 + ai * HALF + m * 16) * 1024 + col0;
#pragma unroll
                    for (int bj = 0; bj < 2; ++bj)
#pragma unroll
                        for (int n = 0; n < 2; ++n) { const f32x4 bs = *(const f32x4*)(out + off + bj * HALF + n * 16); const f32x4 r = bs + gv[bj][n] * acc[ai][bj][m][n]; if (!dry) *(f32x4*)(out + off + bj * HALF + n * 16) = r; else asm volatile("" :: "v"(r)); }
                }
        } else if (atomic) {
            float* sl = slab + ((size_t)(u.li * KS + u.kc) * 256) * 256 + (wc * 32 + 4 * fq);
#pragma unroll
            for (int ai = 0; ai < 2; ++ai)
#pragma unroll
                for (int m = 0; m < 4; ++m) {
                    const int rl = ai * HALF + wr * 64 + m * 16 + fr; const int pos = u.pm * 256 + rl;
                    const int sr = srow[pos];
                    if (sr >= 0) { const float w = swt[pos];
                        if (u.kc == 0 && wc == 0 && fq == 0) atomf[sr * 4 + u.pn] = 1 + u.li * 256 + rl;
#pragma unroll
                        for (int bj = 0; bj < 2; ++bj)
#pragma unroll
                            for (int n = 0; n < 2; ++n) *(f32x4*)(sl + (size_t)rl * 256 + bj * HALF + n * 16) = acc[ai][bj][m][n] * w; }
                }
        } else {
#pragma unroll
            for (int ai = 0; ai < 2; ++ai)
#pragma unroll
                for (int m = 0; m < 4; ++m) {
                    const int pos = row0 + ai * HALF + m * 16;
                    const int sr = srow[pos];
                    if (sr >= 0) { const float w = swt[pos]; bf16_t* rowp = YS + (size_t)sr * 1024 + col0;
#pragma unroll
                        for (int bj = 0; bj < 2; ++bj)
#pragma unroll
                            for (int n = 0; n < 2; ++n) { const f32x4 v = acc[ai][bj][m][n] * w; pg8::u32x2 o; o.x = cvt_pk_bf16(v[0], v[1]); o.y = cvt_pk_bf16(v[2], v[3]); if (!dry) *(pg8::u32x2*)(rowp + bj * HALF + n * 16) = o; else asm volatile("" :: "v"(o)); } }
                }
        }
    }
};
}
namespace fa {
#define FA_LAS __attribute__((address_space(3)))
typedef unsigned short bf16_t;
typedef short bf16x8 __attribute__((ext_vector_type(8)));
typedef short s16x4 __attribute__((ext_vector_type(4)));
typedef float f32x16 __attribute__((ext_vector_type(16)));
typedef float f32x4 __attribute__((ext_vector_type(4)));
typedef unsigned u32x4 __attribute__((ext_vector_type(4)));
typedef float f32x2_t __attribute__((ext_vector_type(2))); typedef __bf16 bf16x2_t __attribute__((ext_vector_type(2)));
constexpr int L_WSF = 131072 + 1024, L_KM = L_WSF + 2048;
constexpr float NEG = -1.0e30f;
__device__ __forceinline__ int crow(int r, int hi) { return (r & 3) + 8 * (r >> 2) + 4 * hi; }
__device__ __forceinline__ void glds16(const void* gsrc, unsigned lds_dst) { unsigned keep;
    asm volatile("s_mov_b32 %0, m0\n\ts_mov_b32 m0, %2\n\ts_nop 0\n\tglobal_load_lds_dwordx4 %1, off\n\ts_mov_b32 m0, %0" : "=&s"(keep) : "v"(gsrc), "s"(lds_dst) : "memory"); }
__device__ __forceinline__ unsigned cvtpk_s(float lo, float hi) { return h16::pk(lo, hi); }
__device__ __forceinline__ float bf2f(short s) { return h16::one((unsigned short)s); }
typedef short v4i16_t __attribute__((ext_vector_type(4)));
__device__ __forceinline__ s16x4 vtr(FA_LAS const unsigned char* p) { return __builtin_bit_cast(s16x4, __builtin_amdgcn_ds_read_tr16_b64_v4i16((FA_LAS v4i16_t*)p)); }
#define FA_WAIT_BAR() asm volatile("s_waitcnt vmcnt(0) lgkmcnt(0)\n\ts_barrier" ::: "memory")
#define FA_LBAR() asm volatile("s_waitcnt lgkmcnt(0)\n\ts_barrier" ::: "memory")

struct Tensors {
    const bf16_t* Q; const bf16_t* K; const bf16_t* V;
    bf16_t* CAT;
    float* ASSQ;
    const float* KMP;
    const bf16_t* GR;
    const float* ret_g;
    const float* KVM;
};

template <bool RET>
__device__ __forceinline__ void attn_unit(int b, int h, int qblk, const Tensors& T, FA_LAS unsigned char* shm) {
    constexpr int NS = RET ? 3 : 4, DIST = NS - 1;
    constexpr int DH = RET ? 128 : 64, ND0 = DH / 16, NDB = DH / 32, NPC = DH / 64, SLOT = 64 * DH * 2, L_K = 0, L_V = NS * SLOT, PER = 2 * NPC, L_R = 98304;
    int tid_ = threadIdx.x; asm volatile("" : "+v"(tid_));
    const int tid = tid_, lane = tid & 63, r32 = lane & 31, hi = lane >> 5; const int wid = __builtin_amdgcn_readfirstlane(tid >> 6);
    const size_t rowbase = (size_t)b * 2048; const int q0 = qblk * 256;
    const unsigned lds0 = (unsigned)(unsigned long)shm;
    FA_LAS float* wsf = (FA_LAS float*)(shm + L_WSF) + wid * 64;
    FA_LAS float* KM = (FA_LAS float*)(shm + L_KM);
    const bf16_t* Kh = T.K + rowbase * 512 + h * DH; const bf16_t* Vh = T.V + rowbase * 512 + h * DH;
    const int NT = RET ? 4 : 4 * (qblk + 1);
#define FA_KV0(i) ((((i) < 4) ? qblk : (qblk - 1 - (((i) - 4) >> 2))) * 256 + ((i) & 3) * 64)
#define FA_DMA(i) do { const int kv0_ = FA_KV0(i); const unsigned so_ = (unsigned)(((i) % NS) * SLOT); \
        _Pragma("unroll") for (int pp = 0; pp < NPC; ++pp) { const int p = wid + 8 * pp; \
            glds16(Kh + (size_t)(kv0_ + lane) * 512 + p * 8, (unsigned)__builtin_amdgcn_readfirstlane(lds0 + L_K + so_ + p * 1024)); } \
        _Pragma("unroll") for (int pp = 0; pp < NPC; ++pp) { const int p = wid + 8 * pp; \
            glds16(Vh + (size_t)(kv0_ + 16 * (p & 3) + (lane >> 2)) * 512 + (p >> 2) * 32 + (lane & 3) * 8, (unsigned)__builtin_amdgcn_readfirstlane(lds0 + L_V + so_ + p * 1024)); } } while (0)
    FA_DMA(0); if (NT > 1) FA_DMA(1); if (DIST > 2 && NT > 2) FA_DMA(2);
    const bf16_t* Qw = T.Q + (rowbase + q0 + wid * 32 + r32) * 512 + h * DH;
    bf16x8 qr[ND0];
#pragma unroll
    for (int d0 = 0; d0 < ND0; ++d0) qr[d0] = *(const bf16x8*)(Qw + d0 * 16 + hi * 8);
    unsigned selmask = 0xffu;
    float cfac[16]; float lg2 = 0.f;
    if (!RET) {
        { const int j = tid >> 6, d = tid & 63; const float* kp = T.KMP + ((size_t)(b * 8 + j) * 2) * 512 + h * 64 + d; KM[tid] = kp[0] + kp[512]; }
        FA_LBAR();
        float g[8];
#pragma unroll
        for (int j = 0; j < 8; ++j) g[j] = 0.f;
#pragma unroll
        for (int d0 = 0; d0 < ND0; ++d0)
#pragma unroll
            for (int jj = 0; jj < 8; ++jj) { const float qv = bf2f(qr[d0][jj]); const int d = 16 * d0 + 8 * hi + jj;
#pragma unroll
                for (int j = 0; j < 8; ++j) g[j] += qv * KM[j * 64 + d]; }
#pragma unroll
        for (int j = 0; j < 8; ++j) g[j] += __shfl_xor(g[j], 32);
        selmask = 0u;
#pragma unroll
        for (int j = 0; j < 8; ++j) { int rank = 0;
#pragma unroll
            for (int mm = 0; mm < 8; ++mm) rank += (mm < qblk && (g[mm] > g[j] || (g[mm] == g[j] && mm < j))) ? 1 : 0;
            if (j < qblk && rank < 3) selmask |= 1u << j; }
    } else {
        lg2 = log2f(1.0f - exp2f(-5.0f - (float)h));
#pragma unroll
        for (int r = 0; r < 16; ++r) cfac[r] = exp2f(-lg2 * (float)((r & 3) + 8 * (r >> 2)));
    }
    f32x16 o[NDB];
#pragma unroll
    for (int db = 0; db < NDB; ++db) o[db] = f32x16{};
    float mhat = 0.f, lrow = 0.f; f32x16 negm = f32x16{}; constexpr float THR = 8.0f;
    if (RET && qblk > 0) {
        const float* kvb = T.KVM + ((size_t)(b * 4 + h) * 8) * 16384;
        const float g256 = exp2f(lg2 * 256.0f);
#pragma unroll 2
        for (int it = 0; it < 8; ++it) { const int idx4 = tid + 512 * it; const int d = idx4 >> 5, e0 = (idx4 & 31) * 4;
            f32x4 acc4 = (f32x4){0.f, 0.f, 0.f, 0.f};
            for (int m = 0; m < qblk; ++m) acc4 = acc4 * g256 + *(const f32x4*)(kvb + (size_t)m * 16384 + d * 128 + e0);
            const int rp = (d & ~12) | ((d & 8) >> 1) | ((d & 4) << 1);
            typedef unsigned u32x2_ __attribute__((ext_vector_type(2)));
            u32x2_ w; w.x = cvtpk_s(acc4[0], acc4[1]); w.y = cvtpk_s(acc4[2], acc4[3]);
            *(FA_LAS u32x2_*)(shm + L_R + (e0 >> 5) * 8192 + rp * 64 + (e0 & 31) * 2) = w; }
        FA_LBAR();
        { FA_LAS const unsigned char* rb = shm + L_R + ((lane >> 4) & 1) * 32 + (lane & 3) * 8 + (4 * hi + ((lane & 15) >> 2)) * 64;
#pragma unroll
          for (int db = 0; db < NDB; ++db)
#pragma unroll
              for (int d0 = 0; d0 < ND0; ++d0) { const s16x4 lo = vtr(rb + db * 8192 + d0 * 1024), hh = vtr(rb + db * 8192 + d0 * 1024 + 512);
                  const bf16x8 rf = (bf16x8){lo[0], lo[1], lo[2], lo[3], hh[0], hh[1], hh[2], hh[3]};
                  o[db] = __builtin_amdgcn_mfma_f32_32x32x16_f16(__builtin_bit_cast(h16::f16x8_t, qr[d0]), __builtin_bit_cast(h16::f16x8_t, rf), o[db], 0, 0, 0); } }
#pragma unroll
        for (int r = 0; r < 16; ++r) { const float rd = exp2f(lg2 * (float)(wid * 32 + crow(r, hi) + 1));
#pragma unroll
            for (int db = 0; db < NDB; ++db) o[db][r] *= rd; }
    }
    const int qrel = wid * 32 + r32;
    for (int i = 0; i < NT; ++i) {
        { const int ahead = (NT - 1 - i) < (DIST - 1) ? (NT - 1 - i) : (DIST - 1);
          if (ahead == 2) { if (PER == 2) asm volatile("s_waitcnt vmcnt(4) lgkmcnt(0)\n\ts_barrier" ::: "memory"); else asm volatile("s_waitcnt vmcnt(8) lgkmcnt(0)\n\ts_barrier" ::: "memory"); }
          else if (ahead == 1) { if (PER == 2) asm volatile("s_waitcnt vmcnt(2) lgkmcnt(0)\n\ts_barrier" ::: "memory"); else asm volatile("s_waitcnt vmcnt(4) lgkmcnt(0)\n\ts_barrier" ::: "memory"); }
          else FA_WAIT_BAR(); }
        if (i + DIST < NT) FA_DMA(i + DIST);
        const bool diag = i < 4; const int t = i & 3; const int j = diag ? qblk : (qblk - 1 - ((i - 4) >> 2));
        const bool mysel = RET ? true : (((selmask >> j) & 1u) != 0u);
        const bool skip = diag ? (64 * t > 32 * wid + 31) : (RET ? false : !__any(mysel));
        if (skip) continue;
        const unsigned so = (unsigned)((i % NS) * SLOT);
        f32x16 p0 = RET ? f32x16{} : negm, p1 = p0;
        { FA_LAS const unsigned char* kb = shm + L_K + so + hi * 1024 + r32 * 16;
#pragma unroll
          for (int d0 = 0; d0 < ND0; ++d0) { const bf16x8 b0 = *(FA_LAS const bf16x8*)(kb + d0 * 2048); const bf16x8 b1 = *(FA_LAS const bf16x8*)(kb + d0 * 2048 + 512);
              p0 = __builtin_amdgcn_mfma_f32_32x32x16_f16(__builtin_bit_cast(h16::f16x8_t, b0), __builtin_bit_cast(h16::f16x8_t, qr[d0]), p0, 0, 0, 0); p1 = __builtin_amdgcn_mfma_f32_32x32x16_f16(__builtin_bit_cast(h16::f16x8_t, b1), __builtin_bit_cast(h16::f16x8_t, qr[d0]), p1, 0, 0, 0); } }
        if (RET) {
            const int qpos = q0 + qrel; const int kv0 = j * 256 + t * 64;
            const float base = (float)(qpos - kv0 - 4 * hi);
            const float rf0 = exp2f(lg2 * base), rf1 = exp2f(lg2 * (base - 32.0f));
#pragma unroll
            for (int r = 0; r < 16; ++r) { p0[r] *= rf0 * cfac[r]; p1[r] *= rf1 * cfac[r]; }
            if (diag) { const int kb_ = 64 * t + 4 * hi;
#pragma unroll
                for (int r = 0; r < 16; ++r) { const int kv = kb_ + (r & 3) + 8 * (r >> 2); if (kv > qrel) p0[r] = 0.f; if (kv + 32 > qrel) p1[r] = 0.f; } }
        } else {
            if (diag) { const int kb_ = 64 * t + 4 * hi;
#pragma unroll
                for (int r = 0; r < 16; ++r) { const int kv = kb_ + (r & 3) + 8 * (r >> 2); if (kv > qrel) p0[r] = NEG; if (kv + 32 > qrel) p1[r] = NEG; } }
            else if (!mysel) {
#pragma unroll
                for (int r = 0; r < 16; ++r) { p0[r] = NEG; p1[r] = NEG; } }
            float rm = fmaxf(fmaxf(p0[0], p1[0]), p0[1]);
#pragma unroll
            for (int r = 1; r < 16; ++r) { rm = fmaxf(fmaxf(rm, p1[r]), (r < 15) ? p0[r + 1] : p1[r]); }
            rm = fmaxf(rm, __shfl_xor(rm, 32));
            if (__any(rm > THR)) {
                const float dl = fmaxf(rm, 0.f);
                mhat += dl;
#pragma unroll
                for (int r = 0; r < 16; ++r) { p0[r] -= dl; p1[r] -= dl; }
#pragma unroll
                for (int r = 0; r < 16; ++r) negm[r] = -mhat;
                const float f = __builtin_amdgcn_exp2f(-dl); lrow *= f;
                asm volatile("" ::: "memory");
                if (hi == 0) wsf[r32] = f;
                asm volatile("s_waitcnt lgkmcnt(0)" ::: "memory");
#pragma unroll
                for (int r = 0; r < 16; ++r) { const float fr_ = wsf[crow(r, hi)];
#pragma unroll
                    for (int db = 0; db < NDB; ++db) o[db][r] *= fr_; }
                asm volatile("s_waitcnt lgkmcnt(0)" ::: "memory");
            }
            float s = 0.f;
#pragma unroll
            for (int r = 0; r < 16; ++r) { p0[r] = __builtin_amdgcn_exp2f(p0[r]); p1[r] = __builtin_amdgcn_exp2f(p1[r]); s += p0[r] + p1[r]; }
            lrow += s;
        }
        bf16x8 pa[4];
        { u32x4 w;
          w.x = cvtpk_s(p0[0], p0[1]); w.y = cvtpk_s(p0[2], p0[3]); w.z = cvtpk_s(p0[4], p0[5]); w.w = cvtpk_s(p0[6], p0[7]); pa[0] = __builtin_bit_cast(bf16x8, w);
          w.x = cvtpk_s(p0[8], p0[9]); w.y = cvtpk_s(p0[10], p0[11]); w.z = cvtpk_s(p0[12], p0[13]); w.w = cvtpk_s(p0[14], p0[15]); pa[1] = __builtin_bit_cast(bf16x8, w);
          w.x = cvtpk_s(p1[0], p1[1]); w.y = cvtpk_s(p1[2], p1[3]); w.z = cvtpk_s(p1[4], p1[5]); w.w = cvtpk_s(p1[6], p1[7]); pa[2] = __builtin_bit_cast(bf16x8, w);
          w.x = cvtpk_s(p1[8], p1[9]); w.y = cvtpk_s(p1[10], p1[11]); w.z = cvtpk_s(p1[12], p1[13]); w.w = cvtpk_s(p1[14], p1[15]); pa[3] = __builtin_bit_cast(bf16x8, w); }
        { FA_LAS const unsigned char* vb = shm + L_V + so + ((lane >> 4) & 1) * 32 + (lane & 3) * 8 + (4 * hi + ((lane & 15) >> 2)) * 64;
#pragma unroll
          for (int db = 0; db < NDB; ++db)
#pragma unroll
              for (int ks = 0; ks < 4; ++ks) { const s16x4 lo = vtr(vb + db * 4096 + ks * 1024), hh = vtr(vb + db * 4096 + ks * 1024 + 512);
                  const bf16x8 vf = (bf16x8){lo[0], lo[1], lo[2], lo[3], hh[0], hh[1], hh[2], hh[3]};
                  o[db] = __builtin_amdgcn_mfma_f32_32x32x16_f16(__builtin_bit_cast(h16::f16x8_t, pa[ks]), __builtin_bit_cast(h16::f16x8_t, vf), o[db], 0, 0, 0); } }
    }
    float rli[16];
    if (!RET) {
        const float l = lrow + __shfl_xor(lrow, 32);
        asm volatile("" ::: "memory");
        if (hi == 0) wsf[32 + r32] = 1.0f / l;
        asm volatile("s_waitcnt lgkmcnt(0)" ::: "memory");
#pragma unroll
        for (int r = 0; r < 16; ++r) rli[r] = wsf[32 + crow(r, hi)];
    } else {
#pragma unroll
        for (int r = 0; r < 16; ++r) rli[r] = 1.0f;
    }
    FA_LBAR();
    FA_LAS bf16_t* stg = (FA_LAS bf16_t*)(shm + wid * 8192);
#pragma unroll
    for (int r = 0; r < 16; ++r) { const int orow = crow(r, hi);
#pragma unroll
        for (int db = 0; db < NDB; ++db) { const unsigned pk = cvtpk_s(o[db][r] * rli[r], 0.f); stg[orow * DH + db * 32 + r32] = (bf16_t)(pk & 0xffffu); } }
    asm volatile("s_waitcnt lgkmcnt(0)" ::: "memory");
    const size_t tok0 = rowbase + q0 + wid * 32;
    if (!RET) {
#pragma unroll
        for (int i = 0; i < 4; ++i) { const int row = i * 8 + (lane >> 3), ch = lane & 7;
            const u32x4 v = *(FA_LAS const u32x4*)(stg + row * 64 + ch * 8);
            float ss = 0.f;
#pragma unroll
            for (int k = 0; k < 4; ++k) { const float a = h16::lo(v[k]), c = h16::hi(v[k]); ss += a * a + c * c; }
            ss += __shfl_xor(ss, 1); ss += __shfl_xor(ss, 2); ss += __shfl_xor(ss, 4);
            if (ch == 0) T.ASSQ[(tok0 + row) * 8 + h] = ss;
            *(u32x4*)(T.CAT + (tok0 + row) * 1024 + h * 64 + ch * 8) = v; }
    } else {
#pragma unroll
        for (int i = 0; i < 8; ++i) { const int row = i * 4 + (lane >> 4), ch = lane & 15;
            const u32x4 v = *(FA_LAS const u32x4*)(stg + row * 128 + ch * 8);
            float x[8];
#pragma unroll
            for (int k = 0; k < 4; ++k) { x[2 * k] = h16::lo(v[k]); x[2 * k + 1] = h16::hi(v[k]); }
            float ss = 0.f;
#pragma unroll
            for (int k = 0; k < 8; ++k) ss += x[k] * x[k];
            ss += __shfl_xor(ss, 1); ss += __shfl_xor(ss, 2); ss += __shfl_xor(ss, 4); ss += __shfl_xor(ss, 8);
            const float rs = 1.0f / sqrtf(ss * (1.0f / 128.0f) + 1e-6f);
            const u32x4 gv = *(const u32x4*)(T.GR + (tok0 + row) * 512 + h * 128 + ch * 8);
            const f32x4 w0 = *(const f32x4*)(T.ret_g + h * 128 + ch * 8), w1 = *(const f32x4*)(T.ret_g + h * 128 + ch * 8 + 4);
            const float wg[8] = {w0[0], w0[1], w0[2], w0[3], w1[0], w1[1], w1[2], w1[3]};
            float y[8];
#pragma unroll
            for (int k = 0; k < 4; ++k) { const float g0 = h16::lo(gv[k]), g1 = h16::hi(gv[k]);
                y[2 * k] = x[2 * k] * rs * wg[2 * k] * g0; y[2 * k + 1] = x[2 * k + 1] * rs * wg[2 * k + 1] * g1; }
            u32x4 ov; ov.x = cvtpk_s(y[0], y[1]); ov.y = cvtpk_s(y[2], y[3]); ov.z = cvtpk_s(y[4], y[5]); ov.w = cvtpk_s(y[6], y[7]);
            *(u32x4*)(T.CAT + (tok0 + row) * 1024 + 512 + h * 128 + ch * 8) = ov; }
    }
    FA_LBAR();
#undef FA_KV0
#undef FA_DMA
}

__device__ __forceinline__ void kv_unit(int b, int h, int m, const bf16_t* Kg, const bf16_t* Vg, float* KVM, FA_LAS unsigned char* shm) {
    constexpr int SLOT = 16384, L_K = 0, L_V = 4 * SLOT;
    int tid_ = threadIdx.x; asm volatile("" : "+v"(tid_));
    const int tid = tid_, lane = tid & 63, r32 = lane & 31, hi = lane >> 5; const int wid = __builtin_amdgcn_readfirstlane(tid >> 6);
    const int dg = wid >> 1, eh = wid & 1;
    const size_t rowbase = (size_t)b * 2048 + (size_t)m * 256;
    const unsigned lds0 = (unsigned)(unsigned long)shm;
    const bf16_t* Kh = Kg + rowbase * 512 + h * 128; const bf16_t* Vh = Vg + rowbase * 512 + h * 128;
#pragma unroll
    for (int t = 0; t < 4; ++t)
#pragma unroll
        for (int pp = 0; pp < 2; ++pp) { const int p = wid + 8 * pp; const size_t off = (size_t)(64 * t + 16 * (p & 3) + (lane >> 2)) * 512 + (p >> 2) * 32 + (lane & 3) * 8;
            glds16(Kh + off, (unsigned)__builtin_amdgcn_readfirstlane(lds0 + L_K + t * SLOT + p * 1024));
            glds16(Vh + off, (unsigned)__builtin_amdgcn_readfirstlane(lds0 + L_V + t * SLOT + p * 1024)); }
    const float lg2 = log2f(1.0f - exp2f(-5.0f - (float)h));
    const float g64 = exp2f(lg2 * 64.0f);
    h16::f16x8_t fd[4];
#pragma unroll
    for (int ks = 0; ks < 4; ++ks)
#pragma unroll
        for (int j = 0; j < 8; ++j) fd[ks][j] = (_Float16)exp2f(lg2 * (float)(63 - (16 * ks + 8 * (j >> 2) + 4 * hi + (j & 3))));
    f32x16 acc[2]; acc[0] = f32x16{}; acc[1] = f32x16{};
    FA_WAIT_BAR();
    const int lb = ((lane >> 4) & 1) * 32 + (lane & 3) * 8 + (4 * hi + ((lane & 15) >> 2)) * 64;
#pragma unroll
    for (int t = 0; t < 4; ++t) {
        if (t > 0) {
#pragma unroll
            for (int r = 0; r < 16; ++r) { acc[0][r] *= g64; acc[1][r] *= g64; } }
        FA_LAS const unsigned char* kb = shm + L_K + t * SLOT + dg * 4096 + lb; FA_LAS const unsigned char* vb = shm + L_V + t * SLOT + (2 * eh) * 4096 + lb;
#pragma unroll
        for (int ks = 0; ks < 4; ++ks) { const s16x4 klo = vtr(kb + ks * 1024), khi = vtr(kb + ks * 1024 + 512);
            const h16::f16x8_t kf = __builtin_bit_cast(h16::f16x8_t, (bf16x8){klo[0], klo[1], klo[2], klo[3], khi[0], khi[1], khi[2], khi[3]});
#pragma unroll
            for (int eb = 0; eb < 2; ++eb) { const s16x4 vlo = vtr(vb + eb * 4096 + ks * 1024), vhi = vtr(vb + eb * 4096 + ks * 1024 + 512);
                const h16::f16x8_t vf = __builtin_bit_cast(h16::f16x8_t, (bf16x8){vlo[0], vlo[1], vlo[2], vlo[3], vhi[0], vhi[1], vhi[2], vhi[3]}) * fd[ks];
                acc[eb] = __builtin_amdgcn_mfma_f32_32x32x16_f16(kf, vf, acc[eb], 0, 0, 0); } }
    }
    float* op = KVM + ((size_t)(b * 4 + h) * 8 + m) * 16384;
#pragma unroll
    for (int eb = 0; eb < 2; ++eb)
#pragma unroll
        for (int r = 0; r < 16; ++r) op[(size_t)(32 * dg + crow(r, hi)) * 128 + 64 * eh + 32 * eb + r32] = acc[eb][r];
    FA_LBAR();
}
}
namespace mk {
#define GAS __attribute__((address_space(1)))
#define LAS __attribute__((address_space(3)))
typedef unsigned short bf16;
typedef unsigned v4u __attribute__((ext_vector_type(4)));
typedef unsigned v2u __attribute__((ext_vector_type(2)));
typedef float f32x4 __attribute__((ext_vector_type(4)));
typedef int i32x4 __attribute__((ext_vector_type(4)));
typedef GAS unsigned gu32;
#define RLX_AGENT __ATOMIC_RELAXED, __HIP_MEMORY_SCOPE_AGENT
#define LDS_WAIT() asm volatile("s_waitcnt lgkmcnt(0)" ::: "memory")
#define VM_WAIT() asm volatile("s_waitcnt vmcnt(0)" ::: "memory")
constexpr int NWAVES = 8;
constexpr size_t MiB = 1u << 20, KiB = 1u << 10;
constexpr size_t WS_CTL = 0;
constexpr size_t CTL_ZERO_BYTES = 64 * KiB;
constexpr size_t WS_MOD = 64 * KiB;
constexpr size_t WS_KMP = 512 * KiB;
constexpr size_t WS_EIDX = 768 * KiB;
constexpr size_t WS_EW = 896 * KiB;
constexpr size_t WS_ROPE = 1 * MiB;
constexpr size_t WS_ASSQ = 2 * MiB;
constexpr size_t WS_SROW = 2 * MiB + 512 * KiB;
constexpr size_t WS_SWT = 2 * MiB + 768 * KiB;
constexpr size_t WS_WCNT = 3 * MiB;
constexpr size_t WS_SEG = 3 * MiB + 64 * KiB;
constexpr size_t WS_ATOMF = 3 * MiB + 128 * KiB;
constexpr size_t WS_SEGD = 3 * MiB + 65 * KiB;
constexpr size_t WS_MGU = 8 * MiB;
constexpr size_t WS_SLAB = 8 * MiB;
constexpr size_t WS_MDN = 96 * MiB;
constexpr size_t WS_XA = 140 * MiB;
constexpr size_t WS_XS = 172 * MiB;
constexpr size_t WS_KVM = 172 * MiB;
constexpr size_t WS_YS = 140 * MiB;
constexpr size_t WS_WIN = 240 * MiB;
constexpr size_t WS_WOUT = 254 * MiB;
constexpr size_t WS_FGU = 258 * MiB;
constexpr size_t WS_FDN = 269 * MiB;
constexpr size_t WS_QKV = 275 * MiB;
constexpr size_t WS_CAT = 387 * MiB;
constexpr size_t WS_HD = 275 * MiB;
constexpr size_t WS_HM = 240 * MiB;
constexpr size_t WS_END = 428 * MiB;
constexpr int XS_ROWS = 34816;
constexpr int CW_BAR = 1024;

constexpr int RING_BYTES = 131072, LDSCTL_OFF = RING_BYTES, MISC_OFF = LDSCTL_OFF + 320, LDS_BYTES = 147456;

#define XB_TMO      128
#define XB_XCNT(j)  (256  + 64 * (j))
#define XB_XSUB(j)  (1280 + 64 * (j))
#define XB_XGEN(j)  (2304 + 64 * (j))
#define XB_TOP      3328
#define XB_TOPGEN   3392
#define XCD_BAR_WORDS 3456
#define XB_SPIN_CAP (1u << 18)
__device__ __forceinline__ unsigned xb_ld(unsigned* p)              { return __hip_atomic_load(p, __ATOMIC_RELAXED, __HIP_MEMORY_SCOPE_AGENT); }
__device__ __forceinline__ unsigned xb_add(unsigned* p, unsigned v) { return __hip_atomic_fetch_add(p, v, __ATOMIC_RELAXED, __HIP_MEMORY_SCOPE_AGENT); }
__device__ __forceinline__ unsigned xb_xcc_id() { return (unsigned)__builtin_amdgcn_s_getreg((3 << 11) | 20) & 0xFu; }
#define XB_SPIN(cond, bar) do { unsigned _sp = 0; while (cond) { __builtin_amdgcn_s_sleep(1); \
    if ((++_sp & 255u) == 0u) { if (xb_ld(&(bar)[XB_TMO])) break; if (_sp > XB_SPIN_CAP) { atomicAdd(&(bar)[XB_TMO], 1u); break; } } } } while (0)
struct XcdBarrier { unsigned* bar; unsigned x; volatile LAS unsigned* st; };
__device__ __forceinline__ XcdBarrier xcd_barrier_post(unsigned* bar, volatile LAS unsigned* st) {
    XcdBarrier b; b.bar = bar; b.x = xb_xcc_id(); b.st = st;
    if (threadIdx.x == 0) (void)xb_add(&bar[XB_XCNT(b.x)], 1u);
    return b;
}
__device__ __forceinline__ void xcd_barrier_complete(unsigned* bar, unsigned x, unsigned& nloc, unsigned& nx) {
    const unsigned G = gridDim.x * gridDim.y * gridDim.z;
    unsigned sum, cnt, mine, sp = 0u;
    for (;;) {
        sum = 0u; cnt = 0u; mine = 0u;
#pragma unroll
        for (unsigned j = 0; j < 16; ++j) { const unsigned c = xb_ld(&bar[XB_XCNT(j)]); sum += c; cnt += (c > 0u) ? 1u : 0u; mine = (j == x) ? c : mine; }
        if (sum == G) break;
        __builtin_amdgcn_s_sleep(1);
        if ((++sp & 255u) == 0u) { if (xb_ld(&bar[XB_TMO])) break; if (sp > XB_SPIN_CAP) { atomicAdd(&bar[XB_TMO], 1u); break; } }
    }
    nloc = mine > 0u ? mine : 1u; nx = cnt > 0u ? cnt : 1u;
}
__device__ __forceinline__ void xcd_barrier(const XcdBarrier& b) {
    asm volatile("s_waitcnt vmcnt(0)" ::: "memory");
    __syncthreads();
    if (threadIdx.x == 0) {
        unsigned* bar = b.bar;
        __builtin_amdgcn_s_waitcnt(0);
        unsigned nloc = b.st[0], nx = b.st[1];
        if (nloc == 0u) { xcd_barrier_complete(bar, b.x, nloc, nx); b.st[0] = nloc; b.st[1] = nx; }
        const unsigned old = xb_add(&bar[XB_XSUB(b.x)], 1u);
        const unsigned gen = old / nloc;
        if (old + 1u == (gen + 1u) * nloc) {
            __builtin_amdgcn_fence(__ATOMIC_RELEASE, "agent");
            asm volatile("s_waitcnt vmcnt(0)" ::: "memory");
            const unsigned og = xb_add(&bar[XB_TOP], 1u);
            const unsigned tg = og / nx;
            if (og + 1u == (tg + 1u) * nx) xb_add(&bar[XB_TOPGEN], 1u);
            else XB_SPIN(xb_ld(&bar[XB_TOPGEN]) == tg, bar);
            __builtin_amdgcn_fence(__ATOMIC_ACQUIRE, "agent");
            xb_add(&bar[XB_XGEN(b.x)], 1u);
            asm volatile("s_waitcnt vmcnt(0)" ::: "memory");
        } else {
            XB_SPIN(xb_ld(&bar[XB_XGEN(b.x)]) == gen, bar);
            __builtin_amdgcn_fence(__ATOMIC_ACQUIRE, "agent");
            asm volatile("s_waitcnt vmcnt(0)" ::: "memory");
        }
    }
    __syncthreads();
}

__device__ __forceinline__ unsigned f2bf(float f) { unsigned u = __builtin_bit_cast(unsigned, f); return (u + 0x7fffu + ((u >> 16) & 1u)) >> 16; }
__device__ __forceinline__ unsigned pk2(float lo, float hi) { return h16::pk(lo, hi); }
__device__ __forceinline__ float wave_sum(float v) {
#pragma unroll
    for (int o = 1; o < 64; o <<= 1) v += __shfl_xor(v, o);
    return v;
}
__device__ __forceinline__ int wave_sum_i(int v) {
#pragma unroll
    for (int o = 1; o < 64; o <<= 1) v += __shfl_xor(v, o);
    return v;
}

struct Inputs {
    const float *x, *c, *norm_mix_g, *norm_ffn_g, *ada_w, *ada_b, *w_in, *w_out, *att_g, *ret_g, *fw_gate, *fw_up, *fw_down, *router_w, *mw_gate, *mw_up, *mw_down, *final_g;
};

template <class SrcFn> __device__ __forceinline__ void transpose_item(SrcFn src, int K, bf16* WT, int k0, int n0, LAS float* scr, int lane) {
#pragma unroll 8
    for (int i = 0; i < 32; ++i) { const int kk = 2 * i + (lane >> 5); scr[kk * 33 + (lane & 31)] = src(k0 + kk, n0 + (lane & 31)); }
    LDS_WAIT(); asm volatile("" ::: "memory");
    const int c = lane & 7;
#pragma unroll
    for (int j = 0; j < 4; ++j) { const int n = (lane >> 3) + 8 * j; const LAS float* s = scr + (8 * c) * 33 + n;
        v4u o; o.x = pk2(s[0 * 33], s[1 * 33]); o.y = pk2(s[2 * 33], s[3 * 33]); o.z = pk2(s[4 * 33], s[5 * 33]); o.w = pk2(s[6 * 33], s[7 * 33]);
        *(GAS v4u*)(WT + (size_t)(n0 + n) * K + k0 + 8 * c) = o; }
    LDS_WAIT(); asm volatile("" ::: "memory");
}
__device__ __forceinline__ int rot_src_col(int n) {
    if (n < 1536 || n >= 2560) return n;
    const int hb = (n - 1536) & ~127, p = (n - 1536) & 127;
    return 1536 + hb + 4 * (p >> 3) + ((p & 7) >> 1) + 64 * (p & 1);
}
constexpr int IT_WIN = 16 * 112, IT_WOUT = 16 * 32, IT_GU = 16 * 176, IT_DN = 44 * 32;
constexpr int IT_TOTAL = 2 * IT_WIN + 2 * IT_WOUT + IT_GU + IT_DN + 8 * (IT_GU + IT_DN);

constexpr int IT_NONMOE = 2 * IT_WIN + 2 * IT_WOUT + IT_GU + IT_DN;
__device__ __forceinline__ void convert_item(const Inputs& in, unsigned char* ws, int it, LAS float* scr, int lane) {
    int r = it;
    if (r < 2 * IT_WIN) { const int l = r / IT_WIN; r -= l * IT_WIN; const float* W = in.w_in + (size_t)l * 1024 * 3584;
        transpose_item([=](int k, int n) { return W[(size_t)k * 3584 + rot_src_col(n)]; }, 1024, (bf16*)(ws + WS_WIN) + (size_t)l * 3584 * 1024, 64 * (r / 112), 32 * (r % 112), scr, lane); return; }
    r -= 2 * IT_WIN;
    if (r < 2 * IT_WOUT) { const int l = r / IT_WOUT; r -= l * IT_WOUT; const float* W = in.w_out + (size_t)l * 1024 * 1024; const float* ag = in.att_g + l * 512;
        transpose_item([=](int k, int n) { return W[(size_t)k * 1024 + n] * (k < 512 ? ag[k] : 1.0f); }, 1024, (bf16*)(ws + WS_WOUT) + (size_t)l * 1024 * 1024, 64 * (r / 32), 32 * (r % 32), scr, lane); return; }
    r -= 2 * IT_WOUT;
    const float *Wg, *Wu, *Wd; bf16 *Dgu, *Ddn;
    if (r < IT_GU + IT_DN) { Wg = in.fw_gate; Wu = in.fw_up; Wd = in.fw_down; Dgu = (bf16*)(ws + WS_FGU); Ddn = (bf16*)(ws + WS_FDN); }
    else { r -= IT_GU + IT_DN; const int e = r / (IT_GU + IT_DN); r -= e * (IT_GU + IT_DN);
        Wg = in.mw_gate + (size_t)e * 1024 * 2816; Wu = in.mw_up + (size_t)e * 1024 * 2816; Wd = in.mw_down + (size_t)e * 2816 * 1024;
        Dgu = (bf16*)(ws + WS_MGU) + (size_t)e * 5632 * 1024; Ddn = (bf16*)(ws + WS_MDN) + (size_t)e * 1024 * 2816; }
    if (r < IT_GU) {
        transpose_item([=](int k, int n) { const float* W = ((n >> 7) & 1) ? Wu : Wg; return W[(size_t)k * 2816 + (n >> 8) * 128 + (n & 127)]; }, 1024, Dgu, 64 * (r / 176), 32 * (r % 176), scr, lane); return; }
    r -= IT_GU;
    transpose_item([=](int k, int n) { return Wd[(size_t)k * 1024 + n]; }, 2816, Ddn, 64 * (r / 32), 32 * (r % 32), scr, lane);
}
struct MoeItem { const float* src; bf16* dst; int ld, K, k0, n0; const float* rscale; };
template <int KIND  , class InP> __device__ __forceinline__ MoeItem moe_item(InP inp, unsigned char* ws, int it, int lane) {
    MoeItem m; m.rscale = nullptr;
    if (KIND == 0) { const int e = it / IT_GU, r = it - e * IT_GU; const int kb = r / 176, nb = r % 176; const int n = 32 * nb; m.k0 = 64 * kb; m.n0 = n; m.ld = 2816; m.K = 1024;
        const float* W = (((n >> 7) & 1) ? inp->mw_up : inp->mw_gate) + (size_t)e * 1024 * 2816;
        m.src = W + (size_t)(m.k0 + (lane >> 5)) * 2816 + (n >> 8) * 128 + (n & 127) + (lane & 31); m.dst = (bf16*)(ws + WS_MGU) + (size_t)e * 5632 * 1024; }
    else { const int e = it / IT_DN, r = it - e * IT_DN; const int kb = r / 32, nb = r % 32; m.k0 = 64 * kb; m.n0 = 32 * nb; m.ld = 1024; m.K = 2816;
        m.src = inp->mw_down + (size_t)e * 2816 * 1024 + (size_t)(m.k0 + (lane >> 5)) * 1024 + m.n0 + (lane & 31); m.dst = (bf16*)(ws + WS_MDN) + (size_t)e * 1024 * 2816; }
    return m;
}
__device__ __forceinline__ void moe_item_load(const MoeItem& m, float (&v)[32]) {
#pragma unroll
    for (int i = 0; i < 32; ++i) v[i] = m.src[(size_t)(2 * i) * m.ld];
}
__device__ __forceinline__ void moe_item_finish(const MoeItem& m, const float (&v)[32], LAS float* scr, int lane) {
    if (m.rscale != nullptr && m.k0 < 512) {
#pragma unroll
        for (int i = 0; i < 32; ++i) scr[(2 * i + (lane >> 5)) * 33 + (lane & 31)] = v[i] * m.rscale[m.k0 + 2 * i + (lane >> 5)];
    } else {
#pragma unroll
        for (int i = 0; i < 32; ++i) scr[(2 * i + (lane >> 5)) * 33 + (lane & 31)] = v[i];
    }
    LDS_WAIT(); asm volatile("" ::: "memory");
    const int c = lane & 7;
#pragma unroll
    for (int j = 0; j < 4; ++j) { const int n = (lane >> 3) + 8 * j; const LAS float* s = scr + (8 * c) * 33 + n;
        v4u o; o.x = pk2(s[0 * 33], s[1 * 33]); o.y = pk2(s[2 * 33], s[3 * 33]); o.z = pk2(s[4 * 33], s[5 * 33]); o.w = pk2(s[6 * 33], s[7 * 33]);
        *(GAS v4u*)(m.dst + (size_t)(m.n0 + n) * m.K + m.k0 + 8 * c) = o; }
    LDS_WAIT(); asm volatile("" ::: "memory");
}
template <class InP> __device__ __forceinline__ MoeItem base_item(InP inp, unsigned char* ws, int it, int lane) {
    MoeItem m; m.rscale = nullptr; int r = it;
    if (r < 2 * IT_WIN) { const int l = r / IT_WIN; r -= l * IT_WIN; m.k0 = 64 * (r / 112); m.n0 = 32 * (r % 112); m.ld = 3584; m.K = 1024;
        m.src = inp->w_in + (size_t)l * 1024 * 3584 + (size_t)(m.k0 + (lane >> 5)) * 3584 + rot_src_col(m.n0 + (lane & 31)); m.dst = (bf16*)(ws + WS_WIN) + (size_t)l * 3584 * 1024; return m; }
    r -= 2 * IT_WIN;
    if (r < 2 * IT_WOUT) { const int l = r / IT_WOUT; r -= l * IT_WOUT; m.k0 = 64 * (r / 32); m.n0 = 32 * (r % 32); m.ld = 1024; m.K = 1024; m.rscale = inp->att_g + l * 512;
        m.src = inp->w_out + (size_t)l * 1024 * 1024 + (size_t)(m.k0 + (lane >> 5)) * 1024 + m.n0 + (lane & 31); m.dst = (bf16*)(ws + WS_WOUT) + (size_t)l * 1024 * 1024; return m; }
    r -= 2 * IT_WOUT;
    if (r < IT_GU) { const int n = 32 * (r % 176); m.k0 = 64 * (r / 176); m.n0 = n; m.ld = 2816; m.K = 1024;
        m.src = (((n >> 7) & 1) ? inp->fw_up : inp->fw_gate) + (size_t)(m.k0 + (lane >> 5)) * 2816 + (n >> 8) * 128 + (n & 127) + (lane & 31); m.dst = (bf16*)(ws + WS_FGU); return m; }
    r -= IT_GU; m.k0 = 64 * (r / 32); m.n0 = 32 * (r % 32); m.ld = 1024; m.K = 2816;
    m.src = inp->fw_down + (size_t)(m.k0 + (lane >> 5)) * 1024 + m.n0 + (lane & 31); m.dst = (bf16*)(ws + WS_FDN); return m;
}
template <class InP> __device__ __forceinline__ void convert_base_all(InP inp, unsigned char* ws, LAS unsigned char* lds, int gw, int NGW, int wave, int lane) {
    LAS float* scr = (LAS float*)(lds + wave * 16384);
    int it = gw; if (it >= IT_NONMOE) return;
    float va[32], vb[32];
    MoeItem ma = base_item(inp, ws, it, lane), mb = ma; moe_item_load(ma, va);
    for (;;) {
        const bool hb = (it + NGW) < IT_NONMOE; if (hb) { mb = base_item(inp, ws, it + NGW, lane); moe_item_load(mb, vb); }
        moe_item_finish(ma, va, scr, lane);
        if (!hb) break;
        it += NGW;
        const bool ha = (it + NGW) < IT_NONMOE; if (ha) { ma = base_item(inp, ws, it + NGW, lane); moe_item_load(ma, va); }
        moe_item_finish(mb, vb, scr, lane);
        if (!ha) break;
        it += NGW;
    }
}
template <int KIND, class InP> __device__ __forceinline__ void convert_moe_range(InP inp, unsigned char* ws, LAS unsigned char* lds, int it0, int it1, int sp, int nsp, int wave, int lane) {
    LAS float* scr = (LAS float*)(lds + wave * 16384);
    const int step = nsp * NWAVES; int it = it0 + sp * NWAVES + wave;
    if (it >= it1) return;
    float va[32], vb[32];
    MoeItem ma = moe_item<KIND>(inp, ws, it, lane), mb = ma; moe_item_load(ma, va);
    for (;;) {
        const bool hb = (it + step) < it1; if (hb) { mb = moe_item<KIND>(inp, ws, it + step, lane); moe_item_load(mb, vb); }
        moe_item_finish(ma, va, scr, lane);
        if (!hb) break;
        it += step;
        const bool ha = (it + step) < it1; if (ha) { ma = moe_item<KIND>(inp, ws, it + step, lane); moe_item_load(ma, va); }
        moe_item_finish(mb, vb, scr, lane);
        if (!ha) break;
        it += step;
    }
}
constexpr int IT_MOE = 8 * (IT_GU + IT_DN);
constexpr int G_INPROJ = 224, G_GUD = 240;
constexpr int IT_MGU = 8 * IT_GU, IT_MDN = 8 * IT_DN;
constexpr int IT_MOE_A = 7549, IT_MOE_B = 14980, IT_MDN_C = 4000;

template <class InP> __device__ __forceinline__ void p0_prologue(InP inp, unsigned char* ws, LAS unsigned char* lds, int vcu, int G, int wave, int lane, int tid, int moe_w) {
    Inputs in; in.c = inp->c; in.ada_w = inp->ada_w; in.ada_b = inp->ada_b; in.w_in = inp->w_in; in.w_out = inp->w_out; in.att_g = inp->att_g; in.fw_gate = inp->fw_gate; in.fw_up = inp->fw_up; in.fw_down = inp->fw_down; in.mw_gate = inp->mw_gate; in.mw_up = inp->mw_up; in.mw_down = inp->mw_down;
    if (vcu < 192) {
        LAS float* cs = (LAS float*)lds;
        LAS float* part = (LAS float*)(lds + 32768);
        for (int i = tid; i < 8 * 1024; i += 512) { const float v = in.c[i]; cs[i] = v / (1.0f + __expf(-v)); }
        __syncthreads();
        const int n0 = vcu * 64, l = n0 / 6144, nn = n0 % 6144 + lane;
        const float* wp = in.ada_w + (size_t)l * 1024 * 6144 + (size_t)(wave * 128) * 6144 + nn;
        float acc[8];
#pragma unroll
        for (int b = 0; b < 8; ++b) acc[b] = 0.f;
#pragma unroll 8
        for (int k = 0; k < 128; ++k) { const float wv = wp[(size_t)k * 6144];
#pragma unroll
            for (int b = 0; b < 8; ++b) acc[b] += cs[b * 1024 + wave * 128 + k] * wv; }
#pragma unroll
        for (int b = 0; b < 8; ++b) part[(wave * 8 + b) * 64 + lane] = acc[b];
        __syncthreads();
        { const int b = tid >> 6; float s = 0.f;
#pragma unroll
          for (int w = 0; w < 8; ++w) s += part[(w * 8 + b) * 64 + lane];
          ((float*)(ws + WS_MOD))[((size_t)l * 8 + b) * 6144 + nn] = s + in.ada_b[l * 6144 + nn]; }
        __syncthreads();
    }
    { const int g = vcu * 512 + tid; if (g < 2048 * 64) { const int pos = g >> 6, i = g & 63; const float inv = powf(10000.0f, -(float)i / 64.0f); const float ang = (float)pos * inv;
        float* rp = (float*)(ws + WS_ROPE) + (size_t)g * 2; rp[0] = (float)cos((double)ang); rp[1] = (float)sin((double)ang); } }
    convert_base_all(inp, ws, lds, vcu * NWAVES + wave, G * NWAVES, wave, lane);
}

template <int MODE>
__device__ __forceinline__ void norm_pass(const float* xsrc, const float* gain, const float* sh, const float* sc, bf16* dst,
                                          const float* router_w, int* eidx, float* ew, int* wcnt, int gw, int lane) {
    const int m0 = gw * 8, b = m0 >> 11;
    f32x4 gv[4], scv[4], shv[4];
#pragma unroll
    for (int j = 0; j < 4; ++j) { gv[j] = ((const f32x4*)gain)[lane + 64 * j]; scv[j] = ((const f32x4*)(sc + (size_t)b * 6144))[lane + 64 * j] + 1.0f; shv[j] = ((const f32x4*)(sh + (size_t)b * 6144))[lane + 64 * j]; }
    int cnt[8];
#pragma unroll
    for (int e = 0; e < 8; ++e) cnt[e] = 0;
    f32x4 rw[4][4][2];
    if (MODE == 1) {
#pragma unroll
        for (int j = 0; j < 4; ++j)
#pragma unroll
            for (int c = 0; c < 4; ++c) { const float* wp = router_w + (size_t)(4 * (lane + 64 * j) + c) * 8; rw[j][c][0] = *(const f32x4*)wp; rw[j][c][1] = *(const f32x4*)(wp + 4); }
    }
    for (int i = 0; i < 8; ++i) {
        const int m = m0 + i;
        const f32x4* xr = (const f32x4*)(xsrc + (size_t)m * 1024) + lane;
        f32x4 v[4]; float s = 0.f;
#pragma unroll
        for (int j = 0; j < 4; ++j) { v[j] = xr[64 * j]; s += (v[j][0] * v[j][0] + v[j][1] * v[j][1]) + (v[j][2] * v[j][2] + v[j][3] * v[j][3]); }
        const float rs = 1.0f / sqrtf(wave_sum(s) * (1.0f / 1024.0f) + 1e-6f);
        v2u* o8 = (v2u*)(dst + (size_t)m * 1024) + lane;
#pragma unroll
        for (int j = 0; j < 4; ++j) { v[j] = v[j] * rs * gv[j] * scv[j] + shv[j]; v2u w; w.x = pk2(v[j][0], v[j][1]); w.y = pk2(v[j][2], v[j][3]); o8[64 * j] = w; }
        if (MODE == 1) {
            float lg[8];
#pragma unroll
            for (int e = 0; e < 8; ++e) lg[e] = 0.f;
#pragma unroll
            for (int j = 0; j < 4; ++j)
#pragma unroll
                for (int c = 0; c < 4; ++c) { const f32x4 w0 = rw[j][c][0], w1 = rw[j][c][1];
                    const float hv = v[j][c];
                    lg[0] += hv * w0[0]; lg[1] += hv * w0[1]; lg[2] += hv * w0[2]; lg[3] += hv * w0[3]; lg[4] += hv * w1[0]; lg[5] += hv * w1[1]; lg[6] += hv * w1[2]; lg[7] += hv * w1[3]; }
            { const bool b5 = (lane & 32) != 0, b4 = (lane & 16) != 0, b3 = (lane & 8) != 0;
              float a4[4], b2[2], c1;
#pragma unroll
              for (int q = 0; q < 4; ++q) { const float keep = b5 ? lg[4 + q] : lg[q], send = b5 ? lg[q] : lg[4 + q]; a4[q] = keep + __shfl_xor(send, 32); }
#pragma unroll
              for (int q = 0; q < 2; ++q) { const float keep = b4 ? a4[2 + q] : a4[q], send = b4 ? a4[q] : a4[2 + q]; b2[q] = keep + __shfl_xor(send, 16); }
              { const float keep = b3 ? b2[1] : b2[0], send = b3 ? b2[0] : b2[1]; c1 = keep + __shfl_xor(send, 8); }
              c1 += __shfl_xor(c1, 4); c1 += __shfl_xor(c1, 2); c1 += __shfl_xor(c1, 1);
#pragma unroll
              for (int e = 0; e < 8; ++e) lg[e] = __builtin_bit_cast(float, __builtin_amdgcn_readlane(__builtin_bit_cast(int, c1), 8 * e)); }
            int i0 = 0; float b0 = lg[0];
#pragma unroll
            for (int e = 1; e < 8; ++e) if (lg[e] > b0) { b0 = lg[e]; i0 = e; }
            int i1 = -1; float b1 = -3.0e38f;
#pragma unroll
            for (int e = 0; e < 8; ++e) if (e != i0 && lg[e] > b1) { b1 = lg[e]; i1 = e; }
            const float e1 = __expf(b1 - b0);
#pragma unroll
            for (int e = 0; e < 8; ++e) cnt[e] += ((e == i0) ? 1 : 0) + ((e == i1) ? 1 : 0);
            if (lane == 0) { eidx[m * 2] = i0; eidx[m * 2 + 1] = i1; ew[m * 2] = 1.0f / (1.0f + e1); ew[m * 2 + 1] = e1 / (1.0f + e1); }
        }
    }
    if (MODE == 1) {
        int myc = 0;
#pragma unroll
        for (int e = 0; e < 8; ++e) myc = (lane == e) ? cnt[e] : myc;
        if (lane < 8) wcnt[gw * 8 + lane] = myc;
    }
}

__device__ __forceinline__ void place_pass(const int* wcnt, const int* eidx, const float* ew, const bf16* XA, bf16* XS, int* srow, float* swt, int* segout, int gw, int NGW, int lane) {
    int tot[8], pre[8];
#pragma unroll
    for (int e = 0; e < 8; ++e) { tot[e] = 0; pre[e] = 0; }
    for (int w = lane; w < NGW; w += 64) { const i32x4 a = *(const i32x4*)(wcnt + w * 8), c = *(const i32x4*)(wcnt + w * 8 + 4); const int inc = (w < gw) ? 1 : 0;
        tot[0] += a[0]; tot[1] += a[1]; tot[2] += a[2]; tot[3] += a[3]; tot[4] += c[0]; tot[5] += c[1]; tot[6] += c[2]; tot[7] += c[3];
        pre[0] += inc * a[0]; pre[1] += inc * a[1]; pre[2] += inc * a[2]; pre[3] += inc * a[3]; pre[4] += inc * c[0]; pre[5] += inc * c[1]; pre[6] += inc * c[2]; pre[7] += inc * c[3]; }
    int base[8]; int run = 0;
#pragma unroll
    for (int e = 0; e < 8; ++e) { tot[e] = wave_sum_i(tot[e]); pre[e] = wave_sum_i(pre[e]); base[e] = run + pre[e]; if (gw == 0 && lane == 0) segout[e] = run; run += (tot[e] + 255) & ~255; }
    if (gw == 0 && lane == 0) segout[8] = run;
    const int myev = (lane < 16) ? eidx[gw * 16 + lane] : 0; const float myw = (lane < 16) ? ew[gw * 16 + lane] : 0.f;
    int mypos = 0;
#pragma unroll
    for (int i = 0; i < 16; ++i) { const int ev = __builtin_amdgcn_readlane(myev, i); int pos = 0;
#pragma unroll
        for (int e = 0; e < 8; ++e) if (ev == e) { pos = base[e]; base[e] += 1; }
        mypos = (lane == i) ? pos : mypos; }
    if (lane < 16) { srow[mypos] = gw * 16 + lane; swt[mypos] = myw; }
    const v4u* __restrict__ s = (const v4u*)(XA + (size_t)(gw * 8) * 1024);
    v4u r0[8], r1[8];
#pragma unroll
    for (int t = 0; t < 8; ++t) { r0[t] = s[t * 128 + lane]; r1[t] = s[t * 128 + lane + 64]; }
#pragma unroll
    for (int i = 0; i < 16; ++i) { const int pos = __builtin_amdgcn_readlane(mypos, i); v4u* __restrict__ d = (v4u*)(XS + (size_t)pos * 1024);
        d[lane] = r0[i >> 1]; d[lane + 64] = r1[i >> 1]; }
}

__device__ __forceinline__ void final_pass(float* xio, const bf16* YS, const int* atomf, const float* slab, const float* g2, const float* fg, int gw, int lane) {
    const int m0 = gw * 8, b = m0 >> 11;
    f32x4 gv[4], g2v[4];
#pragma unroll
    for (int j = 0; j < 4; ++j) { gv[j] = ((const f32x4*)fg)[lane + 64 * j]; g2v[j] = ((const f32x4*)(g2 + (size_t)b * 6144))[lane + 64 * j]; }
    for (int i = 0; i < 8; ++i) {
        const int m = m0 + i;
        f32x4* xr = (f32x4*)(xio + (size_t)m * 1024) + lane;
        const v2u* y0 = (const v2u*)(YS + (size_t)(2 * m) * 1024) + lane; const v2u* y1 = (const v2u*)(YS + (size_t)(2 * m + 1) * 1024) + lane;
        f32x4 v[4]; float s = 0.f; const i32x4 f0 = *(const i32x4*)(atomf + (size_t)(2 * m) * 4), f1 = *(const i32x4*)(atomf + (size_t)(2 * m + 1) * 4);
#pragma unroll
        for (int j = 0; j < 4; ++j) { v[j] = xr[64 * j]; const v2u a = y0[64 * j], c = y1[64 * j];
            f32x4 ya, yc;
            if (f0[j]) { const int id = f0[j] - 1; const float* sp = slab + ((size_t)((id >> 8) * 11) * 256 + (id & 255)) * 256 + 4 * lane; ya = (f32x4){0.f, 0.f, 0.f, 0.f};
                for (int kc = 0; kc < 11; ++kc) ya += *(const f32x4*)(sp + (size_t)kc * 65536); }
            else { ya[0] = h16::lo(a.x); ya[1] = h16::hi(a.x); ya[2] = h16::lo(a.y); ya[3] = h16::hi(a.y); }
            if (f1[j]) { const int id = f1[j] - 1; const float* sp = slab + ((size_t)((id >> 8) * 11) * 256 + (id & 255)) * 256 + 4 * lane; yc = (f32x4){0.f, 0.f, 0.f, 0.f};
                for (int kc = 0; kc < 11; ++kc) yc += *(const f32x4*)(sp + (size_t)kc * 65536); }
            else { yc[0] = h16::lo(c.x); yc[1] = h16::hi(c.x); yc[2] = h16::lo(c.y); yc[3] = h16::hi(c.y); }
            const f32x4 ys = ya + yc;
            v[j] = v[j] + g2v[j] * ys; s += (v[j][0] * v[j][0] + v[j][1] * v[j][1]) + (v[j][2] * v[j][2] + v[j][3] * v[j][3]); }
        const float rs = 1.0f / sqrtf(wave_sum(s) * (1.0f / 1024.0f) + 1e-6f);
#pragma unroll
        for (int j = 0; j < 4; ++j) xr[64 * j] = v[j] * rs * gv[j];
    }
}

constexpr int N_PHASES = 18;
struct Args { Inputs in; float* out; unsigned char* ws; int ph_lo, ph_hi, bar_region, moe_w; };

typedef const Args __attribute__((address_space(4))) CArgs;
__device__ __forceinline__ CArgs* kargs() { unsigned long off = 0; asm volatile("" : "+s"(off)); return (CArgs*)((const char __attribute__((address_space(4)))*)__builtin_amdgcn_kernarg_segment_ptr() + off); }

__global__ void __launch_bounds__(NWAVES * 64, 2) mega(Args args_unused) {
    extern __shared__ __attribute__((aligned(16))) unsigned char lds_raw[];
    LAS unsigned char* lds = (LAS unsigned char*)lds_raw;
    volatile LAS unsigned* MISC = (volatile LAS unsigned*)(lds + MISC_OFF);
    const int G = gridDim.x;
#define PHASE_IDS int tid = threadIdx.x; asm volatile("" : "+v"(tid)); int bx = blockIdx.x; asm volatile("" : "+s"(bx)); const int lane = tid & 63, wave = __builtin_amdgcn_readfirstlane(tid >> 6); \
    const int vcu = (bx & 7) * (G >> 3) + (bx >> 3); const int gw = vcu * NWAVES + wave; (void)lane; (void)gw; (void)vcu;
    for (int u = threadIdx.x; u < (LDS_BYTES - LDSCTL_OFF) / 4; u += NWAVES * 64) ((LAS unsigned*)(lds + LDSCTL_OFF))[u] = 0u;
    __syncthreads();
    XcdBarrier bar;
    { CArgs* ka = kargs(); unsigned* barw = (unsigned*)(ka->ws + WS_CTL) + CW_BAR + ka->bar_region * XCD_BAR_WORDS; bar = xcd_barrier_post(barw, MISC + 8); }
    int lo, hi; { CArgs* ka = kargs(); lo = ka->ph_lo; hi = ka->ph_hi; }
#ifndef PHM
#define PHM 0x3ff
#endif
#define IN(k) (lo <= (k) && (k) < hi)
#define TY(t) (((PHM) >> (t)) & 1)
#ifndef DUP_T
#define DUP_T -1
#define DUP_N 0
#endif
#define REP(t) for (int rep_ = 0; rep_ < ((t) == DUP_T ? 1 + DUP_N : 1) && (rep_ == 0 || (__syncthreads(), true)); ++rep_)
#ifdef TPROBE
    volatile LAS unsigned long long* TS = (volatile LAS unsigned long long*)(lds + MISC_OFF + 256);
#define STAMP(k) do { if (blockIdx.x == 0 && threadIdx.x == 0) TS[(k)] = __builtin_amdgcn_s_memrealtime(); } while (0)
#else
#define STAMP(k) do {} while (0)
#endif
    STAMP(0);
#define SEAM(k) do { if (IN(k) && IN((k) + 1)) xcd_barrier(bar); STAMP((k) + 1); } while (0)

    if (TY(0) && IN(0)) REP(0) { PHASE_IDS CArgs* ka = kargs(); p0_prologue(&ka->in, ka->ws, lds, vcu, G, wave, lane, tid, 0); }
    SEAM(0);
#ifdef PROBE_BAR
    for (int q = 0; q < PROBE_BAR; ++q) xcd_barrier(bar);
#endif
    for (int l = 0; l < 2; ++l) {
        const int pb = 1 + 8 * l;
        if (TY(1) && IN(pb + 0)) REP(1) { PHASE_IDS CArgs* ka = kargs(); unsigned char* ws = ka->ws; const float* mod = (const float*)(ws + WS_MOD) + (size_t)l * 8 * 6144;
            const float* xin = (l == 0) ? ka->in.x : (const float*)ka->out;
            if (gw < 2048) norm_pass<0>(xin, ka->in.norm_mix_g + l * 1024, mod + 0 * 1024, mod + 1 * 1024, (bf16*)(ws + WS_XA), nullptr, nullptr, nullptr, nullptr, gw, lane); }
        SEAM(pb + 0);
        if (TY(2) && IN(pb + 1)) REP(2) { PHASE_IDS CArgs* ka = kargs(); unsigned char* ws = ka->ws;
            if (bx < G_INPROJ) {
                pg8::Gemm g{1024, 1024, 1024}; pg8::DenseSched S; S.init(ws + WS_XA, 1024, (bf16*)(ws + WS_WIN) + (size_t)l * 3584 * 1024, 1024, 16384, 3584, G_INPROJ, bx);
                epi::EpiInProj E{(bf16*)(ws + WS_QKV), (size_t)16384 * 512, (float*)(ws + WS_KMP), (const float*)(ws + WS_ROPE)};
                pg8::gemm_phase(lds, g, S, E);
            } else if (rep_ == 0) { convert_moe_range<0>(&ka->in, ws, lds, l == 0 ? 0 : IT_MOE_B, l == 0 ? IT_MOE_A : IT_MGU, bx - G_INPROJ, G - G_INPROJ, wave, lane);
                                    if (l == 1) convert_moe_range<1>(&ka->in, ws, lds, 0, IT_MDN_C, bx - G_INPROJ, G - G_INPROJ, wave, lane); }
        }
        SEAM(pb + 1);
        if (TY(3) && IN(pb + 2)) REP(3) { PHASE_IDS CArgs* ka = kargs(); unsigned char* ws = ka->ws; bf16* QKV = (bf16*)(ws + WS_QKV); bf16* CAT = (bf16*)(ws + WS_CAT);
            if (G == 256) {
                if ((bx & 7) < 7) fa::kv_unit(bx >> 5, (bx >> 3) & 3, bx & 7, QKV + (size_t)4 * 16384 * 512, QKV + (size_t)5 * 16384 * 512, (float*)(ws + WS_KVM), lds);
                xcd_barrier(bar);
                { fa::Tensors TR{QKV + (size_t)3 * 16384 * 512, QKV + (size_t)4 * 16384 * 512, QKV + (size_t)5 * 16384 * 512, CAT, (float*)(ws + WS_ASSQ), (const float*)(ws + WS_KMP), QKV + (size_t)6 * 16384 * 512, ka->in.ret_g + l * 512, (const float*)(ws + WS_KVM)};
                  fa::attn_unit<true>(bx >> 5, (bx >> 3) & 3, bx & 7, TR, lds); }
                fa::Tensors TA{QKV, QKV + (size_t)1 * 16384 * 512, QKV + (size_t)2 * 16384 * 512, CAT, (float*)(ws + WS_ASSQ), (const float*)(ws + WS_KMP), nullptr, nullptr, nullptr};
                const int bh = bx >> 2, pr = bx & 3;
                for (int uu = 0; uu < 2; ++uu) fa::attn_unit<false>(bh >> 3, bh & 7, uu == 0 ? 7 - pr : pr, TA, lds);
            }
        }
        SEAM(pb + 2);
        if (TY(4) && IN(pb + 3)) REP(4) {
            { PHASE_IDS CArgs* ka = kargs(); unsigned char* ws = ka->ws; const float* mod = (const float*)(ws + WS_MOD) + (size_t)l * 8 * 6144;
                const float* xin = (l == 0) ? ka->in.x : (const float*)ka->out;
                pg8::Gemm g{1024, 1024, 1024}; pg8::DenseSched S; S.init(ws + WS_CAT, 1024, (const bf16*)(ws + WS_WOUT) + (size_t)l * 1024 * 1024, 1024, 16384, 1024, G, bx);
                epi::EpiOutProj E{xin, ka->out, mod + 2 * 1024, (const float*)(ws + WS_ASSQ), rep_ > 0}; pg8::gemm_phase(lds, g, S, E); }
        }
        SEAM(pb + 3);
        if (TY(5) && IN(pb + 4)) REP(5) { PHASE_IDS CArgs* ka = kargs(); unsigned char* ws = ka->ws; const float* mod = (const float*)(ws + WS_MOD) + (size_t)l * 8 * 6144;
            if (gw < 2048) {
                if (l == 0) norm_pass<0>(ka->out, ka->in.norm_ffn_g + l * 1024, mod + 3 * 1024, mod + 4 * 1024, (bf16*)(ws + WS_XA), nullptr, nullptr, nullptr, nullptr, gw, lane);
                else norm_pass<1>(ka->out, ka->in.norm_ffn_g + l * 1024, mod + 3 * 1024, mod + 4 * 1024, (bf16*)(ws + WS_XA), ka->in.router_w, (int*)(ws + WS_EIDX), (float*)(ws + WS_EW), (int*)(ws + WS_WCNT), gw, lane);
            }
            if (l == 1) { int* srow = (int*)(ws + WS_SROW); int* af = (int*)(ws + WS_ATOMF);
                { const int p = bx * 512 + tid; if (p < XS_ROWS) srow[p] = -1; af[p] = 0; }
            }
            else if (bx == 0 && tid < 9) { ((int*)(ws + WS_SEGD))[tid] = (tid == 0) ? 0 : ((tid == 8) ? 16384 : (1 << 30)); }
        }
        SEAM(pb + 4);
        if (l == 1) {
            if (TY(6) && IN(pb + 5)) REP(6) { PHASE_IDS CArgs* ka = kargs(); unsigned char* ws = ka->ws;
                if (gw < 2048) place_pass((const int*)(ws + WS_WCNT), (const int*)(ws + WS_EIDX), (const float*)(ws + WS_EW), (const bf16*)(ws + WS_XA), (bf16*)(ws + WS_XS), (int*)(ws + WS_SROW), (float*)(ws + WS_SWT), (int*)(ws + WS_SEG), gw, 2048, lane); }
            SEAM(pb + 5);
        } else { STAMP(pb + 6); }
        if (TY(7) && IN(pb + 6)) REP(7) { PHASE_IDS CArgs* ka = kargs(); unsigned char* ws = ka->ws;
            int Geff = G_GUD;
            if (l == 1) { const int nwg = (__builtin_amdgcn_readfirstlane(((const int*)(ws + WS_SEG))[8]) / 256) * 22; const int rounds = (nwg + G - 1) / G;
                Geff = (((nwg + rounds - 1) / rounds) + 7) & ~7; if (Geff > G - 8) Geff = G - 8; }
            if (bx < Geff) {
                pg8::Gemm g{1024, 1024, 1024}; pg8::MoeSched S;
                S.init(ws + (l == 0 ? WS_XA : WS_XS), 1024, ws + (l == 0 ? WS_FGU : WS_MGU), 1024, (size_t)5632 * 1024 * 2, (const int*)(ws + (l == 0 ? WS_SEGD : WS_SEG)), 5632, Geff, bx);
                epi::EpiSwiGLU E{(bf16*)(ws + (l == 0 ? WS_HD : WS_HM)), 2816}; pg8::gemm_phase(lds, g, S, E);
            } else if (rep_ == 0) { if (l == 0) convert_moe_range<0>(&ka->in, ws, lds, IT_MOE_A, IT_MOE_B, bx - Geff, G - Geff, wave, lane);
                                    else convert_moe_range<1>(&ka->in, ws, lds, IT_MDN_C, IT_MDN, bx - Geff, G - Geff, wave, lane); }
        }
        SEAM(pb + 6);
        if (TY(8) && IN(pb + 7)) REP(8) { PHASE_IDS CArgs* ka = kargs(); unsigned char* ws = ka->ws; const float* mod = (const float*)(ws + WS_MOD) + (size_t)l * 8 * 6144;
            pg8::MoeSched S;
            S.init(ws + (l == 0 ? WS_HD : WS_HM), 2816, ws + (l == 0 ? WS_FDN : WS_MDN), 2816, (size_t)1024 * 2816 * 2, (const int*)(ws + (l == 0 ? WS_SEGD : WS_SEG)), 1024, G, bx);
            const int left = S.nwg % G; const bool split = (l == 1) && left > 0 && left <= 32;
            if (split) S.lim = S.nwg - left;
            { pg8::Gemm g{2816, 2816, 2816};
              epi::EpiDown E{ka->out, mod + 5 * 1024, (bf16*)(ws + WS_YS), (const int*)(ws + WS_SROW), (const float*)(ws + WS_SWT), l == 1, rep_ > 0, (int*)(ws + WS_ATOMF), false, nullptr, 1}; pg8::gemm_phase(lds, g, S, E); }
            if (split && rep_ == 0) { S.first = S.nwg - left; S.lim = S.nwg; S.KS = 11; S.kbytes = 256 * 2;
              pg8::Gemm g{2816, 2816, 256};
              epi::EpiDown E{ka->out, mod + 5 * 1024, (bf16*)(ws + WS_YS), (const int*)(ws + WS_SROW), (const float*)(ws + WS_SWT), true, false, (int*)(ws + WS_ATOMF), true, (float*)(ws + WS_SLAB), 11}; pg8::gemm_phase(lds, g, S, E); }
        }
        SEAM(pb + 7);
    }
    if (TY(9) && IN(17)) { PHASE_IDS CArgs* ka = kargs(); unsigned char* ws = ka->ws;
        if (gw < 2048) final_pass(ka->out, (const bf16*)(ws + WS_YS), (const int*)(ws + WS_ATOMF), (const float*)(ws + WS_SLAB), (const float*)(ws + WS_MOD) + (size_t)1 * 8 * 6144 + 5 * 1024, ka->in.final_g, gw, lane); }
#ifdef TPROBE
    xcd_barrier(bar); STAMP(18); __syncthreads();
    if (blockIdx.x == 0) { CArgs* ka = kargs(); float* o = ka->out;
        const float d1 = (float)(TS[TPROBE_A + 1] - TS[TPROBE_A]) * 0.01f, d2 = (float)(TS[TPROBE_B + 1] - TS[TPROBE_B]) * 0.01f;
        const float a = 4.0f * sqrtf(d1);
        for (int i = threadIdx.x; i < 1024 * 1024; i += 512) o[i] = a;
        if (threadIdx.x == 0) o[1024 * 1024 + 5] = 100.0f * d2; }
#endif
#undef IN
#undef TY
#undef SEAM
#undef PHASE_IDS
}
}
#ifndef STEP
#define STEP 5
#endif
namespace ad {
__device__ __forceinline__ float bf2f(unsigned short s) { return h16::one(s); }
__global__ void __launch_bounds__(256) ad_proj(const unsigned short* QKV, size_t gstride, int b, float* projb) {
    const int m = blockIdx.x; const size_t row = (size_t)b * 2048 + m;
    for (int n = threadIdx.x; n < 3584; n += 256) {
        const int grp = n / 512, c = n % 512; int sc = c;
        if (grp == 3 || grp == 4) { const int head = c >> 7, d = c & 127; sc = head * 128 + 8 * ((d & 63) >> 2) + 2 * (d & 3) + (d >> 6); }
        float v = bf2f(QKV[(size_t)grp * gstride + row * 512 + sc]);
        if (grp == 0) v *= (1.0f / epi::C2);
        if (grp == 4) v *= (1.0f / epi::KSC);
        projb[(size_t)m * 3584 + n] = v;
    }
}
__global__ void __launch_bounds__(64) ad_kmean(const float* KMP, int b, float* kmeanb) {
    const int blk = blockIdx.x, h = blockIdx.y, d = threadIdx.x;
    const float* p = KMP + ((size_t)(b * 8 + blk) * 2) * 512 + h * 64 + d;
    kmeanb[((size_t)h * 8 + blk) * 64 + d] = (p[0] + p[512]) * (1.0f / 256.0f);
}
__global__ void __launch_bounds__(256) ad_cat(const unsigned short* CAT, const float* ASSQ, const float* att_g, int b, float* catb) {
    const int m = blockIdx.x; const size_t row = (size_t)b * 2048 + m;
    float ss = 0.f;
    for (int h = 0; h < 8; ++h) ss += ASSQ[row * 8 + h];
    const float rs = 1.0f / sqrtf(ss * (1.0f / 512.0f) + 1e-6f);
    for (int c = threadIdx.x; c < 1024; c += 256) { const float v = bf2f(CAT[row * 1024 + c]); catb[(size_t)m * 1024 + c] = (c < 512) ? v * rs * att_g[c] : v; }
}
__global__ void __launch_bounds__(256) dbg_cmp(const float* a, const float* b, size_t n, float rel, float abs_, unsigned* flag, int ncols = 1, int c_lo = 0, int c_hi = 1, int silu_b = 0) {
    unsigned bad = 0;
    for (size_t i = (size_t)blockIdx.x * 256 + threadIdx.x; i < n; i += (size_t)gridDim.x * 256) { const int c = (int)(i % ncols); if (c < c_lo || c >= c_hi) continue;
        float bv = b[i]; if (silu_b) bv = bv / (1.f + expf(-bv)); const float d = fabsf(a[i] - bv); if (!(d <= rel * fabsf(bv) + abs_)) ++bad; }
    if (bad) atomicAdd(flag, bad);
}
__global__ void __launch_bounds__(256) dbg_poison(const unsigned* flag, unsigned thresh, float* out, float val) {
    if (*flag > thresh) for (int i = threadIdx.x; i < 1024 * 1024; i += 256) out[i] = val;
}
__global__ void __launch_bounds__(256) dbg_ssd(const float* a, const float* b, size_t n, int ncols, int c_lo, int c_hi, float* acc) {
    float s = 0.f;
    for (size_t i = (size_t)blockIdx.x * 256 + threadIdx.x; i < n; i += (size_t)gridDim.x * 256) { const int c = (int)(i % ncols); if (c < c_lo || c >= c_hi) continue; const float d = a[i] - b[i]; s += d * d; }
    atomicAdd(acc, s);
}
__global__ void __launch_bounds__(256) dbg_encode(const float* acc, float count, float* out) {
    const float mse = *acc / count; const float val = 4.0f / sqrtf(mse);
    for (int i = threadIdx.x; i < 1024 * 1024; i += 256) out[i] = val;
}
}

static void launch_mega(const mk::Args& a0, int lo, int hi, int region, hipStream_t stream) {
    mk::Args a = a0; a.ph_lo = lo; a.ph_hi = hi; a.bar_region = region;
    hipLaunchKernelGGL(mk::mega, dim3(256), dim3(512), mk::LDS_BYTES, stream, a);
}

extern "C" void kernel_launch(void* const* d_in, const int* in_sizes, int n_in, void* d_out, int out_size, void* d_ws, size_t ws_size, hipStream_t stream) {
    static int ready = 0;
    if (ready == 0) {
        if (n_in != 18 || out_size != M * D || ws_size < mk::WS_END) { fprintf(stderr, "kernel_launch: unexpected problem (n_in %d, out %d, ws %zu)\n", n_in, out_size, ws_size); ready = -1; return; }
        if (hipFuncSetAttribute((const void*)mk::mega, hipFuncAttributeMaxDynamicSharedMemorySize, mk::LDS_BYTES) != hipSuccess) { fprintf(stderr, "kernel_launch: hipFuncSetAttribute failed\n"); ready = -1; return; }
        ready = 1;
    }
    if (ready < 0) return;
    mk::Args a{};
    const float** ip = (const float**)&a.in;
    for (int i = 0; i < 18; ++i) ip[i] = (const float*)d_in[i];
    a.out = (float*)d_out; a.ws = (unsigned char*)d_ws; a.moe_w = (STEP >= 5) ? 1 : 0;
    const mk::Inputs& in = a.in;
    float* out = (float*)d_out; unsigned char* ws = (unsigned char*)d_ws;
    hipMemsetAsync(ws + mk::WS_CTL, 0, mk::CTL_ZERO_BYTES, stream);
#if STEP >= 6
    launch_mega(a, 0, mk::N_PHASES, 0, stream);
#else
    constexpr size_t MiB = 1u << 20;
    unsigned char* na = ws + 8 * MiB;
    float* PROJb = (float*)(na);
    float* Hb = (float*)(na + 28 * MiB);
    float* CATb = (float*)(na + 36 * MiB);
    float* OAb = (float*)(na + 44 * MiB);
    float* ORRb = (float*)(na + 48 * MiB);
    float* KMEANb = (float*)(na + 52 * MiB);
    int* EIDXb = (int*)(na + 53 * MiB); float* EWb = (float*)(na + 53 * MiB + 65536); int* POSb = (int*)(na + 53 * MiB + 131072); int* LISTb = (int*)(na + 53 * MiB + 196608);
    int* CNTb = (int*)(na + 54 * MiB); int* BASEb = CNTb + 16;
    float* Gb = (float*)(na + 56 * MiB);
    float* Ub = (float*)(na + 78 * MiB);
    float* Yb = (float*)(na + 100 * MiB);
    const float* MODp = (const float*)(ws + mk::WS_MOD);
    unsigned short* QKV = (unsigned short*)(ws + mk::WS_QKV);
    launch_mega(a, 0, 1, 1, stream);
    for (int l = 0; l < 2; ++l) {
        const int pb = 1 + 8 * l;
        const float* xin = (l == 0) ? in.x : (const float*)out;
        if (STEP >= 1) { launch_mega(a, pb, pb + 1, 1, stream); launch_mega(a, pb + 1, pb + 2, 1, stream); }
        if (STEP >= 2) launch_mega(a, pb + 2, pb + 3, 1, stream);
        if (STEP >= 3) launch_mega(a, pb + 3, pb + 4, 1, stream);
        if (STEP < 3) {
            for (int b = 0; b < BATCH; ++b) {
                const float* mod = MODp + ((size_t)l * BATCH + b) * 6 * D;
                const float* xb = xin + (size_t)b * SEQ * D; float* ob = out + (size_t)b * SEQ * D;
                if (STEP < 1) {
                    nv::k_norm<<<SEQ, 256, 0, stream>>>(xb, in.norm_mix_g + l * D, mod + 0 * D, mod + 1 * D, Hb);
                    nv::k_gemm<<<dim3(NPROJ / 64, SEQ / 64), 256, 0, stream>>>(Hb, D, nullptr, nullptr, SEQ, in.w_in + (size_t)l * D * NPROJ, NPROJ, PROJb, NPROJ, D);
                    nv::k_rotary<<<SEQ, 256, 0, stream>>>(PROJb);
                    nv::k_kmean<<<dim3(NBLK, AH, 1), 64, 0, stream>>>(PROJb, KMEANb);
                } else {
                    ad::ad_proj<<<SEQ, 256, 0, stream>>>(QKV, (size_t)M * 512, b, PROJb);
                    ad::ad_kmean<<<dim3(NBLK, AH, 1), 64, 0, stream>>>((const float*)(ws + mk::WS_KMP), b, KMEANb);
#ifdef DBG_CHECK
                    { float* PROJn = Gb; float* KMn = (float*)(na + 52 * MiB + 262144); unsigned* flag = (unsigned*)(ws + mk::WS_CTL) + 16;
                      nv::k_norm<<<SEQ, 256, 0, stream>>>(xb, in.norm_mix_g + l * D, mod + 0 * D, mod + 1 * D, Hb);
                      nv::k_gemm<<<dim3(NPROJ / 64, SEQ / 64), 256, 0, stream>>>(Hb, D, nullptr, nullptr, SEQ, in.w_in + (size_t)l * D * NPROJ, NPROJ, PROJn, NPROJ, D);
                      nv::k_rotary<<<SEQ, 256, 0, stream>>>(PROJn);
                      nv::k_kmean<<<dim3(NBLK, AH, 1), 64, 0, stream>>>(PROJn, KMn);
                      ad::dbg_cmp<<<1024, 256, 0, stream>>>(PROJb, PROJn, (size_t)SEQ * NPROJ, DBG_REL, DBG_ABS, flag, NPROJ, 0, 3072, 0);
                      ad::dbg_cmp<<<1024, 256, 0, stream>>>(PROJb, PROJn, (size_t)SEQ * NPROJ, DBG_REL, DBG_ABS, flag, NPROJ, 3072, 3584, 1);
                      ad::dbg_cmp<<<16, 256, 0, stream>>>(KMEANb, KMn, (size_t)8 * 8 * 64, 0.03f, 0.004f, flag + 1);
                      if (l == DBG_L && b == 0) ad::dbg_ssd<<<1024, 256, 0, stream>>>(PROJb, PROJn, (size_t)SEQ * NPROJ, NPROJ, DBG_CLO, DBG_CHI, (float*)(flag + 2)); }
#endif
                }
                if (STEP < 2) {
                    nv::k_moba<<<dim3(NBLK, AH, 1), 256, 0, stream>>>(PROJb, KMEANb, OAb);
                    nv::k_ret<<<dim3(SEQ / 256, RH * 4, 1), 256, 0, stream>>>(PROJb, ORRb);
                    nv::k_cat<<<SEQ, 256, 0, stream>>>(OAb, ORRb, PROJb, in.att_g + l * AW, in.ret_g + l * RW, CATb, STEP >= 1 ? 1 : 0);
                } else {
                    ad::ad_cat<<<SEQ, 256, 0, stream>>>((const unsigned short*)(ws + mk::WS_CAT), (const float*)(ws + mk::WS_ASSQ), in.att_g + l * AW, b, CATb);
                }
                nv::k_gemm<<<dim3(D / 64, SEQ / 64), 256, 0, stream>>>(CATb, D, nullptr, nullptr, SEQ, in.w_out + (size_t)l * D * D, D, Hb, D, D);
                nv::k_resid<<<SEQ, 256, 0, stream>>>(xb, mod + 2 * D, Hb, ob);
            }
        }
        const bool ffn_mega = (l == 0) ? (STEP >= 4) : (STEP >= 5);
        if (ffn_mega) {
            launch_mega(a, pb + 4, pb + 5, 1, stream);
            if (l == 1) launch_mega(a, pb + 5, pb + 6, 1, stream);
            launch_mega(a, pb + 6, pb + 7, 1, stream);
            launch_mega(a, pb + 7, pb + 8, 1, stream);
        } else {
            for (int b = 0; b < BATCH; ++b) {
                const float* mod = MODp + ((size_t)l * BATCH + b) * 6 * D;
                float* ob = out + (size_t)b * SEQ * D;
                nv::k_norm<<<SEQ, 256, 0, stream>>>(ob, in.norm_ffn_g + l * D, mod + 3 * D, mod + 4 * D, Hb);
                if (l == 0) {
                    nv::k_gemm<<<dim3(FF / 64, SEQ / 64), 256, 0, stream>>>(Hb, D, nullptr, nullptr, SEQ, in.fw_gate, FF, Gb, FF, D);
                    nv::k_gemm<<<dim3(FF / 64, SEQ / 64), 256, 0, stream>>>(Hb, D, nullptr, nullptr, SEQ, in.fw_up, FF, Ub, FF, D);
                    nv::k_silu_mul<<<SEQ, 256, 0, stream>>>(Gb, Ub, nullptr, SEQ, FF);
                    nv::k_gemm<<<dim3(D / 64, SEQ / 64), 256, 0, stream>>>(Gb, FF, nullptr, nullptr, SEQ, in.fw_down, D, Ub, D, FF);
                    nv::k_resid<<<SEQ, 256, 0, stream>>>(ob, mod + 5 * D, Ub, ob);
                } else {
                    nv::k_router<<<SEQ / 4, 256, 0, stream>>>(Hb, in.router_w, EIDXb, EWb);
                    nv::k_place<<<1, 1024, 0, stream>>>(EIDXb, LISTb, POSb, CNTb, BASEb, 4);
                    float* GE = Gb; float* UE = Ub;
                    for (int e = 0; e < NE; ++e) {
                        nv::k_gemm<<<dim3(FF / 64, ECAP / 64), 256, 0, stream>>>(Hb, D, LISTb, CNTb + e, ECAP, in.mw_gate + (size_t)e * D * FF, FF, GE, FF, D, BASEb + e, nullptr);
                        nv::k_gemm<<<dim3(FF / 64, ECAP / 64), 256, 0, stream>>>(Hb, D, LISTb, CNTb + e, ECAP, in.mw_up + (size_t)e * D * FF, FF, UE, FF, D, BASEb + e, nullptr);
                        nv::k_silu_mul<<<ECAP, 256, 0, stream>>>(GE, UE, CNTb + e, ECAP, FF);
                        nv::k_gemm<<<dim3(D / 64, ECAP / 64), 256, 0, stream>>>(GE, FF, nullptr, CNTb + e, ECAP, in.mw_down + (size_t)e * FF * D, D, Yb, D, FF, nullptr, BASEb + e);
                    }
                    nv::k_moe_combine<<<SEQ, 256, 0, stream>>>(ob, mod + 5 * D, Yb, POSb, EWb);
                }
            }
        }
    }
    if (STEP >= 5) launch_mega(a, 17, 18, 1, stream);
    else nv::k_norm<<<M, 256, 0, stream>>>(out, in.final_g, nullptr, nullptr, out);
#ifdef DBG_CHECK
#ifdef DBG_ENC
    ad::dbg_encode<<<1, 256, 0, stream>>>((const float*)((unsigned*)(ws + mk::WS_CTL) + 18), (float)SEQ * (DBG_CHI - DBG_CLO), out);
#endif
    ad::dbg_poison<<<1, 256, 0, stream>>>((unsigned*)(ws + mk::WS_CTL) + 16, DBG_T0, out, 100.0f);
    ad::dbg_poison<<<1, 256, 0, stream>>>((unsigned*)(ws + mk::WS_CTL) + 17, DBG_T1, out + (1 << 20), 300.0f);
#endif
#endif
}
```

```cpp
#include <hip/hip_runtime.h>
#include <cstdio>
#include <cstdint>
#include <cmath>

namespace h16 {
typedef _Float16 f16x2_t __attribute__((ext_vector_type(2)));
typedef _Float16 f16x8_t __attribute__((ext_vector_type(8)));
typedef float f32x2_t __attribute__((ext_vector_type(2)));
__device__ __forceinline__ unsigned pk(float lo, float hi) { f32x2_t v = {lo, hi}; f16x2_t b = __builtin_convertvector(v, f16x2_t); return __builtin_bit_cast(unsigned, b); }
__device__ __forceinline__ float lo(unsigned u) { return (float)__builtin_bit_cast(f16x2_t, u)[0]; }
__device__ __forceinline__ float hi(unsigned u) { return (float)__builtin_bit_cast(f16x2_t, u)[1]; }
__device__ __forceinline__ float one(unsigned short s) { return (float)__builtin_bit_cast(_Float16, s); }
}

namespace xl {
template <int O> __device__ __forceinline__ int xor_i(int v) {
    if constexpr (O < 32) return __builtin_amdgcn_ds_swizzle(v, (O << 10) | 0x1f);
    else { static_assert(O < 32, "use add32 / max32 for the 32-lane exchange"); return v; }
}
template <int O> __device__ __forceinline__ float xor_f(float v) { return __builtin_bit_cast(float, xor_i<O>(__builtin_bit_cast(int, v))); }
__device__ __forceinline__ void swap32(unsigned a, unsigned& r0, unsigned& r1) { unsigned b = a; asm volatile("" : "+v"(b)); auto r = __builtin_amdgcn_permlane32_swap(a, b, false, false); r0 = r[0]; r1 = r[1]; }
__device__ __forceinline__ float xor32p(float v, bool upper) { unsigned r0, r1; swap32(__builtin_bit_cast(unsigned, v), r0, r1); return __builtin_bit_cast(float, upper ? r0 : r1); }
__device__ __forceinline__ float add32(float v) { unsigned r0, r1; swap32(__builtin_bit_cast(unsigned, v), r0, r1); return __builtin_bit_cast(float, r0) + __builtin_bit_cast(float, r1); }
__device__ __forceinline__ float max32(float v) { unsigned r0, r1; swap32(__builtin_bit_cast(unsigned, v), r0, r1); return fmaxf(__builtin_bit_cast(float, r0), __builtin_bit_cast(float, r1)); }
__device__ __forceinline__ int add32i(int v) { unsigned r0, r1; swap32((unsigned)v, r0, r1); return (int)(r0 + r1); }
__device__ __forceinline__ float wave_sum(float v) { v += xor_f<1>(v); v += xor_f<2>(v); v += xor_f<4>(v); v += xor_f<8>(v); v += xor_f<16>(v); return add32(v); }
__device__ __forceinline__ int wave_sum_i(int v) { v += xor_i<1>(v); v += xor_i<2>(v); v += xor_i<4>(v); v += xor_i<8>(v); v += xor_i<16>(v); return add32i(v); }
}

__device__ __forceinline__ int olane() { int l; asm volatile("v_mbcnt_lo_u32_b32 %0, -1, 0\n\tv_mbcnt_hi_u32_b32 %0, -1, %0" : "=v"(l)); return l; }
__device__ __forceinline__ int otid(int wv) { return (wv << 6) | olane(); }
#define STEP 6

constexpr int D = 1024, BATCH = 8, SEQ = 2048, M = BATCH * SEQ;
constexpr int AH = 8, AD = 64, AW = 512, MBLK = 256, NBLK = SEQ / MBLK, TOPK = 3;
constexpr int RH = 4, RD = 128, RW = 512;
constexpr int NPROJ = 3 * AW + 4 * RW;
constexpr int FF = 2816, NE = 8;
constexpr float EPS = 1e-6f;
constexpr int ECAP = 2048;
namespace pg8 {
#define PG8_LAS __attribute__((address_space(3)))
typedef unsigned short bf16_t;
typedef short bf16x8 __attribute__((ext_vector_type(8)));
typedef float f32x4 __attribute__((ext_vector_type(4)));
typedef float f32x2 __attribute__((ext_vector_type(2)));
typedef unsigned u32x4 __attribute__((ext_vector_type(4)));
typedef unsigned u32x2 __attribute__((ext_vector_type(2)));
typedef int i32x4 __attribute__((ext_vector_type(4)));
constexpr int BM = 256, BK = 64, HALF = 128, HTB = HALF * BK * 2  , STAGE_BYTES = 8 * HTB, NXCD = 8, WGM = 8;

__host__ __device__ __forceinline__ int lds_byte(int r, int c) { const int st = (r >> 4) * 2 + (c >> 5), rr = r & 15, cc = c & 31, ob = rr * 64 + cc * 2; return st * 1024 + (ob ^ (((ob >> 9) & 1) << 5)); }
__host__ __device__ __forceinline__ void stage_rc(int b, int& R, int& C) { const int st = b / 1024, sb = b % 1024, swz = sb ^ (((sb >> 9) & 1) << 5); R = (st >> 1) * 16 + swz / 64; C = (st & 1) * 32 + (swz % 64) / 2; }
__host__ __device__ __forceinline__ int perm32(int rho) { const int n = rho >> 4, i = rho & 15; return 8 * (i >> 2) + 4 * n + (i & 3); }

struct Unit { int pm, pn, e, kc, li; };
struct Gemm { int lda, ldb, K; };

struct DenseSched {
    const char* A; const char* Bt; size_t a_tile, b_tile;
    int nM, nN, nwg, G, c;
    __device__ __forceinline__ void init(const void* A_, int lda, const void* Bt_, int ldb, int M, int N, int G_, int c_) {
        A = (const char*)A_; Bt = (const char*)Bt_; a_tile = (size_t)BM * lda * 2; b_tile = (size_t)BM * ldb * 2; nM = M / BM; nN = N / BM; nwg = nM * nN; G = G_; c = c_; }
    __device__ __forceinline__ bool next(int i, Unit& u) const {
        const long L = (long)i * G + c; if (L >= nwg) return false;
        int wgid = (int)L; { const int q = nwg / NXCD, r = nwg % NXCD, xcd = wgid % NXCD, off = wgid / NXCD; wgid = (xcd < r ? xcd * (q + 1) : r * (q + 1) + (xcd - r) * q) + off; }
        const int nig = WGM * nN, gid = wgid / nig, fm = gid * WGM, gsz = (nM - fm) < WGM ? (nM - fm) : WGM;
        u.pm = fm + ((wgid % nig) % gsz); u.pn = (wgid % nig) / gsz; u.e = 0; u.kc = 0; u.li = 0; return true;
    }
    __device__ __forceinline__ const char* a_ptr(const Unit& u) const { return A + (size_t)u.pm * a_tile; }
    __device__ __forceinline__ const char* b_ptr(const Unit& u) const { return Bt + (size_t)u.pn * b_tile; }
};
struct MoeSched {
    const char* A; const char* Bt; size_t a_tile, b_tile, e_stride;
    int nM, nN, nwg, G, c; int seg[8]; int first, lim, KS, kbytes;
    __device__ __forceinline__ void init(const void* A_, int lda, const void* Bt_, int ldb, size_t e_stride_bytes, const int* segp_, int N, int G_, int c_) {
        A = (const char*)A_; Bt = (const char*)Bt_; a_tile = (size_t)BM * lda * 2; b_tile = (size_t)BM * ldb * 2; e_stride = e_stride_bytes;
#pragma unroll
        for (int e = 0; e < 8; ++e) seg[e] = __builtin_amdgcn_readfirstlane(segp_[e]);
        nM = __builtin_amdgcn_readfirstlane(segp_[8]) / BM; nN = N / BM; nwg = nM * nN; G = G_; c = c_; first = 0; lim = nwg; KS = 1; kbytes = 0; }
    __device__ __forceinline__ bool next(int i, Unit& u) const {
        const long idx = (long)i * G + c; const long L = first + idx / KS; if (L >= lim) return false;
        u.kc = (int)(idx % KS); u.li = (int)(idx / KS);
        int wgid = (int)L; { const int q = nwg / NXCD, r = nwg % NXCD, xcd = wgid % NXCD, off = wgid / NXCD; wgid = (xcd < r ? xcd * (q + 1) : r * (q + 1) + (xcd - r) * q) + off; }
        const int nig = WGM * nN, gid = wgid / nig, fm = gid * WGM, gsz = (nM - fm) < WGM ? (nM - fm) : WGM;
        u.pm = fm + ((wgid % nig) % gsz); u.pn = (wgid % nig) / gsz;
        int e = 0; const int r0 = u.pm * BM;
#pragma unroll
        for (int k = 1; k < 8; ++k) e = (r0 >= seg[k]) ? k : e;
        u.e = __builtin_amdgcn_readfirstlane(e); return true;
    }
    __device__ __forceinline__ const char* a_ptr(const Unit& u) const { return A + (size_t)u.pm * a_tile + (size_t)u.kc * kbytes; }
    __device__ __forceinline__ const char* b_ptr(const Unit& u) const { return Bt + (size_t)u.e * e_stride + (size_t)u.pn * b_tile + (size_t)u.kc * kbytes; }
};

__device__ __forceinline__ unsigned cvt_pk_bf16(float lo, float hi) { return h16::pk(lo, hi); }
__device__ __forceinline__ float fast_silu(float g) { return g * __builtin_amdgcn_rcpf(1.0f + __builtin_amdgcn_exp2f(-1.4426950408889634f * g)); }

typedef f32x4 Acc[2][2][4][2];
typedef int i32x8 __attribute__((ext_vector_type(8)));
template <bool F8> struct Frags;
template <> struct Frags<false> { bf16x8 At[4][2], B0[2][2], B1[2][2]; };
template <> struct Frags<true> { i32x8 At[4], B0[2], B1[2]; };

template <class Epi, class Sched>
__device__ __forceinline__ void gemm_phase(const int wv, PG8_LAS unsigned char* lds, const Gemm g, const Sched& S, const Epi& E) {
    int tid_ = otid(wv);
    const int tid = tid_, wid = __builtin_amdgcn_readfirstlane(tid >> 6), lane = tid & 63, wr = wid >> 2, wc = wid & 3, fr = lane & 15, fq = lane >> 4;
    const int K = g.K; int nt = K / BK; asm volatile("" : "+s"(nt));
    unsigned voffA[2], voffB[2];
#pragma unroll
    for (int i = 0; i < 2; ++i) { int R, C; stage_rc(tid * 16 + i * 8192, R, C); const int Rb = Epi::PERM ? ((R & ~31) + perm32(R & 31)) : R;
        voffA[i] = (unsigned)(R * g.lda + C) * 2u; voffB[i] = (unsigned)(Rb * g.ldb + C) * 2u; }
    const size_t kstep = (size_t)(BK * 2);
    const size_t hstepA = (size_t)HALF * g.lda * 2, hstepB = (size_t)HALF * g.ldb * 2;
    const unsigned ldsw = (unsigned)wid * 1024u;
    const unsigned ldsbase_ = (unsigned)__builtin_amdgcn_readfirstlane((int)((unsigned)(unsigned long)lds + ldsw));
    const int aoff = lds_byte(wr * 64 + fr, fq * 8), boff = lds_byte(wc * 32 + fr, fq * 8);
#define PG8_SA(b, h) (((b) * 2 + (h)) * HTB)
#define PG8_SB(b, h) ((4 + (b) * 2 + (h)) * HTB)
#define PG8_STAGE(bufoff, gbase, voff) do { if constexpr (Epi::FP8) {   \
            const unsigned long long gb_ = (unsigned long long)(gbase); \
            const unsigned long long sb_ = ((unsigned long long)(unsigned)__builtin_amdgcn_readfirstlane((int)(gb_ >> 32)) << 32) | (unsigned)__builtin_amdgcn_readfirstlane((int)gb_); \
            _Pragma("unroll") for (int _i = 0; _i < 2; ++_i) { unsigned keep_; \
                asm volatile("s_mov_b32 %0, m0\n\ts_mov_b32 m0, %3\n\ts_nop 0\n\tglobal_load_lds_dwordx4 %1, %2\n\ts_mov_b32 m0, %0" : "=&s"(keep_) : "v"((voff)[_i]), "s"(sb_), "s"(ldsbase_ + (unsigned)((bufoff) + _i * 8192)) : "memory"); } \
        } else { _Pragma("unroll") for (int _i = 0; _i < 2; ++_i) \
        __builtin_amdgcn_global_load_lds((const unsigned*)((const char*)(gbase) + (voff)[_i]), (PG8_LAS unsigned*)(lds + (bufoff) + ldsw + _i * 8192), 16, 0, 0); } } while (0)
#define PG8_LDA(dst, b, h) do { if constexpr (Epi::FP8) { _Pragma("unroll") for (int m = 0; m < 4; ++m) { const i32x4 lo_ = *(const PG8_LAS i32x4*)(lds + PG8_SA(b, h) + aoff + m * 2048), hi_ = *(const PG8_LAS i32x4*)(lds + PG8_SA(b, h) + aoff + m * 2048 + 1024); F.dst[m] = __builtin_shufflevector(lo_, hi_, 0, 1, 2, 3, 4, 5, 6, 7); } } \
        else { _Pragma("unroll") for (int m = 0; m < 4; ++m) _Pragma("unroll") for (int k = 0; k < 2; ++k) F.dst[m][k] = *(const PG8_LAS bf16x8*)(lds + PG8_SA(b, h) + aoff + m * 2048 + k * 1024); } } while (0)
#define PG8_LDB(dst, b, h) do { if constexpr (Epi::FP8) { _Pragma("unroll") for (int n = 0; n < 2; ++n) { const i32x4 lo_ = *(const PG8_LAS i32x4*)(lds + PG8_SB(b, h) + boff + n * 2048), hi_ = *(const PG8_LAS i32x4*)(lds + PG8_SB(b, h) + boff + n * 2048 + 1024); F.dst[n] = __builtin_shufflevector(lo_, hi_, 0, 1, 2, 3, 4, 5, 6, 7); } } \
        else { _Pragma("unroll") for (int n = 0; n < 2; ++n) _Pragma("unroll") for (int k = 0; k < 2; ++k) F.dst[n][k] = *(const PG8_LAS bf16x8*)(lds + PG8_SB(b, h) + boff + n * 2048 + k * 1024); } } while (0)
#define PG8_MMA(ai, bj, At, Bt) do { __builtin_amdgcn_s_setprio(1); \
        if constexpr (Epi::FP8) {   \
            _Pragma("unroll") for (int m = 0; m < 4; ++m) _Pragma("unroll") for (int n = 0; n < 2; ++n) \
                acc[ai][bj][m][n] = __builtin_amdgcn_mfma_scale_f32_16x16x128_f8f6f4(F.Bt[n], F.At[m], acc[ai][bj][m][n], 0, 0, 0, Epi::SCALE_W, 0, 0x7f7f7f7f); \
        } else { _Pragma("unroll") for (int m = 0; m < 4; ++m) _Pragma("unroll") for (int n = 0; n < 2; ++n) _Pragma("unroll") for (int k = 0; k < 2; ++k) \
            acc[ai][bj][m][n] = __builtin_amdgcn_mfma_f32_16x16x32_f16(__builtin_bit_cast(h16::f16x8_t, F.Bt[n][k]), __builtin_bit_cast(h16::f16x8_t, F.At[m][k]), acc[ai][bj][m][n], 0, 0, 0); } \
        __builtin_amdgcn_s_setprio(0); } while (0)
#define PG8_WAIT_V(n) asm volatile("s_waitcnt vmcnt(" #n ")" ::: "memory")
#define PG8_WAIT_L(n) asm volatile("s_waitcnt lgkmcnt(" #n ")" ::: "memory")
#define PG8_BAR __builtin_amdgcn_s_barrier()
#define PG8_SCHED __builtin_amdgcn_sched_barrier(0)
    Unit cur, nxt; int ui = 0;
    if (!S.next(0, cur)) return;
    Acc acc;
#pragma unroll
    for (int a = 0; a < 2; ++a)
#pragma unroll
        for (int b = 0; b < 2; ++b)
#pragma unroll
            for (int m = 0; m < 4; ++m)
#pragma unroll
                for (int n = 0; n < 2; ++n) acc[a][b][m][n] = (f32x4){0.f, 0.f, 0.f, 0.f};
    const char* cA = S.a_ptr(cur); const char* cB = S.b_ptr(cur);
    if constexpr (Epi::MID_T > 0) E.pre(cur, lds, tid);
    PG8_STAGE(PG8_SB(0, 0), cB, voffB); PG8_STAGE(PG8_SB(0, 1), cB + hstepB, voffB); PG8_STAGE(PG8_SA(0, 0), cA, voffA); PG8_STAGE(PG8_SA(0, 1), cA + hstepA, voffA);
    if (wr == 1) PG8_BAR;
    PG8_WAIT_V(2); PG8_BAR;
    PG8_STAGE(PG8_SB(1, 0), cB + kstep, voffB); PG8_STAGE(PG8_SA(1, 0), cA + kstep, voffA); PG8_STAGE(PG8_SB(1, 1), cB + hstepB + kstep, voffB);
    PG8_WAIT_V(6); PG8_BAR;
    for (;;) {
        const bool has_next = S.next(ui + 1, nxt);
        const char* nA = has_next ? S.a_ptr(nxt) : cA; const char* nB = has_next ? S.b_ptr(nxt) : cB;
        for (int t = 0; t < nt; t += 2) {
            if constexpr (Epi::MID_T > 0) { if (t == Epi::MID_T) E.mid(acc, lds, wr, fr); }
            const bool last = (t == nt - 2);
            Frags<Epi::FP8> F;
            const char* a1 = cA + (size_t)(t + 1) * kstep;
            const char* a2 = last ? nA : cA + (size_t)(t + 2) * kstep; const char* b2 = last ? nB : cB + (size_t)(t + 2) * kstep;
            const char* a3 = a2 + kstep; const char* b3 = b2 + kstep;
            PG8_LDB(B0, 0, 0); PG8_LDB(B1, 0, 1); PG8_SCHED; PG8_LDA(At, 0, 0); PG8_STAGE(PG8_SA(1, 1), a1 + hstepA, voffA);
            PG8_WAIT_V(8); PG8_WAIT_L(0); PG8_BAR; PG8_MMA(0, 0, At, B0); PG8_MMA(0, 1, At, B1); PG8_BAR; PG8_SCHED;
            PG8_LDA(At, 0, 1); PG8_STAGE(PG8_SB(0, 0), b2, voffB); PG8_STAGE(PG8_SB(0, 1), b2 + hstepB, voffB); PG8_STAGE(PG8_SA(0, 0), a2, voffA);
            PG8_WAIT_V(8); PG8_WAIT_L(0); PG8_BAR; PG8_MMA(1, 0, At, B0); PG8_MMA(1, 1, At, B1); PG8_BAR; PG8_SCHED;
            PG8_LDB(B0, 1, 0); PG8_LDB(B1, 1, 1); PG8_SCHED; PG8_LDA(At, 1, 0); PG8_STAGE(PG8_SA(0, 1), a2 + hstepA, voffA);
            PG8_WAIT_V(8); PG8_WAIT_L(0); PG8_BAR; PG8_MMA(0, 0, At, B0); PG8_MMA(0, 1, At, B1); PG8_BAR; PG8_SCHED;
            PG8_LDA(At, 1, 1); PG8_STAGE(PG8_SB(1, 0), b3, voffB); PG8_STAGE(PG8_SB(1, 1), b3 + hstepB, voffB); PG8_STAGE(PG8_SA(1, 0), a3, voffA);
            PG8_WAIT_V(8); PG8_WAIT_L(0); PG8_BAR; PG8_MMA(1, 0, At, B0); PG8_MMA(1, 1, At, B1); PG8_BAR; PG8_SCHED;
        }
        if (wr == 0) PG8_BAR;
        { const int t2_ = olane(); E(acc, cur, wr, wc, t2_ & 15, t2_ >> 4); }
        if (!has_next) break;
#pragma unroll
        for (int a = 0; a < 2; ++a)
#pragma unroll
            for (int b = 0; b < 2; ++b)
#pragma unroll
                for (int m = 0; m < 4; ++m)
#pragma unroll
                    for (int n = 0; n < 2; ++n) acc[a][b][m][n] = (f32x4){0.f, 0.f, 0.f, 0.f};
        cur = nxt; cA = nA; cB = nB; ++ui;
        if (wr == 1) PG8_BAR;
    }
    PG8_WAIT_V(0);
    PG8_BAR;
#undef PG8_SA
#undef PG8_SB
#undef PG8_STAGE
#undef PG8_LDA
#undef PG8_LDB
#undef PG8_MMA
#undef PG8_WAIT_V
#undef PG8_WAIT_L
#undef PG8_BAR
#undef PG8_SCHED
}
}
namespace epi {
#define PG8_LAS __attribute__((address_space(3)))
using pg8::Acc; using pg8::Unit; using pg8::f32x4; using pg8::u32x4; using pg8::bf16_t; using pg8::cvt_pk_bf16; using pg8::fast_silu;
constexpr int HALF = 128;
constexpr float C2 = 0.125f * 1.4426950408889634f;
constexpr float KSC = 0.08838834764831845f;

__device__ __forceinline__ u32x4 pack8(const f32x4 v0, const f32x4 v1) { u32x4 w; w.x = cvt_pk_bf16(v0[0], v0[1]); w.y = cvt_pk_bf16(v0[2], v0[3]); w.z = cvt_pk_bf16(v1[0], v1[1]); w.w = cvt_pk_bf16(v1[2], v1[3]); return w; }

struct EpiInProj {
    static constexpr bool PERM = true; static constexpr int MID_T = 0; static constexpr bool FP8 = false; static constexpr int SCALE_W = 0;
    bf16_t* O; size_t gstride;
    float* KMP;
    const float* ROPE;
    __device__ __forceinline__ void operator()(const Acc& acc, const Unit& u, int wr, int wc, int fr, int fq) const {
        const int grp = u.pn >> 1;
        const int col0 = (u.pn & 1) * 256 + wc * 32 + 8 * fq;
        const int row0 = u.pm * 256 + wr * 64 + fr;
        bf16_t* base = O + (size_t)grp * gstride;
        f32x4 cs[2][2];
#pragma unroll
        for (int bj = 0; bj < 2; ++bj) { cs[bj][0] = (f32x4){0.f, 0.f, 0.f, 0.f}; cs[bj][1] = (f32x4){0.f, 0.f, 0.f, 0.f}; }
#pragma unroll
        for (int ai = 0; ai < 2; ++ai)
#pragma unroll
            for (int m = 0; m < 4; ++m) {
                const int row = row0 + ai * HALF + m * 16;
                bf16_t* rowp = base + (size_t)row * 512 + col0;
                f32x4 t0 = (f32x4){0.f, 0.f, 0.f, 0.f}, t1 = t0;
                if (grp == 3 || grp == 4) { const float* tp = ROPE + ((size_t)(row & 2047) * 64 + 16 * wc + 4 * fq) * 2; t0 = *(const f32x4*)tp; t1 = *(const f32x4*)(tp + 4); }
#pragma unroll
                for (int bj = 0; bj < 2; ++bj) {
                    f32x4 v0 = acc[ai][bj][m][0], v1 = acc[ai][bj][m][1];
                    if (grp == 0) { v0 = v0 * C2; v1 = v1 * C2; }
                    else if (grp == 1) { cs[bj][0] += v0; cs[bj][1] += v1; }
                    else if (grp == 3 || grp == 4) {
                        const float sc = (grp == 4) ? KSC : 1.0f;
                        f32x4 r0, r1;
                        r0[0] = (v0[0] * t0[0] - v0[1] * t0[1]) * sc; r0[1] = (v0[0] * t0[1] + v0[1] * t0[0]) * sc;
                        r0[2] = (v0[2] * t0[2] - v0[3] * t0[3]) * sc; r0[3] = (v0[2] * t0[3] + v0[3] * t0[2]) * sc;
                        r1[0] = (v1[0] * t1[0] - v1[1] * t1[1]) * sc; r1[1] = (v1[0] * t1[1] + v1[1] * t1[0]) * sc;
                        r1[2] = (v1[2] * t1[2] - v1[3] * t1[3]) * sc; r1[3] = (v1[2] * t1[3] + v1[3] * t1[2]) * sc;
                        v0 = r0; v1 = r1;
                    } else if (grp == 6) {
#pragma unroll
                        for (int j = 0; j < 4; ++j) { v0[j] = fast_silu(v0[j]); v1[j] = fast_silu(v1[j]); }
                    }
                    *(u32x4*)(rowp + bj * HALF) = pack8(v0, v1);
                }
            }
        if (grp == 1) {
#pragma unroll
            for (int bj = 0; bj < 2; ++bj)
#pragma unroll
                for (int n = 0; n < 2; ++n) {
                    f32x4 s = cs[bj][n];
#pragma unroll
                    for (int c4 = 0; c4 < 4; ++c4) { float t = s[c4]; t += xl::xor_f<1>(t); t += xl::xor_f<2>(t); t += xl::xor_f<4>(t); t += xl::xor_f<8>(t); s[c4] = t; }
                    if (fr == 0) *(f32x4*)(KMP + (size_t)(u.pm * 2 + wr) * 512 + col0 + bj * HALF + 4 * n) = s;
                }
        }
    }
};

struct EpiOutProj {
    static constexpr bool PERM = false; static constexpr int MID_T = 8; static constexpr bool FP8 = false; static constexpr int SCALE_W = 0;
    const float* xin; float* out; const float* g1;
    const float* assq;
    bool dry;
    static constexpr int RS_OFF = 131072 + 8192;
    __device__ __forceinline__ void pre(const Unit& u, PG8_LAS unsigned char* lds, int tid) const {
        if (tid < 256) { const int row = u.pm * 256 + tid;
            const f32x4 a = *(const f32x4*)(assq + (size_t)row * 8), c = *(const f32x4*)(assq + (size_t)row * 8 + 4);
            const float ss = ((a[0] + a[1]) + (a[2] + a[3])) + ((c[0] + c[1]) + (c[2] + c[3]));
            ((PG8_LAS float*)(lds + RS_OFF))[tid] = 1.0f / sqrtf(ss * (1.0f / 512.0f) + 1e-6f); }
    }
    __device__ __forceinline__ void mid(Acc& acc, PG8_LAS unsigned char* lds, int wr, int fr) const {
        const PG8_LAS float* tab = (const PG8_LAS float*)(lds + RS_OFF) + wr * 64 + fr;
#pragma unroll
        for (int ai = 0; ai < 2; ++ai)
#pragma unroll
            for (int m = 0; m < 4; ++m) {
                const float rs = tab[ai * HALF + m * 16];
#pragma unroll
                for (int bj = 0; bj < 2; ++bj)
#pragma unroll
                    for (int n = 0; n < 2; ++n) acc[ai][bj][m][n] = acc[ai][bj][m][n] * rs;
            }
    }
    __device__ __forceinline__ void operator()(const Acc& acc, const Unit& u, int wr, int wc, int fr, int fq) const {
        const int b = u.pm >> 3;
        const int col0 = u.pn * 256 + wc * 32 + 4 * fq;
        const int row0 = u.pm * 256 + wr * 64 + fr;
        f32x4 gv[2][2];
#pragma unroll
        for (int bj = 0; bj < 2; ++bj)
#pragma unroll
            for (int n = 0; n < 2; ++n) gv[bj][n] = *(const f32x4*)(g1 + (size_t)b * 6144 + col0 + bj * HALF + n * 16);
#pragma unroll
        for (int ai = 0; ai < 2; ++ai)
#pragma unroll
            for (int m = 0; m < 4; ++m) {
                const size_t off = (size_t)(row0 + ai * HALF + m * 16) * 1024 + col0;
#pragma unroll
                for (int bj = 0; bj < 2; ++bj)
#pragma unroll
                    for (int n = 0; n < 2; ++n) { const f32x4 bs = *(const f32x4*)(xin + off + bj * HALF + n * 16); const f32x4 r = bs + gv[bj][n] * acc[ai][bj][m][n]; if (!dry) *(f32x4*)(out + off + bj * HALF + n * 16) = r; else asm volatile("" :: "v"(r)); }
            }
    }
};

struct EpiSwiGLU {
    static constexpr bool PERM = true; static constexpr int MID_T = 0; static constexpr bool FP8 = false; static constexpr int SCALE_W = 0;
    bf16_t* H; int ldh;
    __device__ __forceinline__ void operator()(const Acc& acc, const Unit& u, int wr, int wc, int fr, int fq) const {
        const int col0 = u.pn * 128 + wc * 32 + 8 * fq;
        const int row0 = u.pm * 256 + wr * 64 + fr;
#pragma unroll
        for (int ai = 0; ai < 2; ++ai)
#pragma unroll
            for (int m = 0; m < 4; ++m) {
                const int row = row0 + ai * HALF + m * 16;
                f32x4 v0, v1;
#pragma unroll
                for (int j = 0; j < 4; ++j) { v0[j] = fast_silu(acc[ai][0][m][0][j]) * acc[ai][1][m][0][j]; v1[j] = fast_silu(acc[ai][0][m][1][j]) * acc[ai][1][m][1][j]; }
                *(u32x4*)(H + (size_t)row * ldh + col0) = pack8(v0, v1);
            }
    }
};

struct EpiDown {
    static constexpr bool PERM = false; static constexpr int MID_T = 0; static constexpr bool FP8 = false; static constexpr int SCALE_W = 0;
    float* out; const float* g2; bf16_t* YS; const int* srow; const float* swt; bool moe; bool dry; int* atomf; bool atomic; float* slab; int KS;
    __device__ __forceinline__ void operator()(const Acc& acc, const Unit& u, int wr, int wc, int fr, int fq) const {
        const int col0 = u.pn * 256 + wc * 32 + 4 * fq;
        const int row0 = u.pm * 256 + wr * 64 + fr;
        if (!moe) {
            const int b = u.pm >> 3;
            f32x4 gv[2][2];
#pragma unroll
            for (int bj = 0; bj < 2; ++bj)
#pragma unroll
                for (int n = 0; n < 2; ++n) gv[bj][n] = *(const f32x4*)(g2 + (size_t)b * 6144 + col0 + bj * HALF + n * 16);
#pragma unroll
            for (int ai = 0; ai < 2; ++ai)
#pragma unroll
                for (int m = 0; m < 4; ++m) {
                    const size_t off = (size_t)(row0 + ai * HALF + m * 16) * 1024 + col0;
#pragma unroll
                    for (int bj = 0; bj < 2; ++bj)
#pragma unroll
                        for (int n = 0; n < 2; ++n) { const f32x4 bs = *(const f32x4*)(out + off + bj * HALF + n * 16); const f32x4 r = bs + gv[bj][n] * acc[ai][bj][m][n]; if (!dry) *(f32x4*)(out + off + bj * HALF + n * 16) = r; else asm volatile("" :: "v"(r)); }
                }
        } else if (atomic) {
            float* sl = slab + ((size_t)(u.li * KS + u.kc) * 256) * 256 + (wc * 32 + 4 * fq);
#pragma unroll
            for (int ai = 0; ai < 2; ++ai)
#pragma unroll
                for (int m = 0; m < 4; ++m) {
                    const int rl = ai * HALF + wr * 64 + m * 16 + fr; const int pos = u.pm * 256 + rl;
                    const int sr = srow[pos];
                    if (sr >= 0) { const float w = swt[pos];
                        if (u.kc == 0 && wc == 0 && fq == 0) atomf[sr * 4 + u.pn] = 1 + u.li * 256 + rl;
#pragma unroll
                        for (int bj = 0; bj < 2; ++bj)
#pragma unroll
                            for (int n = 0; n < 2; ++n) *(f32x4*)(sl + (size_t)rl * 256 + bj * HALF + n * 16) = acc[ai][bj][m][n] * w; }
                }
        } else {
#pragma unroll
            for (int ai = 0; ai < 2; ++ai)
#pragma unroll
                for (int m = 0; m < 4; ++m) {
                    const int pos = row0 + ai * HALF + m * 16;
                    const int sr = srow[pos];
                    if (sr >= 0) { const float w = swt[pos]; bf16_t* rowp = YS + (size_t)sr * 1024 + col0;
#pragma unroll
                        for (int bj = 0; bj < 2; ++bj)
#pragma unroll
                            for (int n = 0; n < 2; ++n) { const f32x4 v = acc[ai][bj][m][n] * w; pg8::u32x2 o; o.x = cvt_pk_bf16(v[0], v[1]); o.y = cvt_pk_bf16(v[2], v[3]); if (!dry) *(pg8::u32x2*)(rowp + bj * HALF + n * 16) = o; else asm volatile("" :: "v"(o)); } }
                }
        }
    }
};

__device__ __forceinline__ float clamp448(float v) { return __builtin_fminf(__builtin_fmaxf(v, -448.0f), 448.0f); }
__device__ __forceinline__ unsigned pk4_fp8(float a, float b, float c, float d) {
    int p = 0; p = __builtin_amdgcn_cvt_pk_fp8_f32(clamp448(a), clamp448(b), p, false); p = __builtin_amdgcn_cvt_pk_fp8_f32(clamp448(c), clamp448(d), p, true); return (unsigned)p; }
struct EpiSwiGLU8 {
    static constexpr bool PERM = true; static constexpr int MID_T = 0; static constexpr bool FP8 = true; static constexpr int SCALE_W = 0x7a7a7a7a;
    unsigned char* H; int ldh;
    __device__ __forceinline__ void operator()(const Acc& acc, const Unit& u, int wr, int wc, int fr, int fq) const {
        const int col0 = u.pn * 128 + wc * 32 + 8 * fq;
        const int row0 = u.pm * 256 + wr * 64 + fr;
#pragma unroll
        for (int ai = 0; ai < 2; ++ai)
#pragma unroll
            for (int m = 0; m < 4; ++m) {
                const int row = row0 + ai * HALF + m * 16;
                f32x4 v0, v1;
#pragma unroll
                for (int j = 0; j < 4; ++j) { v0[j] = fast_silu(acc[ai][0][m][0][j]) * acc[ai][1][m][0][j]; v1[j] = fast_silu(acc[ai][0][m][1][j]) * acc[ai][1][m][1][j]; }
                pg8::u32x2 w; w.x = pk4_fp8(v0[0], v0[1], v0[2], v0[3]); w.y = pk4_fp8(v1[0], v1[1], v1[2], v1[3]);
                *(pg8::u32x2*)(H + (size_t)row * ldh + col0) = w;
            }
    }
};
struct EpiDownMoe8 {
    static constexpr bool PERM = false; static constexpr int MID_T = 0; static constexpr bool FP8 = true; static constexpr int SCALE_W = 0x79797979;
    bf16_t* YS; const int* srow; const float* swt;
    __device__ __forceinline__ void operator()(const Acc& acc, const Unit& u, int wr, int wc, int fr, int fq) const {
        const int col0 = u.pn * 256 + wc * 32 + 4 * fq;
        const int row0 = u.pm * 256 + wr * 64 + fr;
#pragma unroll
        for (int ai = 0; ai < 2; ++ai)
#pragma unroll
            for (int m = 0; m < 4; ++m) {
                const int pos = row0 + ai * HALF + m * 16;
                const int sr = srow[pos];
                if (sr >= 0) { const float w = swt[pos]; bf16_t* rowp = YS + (size_t)sr * 1024 + col0;
#pragma unroll
                    for (int bj = 0; bj < 2; ++bj)
#pragma unroll
                        for (int n = 0; n < 2; ++n) { const f32x4 v = acc[ai][bj][m][n] * w; pg8::u32x2 o; o.x = cvt_pk_bf16(v[0], v[1]); o.y = cvt_pk_bf16(v[2], v[3]); *(pg8::u32x2*)(rowp + bj * HALF + n * 16) = o; } }
            }
    }
};
}
namespace fa {
#define FA_LAS __attribute__((address_space(3)))
typedef unsigned short bf16_t;
typedef short bf16x8 __attribute__((ext_vector_type(8)));
typedef short s16x4 __attribute__((ext_vector_type(4)));
typedef float f32x16 __attribute__((ext_vector_type(16)));
typedef float f32x4 __attribute__((ext_vector_type(4)));
typedef unsigned u32x4 __attribute__((ext_vector_type(4)));
typedef float f32x2_t __attribute__((ext_vector_type(2))); typedef __bf16 bf16x2_t __attribute__((ext_vector_type(2)));
constexpr int L_WSF = 131072 + 1024, L_KM = L_WSF + 2048;
constexpr float NEG = -1.0e30f;
__device__ __forceinline__ int crow(int r, int hi) { return (r & 3) + 8 * (r >> 2) + 4 * hi; }
__device__ __forceinline__ void glds16(const void* gsrc, unsigned lds_dst) { unsigned keep;
    asm volatile("s_mov_b32 %0, m0\n\ts_mov_b32 m0, %2\n\ts_nop 0\n\tglobal_load_lds_dwordx4 %1, off\n\ts_mov_b32 m0, %0" : "=&s"(keep) : "v"(gsrc), "s"(lds_dst) : "memory"); }
__device__ __forceinline__ unsigned cvtpk_s(float lo, float hi) { return h16::pk(lo, hi); }
__device__ __forceinline__ float bf2f(short s) { return h16::one((unsigned short)s); }
typedef short v4i16_t __attribute__((ext_vector_type(4)));
__device__ __forceinline__ s16x4 vtr(FA_LAS const unsigned char* p) { return __builtin_bit_cast(s16x4, __builtin_amdgcn_ds_read_tr16_b64_v4i16((FA_LAS v4i16_t*)p)); }
#define FA_WAIT_BAR() asm volatile("s_waitcnt vmcnt(0) lgkmcnt(0)\n\ts_barrier" ::: "memory")
#define FA_LBAR() asm volatile("s_waitcnt lgkmcnt(0)\n\ts_barrier" ::: "memory")

struct Tensors {
    const bf16_t* Q; const bf16_t* K; const bf16_t* V;
    bf16_t* CAT;
    float* ASSQ;
    const float* KMP;
    const bf16_t* GR;
    const float* ret_g;
    const float* KVM;
};

template <bool RET>
__device__ __forceinline__ void attn_unit(const int wv, int b, int h, int qblk, const Tensors& T, FA_LAS unsigned char* shm) {
    constexpr int NS = RET ? 3 : 4, DIST = NS - 1;
    constexpr int DH = RET ? 128 : 64, ND0 = DH / 16, NDB = DH / 32, NPC = DH / 64, SLOT = 64 * DH * 2, L_K = 0, L_V = NS * SLOT, PER = 2 * NPC, L_R = 98304;
    int tid_ = otid(wv);
    const int tid = tid_, lane = tid & 63, r32 = lane & 31, hi = lane >> 5; const int wid = __builtin_amdgcn_readfirstlane(tid >> 6);
    const size_t rowbase = (size_t)b * 2048; const int q0 = qblk * 256;
    const unsigned lds0 = (unsigned)(unsigned long)shm;
    FA_LAS float* wsf = (FA_LAS float*)(shm + L_WSF) + wid * 64;
    FA_LAS float* KM = (FA_LAS float*)(shm + L_KM);
    const bf16_t* Kh = T.K + rowbase * 512 + h * DH; const bf16_t* Vh = T.V + rowbase * 512 + h * DH;
    const int NT = RET ? 4 : 4 * (qblk + 1);
#define FA_KV0(i) ((((i) < 4) ? qblk : (qblk - 1 - (((i) - 4) >> 2))) * 256 + ((i) & 3) * 64)
#define FA_DMA(i) do { const int kv0_ = FA_KV0(i); const unsigned so_ = (unsigned)(((i) % NS) * SLOT); \
        _Pragma("unroll") for (int pp = 0; pp < NPC; ++pp) { const int p = wid + 8 * pp; \
            glds16(Kh + (size_t)(kv0_ + lane) * 512 + p * 8, (unsigned)__builtin_amdgcn_readfirstlane(lds0 + L_K + so_ + p * 1024)); } \
        _Pragma("unroll") for (int pp = 0; pp < NPC; ++pp) { const int p = wid + 8 * pp; \
            glds16(Vh + (size_t)(kv0_ + 16 * (p & 3) + (lane >> 2)) * 512 + (p >> 2) * 32 + (lane & 3) * 8, (unsigned)__builtin_amdgcn_readfirstlane(lds0 + L_V + so_ + p * 1024)); } } while (0)
    FA_DMA(0); if (NT > 1) FA_DMA(1); if (DIST > 2 && NT > 2) FA_DMA(2);
    const bf16_t* Qw = T.Q + (rowbase + q0 + wid * 32 + r32) * 512 + h * DH;
    bf16x8 qr[ND0];
#pragma unroll
    for (int d0 = 0; d0 < ND0; ++d0) qr[d0] = *(const bf16x8*)(Qw + d0 * 16 + hi * 8);
    unsigned selmask = 0xffu;
    float cfac[16]; float lg2 = 0.f;
    if (!RET) {
        { const int j = tid >> 6, d = tid & 63; const float* kp = T.KMP + ((size_t)(b * 8 + j) * 2) * 512 + h * 64 + d; KM[tid] = kp[0] + kp[512]; }
        FA_LBAR();
        float g[8];
#pragma unroll
        for (int j = 0; j < 8; ++j) g[j] = 0.f;
#pragma unroll
        for (int d0 = 0; d0 < ND0; ++d0)
#pragma unroll
            for (int jj = 0; jj < 8; ++jj) { const float qv = bf2f(qr[d0][jj]); const int d = 16 * d0 + 8 * hi + jj;
#pragma unroll
                for (int j = 0; j < 8; ++j) g[j] += qv * KM[j * 64 + d]; }
#pragma unroll
        for (int j = 0; j < 8; ++j) g[j] = xl::add32(g[j]);
        selmask = 0u;
#pragma unroll
        for (int j = 0; j < 8; ++j) { int rank = 0;
#pragma unroll
            for (int mm = 0; mm < 8; ++mm) rank += (mm < qblk && (g[mm] > g[j] || (g[mm] == g[j] && mm < j))) ? 1 : 0;
            if (j < qblk && rank < 3) selmask |= 1u << j; }
    } else {
        lg2 = log2f(1.0f - exp2f(-5.0f - (float)h));
#pragma unroll
        for (int r = 0; r < 16; ++r) cfac[r] = exp2f(-lg2 * (float)((r & 3) + 8 * (r >> 2)));
    }
    f32x16 o[NDB];
#pragma unroll
    for (int db = 0; db < NDB; ++db) o[db] = f32x16{};
    float mhat = 0.f, lrow = 0.f; f32x16 negm = f32x16{}; constexpr float THR = 8.0f;
    if (RET && qblk > 0) {
        const float* kvb = T.KVM + ((size_t)(b * 4 + h) * 8) * 16384;
        const float g256 = exp2f(lg2 * 256.0f);
#pragma unroll 2
        for (int it = 0; it < 8; ++it) { const int idx4 = tid + 512 * it; const int d = idx4 >> 5, e0 = (idx4 & 31) * 4;
            f32x4 acc4 = (f32x4){0.f, 0.f, 0.f, 0.f};
            for (int m = 0; m < qblk; ++m) acc4 = acc4 * g256 + *(const f32x4*)(kvb + (size_t)m * 16384 + d * 128 + e0);
            const int rp = (d & ~12) | ((d & 8) >> 1) | ((d & 4) << 1);
            typedef unsigned u32x2_ __attribute__((ext_vector_type(2)));
            u32x2_ w; w.x = cvtpk_s(acc4[0], acc4[1]); w.y = cvtpk_s(acc4[2], acc4[3]);
            *(FA_LAS u32x2_*)(shm + L_R + (e0 >> 5) * 8192 + rp * 64 + (e0 & 31) * 2) = w; }
        FA_LBAR();
        { FA_LAS const unsigned char* rb = shm + L_R + ((lane >> 4) & 1) * 32 + (lane & 3) * 8 + (4 * hi + ((lane & 15) >> 2)) * 64;
#pragma unroll
          for (int db = 0; db < NDB; ++db)
#pragma unroll
              for (int d0 = 0; d0 < ND0; ++d0) { const s16x4 lo = vtr(rb + db * 8192 + d0 * 1024), hh = vtr(rb + db * 8192 + d0 * 1024 + 512);
                  const bf16x8 rf = (bf16x8){lo[0], lo[1], lo[2], lo[3], hh[0], hh[1], hh[2], hh[3]};
                  o[db] = __builtin_amdgcn_mfma_f32_32x32x16_f16(__builtin_bit_cast(h16::f16x8_t, qr[d0]), __builtin_bit_cast(h16::f16x8_t, rf), o[db], 0, 0, 0); } }
#pragma unroll
        for (int r = 0; r < 16; ++r) { const float rd = exp2f(lg2 * (float)(wid * 32 + crow(r, hi) + 1));
#pragma unroll
            for (int db = 0; db < NDB; ++db) o[db][r] *= rd; }
    }
    const int qrel = wid * 32 + r32;
    for (int i = 0; i < NT; ++i) {
        { const int ahead = (NT - 1 - i) < (DIST - 1) ? (NT - 1 - i) : (DIST - 1);
          if (ahead == 2) { if (PER == 2) asm volatile("s_waitcnt vmcnt(4) lgkmcnt(0)\n\ts_barrier" ::: "memory"); else asm volatile("s_waitcnt vmcnt(8) lgkmcnt(0)\n\ts_barrier" ::: "memory"); }
          else if (ahead == 1) { if (PER == 2) asm volatile("s_waitcnt vmcnt(2) lgkmcnt(0)\n\ts_barrier" ::: "memory"); else asm volatile("s_waitcnt vmcnt(4) lgkmcnt(0)\n\ts_barrier" ::: "memory"); }
          else FA_WAIT_BAR(); }
        if (i + DIST < NT) FA_DMA(i + DIST);
        const bool diag = i < 4; const int t = i & 3; const int j = diag ? qblk : (qblk - 1 - ((i - 4) >> 2));
        const bool mysel = RET ? true : (((selmask >> j) & 1u) != 0u);
        const bool skip = diag ? (64 * t > 32 * wid + 31) : (RET ? false : !__any(mysel));
        if (skip) continue;
        const unsigned so = (unsigned)((i % NS) * SLOT);
        f32x16 p0 = RET ? f32x16{} : negm, p1 = p0;
        { FA_LAS const unsigned char* kb = shm + L_K + so + hi * 1024 + r32 * 16;
#pragma unroll
          for (int d0 = 0; d0 < ND0; ++d0) { const bf16x8 b0 = *(FA_LAS const bf16x8*)(kb + d0 * 2048); const bf16x8 b1 = *(FA_LAS const bf16x8*)(kb + d0 * 2048 + 512);
              p0 = __builtin_amdgcn_mfma_f32_32x32x16_f16(__builtin_bit_cast(h16::f16x8_t, b0), __builtin_bit_cast(h16::f16x8_t, qr[d0]), p0, 0, 0, 0); p1 = __builtin_amdgcn_mfma_f32_32x32x16_f16(__builtin_bit_cast(h16::f16x8_t, b1), __builtin_bit_cast(h16::f16x8_t, qr[d0]), p1, 0, 0, 0); } }
        if (RET) {
            const int qpos = q0 + qrel; const int kv0 = j * 256 + t * 64;
            const float base = (float)(qpos - kv0 - 4 * hi);
            const float rf0 = exp2f(lg2 * base), rf1 = exp2f(lg2 * (base - 32.0f));
#pragma unroll
            for (int r = 0; r < 16; ++r) { p0[r] *= rf0 * cfac[r]; p1[r] *= rf1 * cfac[r]; }
            if (diag) { const int kb_ = 64 * t + 4 * hi;
#pragma unroll
                for (int r = 0; r < 16; ++r) { const int kv = kb_ + (r & 3) + 8 * (r >> 2); if (kv > qrel) p0[r] = 0.f; if (kv + 32 > qrel) p1[r] = 0.f; } }
        } else {
            if (diag) { const int kb_ = 64 * t + 4 * hi;
#pragma unroll
                for (int r = 0; r < 16; ++r) { const int kv = kb_ + (r & 3) + 8 * (r >> 2); if (kv > qrel) p0[r] = NEG; if (kv + 32 > qrel) p1[r] = NEG; } }
            else if (!mysel) {
#pragma unroll
                for (int r = 0; r < 16; ++r) { p0[r] = NEG; p1[r] = NEG; } }
            float rm = fmaxf(fmaxf(p0[0], p1[0]), p0[1]);
#pragma unroll
            for (int r = 1; r < 16; ++r) { rm = fmaxf(fmaxf(rm, p1[r]), (r < 15) ? p0[r + 1] : p1[r]); }
            rm = xl::max32(rm);
            if (__any(rm > THR)) {
                const float dl = fmaxf(rm, 0.f);
                mhat += dl;
#pragma unroll
                for (int r = 0; r < 16; ++r) { p0[r] -= dl; p1[r] -= dl; }
#pragma unroll
                for (int r = 0; r < 16; ++r) negm[r] = -mhat;
                const float f = __builtin_amdgcn_exp2f(-dl); lrow *= f;
                asm volatile("" ::: "memory");
                if (hi == 0) wsf[r32] = f;
                asm volatile("s_waitcnt lgkmcnt(0)" ::: "memory");
#pragma unroll
                for (int r = 0; r < 16; ++r) { const float fr_ = wsf[crow(r, hi)];
#pragma unroll
                    for (int db = 0; db < NDB; ++db) o[db][r] *= fr_; }
                asm volatile("s_waitcnt lgkmcnt(0)" ::: "memory");
            }
            float s = 0.f;
#pragma unroll
            for (int r = 0; r < 16; ++r) { p0[r] = __builtin_amdgcn_exp2f(p0[r]); p1[r] = __builtin_amdgcn_exp2f(p1[r]); s += p0[r] + p1[r]; }
            lrow += s;
        }
        bf16x8 pa[4];
        { u32x4 w;
          w.x = cvtpk_s(p0[0], p0[1]); w.y = cvtpk_s(p0[2], p0[3]); w.z = cvtpk_s(p0[4], p0[5]); w.w = cvtpk_s(p0[6], p0[7]); pa[0] = __builtin_bit_cast(bf16x8, w);
          w.x = cvtpk_s(p0[8], p0[9]); w.y = cvtpk_s(p0[10], p0[11]); w.z = cvtpk_s(p0[12], p0[13]); w.w = cvtpk_s(p0[14], p0[15]); pa[1] = __builtin_bit_cast(bf16x8, w);
          w.x = cvtpk_s(p1[0], p1[1]); w.y = cvtpk_s(p1[2], p1[3]); w.z = cvtpk_s(p1[4], p1[5]); w.w = cvtpk_s(p1[6], p1[7]); pa[2] = __builtin_bit_cast(bf16x8, w);
          w.x = cvtpk_s(p1[8], p1[9]); w.y = cvtpk_s(p1[10], p1[11]); w.z = cvtpk_s(p1[12], p1[13]); w.w = cvtpk_s(p1[14], p1[15]); pa[3] = __builtin_bit_cast(bf16x8, w); }
        { FA_LAS const unsigned char* vb = shm + L_V + so + ((lane >> 4) & 1) * 32 + (lane & 3) * 8 + (4 * hi + ((lane & 15) >> 2)) * 64;
#pragma unroll
          for (int db = 0; db < NDB; ++db)
#pragma unroll
              for (int ks = 0; ks < 4; ++ks) { const s16x4 lo = vtr(vb + db * 4096 + ks * 1024), hh = vtr(vb + db * 4096 + ks * 1024 + 512);
                  const bf16x8 vf = (bf16x8){lo[0], lo[1], lo[2], lo[3], hh[0], hh[1], hh[2], hh[3]};
                  o[db] = __builtin_amdgcn_mfma_f32_32x32x16_f16(__builtin_bit_cast(h16::f16x8_t, pa[ks]), __builtin_bit_cast(h16::f16x8_t, vf), o[db], 0, 0, 0); } }
    }
    float rli[16];
    if (!RET) {
        const float l = xl::add32(lrow);
        asm volatile("" ::: "memory");
        if (hi == 0) wsf[32 + r32] = 1.0f / l;
        asm volatile("s_waitcnt lgkmcnt(0)" ::: "memory");
#pragma unroll
        for (int r = 0; r < 16; ++r) rli[r] = wsf[32 + crow(r, hi)];
    } else {
#pragma unroll
        for (int r = 0; r < 16; ++r) rli[r] = 1.0f;
    }
    FA_LBAR();
    FA_LAS bf16_t* stg = (FA_LAS bf16_t*)(shm + wid * 8192);
#pragma unroll
    for (int r = 0; r < 16; ++r) { const int orow = crow(r, hi);
#pragma unroll
        for (int db = 0; db < NDB; ++db) { const unsigned pk = cvtpk_s(o[db][r] * rli[r], 0.f); stg[orow * DH + db * 32 + r32] = (bf16_t)(pk & 0xffffu); } }
    asm volatile("s_waitcnt lgkmcnt(0)" ::: "memory");
    const size_t tok0 = rowbase + q0 + wid * 32;
    if (!RET) {
#pragma unroll
        for (int i = 0; i < 4; ++i) { const int row = i * 8 + (lane >> 3), ch = lane & 7;
            const u32x4 v = *(FA_LAS const u32x4*)(stg + row * 64 + ch * 8);
            float ss = 0.f;
#pragma unroll
            for (int k = 0; k < 4; ++k) { const float a = h16::lo(v[k]), c = h16::hi(v[k]); ss += a * a + c * c; }
            ss += xl::xor_f<1>(ss); ss += xl::xor_f<2>(ss); ss += xl::xor_f<4>(ss);
            if (ch == 0) T.ASSQ[(tok0 + row) * 8 + h] = ss;
            *(u32x4*)(T.CAT + (tok0 + row) * 1024 + h * 64 + ch * 8) = v; }
    } else {
#pragma unroll
        for (int i = 0; i < 8; ++i) { const int row = i * 4 + (lane >> 4), ch = lane & 15;
            const u32x4 v = *(FA_LAS const u32x4*)(stg + row * 128 + ch * 8);
            float x[8];
#pragma unroll
            for (int k = 0; k < 4; ++k) { x[2 * k] = h16::lo(v[k]); x[2 * k + 1] = h16::hi(v[k]); }
            float ss = 0.f;
#pragma unroll
            for (int k = 0; k < 8; ++k) ss += x[k] * x[k];
            ss += xl::xor_f<1>(ss); ss += xl::xor_f<2>(ss); ss += xl::xor_f<4>(ss); ss += xl::xor_f<8>(ss);
            const float rs = 1.0f / sqrtf(ss * (1.0f / 128.0f) + 1e-6f);
            const u32x4 gv = *(const u32x4*)(T.GR + (tok0 + row) * 512 + h * 128 + ch * 8);
            const f32x4 w0 = *(const f32x4*)(T.ret_g + h * 128 + ch * 8), w1 = *(const f32x4*)(T.ret_g + h * 128 + ch * 8 + 4);
            const float wg[8] = {w0[0], w0[1], w0[2], w0[3], w1[0], w1[1], w1[2], w1[3]};
            float y[8];
#pragma unroll
            for (int k = 0; k < 4; ++k) { const float g0 = h16::lo(gv[k]), g1 = h16::hi(gv[k]);
                y[2 * k] = x[2 * k] * rs * wg[2 * k] * g0; y[2 * k + 1] = x[2 * k + 1] * rs * wg[2 * k + 1] * g1; }
            u32x4 ov; ov.x = cvtpk_s(y[0], y[1]); ov.y = cvtpk_s(y[2], y[3]); ov.z = cvtpk_s(y[4], y[5]); ov.w = cvtpk_s(y[6], y[7]);
            *(u32x4*)(T.CAT + (tok0 + row) * 1024 + 512 + h * 128 + ch * 8) = ov; }
    }
    FA_LBAR();
#undef FA_KV0
#undef FA_DMA
}

__device__ __forceinline__ void kv_unit(const int wv, int b, int h, int m, const bf16_t* Kg, const bf16_t* Vg, float* KVM, FA_LAS unsigned char* shm) {
    constexpr int SLOT = 16384, L_K = 0, L_V = 4 * SLOT;
    int tid_ = otid(wv);
    const int tid = tid_, lane = tid & 63, r32 = lane & 31, hi = lane >> 5; const int wid = __builtin_amdgcn_readfirstlane(tid >> 6);
    const int dg = wid >> 1, eh = wid & 1;
    const size_t rowbase = (size_t)b * 2048 + (size_t)m * 256;
    const unsigned lds0 = (unsigned)(unsigned long)shm;
    const bf16_t* Kh = Kg + rowbase * 512 + h * 128; const bf16_t* Vh = Vg + rowbase * 512 + h * 128;
#pragma unroll
    for (int t = 0; t < 4; ++t)
#pragma unroll
        for (int pp = 0; pp < 2; ++pp) { const int p = wid + 8 * pp; const size_t off = (size_t)(64 * t + 16 * (p & 3) + (lane >> 2)) * 512 + (p >> 2) * 32 + (lane & 3) * 8;
            glds16(Kh + off, (unsigned)__builtin_amdgcn_readfirstlane(lds0 + L_K + t * SLOT + p * 1024));
            glds16(Vh + off, (unsigned)__builtin_amdgcn_readfirstlane(lds0 + L_V + t * SLOT + p * 1024)); }
    const float lg2 = log2f(1.0f - exp2f(-5.0f - (float)h));
    const float g64 = exp2f(lg2 * 64.0f);
    h16::f16x8_t fd[4];
#pragma unroll
    for (int ks = 0; ks < 4; ++ks)
#pragma unroll
        for (int j = 0; j < 8; ++j) fd[ks][j] = (_Float16)exp2f(lg2 * (float)(63 - (16 * ks + 8 * (j >> 2) + 4 * hi + (j & 3))));
    f32x16 acc[2]; acc[0] = f32x16{}; acc[1] = f32x16{};
    FA_WAIT_BAR();
    const int lb = ((lane >> 4) & 1) * 32 + (lane & 3) * 8 + (4 * hi + ((lane & 15) >> 2)) * 64;
#pragma unroll
    for (int t = 0; t < 4; ++t) {
        if (t > 0) {
#pragma unroll
            for (int r = 0; r < 16; ++r) { acc[0][r] *= g64; acc[1][r] *= g64; } }
        FA_LAS const unsigned char* kb = shm + L_K + t * SLOT + dg * 4096 + lb; FA_LAS const unsigned char* vb = shm + L_V + t * SLOT + (2 * eh) * 4096 + lb;
#pragma unroll
        for (int ks = 0; ks < 4; ++ks) { const s16x4 klo = vtr(kb + ks * 1024), khi = vtr(kb + ks * 1024 + 512);
            const h16::f16x8_t kf = __builtin_bit_cast(h16::f16x8_t, (bf16x8){klo[0], klo[1], klo[2], klo[3], khi[0], khi[1], khi[2], khi[3]});
#pragma unroll
            for (int eb = 0; eb < 2; ++eb) { const s16x4 vlo = vtr(vb + eb * 4096 + ks * 1024), vhi = vtr(vb + eb * 4096 + ks * 1024 + 512);
                const h16::f16x8_t vf = __builtin_bit_cast(h16::f16x8_t, (bf16x8){vlo[0], vlo[1], vlo[2], vlo[3], vhi[0], vhi[1], vhi[2], vhi[3]}) * fd[ks];
                acc[eb] = __builtin_amdgcn_mfma_f32_32x32x16_f16(kf, vf, acc[eb], 0, 0, 0); } }
    }
    float* op = KVM + ((size_t)(b * 4 + h) * 8 + m) * 16384;
#pragma unroll
    for (int eb = 0; eb < 2; ++eb)
#pragma unroll
        for (int r = 0; r < 16; ++r) op[(size_t)(32 * dg + crow(r, hi)) * 128 + 64 * eh + 32 * eb + r32] = acc[eb][r];
    FA_LBAR();
}
}
namespace mk {
#define GAS __attribute__((address_space(1)))
#define LAS __attribute__((address_space(3)))
typedef unsigned short bf16;
typedef unsigned v4u __attribute__((ext_vector_type(4)));
typedef unsigned v2u __attribute__((ext_vector_type(2)));
typedef float f32x4 __attribute__((ext_vector_type(4)));
typedef int i32x4 __attribute__((ext_vector_type(4)));
typedef GAS unsigned gu32;
#define RLX_AGENT __ATOMIC_RELAXED, __HIP_MEMORY_SCOPE_AGENT
#define LDS_WAIT() asm volatile("s_waitcnt lgkmcnt(0)" ::: "memory")
#define VM_WAIT() asm volatile("s_waitcnt vmcnt(0)" ::: "memory")
constexpr int NWAVES = 8;
constexpr size_t MiB = 1u << 20, KiB = 1u << 10;
constexpr size_t WS_CTL = 0;
constexpr size_t CTL_ZERO_BYTES = 64 * KiB;
constexpr size_t WS_MOD = 64 * KiB;
constexpr size_t WS_KMP = 512 * KiB;
constexpr size_t WS_EIDX = 768 * KiB;
constexpr size_t WS_EW = 896 * KiB;
constexpr size_t WS_ROPE = 1 * MiB;
constexpr size_t WS_ASSQ = 2 * MiB;
constexpr size_t WS_SROW = 2 * MiB + 512 * KiB;
constexpr size_t WS_SWT = 2 * MiB + 768 * KiB;
constexpr size_t WS_WCNT = 3 * MiB;
constexpr size_t WS_SEG = 3 * MiB + 64 * KiB;
constexpr size_t WS_ATOMF = 3 * MiB + 128 * KiB;
constexpr size_t WS_SEGD = 3 * MiB + 65 * KiB;
constexpr size_t WS_MGU = 8 * MiB;
constexpr size_t WS_SLAB = 8 * MiB;
constexpr size_t WS_MDN = 96 * MiB;
constexpr size_t WS_XA = 140 * MiB;
constexpr size_t WS_XS = 172 * MiB;
constexpr size_t WS_KVM = 172 * MiB;
constexpr size_t WS_YS = 140 * MiB;
constexpr size_t WS_WIN = 240 * MiB;
constexpr size_t WS_WOUT = 254 * MiB;
constexpr size_t WS_FGU = 258 * MiB;
constexpr size_t WS_FDN = 269 * MiB;
constexpr size_t WS_QKV = 275 * MiB;
constexpr size_t WS_CAT = 387 * MiB;
constexpr size_t WS_HD = 275 * MiB;
constexpr size_t WS_HM = 240 * MiB;
constexpr size_t WS_END = 428 * MiB;
constexpr int XS_ROWS = 34816;
constexpr int CW_BAR = 1024;

constexpr int RING_BYTES = 131072, LDSCTL_OFF = RING_BYTES, MISC_OFF = LDSCTL_OFF + 320, LDS_BYTES = 147456;

#define XB_TMO      128
#define XB_XCNT(j)  (256  + 64 * (j))
#define XB_XSUB(j)  (1280 + 64 * (j))
#define XB_XGEN(j)  (2304 + 64 * (j))
#define XB_TOP      3328
#define XB_TOPGEN   3392
#define XCD_BAR_WORDS 3456
#define XB_SPIN_CAP (1u << 18)
__device__ __forceinline__ unsigned xb_ld(unsigned* p)              { return __hip_atomic_load(p, __ATOMIC_RELAXED, __HIP_MEMORY_SCOPE_AGENT); }
__device__ __forceinline__ unsigned xb_add(unsigned* p, unsigned v) { return __hip_atomic_fetch_add(p, v, __ATOMIC_RELAXED, __HIP_MEMORY_SCOPE_AGENT); }
__device__ __forceinline__ unsigned xb_xcc_id() { return (unsigned)__builtin_amdgcn_s_getreg((3 << 11) | 20) & 0xFu; }
#define XB_SPIN(cond, bar) do { unsigned _sp = 0; while (cond) { __builtin_amdgcn_s_sleep(1); \
    if ((++_sp & 255u) == 0u) { if (xb_ld(&(bar)[XB_TMO])) break; if (_sp > XB_SPIN_CAP) { atomicAdd(&(bar)[XB_TMO], 1u); break; } } } } while (0)
struct XcdBarrier { unsigned* bar; unsigned x; volatile LAS unsigned* st; int wv; };
__device__ __forceinline__ XcdBarrier xcd_barrier_post(unsigned* bar, volatile LAS unsigned* st, int wv) {
    XcdBarrier b; b.bar = bar; b.x = xb_xcc_id(); b.st = st; b.wv = wv;
    if (otid(wv) == 0) (void)xb_add(&bar[XB_XCNT(b.x)], 1u);
    return b;
}
__device__ __forceinline__ void xcd_barrier_complete(unsigned* bar, unsigned x, unsigned& nloc, unsigned& nx) {
    const unsigned G = gridDim.x * gridDim.y * gridDim.z;
    unsigned sum, cnt, mine, sp = 0u;
    for (;;) {
        sum = 0u; cnt = 0u; mine = 0u;
#pragma unroll
        for (unsigned j = 0; j < 16; ++j) { const unsigned c = xb_ld(&bar[XB_XCNT(j)]); sum += c; cnt += (c > 0u) ? 1u : 0u; mine = (j == x) ? c : mine; }
        if (sum == G) break;
        __builtin_amdgcn_s_sleep(1);
        if ((++sp & 255u) == 0u) { if (xb_ld(&bar[XB_TMO])) break; if (sp > XB_SPIN_CAP) { atomicAdd(&bar[XB_TMO], 1u); break; } }
    }
    nloc = mine > 0u ? mine : 1u; nx = cnt > 0u ? cnt : 1u;
}
__device__ __forceinline__ void xcd_barrier(const XcdBarrier& b) {
    asm volatile("s_waitcnt vmcnt(0)" ::: "memory");
    __syncthreads();
    if (otid(b.wv) == 0) {
        unsigned* bar = b.bar;
        __builtin_amdgcn_s_waitcnt(0);
        unsigned nloc = b.st[0], nx = b.st[1];
        if (nloc == 0u) { xcd_barrier_complete(bar, b.x, nloc, nx); b.st[0] = nloc; b.st[1] = nx; }
        const unsigned old = xb_add(&bar[XB_XSUB(b.x)], 1u);
        const unsigned gen = old / nloc;
        if (old + 1u == (gen + 1u) * nloc) {
            __builtin_amdgcn_fence(__ATOMIC_RELEASE, "agent");
            asm volatile("s_waitcnt vmcnt(0)" ::: "memory");
            const unsigned og = xb_add(&bar[XB_TOP], 1u);
            const unsigned tg = og / nx;
            if (og + 1u == (tg + 1u) * nx) xb_add(&bar[XB_TOPGEN], 1u);
            else XB_SPIN(xb_ld(&bar[XB_TOPGEN]) == tg, bar);
            __builtin_amdgcn_fence(__ATOMIC_ACQUIRE, "agent");
            xb_add(&bar[XB_XGEN(b.x)], 1u);
            asm volatile("s_waitcnt vmcnt(0)" ::: "memory");
        } else {
            XB_SPIN(xb_ld(&bar[XB_XGEN(b.x)]) == gen, bar);
            __builtin_amdgcn_fence(__ATOMIC_ACQUIRE, "agent");
            asm volatile("s_waitcnt vmcnt(0)" ::: "memory");
        }
    }
    __syncthreads();
}

__device__ __forceinline__ unsigned f2bf(float f) { unsigned u = __builtin_bit_cast(unsigned, f); return (u + 0x7fffu + ((u >> 16) & 1u)) >> 16; }
__device__ __forceinline__ unsigned pk2(float lo, float hi) { return h16::pk(lo, hi); }
using xl::wave_sum; using xl::wave_sum_i;

struct Inputs {
    const float *x, *c, *norm_mix_g, *norm_ffn_g, *ada_w, *ada_b, *w_in, *w_out, *att_g, *ret_g, *fw_gate, *fw_up, *fw_down, *router_w, *mw_gate, *mw_up, *mw_down, *final_g;
};

template <class SrcFn> __device__ __forceinline__ void transpose_item(SrcFn src, int K, bf16* WT, int k0, int n0, LAS float* scr, int lane) {
#pragma unroll 8
    for (int i = 0; i < 32; ++i) { const int kk = 2 * i + (lane >> 5); scr[kk * 33 + (lane & 31)] = src(k0 + kk, n0 + (lane & 31)); }
    LDS_WAIT(); asm volatile("" ::: "memory");
    const int c = lane & 7;
#pragma unroll
    for (int j = 0; j < 4; ++j) { const int n = (lane >> 3) + 8 * j; const LAS float* s = scr + (8 * c) * 33 + n;
        v4u o; o.x = pk2(s[0 * 33], s[1 * 33]); o.y = pk2(s[2 * 33], s[3 * 33]); o.z = pk2(s[4 * 33], s[5 * 33]); o.w = pk2(s[6 * 33], s[7 * 33]);
        *(GAS v4u*)(WT + (size_t)(n0 + n) * K + k0 + 8 * c) = o; }
    LDS_WAIT(); asm volatile("" ::: "memory");
}
__device__ __forceinline__ int rot_src_col(int n) {
    if (n < 1536 || n >= 2560) return n;
    const int hb = (n - 1536) & ~127, p = (n - 1536) & 127;
    return 1536 + hb + 4 * (p >> 3) + ((p & 7) >> 1) + 64 * (p & 1);
}
constexpr int IT_WIN = 16 * 112, IT_WOUT = 16 * 32, IT_GU = 16 * 176, IT_DN = 44 * 32;
constexpr int IT_TOTAL = 2 * IT_WIN + 2 * IT_WOUT + IT_GU + IT_DN + 8 * (IT_GU + IT_DN);

constexpr int IT_NONMOE = 2 * IT_WIN + 2 * IT_WOUT + IT_GU + IT_DN;
__device__ __forceinline__ void convert_item(const Inputs& in, unsigned char* ws, int it, LAS float* scr, int lane) {
    int r = it;
    if (r < 2 * IT_WIN) { const int l = r / IT_WIN; r -= l * IT_WIN; const float* W = in.w_in + (size_t)l * 1024 * 3584;
        transpose_item([=](int k, int n) { return W[(size_t)k * 3584 + rot_src_col(n)]; }, 1024, (bf16*)(ws + WS_WIN) + (size_t)l * 3584 * 1024, 64 * (r / 112), 32 * (r % 112), scr, lane); return; }
    r -= 2 * IT_WIN;
    if (r < 2 * IT_WOUT) { const int l = r / IT_WOUT; r -= l * IT_WOUT; const float* W = in.w_out + (size_t)l * 1024 * 1024; const float* ag = in.att_g + l * 512;
        transpose_item([=](int k, int n) { return W[(size_t)k * 1024 + n] * (k < 512 ? ag[k] : 1.0f); }, 1024, (bf16*)(ws + WS_WOUT) + (size_t)l * 1024 * 1024, 64 * (r / 32), 32 * (r % 32), scr, lane); return; }
    r -= 2 * IT_WOUT;
    const float *Wg, *Wu, *Wd; bf16 *Dgu, *Ddn;
    if (r < IT_GU + IT_DN) { Wg = in.fw_gate; Wu = in.fw_up; Wd = in.fw_down; Dgu = (bf16*)(ws + WS_FGU); Ddn = (bf16*)(ws + WS_FDN); }
    else { r -= IT_GU + IT_DN; const int e = r / (IT_GU + IT_DN); r -= e * (IT_GU + IT_DN);
        Wg = in.mw_gate + (size_t)e * 1024 * 2816; Wu = in.mw_up + (size_t)e * 1024 * 2816; Wd = in.mw_down + (size_t)e * 2816 * 1024;
        Dgu = (bf16*)(ws + WS_MGU) + (size_t)e * 5632 * 1024; Ddn = (bf16*)(ws + WS_MDN) + (size_t)e * 1024 * 2816; }
    if (r < IT_GU) {
        transpose_item([=](int k, int n) { const float* W = ((n >> 7) & 1) ? Wu : Wg; return W[(size_t)k * 2816 + (n >> 8) * 128 + (n & 127)]; }, 1024, Dgu, 64 * (r / 176), 32 * (r % 176), scr, lane); return; }
    r -= IT_GU;
    transpose_item([=](int k, int n) { return Wd[(size_t)k * 1024 + n]; }, 2816, Ddn, 64 * (r / 32), 32 * (r % 32), scr, lane);
}
struct MoeItem { const float* src; bf16* dst; int ld, K, k0, n0; const float* rscale; float f8scale; };
template <int KIND  , class InP> __device__ __forceinline__ MoeItem moe_item(InP inp, unsigned char* ws, int it, int lane) {
    MoeItem m; m.rscale = nullptr; m.f8scale = (KIND == 0) ? 32.0f : 64.0f;
    if (KIND == 0) { const int e = it / IT_GU, r = it - e * IT_GU; const int kb = r / 176, nb = r % 176; const int n = 32 * nb; m.k0 = 64 * kb; m.n0 = n; m.ld = 2816; m.K = 1024;
        const float* W = (((n >> 7) & 1) ? inp->mw_up : inp->mw_gate) + (size_t)e * 1024 * 2816;
        m.src = W + (size_t)(m.k0 + (lane >> 5)) * 2816 + (n >> 8) * 128 + (n & 127) + (lane & 31); m.dst = (bf16*)(ws + WS_MGU + (size_t)e * 5632 * 1024); }
    else { const int e = it / IT_DN, r = it - e * IT_DN; const int kb = r / 32, nb = r % 32; m.k0 = 64 * kb; m.n0 = 32 * nb; m.ld = 1024; m.K = 2816;
        m.src = inp->mw_down + (size_t)e * 2816 * 1024 + (size_t)(m.k0 + (lane >> 5)) * 1024 + m.n0 + (lane & 31); m.dst = (bf16*)(ws + WS_MDN + (size_t)e * 1024 * 2816); }
    return m;
}
__device__ __forceinline__ void moe_item_load(const MoeItem& m, float (&v)[32]) {
#pragma unroll
    for (int i = 0; i < 32; ++i) v[i] = m.src[(size_t)(2 * i) * m.ld];
}
__device__ __forceinline__ void moe_item_finish(const MoeItem& m, const float (&v)[32], LAS float* scr, int lane) {
    if (m.rscale != nullptr && m.k0 < 512) {
#pragma unroll
        for (int i = 0; i < 32; ++i) scr[(2 * i + (lane >> 5)) * 33 + (lane & 31)] = v[i] * m.rscale[m.k0 + 2 * i + (lane >> 5)];
    } else {
#pragma unroll
        for (int i = 0; i < 32; ++i) scr[(2 * i + (lane >> 5)) * 33 + (lane & 31)] = v[i];
    }
    LDS_WAIT(); asm volatile("" ::: "memory");
    const int c = lane & 7;
    if (m.f8scale != 0.f) {
        const float sc = m.f8scale; unsigned char* d8 = (unsigned char*)m.dst;
#pragma unroll
        for (int j = 0; j < 4; ++j) { const int n = (lane >> 3) + 8 * j; const LAS float* s = scr + (8 * c) * 33 + n;
            v2u o; int p = 0; p = __builtin_amdgcn_cvt_pk_fp8_f32(s[0 * 33] * sc, s[1 * 33] * sc, p, false); p = __builtin_amdgcn_cvt_pk_fp8_f32(s[2 * 33] * sc, s[3 * 33] * sc, p, true); o.x = (unsigned)p;
            p = 0; p = __builtin_amdgcn_cvt_pk_fp8_f32(s[4 * 33] * sc, s[5 * 33] * sc, p, false); p = __builtin_amdgcn_cvt_pk_fp8_f32(s[6 * 33] * sc, s[7 * 33] * sc, p, true); o.y = (unsigned)p;
            *(GAS v2u*)(d8 + (size_t)(m.n0 + n) * m.K + m.k0 + 8 * c) = o; }
    } else {
#pragma unroll
        for (int j = 0; j < 4; ++j) { const int n = (lane >> 3) + 8 * j; const LAS float* s = scr + (8 * c) * 33 + n;
            v4u o; o.x = pk2(s[0 * 33], s[1 * 33]); o.y = pk2(s[2 * 33], s[3 * 33]); o.z = pk2(s[4 * 33], s[5 * 33]); o.w = pk2(s[6 * 33], s[7 * 33]);
            *(GAS v4u*)(m.dst + (size_t)(m.n0 + n) * m.K + m.k0 + 8 * c) = o; }
    }
    LDS_WAIT(); asm volatile("" ::: "memory");
}
template <class InP> __device__ __forceinline__ MoeItem base_item(InP inp, unsigned char* ws, int it, int lane) {
    MoeItem m; m.rscale = nullptr; m.f8scale = 0.f; int r = it;
    if (r < 2 * IT_WIN) { const int l = r / IT_WIN; r -= l * IT_WIN; m.k0 = 64 * (r / 112); m.n0 = 32 * (r % 112); m.ld = 3584; m.K = 1024;
        m.src = inp->w_in + (size_t)l * 1024 * 3584 + (size_t)(m.k0 + (lane >> 5)) * 3584 + rot_src_col(m.n0 + (lane & 31)); m.dst = (bf16*)(ws + WS_WIN) + (size_t)l * 3584 * 1024; return m; }
    r -= 2 * IT_WIN;
    if (r < 2 * IT_WOUT) { const int l = r / IT_WOUT; r -= l * IT_WOUT; m.k0 = 64 * (r / 32); m.n0 = 32 * (r % 32); m.ld = 1024; m.K = 1024; m.rscale = inp->att_g + l * 512;
        m.src = inp->w_out + (size_t)l * 1024 * 1024 + (size_t)(m.k0 + (lane >> 5)) * 1024 + m.n0 + (lane & 31); m.dst = (bf16*)(ws + WS_WOUT) + (size_t)l * 1024 * 1024; return m; }
    r -= 2 * IT_WOUT;
    if (r < IT_GU) { const int n = 32 * (r % 176); m.k0 = 64 * (r / 176); m.n0 = n; m.ld = 2816; m.K = 1024;
        m.src = (((n >> 7) & 1) ? inp->fw_up : inp->fw_gate) + (size_t)(m.k0 + (lane >> 5)) * 2816 + (n >> 8) * 128 + (n & 127) + (lane & 31); m.dst = (bf16*)(ws + WS_FGU); return m; }
    r -= IT_GU; m.k0 = 64 * (r / 32); m.n0 = 32 * (r % 32); m.ld = 1024; m.K = 2816;
    m.src = inp->fw_down + (size_t)(m.k0 + (lane >> 5)) * 1024 + m.n0 + (lane & 31); m.dst = (bf16*)(ws + WS_FDN); return m;
}
template <class InP> __device__ __forceinline__ void convert_base_all(InP inp, unsigned char* ws, LAS unsigned char* lds, int gw, int NGW, int wave, int lane) {
    LAS float* scr = (LAS float*)(lds + wave * 16384);
    int it = gw; if (it >= IT_NONMOE) return;
    float va[32], vb[32];
    MoeItem ma = base_item(inp, ws, it, lane), mb = ma; moe_item_load(ma, va);
    for (;;) {
        const bool hb = (it + NGW) < IT_NONMOE; if (hb) { mb = base_item(inp, ws, it + NGW, lane); moe_item_load(mb, vb); }
        moe_item_finish(ma, va, scr, lane);
        if (!hb) break;
        it += NGW;
        const bool ha = (it + NGW) < IT_NONMOE; if (ha) { ma = base_item(inp, ws, it + NGW, lane); moe_item_load(ma, va); }
        moe_item_finish(mb, vb, scr, lane);
        if (!ha) break;
        it += NGW;
    }
}
template <int KIND, class InP> __device__ __forceinline__ void convert_moe_range(InP inp, unsigned char* ws, LAS unsigned char* lds, int it0, int it1, int sp, int nsp, int wave, int lane) {
    LAS float* scr = (LAS float*)(lds + wave * 16384);
    const int step = nsp * NWAVES; int it = it0 + sp * NWAVES + wave;
    if (it >= it1) return;
    float va[32], vb[32];
    MoeItem ma = moe_item<KIND>(inp, ws, it, lane), mb = ma; moe_item_load(ma, va);
    for (;;) {
        const bool hb = (it + step) < it1; if (hb) { mb = moe_item<KIND>(inp, ws, it + step, lane); moe_item_load(mb, vb); }
        moe_item_finish(ma, va, scr, lane);
        if (!hb) break;
        it += step;
        const bool ha = (it + step) < it1; if (ha) { ma = moe_item<KIND>(inp, ws, it + step, lane); moe_item_load(ma, va); }
        moe_item_finish(mb, vb, scr, lane);
        if (!ha) break;
        it += step;
    }
}
constexpr int IT_MOE = 8 * (IT_GU + IT_DN);
constexpr int G_INPROJ = 224, G_GUD = 240;
constexpr int IT_MGU = 8 * IT_GU, IT_MDN = 8 * IT_DN;
constexpr int IT_MOE_A = 7549, IT_MOE_B = 14980, IT_MDN_C = 4000;

template <class InP> __device__ __forceinline__ void p0_prologue(InP inp, unsigned char* ws, LAS unsigned char* lds, int vcu, int G, int wave, int lane, int tid, int moe_w) {
    Inputs in; in.c = inp->c; in.ada_w = inp->ada_w; in.ada_b = inp->ada_b; in.w_in = inp->w_in; in.w_out = inp->w_out; in.att_g = inp->att_g; in.fw_gate = inp->fw_gate; in.fw_up = inp->fw_up; in.fw_down = inp->fw_down; in.mw_gate = inp->mw_gate; in.mw_up = inp->mw_up; in.mw_down = inp->mw_down;
    if (vcu < 192) {
        LAS float* cs = (LAS float*)lds;
        LAS float* part = (LAS float*)(lds + 32768);
        for (int i = tid; i < 8 * 1024; i += 512) { const float v = in.c[i]; cs[i] = v / (1.0f + __expf(-v)); }
        __syncthreads();
        const int n0 = vcu * 64, l = n0 / 6144, nn = n0 % 6144 + lane;
        const float* wp = in.ada_w + (size_t)l * 1024 * 6144 + (size_t)(wave * 128) * 6144 + nn;
        float acc[8];
#pragma unroll
        for (int b = 0; b < 8; ++b) acc[b] = 0.f;
#pragma unroll 8
        for (int k = 0; k < 128; ++k) { const float wv = wp[(size_t)k * 6144];
#pragma unroll
            for (int b = 0; b < 8; ++b) acc[b] += cs[b * 1024 + wave * 128 + k] * wv; }
#pragma unroll
        for (int b = 0; b < 8; ++b) part[(wave * 8 + b) * 64 + lane] = acc[b];
        __syncthreads();
        { const int b = tid >> 6; float s = 0.f;
#pragma unroll
          for (int w = 0; w < 8; ++w) s += part[(w * 8 + b) * 64 + lane];
          ((float*)(ws + WS_MOD))[((size_t)l * 8 + b) * 6144 + nn] = s + in.ada_b[l * 6144 + nn]; }
        __syncthreads();
    }
    { const int g = vcu * 512 + tid; if (g < 2048 * 64) { const int pos = g >> 6, i = g & 63; const float inv = powf(10000.0f, -(float)i / 64.0f); const float ang = (float)pos * inv;
        float* rp = (float*)(ws + WS_ROPE) + (size_t)g * 2; rp[0] = (float)cos((double)ang); rp[1] = (float)sin((double)ang); } }
    convert_base_all(inp, ws, lds, vcu * NWAVES + wave, G * NWAVES, wave, lane);
}

template <int MODE>
__device__ __forceinline__ void norm_pass(const float* xsrc, const float* gain, const float* sh, const float* sc, bf16* dst,
                                          const float* router_w, int* eidx, float* ew, int* wcnt, int gw, int lane) {
    const int m0 = gw * 8, b = m0 >> 11;
    f32x4 gv[4], scv[4], shv[4];
#pragma unroll
    for (int j = 0; j < 4; ++j) { gv[j] = ((const f32x4*)gain)[lane + 64 * j]; scv[j] = ((const f32x4*)(sc + (size_t)b * 6144))[lane + 64 * j] + 1.0f; shv[j] = ((const f32x4*)(sh + (size_t)b * 6144))[lane + 64 * j]; }
    int cnt[8];
#pragma unroll
    for (int e = 0; e < 8; ++e) cnt[e] = 0;
    f32x4 rw[4][4][2];
    if (MODE == 1) {
#pragma unroll
        for (int j = 0; j < 4; ++j)
#pragma unroll
            for (int c = 0; c < 4; ++c) { const float* wp = router_w + (size_t)(4 * (lane + 64 * j) + c) * 8; rw[j][c][0] = *(const f32x4*)wp; rw[j][c][1] = *(const f32x4*)(wp + 4); }
    }
    for (int i = 0; i < 8; ++i) {
        const int m = m0 + i;
        const f32x4* xr = (const f32x4*)(xsrc + (size_t)m * 1024) + lane;
        f32x4 v[4]; float s = 0.f;
#pragma unroll
        for (int j = 0; j < 4; ++j) { v[j] = xr[64 * j]; s += (v[j][0] * v[j][0] + v[j][1] * v[j][1]) + (v[j][2] * v[j][2] + v[j][3] * v[j][3]); }
        const float rs = 1.0f / sqrtf(wave_sum(s) * (1.0f / 1024.0f) + 1e-6f);
        v2u* o8 = (v2u*)(dst + (size_t)m * 1024) + lane;
#pragma unroll
        for (int j = 0; j < 4; ++j) { v[j] = v[j] * rs * gv[j] * scv[j] + shv[j]; v2u w; w.x = pk2(v[j][0], v[j][1]); w.y = pk2(v[j][2], v[j][3]); o8[64 * j] = w; }
        if (MODE == 1) {
            float lg[8];
#pragma unroll
            for (int e = 0; e < 8; ++e) lg[e] = 0.f;
#pragma unroll
            for (int j = 0; j < 4; ++j)
#pragma unroll
                for (int c = 0; c < 4; ++c) { const f32x4 w0 = rw[j][c][0], w1 = rw[j][c][1];
                    const float hv = v[j][c];
                    lg[0] += hv * w0[0]; lg[1] += hv * w0[1]; lg[2] += hv * w0[2]; lg[3] += hv * w0[3]; lg[4] += hv * w1[0]; lg[5] += hv * w1[1]; lg[6] += hv * w1[2]; lg[7] += hv * w1[3]; }
            { const bool b5 = (lane & 32) != 0, b4 = (lane & 16) != 0, b3 = (lane & 8) != 0;
              float a4[4], b2[2], c1;
#pragma unroll
              for (int q = 0; q < 4; ++q) { const float keep = b5 ? lg[4 + q] : lg[q], send = b5 ? lg[q] : lg[4 + q]; a4[q] = keep + xl::xor32p(send, b5); }
#pragma unroll
              for (int q = 0; q < 2; ++q) { const float keep = b4 ? a4[2 + q] : a4[q], send = b4 ? a4[q] : a4[2 + q]; b2[q] = keep + xl::xor_f<16>(send); }
              { const float keep = b3 ? b2[1] : b2[0], send = b3 ? b2[0] : b2[1]; c1 = keep + xl::xor_f<8>(send); }
              c1 += xl::xor_f<4>(c1); c1 += xl::xor_f<2>(c1); c1 += xl::xor_f<1>(c1);
#pragma unroll
              for (int e = 0; e < 8; ++e) lg[e] = __builtin_bit_cast(float, __builtin_amdgcn_readlane(__builtin_bit_cast(int, c1), 8 * e)); }
            int i0 = 0; float b0 = lg[0];
#pragma unroll
            for (int e = 1; e < 8; ++e) if (lg[e] > b0) { b0 = lg[e]; i0 = e; }
            int i1 = -1; float b1 = -3.0e38f;
#pragma unroll
            for (int e = 0; e < 8; ++e) if (e != i0 && lg[e] > b1) { b1 = lg[e]; i1 = e; }
            const float e1 = __expf(b1 - b0);
#pragma unroll
            for (int e = 0; e < 8; ++e) cnt[e] += ((e == i0) ? 1 : 0) + ((e == i1) ? 1 : 0);
            if (lane == 0) { eidx[m * 2] = i0; eidx[m * 2 + 1] = i1; ew[m * 2] = 1.0f / (1.0f + e1); ew[m * 2 + 1] = e1 / (1.0f + e1); }
        }
    }
    if (MODE == 1) {
        int myc = 0;
#pragma unroll
        for (int e = 0; e < 8; ++e) myc = (lane == e) ? cnt[e] : myc;
        if (lane < 8) wcnt[gw * 8 + lane] = myc;
    }
}

__device__ __forceinline__ void place_pass(const int* wcnt, const int* eidx, const float* ew, const bf16* XA, bf16* XS, int* srow, float* swt, int* segout, int gw, int NGW, int lane) {
    int tot[8], pre[8];
#pragma unroll
    for (int e = 0; e < 8; ++e) { tot[e] = 0; pre[e] = 0; }
    for (int w = lane; w < NGW; w += 64) { const i32x4 a = *(const i32x4*)(wcnt + w * 8), c = *(const i32x4*)(wcnt + w * 8 + 4); const int inc = (w < gw) ? 1 : 0;
        tot[0] += a[0]; tot[1] += a[1]; tot[2] += a[2]; tot[3] += a[3]; tot[4] += c[0]; tot[5] += c[1]; tot[6] += c[2]; tot[7] += c[3];
        pre[0] += inc * a[0]; pre[1] += inc * a[1]; pre[2] += inc * a[2]; pre[3] += inc * a[3]; pre[4] += inc * c[0]; pre[5] += inc * c[1]; pre[6] += inc * c[2]; pre[7] += inc * c[3]; }
    int base[8]; int run = 0;
#pragma unroll
    for (int e = 0; e < 8; ++e) { tot[e] = wave_sum_i(tot[e]); pre[e] = wave_sum_i(pre[e]); base[e] = run + pre[e]; if (gw == 0 && lane == 0) segout[e] = run; run += (tot[e] + 255) & ~255; }
    if (gw == 0 && lane == 0) segout[8] = run;
    const int myev = (lane < 16) ? eidx[gw * 16 + lane] : 0; const float myw = (lane < 16) ? ew[gw * 16 + lane] : 0.f;
    int mypos = 0;
#pragma unroll
    for (int i = 0; i < 16; ++i) { const int ev = __builtin_amdgcn_readlane(myev, i); int pos = 0;
#pragma unroll
        for (int e = 0; e < 8; ++e) if (ev == e) { pos = base[e]; base[e] += 1; }
        mypos = (lane == i) ? pos : mypos; }
    if (lane < 16) { srow[mypos] = gw * 16 + lane; swt[mypos] = myw; }
    const v4u* __restrict__ s = (const v4u*)(XA + (size_t)(gw * 8) * 1024);
    v4u r0[8], r1[8];
#pragma unroll
    for (int t = 0; t < 8; ++t) { r0[t] = s[t * 128 + lane]; r1[t] = s[t * 128 + lane + 64]; }
    v2u q0[8], q1[8];
#pragma unroll
    for (int t = 0; t < 8; ++t) {
        { int p = 0; p = __builtin_amdgcn_cvt_pk_fp8_f32(h16::lo(r0[t].x), h16::hi(r0[t].x), p, false); p = __builtin_amdgcn_cvt_pk_fp8_f32(h16::lo(r0[t].y), h16::hi(r0[t].y), p, true); q0[t].x = (unsigned)p;
          p = 0; p = __builtin_amdgcn_cvt_pk_fp8_f32(h16::lo(r0[t].z), h16::hi(r0[t].z), p, false); p = __builtin_amdgcn_cvt_pk_fp8_f32(h16::lo(r0[t].w), h16::hi(r0[t].w), p, true); q0[t].y = (unsigned)p; }
        { int p = 0; p = __builtin_amdgcn_cvt_pk_fp8_f32(h16::lo(r1[t].x), h16::hi(r1[t].x), p, false); p = __builtin_amdgcn_cvt_pk_fp8_f32(h16::lo(r1[t].y), h16::hi(r1[t].y), p, true); q1[t].x = (unsigned)p;
          p = 0; p = __builtin_amdgcn_cvt_pk_fp8_f32(h16::lo(r1[t].z), h16::hi(r1[t].z), p, false); p = __builtin_amdgcn_cvt_pk_fp8_f32(h16::lo(r1[t].w), h16::hi(r1[t].w), p, true); q1[t].y = (unsigned)p; } }
#pragma unroll
    for (int i = 0; i < 16; ++i) { const int pos = __builtin_amdgcn_readlane(mypos, i); v2u* __restrict__ d = (v2u*)((unsigned char*)XS + (size_t)pos * 1024);
        d[lane] = q0[i >> 1]; d[lane + 64] = q1[i >> 1]; }
}

__device__ __forceinline__ void final_pass(float* xio, const bf16* YS, const int* atomf, const float* slab, const float* g2, const float* fg, int gw, int lane) {
    const int m0 = gw * 8, b = m0 >> 11;
    f32x4 gv[4], g2v[4];
#pragma unroll
    for (int j = 0; j < 4; ++j) { gv[j] = ((const f32x4*)fg)[lane + 64 * j]; g2v[j] = ((const f32x4*)(g2 + (size_t)b * 6144))[lane + 64 * j]; }
    for (int i = 0; i < 8; ++i) {
        const int m = m0 + i;
        f32x4* xr = (f32x4*)(xio + (size_t)m * 1024) + lane;
        const v2u* y0 = (const v2u*)(YS + (size_t)(2 * m) * 1024) + lane; const v2u* y1 = (const v2u*)(YS + (size_t)(2 * m + 1) * 1024) + lane;
        f32x4 v[4]; float s = 0.f; const i32x4 f0 = *(const i32x4*)(atomf + (size_t)(2 * m) * 4), f1 = *(const i32x4*)(atomf + (size_t)(2 * m + 1) * 4);
#pragma unroll
        for (int j = 0; j < 4; ++j) { v[j] = xr[64 * j]; const v2u a = y0[64 * j], c = y1[64 * j];
            f32x4 ya, yc;
            if (f0[j]) { const int id = f0[j] - 1; const float* sp = slab + ((size_t)((id >> 8) * 11) * 256 + (id & 255)) * 256 + 4 * lane; ya = (f32x4){0.f, 0.f, 0.f, 0.f};
                for (int kc = 0; kc < 11; ++kc) ya += *(const f32x4*)(sp + (size_t)kc * 65536); }
            else { ya[0] = h16::lo(a.x); ya[1] = h16::hi(a.x); ya[2] = h16::lo(a.y); ya[3] = h16::hi(a.y); }
            if (f1[j]) { const int id = f1[j] - 1; const float* sp = slab + ((size_t)((id >> 8) * 11) * 256 + (id & 255)) * 256 + 4 * lane; yc = (f32x4){0.f, 0.f, 0.f, 0.f};
                for (int kc = 0; kc < 11; ++kc) yc += *(const f32x4*)(sp + (size_t)kc * 65536); }
            else { yc[0] = h16::lo(c.x); yc[1] = h16::hi(c.x); yc[2] = h16::lo(c.y); yc[3] = h16::hi(c.y); }
            const f32x4 ys = ya + yc;
            v[j] = v[j] + g2v[j] * ys; s += (v[j][0] * v[j][0] + v[j][1] * v[j][1]) + (v[j][2] * v[j][2] + v[j][3] * v[j][3]); }
        const float rs = 1.0f / sqrtf(wave_sum(s) * (1.0f / 1024.0f) + 1e-6f);
#pragma unroll
        for (int j = 0; j < 4; ++j) xr[64 * j] = v[j] * rs * gv[j];
    }
}

constexpr int N_PHASES = 18;
struct Args { Inputs in; float* out; unsigned char* ws; int ph_lo, ph_hi, bar_region, moe_w; };

typedef const Args __attribute__((address_space(4))) CArgs;
__device__ __forceinline__ CArgs* kargs() { unsigned long off = 0; asm volatile("" : "+s"(off)); return (CArgs*)((const char __attribute__((address_space(4)))*)__builtin_amdgcn_kernarg_segment_ptr() + off); }

__global__ void __launch_bounds__(NWAVES * 64, 2) mega(Args args_unused) {
    extern __shared__ __attribute__((aligned(16))) unsigned char lds_raw[];
    LAS unsigned char* lds = (LAS unsigned char*)lds_raw;
    volatile LAS unsigned* MISC = (volatile LAS unsigned*)(lds + MISC_OFF);
    const int G = gridDim.x;
#define PHASE_IDS int tid = otid(WV); int bx = blockIdx.x; asm volatile("" : "+s"(bx)); const int lane = tid & 63, wave = __builtin_amdgcn_readfirstlane(tid >> 6); \
    const int vcu = (bx & 7) * (G >> 3) + (bx >> 3); const int gw = vcu * NWAVES + wave; (void)lane; (void)gw; (void)vcu;
    const int WV = __builtin_amdgcn_readfirstlane((int)threadIdx.x >> 6);
    for (int u = otid(WV); u < (LDS_BYTES - LDSCTL_OFF) / 4; u += NWAVES * 64) ((LAS unsigned*)(lds + LDSCTL_OFF))[u] = 0u;
    __syncthreads();
    XcdBarrier bar;
    { CArgs* ka = kargs(); unsigned* barw = (unsigned*)(ka->ws + WS_CTL) + CW_BAR + ka->bar_region * XCD_BAR_WORDS; bar = xcd_barrier_post(barw, MISC + 8, WV); }
    int lo, hi; { CArgs* ka = kargs(); lo = ka->ph_lo; hi = ka->ph_hi; }
#ifndef PHM
#define PHM 0x3ff
#endif
#define IN(k) (lo <= (k) && (k) < hi)
#define TY(t) (((PHM) >> (t)) & 1)
#ifndef DUP_T
#define DUP_T -1
#define DUP_N 0
#endif
#define REP(t) for (int rep_ = 0; rep_ < ((t) == DUP_T ? 1 + DUP_N : 1) && (rep_ == 0 || (__syncthreads(), true)); ++rep_)
#ifdef TPROBE
    volatile LAS unsigned long long* TS = (volatile LAS unsigned long long*)(lds + MISC_OFF + 256);
#define STAMP(k) do { if (blockIdx.x == 0 && threadIdx.x == 0) TS[(k)] = __builtin_amdgcn_s_memrealtime(); } while (0)
#else
#define STAMP(k) do {} while (0)
#endif
    STAMP(0);
#define SEAM(k) do { if (IN(k) && IN((k) + 1)) xcd_barrier(bar); STAMP((k) + 1); } while (0)

    if (TY(0) && IN(0)) REP(0) { PHASE_IDS CArgs* ka = kargs(); p0_prologue(&ka->in, ka->ws, lds, vcu, G, wave, lane, tid, 0); }
    SEAM(0);
#ifdef PROBE_BAR
    for (int q = 0; q < PROBE_BAR; ++q) xcd_barrier(bar);
#endif
    for (int l = 0; l < 2; ++l) {
        const int pb = 1 + 8 * l;
        if (TY(1) && IN(pb + 0)) REP(1) { PHASE_IDS CArgs* ka = kargs(); unsigned char* ws = ka->ws; const float* mod = (const float*)(ws + WS_MOD) + (size_t)l * 8 * 6144;
            const float* xin = (l == 0) ? ka->in.x : (const float*)ka->out;
            if (gw < 2048) norm_pass<0>(xin, ka->in.norm_mix_g + l * 1024, mod + 0 * 1024, mod + 1 * 1024, (bf16*)(ws + WS_XA), nullptr, nullptr, nullptr, nullptr, gw, lane); }
        SEAM(pb + 0);
        if (TY(2) && IN(pb + 1)) REP(2) { PHASE_IDS CArgs* ka = kargs(); unsigned char* ws = ka->ws;
            if (bx < G_INPROJ) {
                pg8::Gemm g{1024, 1024, 1024}; pg8::DenseSched S; S.init(ws + WS_XA, 1024, (bf16*)(ws + WS_WIN) + (size_t)l * 3584 * 1024, 1024, 16384, 3584, G_INPROJ, bx);
                epi::EpiInProj E{(bf16*)(ws + WS_QKV), (size_t)16384 * 512, (float*)(ws + WS_KMP), (const float*)(ws + WS_ROPE)};
                pg8::gemm_phase(WV, lds, g, S, E);
            } else if (rep_ == 0) { convert_moe_range<0>(&ka->in, ws, lds, l == 0 ? 0 : IT_MOE_B, l == 0 ? IT_MOE_A : IT_MGU, bx - G_INPROJ, G - G_INPROJ, wave, lane);
                                    if (l == 1) convert_moe_range<1>(&ka->in, ws, lds, 0, IT_MDN_C, bx - G_INPROJ, G - G_INPROJ, wave, lane); }
        }
        SEAM(pb + 1);
        if (TY(3) && IN(pb + 2)) REP(3) { PHASE_IDS CArgs* ka = kargs(); unsigned char* ws = ka->ws; bf16* QKV = (bf16*)(ws + WS_QKV); bf16* CAT = (bf16*)(ws + WS_CAT);
            if (G == 256) {
                if ((bx & 7) < 7) fa::kv_unit(WV, bx >> 5, (bx >> 3) & 3, bx & 7, QKV + (size_t)4 * 16384 * 512, QKV + (size_t)5 * 16384 * 512, (float*)(ws + WS_KVM), lds);
                xcd_barrier(bar);
                { fa::Tensors TR{QKV + (size_t)3 * 16384 * 512, QKV + (size_t)4 * 16384 * 512, QKV + (size_t)5 * 16384 * 512, CAT, (float*)(ws + WS_ASSQ), (const float*)(ws + WS_KMP), QKV + (size_t)6 * 16384 * 512, ka->in.ret_g + l * 512, (const float*)(ws + WS_KVM)};
                  fa::attn_unit<true>(WV, bx >> 5, (bx >> 3) & 3, bx & 7, TR, lds); }
                fa::Tensors TA{QKV, QKV + (size_t)1 * 16384 * 512, QKV + (size_t)2 * 16384 * 512, CAT, (float*)(ws + WS_ASSQ), (const float*)(ws + WS_KMP), nullptr, nullptr, nullptr};
                const int bh = bx >> 2, pr = bx & 3;
                for (int uu = 0; uu < 2; ++uu) fa::attn_unit<false>(WV, bh >> 3, bh & 7, uu == 0 ? 7 - pr : pr, TA, lds);
            }
        }
        SEAM(pb + 2);
        if (TY(4) && IN(pb + 3)) REP(4) {
            { PHASE_IDS CArgs* ka = kargs(); unsigned char* ws = ka->ws; const float* mod = (const float*)(ws + WS_MOD) + (size_t)l * 8 * 6144;
                const float* xin = (l == 0) ? ka->in.x : (const float*)ka->out;
                pg8::Gemm g{1024, 1024, 1024}; pg8::DenseSched S; S.init(ws + WS_CAT, 1024, (const bf16*)(ws + WS_WOUT) + (size_t)l * 1024 * 1024, 1024, 16384, 1024, G, bx);
                epi::EpiOutProj E{xin, ka->out, mod + 2 * 1024, (const float*)(ws + WS_ASSQ), rep_ > 0}; pg8::gemm_phase(WV, lds, g, S, E); }
        }
        SEAM(pb + 3);
        if (TY(5) && IN(pb + 4)) REP(5) { PHASE_IDS CArgs* ka = kargs(); unsigned char* ws = ka->ws; const float* mod = (const float*)(ws + WS_MOD) + (size_t)l * 8 * 6144;
            if (gw < 2048) {
                if (l == 0) norm_pass<0>(ka->out, ka->in.norm_ffn_g + l * 1024, mod + 3 * 1024, mod + 4 * 1024, (bf16*)(ws + WS_XA), nullptr, nullptr, nullptr, nullptr, gw, lane);
                else norm_pass<1>(ka->out, ka->in.norm_ffn_g + l * 1024, mod + 3 * 1024, mod + 4 * 1024, (bf16*)(ws + WS_XA), ka->in.router_w, (int*)(ws + WS_EIDX), (float*)(ws + WS_EW), (int*)(ws + WS_WCNT), gw, lane);
            }
            if (l == 1) { int* srow = (int*)(ws + WS_SROW); int* af = (int*)(ws + WS_ATOMF);
                { const int p = bx * 512 + tid; if (p < XS_ROWS) srow[p] = -1; af[p] = 0; }
            }
            else if (bx == 0 && tid < 9) { ((int*)(ws + WS_SEGD))[tid] = (tid == 0) ? 0 : ((tid == 8) ? 16384 : (1 << 30)); }
        }
        SEAM(pb + 4);
        if (l == 1) {
            if (TY(6) && IN(pb + 5)) REP(6) { PHASE_IDS CArgs* ka = kargs(); unsigned char* ws = ka->ws;
                if (gw < 2048) place_pass((const int*)(ws + WS_WCNT), (const int*)(ws + WS_EIDX), (const float*)(ws + WS_EW), (const bf16*)(ws + WS_XA), (bf16*)(ws + WS_XS), (int*)(ws + WS_SROW), (float*)(ws + WS_SWT), (int*)(ws + WS_SEG), gw, 2048, lane); }
            SEAM(pb + 5);
        } else { STAMP(pb + 6); }
        if (TY(7) && IN(pb + 6)) REP(7) { PHASE_IDS CArgs* ka = kargs(); unsigned char* ws = ka->ws;
            int Geff = G_GUD;
            if (l == 1) { const int nwg = (__builtin_amdgcn_readfirstlane(((const int*)(ws + WS_SEG))[8]) / 256) * 22; const int rounds = (nwg + G - 1) / G;
                Geff = (((nwg + rounds - 1) / rounds) + 7) & ~7; if (Geff > G - 8) Geff = G - 8; }
            if (bx < Geff) {
                if (l == 0) { pg8::Gemm g{1024, 1024, 1024}; pg8::MoeSched S;
                    S.init(ws + WS_XA, 1024, ws + WS_FGU, 1024, (size_t)5632 * 1024 * 2, (const int*)(ws + WS_SEGD), 5632, Geff, bx);
                    epi::EpiSwiGLU E{(bf16*)(ws + WS_HD), 2816}; pg8::gemm_phase(WV, lds, g, S, E);
                } else {
                    pg8::Gemm g{512, 512, 512}; pg8::MoeSched S;
                    S.init(ws + WS_XS, 512, ws + WS_MGU, 512, (size_t)5632 * 1024, (const int*)(ws + WS_SEG), 5632, Geff, bx);
                    epi::EpiSwiGLU8 E{ws + WS_HM, 2816}; pg8::gemm_phase(WV, lds, g, S, E);
                }
            } else if (rep_ == 0) { if (l == 0) convert_moe_range<0>(&ka->in, ws, lds, IT_MOE_A, IT_MOE_B, bx - Geff, G - Geff, wave, lane);
                                    else convert_moe_range<1>(&ka->in, ws, lds, IT_MDN_C, IT_MDN, bx - Geff, G - Geff, wave, lane); }
        }
        SEAM(pb + 6);
        if (TY(8) && IN(pb + 7)) REP(8) { PHASE_IDS CArgs* ka = kargs(); unsigned char* ws = ka->ws; const float* mod = (const float*)(ws + WS_MOD) + (size_t)l * 8 * 6144;
            if (l == 0) { pg8::MoeSched S; S.init(ws + WS_HD, 2816, ws + WS_FDN, 2816, (size_t)1024 * 2816 * 2, (const int*)(ws + WS_SEGD), 1024, G, bx);
                pg8::Gemm g{2816, 2816, 2816};
                epi::EpiDown E{ka->out, mod + 5 * 1024, (bf16*)(ws + WS_YS), (const int*)(ws + WS_SROW), (const float*)(ws + WS_SWT), false, rep_ > 0, (int*)(ws + WS_ATOMF), false, nullptr, 1}; pg8::gemm_phase(WV, lds, g, S, E);
            } else {
                pg8::MoeSched S; S.init(ws + WS_HM, 1408, ws + WS_MDN, 1408, (size_t)1024 * 2816, (const int*)(ws + WS_SEG), 1024, G, bx);
                pg8::Gemm g{1408, 1408, 1408};
                epi::EpiDownMoe8 E{(bf16*)(ws + WS_YS), (const int*)(ws + WS_SROW), (const float*)(ws + WS_SWT)}; pg8::gemm_phase(WV, lds, g, S, E);
            }
        }
        SEAM(pb + 7);
    }
    if (TY(9) && IN(17)) { PHASE_IDS CArgs* ka = kargs(); unsigned char* ws = ka->ws;
        if (gw < 2048) final_pass(ka->out, (const bf16*)(ws + WS_YS), (const int*)(ws + WS_ATOMF), (const float*)(ws + WS_SLAB), (const float*)(ws + WS_MOD) + (size_t)1 * 8 * 6144 + 5 * 1024, ka->in.final_g, gw, lane); }
#ifdef TPROBE
    xcd_barrier(bar); STAMP(18); __syncthreads();
    if (blockIdx.x == 0) { CArgs* ka = kargs(); float* o = ka->out;
        const float d1 = (float)(TS[TPROBE_A + 1] - TS[TPROBE_A]) * 0.01f, d2 = (float)(TS[TPROBE_B + 1] - TS[TPROBE_B]) * 0.01f;
        const float a = 4.0f * sqrtf(d1);
        for (int i = threadIdx.x; i < 1024 * 1024; i += 512) o[i] = a;
        if (threadIdx.x == 0) o[1024 * 1024 + 5] = 100.0f * d2; }
#endif
#undef IN
#undef TY
#undef SEAM
#undef PHASE_IDS
}
}
#ifndef STEP
#define STEP 5
#endif
namespace ad {
__device__ __forceinline__ float bf2f(unsigned short s) { return h16::one(s); }
__global__ void __launch_bounds__(256) ad_proj(const unsigned short* QKV, size_t gstride, int b, float* projb) {
    const int m = blockIdx.x; const size_t row = (size_t)b * 2048 + m;
    for (int n = threadIdx.x; n < 3584; n += 256) {
        const int grp = n / 512, c = n % 512; int sc = c;
        if (grp == 3 || grp == 4) { const int head = c >> 7, d = c & 127; sc = head * 128 + 8 * ((d & 63) >> 2) + 2 * (d & 3) + (d >> 6); }
        float v = bf2f(QKV[(size_t)grp * gstride + row * 512 + sc]);
        if (grp == 0) v *= (1.0f / epi::C2);
        if (grp == 4) v *= (1.0f / epi::KSC);
        projb[(size_t)m * 3584 + n] = v;
    }
}
__global__ void __launch_bounds__(64) ad_kmean(const float* KMP, int b, float* kmeanb) {
    const int blk = blockIdx.x, h = blockIdx.y, d = threadIdx.x;
    const float* p = KMP + ((size_t)(b * 8 + blk) * 2) * 512 + h * 64 + d;
    kmeanb[((size_t)h * 8 + blk) * 64 + d] = (p[0] + p[512]) * (1.0f / 256.0f);
}
__global__ void __launch_bounds__(256) ad_cat(const unsigned short* CAT, const float* ASSQ, const float* att_g, int b, float* catb) {
    const int m = blockIdx.x; const size_t row = (size_t)b * 2048 + m;
    float ss = 0.f;
    for (int h = 0; h < 8; ++h) ss += ASSQ[row * 8 + h];
    const float rs = 1.0f / sqrtf(ss * (1.0f / 512.0f) + 1e-6f);
    for (int c = threadIdx.x; c < 1024; c += 256) { const float v = bf2f(CAT[row * 1024 + c]); catb[(size_t)m * 1024 + c] = (c < 512) ? v * rs * att_g[c] : v; }
}
__global__ void __launch_bounds__(256) dbg_cmp(const float* a, const float* b, size_t n, float rel, float abs_, unsigned* flag, int ncols = 1, int c_lo = 0, int c_hi = 1, int silu_b = 0) {
    unsigned bad = 0;
    for (size_t i = (size_t)blockIdx.x * 256 + threadIdx.x; i < n; i += (size_t)gridDim.x * 256) { const int c = (int)(i % ncols); if (c < c_lo || c >= c_hi) continue;
        float bv = b[i]; if (silu_b) bv = bv / (1.f + expf(-bv)); const float d = fabsf(a[i] - bv); if (!(d <= rel * fabsf(bv) + abs_)) ++bad; }
    if (bad) atomicAdd(flag, bad);
}
__global__ void __launch_bounds__(256) dbg_poison(const unsigned* flag, unsigned thresh, float* out, float val) {
    if (*flag > thresh) for (int i = threadIdx.x; i < 1024 * 1024; i += 256) out[i] = val;
}
__global__ void __launch_bounds__(256) dbg_ssd(const float* a, const float* b, size_t n, int ncols, int c_lo, int c_hi, float* acc) {
    float s = 0.f;
    for (size_t i = (size_t)blockIdx.x * 256 + threadIdx.x; i < n; i += (size_t)gridDim.x * 256) { const int c = (int)(i % ncols); if (c < c_lo || c >= c_hi) continue; const float d = a[i] - b[i]; s += d * d; }
    atomicAdd(acc, s);
}
__global__ void __launch_bounds__(256) dbg_encode(const float* acc, float count, float* out) {
    const float mse = *acc / count; const float val = 4.0f / sqrtf(mse);
    for (int i = threadIdx.x; i < 1024 * 1024; i += 256) out[i] = val;
}
}

static void launch_mega(const mk::Args& a0, int lo, int hi, int region, hipStream_t stream) {
    mk::Args a = a0; a.ph_lo = lo; a.ph_hi = hi; a.bar_region = region;
    hipLaunchKernelGGL(mk::mega, dim3(256), dim3(512), mk::LDS_BYTES, stream, a);
}

extern "C" void kernel_launch(void* const* d_in, const int* in_sizes, int n_in, void* d_out, int out_size, void* d_ws, size_t ws_size, hipStream_t stream) {
    static int ready = 0;
    if (ready == 0) {
        if (n_in != 18 || out_size != M * D || ws_size < mk::WS_END) { fprintf(stderr, "kernel_launch: unexpected problem (n_in %d, out %d, ws %zu)\n", n_in, out_size, ws_size); ready = -1; return; }
        if (hipFuncSetAttribute((const void*)mk::mega, hipFuncAttributeMaxDynamicSharedMemorySize, mk::LDS_BYTES) != hipSuccess) { fprintf(stderr, "kernel_launch: hipFuncSetAttribute failed\n"); ready = -1; return; }
        ready = 1;
    }
    if (ready < 0) return;
    mk::Args a{};
    const float** ip = (const float**)&a.in;
    for (int i = 0; i < 18; ++i) ip[i] = (const float*)d_in[i];
    a.out = (float*)d_out; a.ws = (unsigned char*)d_ws; a.moe_w = (STEP >= 5) ? 1 : 0;
    const mk::Inputs& in = a.in;
    float* out = (float*)d_out; unsigned char* ws = (unsigned char*)d_ws;
    hipMemsetAsync(ws + mk::WS_CTL, 0, mk::CTL_ZERO_BYTES, stream);
#if STEP >= 6
    launch_mega(a, 0, mk::N_PHASES, 0, stream);
#else
    constexpr size_t MiB = 1u << 20;
    unsigned char* na = ws + 8 * MiB;
    float* PROJb = (float*)(na);
    float* Hb = (float*)(na + 28 * MiB);
    float* CATb = (float*)(na + 36 * MiB);
    float* OAb = (float*)(na + 44 * MiB);
    float* ORRb = (float*)(na + 48 * MiB);
    float* KMEANb = (float*)(na + 52 * MiB);
    int* EIDXb = (int*)(na + 53 * MiB); float* EWb = (float*)(na + 53 * MiB + 65536); int* POSb = (int*)(na + 53 * MiB + 131072); int* LISTb = (int*)(na + 53 * MiB + 196608);
    int* CNTb = (int*)(na + 54 * MiB); int* BASEb = CNTb + 16;
    float* Gb = (float*)(na + 56 * MiB);
    float* Ub = (float*)(na + 78 * MiB);
    float* Yb = (float*)(na + 100 * MiB);
    const float* MODp = (const float*)(ws + mk::WS_MOD);
    unsigned short* QKV = (unsigned short*)(ws + mk::WS_QKV);
    launch_mega(a, 0, 1, 1, stream);
    for (int l = 0; l < 2; ++l) {
        const int pb = 1 + 8 * l;
        const float* xin = (l == 0) ? in.x : (const float*)out;
        if (STEP >= 1) { launch_mega(a, pb, pb + 1, 1, stream); launch_mega(a, pb + 1, pb + 2, 1, stream); }
        if (STEP >= 2) launch_mega(a, pb + 2, pb + 3, 1, stream);
        if (STEP >= 3) launch_mega(a, pb + 3, pb + 4, 1, stream);
        if (STEP < 3) {
            for (int b = 0; b < BATCH; ++b) {
                const float* mod = MODp + ((size_t)l * BATCH + b) * 6 * D;
                const float* xb = xin + (size_t)b * SEQ * D; float* ob = out + (size_t)b * SEQ * D;
                if (STEP < 1) {
                    nv::k_norm<<<SEQ, 256, 0, stream>>>(xb, in.norm_mix_g + l * D, mod + 0 * D, mod + 1 * D, Hb);
                    nv::k_gemm<<<dim3(NPROJ / 64, SEQ / 64), 256, 0, stream>>>(Hb, D, nullptr, nullptr, SEQ, in.w_in + (size_t)l * D * NPROJ, NPROJ, PROJb, NPROJ, D);
                    nv::k_rotary<<<SEQ, 256, 0, stream>>>(PROJb);
                    nv::k_kmean<<<dim3(NBLK, AH, 1), 64, 0, stream>>>(PROJb, KMEANb);
                } else {
                    ad::ad_proj<<<SEQ, 256, 0, stream>>>(QKV, (size_t)M * 512, b, PROJb);
                    ad::ad_kmean<<<dim3(NBLK, AH, 1), 64, 0, stream>>>((const float*)(ws + mk::WS_KMP), b, KMEANb);
#ifdef DBG_CHECK
                    { float* PROJn = Gb; float* KMn = (float*)(na + 52 * MiB + 262144); unsigned* flag = (unsigned*)(ws + mk::WS_CTL) + 16;
                      nv::k_norm<<<SEQ, 256, 0, stream>>>(xb, in.norm_mix_g + l * D, mod + 0 * D, mod + 1 * D, Hb);
                      nv::k_gemm<<<dim3(NPROJ / 64, SEQ / 64), 256, 0, stream>>>(Hb, D, nullptr, nullptr, SEQ, in.w_in + (size_t)l * D * NPROJ, NPROJ, PROJn, NPROJ, D);
                      nv::k_rotary<<<SEQ, 256, 0, stream>>>(PROJn);
                      nv::k_kmean<<<dim3(NBLK, AH, 1), 64, 0, stream>>>(PROJn, KMn);
                      ad::dbg_cmp<<<1024, 256, 0, stream>>>(PROJb, PROJn, (size_t)SEQ * NPROJ, DBG_REL, DBG_ABS, flag, NPROJ, 0, 3072, 0);
                      ad::dbg_cmp<<<1024, 256, 0, stream>>>(PROJb, PROJn, (size_t)SEQ * NPROJ, DBG_REL, DBG_ABS, flag, NPROJ, 3072, 3584, 1);
                      ad::dbg_cmp<<<16, 256, 0, stream>>>(KMEANb, KMn, (size_t)8 * 8 * 64, 0.03f, 0.004f, flag + 1);
                      if (l == DBG_L && b == 0) ad::dbg_ssd<<<1024, 256, 0, stream>>>(PROJb, PROJn, (size_t)SEQ * NPROJ, NPROJ, DBG_CLO, DBG_CHI, (float*)(flag + 2)); }
#endif
                }
                if (STEP < 2) {
                    nv::k_moba<<<dim3(NBLK, AH, 1), 256, 0, stream>>>(PROJb, KMEANb, OAb);
                    nv::k_ret<<<dim3(SEQ / 256, RH * 4, 1), 256, 0, stream>>>(PROJb, ORRb);
                    nv::k_cat<<<SEQ, 256, 0, stream>>>(OAb, ORRb, PROJb, in.att_g + l * AW, in.ret_g + l * RW, CATb, STEP >= 1 ? 1 : 0);
                } else {
                    ad::ad_cat<<<SEQ, 256, 0, stream>>>((const unsigned short*)(ws + mk::WS_CAT), (const float*)(ws + mk::WS_ASSQ), in.att_g + l * AW, b, CATb);
                }
                nv::k_gemm<<<dim3(D / 64, SEQ / 64), 256, 0, stream>>>(CATb, D, nullptr, nullptr, SEQ, in.w_out + (size_t)l * D * D, D, Hb, D, D);
                nv::k_resid<<<SEQ, 256, 0, stream>>>(xb, mod + 2 * D, Hb, ob);
            }
        }
        const bool ffn_mega = (l == 0) ? (STEP >= 4) : (STEP >= 5);
        if (ffn_mega) {
            launch_mega(a, pb + 4, pb + 5, 1, stream);
            if (l == 1) launch_mega(a, pb + 5, pb + 6, 1, stream);
            launch_mega(a, pb + 6, pb + 7, 1, stream);
            launch_mega(a, pb + 7, pb + 8, 1, stream);
        } else {
            for (int b = 0; b < BATCH; ++b) {
                const float* mod = MODp + ((size_t)l * BATCH + b) * 6 * D;
                float* ob = out + (size_t)b * SEQ * D;
                nv::k_norm<<<SEQ, 256, 0, stream>>>(ob, in.norm_ffn_g + l * D, mod + 3 * D, mod + 4 * D, Hb);
                if (l == 0) {
                    nv::k_gemm<<<dim3(FF / 64, SEQ / 64), 256, 0, stream>>>(Hb, D, nullptr, nullptr, SEQ, in.fw_gate, FF, Gb, FF, D);
                    nv::k_gemm<<<dim3(FF / 64, SEQ / 64), 256, 0, stream>>>(Hb, D, nullptr, nullptr, SEQ, in.fw_up, FF, Ub, FF, D);
                    nv::k_silu_mul<<<SEQ, 256, 0, stream>>>(Gb, Ub, nullptr, SEQ, FF);
                    nv::k_gemm<<<dim3(D / 64, SEQ / 64), 256, 0, stream>>>(Gb, FF, nullptr, nullptr, SEQ, in.fw_down, D, Ub, D, FF);
                    nv::k_resid<<<SEQ, 256, 0, stream>>>(ob, mod + 5 * D, Ub, ob);
                } else {
                    nv::k_router<<<SEQ / 4, 256, 0, stream>>>(Hb, in.router_w, EIDXb, EWb);
                    nv::k_place<<<1, 1024, 0, stream>>>(EIDXb, LISTb, POSb, CNTb, BASEb, 4);
                    float* GE = Gb; float* UE = Ub;
                    for (int e = 0; e < NE; ++e) {
                        nv::k_gemm<<<dim3(FF / 64, ECAP / 64), 256, 0, stream>>>(Hb, D, LISTb, CNTb + e, ECAP, in.mw_gate + (size_t)e * D * FF, FF, GE, FF, D, BASEb + e, nullptr);
                        nv::k_gemm<<<dim3(FF / 64, ECAP / 64), 256, 0, stream>>>(Hb, D, LISTb, CNTb + e, ECAP, in.mw_up + (size_t)e * D * FF, FF, UE, FF, D, BASEb + e, nullptr);
                        nv::k_silu_mul<<<ECAP, 256, 0, stream>>>(GE, UE, CNTb + e, ECAP, FF);
                        nv::k_gemm<<<dim3(D / 64, ECAP / 64), 256, 0, stream>>>(GE, FF, nullptr, CNTb + e, ECAP, in.mw_down + (size_t)e * FF * D, D, Yb, D, FF, nullptr, BASEb + e);
                    }
                    nv::k_moe_combine<<<SEQ, 256, 0, stream>>>(ob, mod + 5 * D, Yb, POSb, EWb);
                }
            }
        }
    }
    if (STEP >= 5) launch_mega(a, 17, 18, 1, stream);
    else nv::k_norm<<<M, 256, 0, stream>>>(out, in.final_g, nullptr, nullptr, out);
#ifdef DBG_CHECK
#ifdef DBG_ENC
    ad::dbg_encode<<<1, 256, 0, stream>>>((const float*)((unsigned*)(ws + mk::WS_CTL) + 18), (float)SEQ * (DBG_CHI - DBG_CLO), out);
#endif
    ad::dbg_poison<<<1, 256, 0, stream>>>((unsigned*)(ws + mk::WS_CTL) + 16, DBG_T0, out, 100.0f);
    ad::dbg_poison<<<1, 256, 0, stream>>>((unsigned*)(ws + mk::WS_CTL) + 17, DBG_T1, out + (1 << 20), 300.0f);
#endif
#endif
}
```

```cpp
#include <hip/hip_runtime.h>
#include <cstdio>
#include <cstdint>
#include <cmath>

namespace h16 {
typedef _Float16 f16x2_t __attribute__((ext_vector_type(2)));
typedef _Float16 f16x8_t __attribute__((ext_vector_type(8)));
typedef float f32x2_t __attribute__((ext_vector_type(2)));
__device__ __forceinline__ unsigned pk(float lo, float hi) { f32x2_t v = {lo, hi}; f16x2_t b = __builtin_convertvector(v, f16x2_t); return __builtin_bit_cast(unsigned, b); }
__device__ __forceinline__ float lo(unsigned u) { return (float)__builtin_bit_cast(f16x2_t, u)[0]; }
__device__ __forceinline__ float hi(unsigned u) { return (float)__builtin_bit_cast(f16x2_t, u)[1]; }
__device__ __forceinline__ float one(unsigned short s) { return (float)__builtin_bit_cast(_Float16, s); }
}

namespace xl {
template <int O> __device__ __forceinline__ int xor_i(int v) {
    if constexpr (O < 32) return __builtin_amdgcn_ds_swizzle(v, (O << 10) | 0x1f);
    else { static_assert(O < 32, "use add32 / max32 for the 32-lane exchange"); return v; }
}
template <int O> __device__ __forceinline__ float xor_f(float v) { return __builtin_bit_cast(float, xor_i<O>(__builtin_bit_cast(int, v))); }
__device__ __forceinline__ void swap32(unsigned a, unsigned& r0, unsigned& r1) { unsigned b = a; asm volatile("" : "+v"(b)); auto r = __builtin_amdgcn_permlane32_swap(a, b, false, false); r0 = r[0]; r1 = r[1]; }
__device__ __forceinline__ float xor32p(float v, bool upper) { unsigned r0, r1; swap32(__builtin_bit_cast(unsigned, v), r0, r1); return __builtin_bit_cast(float, upper ? r0 : r1); }
__device__ __forceinline__ float add32(float v) { unsigned r0, r1; swap32(__builtin_bit_cast(unsigned, v), r0, r1); return __builtin_bit_cast(float, r0) + __builtin_bit_cast(float, r1); }
__device__ __forceinline__ float max32(float v) { unsigned r0, r1; swap32(__builtin_bit_cast(unsigned, v), r0, r1); return fmaxf(__builtin_bit_cast(float, r0), __builtin_bit_cast(float, r1)); }
__device__ __forceinline__ int add32i(int v) { unsigned r0, r1; swap32((unsigned)v, r0, r1); return (int)(r0 + r1); }
__device__ __forceinline__ float wave_sum(float v) { v += xor_f<1>(v); v += xor_f<2>(v); v += xor_f<4>(v); v += xor_f<8>(v); v += xor_f<16>(v); return add32(v); }
__device__ __forceinline__ int wave_sum_i(int v) { v += xor_i<1>(v); v += xor_i<2>(v); v += xor_i<4>(v); v += xor_i<8>(v); v += xor_i<16>(v); return add32i(v); }
}

__device__ __forceinline__ int olane() { int l; asm volatile("v_mbcnt_lo_u32_b32 %0, -1, 0\n\tv_mbcnt_hi_u32_b32 %0, -1, %0" : "=v"(l)); return l; }
__device__ __forceinline__ int otid(int wv) { return (wv << 6) | olane(); }
#define STEP 6

constexpr int D = 1024, BATCH = 8, SEQ = 2048, M = BATCH * SEQ;
constexpr int AH = 8, AD = 64, AW = 512, MBLK = 256, NBLK = SEQ / MBLK, TOPK = 3;
constexpr int RH = 4, RD = 128, RW = 512;
constexpr int NPROJ = 3 * AW + 4 * RW;
constexpr int FF = 2816, NE = 8;
constexpr float EPS = 1e-6f;
constexpr int ECAP = 2048;
namespace pg8 {
#define PG8_LAS __attribute__((address_space(3)))
typedef unsigned short bf16_t;
typedef short bf16x8 __attribute__((ext_vector_type(8)));
typedef float f32x4 __attribute__((ext_vector_type(4)));
typedef float f32x2 __attribute__((ext_vector_type(2)));
typedef unsigned u32x4 __attribute__((ext_vector_type(4)));
typedef unsigned u32x2 __attribute__((ext_vector_type(2)));
typedef int i32x4 __attribute__((ext_vector_type(4)));
constexpr int BM = 256, BK = 64, HALF = 128, HTB = HALF * BK * 2  , STAGE_BYTES = 8 * HTB, NXCD = 8, WGM = 8;

__host__ __device__ __forceinline__ int lds_byte(int r, int c) { const int st = (r >> 4) * 2 + (c >> 5), rr = r & 15, cc = c & 31, ob = rr * 64 + cc * 2; return st * 1024 + (ob ^ (((ob >> 9) & 1) << 5)); }
__host__ __device__ __forceinline__ void stage_rc(int b, int& R, int& C) { const int st = b / 1024, sb = b % 1024, swz = sb ^ (((sb >> 9) & 1) << 5); R = (st >> 1) * 16 + swz / 64; C = (st & 1) * 32 + (swz % 64) / 2; }
__host__ __device__ __forceinline__ int perm32(int rho) { const int n = rho >> 4, i = rho & 15; return 8 * (i >> 2) + 4 * n + (i & 3); }

struct Unit { int pm, pn, e, kc, li; };
struct Gemm { int lda, ldb, K; };

struct DenseSched {
    const char* A; const char* Bt; size_t a_tile, b_tile;
    int nM, nN, nwg, G, c;
    __device__ __forceinline__ void init(const void* A_, int lda, const void* Bt_, int ldb, int M, int N, int G_, int c_) {
        A = (const char*)A_; Bt = (const char*)Bt_; a_tile = (size_t)BM * lda * 2; b_tile = (size_t)BM * ldb * 2; nM = M / BM; nN = N / BM; nwg = nM * nN; G = G_; c = c_; }
    __device__ __forceinline__ bool next(int i, Unit& u) const {
        const long L = (long)i * G + c; if (L >= nwg) return false;
        int wgid = (int)L; { const int q = nwg / NXCD, r = nwg % NXCD, xcd = wgid % NXCD, off = wgid / NXCD; wgid = (xcd < r ? xcd * (q + 1) : r * (q + 1) + (xcd - r) * q) + off; }
        const int nig = WGM * nN, gid = wgid / nig, fm = gid * WGM, gsz = (nM - fm) < WGM ? (nM - fm) : WGM;
        u.pm = fm + ((wgid % nig) % gsz); u.pn = (wgid % nig) / gsz; u.e = 0; u.kc = 0; u.li = 0; return true;
    }
    __device__ __forceinline__ const char* a_ptr(const Unit& u) const { return A + (size_t)u.pm * a_tile; }
    __device__ __forceinline__ const char* b_ptr(const Unit& u) const { return Bt + (size_t)u.pn * b_tile; }
};
struct MoeSched {
    const char* A; const char* Bt; size_t a_tile, b_tile, e_stride;
    int nM, nN, nwg, G, c; int seg[8]; int first, lim, KS, kbytes;
    __device__ __forceinline__ void init(const void* A_, int lda, const void* Bt_, int ldb, size_t e_stride_bytes, const int* segp_, int N, int G_, int c_) {
        A = (const char*)A_; Bt = (const char*)Bt_; a_tile = (size_t)BM * lda * 2; b_tile = (size_t)BM * ldb * 2; e_stride = e_stride_bytes;
#pragma unroll
        for (int e = 0; e < 8; ++e) seg[e] = __builtin_amdgcn_readfirstlane(segp_[e]);
        nM = __builtin_amdgcn_readfirstlane(segp_[8]) / BM; nN = N / BM; nwg = nM * nN; G = G_; c = c_; first = 0; lim = nwg; KS = 1; kbytes = 0; }
    __device__ __forceinline__ bool next(int i, Unit& u) const {
        const long idx = (long)i * G + c; const long L = first + idx / KS; if (L >= lim) return false;
        u.kc = (int)(idx % KS); u.li = (int)(idx / KS);
        int wgid = (int)L; { const int q = nwg / NXCD, r = nwg % NXCD, xcd = wgid % NXCD, off = wgid / NXCD; wgid = (xcd < r ? xcd * (q + 1) : r * (q + 1) + (xcd - r) * q) + off; }
        const int nig = WGM * nN, gid = wgid / nig, fm = gid * WGM, gsz = (nM - fm) < WGM ? (nM - fm) : WGM;
        u.pm = fm + ((wgid % nig) % gsz); u.pn = (wgid % nig) / gsz;
        int e = 0; const int r0 = u.pm * BM;
#pragma unroll
        for (int k = 1; k < 8; ++k) e = (r0 >= seg[k]) ? k : e;
        u.e = __builtin_amdgcn_readfirstlane(e); return true;
    }
    __device__ __forceinline__ const char* a_ptr(const Unit& u) const { return A + (size_t)u.pm * a_tile + (size_t)u.kc * kbytes; }
    __device__ __forceinline__ const char* b_ptr(const Unit& u) const { return Bt + (size_t)u.e * e_stride + (size_t)u.pn * b_tile + (size_t)u.kc * kbytes; }
};

__device__ __forceinline__ unsigned cvt_pk_bf16(float lo, float hi) { return h16::pk(lo, hi); }
__device__ __forceinline__ float fast_silu(float g) { return g * __builtin_amdgcn_rcpf(1.0f + __builtin_amdgcn_exp2f(-1.4426950408889634f * g)); }

typedef f32x4 Acc[2][2][4][2];
typedef int i32x8 __attribute__((ext_vector_type(8)));
template <bool F8> struct Frags;
template <> struct Frags<false> { bf16x8 At[4][2], B0[2][2], B1[2][2]; };
template <> struct Frags<true> { i32x8 At[4], B0[2], B1[2]; };

template <class Epi, class Sched>
__device__ __forceinline__ void gemm_phase(const int wv, PG8_LAS unsigned char* lds, const Gemm g, const Sched& S, const Epi& E) {
    int tid_ = otid(wv);
    const int tid = tid_, wid = __builtin_amdgcn_readfirstlane(tid >> 6), lane = tid & 63, wr = wid >> 2, wc = wid & 3, fr = lane & 15, fq = lane >> 4;
    const int K = g.K; int nt = K / BK; asm volatile("" : "+s"(nt));
    unsigned voffA[2], voffB[2];
#pragma unroll
    for (int i = 0; i < 2; ++i) { int R, C; stage_rc(tid * 16 + i * 8192, R, C); const int Rb = Epi::PERM ? ((R & ~31) + perm32(R & 31)) : R;
        voffA[i] = (unsigned)(R * g.lda + C) * 2u; voffB[i] = (unsigned)(Rb * g.ldb + C) * 2u; }
    const size_t kstep = (size_t)(BK * 2);
    const size_t hstepA = (size_t)HALF * g.lda * 2, hstepB = (size_t)HALF * g.ldb * 2;
    const unsigned ldsw = (unsigned)wid * 1024u;
    const unsigned ldsbase_ = (unsigned)__builtin_amdgcn_readfirstlane((int)((unsigned)(unsigned long)lds + ldsw));
    const int aoff = lds_byte(wr * 64 + fr, fq * 8), boff = lds_byte(wc * 32 + fr, fq * 8);
#define PG8_SA(b, h) (((b) * 2 + (h)) * HTB)
#define PG8_SB(b, h) ((4 + (b) * 2 + (h)) * HTB)
#define PG8_STAGE(bufoff, gbase, voff) do { if constexpr (Epi::FP8) {   \
            const unsigned long long gb_ = (unsigned long long)(gbase); \
            const unsigned long long sb_ = ((unsigned long long)(unsigned)__builtin_amdgcn_readfirstlane((int)(gb_ >> 32)) << 32) | (unsigned)__builtin_amdgcn_readfirstlane((int)gb_); \
            _Pragma("unroll") for (int _i = 0; _i < 2; ++_i) { unsigned keep_; \
                asm volatile("s_mov_b32 %0, m0\n\ts_mov_b32 m0, %3\n\ts_nop 0\n\tglobal_load_lds_dwordx4 %1, %2\n\ts_mov_b32 m0, %0" : "=&s"(keep_) : "v"((voff)[_i]), "s"(sb_), "s"(ldsbase_ + (unsigned)((bufoff) + _i * 8192)) : "memory"); } \
        } else { _Pragma("unroll") for (int _i = 0; _i < 2; ++_i) \
        __builtin_amdgcn_global_load_lds((const unsigned*)((const char*)(gbase) + (voff)[_i]), (PG8_LAS unsigned*)(lds + (bufoff) + ldsw + _i * 8192), 16, 0, 0); } } while (0)
#define PG8_LDA(dst, b, h) do { if constexpr (Epi::FP8) { _Pragma("unroll") for (int m = 0; m < 4; ++m) { const i32x4 lo_ = *(const PG8_LAS i32x4*)(lds + PG8_SA(b, h) + aoff + m * 2048), hi_ = *(const PG8_LAS i32x4*)(lds + PG8_SA(b, h) + aoff + m * 2048 + 1024); F.dst[m] = __builtin_shufflevector(lo_, hi_, 0, 1, 2, 3, 4, 5, 6, 7); } } \
        else { _Pragma("unroll") for (int m = 0; m < 4; ++m) _Pragma("unroll") for (int k = 0; k < 2; ++k) F.dst[m][k] = *(const PG8_LAS bf16x8*)(lds + PG8_SA(b, h) + aoff + m * 2048 + k * 1024); } } while (0)
#define PG8_LDB(dst, b, h) do { if constexpr (Epi::FP8) { _Pragma("unroll") for (int n = 0; n < 2; ++n) { const i32x4 lo_ = *(const PG8_LAS i32x4*)(lds + PG8_SB(b, h) + boff + n * 2048), hi_ = *(const PG8_LAS i32x4*)(lds + PG8_SB(b, h) + boff + n * 2048 + 1024); F.dst[n] = __builtin_shufflevector(lo_, hi_, 0, 1, 2, 3, 4, 5, 6, 7); } } \
        else { _Pragma("unroll") for (int n = 0; n < 2; ++n) _Pragma("unroll") for (int k = 0; k < 2; ++k) F.dst[n][k] = *(const PG8_LAS bf16x8*)(lds + PG8_SB(b, h) + boff + n * 2048 + k * 1024); } } while (0)
#define PG8_MMA(ai, bj, At, Bt) do { __builtin_amdgcn_s_setprio(1); \
        if constexpr (Epi::FP8) {   \
            _Pragma("unroll") for (int m = 0; m < 4; ++m) _Pragma("unroll") for (int n = 0; n < 2; ++n) \
                acc[ai][bj][m][n] = __builtin_amdgcn_mfma_scale_f32_16x16x128_f8f6f4(F.Bt[n], F.At[m], acc[ai][bj][m][n], 0, 0, 0, Epi::SCALE_W, 0, 0x7f7f7f7f); \
        } else { _Pragma("unroll") for (int m = 0; m < 4; ++m) _Pragma("unroll") for (int n = 0; n < 2; ++n) _Pragma("unroll") for (int k = 0; k < 2; ++k) \
            acc[ai][bj][m][n] = __builtin_amdgcn_mfma_f32_16x16x32_f16(__builtin_bit_cast(h16::f16x8_t, F.Bt[n][k]), __builtin_bit_cast(h16::f16x8_t, F.At[m][k]), acc[ai][bj][m][n], 0, 0, 0); } \
        __builtin_amdgcn_s_setprio(0); } while (0)
#define PG8_WAIT_V(n) asm volatile("s_waitcnt vmcnt(" #n ")" ::: "memory")
#define PG8_WAIT_L(n) asm volatile("s_waitcnt lgkmcnt(" #n ")" ::: "memory")
#define PG8_BAR __builtin_amdgcn_s_barrier()
#define PG8_SCHED __builtin_amdgcn_sched_barrier(0)
    Unit cur, nxt; int ui = 0;
    if (!S.next(0, cur)) return;
    Acc acc;
#pragma unroll
    for (int a = 0; a < 2; ++a)
#pragma unroll
        for (int b = 0; b < 2; ++b)
#pragma unroll
            for (int m = 0; m < 4; ++m)
#pragma unroll
                for (int n = 0; n < 2; ++n) acc[a][b][m][n] = (f32x4){0.f, 0.f, 0.f, 0.f};
    const char* cA = S.a_ptr(cur); const char* cB = S.b_ptr(cur);
    if constexpr (Epi::MID_T > 0) E.pre(cur, lds, tid);
    PG8_STAGE(PG8_SB(0, 0), cB, voffB); PG8_STAGE(PG8_SB(0, 1), cB + hstepB, voffB); PG8_STAGE(PG8_SA(0, 0), cA, voffA); PG8_STAGE(PG8_SA(0, 1), cA + hstepA, voffA);
    if (wr == 1) PG8_BAR;
    PG8_WAIT_V(2); PG8_BAR;
    PG8_STAGE(PG8_SB(1, 0), cB + kstep, voffB); PG8_STAGE(PG8_SA(1, 0), cA + kstep, voffA); PG8_STAGE(PG8_SB(1, 1), cB + hstepB + kstep, voffB);
    PG8_WAIT_V(6); PG8_BAR;
    for (;;) {
        const bool has_next = S.next(ui + 1, nxt);
        const char* nA = has_next ? S.a_ptr(nxt) : cA; const char* nB = has_next ? S.b_ptr(nxt) : cB;
        for (int t = 0; t < nt; t += 2) {
            if constexpr (Epi::MID_T > 0) { if (t == Epi::MID_T) E.mid(acc, lds, wr, fr); }
            const bool last = (t == nt - 2);
            Frags<Epi::FP8> F;
            const char* a1 = cA + (size_t)(t + 1) * kstep;
            const char* a2 = last ? nA : cA + (size_t)(t + 2) * kstep; const char* b2 = last ? nB : cB + (size_t)(t + 2) * kstep;
            const char* a3 = a2 + kstep; const char* b3 = b2 + kstep;
            PG8_LDB(B0, 0, 0); PG8_LDB(B1, 0, 1); PG8_SCHED; PG8_LDA(At, 0, 0); PG8_STAGE(PG8_SA(1, 1), a1 + hstepA, voffA);
            PG8_WAIT_V(8); PG8_WAIT_L(0); PG8_BAR; PG8_MMA(0, 0, At, B0); PG8_MMA(0, 1, At, B1); PG8_BAR; PG8_SCHED;
            PG8_LDA(At, 0, 1); PG8_STAGE(PG8_SB(0, 0), b2, voffB); PG8_STAGE(PG8_SB(0, 1), b2 + hstepB, voffB); PG8_STAGE(PG8_SA(0, 0), a2, voffA);
            PG8_WAIT_V(8); PG8_WAIT_L(0); PG8_BAR; PG8_MMA(1, 0, At, B0); PG8_MMA(1, 1, At, B1); PG8_BAR; PG8_SCHED;
            PG8_LDB(B0, 1, 0); PG8_LDB(B1, 1, 1); PG8_SCHED; PG8_LDA(At, 1, 0); PG8_STAGE(PG8_SA(0, 1), a2 + hstepA, voffA);
            PG8_WAIT_V(8); PG8_WAIT_L(0); PG8_BAR; PG8_MMA(0, 0, At, B0); PG8_MMA(0, 1, At, B1); PG8_BAR; PG8_SCHED;
            PG8_LDA(At, 1, 1); PG8_STAGE(PG8_SB(1, 0), b3, voffB); PG8_STAGE(PG8_SB(1, 1), b3 + hstepB, voffB); PG8_STAGE(PG8_SA(1, 0), a3, voffA);
            PG8_WAIT_V(8); PG8_WAIT_L(0); PG8_BAR; PG8_MMA(1, 0, At, B0); PG8_MMA(1, 1, At, B1); PG8_BAR; PG8_SCHED;
        }
        if (wr == 0) PG8_BAR;
        { const int t2_ = olane(); E(acc, cur, wr, wc, t2_ & 15, t2_ >> 4); }
        if (!has_next) break;
#pragma unroll
        for (int a = 0; a < 2; ++a)
#pragma unroll
            for (int b = 0; b < 2; ++b)
#pragma unroll
                for (int m = 0; m < 4; ++m)
#pragma unroll
                    for (int n = 0; n < 2; ++n) acc[a][b][m][n] = (f32x4){0.f, 0.f, 0.f, 0.f};
        cur = nxt; cA = nA; cB = nB; ++ui;
        if (wr == 1) PG8_BAR;
    }
    PG8_WAIT_V(0);
    PG8_BAR;
#undef PG8_SA
#undef PG8_SB
#undef PG8_STAGE
#undef PG8_LDA
#undef PG8_LDB
#undef PG8_MMA
#undef PG8_WAIT_V
#undef PG8_WAIT_L
#undef PG8_BAR
#undef PG8_SCHED
}
}
namespace epi {
#define PG8_LAS __attribute__((address_space(3)))
using pg8::Acc; using pg8::Unit; using pg8::f32x4; using pg8::u32x4; using pg8::bf16_t; using pg8::cvt_pk_bf16; using pg8::fast_silu;
constexpr int HALF = 128;
constexpr float C2 = 0.125f * 1.4426950408889634f;
constexpr float KSC = 0.08838834764831845f;

__device__ __forceinline__ u32x4 pack8(const f32x4 v0, const f32x4 v1) { u32x4 w; w.x = cvt_pk_bf16(v0[0], v0[1]); w.y = cvt_pk_bf16(v0[2], v0[3]); w.z = cvt_pk_bf16(v1[0], v1[1]); w.w = cvt_pk_bf16(v1[2], v1[3]); return w; }

struct EpiInProj {
    static constexpr bool PERM = true; static constexpr int MID_T = 0; static constexpr bool FP8 = false; static constexpr int SCALE_W = 0;
    bf16_t* O; size_t gstride;
    float* KMP;
    const float* ROPE;
    __device__ __forceinline__ void operator()(const Acc& acc, const Unit& u, int wr, int wc, int fr, int fq) const {
        const int grp = u.pn >> 1;
        const int col0 = (u.pn & 1) * 256 + wc * 32 + 8 * fq;
        const int row0 = u.pm * 256 + wr * 64 + fr;
        bf16_t* base = O + (size_t)grp * gstride;
        f32x4 cs[2][2];
#pragma unroll
        for (int bj = 0; bj < 2; ++bj) { cs[bj][0] = (f32x4){0.f, 0.f, 0.f, 0.f}; cs[bj][1] = (f32x4){0.f, 0.f, 0.f, 0.f}; }
#pragma unroll
        for (int ai = 0; ai < 2; ++ai)
#pragma unroll
            for (int m = 0; m < 4; ++m) {
                const int row = row0 + ai * HALF + m * 16;
                bf16_t* rowp = base + (size_t)row * 512 + col0;
                f32x4 t0 = (f32x4){0.f, 0.f, 0.f, 0.f}, t1 = t0;
                if (grp == 3 || grp == 4) { const float* tp = ROPE + ((size_t)(row & 2047) * 64 + 16 * wc + 4 * fq) * 2; t0 = *(const f32x4*)tp; t1 = *(const f32x4*)(tp + 4); }
#pragma unroll
                for (int bj = 0; bj < 2; ++bj) {
                    f32x4 v0 = acc[ai][bj][m][0], v1 = acc[ai][bj][m][1];
                    if (grp == 0) { v0 = v0 * C2; v1 = v1 * C2; }
                    else if (grp == 1) { cs[bj][0] += v0; cs[bj][1] += v1; }
                    else if (grp == 3 || grp == 4) {
                        const float sc = (grp == 4) ? KSC : 1.0f;
                        f32x4 r0, r1;
                        r0[0] = (v0[0] * t0[0] - v0[1] * t0[1]) * sc; r0[1] = (v0[0] * t0[1] + v0[1] * t0[0]) * sc;
                        r0[2] = (v0[2] * t0[2] - v0[3] * t0[3]) * sc; r0[3] = (v0[2] * t0[3] + v0[3] * t0[2]) * sc;
                        r1[0] = (v1[0] * t1[0] - v1[1] * t1[1]) * sc; r1[1] = (v1[0] * t1[1] + v1[1] * t1[0]) * sc;
                        r1[2] = (v1[2] * t1[2] - v1[3] * t1[3]) * sc; r1[3] = (v1[2] * t1[3] + v1[3] * t1[2]) * sc;
                        v0 = r0; v1 = r1;
                    } else if (grp == 6) {
#pragma unroll
                        for (int j = 0; j < 4; ++j) { v0[j] = fast_silu(v0[j]); v1[j] = fast_silu(v1[j]); }
                    }
                    *(u32x4*)(rowp + bj * HALF) = pack8(v0, v1);
                }
            }
        if (grp == 1) {
#pragma unroll
            for (int bj = 0; bj < 2; ++bj)
#pragma unroll
                for (int n = 0; n < 2; ++n) {
                    f32x4 s = cs[bj][n];
#pragma unroll
                    for (int c4 = 0; c4 < 4; ++c4) { float t = s[c4]; t += xl::xor_f<1>(t); t += xl::xor_f<2>(t); t += xl::xor_f<4>(t); t += xl::xor_f<8>(t); s[c4] = t; }
                    if (fr == 0) *(f32x4*)(KMP + (size_t)(u.pm * 2 + wr) * 512 + col0 + bj * HALF + 4 * n) = s;
                }
        }
    }
};

struct EpiOutProj {
    static constexpr bool PERM = false; static constexpr int MID_T = 8; static constexpr bool FP8 = false; static constexpr int SCALE_W = 0;
    const float* xin; float* out; const float* g1;
    const float* assq;
    bool dry;
    static constexpr int RS_OFF = 131072 + 8192;
    __device__ __forceinline__ void pre(const Unit& u, PG8_LAS unsigned char* lds, int tid) const {
        if (tid < 256) { const int row = u.pm * 256 + tid;
            const f32x4 a = *(const f32x4*)(assq + (size_t)row * 8), c = *(const f32x4*)(assq + (size_t)row * 8 + 4);
            const float ss = ((a[0] + a[1]) + (a[2] + a[3])) + ((c[0] + c[1]) + (c[2] + c[3]));
            ((PG8_LAS float*)(lds + RS_OFF))[tid] = 1.0f / sqrtf(ss * (1.0f / 512.0f) + 1e-6f); }
    }
    __device__ __forceinline__ void mid(Acc& acc, PG8_LAS unsigned char* lds, int wr, int fr) const {
        const PG8_LAS float* tab = (const PG8_LAS float*)(lds + RS_OFF) + wr * 64 + fr;
#pragma unroll
        for (int ai = 0; ai < 2; ++ai)
#pragma unroll
            for (int m = 0; m < 4; ++m) {
                const float rs = tab[ai * HALF + m * 16];
#pragma unroll
                for (int bj = 0; bj < 2; ++bj)
#pragma unroll
                    for (int n = 0; n < 2; ++n) acc[ai][bj][m][n] = acc[ai][bj][m][n] * rs;
            }
    }
    __device__ __forceinline__ void operator()(const Acc& acc, const Unit& u, int wr, int wc, int fr, int fq) const {
        const int b = u.pm >> 3;
        const int col0 = u.pn * 256 + wc * 32 + 4 * fq;
        const int row0 = u.pm * 256 + wr * 64 + fr;
        f32x4 gv[2][2];
#pragma unroll
        for (int bj = 0; bj < 2; ++bj)
#pragma unroll
            for (int n = 0; n < 2; ++n) gv[bj][n] = *(const f32x4*)(g1 + (size_t)b * 6144 + col0 + bj * HALF + n * 16);
#pragma unroll
        for (int ai = 0; ai < 2; ++ai)
#pragma unroll
            for (int m = 0; m < 4; ++m) {
                const size_t off = (size_t)(row0 + ai * HALF + m * 16) * 1024 + col0;
#pragma unroll
                for (int bj = 0; bj < 2; ++bj)
#pragma unroll
                    for (int n = 0; n < 2; ++n) { const f32x4 bs = *(const f32x4*)(xin + off + bj * HALF + n * 16); const f32x4 r = bs + gv[bj][n] * acc[ai][bj][m][n]; if (!dry) *(f32x4*)(out + off + bj * HALF + n * 16) = r; else asm volatile("" :: "v"(r)); }
            }
    }
};

struct EpiSwiGLU {
    static constexpr bool PERM = true; static constexpr int MID_T = 0; static constexpr bool FP8 = false; static constexpr int SCALE_W = 0;
    bf16_t* H; int ldh;
    __device__ __forceinline__ void operator()(const Acc& acc, const Unit& u, int wr, int wc, int fr, int fq) const {
        const int col0 = u.pn * 128 + wc * 32 + 8 * fq;
        const int row0 = u.pm * 256 + wr * 64 + fr;
#pragma unroll
        for (int ai = 0; ai < 2; ++ai)
#pragma unroll
            for (int m = 0; m < 4; ++m) {
                const int row = row0 + ai * HALF + m * 16;
                f32x4 v0, v1;
#pragma unroll
                for (int j = 0; j < 4; ++j) { v0[j] = fast_silu(acc[ai][0][m][0][j]) * acc[ai][1][m][0][j]; v1[j] = fast_silu(acc[ai][0][m][1][j]) * acc[ai][1][m][1][j]; }
                *(u32x4*)(H + (size_t)row * ldh + col0) = pack8(v0, v1);
            }
    }
};

struct EpiDown {
    static constexpr bool PERM = false; static constexpr int MID_T = 0; static constexpr bool FP8 = false; static constexpr int SCALE_W = 0;
    float* out; const float* g2; bf16_t* YS; const int* srow; const float* swt; bool moe; bool dry; int* atomf; bool atomic; float* slab; int KS;
    __device__ __forceinline__ void operator()(const Acc& acc, const Unit& u, int wr, int wc, int fr, int fq) const {
        const int col0 = u.pn * 256 + wc * 32 + 4 * fq;
        const int row0 = u.pm * 256 + wr * 64 + fr;
        if (!moe) {
            const int b = u.pm >> 3;
            f32x4 gv[2][2];
#pragma unroll
            for (int bj = 0; bj < 2; ++bj)
#pragma unroll
                for (int n = 0; n < 2; ++n) gv[bj][n] = *(const f32x4*)(g2 + (size_t)b * 6144 + col0 + bj * HALF + n * 16);
#pragma unroll
            for (int ai = 0; ai < 2; ++ai)
#pragma unroll
                for (int m = 0; m < 4; ++m) {
                    const size_t off = (size_t)(row0 + ai * HALF + m * 16) * 1024 + col0;
#pragma unroll
                    for (int bj = 0; bj < 2; ++bj)
#pragma unroll
                        for (int n = 0; n < 2; ++n) { const f32x4 bs = *(const f32x4*)(out + off + bj * HALF + n * 16); const f32x4 r = bs + gv[bj][n] * acc[ai][bj][m][n]; if (!dry) *(f32x4*)(out + off + bj * HALF + n * 16) = r; else asm volatile("" :: "v"(r)); }
                }
        } else if (atomic) {
            float* sl = slab + ((size_t)(u.li * KS + u.kc) * 256) * 256 + (wc * 32 + 4 * fq);
#pragma unroll
            for (int ai = 0; ai < 2; ++ai)
#pragma unroll
                for (int m = 0; m < 4; ++m) {
                    const int rl = ai * HALF + wr * 64 + m * 16 + fr; const int pos = u.pm * 256 + rl;
                    const int sr = srow[pos];
                    if (sr >= 0) { const float w = swt[pos];
                        if (u.kc == 0 && wc == 0 && fq == 0) atomf[sr * 4 + u.pn] = 1 + u.li * 256 + rl;
#pragma unroll
                        for (int bj = 0; bj < 2; ++bj)
#pragma unroll
                            for (int n = 0; n < 2; ++n) *(f32x4*)(sl + (size_t)rl * 256 + bj * HALF + n * 16) = acc[ai][bj][m][n] * w; }
                }
        } else {
#pragma unroll
            for (int ai = 0; ai < 2; ++ai)
#pragma unroll
                for (int m = 0; m < 4; ++m) {
                    const int pos = row0 + ai * HALF + m * 16;
                    const int sr = srow[pos];
                    if (sr >= 0) { const float w = swt[pos]; bf16_t* rowp = YS + (size_t)sr * 1024 + col0;
#pragma unroll
                        for (int bj = 0; bj < 2; ++bj)
#pragma unroll
                            for (int n = 0; n < 2; ++n) { const f32x4 v = acc[ai][bj][m][n] * w; pg8::u32x2 o; o.x = cvt_pk_bf16(v[0], v[1]); o.y = cvt_pk_bf16(v[2], v[3]); if (!dry) *(pg8::u32x2*)(rowp + bj * HALF + n * 16) = o; else asm volatile("" :: "v"(o)); } }
                }
        }
    }
};

__device__ __forceinline__ float clamp448(float v) { return __builtin_fminf(__builtin_fmaxf(v, -448.0f), 448.0f); }
__device__ __forceinline__ unsigned pk4_fp8(float a, float b, float c, float d) {
    int p = 0; p = __builtin_amdgcn_cvt_pk_fp8_f32(clamp448(a), clamp448(b), p, false); p = __builtin_amdgcn_cvt_pk_fp8_f32(clamp448(c), clamp448(d), p, true); return (unsigned)p; }
struct EpiSwiGLU8 {
    static constexpr bool PERM = true; static constexpr int MID_T = 0; static constexpr bool FP8 = true; static constexpr int SCALE_W = 0x7a7a7a7a;
    unsigned char* H; int ldh;
    __device__ __forceinline__ void operator()(const Acc& acc, const Unit& u, int wr, int wc, int fr, int fq) const {
        const int col0 = u.pn * 128 + wc * 32 + 8 * fq;
        const int row0 = u.pm * 256 + wr * 64 + fr;
#pragma unroll
        for (int ai = 0; ai < 2; ++ai)
#pragma unroll
            for (int m = 0; m < 4; ++m) {
                const int row = row0 + ai * HALF + m * 16;
                f32x4 v0, v1;
#pragma unroll
                for (int j = 0; j < 4; ++j) { v0[j] = fast_silu(acc[ai][0][m][0][j]) * acc[ai][1][m][0][j]; v1[j] = fast_silu(acc[ai][0][m][1][j]) * acc[ai][1][m][1][j]; }
                pg8::u32x2 w; w.x = pk4_fp8(v0[0], v0[1], v0[2], v0[3]); w.y = pk4_fp8(v1[0], v1[1], v1[2], v1[3]);
                *(pg8::u32x2*)(H + (size_t)row * ldh + col0) = w;
            }
    }
};
struct EpiDownMoe8 {
    static constexpr bool PERM = false; static constexpr int MID_T = 0; static constexpr bool FP8 = true; static constexpr int SCALE_W = 0x79797979;
    bf16_t* YS; const int* srow; const float* swt;
    __device__ __forceinline__ void operator()(const Acc& acc, const Unit& u, int wr, int wc, int fr, int fq) const {
        const int col0 = u.pn * 256 + wc * 32 + 4 * fq;
        const int row0 = u.pm * 256 + wr * 64 + fr;
#pragma unroll
        for (int ai = 0; ai < 2; ++ai)
#pragma unroll
            for (int m = 0; m < 4; ++m) {
                const int pos = row0 + ai * HALF + m * 16;
                const int sr = srow[pos];
                if (sr >= 0) { const float w = swt[pos]; bf16_t* rowp = YS + (size_t)sr * 1024 + col0;
#pragma unroll
                    for (int bj = 0; bj < 2; ++bj)
#pragma unroll
                        for (int n = 0; n < 2; ++n) { const f32x4 v = acc[ai][bj][m][n] * w; pg8::u32x2 o; o.x = cvt_pk_bf16(v[0], v[1]); o.y = cvt_pk_bf16(v[2], v[3]); *(pg8::u32x2*)(rowp + bj * HALF + n * 16) = o; } }
            }
    }
};
}
namespace fa {
#define FA_LAS __attribute__((address_space(3)))
typedef unsigned short bf16_t;
typedef short bf16x8 __attribute__((ext_vector_type(8)));
typedef short s16x4 __attribute__((ext_vector_type(4)));
typedef float f32x16 __attribute__((ext_vector_type(16)));
typedef float f32x4 __attribute__((ext_vector_type(4)));
typedef unsigned u32x4 __attribute__((ext_vector_type(4)));
typedef float f32x2_t __attribute__((ext_vector_type(2))); typedef __bf16 bf16x2_t __attribute__((ext_vector_type(2)));
constexpr int L_WSF = 131072 + 1024, L_KM = L_WSF + 2048;
constexpr float NEG = -1.0e30f;
__device__ __forceinline__ int crow(int r, int hi) { return (r & 3) + 8 * (r >> 2) + 4 * hi; }
__device__ __forceinline__ void glds16(const void* gsrc, unsigned lds_dst) { unsigned keep;
    asm volatile("s_mov_b32 %0, m0\n\ts_mov_b32 m0, %2\n\ts_nop 0\n\tglobal_load_lds_dwordx4 %1, off\n\ts_mov_b32 m0, %0" : "=&s"(keep) : "v"(gsrc), "s"(lds_dst) : "memory"); }
__device__ __forceinline__ unsigned cvtpk_s(float lo, float hi) { return h16::pk(lo, hi); }
__device__ __forceinline__ float bf2f(short s) { return h16::one((unsigned short)s); }
typedef short v4i16_t __attribute__((ext_vector_type(4)));
__device__ __forceinline__ s16x4 vtr(FA_LAS const unsigned char* p) { return __builtin_bit_cast(s16x4, __builtin_amdgcn_ds_read_tr16_b64_v4i16((FA_LAS v4i16_t*)p)); }
#define FA_WAIT_BAR() asm volatile("s_waitcnt vmcnt(0) lgkmcnt(0)\n\ts_barrier" ::: "memory")
#define FA_LBAR() asm volatile("s_waitcnt lgkmcnt(0)\n\ts_barrier" ::: "memory")

struct Tensors {
    const bf16_t* Q; const bf16_t* K; const bf16_t* V;
    bf16_t* CAT;
    float* ASSQ;
    const float* KMP;
    const bf16_t* GR;
    const float* ret_g;
    const float* KVM;
};

template <bool RET>
__device__ __forceinline__ void attn_unit(const int wv, int b, int h, int qblk, const Tensors& T, FA_LAS unsigned char* shm) {
    constexpr int NS = RET ? 3 : 4, DIST = NS - 1;
    constexpr int DH = RET ? 128 : 64, ND0 = DH / 16, NDB = DH / 32, NPC = DH / 64, SLOT = 64 * DH * 2, L_K = 0, L_V = NS * SLOT, PER = 2 * NPC, L_R = 98304;
    int tid_ = otid(wv);
    const int tid = tid_, lane = tid & 63, r32 = lane & 31, hi = lane >> 5; const int wid = __builtin_amdgcn_readfirstlane(tid >> 6);
    const size_t rowbase = (size_t)b * 2048; const int q0 = qblk * 256;
    const unsigned lds0 = (unsigned)(unsigned long)shm;
    FA_LAS float* wsf = (FA_LAS float*)(shm + L_WSF) + wid * 64;
    FA_LAS float* KM = (FA_LAS float*)(shm + L_KM);
    const bf16_t* Kh = T.K + rowbase * 512 + h * DH; const bf16_t* Vh = T.V + rowbase * 512 + h * DH;
    const int NT = RET ? 4 : 4 * (qblk + 1);
#define FA_KV0(i) ((((i) < 4) ? qblk : (qblk - 1 - (((i) - 4) >> 2))) * 256 + ((i) & 3) * 64)
#define FA_DMA(i) do { const int kv0_ = FA_KV0(i); const unsigned so_ = (unsigned)(((i) % NS) * SLOT); \
        _Pragma("unroll") for (int pp = 0; pp < NPC; ++pp) { const int p = wid + 8 * pp; \
            glds16(Kh + (size_t)(kv0_ + lane) * 512 + p * 8, (unsigned)__builtin_amdgcn_readfirstlane(lds0 + L_K + so_ + p * 1024)); } \
        _Pragma("unroll") for (int pp = 0; pp < NPC; ++pp) { const int p = wid + 8 * pp; \
            glds16(Vh + (size_t)(kv0_ + 16 * (p & 3) + (lane >> 2)) * 512 + (p >> 2) * 32 + (lane & 3) * 8, (unsigned)__builtin_amdgcn_readfirstlane(lds0 + L_V + so_ + p * 1024)); } } while (0)
    FA_DMA(0); if (NT > 1) FA_DMA(1); if (DIST > 2 && NT > 2) FA_DMA(2);
    const bf16_t* Qw = T.Q + (rowbase + q0 + wid * 32 + r32) * 512 + h * DH;
    bf16x8 qr[ND0];
#pragma unroll
    for (int d0 = 0; d0 < ND0; ++d0) qr[d0] = *(const bf16x8*)(Qw + d0 * 16 + hi * 8);
    unsigned selmask = 0xffu;
    float cfac[16]; float lg2 = 0.f;
    if (!RET) {
        { const int j = tid >> 6, d = tid & 63; const float* kp = T.KMP + ((size_t)(b * 8 + j) * 2) * 512 + h * 64 + d; KM[tid] = kp[0] + kp[512]; }
        FA_LBAR();
        float g[8];
#pragma unroll
        for (int j = 0; j < 8; ++j) g[j] = 0.f;
#pragma unroll
        for (int d0 = 0; d0 < ND0; ++d0)
#pragma unroll
            for (int jj = 0; jj < 8; ++jj) { const float qv = bf2f(qr[d0][jj]); const int d = 16 * d0 + 8 * hi + jj;
#pragma unroll
                for (int j = 0; j < 8; ++j) g[j] += qv * KM[j * 64 + d]; }
#pragma unroll
        for (int j = 0; j < 8; ++j) g[j] = xl::add32(g[j]);
        selmask = 0u;
#pragma unroll
        for (int j = 0; j < 8; ++j) { int rank = 0;
#pragma unroll
            for (int mm = 0; mm < 8; ++mm) rank += (mm < qblk && (g[mm] > g[j] || (g[mm] == g[j] && mm < j))) ? 1 : 0;
            if (j < qblk && rank < 3) selmask |= 1u << j; }
    } else {
        lg2 = log2f(1.0f - exp2f(-5.0f - (float)h));
#pragma unroll
        for (int r = 0; r < 16; ++r) cfac[r] = exp2f(-lg2 * (float)((r & 3) + 8 * (r >> 2)));
    }
    f32x16 o[NDB];
#pragma unroll
    for (int db = 0; db < NDB; ++db) o[db] = f32x16{};
    float mhat = 0.f, lrow = 0.f; f32x16 negm = f32x16{}; constexpr float THR = 8.0f;
    if (RET && qblk > 0) {
        const float* kvb = T.KVM + ((size_t)(b * 4 + h) * 8) * 16384;
        const float g256 = exp2f(lg2 * 256.0f);
#pragma unroll 2
        for (int it = 0; it < 8; ++it) { const int idx4 = tid + 512 * it; const int d = idx4 >> 5, e0 = (idx4 & 31) * 4;
            f32x4 acc4 = (f32x4){0.f, 0.f, 0.f, 0.f};
            for (int m = 0; m < qblk; ++m) acc4 = acc4 * g256 + *(const f32x4*)(kvb + (size_t)m * 16384 + d * 128 + e0);
            const int rp = (d & ~12) | ((d & 8) >> 1) | ((d & 4) << 1);
            typedef unsigned u32x2_ __attribute__((ext_vector_type(2)));
            u32x2_ w; w.x = cvtpk_s(acc4[0], acc4[1]); w.y = cvtpk_s(acc4[2], acc4[3]);
            *(FA_LAS u32x2_*)(shm + L_R + (e0 >> 5) * 8192 + rp * 64 + (e0 & 31) * 2) = w; }
        FA_LBAR();
        { FA_LAS const unsigned char* rb = shm + L_R + ((lane >> 4) & 1) * 32 + (lane & 3) * 8 + (4 * hi + ((lane & 15) >> 2)) * 64;
#pragma unroll
          for (int db = 0; db < NDB; ++db)
#pragma unroll
              for (int d0 = 0; d0 < ND0; ++d0) { const s16x4 lo = vtr(rb + db * 8192 + d0 * 1024), hh = vtr(rb + db * 8192 + d0 * 1024 + 512);
                  const bf16x8 rf = (bf16x8){lo[0], lo[1], lo[2], lo[3], hh[0], hh[1], hh[2], hh[3]};
                  o[db] = __builtin_amdgcn_mfma_f32_32x32x16_f16(__builtin_bit_cast(h16::f16x8_t, qr[d0]), __builtin_bit_cast(h16::f16x8_t, rf), o[db], 0, 0, 0); } }
#pragma unroll
        for (int r = 0; r < 16; ++r) { const float rd = exp2f(lg2 * (float)(wid * 32 + crow(r, hi) + 1));
#pragma unroll
            for (int db = 0; db < NDB; ++db) o[db][r] *= rd; }
    }
    const int qrel = wid * 32 + r32;
    for (int i = 0; i < NT; ++i) {
        { const int ahead = (NT - 1 - i) < (DIST - 1) ? (NT - 1 - i) : (DIST - 1);
          if (ahead == 2) { if (PER == 2) asm volatile("s_waitcnt vmcnt(4) lgkmcnt(0)\n\ts_barrier" ::: "memory"); else asm volatile("s_waitcnt vmcnt(8) lgkmcnt(0)\n\ts_barrier" ::: "memory"); }
          else if (ahead == 1) { if (PER == 2) asm volatile("s_waitcnt vmcnt(2) lgkmcnt(0)\n\ts_barrier" ::: "memory"); else asm volatile("s_waitcnt vmcnt(4) lgkmcnt(0)\n\ts_barrier" ::: "memory"); }
          else FA_WAIT_BAR(); }
        if (i + DIST < NT) FA_DMA(i + DIST);
        const bool diag = i < 4; const int t = i & 3; const int j = diag ? qblk : (qblk - 1 - ((i - 4) >> 2));
        const bool mysel = RET ? true : (((selmask >> j) & 1u) != 0u);
        const bool skip = diag ? (64 * t > 32 * wid + 31) : (RET ? false : !__any(mysel));
        if (skip) continue;
        const unsigned so = (unsigned)((i % NS) * SLOT);
        f32x16 p0 = RET ? f32x16{} : negm, p1 = p0;
        { FA_LAS const unsigned char* kb = shm + L_K + so + hi * 1024 + r32 * 16;
#pragma unroll
          for (int d0 = 0; d0 < ND0; ++d0) { const bf16x8 b0 = *(FA_LAS const bf16x8*)(kb + d0 * 2048); const bf16x8 b1 = *(FA_LAS const bf16x8*)(kb + d0 * 2048 + 512);
              p0 = __builtin_amdgcn_mfma_f32_32x32x16_f16(__builtin_bit_cast(h16::f16x8_t, b0), __builtin_bit_cast(h16::f16x8_t, qr[d0]), p0, 0, 0, 0); p1 = __builtin_amdgcn_mfma_f32_32x32x16_f16(__builtin_bit_cast(h16::f16x8_t, b1), __builtin_bit_cast(h16::f16x8_t, qr[d0]), p1, 0, 0, 0); } }
        if (RET) {
            const int qpos = q0 + qrel; const int kv0 = j * 256 + t * 64;
            const float base = (float)(qpos - kv0 - 4 * hi);
            const float rf0 = exp2f(lg2 * base), rf1 = exp2f(lg2 * (base - 32.0f));
#pragma unroll
            for (int r = 0; r < 16; ++r) { p0[r] *= rf0 * cfac[r]; p1[r] *= rf1 * cfac[r]; }
            if (diag) { const int kb_ = 64 * t + 4 * hi;
#pragma unroll
                for (int r = 0; r < 16; ++r) { const int kv = kb_ + (r & 3) + 8 * (r >> 2); if (kv > qrel) p0[r] = 0.f; if (kv + 32 > qrel) p1[r] = 0.f; } }
        } else {
            if (diag) { const int kb_ = 64 * t + 4 * hi;
#pragma unroll
                for (int r = 0; r < 16; ++r) { const int kv = kb_ + (r & 3) + 8 * (r >> 2); if (kv > qrel) p0[r] = NEG; if (kv + 32 > qrel) p1[r] = NEG; } }
            else if (!mysel) {
#pragma unroll
                for (int r = 0; r < 16; ++r) { p0[r] = NEG; p1[r] = NEG; } }
            float rm = fmaxf(fmaxf(p0[0], p1[0]), p0[1]);
#pragma unroll
            for (int r = 1; r < 16; ++r) { rm = fmaxf(fmaxf(rm, p1[r]), (r < 15) ? p0[r + 1] : p1[r]); }
            rm = xl::max32(rm);
            if (__any(rm > THR)) {
                const float dl = fmaxf(rm, 0.f);
                mhat += dl;
#pragma unroll
                for (int r = 0; r < 16; ++r) { p0[r] -= dl; p1[r] -= dl; }
#pragma unroll
                for (int r = 0; r < 16; ++r) negm[r] = -mhat;
                const float f = __builtin_amdgcn_exp2f(-dl); lrow *= f;
                asm volatile("" ::: "memory");
                if (hi == 0) wsf[r32] = f;
                asm volatile("s_waitcnt lgkmcnt(0)" ::: "memory");
#pragma unroll
                for (int r = 0; r < 16; ++r) { const float fr_ = wsf[crow(r, hi)];
#pragma unroll
                    for (int db = 0; db < NDB; ++db) o[db][r] *= fr_; }
                asm volatile("s_waitcnt lgkmcnt(0)" ::: "memory");
            }
            float s = 0.f;
#pragma unroll
            for (int r = 0; r < 16; ++r) { p0[r] = __builtin_amdgcn_exp2f(p0[r]); p1[r] = __builtin_amdgcn_exp2f(p1[r]); s += p0[r] + p1[r]; }
            lrow += s;
        }
        bf16x8 pa[4];
        { u32x4 w;
          w.x = cvtpk_s(p0[0], p0[1]); w.y = cvtpk_s(p0[2], p0[3]); w.z = cvtpk_s(p0[4], p0[5]); w.w = cvtpk_s(p0[6], p0[7]); pa[0] = __builtin_bit_cast(bf16x8, w);
          w.x = cvtpk_s(p0[8], p0[9]); w.y = cvtpk_s(p0[10], p0[11]); w.z = cvtpk_s(p0[12], p0[13]); w.w = cvtpk_s(p0[14], p0[15]); pa[1] = __builtin_bit_cast(bf16x8, w);
          w.x = cvtpk_s(p1[0], p1[1]); w.y = cvtpk_s(p1[2], p1[3]); w.z = cvtpk_s(p1[4], p1[5]); w.w = cvtpk_s(p1[6], p1[7]); pa[2] = __builtin_bit_cast(bf16x8, w);
          w.x = cvtpk_s(p1[8], p1[9]); w.y = cvtpk_s(p1[10], p1[11]); w.z = cvtpk_s(p1[12], p1[13]); w.w = cvtpk_s(p1[14], p1[15]); pa[3] = __builtin_bit_cast(bf16x8, w); }
        { FA_LAS const unsigned char* vb = shm + L_V + so + ((lane >> 4) & 1) * 32 + (lane & 3) * 8 + (4 * hi + ((lane & 15) >> 2)) * 64;
#pragma unroll
          for (int db = 0; db < NDB; ++db)
#pragma unroll
              for (int ks = 0; ks < 4; ++ks) { const s16x4 lo = vtr(vb + db * 4096 + ks * 1024), hh = vtr(vb + db * 4096 + ks * 1024 + 512);
                  const bf16x8 vf = (bf16x8){lo[0], lo[1], lo[2], lo[3], hh[0], hh[1], hh[2], hh[3]};
                  o[db] = __builtin_amdgcn_mfma_f32_32x32x16_f16(__builtin_bit_cast(h16::f16x8_t, pa[ks]), __builtin_bit_cast(h16::f16x8_t, vf), o[db], 0, 0, 0); } }
    }
    float rli[16];
    if (!RET) {
        const float l = xl::add32(lrow);
        asm volatile("" ::: "memory");
        if (hi == 0) wsf[32 + r32] = 1.0f / l;
        asm volatile("s_waitcnt lgkmcnt(0)" ::: "memory");
#pragma unroll
        for (int r = 0; r < 16; ++r) rli[r] = wsf[32 + crow(r, hi)];
    } else {
#pragma unroll
        for (int r = 0; r < 16; ++r) rli[r] = 1.0f;
    }
    FA_LBAR();
    FA_LAS bf16_t* stg = (FA_LAS bf16_t*)(shm + wid * 8192);
#pragma unroll
    for (int r = 0; r < 16; ++r) { const int orow = crow(r, hi);
#pragma unroll
        for (int db = 0; db < NDB; ++db) { const unsigned pk = cvtpk_s(o[db][r] * rli[r], 0.f); stg[orow * DH + db * 32 + r32] = (bf16_t)(pk & 0xffffu); } }
    asm volatile("s_waitcnt lgkmcnt(0)" ::: "memory");
    const size_t tok0 = rowbase + q0 + wid * 32;
    if (!RET) {
#pragma unroll
        for (int i = 0; i < 4; ++i) { const int row = i * 8 + (lane >> 3), ch = lane & 7;
            const u32x4 v = *(FA_LAS const u32x4*)(stg + row * 64 + ch * 8);
            float ss = 0.f;
#pragma unroll
            for (int k = 0; k < 4; ++k) { const float a = h16::lo(v[k]), c = h16::hi(v[k]); ss += a * a + c * c; }
            ss += xl::xor_f<1>(ss); ss += xl::xor_f<2>(ss); ss += xl::xor_f<4>(ss);
            if (ch == 0) T.ASSQ[(tok0 + row) * 8 + h] = ss;
            *(u32x4*)(T.CAT + (tok0 + row) * 1024 + h * 64 + ch * 8) = v; }
    } else {
#pragma unroll
        for (int i = 0; i < 8; ++i) { const int row = i * 4 + (lane >> 4), ch = lane & 15;
            const u32x4 v = *(FA_LAS const u32x4*)(stg + row * 128 + ch * 8);
            float x[8];
#pragma unroll
            for (int k = 0; k < 4; ++k) { x[2 * k] = h16::lo(v[k]); x[2 * k + 1] = h16::hi(v[k]); }
            float ss = 0.f;
#pragma unroll
            for (int k = 0; k < 8; ++k) ss += x[k] * x[k];
            ss += xl::xor_f<1>(ss); ss += xl::xor_f<2>(ss); ss += xl::xor_f<4>(ss); ss += xl::xor_f<8>(ss);
            const float rs = 1.0f / sqrtf(ss * (1.0f / 128.0f) + 1e-6f);
            const u32x4 gv = *(const u32x4*)(T.GR + (tok0 + row) * 512 + h * 128 + ch * 8);
            const f32x4 w0 = *(const f32x4*)(T.ret_g + h * 128 + ch * 8), w1 = *(const f32x4*)(T.ret_g + h * 128 + ch * 8 + 4);
            const float wg[8] = {w0[0], w0[1], w0[2], w0[3], w1[0], w1[1], w1[2], w1[3]};
            float y[8];
#pragma unroll
            for (int k = 0; k < 4; ++k) { const float g0 = h16::lo(gv[k]), g1 = h16::hi(gv[k]);
                y[2 * k] = x[2 * k] * rs * wg[2 * k] * g0; y[2 * k + 1] = x[2 * k + 1] * rs * wg[2 * k + 1] * g1; }
            u32x4 ov; ov.x = cvtpk_s(y[0], y[1]); ov.y = cvtpk_s(y[2], y[3]); ov.z = cvtpk_s(y[4], y[5]); ov.w = cvtpk_s(y[6], y[7]);
            *(u32x4*)(T.CAT + (tok0 + row) * 1024 + 512 + h * 128 + ch * 8) = ov; }
    }
    FA_LBAR();
#undef FA_KV0
#undef FA_DMA
}

__device__ __forceinline__ void kv_unit(const int wv, int b, int h, int m, const bf16_t* Kg, const bf16_t* Vg, float* KVM, FA_LAS unsigned char* shm) {
    constexpr int SLOT = 16384, L_K = 0, L_V = 4 * SLOT;
    int tid_ = otid(wv);
    const int tid = tid_, lane = tid & 63, r32 = lane & 31, hi = lane >> 5; const int wid = __builtin_amdgcn_readfirstlane(tid >> 6);
    const int dg = wid >> 1, eh = wid & 1;
    const size_t rowbase = (size_t)b * 2048 + (size_t)m * 256;
    const unsigned lds0 = (unsigned)(unsigned long)shm;
    const bf16_t* Kh = Kg + rowbase * 512 + h * 128; const bf16_t* Vh = Vg + rowbase * 512 + h * 128;
#pragma unroll
    for (int t = 0; t < 4; ++t)
#pragma unroll
        for (int pp = 0; pp < 2; ++pp) { const int p = wid + 8 * pp; const size_t off = (size_t)(64 * t + 16 * (p & 3) + (lane >> 2)) * 512 + (p >> 2) * 32 + (lane & 3) * 8;
            glds16(Kh + off, (unsigned)__builtin_amdgcn_readfirstlane(lds0 + L_K + t * SLOT + p * 1024));
            glds16(Vh + off, (unsigned)__builtin_amdgcn_readfirstlane(lds0 + L_V + t * SLOT + p * 1024)); }
    const float lg2 = log2f(1.0f - exp2f(-5.0f - (float)h));
    const float g64 = exp2f(lg2 * 64.0f);
    h16::f16x8_t fd[4];
#pragma unroll
    for (int ks = 0; ks < 4; ++ks)
#pragma unroll
        for (int j = 0; j < 8; ++j) fd[ks][j] = (_Float16)exp2f(lg2 * (float)(63 - (16 * ks + 8 * (j >> 2) + 4 * hi + (j & 3))));
    f32x16 acc[2]; acc[0] = f32x16{}; acc[1] = f32x16{};
    FA_WAIT_BAR();
    const int lb = ((lane >> 4) & 1) * 32 + (lane & 3) * 8 + (4 * hi + ((lane & 15) >> 2)) * 64;
#pragma unroll
    for (int t = 0; t < 4; ++t) {
        if (t > 0) {
#pragma unroll
            for (int r = 0; r < 16; ++r) { acc[0][r] *= g64; acc[1][r] *= g64; } }
        FA_LAS const unsigned char* kb = shm + L_K + t * SLOT + dg * 4096 + lb; FA_LAS const unsigned char* vb = shm + L_V + t * SLOT + (2 * eh) * 4096 + lb;
#pragma unroll
        for (int ks = 0; ks < 4; ++ks) { const s16x4 klo = vtr(kb + ks * 1024), khi = vtr(kb + ks * 1024 + 512);
            const h16::f16x8_t kf = __builtin_bit_cast(h16::f16x8_t, (bf16x8){klo[0], klo[1], klo[2], klo[3], khi[0], khi[1], khi[2], khi[3]});
#pragma unroll
            for (int eb = 0; eb < 2; ++eb) { const s16x4 vlo = vtr(vb + eb * 4096 + ks * 1024), vhi = vtr(vb + eb * 4096 + ks * 1024 + 512);
                const h16::f16x8_t vf = __builtin_bit_cast(h16::f16x8_t, (bf16x8){vlo[0], vlo[1], vlo[2], vlo[3], vhi[0], vhi[1], vhi[2], vhi[3]}) * fd[ks];
                acc[eb] = __builtin_amdgcn_mfma_f32_32x32x16_f16(kf, vf, acc[eb], 0, 0, 0); } }
    }
    float* op = KVM + ((size_t)(b * 4 + h) * 8 + m) * 16384;
#pragma unroll
    for (int eb = 0; eb < 2; ++eb)
#pragma unroll
        for (int r = 0; r < 16; ++r) op[(size_t)(32 * dg + crow(r, hi)) * 128 + 64 * eh + 32 * eb + r32] = acc[eb][r];
    FA_LBAR();
}
}
namespace mk {
#define GAS __attribute__((address_space(1)))
#define LAS __attribute__((address_space(3)))
typedef unsigned short bf16;
typedef unsigned v4u __attribute__((ext_vector_type(4)));
typedef unsigned v2u __attribute__((ext_vector_type(2)));
typedef float f32x4 __attribute__((ext_vector_type(4)));
typedef int i32x4 __attribute__((ext_vector_type(4)));
typedef GAS unsigned gu32;
#define RLX_AGENT __ATOMIC_RELAXED, __HIP_MEMORY_SCOPE_AGENT
#define LDS_WAIT() asm volatile("s_waitcnt lgkmcnt(0)" ::: "memory")
#define VM_WAIT() asm volatile("s_waitcnt vmcnt(0)" ::: "memory")
constexpr int NWAVES = 8;
constexpr size_t MiB = 1u << 20, KiB = 1u << 10;
constexpr size_t WS_CTL = 0;
constexpr size_t CTL_ZERO_BYTES = 64 * KiB;
constexpr size_t WS_MOD = 64 * KiB;
constexpr size_t WS_KMP = 512 * KiB;
constexpr size_t WS_EIDX = 768 * KiB;
constexpr size_t WS_EW = 896 * KiB;
constexpr size_t WS_ROPE = 1 * MiB;
constexpr size_t WS_ASSQ = 2 * MiB;
constexpr size_t WS_SROW = 2 * MiB + 512 * KiB;
constexpr size_t WS_SWT = 2 * MiB + 768 * KiB;
constexpr size_t WS_WCNT = 3 * MiB;
constexpr size_t WS_SEG = 3 * MiB + 64 * KiB;
constexpr size_t WS_ATOMF = 3 * MiB + 128 * KiB;
constexpr size_t WS_SEGD = 3 * MiB + 65 * KiB;
constexpr size_t WS_MGU = 8 * MiB;
constexpr size_t WS_SLAB = 8 * MiB;
constexpr size_t WS_MDN = 96 * MiB;
constexpr size_t WS_XA = 140 * MiB;
constexpr size_t WS_XS = 172 * MiB;
constexpr size_t WS_KVM = 172 * MiB;
constexpr size_t WS_YS = 140 * MiB;
constexpr size_t WS_WIN = 240 * MiB;
constexpr size_t WS_WOUT = 254 * MiB;
constexpr size_t WS_FGU = 258 * MiB;
constexpr size_t WS_FDN = 269 * MiB;
constexpr size_t WS_QKV = 275 * MiB;
constexpr size_t WS_CAT = 387 * MiB;
constexpr size_t WS_HD = 275 * MiB;
constexpr size_t WS_HM = 240 * MiB;
constexpr size_t WS_END = 428 * MiB;
constexpr int XS_ROWS = 34816;
constexpr int CW_BAR = 1024;

constexpr int RING_BYTES = 131072, LDSCTL_OFF = RING_BYTES, MISC_OFF = LDSCTL_OFF + 320, LDS_BYTES = 147456;

#define XB_TMO      128
#define XB_XCNT(j)  (256  + 64 * (j))
#define XB_XSUB(j)  (1280 + 64 * (j))
#define XB_XGEN(j)  (2304 + 64 * (j))
#define XB_TOP      3328
#define XB_TOPGEN   3392
#define XCD_BAR_WORDS 3456
#define XB_SPIN_CAP (1u << 18)
__device__ __forceinline__ unsigned xb_ld(unsigned* p)              { return __hip_atomic_load(p, __ATOMIC_RELAXED, __HIP_MEMORY_SCOPE_AGENT); }
__device__ __forceinline__ unsigned xb_add(unsigned* p, unsigned v) { return __hip_atomic_fetch_add(p, v, __ATOMIC_RELAXED, __HIP_MEMORY_SCOPE_AGENT); }
__device__ __forceinline__ unsigned xb_xcc_id() { return (unsigned)__builtin_amdgcn_s_getreg((3 << 11) | 20) & 0xFu; }
#define XB_SPIN(cond, bar) do { unsigned _sp = 0; while (cond) { __builtin_amdgcn_s_sleep(1); \
    if ((++_sp & 255u) == 0u) { if (xb_ld(&(bar)[XB_TMO])) break; if (_sp > XB_SPIN_CAP) { atomicAdd(&(bar)[XB_TMO], 1u); break; } } } } while (0)
struct XcdBarrier { unsigned* bar; unsigned x; volatile LAS unsigned* st; int wv; };
__device__ __forceinline__ XcdBarrier xcd_barrier_post(unsigned* bar, volatile LAS unsigned* st, int wv) {
    XcdBarrier b; b.bar = bar; b.x = xb_xcc_id(); b.st = st; b.wv = wv;
    if (otid(wv) == 0) (void)xb_add(&bar[XB_XCNT(b.x)], 1u);
    return b;
}
__device__ __forceinline__ void xcd_barrier_complete(unsigned* bar, unsigned x, unsigned& nloc, unsigned& nx) {
    const unsigned G = gridDim.x * gridDim.y * gridDim.z;
    unsigned sum, cnt, mine, sp = 0u;
    for (;;) {
        sum = 0u; cnt = 0u; mine = 0u;
#pragma unroll
        for (unsigned j = 0; j < 16; ++j) { const unsigned c = xb_ld(&bar[XB_XCNT(j)]); sum += c; cnt += (c > 0u) ? 1u : 0u; mine = (j == x) ? c : mine; }
        if (sum == G) break;
        __builtin_amdgcn_s_sleep(1);
        if ((++sp & 255u) == 0u) { if (xb_ld(&bar[XB_TMO])) break; if (sp > XB_SPIN_CAP) { atomicAdd(&bar[XB_TMO], 1u); break; } }
    }
    nloc = mine > 0u ? mine : 1u; nx = cnt > 0u ? cnt : 1u;
}
__device__ __forceinline__ void xcd_barrier(const XcdBarrier& b) {
    asm volatile("s_waitcnt vmcnt(0)" ::: "memory");
    __syncthreads();
    if (otid(b.wv) == 0) {
        unsigned* bar = b.bar;
        __builtin_amdgcn_s_waitcnt(0);
        unsigned nloc = b.st[0], nx = b.st[1];
        if (nloc == 0u) { xcd_barrier_complete(bar, b.x, nloc, nx); b.st[0] = nloc; b.st[1] = nx; }
        const unsigned old = xb_add(&bar[XB_XSUB(b.x)], 1u);
        const unsigned gen = old / nloc;
        if (old + 1u == (gen + 1u) * nloc) {
            __builtin_amdgcn_fence(__ATOMIC_RELEASE, "agent");
            asm volatile("s_waitcnt vmcnt(0)" ::: "memory");
            const unsigned og = xb_add(&bar[XB_TOP], 1u);
            const unsigned tg = og / nx;
            if (og + 1u == (tg + 1u) * nx) xb_add(&bar[XB_TOPGEN], 1u);
            else XB_SPIN(xb_ld(&bar[XB_TOPGEN]) == tg, bar);
            __builtin_amdgcn_fence(__ATOMIC_ACQUIRE, "agent");
            xb_add(&bar[XB_XGEN(b.x)], 1u);
            asm volatile("s_waitcnt vmcnt(0)" ::: "memory");
        } else {
            XB_SPIN(xb_ld(&bar[XB_XGEN(b.x)]) == gen, bar);
            __builtin_amdgcn_fence(__ATOMIC_ACQUIRE, "agent");
            asm volatile("s_waitcnt vmcnt(0)" ::: "memory");
        }
    }
    __syncthreads();
}

__device__ __forceinline__ unsigned f2bf(float f) { unsigned u = __builtin_bit_cast(unsigned, f); return (u + 0x7fffu + ((u >> 16) & 1u)) >> 16; }
__device__ __forceinline__ unsigned pk2(float lo, float hi) { return h16::pk(lo, hi); }
using xl::wave_sum; using xl::wave_sum_i;

struct Inputs {
    const float *x, *c, *norm_mix_g, *norm_ffn_g, *ada_w, *ada_b, *w_in, *w_out, *att_g, *ret_g, *fw_gate, *fw_up, *fw_down, *router_w, *mw_gate, *mw_up, *mw_down, *final_g;
};

template <class SrcFn> __device__ __forceinline__ void transpose_item(SrcFn src, int K, bf16* WT, int k0, int n0, LAS float* scr, int lane) {
#pragma unroll 8
    for (int i = 0; i < 32; ++i) { const int kk = 2 * i + (lane >> 5); scr[kk * 33 + (lane & 31)] = src(k0 + kk, n0 + (lane & 31)); }
    LDS_WAIT(); asm volatile("" ::: "memory");
    const int c = lane & 7;
#pragma unroll
    for (int j = 0; j < 4; ++j) { const int n = (lane >> 3) + 8 * j; const LAS float* s = scr + (8 * c) * 33 + n;
        v4u o; o.x = pk2(s[0 * 33], s[1 * 33]); o.y = pk2(s[2 * 33], s[3 * 33]); o.z = pk2(s[4 * 33], s[5 * 33]); o.w = pk2(s[6 * 33], s[7 * 33]);
        *(GAS v4u*)(WT + (size_t)(n0 + n) * K + k0 + 8 * c) = o; }
    LDS_WAIT(); asm volatile("" ::: "memory");
}
__device__ __forceinline__ int rot_src_col(int n) {
    if (n < 1536 || n >= 2560) return n;
    const int hb = (n - 1536) & ~127, p = (n - 1536) & 127;
    return 1536 + hb + 4 * (p >> 3) + ((p & 7) >> 1) + 64 * (p & 1);
}
constexpr int IT_WIN = 16 * 112, IT_WOUT = 16 * 32, IT_GU = 16 * 176, IT_DN = 44 * 32;
constexpr int IT_TOTAL = 2 * IT_WIN + 2 * IT_WOUT + IT_GU + IT_DN + 8 * (IT_GU + IT_DN);

constexpr int IT_NONMOE = 2 * IT_WIN + 2 * IT_WOUT + IT_GU + IT_DN;
__device__ __forceinline__ void convert_item(const Inputs& in, unsigned char* ws, int it, LAS float* scr, int lane) {
    int r = it;
    if (r < 2 * IT_WIN) { const int l = r / IT_WIN; r -= l * IT_WIN; const float* W = in.w_in + (size_t)l * 1024 * 3584;
        transpose_item([=](int k, int n) { return W[(size_t)k * 3584 + rot_src_col(n)]; }, 1024, (bf16*)(ws + WS_WIN) + (size_t)l * 3584 * 1024, 64 * (r / 112), 32 * (r % 112), scr, lane); return; }
    r -= 2 * IT_WIN;
    if (r < 2 * IT_WOUT) { const int l = r / IT_WOUT; r -= l * IT_WOUT; const float* W = in.w_out + (size_t)l * 1024 * 1024; const float* ag = in.att_g + l * 512;
        transpose_item([=](int k, int n) { return W[(size_t)k * 1024 + n] * (k < 512 ? ag[k] : 1.0f); }, 1024, (bf16*)(ws + WS_WOUT) + (size_t)l * 1024 * 1024, 64 * (r / 32), 32 * (r % 32), scr, lane); return; }
    r -= 2 * IT_WOUT;
    const float *Wg, *Wu, *Wd; bf16 *Dgu, *Ddn;
    if (r < IT_GU + IT_DN) { Wg = in.fw_gate; Wu = in.fw_up; Wd = in.fw_down; Dgu = (bf16*)(ws + WS_FGU); Ddn = (bf16*)(ws + WS_FDN); }
    else { r -= IT_GU + IT_DN; const int e = r / (IT_GU + IT_DN); r -= e * (IT_GU + IT_DN);
        Wg = in.mw_gate + (size_t)e * 1024 * 2816; Wu = in.mw_up + (size_t)e * 1024 * 2816; Wd = in.mw_down + (size_t)e * 2816 * 1024;
        Dgu = (bf16*)(ws + WS_MGU) + (size_t)e * 5632 * 1024; Ddn = (bf16*)(ws + WS_MDN) + (size_t)e * 1024 * 2816; }
    if (r < IT_GU) {
        transpose_item([=](int k, int n) { const float* W = ((n >> 7) & 1) ? Wu : Wg; return W[(size_t)k * 2816 + (n >> 8) * 128 + (n & 127)]; }, 1024, Dgu, 64 * (r / 176), 32 * (r % 176), scr, lane); return; }
    r -= IT_GU;
    transpose_item([=](int k, int n) { return Wd[(size_t)k * 1024 + n]; }, 2816, Ddn, 64 * (r / 32), 32 * (r % 32), scr, lane);
}
struct MoeItem { const float* src; bf16* dst; int ld, K, k0, n0; const float* rscale; float f8scale; };
template <int KIND  , class InP> __device__ __forceinline__ MoeItem moe_item(InP inp, unsigned char* ws, int it, int lane) {
    MoeItem m; m.rscale = nullptr; m.f8scale = (KIND == 0) ? 32.0f : 64.0f;
    if (KIND == 0) { const int e = it / IT_GU, r = it - e * IT_GU; const int kb = r / 176, nb = r % 176; const int n = 32 * nb; m.k0 = 64 * kb; m.n0 = n; m.ld = 2816; m.K = 1024;
        const float* W = (((n >> 7) & 1) ? inp->mw_up : inp->mw_gate) + (size_t)e * 1024 * 2816;
        m.src = W + (size_t)(m.k0 + (lane >> 5)) * 2816 + (n >> 8) * 128 + (n & 127) + (lane & 31); m.dst = (bf16*)(ws + WS_MGU + (size_t)e * 5632 * 1024); }
    else { const int e = it / IT_DN, r = it - e * IT_DN; const int kb = r / 32, nb = r % 32; m.k0 = 64 * kb; m.n0 = 32 * nb; m.ld = 1024; m.K = 2816;
        m.src = inp->mw_down + (size_t)e * 2816 * 1024 + (size_t)(m.k0 + (lane >> 5)) * 1024 + m.n0 + (lane & 31); m.dst = (bf16*)(ws + WS_MDN + (size_t)e * 1024 * 2816); }
    return m;
}
__device__ __forceinline__ void moe_item_load(const MoeItem& m, float (&v)[32]) {
#pragma unroll
    for (int i = 0; i < 32; ++i) v[i] = m.src[(size_t)(2 * i) * m.ld];
}
__device__ __forceinline__ void moe_item_finish(const MoeItem& m, const float (&v)[32], LAS float* scr, int lane) {
    if (m.rscale != nullptr && m.k0 < 512) {
#pragma unroll
        for (int i = 0; i < 32; ++i) scr[(2 * i + (lane >> 5)) * 33 + (lane & 31)] = v[i] * m.rscale[m.k0 + 2 * i + (lane >> 5)];
    } else {
#pragma unroll
        for (int i = 0; i < 32; ++i) scr[(2 * i + (lane >> 5)) * 33 + (lane & 31)] = v[i];
    }
    LDS_WAIT(); asm volatile("" ::: "memory");
    const int c = lane & 7;
    if (m.f8scale != 0.f) {
        const float sc = m.f8scale; unsigned char* d8 = (unsigned char*)m.dst;
#pragma unroll
        for (int j = 0; j < 4; ++j) { const int n = (lane >> 3) + 8 * j; const LAS float* s = scr + (8 * c) * 33 + n;
            v2u o; int p = 0; p = __builtin_amdgcn_cvt_pk_fp8_f32(s[0 * 33] * sc, s[1 * 33] * sc, p, false); p = __builtin_amdgcn_cvt_pk_fp8_f32(s[2 * 33] * sc, s[3 * 33] * sc, p, true); o.x = (unsigned)p;
            p = 0; p = __builtin_amdgcn_cvt_pk_fp8_f32(s[4 * 33] * sc, s[5 * 33] * sc, p, false); p = __builtin_amdgcn_cvt_pk_fp8_f32(s[6 * 33] * sc, s[7 * 33] * sc, p, true); o.y = (unsigned)p;
            *(GAS v2u*)(d8 + (size_t)(m.n0 + n) * m.K + m.k0 + 8 * c) = o; }
    } else {
#pragma unroll
        for (int j = 0; j < 4; ++j) { const int n = (lane >> 3) + 8 * j; const LAS float* s = scr + (8 * c) * 33 + n;
            v4u o; o.x = pk2(s[0 * 33], s[1 * 33]); o.y = pk2(s[2 * 33], s[3 * 33]); o.z = pk2(s[4 * 33], s[5 * 33]); o.w = pk2(s[6 * 33], s[7 * 33]);
            *(GAS v4u*)(m.dst + (size_t)(m.n0 + n) * m.K + m.k0 + 8 * c) = o; }
    }
    LDS_WAIT(); asm volatile("" ::: "memory");
}
template <class InP> __device__ __forceinline__ MoeItem base_item(InP inp, unsigned char* ws, int it, int lane) {
    MoeItem m; m.rscale = nullptr; m.f8scale = 0.f; int r = it;
    if (r < 2 * IT_WIN) { const int l = r / IT_WIN; r -= l * IT_WIN; m.k0 = 64 * (r / 112); m.n0 = 32 * (r % 112); m.ld = 3584; m.K = 1024;
        m.src = inp->w_in + (size_t)l * 1024 * 3584 + (size_t)(m.k0 + (lane >> 5)) * 3584 + rot_src_col(m.n0 + (lane & 31)); m.dst = (bf16*)(ws + WS_WIN) + (size_t)l * 3584 * 1024; return m; }
    r -= 2 * IT_WIN;
    if (r < 2 * IT_WOUT) { const int l = r / IT_WOUT; r -= l * IT_WOUT; m.k0 = 64 * (r / 32); m.n0 = 32 * (r % 32); m.ld = 1024; m.K = 1024; m.rscale = inp->att_g + l * 512;
        m.src = inp->w_out + (size_t)l * 1024 * 1024 + (size_t)(m.k0 + (lane >> 5)) * 1024 + m.n0 + (lane & 31); m.dst = (bf16*)(ws + WS_WOUT) + (size_t)l * 1024 * 1024; return m; }
    r -= 2 * IT_WOUT;
    if (r < IT_GU) { const int n = 32 * (r % 176); m.k0 = 64 * (r / 176); m.n0 = n; m.ld = 2816; m.K = 1024;
        m.src = (((n >> 7) & 1) ? inp->fw_up : inp->fw_gate) + (size_t)(m.k0 + (lane >> 5)) * 2816 + (n >> 8) * 128 + (n & 127) + (lane & 31); m.dst = (bf16*)(ws + WS_FGU); return m; }
    r -= IT_GU; m.k0 = 64 * (r / 32); m.n0 = 32 * (r % 32); m.ld = 1024; m.K = 2816;
    m.src = inp->fw_down + (size_t)(m.k0 + (lane >> 5)) * 1024 + m.n0 + (lane & 31); m.dst = (bf16*)(ws + WS_FDN); return m;
}
template <class InP> __device__ __forceinline__ void convert_base_all(InP inp, unsigned char* ws, LAS unsigned char* lds, int gw, int NGW, int wave, int lane) {
    LAS float* scr = (LAS float*)(lds + wave * 16384);
    int it = gw; if (it >= IT_NONMOE) return;
    float va[32], vb[32];
    MoeItem ma = base_item(inp, ws, it, lane), mb = ma; moe_item_load(ma, va);
    for (;;) {
        const bool hb = (it + NGW) < IT_NONMOE; if (hb) { mb = base_item(inp, ws, it + NGW, lane); moe_item_load(mb, vb); }
        moe_item_finish(ma, va, scr, lane);
        if (!hb) break;
        it += NGW;
        const bool ha = (it + NGW) < IT_NONMOE; if (ha) { ma = base_item(inp, ws, it + NGW, lane); moe_item_load(ma, va); }
        moe_item_finish(mb, vb, scr, lane);
        if (!ha) break;
        it += NGW;
    }
}
template <int KIND, class InP> __device__ __forceinline__ void convert_moe_range(InP inp, unsigned char* ws, LAS unsigned char* lds, int it0, int it1, int sp, int nsp, int wave, int lane) {
    LAS float* scr = (LAS float*)(lds + wave * 16384);
    const int step = nsp * NWAVES; int it = it0 + sp * NWAVES + wave;
    if (it >= it1) return;
    float va[32], vb[32];
    MoeItem ma = moe_item<KIND>(inp, ws, it, lane), mb = ma; moe_item_load(ma, va);
    for (;;) {
        const bool hb = (it + step) < it1; if (hb) { mb = moe_item<KIND>(inp, ws, it + step, lane); moe_item_load(mb, vb); }
        moe_item_finish(ma, va, scr, lane);
        if (!hb) break;
        it += step;
        const bool ha = (it + step) < it1; if (ha) { ma = moe_item<KIND>(inp, ws, it + step, lane); moe_item_load(ma, va); }
        moe_item_finish(mb, vb, scr, lane);
        if (!ha) break;
        it += step;
    }
}
constexpr int IT_MOE = 8 * (IT_GU + IT_DN);
constexpr int G_INPROJ = 224, G_GUD = 240;
#ifndef MOE_SPARE
#define MOE_SPARE 0
#endif
constexpr int IT_MGU = 8 * IT_GU, IT_MDN = 8 * IT_DN;
#ifndef SPLIT_A
#define SPLIT_A 15000
#define SPLIT_B 22528
#define SPLIT_C 11264
#endif
constexpr int IT_MOE_A = SPLIT_A, IT_MOE_B = SPLIT_B, IT_MDN_C = SPLIT_C;

template <class InP> __device__ __forceinline__ void p0_prologue(InP inp, unsigned char* ws, LAS unsigned char* lds, int vcu, int G, int wave, int lane, int tid, int moe_w) {
    Inputs in; in.c = inp->c; in.ada_w = inp->ada_w; in.ada_b = inp->ada_b; in.w_in = inp->w_in; in.w_out = inp->w_out; in.att_g = inp->att_g; in.fw_gate = inp->fw_gate; in.fw_up = inp->fw_up; in.fw_down = inp->fw_down; in.mw_gate = inp->mw_gate; in.mw_up = inp->mw_up; in.mw_down = inp->mw_down;
    if (vcu < 192) {
        LAS float* cs = (LAS float*)lds;
        LAS float* part = (LAS float*)(lds + 32768);
        for (int i = tid; i < 8 * 1024; i += 512) { const float v = in.c[i]; cs[i] = v / (1.0f + __expf(-v)); }
        __syncthreads();
        const int n0 = vcu * 64, l = n0 / 6144, nn = n0 % 6144 + lane;
        const float* wp = in.ada_w + (size_t)l * 1024 * 6144 + (size_t)(wave * 128) * 6144 + nn;
        float acc[8];
#pragma unroll
        for (int b = 0; b < 8; ++b) acc[b] = 0.f;
#pragma unroll 8
        for (int k = 0; k < 128; ++k) { const float wv = wp[(size_t)k * 6144];
#pragma unroll
            for (int b = 0; b < 8; ++b) acc[b] += cs[b * 1024 + wave * 128 + k] * wv; }
#pragma unroll
        for (int b = 0; b < 8; ++b) part[(wave * 8 + b) * 64 + lane] = acc[b];
        __syncthreads();
        { const int b = tid >> 6; float s = 0.f;
#pragma unroll
          for (int w = 0; w < 8; ++w) s += part[(w * 8 + b) * 64 + lane];
          ((float*)(ws + WS_MOD))[((size_t)l * 8 + b) * 6144 + nn] = s + in.ada_b[l * 6144 + nn]; }
        __syncthreads();
    }
    { const int g = vcu * 512 + tid; if (g < 2048 * 64) { const int pos = g >> 6, i = g & 63; const float inv = powf(10000.0f, -(float)i / 64.0f); const float ang = (float)pos * inv;
        float* rp = (float*)(ws + WS_ROPE) + (size_t)g * 2; rp[0] = (float)cos((double)ang); rp[1] = (float)sin((double)ang); } }
    convert_base_all(inp, ws, lds, vcu * NWAVES + wave, G * NWAVES, wave, lane);
}

template <int MODE>
__device__ __forceinline__ void norm_pass(const float* xsrc, const float* gain, const float* sh, const float* sc, bf16* dst,
                                          const float* router_w, int* eidx, float* ew, int* wcnt, int gw, int lane) {
    const int m0 = gw * 8, b = m0 >> 11;
    f32x4 gv[4], scv[4], shv[4];
#pragma unroll
    for (int j = 0; j < 4; ++j) { gv[j] = ((const f32x4*)gain)[lane + 64 * j]; scv[j] = ((const f32x4*)(sc + (size_t)b * 6144))[lane + 64 * j] + 1.0f; shv[j] = ((const f32x4*)(sh + (size_t)b * 6144))[lane + 64 * j]; }
    int cnt[8];
#pragma unroll
    for (int e = 0; e < 8; ++e) cnt[e] = 0;
    f32x4 rw[4][4][2];
    if (MODE == 1) {
#pragma unroll
        for (int j = 0; j < 4; ++j)
#pragma unroll
            for (int c = 0; c < 4; ++c) { const float* wp = router_w + (size_t)(4 * (lane + 64 * j) + c) * 8; rw[j][c][0] = *(const f32x4*)wp; rw[j][c][1] = *(const f32x4*)(wp + 4); }
    }
    for (int i = 0; i < 8; ++i) {
        const int m = m0 + i;
        const f32x4* xr = (const f32x4*)(xsrc + (size_t)m * 1024) + lane;
        f32x4 v[4]; float s = 0.f;
#pragma unroll
        for (int j = 0; j < 4; ++j) { v[j] = xr[64 * j]; s += (v[j][0] * v[j][0] + v[j][1] * v[j][1]) + (v[j][2] * v[j][2] + v[j][3] * v[j][3]); }
        const float rs = 1.0f / sqrtf(wave_sum(s) * (1.0f / 1024.0f) + 1e-6f);
        v2u* o8 = (v2u*)(dst + (size_t)m * 1024) + lane;
#pragma unroll
        for (int j = 0; j < 4; ++j) { v[j] = v[j] * rs * gv[j] * scv[j] + shv[j]; v2u w; w.x = pk2(v[j][0], v[j][1]); w.y = pk2(v[j][2], v[j][3]); o8[64 * j] = w; }
        if (MODE == 1) {
            float lg[8];
#pragma unroll
            for (int e = 0; e < 8; ++e) lg[e] = 0.f;
#pragma unroll
            for (int j = 0; j < 4; ++j)
#pragma unroll
                for (int c = 0; c < 4; ++c) { const f32x4 w0 = rw[j][c][0], w1 = rw[j][c][1];
                    const float hv = v[j][c];
                    lg[0] += hv * w0[0]; lg[1] += hv * w0[1]; lg[2] += hv * w0[2]; lg[3] += hv * w0[3]; lg[4] += hv * w1[0]; lg[5] += hv * w1[1]; lg[6] += hv * w1[2]; lg[7] += hv * w1[3]; }
            { const bool b5 = (lane & 32) != 0, b4 = (lane & 16) != 0, b3 = (lane & 8) != 0;
              float a4[4], b2[2], c1;
#pragma unroll
              for (int q = 0; q < 4; ++q) { const float keep = b5 ? lg[4 + q] : lg[q], send = b5 ? lg[q] : lg[4 + q]; a4[q] = keep + xl::xor32p(send, b5); }
#pragma unroll
              for (int q = 0; q < 2; ++q) { const float keep = b4 ? a4[2 + q] : a4[q], send = b4 ? a4[q] : a4[2 + q]; b2[q] = keep + xl::xor_f<16>(send); }
              { const float keep = b3 ? b2[1] : b2[0], send = b3 ? b2[0] : b2[1]; c1 = keep + xl::xor_f<8>(send); }
              c1 += xl::xor_f<4>(c1); c1 += xl::xor_f<2>(c1); c1 += xl::xor_f<1>(c1);
#pragma unroll
              for (int e = 0; e < 8; ++e) lg[e] = __builtin_bit_cast(float, __builtin_amdgcn_readlane(__builtin_bit_cast(int, c1), 8 * e)); }
            int i0 = 0; float b0 = lg[0];
#pragma unroll
            for (int e = 1; e < 8; ++e) if (lg[e] > b0) { b0 = lg[e]; i0 = e; }
            int i1 = -1; float b1 = -3.0e38f;
#pragma unroll
            for (int e = 0; e < 8; ++e) if (e != i0 && lg[e] > b1) { b1 = lg[e]; i1 = e; }
            const float e1 = __expf(b1 - b0);
#pragma unroll
            for (int e = 0; e < 8; ++e) cnt[e] += ((e == i0) ? 1 : 0) + ((e == i1) ? 1 : 0);
            if (lane == 0) { eidx[m * 2] = i0; eidx[m * 2 + 1] = i1; ew[m * 2] = 1.0f / (1.0f + e1); ew[m * 2 + 1] = e1 / (1.0f + e1); }
        }
    }
    if (MODE == 1) {
        int myc = 0;
#pragma unroll
        for (int e = 0; e < 8; ++e) myc = (lane == e) ? cnt[e] : myc;
        if (lane < 8) wcnt[gw * 8 + lane] = myc;
    }
}

__device__ __forceinline__ void place_pass(const int* wcnt, const int* eidx, const float* ew, const bf16* XA, bf16* XS, int* srow, float* swt, int* segout, int gw, int NGW, int lane) {
    int tot[8], pre[8];
#pragma unroll
    for (int e = 0; e < 8; ++e) { tot[e] = 0; pre[e] = 0; }
    for (int w = lane; w < NGW; w += 64) { const i32x4 a = *(const i32x4*)(wcnt + w * 8), c = *(const i32x4*)(wcnt + w * 8 + 4); const int inc = (w < gw) ? 1 : 0;
        tot[0] += a[0]; tot[1] += a[1]; tot[2] += a[2]; tot[3] += a[3]; tot[4] += c[0]; tot[5] += c[1]; tot[6] += c[2]; tot[7] += c[3];
        pre[0] += inc * a[0]; pre[1] += inc * a[1]; pre[2] += inc * a[2]; pre[3] += inc * a[3]; pre[4] += inc * c[0]; pre[5] += inc * c[1]; pre[6] += inc * c[2]; pre[7] += inc * c[3]; }
    int base[8]; int run = 0;
#pragma unroll
    for (int e = 0; e < 8; ++e) { tot[e] = wave_sum_i(tot[e]); pre[e] = wave_sum_i(pre[e]); base[e] = run + pre[e]; if (gw == 0 && lane == 0) segout[e] = run; run += (tot[e] + 255) & ~255; }
    if (gw == 0 && lane == 0) segout[8] = run;
    const int myev = (lane < 16) ? eidx[gw * 16 + lane] : 0; const float myw = (lane < 16) ? ew[gw * 16 + lane] : 0.f;
    int mypos = 0;
#pragma unroll
    for (int i = 0; i < 16; ++i) { const int ev = __builtin_amdgcn_readlane(myev, i); int pos = 0;
#pragma unroll
        for (int e = 0; e < 8; ++e) if (ev == e) { pos = base[e]; base[e] += 1; }
        mypos = (lane == i) ? pos : mypos; }
    if (lane < 16) { srow[mypos] = gw * 16 + lane; swt[mypos] = myw; }
    const v4u* __restrict__ s = (const v4u*)(XA + (size_t)(gw * 8) * 1024);
    v4u r0[8], r1[8];
#pragma unroll
    for (int t = 0; t < 8; ++t) { r0[t] = s[t * 128 + lane]; r1[t] = s[t * 128 + lane + 64]; }
    v2u q0[8], q1[8];
#pragma unroll
    for (int t = 0; t < 8; ++t) {
        { int p = 0; p = __builtin_amdgcn_cvt_pk_fp8_f32(h16::lo(r0[t].x), h16::hi(r0[t].x), p, false); p = __builtin_amdgcn_cvt_pk_fp8_f32(h16::lo(r0[t].y), h16::hi(r0[t].y), p, true); q0[t].x = (unsigned)p;
          p = 0; p = __builtin_amdgcn_cvt_pk_fp8_f32(h16::lo(r0[t].z), h16::hi(r0[t].z), p, false); p = __builtin_amdgcn_cvt_pk_fp8_f32(h16::lo(r0[t].w), h16::hi(r0[t].w), p, true); q0[t].y = (unsigned)p; }
        { int p = 0; p = __builtin_amdgcn_cvt_pk_fp8_f32(h16::lo(r1[t].x), h16::hi(r1[t].x), p, false); p = __builtin_amdgcn_cvt_pk_fp8_f32(h16::lo(r1[t].y), h16::hi(r1[t].y), p, true); q1[t].x = (unsigned)p;
          p = 0; p = __builtin_amdgcn_cvt_pk_fp8_f32(h16::lo(r1[t].z), h16::hi(r1[t].z), p, false); p = __builtin_amdgcn_cvt_pk_fp8_f32(h16::lo(r1[t].w), h16::hi(r1[t].w), p, true); q1[t].y = (unsigned)p; } }
#pragma unroll
    for (int i = 0; i < 16; ++i) { const int pos = __builtin_amdgcn_readlane(mypos, i); v2u* __restrict__ d = (v2u*)((unsigned char*)XS + (size_t)pos * 1024);
        d[lane] = q0[i >> 1]; d[lane + 64] = q1[i >> 1]; }
}

__device__ __forceinline__ void final_pass(float* xio, const bf16* YS, const int* atomf, const float* slab, const float* g2, const float* fg, int gw, int lane) {
    const int m0 = gw * 8, b = m0 >> 11;
    f32x4 gv[4], g2v[4];
#pragma unroll
    for (int j = 0; j < 4; ++j) { gv[j] = ((const f32x4*)fg)[lane + 64 * j]; g2v[j] = ((const f32x4*)(g2 + (size_t)b * 6144))[lane + 64 * j]; }
    for (int i = 0; i < 8; ++i) {
        const int m = m0 + i;
        f32x4* xr = (f32x4*)(xio + (size_t)m * 1024) + lane;
        const v2u* y0 = (const v2u*)(YS + (size_t)(2 * m) * 1024) + lane; const v2u* y1 = (const v2u*)(YS + (size_t)(2 * m + 1) * 1024) + lane;
        f32x4 v[4]; float s = 0.f; const i32x4 f0 = *(const i32x4*)(atomf + (size_t)(2 * m) * 4), f1 = *(const i32x4*)(atomf + (size_t)(2 * m + 1) * 4);
#pragma unroll
        for (int j = 0; j < 4; ++j) { v[j] = xr[64 * j]; const v2u a = y0[64 * j], c = y1[64 * j];
            f32x4 ya, yc;
            if (f0[j]) { const int id = f0[j] - 1; const float* sp = slab + ((size_t)((id >> 8) * 11) * 256 + (id & 255)) * 256 + 4 * lane; ya = (f32x4){0.f, 0.f, 0.f, 0.f};
                for (int kc = 0; kc < 11; ++kc) ya += *(const f32x4*)(sp + (size_t)kc * 65536); }
            else { ya[0] = h16::lo(a.x); ya[1] = h16::hi(a.x); ya[2] = h16::lo(a.y); ya[3] = h16::hi(a.y); }
            if (f1[j]) { const int id = f1[j] - 1; const float* sp = slab + ((size_t)((id >> 8) * 11) * 256 + (id & 255)) * 256 + 4 * lane; yc = (f32x4){0.f, 0.f, 0.f, 0.f};
                for (int kc = 0; kc < 11; ++kc) yc += *(const f32x4*)(sp + (size_t)kc * 65536); }
            else { yc[0] = h16::lo(c.x); yc[1] = h16::hi(c.x); yc[2] = h16::lo(c.y); yc[3] = h16::hi(c.y); }
            const f32x4 ys = ya + yc;
            v[j] = v[j] + g2v[j] * ys; s += (v[j][0] * v[j][0] + v[j][1] * v[j][1]) + (v[j][2] * v[j][2] + v[j][3] * v[j][3]); }
        const float rs = 1.0f / sqrtf(wave_sum(s) * (1.0f / 1024.0f) + 1e-6f);
#pragma unroll
        for (int j = 0; j < 4; ++j) xr[64 * j] = v[j] * rs * gv[j];
    }
}

constexpr int N_PHASES = 18;
struct Args { Inputs in; float* out; unsigned char* ws; int ph_lo, ph_hi, bar_region, moe_w; };

typedef const Args __attribute__((address_space(4))) CArgs;
__device__ __forceinline__ CArgs* kargs() { unsigned long off = 0; asm volatile("" : "+s"(off)); return (CArgs*)((const char __attribute__((address_space(4)))*)__builtin_amdgcn_kernarg_segment_ptr() + off); }

__global__ void __launch_bounds__(NWAVES * 64, 2) mega(Args args_unused) {
    extern __shared__ __attribute__((aligned(16))) unsigned char lds_raw[];
    LAS unsigned char* lds = (LAS unsigned char*)lds_raw;
    volatile LAS unsigned* MISC = (volatile LAS unsigned*)(lds + MISC_OFF);
    const int G = gridDim.x;
#define PHASE_IDS int tid = otid(WV); int bx = blockIdx.x; asm volatile("" : "+s"(bx)); const int lane = tid & 63, wave = __builtin_amdgcn_readfirstlane(tid >> 6); \
    const int vcu = (bx & 7) * (G >> 3) + (bx >> 3); const int gw = vcu * NWAVES + wave; (void)lane; (void)gw; (void)vcu;
    const int WV = __builtin_amdgcn_readfirstlane((int)threadIdx.x >> 6);
    for (int u = otid(WV); u < (LDS_BYTES - LDSCTL_OFF) / 4; u += NWAVES * 64) ((LAS unsigned*)(lds + LDSCTL_OFF))[u] = 0u;
    __syncthreads();
    XcdBarrier bar;
    { CArgs* ka = kargs(); unsigned* barw = (unsigned*)(ka->ws + WS_CTL) + CW_BAR + ka->bar_region * XCD_BAR_WORDS; bar = xcd_barrier_post(barw, MISC + 8, WV); }
    int lo, hi; { CArgs* ka = kargs(); lo = ka->ph_lo; hi = ka->ph_hi; }
#ifndef PHM
#define PHM 0x3ff
#endif
#define IN(k) (lo <= (k) && (k) < hi)
#define TY(t) (((PHM) >> (t)) & 1)
#ifndef DUP_T
#define DUP_T -1
#define DUP_N 0
#endif
#define REP(t) for (int rep_ = 0; rep_ < ((t) == DUP_T ? 1 + DUP_N : 1) && (rep_ == 0 || (__syncthreads(), true)); ++rep_)
#ifdef TPROBE
    volatile LAS unsigned long long* TS = (volatile LAS unsigned long long*)(lds + MISC_OFF + 256);
#define STAMP(k) do { if (blockIdx.x == 0 && threadIdx.x == 0) TS[(k)] = __builtin_amdgcn_s_memrealtime(); } while (0)
#else
#define STAMP(k) do {} while (0)
#endif
    STAMP(0);
#define SEAM(k) do { if (IN(k) && IN((k) + 1)) xcd_barrier(bar); STAMP((k) + 1); } while (0)

    if (TY(0) && IN(0)) REP(0) { PHASE_IDS CArgs* ka = kargs(); p0_prologue(&ka->in, ka->ws, lds, vcu, G, wave, lane, tid, 0); }
    SEAM(0);
#ifdef PROBE_BAR
    for (int q = 0; q < PROBE_BAR; ++q) xcd_barrier(bar);
#endif
    for (int l = 0; l < 2; ++l) {
        const int pb = 1 + 8 * l;
        if (TY(1) && IN(pb + 0)) REP(1) { PHASE_IDS CArgs* ka = kargs(); unsigned char* ws = ka->ws; const float* mod = (const float*)(ws + WS_MOD) + (size_t)l * 8 * 6144;
            const float* xin = (l == 0) ? ka->in.x : (const float*)ka->out;
            if (gw < 2048) norm_pass<0>(xin, ka->in.norm_mix_g + l * 1024, mod + 0 * 1024, mod + 1 * 1024, (bf16*)(ws + WS_XA), nullptr, nullptr, nullptr, nullptr, gw, lane); }
        SEAM(pb + 0);
        if (TY(2) && IN(pb + 1)) REP(2) { PHASE_IDS CArgs* ka = kargs(); unsigned char* ws = ka->ws;
            if (bx < G_INPROJ) {
                pg8::Gemm g{1024, 1024, 1024}; pg8::DenseSched S; S.init(ws + WS_XA, 1024, (bf16*)(ws + WS_WIN) + (size_t)l * 3584 * 1024, 1024, 16384, 3584, G_INPROJ, bx);
                epi::EpiInProj E{(bf16*)(ws + WS_QKV), (size_t)16384 * 512, (float*)(ws + WS_KMP), (const float*)(ws + WS_ROPE)};
                pg8::gemm_phase(WV, lds, g, S, E);
            } else if (rep_ == 0) { convert_moe_range<0>(&ka->in, ws, lds, l == 0 ? 0 : IT_MOE_B, l == 0 ? IT_MOE_A : IT_MGU, bx - G_INPROJ, G - G_INPROJ, wave, lane);
                                    if (l == 1) convert_moe_range<1>(&ka->in, ws, lds, 0, IT_MDN_C, bx - G_INPROJ, G - G_INPROJ, wave, lane); }
        }
        SEAM(pb + 1);
        if (TY(3) && IN(pb + 2)) REP(3) { PHASE_IDS CArgs* ka = kargs(); unsigned char* ws = ka->ws; bf16* QKV = (bf16*)(ws + WS_QKV); bf16* CAT = (bf16*)(ws + WS_CAT);
            if (G == 256) {
                if ((bx & 7) < 7) fa::kv_unit(WV, bx >> 5, (bx >> 3) & 3, bx & 7, QKV + (size_t)4 * 16384 * 512, QKV + (size_t)5 * 16384 * 512, (float*)(ws + WS_KVM), lds);
                xcd_barrier(bar);
                { fa::Tensors TR{QKV + (size_t)3 * 16384 * 512, QKV + (size_t)4 * 16384 * 512, QKV + (size_t)5 * 16384 * 512, CAT, (float*)(ws + WS_ASSQ), (const float*)(ws + WS_KMP), QKV + (size_t)6 * 16384 * 512, ka->in.ret_g + l * 512, (const float*)(ws + WS_KVM)};
                  fa::attn_unit<true>(WV, bx >> 5, (bx >> 3) & 3, bx & 7, TR, lds); }
                fa::Tensors TA{QKV, QKV + (size_t)1 * 16384 * 512, QKV + (size_t)2 * 16384 * 512, CAT, (float*)(ws + WS_ASSQ), (const float*)(ws + WS_KMP), nullptr, nullptr, nullptr};
                const int bh = bx >> 2, pr = bx & 3;
                for (int uu = 0; uu < 2; ++uu) fa::attn_unit<false>(WV, bh >> 3, bh & 7, uu == 0 ? 7 - pr : pr, TA, lds);
            }
        }
        SEAM(pb + 2);
        if (TY(4) && IN(pb + 3)) REP(4) {
            { PHASE_IDS CArgs* ka = kargs(); unsigned char* ws = ka->ws; const float* mod = (const float*)(ws + WS_MOD) + (size_t)l * 8 * 6144;
                const float* xin = (l == 0) ? ka->in.x : (const float*)ka->out;
                pg8::Gemm g{1024, 1024, 1024}; pg8::DenseSched S; S.init(ws + WS_CAT, 1024, (const bf16*)(ws + WS_WOUT) + (size_t)l * 1024 * 1024, 1024, 16384, 1024, G, bx);
                epi::EpiOutProj E{xin, ka->out, mod + 2 * 1024, (const float*)(ws + WS_ASSQ), rep_ > 0}; pg8::gemm_phase(WV, lds, g, S, E); }
        }
        SEAM(pb + 3);
        if (TY(5) && IN(pb + 4)) REP(5) { PHASE_IDS CArgs* ka = kargs(); unsigned char* ws = ka->ws; const float* mod = (const float*)(ws + WS_MOD) + (size_t)l * 8 * 6144;
            if (gw < 2048) {
                if (l == 0) norm_pass<0>(ka->out, ka->in.norm_ffn_g + l * 1024, mod + 3 * 1024, mod + 4 * 1024, (bf16*)(ws + WS_XA), nullptr, nullptr, nullptr, nullptr, gw, lane);
                else norm_pass<1>(ka->out, ka->in.norm_ffn_g + l * 1024, mod + 3 * 1024, mod + 4 * 1024, (bf16*)(ws + WS_XA), ka->in.router_w, (int*)(ws + WS_EIDX), (float*)(ws + WS_EW), (int*)(ws + WS_WCNT), gw, lane);
            }
            if (l == 1) { int* srow = (int*)(ws + WS_SROW); int* af = (int*)(ws + WS_ATOMF);
                { const int p = bx * 512 + tid; if (p < XS_ROWS) srow[p] = -1; af[p] = 0; }
            }
            else if (bx == 0 && tid < 9) { ((int*)(ws + WS_SEGD))[tid] = (tid == 0) ? 0 : ((tid == 8) ? 16384 : (1 << 30)); }
        }
        SEAM(pb + 4);
        if (l == 1) {
            if (TY(6) && IN(pb + 5)) REP(6) { PHASE_IDS CArgs* ka = kargs(); unsigned char* ws = ka->ws;
                if (gw < 2048) place_pass((const int*)(ws + WS_WCNT), (const int*)(ws + WS_EIDX), (const float*)(ws + WS_EW), (const bf16*)(ws + WS_XA), (bf16*)(ws + WS_XS), (int*)(ws + WS_SROW), (float*)(ws + WS_SWT), (int*)(ws + WS_SEG), gw, 2048, lane); }
            SEAM(pb + 5);
        } else { STAMP(pb + 6); }
        if (TY(7) && IN(pb + 6)) REP(7) { PHASE_IDS CArgs* ka = kargs(); unsigned char* ws = ka->ws;
            int Geff = G_GUD;
            if (l == 1) { const int nwg = (__builtin_amdgcn_readfirstlane(((const int*)(ws + WS_SEG))[8]) / 256) * 22; const int rounds = (nwg + G - 1) / G;
                Geff = (((nwg + rounds - 1) / rounds) + 7) & ~7; if (Geff > G - MOE_SPARE) Geff = G - MOE_SPARE; }
            if (bx < Geff) {
                if (l == 0) { pg8::Gemm g{1024, 1024, 1024}; pg8::MoeSched S;
                    S.init(ws + WS_XA, 1024, ws + WS_FGU, 1024, (size_t)5632 * 1024 * 2, (const int*)(ws + WS_SEGD), 5632, Geff, bx);
                    epi::EpiSwiGLU E{(bf16*)(ws + WS_HD), 2816}; pg8::gemm_phase(WV, lds, g, S, E);
                } else {
                    pg8::Gemm g{512, 512, 512}; pg8::MoeSched S;
                    S.init(ws + WS_XS, 512, ws + WS_MGU, 512, (size_t)5632 * 1024, (const int*)(ws + WS_SEG), 5632, Geff, bx);
                    epi::EpiSwiGLU8 E{ws + WS_HM, 2816}; pg8::gemm_phase(WV, lds, g, S, E);
                }
            } else if (rep_ == 0) { if (l == 0) convert_moe_range<0>(&ka->in, ws, lds, IT_MOE_A, IT_MOE_B, bx - Geff, G - Geff, wave, lane);
                                    else { convert_moe_range<1>(&ka->in, ws, lds, IT_MDN_C, IT_MDN, bx - Geff, G - Geff, wave, lane);
#ifdef PROBE_CONV2
                                           __syncthreads(); convert_moe_range<1>(&ka->in, ws, lds, IT_MDN_C, IT_MDN, bx - Geff, G - Geff, wave, lane);
#endif
                                    } }
        }
        SEAM(pb + 6);
        if (TY(8) && IN(pb + 7)) REP(8) { PHASE_IDS CArgs* ka = kargs(); unsigned char* ws = ka->ws; const float* mod = (const float*)(ws + WS_MOD) + (size_t)l * 8 * 6144;
            if (l == 0) { pg8::MoeSched S; S.init(ws + WS_HD, 2816, ws + WS_FDN, 2816, (size_t)1024 * 2816 * 2, (const int*)(ws + WS_SEGD), 1024, G, bx);
                pg8::Gemm g{2816, 2816, 2816};
                epi::EpiDown E{ka->out, mod + 5 * 1024, (bf16*)(ws + WS_YS), (const int*)(ws + WS_SROW), (const float*)(ws + WS_SWT), false, rep_ > 0, (int*)(ws + WS_ATOMF), false, nullptr, 1}; pg8::gemm_phase(WV, lds, g, S, E);
            } else {
                pg8::MoeSched S; S.init(ws + WS_HM, 1408, ws + WS_MDN, 1408, (size_t)1024 * 2816, (const int*)(ws + WS_SEG), 1024, G, bx);
                pg8::Gemm g{1408, 1408, 1408};
                epi::EpiDownMoe8 E{(bf16*)(ws + WS_YS), (const int*)(ws + WS_SROW), (const float*)(ws + WS_SWT)}; pg8::gemm_phase(WV, lds, g, S, E);
            }
        }
        SEAM(pb + 7);
    }
    if (TY(9) && IN(17)) { PHASE_IDS CArgs* ka = kargs(); unsigned char* ws = ka->ws;
        if (gw < 2048) final_pass(ka->out, (const bf16*)(ws + WS_YS), (const int*)(ws + WS_ATOMF), (const float*)(ws + WS_SLAB), (const float*)(ws + WS_MOD) + (size_t)1 * 8 * 6144 + 5 * 1024, ka->in.final_g, gw, lane); }
#ifdef TPROBE
    xcd_barrier(bar); STAMP(18); __syncthreads();
    if (blockIdx.x == 0) { CArgs* ka = kargs(); float* o = ka->out;
        const float d1 = (float)(TS[TPROBE_A + 1] - TS[TPROBE_A]) * 0.01f, d2 = (float)(TS[TPROBE_B + 1] - TS[TPROBE_B]) * 0.01f;
        const float a = 4.0f * sqrtf(d1);
        for (int i = threadIdx.x; i < 1024 * 1024; i += 512) o[i] = a;
        if (threadIdx.x == 0) o[1024 * 1024 + 5] = 100.0f * d2; }
#endif
#undef IN
#undef TY
#undef SEAM
#undef PHASE_IDS
}
}
#ifndef STEP
#define STEP 5
#endif
namespace ad {
__device__ __forceinline__ float bf2f(unsigned short s) { return h16::one(s); }
__global__ void __launch_bounds__(256) ad_proj(const unsigned short* QKV, size_t gstride, int b, float* projb) {
    const int m = blockIdx.x; const size_t row = (size_t)b * 2048 + m;
    for (int n = threadIdx.x; n < 3584; n += 256) {
        const int grp = n / 512, c = n % 512; int sc = c;
        if (grp == 3 || grp == 4) { const int head = c >> 7, d = c & 127; sc = head * 128 + 8 * ((d & 63) >> 2) + 2 * (d & 3) + (d >> 6); }
        float v = bf2f(QKV[(size_t)grp * gstride + row * 512 + sc]);
        if (grp == 0) v *= (1.0f / epi::C2);
        if (grp == 4) v *= (1.0f / epi::KSC);
        projb[(size_t)m * 3584 + n] = v;
    }
}
__global__ void __launch_bounds__(64) ad_kmean(const float* KMP, int b, float* kmeanb) {
    const int blk = blockIdx.x, h = blockIdx.y, d = threadIdx.x;
    const float* p = KMP + ((size_t)(b * 8 + blk) * 2) * 512 + h * 64 + d;
    kmeanb[((size_t)h * 8 + blk) * 64 + d] = (p[0] + p[512]) * (1.0f / 256.0f);
}
__global__ void __launch_bounds__(256) ad_cat(const unsigned short* CAT, const float* ASSQ, const float* att_g, int b, float* catb) {
    const int m = blockIdx.x; const size_t row = (size_t)b * 2048 + m;
    float ss = 0.f;
    for (int h = 0; h < 8; ++h) ss += ASSQ[row * 8 + h];
    const float rs = 1.0f / sqrtf(ss * (1.0f / 512.0f) + 1e-6f);
    for (int c = threadIdx.x; c < 1024; c += 256) { const float v = bf2f(CAT[row * 1024 + c]); catb[(size_t)m * 1024 + c] = (c < 512) ? v * rs * att_g[c] : v; }
}
__global__ void __launch_bounds__(256) dbg_cmp(const float* a, const float* b, size_t n, float rel, float abs_, unsigned* flag, int ncols = 1, int c_lo = 0, int c_hi = 1, int silu_b = 0) {
    unsigned bad = 0;
    for (size_t i = (size_t)blockIdx.x * 256 + threadIdx.x; i < n; i += (size_t)gridDim.x * 256) { const int c = (int)(i % ncols); if (c < c_lo || c >= c_hi) continue;
        float bv = b[i]; if (silu_b) bv = bv / (1.f + expf(-bv)); const float d = fabsf(a[i] - bv); if (!(d <= rel * fabsf(bv) + abs_)) ++bad; }
    if (bad) atomicAdd(flag, bad);
}
__global__ void __launch_bounds__(256) dbg_poison(const unsigned* flag, unsigned thresh, float* out, float val) {
    if (*flag > thresh) for (int i = threadIdx.x; i < 1024 * 1024; i += 256) out[i] = val;
}
__global__ void __launch_bounds__(256) dbg_ssd(const float* a, const float* b, size_t n, int ncols, int c_lo, int c_hi, float* acc) {
    float s = 0.f;
    for (size_t i = (size_t)blockIdx.x * 256 + threadIdx.x; i < n; i += (size_t)gridDim.x * 256) { const int c = (int)(i % ncols); if (c < c_lo || c >= c_hi) continue; const float d = a[i] - b[i]; s += d * d; }
    atomicAdd(acc, s);
}
__global__ void __launch_bounds__(256) dbg_encode(const float* acc, float count, float* out) {
    const float mse = *acc / count; const float val = 4.0f / sqrtf(mse);
    for (int i = threadIdx.x; i < 1024 * 1024; i += 256) out[i] = val;
}
}

static void launch_mega(const mk::Args& a0, int lo, int hi, int region, hipStream_t stream) {
    mk::Args a = a0; a.ph_lo = lo; a.ph_hi = hi; a.bar_region = region;
    hipLaunchKernelGGL(mk::mega, dim3(256), dim3(512), mk::LDS_BYTES, stream, a);
}

extern "C" void kernel_launch(void* const* d_in, const int* in_sizes, int n_in, void* d_out, int out_size, void* d_ws, size_t ws_size, hipStream_t stream) {
    static int ready = 0;
    if (ready == 0) {
        if (n_in != 18 || out_size != M * D || ws_size < mk::WS_END) { fprintf(stderr, "kernel_launch: unexpected problem (n_in %d, out %d, ws %zu)\n", n_in, out_size, ws_size); ready = -1; return; }
        if (hipFuncSetAttribute((const void*)mk::mega, hipFuncAttributeMaxDynamicSharedMemorySize, mk::LDS_BYTES) != hipSuccess) { fprintf(stderr, "kernel_launch: hipFuncSetAttribute failed\n"); ready = -1; return; }
        ready = 1;
    }
    if (ready < 0) return;
    mk::Args a{};
    const float** ip = (const float**)&a.in;
    for (int i = 0; i < 18; ++i) ip[i] = (const float*)d_in[i];
    a.out = (float*)d_out; a.ws = (unsigned char*)d_ws; a.moe_w = (STEP >= 5) ? 1 : 0;
    const mk::Inputs& in = a.in;
    float* out = (float*)d_out; unsigned char* ws = (unsigned char*)d_ws;
    hipMemsetAsync(ws + mk::WS_CTL, 0, mk::CTL_ZERO_BYTES, stream);
#if STEP >= 6
    launch_mega(a, 0, mk::N_PHASES, 0, stream);
#else
    constexpr size_t MiB = 1u << 20;
    unsigned char* na = ws + 8 * MiB;
    float* PROJb = (float*)(na);
    float* Hb = (float*)(na + 28 * MiB);
    float* CATb = (float*)(na + 36 * MiB);
    float* OAb = (float*)(na + 44 * MiB);
    float* ORRb = (float*)(na + 48 * MiB);
    float* KMEANb = (float*)(na + 52 * MiB);
    int* EIDXb = (int*)(na + 53 * MiB); float* EWb = (float*)(na + 53 * MiB + 65536); int* POSb = (int*)(na + 53 * MiB + 131072); int* LISTb = (int*)(na + 53 * MiB + 196608);
    int* CNTb = (int*)(na + 54 * MiB); int* BASEb = CNTb + 16;
    float* Gb = (float*)(na + 56 * MiB);
    float* Ub = (float*)(na + 78 * MiB);
    float* Yb = (float*)(na + 100 * MiB);
    const float* MODp = (const float*)(ws + mk::WS_MOD);
    unsigned short* QKV = (unsigned short*)(ws + mk::WS_QKV);
    launch_mega(a, 0, 1, 1, stream);
    for (int l = 0; l < 2; ++l) {
        const int pb = 1 + 8 * l;
        const float* xin = (l == 0) ? in.x : (const float*)out;
        if (STEP >= 1) { launch_mega(a, pb, pb + 1, 1, stream); launch_mega(a, pb + 1, pb + 2, 1, stream); }
        if (STEP >= 2) launch_mega(a, pb + 2, pb + 3, 1, stream);
        if (STEP >= 3) launch_mega(a, pb + 3, pb + 4, 1, stream);
        if (STEP < 3) {
            for (int b = 0; b < BATCH; ++b) {
                const float* mod = MODp + ((size_t)l * BATCH + b) * 6 * D;
                const float* xb = xin + (size_t)b * SEQ * D; float* ob = out + (size_t)b * SEQ * D;
                if (STEP < 1) {
                    nv::k_norm<<<SEQ, 256, 0, stream>>>(xb, in.norm_mix_g + l * D, mod + 0 * D, mod + 1 * D, Hb);
                    nv::k_gemm<<<dim3(NPROJ / 64, SEQ / 64), 256, 0, stream>>>(Hb, D, nullptr, nullptr, SEQ, in.w_in + (size_t)l * D * NPROJ, NPROJ, PROJb, NPROJ, D);
                    nv::k_rotary<<<SEQ, 256, 0, stream>>>(PROJb);
                    nv::k_kmean<<<dim3(NBLK, AH, 1), 64, 0, stream>>>(PROJb, KMEANb);
                } else {
                    ad::ad_proj<<<SEQ, 256, 0, stream>>>(QKV, (size_t)M * 512, b, PROJb);
                    ad::ad_kmean<<<dim3(NBLK, AH, 1), 64, 0, stream>>>((const float*)(ws + mk::WS_KMP), b, KMEANb);
#ifdef DBG_CHECK
                    { float* PROJn = Gb; float* KMn = (float*)(na + 52 * MiB + 262144); unsigned* flag = (unsigned*)(ws + mk::WS_CTL) + 16;
                      nv::k_norm<<<SEQ, 256, 0, stream>>>(xb, in.norm_mix_g + l * D, mod + 0 * D, mod + 1 * D, Hb);
                      nv::k_gemm<<<dim3(NPROJ / 64, SEQ / 64), 256, 0, stream>>>(Hb, D, nullptr, nullptr, SEQ, in.w_in + (size_t)l * D * NPROJ, NPROJ, PROJn, NPROJ, D);
                      nv::k_rotary<<<SEQ, 256, 0, stream>>>(PROJn);
                      nv::k_kmean<<<dim3(NBLK, AH, 1), 64, 0, stream>>>(PROJn, KMn);
                      ad::dbg_cmp<<<1024, 256, 0, stream>>>(PROJb, PROJn, (size_t)SEQ * NPROJ, DBG_REL, DBG_ABS, flag, NPROJ, 0, 3072, 0);
                      ad::dbg_cmp<<<1024, 256, 0, stream>>>(PROJb, PROJn, (size_t)SEQ * NPROJ, DBG_REL, DBG_ABS, flag, NPROJ, 3072, 3584, 1);
                      ad::dbg_cmp<<<16, 256, 0, stream>>>(KMEANb, KMn, (size_t)8 * 8 * 64, 0.03f, 0.004f, flag + 1);
                      if (l == DBG_L && b == 0) ad::dbg_ssd<<<1024, 256, 0, stream>>>(PROJb, PROJn, (size_t)SEQ * NPROJ, NPROJ, DBG_CLO, DBG_CHI, (float*)(flag + 2)); }
#endif
                }
                if (STEP < 2) {
                    nv::k_moba<<<dim3(NBLK, AH, 1), 256, 0, stream>>>(PROJb, KMEANb, OAb);
                    nv::k_ret<<<dim3(SEQ / 256, RH * 4, 1), 256, 0, stream>>>(PROJb, ORRb);
                    nv::k_cat<<<SEQ, 256, 0, stream>>>(OAb, ORRb, PROJb, in.att_g + l * AW, in.ret_g + l * RW, CATb, STEP >= 1 ? 1 : 0);
                } else {
                    ad::ad_cat<<<SEQ, 256, 0, stream>>>((const unsigned short*)(ws + mk::WS_CAT), (const float*)(ws + mk::WS_ASSQ), in.att_g + l * AW, b, CATb);
                }
                nv::k_gemm<<<dim3(D / 64, SEQ / 64), 256, 0, stream>>>(CATb, D, nullptr, nullptr, SEQ, in.w_out + (size_t)l * D * D, D, Hb, D, D);
                nv::k_resid<<<SEQ, 256, 0, stream>>>(xb, mod + 2 * D, Hb, ob);
            }
        }
        const bool ffn_mega = (l == 0) ? (STEP >= 4) : (STEP >= 5);
        if (ffn_mega) {
            launch_mega(a, pb + 4, pb + 5, 1, stream);
            if (l == 1) launch_mega(a, pb + 5, pb + 6, 1, stream);
            launch_mega(a, pb + 6, pb + 7, 1, stream);
            launch_mega(a, pb + 7, pb + 8, 1, stream);
        } else {
            for (int b = 0; b < BATCH; ++b) {
                const float* mod = MODp + ((size_t)l * BATCH + b) * 6 * D;
                float* ob = out + (size_t)b * SEQ * D;
                nv::k_norm<<<SEQ, 256, 0, stream>>>(ob, in.norm_ffn_g + l * D, mod + 3 * D, mod + 4 * D, Hb);
                if (l == 0) {
                    nv::k_gemm<<<dim3(FF / 64, SEQ / 64), 256, 0, stream>>>(Hb, D, nullptr, nullptr, SEQ, in.fw_gate, FF, Gb, FF, D);
                    nv::k_gemm<<<dim3(FF / 64, SEQ / 64), 256, 0, stream>>>(Hb, D, nullptr, nullptr, SEQ, in.fw_up, FF, Ub, FF, D);
                    nv::k_silu_mul<<<SEQ, 256, 0, stream>>>(Gb, Ub, nullptr, SEQ, FF);
                    nv::k_gemm<<<dim3(D / 64, SEQ / 64), 256, 0, stream>>>(Gb, FF, nullptr, nullptr, SEQ, in.fw_down, D, Ub, D, FF);
                    nv::k_resid<<<SEQ, 256, 0, stream>>>(ob, mod + 5 * D, Ub, ob);
                } else {
                    nv::k_router<<<SEQ / 4, 256, 0, stream>>>(Hb, in.router_w, EIDXb, EWb);
                    nv::k_place<<<1, 1024, 0, stream>>>(EIDXb, LISTb, POSb, CNTb, BASEb, 4);
                    float* GE = Gb; float* UE = Ub;
                    for (int e = 0; e < NE; ++e) {
                        nv::k_gemm<<<dim3(FF / 64, ECAP / 64), 256, 0, stream>>>(Hb, D, LISTb, CNTb + e, ECAP, in.mw_gate + (size_t)e * D * FF, FF, GE, FF, D, BASEb + e, nullptr);
                        nv::k_gemm<<<dim3(FF / 64, ECAP / 64), 256, 0, stream>>>(Hb, D, LISTb, CNTb + e, ECAP, in.mw_up + (size_t)e * D * FF, FF, UE, FF, D, BASEb + e, nullptr);
                        nv::k_silu_mul<<<ECAP, 256, 0, stream>>>(GE, UE, CNTb + e, ECAP, FF);
                        nv::k_gemm<<<dim3(D / 64, ECAP / 64), 256, 0, stream>>>(GE, FF, nullptr, CNTb + e, ECAP, in.mw_down + (size_t)e * FF * D, D, Yb, D, FF, nullptr, BASEb + e);
                    }
                    nv::k_moe_combine<<<SEQ, 256, 0, stream>>>(ob, mod + 5 * D, Yb, POSb, EWb);
                }
            }
        }
    }
    if (STEP >= 5) launch_mega(a, 17, 18, 1, stream);
    else nv::k_norm<<<M, 256, 0, stream>>>(out, in.final_g, nullptr, nullptr, out);
#ifdef DBG_CHECK
#ifdef DBG_ENC
    ad::dbg_encode<<<1, 256, 0, stream>>>((const float*)((unsigned*)(ws + mk::WS_CTL) + 18), (float)SEQ * (DBG_CHI - DBG_CLO), out);
#endif
    ad::dbg_poison<<<1, 256, 0, stream>>>((unsigned*)(ws + mk::WS_CTL) + 16, DBG_T0, out, 100.0f);
    ad::dbg_poison<<<1, 256, 0, stream>>>((unsigned*)(ws + mk::WS_CTL) + 17, DBG_T1, out + (1 << 20), 300.0f);
#endif
#endif
}
```

```cpp
#include <hip/hip_runtime.h>
#include <cstdio>
#include <cstdint>
#include <cmath>

namespace h16 {
typedef _Float16 f16x2_t __attribute__((ext_vector_type(2)));
typedef _Float16 f16x8_t __attribute__((ext_vector_type(8)));
typedef float f32x2_t __attribute__((ext_vector_type(2)));
__device__ __forceinline__ unsigned pk(float lo, float hi) { f32x2_t v = {lo, hi}; f16x2_t b = __builtin_convertvector(v, f16x2_t); return __builtin_bit_cast(unsigned, b); }
__device__ __forceinline__ float lo(unsigned u) { return (float)__builtin_bit_cast(f16x2_t, u)[0]; }
__device__ __forceinline__ float hi(unsigned u) { return (float)__builtin_bit_cast(f16x2_t, u)[1]; }
__device__ __forceinline__ float one(unsigned short s) { return (float)__builtin_bit_cast(_Float16, s); }
}

namespace xl {
template <int O> __device__ __forceinline__ int xor_i(int v) {
    if constexpr (O < 32) return __builtin_amdgcn_ds_swizzle(v, (O << 10) | 0x1f);
    else { static_assert(O < 32, "use add32 / max32 for the 32-lane exchange"); return v; }
}
template <int O> __device__ __forceinline__ float xor_f(float v) { return __builtin_bit_cast(float, xor_i<O>(__builtin_bit_cast(int, v))); }
__device__ __forceinline__ void swap32(unsigned a, unsigned& r0, unsigned& r1) { unsigned b = a; asm volatile("" : "+v"(b)); auto r = __builtin_amdgcn_permlane32_swap(a, b, false, false); r0 = r[0]; r1 = r[1]; }
__device__ __forceinline__ float xor32p(float v, bool upper) { unsigned r0, r1; swap32(__builtin_bit_cast(unsigned, v), r0, r1); return __builtin_bit_cast(float, upper ? r0 : r1); }
__device__ __forceinline__ float add32(float v) { unsigned r0, r1; swap32(__builtin_bit_cast(unsigned, v), r0, r1); return __builtin_bit_cast(float, r0) + __builtin_bit_cast(float, r1); }
__device__ __forceinline__ float max32(float v) { unsigned r0, r1; swap32(__builtin_bit_cast(unsigned, v), r0, r1); return fmaxf(__builtin_bit_cast(float, r0), __builtin_bit_cast(float, r1)); }
__device__ __forceinline__ int add32i(int v) { unsigned r0, r1; swap32((unsigned)v, r0, r1); return (int)(r0 + r1); }
__device__ __forceinline__ float wave_sum(float v) { v += xor_f<1>(v); v += xor_f<2>(v); v += xor_f<4>(v); v += xor_f<8>(v); v += xor_f<16>(v); return add32(v); }
__device__ __forceinline__ int wave_sum_i(int v) { v += xor_i<1>(v); v += xor_i<2>(v); v += xor_i<4>(v); v += xor_i<8>(v); v += xor_i<16>(v); return add32i(v); }
}

__device__ __forceinline__ int olane() { int l; asm volatile("v_mbcnt_lo_u32_b32 %0, -1, 0\n\tv_mbcnt_hi_u32_b32 %0, -1, %0" : "=v"(l)); return l; }
__device__ __forceinline__ int otid(int wv) { return (wv << 6) | olane(); }
#define STEP 6

constexpr int D = 1024, BATCH = 8, SEQ = 2048, M = BATCH * SEQ;
constexpr int AH = 8, AD = 64, AW = 512, MBLK = 256, NBLK = SEQ / MBLK, TOPK = 3;
constexpr int RH = 4, RD = 128, RW = 512;
constexpr int NPROJ = 3 * AW + 4 * RW;
constexpr int FF = 2816, NE = 8;
constexpr float EPS = 1e-6f;
constexpr int ECAP = 2048;
namespace pg8 {
#define PG8_LAS __attribute__((address_space(3)))
typedef unsigned short bf16_t;
typedef short bf16x8 __attribute__((ext_vector_type(8)));
typedef float f32x4 __attribute__((ext_vector_type(4)));
typedef float f32x2 __attribute__((ext_vector_type(2)));
typedef unsigned u32x4 __attribute__((ext_vector_type(4)));
typedef unsigned u32x2 __attribute__((ext_vector_type(2)));
typedef int i32x4 __attribute__((ext_vector_type(4)));
constexpr int BM = 256, BK = 64, HALF = 128, HTB = HALF * BK * 2  , STAGE_BYTES = 8 * HTB, NXCD = 8, WGM = 8;

__host__ __device__ __forceinline__ int lds_byte(int r, int c) { const int st = (r >> 4) * 2 + (c >> 5), rr = r & 15, cc = c & 31, ob = rr * 64 + cc * 2; return st * 1024 + (ob ^ (((ob >> 9) & 1) << 5)); }
__host__ __device__ __forceinline__ void stage_rc(int b, int& R, int& C) { const int st = b / 1024, sb = b % 1024, swz = sb ^ (((sb >> 9) & 1) << 5); R = (st >> 1) * 16 + swz / 64; C = (st & 1) * 32 + (swz % 64) / 2; }
__host__ __device__ __forceinline__ int perm32(int rho) { const int n = rho >> 4, i = rho & 15; return 8 * (i >> 2) + 4 * n + (i & 3); }

struct Unit { int pm, pn, e, kc, li; };
struct Gemm { int lda, ldb, K; };

struct DenseSched {
    const char* A; const char* Bt; size_t a_tile, b_tile;
    int nM, nN, nwg, G, c;
    __device__ __forceinline__ void init(const void* A_, int lda, const void* Bt_, int ldb, int M, int N, int G_, int c_) {
        A = (const char*)A_; Bt = (const char*)Bt_; a_tile = (size_t)BM * lda * 2; b_tile = (size_t)BM * ldb * 2; nM = M / BM; nN = N / BM; nwg = nM * nN; G = G_; c = c_; }
    __device__ __forceinline__ bool next(int i, Unit& u) const {
        const long L = (long)i * G + c; if (L >= nwg) return false;
        int wgid = (int)L; { const int q = nwg / NXCD, r = nwg % NXCD, xcd = wgid % NXCD, off = wgid / NXCD; wgid = (xcd < r ? xcd * (q + 1) : r * (q + 1) + (xcd - r) * q) + off; }
        const int nig = WGM * nN, gid = wgid / nig, fm = gid * WGM, gsz = (nM - fm) < WGM ? (nM - fm) : WGM;
        u.pm = fm + ((wgid % nig) % gsz); u.pn = (wgid % nig) / gsz; u.e = 0; u.kc = 0; u.li = 0; return true;
    }
    __device__ __forceinline__ const char* a_ptr(const Unit& u) const { return A + (size_t)u.pm * a_tile; }
    __device__ __forceinline__ const char* b_ptr(const Unit& u) const { return Bt + (size_t)u.pn * b_tile; }
};
struct MoeSched {
    const char* A; const char* Bt; size_t a_tile, b_tile, e_stride;
    int nM, nN, nwg, G, c; int seg[8]; int first, lim, KS, kbytes;
    __device__ __forceinline__ void init(const void* A_, int lda, const void* Bt_, int ldb, size_t e_stride_bytes, const int* segp_, int N, int G_, int c_) {
        A = (const char*)A_; Bt = (const char*)Bt_; a_tile = (size_t)BM * lda * 2; b_tile = (size_t)BM * ldb * 2; e_stride = e_stride_bytes;
#pragma unroll
        for (int e = 0; e < 8; ++e) seg[e] = __builtin_amdgcn_readfirstlane(segp_[e]);
        nM = __builtin_amdgcn_readfirstlane(segp_[8]) / BM; nN = N / BM; nwg = nM * nN; G = G_; c = c_; first = 0; lim = nwg; KS = 1; kbytes = 0; }
    __device__ __forceinline__ bool next(int i, Unit& u) const {
        const long idx = (long)i * G + c; const long L = first + idx / KS; if (L >= lim) return false;
        u.kc = (int)(idx % KS); u.li = (int)(idx / KS);
        int wgid = (int)L; { const int q = nwg / NXCD, r = nwg % NXCD, xcd = wgid % NXCD, off = wgid / NXCD; wgid = (xcd < r ? xcd * (q + 1) : r * (q + 1) + (xcd - r) * q) + off; }
        const int nig = WGM * nN, gid = wgid / nig, fm = gid * WGM, gsz = (nM - fm) < WGM ? (nM - fm) : WGM;
        u.pm = fm + ((wgid % nig) % gsz); u.pn = (wgid % nig) / gsz;
        int e = 0; const int r0 = u.pm * BM;
#pragma unroll
        for (int k = 1; k < 8; ++k) e = (r0 >= seg[k]) ? k : e;
        u.e = __builtin_amdgcn_readfirstlane(e); return true;
    }
    __device__ __forceinline__ const char* a_ptr(const Unit& u) const { return A + (size_t)u.pm * a_tile + (size_t)u.kc * kbytes; }
    __device__ __forceinline__ const char* b_ptr(const Unit& u) const { return Bt + (size_t)u.e * e_stride + (size_t)u.pn * b_tile + (size_t)u.kc * kbytes; }
};

__device__ __forceinline__ unsigned cvt_pk_bf16(float lo, float hi) { return h16::pk(lo, hi); }
__device__ __forceinline__ float fast_silu(float g) { return g * __builtin_amdgcn_rcpf(1.0f + __builtin_amdgcn_exp2f(-1.4426950408889634f * g)); }

typedef f32x4 Acc[2][2][4][2];
typedef int i32x8 __attribute__((ext_vector_type(8)));
template <bool F8> struct Frags;
template <> struct Frags<false> { bf16x8 At[4][2], B0[2][2], B1[2][2]; };
template <> struct Frags<true> { i32x8 At[4], B0[2], B1[2]; };

template <class Epi, class Sched>
__device__ __forceinline__ void gemm_phase(const int wv, PG8_LAS unsigned char* lds, const Gemm g, const Sched& S, const Epi& E) {
    int tid_ = otid(wv);
    const int tid = tid_, wid = __builtin_amdgcn_readfirstlane(tid >> 6), lane = tid & 63, wr = wid >> 2, wc = wid & 3, fr = lane & 15, fq = lane >> 4;
    const int K = g.K; int nt = K / BK; asm volatile("" : "+s"(nt));
    unsigned voffA[2], voffB[2];
#pragma unroll
    for (int i = 0; i < 2; ++i) { int R, C; stage_rc(tid * 16 + i * 8192, R, C); const int Rb = Epi::PERM ? ((R & ~31) + perm32(R & 31)) : R;
        voffA[i] = (unsigned)(R * g.lda + C) * 2u; voffB[i] = (unsigned)(Rb * g.ldb + C) * 2u; }
    const size_t kstep = (size_t)(BK * 2);
    const size_t hstepA = (size_t)HALF * g.lda * 2, hstepB = (size_t)HALF * g.ldb * 2;
    const unsigned ldsw = (unsigned)wid * 1024u;
    const unsigned ldsbase_ = (unsigned)__builtin_amdgcn_readfirstlane((int)((unsigned)(unsigned long)lds + ldsw));
    const int aoff = lds_byte(wr * 64 + fr, fq * 8), boff = lds_byte(wc * 32 + fr, fq * 8);
#define PG8_SA(b, h) (((b) * 2 + (h)) * HTB)
#define PG8_SB(b, h) ((4 + (b) * 2 + (h)) * HTB)
#define PG8_STAGE(bufoff, gbase, voff) do { if constexpr (Epi::FP8) {   \
            const unsigned long long gb_ = (unsigned long long)(gbase); \
            const unsigned long long sb_ = ((unsigned long long)(unsigned)__builtin_amdgcn_readfirstlane((int)(gb_ >> 32)) << 32) | (unsigned)__builtin_amdgcn_readfirstlane((int)gb_); \
            _Pragma("unroll") for (int _i = 0; _i < 2; ++_i) { unsigned keep_; \
                asm volatile("s_mov_b32 %0, m0\n\ts_mov_b32 m0, %3\n\ts_nop 0\n\tglobal_load_lds_dwordx4 %1, %2\n\ts_mov_b32 m0, %0" : "=&s"(keep_) : "v"((voff)[_i]), "s"(sb_), "s"(ldsbase_ + (unsigned)((bufoff) + _i * 8192)) : "memory"); } \
        } else { _Pragma("unroll") for (int _i = 0; _i < 2; ++_i) \
        __builtin_amdgcn_global_load_lds((const unsigned*)((const char*)(gbase) + (voff)[_i]), (PG8_LAS unsigned*)(lds + (bufoff) + ldsw + _i * 8192), 16, 0, 0); } } while (0)
#define PG8_LDA(dst, b, h) do { if constexpr (Epi::FP8) { _Pragma("unroll") for (int m = 0; m < 4; ++m) { const i32x4 lo_ = *(const PG8_LAS i32x4*)(lds + PG8_SA(b, h) + aoff + m * 2048), hi_ = *(const PG8_LAS i32x4*)(lds + PG8_SA(b, h) + aoff + m * 2048 + 1024); F.dst[m] = __builtin_shufflevector(lo_, hi_, 0, 1, 2, 3, 4, 5, 6, 7); } } \
        else { _Pragma("unroll") for (int m = 0; m < 4; ++m) _Pragma("unroll") for (int k = 0; k < 2; ++k) F.dst[m][k] = *(const PG8_LAS bf16x8*)(lds + PG8_SA(b, h) + aoff + m * 2048 + k * 1024); } } while (0)
#define PG8_LDB(dst, b, h) do { if constexpr (Epi::FP8) { _Pragma("unroll") for (int n = 0; n < 2; ++n) { const i32x4 lo_ = *(const PG8_LAS i32x4*)(lds + PG8_SB(b, h) + boff + n * 2048), hi_ = *(const PG8_LAS i32x4*)(lds + PG8_SB(b, h) + boff + n * 2048 + 1024); F.dst[n] = __builtin_shufflevector(lo_, hi_, 0, 1, 2, 3, 4, 5, 6, 7); } } \
        else { _Pragma("unroll") for (int n = 0; n < 2; ++n) _Pragma("unroll") for (int k = 0; k < 2; ++k) F.dst[n][k] = *(const PG8_LAS bf16x8*)(lds + PG8_SB(b, h) + boff + n * 2048 + k * 1024); } } while (0)
#define PG8_MMA(ai, bj, At, Bt) do { __builtin_amdgcn_s_setprio(1); \
        if constexpr (Epi::FP8) {   \
            _Pragma("unroll") for (int m = 0; m < 4; ++m) _Pragma("unroll") for (int n = 0; n < 2; ++n) \
                acc[ai][bj][m][n] = __builtin_amdgcn_mfma_scale_f32_16x16x128_f8f6f4(F.Bt[n], F.At[m], acc[ai][bj][m][n], 0, 0, 0, Epi::SCALE_W, 0, 0x7f7f7f7f); \
        } else { _Pragma("unroll") for (int m = 0; m < 4; ++m) _Pragma("unroll") for (int n = 0; n < 2; ++n) _Pragma("unroll") for (int k = 0; k < 2; ++k) \
            acc[ai][bj][m][n] = __builtin_amdgcn_mfma_f32_16x16x32_f16(__builtin_bit_cast(h16::f16x8_t, F.Bt[n][k]), __builtin_bit_cast(h16::f16x8_t, F.At[m][k]), acc[ai][bj][m][n], 0, 0, 0); } \
        __builtin_amdgcn_s_setprio(0); } while (0)
#define PG8_WAIT_V(n) asm volatile("s_waitcnt vmcnt(" #n ")" ::: "memory")
#define PG8_WAIT_L(n) asm volatile("s_waitcnt lgkmcnt(" #n ")" ::: "memory")
#define PG8_BAR __builtin_amdgcn_s_barrier()
#define PG8_SCHED __builtin_amdgcn_sched_barrier(0)
    Unit cur, nxt; int ui = 0;
    if (!S.next(0, cur)) return;
    Acc acc;
#pragma unroll
    for (int a = 0; a < 2; ++a)
#pragma unroll
        for (int b = 0; b < 2; ++b)
#pragma unroll
            for (int m = 0; m < 4; ++m)
#pragma unroll
                for (int n = 0; n < 2; ++n) acc[a][b][m][n] = (f32x4){0.f, 0.f, 0.f, 0.f};
    const char* cA = S.a_ptr(cur); const char* cB = S.b_ptr(cur);
    if constexpr (Epi::MID_T > 0) E.pre(cur, lds, tid);
    PG8_STAGE(PG8_SB(0, 0), cB, voffB); PG8_STAGE(PG8_SB(0, 1), cB + hstepB, voffB); PG8_STAGE(PG8_SA(0, 0), cA, voffA); PG8_STAGE(PG8_SA(0, 1), cA + hstepA, voffA);
    if (wr == 1) PG8_BAR;
    PG8_WAIT_V(2); PG8_BAR;
    PG8_STAGE(PG8_SB(1, 0), cB + kstep, voffB); PG8_STAGE(PG8_SA(1, 0), cA + kstep, voffA); PG8_STAGE(PG8_SB(1, 1), cB + hstepB + kstep, voffB);
    PG8_WAIT_V(6); PG8_BAR;
    for (;;) {
        const bool has_next = S.next(ui + 1, nxt);
        const char* nA = has_next ? S.a_ptr(nxt) : cA; const char* nB = has_next ? S.b_ptr(nxt) : cB;
        for (int t = 0; t < nt; t += 2) {
            if constexpr (Epi::MID_T > 0) { if (t == Epi::MID_T) E.mid(acc, lds, wr, fr); }
            const bool last = (t == nt - 2);
            Frags<Epi::FP8> F;
            const char* a1 = cA + (size_t)(t + 1) * kstep;
            const char* a2 = last ? nA : cA + (size_t)(t + 2) * kstep; const char* b2 = last ? nB : cB + (size_t)(t + 2) * kstep;
            const char* a3 = a2 + kstep; const char* b3 = b2 + kstep;
            PG8_LDB(B0, 0, 0); PG8_LDB(B1, 0, 1); PG8_SCHED; PG8_LDA(At, 0, 0); PG8_STAGE(PG8_SA(1, 1), a1 + hstepA, voffA);
            PG8_WAIT_V(8); PG8_WAIT_L(0); PG8_BAR; PG8_MMA(0, 0, At, B0); PG8_MMA(0, 1, At, B1); PG8_BAR; PG8_SCHED;
            PG8_LDA(At, 0, 1); PG8_STAGE(PG8_SB(0, 0), b2, voffB); PG8_STAGE(PG8_SB(0, 1), b2 + hstepB, voffB); PG8_STAGE(PG8_SA(0, 0), a2, voffA);
            PG8_WAIT_V(8); PG8_WAIT_L(0); PG8_BAR; PG8_MMA(1, 0, At, B0); PG8_MMA(1, 1, At, B1); PG8_BAR; PG8_SCHED;
            PG8_LDB(B0, 1, 0); PG8_LDB(B1, 1, 1); PG8_SCHED; PG8_LDA(At, 1, 0); PG8_STAGE(PG8_SA(0, 1), a2 + hstepA, voffA);
            PG8_WAIT_V(8); PG8_WAIT_L(0); PG8_BAR; PG8_MMA(0, 0, At, B0); PG8_MMA(0, 1, At, B1); PG8_BAR; PG8_SCHED;
            PG8_LDA(At, 1, 1); PG8_STAGE(PG8_SB(1, 0), b3, voffB); PG8_STAGE(PG8_SB(1, 1), b3 + hstepB, voffB); PG8_STAGE(PG8_SA(1, 0), a3, voffA);
            PG8_WAIT_V(8); PG8_WAIT_L(0); PG8_BAR; PG8_MMA(1, 0, At, B0); PG8_MMA(1, 1, At, B1); PG8_BAR; PG8_SCHED;
        }
        if (wr == 0) PG8_BAR;
        { const int t2_ = olane(); E(acc, cur, wr, wc, t2_ & 15, t2_ >> 4); }
        if (!has_next) break;
#pragma unroll
        for (int a = 0; a < 2; ++a)
#pragma unroll
            for (int b = 0; b < 2; ++b)
#pragma unroll
                for (int m = 0; m < 4; ++m)
#pragma unroll
                    for (int n = 0; n < 2; ++n) acc[a][b][m][n] = (f32x4){0.f, 0.f, 0.f, 0.f};
        cur = nxt; cA = nA; cB = nB; ++ui;
        if (wr == 1) PG8_BAR;
    }
    PG8_WAIT_V(0);
    PG8_BAR;
#undef PG8_SA
#undef PG8_SB
#undef PG8_STAGE
#undef PG8_LDA
#undef PG8_LDB
#undef PG8_MMA
#undef PG8_WAIT_V
#undef PG8_WAIT_L
#undef PG8_BAR
#undef PG8_SCHED
}
}
namespace epi {
#define PG8_LAS __attribute__((address_space(3)))
using pg8::Acc; using pg8::Unit; using pg8::f32x4; using pg8::u32x4; using pg8::bf16_t; using pg8::cvt_pk_bf16; using pg8::fast_silu;
constexpr int HALF = 128;
constexpr float C2 = 0.125f * 1.4426950408889634f;
constexpr float KSC = 0.08838834764831845f;

__device__ __forceinline__ u32x4 pack8(const f32x4 v0, const f32x4 v1) { u32x4 w; w.x = cvt_pk_bf16(v0[0], v0[1]); w.y = cvt_pk_bf16(v0[2], v0[3]); w.z = cvt_pk_bf16(v1[0], v1[1]); w.w = cvt_pk_bf16(v1[2], v1[3]); return w; }

struct EpiInProj {
    static constexpr bool PERM = true; static constexpr int MID_T = 0; static constexpr bool FP8 = false; static constexpr int SCALE_W = 0;
    bf16_t* O; size_t gstride;
    float* KMP;
    const float* ROPE;
    __device__ __forceinline__ void operator()(const Acc& acc, const Unit& u, int wr, int wc, int fr, int fq) const {
        const int grp = u.pn >> 1;
        const int col0 = (u.pn & 1) * 256 + wc * 32 + 8 * fq;
        const int row0 = u.pm * 256 + wr * 64 + fr;
        bf16_t* base = O + (size_t)grp * gstride;
        f32x4 cs[2][2];
#pragma unroll
        for (int bj = 0; bj < 2; ++bj) { cs[bj][0] = (f32x4){0.f, 0.f, 0.f, 0.f}; cs[bj][1] = (f32x4){0.f, 0.f, 0.f, 0.f}; }
#pragma unroll
        for (int ai = 0; ai < 2; ++ai)
#pragma unroll
            for (int m = 0; m < 4; ++m) {
                const int row = row0 + ai * HALF + m * 16;
                bf16_t* rowp = base + (size_t)row * 512 + col0;
                f32x4 t0 = (f32x4){0.f, 0.f, 0.f, 0.f}, t1 = t0;
                if (grp == 3 || grp == 4) { const float* tp = ROPE + ((size_t)(row & 2047) * 64 + 16 * wc + 4 * fq) * 2; t0 = *(const f32x4*)tp; t1 = *(const f32x4*)(tp + 4); }
#pragma unroll
                for (int bj = 0; bj < 2; ++bj) {
                    f32x4 v0 = acc[ai][bj][m][0], v1 = acc[ai][bj][m][1];
                    if (grp == 0) { v0 = v0 * C2; v1 = v1 * C2; }
                    else if (grp == 1) { cs[bj][0] += v0; cs[bj][1] += v1; }
                    else if (grp == 3 || grp == 4) {
                        const float sc = (grp == 4) ? KSC : 1.0f;
                        f32x4 r0, r1;
                        r0[0] = (v0[0] * t0[0] - v0[1] * t0[1]) * sc; r0[1] = (v0[0] * t0[1] + v0[1] * t0[0]) * sc;
                        r0[2] = (v0[2] * t0[2] - v0[3] * t0[3]) * sc; r0[3] = (v0[2] * t0[3] + v0[3] * t0[2]) * sc;
                        r1[0] = (v1[0] * t1[0] - v1[1] * t1[1]) * sc; r1[1] = (v1[0] * t1[1] + v1[1] * t1[0]) * sc;
                        r1[2] = (v1[2] * t1[2] - v1[3] * t1[3]) * sc; r1[3] = (v1[2] * t1[3] + v1[3] * t1[2]) * sc;
                        v0 = r0; v1 = r1;
                    } else if (grp == 6) {
#pragma unroll
                        for (int j = 0; j < 4; ++j) { v0[j] = fast_silu(v0[j]); v1[j] = fast_silu(v1[j]); }
                    }
                    *(u32x4*)(rowp + bj * HALF) = pack8(v0, v1);
                }
            }
        if (grp == 1) {
#pragma unroll
            for (int bj = 0; bj < 2; ++bj)
#pragma unroll
                for (int n = 0; n < 2; ++n) {
                    f32x4 s = cs[bj][n];
#pragma unroll
                    for (int c4 = 0; c4 < 4; ++c4) { float t = s[c4]; t += xl::xor_f<1>(t); t += xl::xor_f<2>(t); t += xl::xor_f<4>(t); t += xl::xor_f<8>(t); s[c4] = t; }
                    if (fr == 0) *(f32x4*)(KMP + (size_t)(u.pm * 2 + wr) * 512 + col0 + bj * HALF + 4 * n) = s;
                }
        }
    }
};

struct EpiOutProj {
    static constexpr bool PERM = false; static constexpr int MID_T = 8; static constexpr bool FP8 = false; static constexpr int SCALE_W = 0;
    const float* xin; float* out; const float* g1;
    const float* assq;
    bool dry;
    static constexpr int RS_OFF = 131072 + 8192;
    __device__ __forceinline__ void pre(const Unit& u, PG8_LAS unsigned char* lds, int tid) const {
        if (tid < 256) { const int row = u.pm * 256 + tid;
            const f32x4 a = *(const f32x4*)(assq + (size_t)row * 8), c = *(const f32x4*)(assq + (size_t)row * 8 + 4);
            const float ss = ((a[0] + a[1]) + (a[2] + a[3])) + ((c[0] + c[1]) + (c[2] + c[3]));
            ((PG8_LAS float*)(lds + RS_OFF))[tid] = 1.0f / sqrtf(ss * (1.0f / 512.0f) + 1e-6f); }
    }
    __device__ __forceinline__ void mid(Acc& acc, PG8_LAS unsigned char* lds, int wr, int fr) const {
        const PG8_LAS float* tab = (const PG8_LAS float*)(lds + RS_OFF) + wr * 64 + fr;
#pragma unroll
        for (int ai = 0; ai < 2; ++ai)
#pragma unroll
            for (int m = 0; m < 4; ++m) {
                const float rs = tab[ai * HALF + m * 16];
#pragma unroll
                for (int bj = 0; bj < 2; ++bj)
#pragma unroll
                    for (int n = 0; n < 2; ++n) acc[ai][bj][m][n] = acc[ai][bj][m][n] * rs;
            }
    }
    __device__ __forceinline__ void operator()(const Acc& acc, const Unit& u, int wr, int wc, int fr, int fq) const {
        const int b = u.pm >> 3;
        const int col0 = u.pn * 256 + wc * 32 + 4 * fq;
        const int row0 = u.pm * 256 + wr * 64 + fr;
        f32x4 gv[2][2];
#pragma unroll
        for (int bj = 0; bj < 2; ++bj)
#pragma unroll
            for (int n = 0; n < 2; ++n) gv[bj][n] = *(const f32x4*)(g1 + (size_t)b * 6144 + col0 + bj * HALF + n * 16);
#pragma unroll
        for (int ai = 0; ai < 2; ++ai)
#pragma unroll
            for (int m = 0; m < 4; ++m) {
                const size_t off = (size_t)(row0 + ai * HALF + m * 16) * 1024 + col0;
#pragma unroll
                for (int bj = 0; bj < 2; ++bj)
#pragma unroll
                    for (int n = 0; n < 2; ++n) { const f32x4 bs = *(const f32x4*)(xin + off + bj * HALF + n * 16); const f32x4 r = bs + gv[bj][n] * acc[ai][bj][m][n]; if (!dry) *(f32x4*)(out + off + bj * HALF + n * 16) = r; else asm volatile("" :: "v"(r)); }
            }
    }
};

struct EpiSwiGLU {
    static constexpr bool PERM = true; static constexpr int MID_T = 0; static constexpr bool FP8 = false; static constexpr int SCALE_W = 0;
    bf16_t* H; int ldh;
    __device__ __forceinline__ void operator()(const Acc& acc, const Unit& u, int wr, int wc, int fr, int fq) const {
        const int col0 = u.pn * 128 + wc * 32 + 8 * fq;
        const int row0 = u.pm * 256 + wr * 64 + fr;
#pragma unroll
        for (int ai = 0; ai < 2; ++ai)
#pragma unroll
            for (int m = 0; m < 4; ++m) {
                const int row = row0 + ai * HALF + m * 16;
                f32x4 v0, v1;
#pragma unroll
                for (int j = 0; j < 4; ++j) { v0[j] = fast_silu(acc[ai][0][m][0][j]) * acc[ai][1][m][0][j]; v1[j] = fast_silu(acc[ai][0][m][1][j]) * acc[ai][1][m][1][j]; }
                *(u32x4*)(H + (size_t)row * ldh + col0) = pack8(v0, v1);
            }
    }
};

struct EpiDown {
    static constexpr bool PERM = false; static constexpr int MID_T = 0; static constexpr bool FP8 = false; static constexpr int SCALE_W = 0;
    float* out; const float* g2; bf16_t* YS; const int* srow; const float* swt; bool moe; bool dry; int* atomf; bool atomic; float* slab; int KS;
    __device__ __forceinline__ void operator()(const Acc& acc, const Unit& u, int wr, int wc, int fr, int fq) const {
        const int col0 = u.pn * 256 + wc * 32 + 4 * fq;
        const int row0 = u.pm * 256 + wr * 64 + fr;
        if (!moe) {
            const int b = u.pm >> 3;
            f32x4 gv[2][2];
#pragma unroll
            for (int bj = 0; bj < 2; ++bj)
#pragma unroll
                for (int n = 0; n < 2; ++n) gv[bj][n] = *(const f32x4*)(g2 + (size_t)b * 6144 + col0 + bj * HALF + n * 16);
#pragma unroll
            for (int ai = 0; ai < 2; ++ai)
#pragma unroll
                for (int m = 0; m < 4; ++m) {
                    const size_t off = (size_t)(row0 + ai * HALF + m * 16) * 1024 + col0;
#pragma unroll
                    for (int bj = 0; bj < 2; ++bj)
#pragma unroll
                        for (int n = 0; n < 2; ++n) { const f32x4 bs = *(const f32x4*)(out + off + bj * HALF + n * 16); const f32x4 r = bs + gv[bj][n] * acc[ai][bj][m][n]; if (!dry) *(f32x4*)(out + off + bj * HALF + n * 16) = r; else asm volatile("" :: "v"(r)); }
                }
        } else if (atomic) {
            float* sl = slab + ((size_t)(u.li * KS + u.kc) * 256) * 256 + (wc * 32 + 4 * fq);
#pragma unroll
            for (int ai = 0; ai < 2; ++ai)
#pragma unroll
                for (int m = 0; m < 4; ++m) {
                    const int rl = ai * HALF + wr * 64 + m * 16 + fr; const int pos = u.pm * 256 + rl;
                    const int sr = srow[pos];
                    if (sr >= 0) { const float w = swt[pos];
                        if (u.kc == 0 && wc == 0 && fq == 0) atomf[sr * 4 + u.pn] = 1 + u.li * 256 + rl;
#pragma unroll
                        for (int bj = 0; bj < 2; ++bj)
#pragma unroll
                            for (int n = 0; n < 2; ++n) *(f32x4*)(sl + (size_t)rl * 256 + bj * HALF + n * 16) = acc[ai][bj][m][n] * w; }
                }
        } else {
#pragma unroll
            for (int ai = 0; ai < 2; ++ai)
#pragma unroll
                for (int m = 0; m < 4; ++m) {
                    const int pos = row0 + ai * HALF + m * 16;
                    const int sr = srow[pos];
                    if (sr >= 0) { const float w = swt[pos]; bf16_t* rowp = YS + (size_t)sr * 1024 + col0;
#pragma unroll
                        for (int bj = 0; bj < 2; ++bj)
#pragma unroll
                            for (int n = 0; n < 2; ++n) { const f32x4 v = acc[ai][bj][m][n] * w; pg8::u32x2 o; o.x = cvt_pk_bf16(v[0], v[1]); o.y = cvt_pk_bf16(v[2], v[3]); if (!dry) *(pg8::u32x2*)(rowp + bj * HALF + n * 16) = o; else asm volatile("" :: "v"(o)); } }
                }
        }
    }
};

__device__ __forceinline__ float clamp448(float v) { return __builtin_fminf(__builtin_fmaxf(v, -448.0f), 448.0f); }
__device__ __forceinline__ unsigned pk4_fp8(float a, float b, float c, float d) {
    int p = 0; p = __builtin_amdgcn_cvt_pk_fp8_f32(clamp448(a), clamp448(b), p, false); p = __builtin_amdgcn_cvt_pk_fp8_f32(clamp448(c), clamp448(d), p, true); return (unsigned)p; }
struct EpiSwiGLU8 {
    static constexpr bool PERM = true; static constexpr int MID_T = 0; static constexpr bool FP8 = true; static constexpr int SCALE_W = 0x7a7a7a7a;
    unsigned char* H; int ldh;
    __device__ __forceinline__ void operator()(const Acc& acc, const Unit& u, int wr, int wc, int fr, int fq) const {
        const int col0 = u.pn * 128 + wc * 32 + 8 * fq;
        const int row0 = u.pm * 256 + wr * 64 + fr;
#pragma unroll
        for (int ai = 0; ai < 2; ++ai)
#pragma unroll
            for (int m = 0; m < 4; ++m) {
                const int row = row0 + ai * HALF + m * 16;
                f32x4 v0, v1;
#pragma unroll
                for (int j = 0; j < 4; ++j) { v0[j] = fast_silu(acc[ai][0][m][0][j]) * acc[ai][1][m][0][j]; v1[j] = fast_silu(acc[ai][0][m][1][j]) * acc[ai][1][m][1][j]; }
                pg8::u32x2 w; w.x = pk4_fp8(v0[0], v0[1], v0[2], v0[3]); w.y = pk4_fp8(v1[0], v1[1], v1[2], v1[3]);
                *(pg8::u32x2*)(H + (size_t)row * ldh + col0) = w;
            }
    }
};
struct EpiDownDense8 {
    static constexpr bool PERM = false; static constexpr int MID_T = 0; static constexpr bool FP8 = true; static constexpr int SCALE_W = 0x79797979;
    float* out; const float* g2; bool dry;
    __device__ __forceinline__ void operator()(const Acc& acc, const Unit& u, int wr, int wc, int fr, int fq) const {
        const int col0 = u.pn * 256 + wc * 32 + 4 * fq;
        const int row0 = u.pm * 256 + wr * 64 + fr;
        const int b = u.pm >> 3;
        f32x4 gv[2][2];
#pragma unroll
        for (int bj = 0; bj < 2; ++bj)
#pragma unroll
            for (int n = 0; n < 2; ++n) gv[bj][n] = *(const f32x4*)(g2 + (size_t)b * 6144 + col0 + bj * HALF + n * 16);
#pragma unroll
        for (int ai = 0; ai < 2; ++ai)
#pragma unroll
            for (int m = 0; m < 4; ++m) {
                const size_t off = (size_t)(row0 + ai * HALF + m * 16) * 1024 + col0;
#pragma unroll
                for (int bj = 0; bj < 2; ++bj)
#pragma unroll
                    for (int n = 0; n < 2; ++n) { const f32x4 bs = *(const f32x4*)(out + off + bj * HALF + n * 16); const f32x4 r = bs + gv[bj][n] * acc[ai][bj][m][n]; if (!dry) *(f32x4*)(out + off + bj * HALF + n * 16) = r; else asm volatile("" :: "v"(r)); }
            }
    }
};
struct EpiDownMoe8 {
    static constexpr bool PERM = false; static constexpr int MID_T = 0; static constexpr bool FP8 = true; static constexpr int SCALE_W = 0x79797979;
    bf16_t* YS; const int* srow; const float* swt;
    __device__ __forceinline__ void operator()(const Acc& acc, const Unit& u, int wr, int wc, int fr, int fq) const {
        const int col0 = u.pn * 256 + wc * 32 + 4 * fq;
        const int row0 = u.pm * 256 + wr * 64 + fr;
#pragma unroll
        for (int ai = 0; ai < 2; ++ai)
#pragma unroll
            for (int m = 0; m < 4; ++m) {
                const int pos = row0 + ai * HALF + m * 16;
                const int sr = srow[pos];
                if (sr >= 0) { const float w = swt[pos]; bf16_t* rowp = YS + (size_t)sr * 1024 + col0;
#pragma unroll
                    for (int bj = 0; bj < 2; ++bj)
#pragma unroll
                        for (int n = 0; n < 2; ++n) { const f32x4 v = acc[ai][bj][m][n] * w; pg8::u32x2 o; o.x = cvt_pk_bf16(v[0], v[1]); o.y = cvt_pk_bf16(v[2], v[3]); *(pg8::u32x2*)(rowp + bj * HALF + n * 16) = o; } }
            }
    }
};
}
namespace fa {
#define FA_LAS __attribute__((address_space(3)))
typedef unsigned short bf16_t;
typedef short bf16x8 __attribute__((ext_vector_type(8)));
typedef short s16x4 __attribute__((ext_vector_type(4)));
typedef float f32x16 __attribute__((ext_vector_type(16)));
typedef float f32x4 __attribute__((ext_vector_type(4)));
typedef unsigned u32x4 __attribute__((ext_vector_type(4)));
typedef float f32x2_t __attribute__((ext_vector_type(2))); typedef __bf16 bf16x2_t __attribute__((ext_vector_type(2)));
constexpr int L_WSF = 131072 + 1024, L_KM = L_WSF + 2048;
constexpr float NEG = -1.0e30f;
__device__ __forceinline__ int crow(int r, int hi) { return (r & 3) + 8 * (r >> 2) + 4 * hi; }
__device__ __forceinline__ void glds16(const void* gsrc, unsigned lds_dst) { unsigned keep;
    asm volatile("s_mov_b32 %0, m0\n\ts_mov_b32 m0, %2\n\ts_nop 0\n\tglobal_load_lds_dwordx4 %1, off\n\ts_mov_b32 m0, %0" : "=&s"(keep) : "v"(gsrc), "s"(lds_dst) : "memory"); }
__device__ __forceinline__ unsigned cvtpk_s(float lo, float hi) { return h16::pk(lo, hi); }
__device__ __forceinline__ float bf2f(short s) { return h16::one((unsigned short)s); }
typedef short v4i16_t __attribute__((ext_vector_type(4)));
__device__ __forceinline__ s16x4 vtr(FA_LAS const unsigned char* p) { return __builtin_bit_cast(s16x4, __builtin_amdgcn_ds_read_tr16_b64_v4i16((FA_LAS v4i16_t*)p)); }
#define FA_WAIT_BAR() asm volatile("s_waitcnt vmcnt(0) lgkmcnt(0)\n\ts_barrier" ::: "memory")
#define FA_LBAR() asm volatile("s_waitcnt lgkmcnt(0)\n\ts_barrier" ::: "memory")

struct Tensors {
    const bf16_t* Q; const bf16_t* K; const bf16_t* V;
    bf16_t* CAT;
    float* ASSQ;
    const float* KMP;
    const bf16_t* GR;
    const float* ret_g;
    const float* KVM;
};

template <bool RET>
__device__ __forceinline__ void attn_unit(const int wv, int b, int h, int qblk, const Tensors& T, FA_LAS unsigned char* shm) {
    constexpr int NS = RET ? 3 : 4, DIST = NS - 1;
    constexpr int DH = RET ? 128 : 64, ND0 = DH / 16, NDB = DH / 32, NPC = DH / 64, SLOT = 64 * DH * 2, L_K = 0, L_V = NS * SLOT, PER = 2 * NPC, L_R = 98304;
    int tid_ = otid(wv);
    const int tid = tid_, lane = tid & 63, r32 = lane & 31, hi = lane >> 5; const int wid = __builtin_amdgcn_readfirstlane(tid >> 6);
    const size_t rowbase = (size_t)b * 2048; const int q0 = qblk * 256;
    const unsigned lds0 = (unsigned)(unsigned long)shm;
    FA_LAS float* wsf = (FA_LAS float*)(shm + L_WSF) + wid * 64;
    FA_LAS float* KM = (FA_LAS float*)(shm + L_KM);
    const bf16_t* Kh = T.K + rowbase * 512 + h * DH; const bf16_t* Vh = T.V + rowbase * 512 + h * DH;
    const int NT = RET ? 4 : 4 * (qblk + 1);
#define FA_KV0(i) ((((i) < 4) ? qblk : (qblk - 1 - (((i) - 4) >> 2))) * 256 + ((i) & 3) * 64)
#define FA_DMA(i) do { const int kv0_ = FA_KV0(i); const unsigned so_ = (unsigned)(((i) % NS) * SLOT); \
        _Pragma("unroll") for (int pp = 0; pp < NPC; ++pp) { const int p = wid + 8 * pp; \
            glds16(Kh + (size_t)(kv0_ + lane) * 512 + p * 8, (unsigned)__builtin_amdgcn_readfirstlane(lds0 + L_K + so_ + p * 1024)); } \
        _Pragma("unroll") for (int pp = 0; pp < NPC; ++pp) { const int p = wid + 8 * pp; \
            glds16(Vh + (size_t)(kv0_ + 16 * (p & 3) + (lane >> 2)) * 512 + (p >> 2) * 32 + (lane & 3) * 8, (unsigned)__builtin_amdgcn_readfirstlane(lds0 + L_V + so_ + p * 1024)); } } while (0)
    FA_DMA(0); if (NT > 1) FA_DMA(1); if (DIST > 2 && NT > 2) FA_DMA(2);
    const bf16_t* Qw = T.Q + (rowbase + q0 + wid * 32 + r32) * 512 + h * DH;
    bf16x8 qr[ND0];
#pragma unroll
    for (int d0 = 0; d0 < ND0; ++d0) qr[d0] = *(const bf16x8*)(Qw + d0 * 16 + hi * 8);
    unsigned selmask = 0xffu;
    float cfac[16]; float lg2 = 0.f;
    if (!RET) {
        { const int j = tid >> 6, d = tid & 63; const float* kp = T.KMP + ((size_t)(b * 8 + j) * 2) * 512 + h * 64 + d; KM[tid] = kp[0] + kp[512]; }
        FA_LBAR();
        float g[8];
#pragma unroll
        for (int j = 0; j < 8; ++j) g[j] = 0.f;
#pragma unroll
        for (int d0 = 0; d0 < ND0; ++d0)
#pragma unroll
            for (int jj = 0; jj < 8; ++jj) { const float qv = bf2f(qr[d0][jj]); const int d = 16 * d0 + 8 * hi + jj;
#pragma unroll
                for (int j = 0; j < 8; ++j) g[j] += qv * KM[j * 64 + d]; }
#pragma unroll
        for (int j = 0; j < 8; ++j) g[j] = xl::add32(g[j]);
        selmask = 0u;
#pragma unroll
        for (int j = 0; j < 8; ++j) { int rank = 0;
#pragma unroll
            for (int mm = 0; mm < 8; ++mm) rank += (mm < qblk && (g[mm] > g[j] || (g[mm] == g[j] && mm < j))) ? 1 : 0;
            if (j < qblk && rank < 3) selmask |= 1u << j; }
    } else {
        lg2 = log2f(1.0f - exp2f(-5.0f - (float)h));
#pragma unroll
        for (int r = 0; r < 16; ++r) cfac[r] = exp2f(-lg2 * (float)((r & 3) + 8 * (r >> 2)));
    }
    f32x16 o[NDB];
#pragma unroll
    for (int db = 0; db < NDB; ++db) o[db] = f32x16{};
    float mhat = 0.f, lrow = 0.f; f32x16 negm = f32x16{}; constexpr float THR = 8.0f;
    if (RET && qblk > 0) {
        const float* kvb = T.KVM + ((size_t)(b * 4 + h) * 8) * 16384;
        const float g256 = exp2f(lg2 * 256.0f);
#pragma unroll 2
        for (int it = 0; it < 8; ++it) { const int idx4 = tid + 512 * it; const int d = idx4 >> 5, e0 = (idx4 & 31) * 4;
            f32x4 acc4 = (f32x4){0.f, 0.f, 0.f, 0.f};
            for (int m = 0; m < qblk; ++m) acc4 = acc4 * g256 + *(const f32x4*)(kvb + (size_t)m * 16384 + d * 128 + e0);
            const int rp = (d & ~12) | ((d & 8) >> 1) | ((d & 4) << 1);
            typedef unsigned u32x2_ __attribute__((ext_vector_type(2)));
            u32x2_ w; w.x = cvtpk_s(acc4[0], acc4[1]); w.y = cvtpk_s(acc4[2], acc4[3]);
            *(FA_LAS u32x2_*)(shm + L_R + (e0 >> 5) * 8192 + rp * 64 + (e0 & 31) * 2) = w; }
        FA_LBAR();
        { FA_LAS const unsigned char* rb = shm + L_R + ((lane >> 4) & 1) * 32 + (lane & 3) * 8 + (4 * hi + ((lane & 15) >> 2)) * 64;
#pragma unroll
          for (int db = 0; db < NDB; ++db)
#pragma unroll
              for (int d0 = 0; d0 < ND0; ++d0) { const s16x4 lo = vtr(rb + db * 8192 + d0 * 1024), hh = vtr(rb + db * 8192 + d0 * 1024 + 512);
                  const bf16x8 rf = (bf16x8){lo[0], lo[1], lo[2], lo[3], hh[0], hh[1], hh[2], hh[3]};
                  o[db] = __builtin_amdgcn_mfma_f32_32x32x16_f16(__builtin_bit_cast(h16::f16x8_t, qr[d0]), __builtin_bit_cast(h16::f16x8_t, rf), o[db], 0, 0, 0); } }
#pragma unroll
        for (int r = 0; r < 16; ++r) { const float rd = exp2f(lg2 * (float)(wid * 32 + crow(r, hi) + 1));
#pragma unroll
            for (int db = 0; db < NDB; ++db) o[db][r] *= rd; }
    }
    const int qrel = wid * 32 + r32;
    for (int i = 0; i < NT; ++i) {
        { const int ahead = (NT - 1 - i) < (DIST - 1) ? (NT - 1 - i) : (DIST - 1);
          if (ahead == 2) { if (PER == 2) asm volatile("s_waitcnt vmcnt(4) lgkmcnt(0)\n\ts_barrier" ::: "memory"); else asm volatile("s_waitcnt vmcnt(8) lgkmcnt(0)\n\ts_barrier" ::: "memory"); }
          else if (ahead == 1) { if (PER == 2) asm volatile("s_waitcnt vmcnt(2) lgkmcnt(0)\n\ts_barrier" ::: "memory"); else asm volatile("s_waitcnt vmcnt(4) lgkmcnt(0)\n\ts_barrier" ::: "memory"); }
          else FA_WAIT_BAR(); }
        if (i + DIST < NT) FA_DMA(i + DIST);
        const bool diag = i < 4; const int t = i & 3; const int j = diag ? qblk : (qblk - 1 - ((i - 4) >> 2));
        const bool mysel = RET ? true : (((selmask >> j) & 1u) != 0u);
        const bool skip = diag ? (64 * t > 32 * wid + 31) : (RET ? false : !__any(mysel));
        if (skip) continue;
        const unsigned so = (unsigned)((i % NS) * SLOT);
        f32x16 p0 = RET ? f32x16{} : negm, p1 = p0;
        { FA_LAS const unsigned char* kb = shm + L_K + so + hi * 1024 + r32 * 16;
#pragma unroll
          for (int d0 = 0; d0 < ND0; ++d0) { const bf16x8 b0 = *(FA_LAS const bf16x8*)(kb + d0 * 2048); const bf16x8 b1 = *(FA_LAS const bf16x8*)(kb + d0 * 2048 + 512);
              p0 = __builtin_amdgcn_mfma_f32_32x32x16_f16(__builtin_bit_cast(h16::f16x8_t, b0), __builtin_bit_cast(h16::f16x8_t, qr[d0]), p0, 0, 0, 0); p1 = __builtin_amdgcn_mfma_f32_32x32x16_f16(__builtin_bit_cast(h16::f16x8_t, b1), __builtin_bit_cast(h16::f16x8_t, qr[d0]), p1, 0, 0, 0); } }
        if (RET) {
            const int qpos = q0 + qrel; const int kv0 = j * 256 + t * 64;
            const float base = (float)(qpos - kv0 - 4 * hi);
            const float rf0 = exp2f(lg2 * base), rf1 = exp2f(lg2 * (base - 32.0f));
#pragma unroll
            for (int r = 0; r < 16; ++r) { p0[r] *= rf0 * cfac[r]; p1[r] *= rf1 * cfac[r]; }
            if (diag) { const int kb_ = 64 * t + 4 * hi;
#pragma unroll
                for (int r = 0; r < 16; ++r) { const int kv = kb_ + (r & 3) + 8 * (r >> 2); if (kv > qrel) p0[r] = 0.f; if (kv + 32 > qrel) p1[r] = 0.f; } }
        } else {
            if (diag) { const int kb_ = 64 * t + 4 * hi;
#pragma unroll
                for (int r = 0; r < 16; ++r) { const int kv = kb_ + (r & 3) + 8 * (r >> 2); if (kv > qrel) p0[r] = NEG; if (kv + 32 > qrel) p1[r] = NEG; } }
            else if (!mysel) {
#pragma unroll
                for (int r = 0; r < 16; ++r) { p0[r] = NEG; p1[r] = NEG; } }
            float rm = fmaxf(fmaxf(p0[0], p1[0]), p0[1]);
#pragma unroll
            for (int r = 1; r < 16; ++r) { rm = fmaxf(fmaxf(rm, p1[r]), (r < 15) ? p0[r + 1] : p1[r]); }
            rm = xl::max32(rm);
            if (__any(rm > THR)) {
                const float dl = fmaxf(rm, 0.f);
                mhat += dl;
#pragma unroll
                for (int r = 0; r < 16; ++r) { p0[r] -= dl; p1[r] -= dl; }
#pragma unroll
                for (int r = 0; r < 16; ++r) negm[r] = -mhat;
                const float f = __builtin_amdgcn_exp2f(-dl); lrow *= f;
                asm volatile("" ::: "memory");
                if (hi == 0) wsf[r32] = f;
                asm volatile("s_waitcnt lgkmcnt(0)" ::: "memory");
#pragma unroll
                for (int r = 0; r < 16; ++r) { const float fr_ = wsf[crow(r, hi)];
#pragma unroll
                    for (int db = 0; db < NDB; ++db) o[db][r] *= fr_; }
                asm volatile("s_waitcnt lgkmcnt(0)" ::: "memory");
            }
            float s = 0.f;
#pragma unroll
            for (int r = 0; r < 16; ++r) { p0[r] = __builtin_amdgcn_exp2f(p0[r]); p1[r] = __builtin_amdgcn_exp2f(p1[r]); s += p0[r] + p1[r]; }
            lrow += s;
        }
        bf16x8 pa[4];
        { u32x4 w;
          w.x = cvtpk_s(p0[0], p0[1]); w.y = cvtpk_s(p0[2], p0[3]); w.z = cvtpk_s(p0[4], p0[5]); w.w = cvtpk_s(p0[6], p0[7]); pa[0] = __builtin_bit_cast(bf16x8, w);
          w.x = cvtpk_s(p0[8], p0[9]); w.y = cvtpk_s(p0[10], p0[11]); w.z = cvtpk_s(p0[12], p0[13]); w.w = cvtpk_s(p0[14], p0[15]); pa[1] = __builtin_bit_cast(bf16x8, w);
          w.x = cvtpk_s(p1[0], p1[1]); w.y = cvtpk_s(p1[2], p1[3]); w.z = cvtpk_s(p1[4], p1[5]); w.w = cvtpk_s(p1[6], p1[7]); pa[2] = __builtin_bit_cast(bf16x8, w);
          w.x = cvtpk_s(p1[8], p1[9]); w.y = cvtpk_s(p1[10], p1[11]); w.z = cvtpk_s(p1[12], p1[13]); w.w = cvtpk_s(p1[14], p1[15]); pa[3] = __builtin_bit_cast(bf16x8, w); }
        { FA_LAS const unsigned char* vb = shm + L_V + so + ((lane >> 4) & 1) * 32 + (lane & 3) * 8 + (4 * hi + ((lane & 15) >> 2)) * 64;
#pragma unroll
          for (int db = 0; db < NDB; ++db)
#pragma unroll
              for (int ks = 0; ks < 4; ++ks) { const s16x4 lo = vtr(vb + db * 4096 + ks * 1024), hh = vtr(vb + db * 4096 + ks * 1024 + 512);
                  const bf16x8 vf = (bf16x8){lo[0], lo[1], lo[2], lo[3], hh[0], hh[1], hh[2], hh[3]};
                  o[db] = __builtin_amdgcn_mfma_f32_32x32x16_f16(__builtin_bit_cast(h16::f16x8_t, pa[ks]), __builtin_bit_cast(h16::f16x8_t, vf), o[db], 0, 0, 0); } }
    }
    float rli[16];
    if (!RET) {
        const float l = xl::add32(lrow);
        asm volatile("" ::: "memory");
        if (hi == 0) wsf[32 + r32] = 1.0f / l;
        asm volatile("s_waitcnt lgkmcnt(0)" ::: "memory");
#pragma unroll
        for (int r = 0; r < 16; ++r) rli[r] = wsf[32 + crow(r, hi)];
    } else {
#pragma unroll
        for (int r = 0; r < 16; ++r) rli[r] = 1.0f;
    }
    FA_LBAR();
    FA_LAS bf16_t* stg = (FA_LAS bf16_t*)(shm + wid * 8192);
#pragma unroll
    for (int r = 0; r < 16; ++r) { const int orow = crow(r, hi);
#pragma unroll
        for (int db = 0; db < NDB; ++db) { const unsigned pk = cvtpk_s(o[db][r] * rli[r], 0.f); stg[orow * DH + db * 32 + r32] = (bf16_t)(pk & 0xffffu); } }
    asm volatile("s_waitcnt lgkmcnt(0)" ::: "memory");
    const size_t tok0 = rowbase + q0 + wid * 32;
    if (!RET) {
#pragma unroll
        for (int i = 0; i < 4; ++i) { const int row = i * 8 + (lane >> 3), ch = lane & 7;
            const u32x4 v = *(FA_LAS const u32x4*)(stg + row * 64 + ch * 8);
            float ss = 0.f;
#pragma unroll
            for (int k = 0; k < 4; ++k) { const float a = h16::lo(v[k]), c = h16::hi(v[k]); ss += a * a + c * c; }
            ss += xl::xor_f<1>(ss); ss += xl::xor_f<2>(ss); ss += xl::xor_f<4>(ss);
            if (ch == 0) T.ASSQ[(tok0 + row) * 8 + h] = ss;
            *(u32x4*)(T.CAT + (tok0 + row) * 1024 + h * 64 + ch * 8) = v; }
    } else {
#pragma unroll
        for (int i = 0; i < 8; ++i) { const int row = i * 4 + (lane >> 4), ch = lane & 15;
            const u32x4 v = *(FA_LAS const u32x4*)(stg + row * 128 + ch * 8);
            float x[8];
#pragma unroll
            for (int k = 0; k < 4; ++k) { x[2 * k] = h16::lo(v[k]); x[2 * k + 1] = h16::hi(v[k]); }
            float ss = 0.f;
#pragma unroll
            for (int k = 0; k < 8; ++k) ss += x[k] * x[k];
            ss += xl::xor_f<1>(ss); ss += xl::xor_f<2>(ss); ss += xl::xor_f<4>(ss); ss += xl::xor_f<8>(ss);
            const float rs = 1.0f / sqrtf(ss * (1.0f / 128.0f) + 1e-6f);
            const u32x4 gv = *(const u32x4*)(T.GR + (tok0 + row) * 512 + h * 128 + ch * 8);
            const f32x4 w0 = *(const f32x4*)(T.ret_g + h * 128 + ch * 8), w1 = *(const f32x4*)(T.ret_g + h * 128 + ch * 8 + 4);
            const float wg[8] = {w0[0], w0[1], w0[2], w0[3], w1[0], w1[1], w1[2], w1[3]};
            float y[8];
#pragma unroll
            for (int k = 0; k < 4; ++k) { const float g0 = h16::lo(gv[k]), g1 = h16::hi(gv[k]);
                y[2 * k] = x[2 * k] * rs * wg[2 * k] * g0; y[2 * k + 1] = x[2 * k + 1] * rs * wg[2 * k + 1] * g1; }
            u32x4 ov; ov.x = cvtpk_s(y[0], y[1]); ov.y = cvtpk_s(y[2], y[3]); ov.z = cvtpk_s(y[4], y[5]); ov.w = cvtpk_s(y[6], y[7]);
            *(u32x4*)(T.CAT + (tok0 + row) * 1024 + 512 + h * 128 + ch * 8) = ov; }
    }
    FA_LBAR();
#undef FA_KV0
#undef FA_DMA
}

__device__ __forceinline__ void kv_unit(const int wv, int b, int h, int m, const bf16_t* Kg, const bf16_t* Vg, float* KVM, FA_LAS unsigned char* shm) {
    constexpr int SLOT = 16384, L_K = 0, L_V = 4 * SLOT;
    int tid_ = otid(wv);
    const int tid = tid_, lane = tid & 63, r32 = lane & 31, hi = lane >> 5; const int wid = __builtin_amdgcn_readfirstlane(tid >> 6);
    const int dg = wid >> 1, eh = wid & 1;
    const size_t rowbase = (size_t)b * 2048 + (size_t)m * 256;
    const unsigned lds0 = (unsigned)(unsigned long)shm;
    const bf16_t* Kh = Kg + rowbase * 512 + h * 128; const bf16_t* Vh = Vg + rowbase * 512 + h * 128;
#pragma unroll
    for (int t = 0; t < 4; ++t)
#pragma unroll
        for (int pp = 0; pp < 2; ++pp) { const int p = wid + 8 * pp; const size_t off = (size_t)(64 * t + 16 * (p & 3) + (lane >> 2)) * 512 + (p >> 2) * 32 + (lane & 3) * 8;
            glds16(Kh + off, (unsigned)__builtin_amdgcn_readfirstlane(lds0 + L_K + t * SLOT + p * 1024));
            glds16(Vh + off, (unsigned)__builtin_amdgcn_readfirstlane(lds0 + L_V + t * SLOT + p * 1024)); }
    const float lg2 = log2f(1.0f - exp2f(-5.0f - (float)h));
    const float g64 = exp2f(lg2 * 64.0f);
    h16::f16x8_t fd[4];
#pragma unroll
    for (int ks = 0; ks < 4; ++ks)
#pragma unroll
        for (int j = 0; j < 8; ++j) fd[ks][j] = (_Float16)exp2f(lg2 * (float)(63 - (16 * ks + 8 * (j >> 2) + 4 * hi + (j & 3))));
    f32x16 acc[2]; acc[0] = f32x16{}; acc[1] = f32x16{};
    FA_WAIT_BAR();
    const int lb = ((lane >> 4) & 1) * 32 + (lane & 3) * 8 + (4 * hi + ((lane & 15) >> 2)) * 64;
#pragma unroll
    for (int t = 0; t < 4; ++t) {
        if (t > 0) {
#pragma unroll
            for (int r = 0; r < 16; ++r) { acc[0][r] *= g64; acc[1][r] *= g64; } }
        FA_LAS const unsigned char* kb = shm + L_K + t * SLOT + dg * 4096 + lb; FA_LAS const unsigned char* vb = shm + L_V + t * SLOT + (2 * eh) * 4096 + lb;
#pragma unroll
        for (int ks = 0; ks < 4; ++ks) { const s16x4 klo = vtr(kb + ks * 1024), khi = vtr(kb + ks * 1024 + 512);
            const h16::f16x8_t kf = __builtin_bit_cast(h16::f16x8_t, (bf16x8){klo[0], klo[1], klo[2], klo[3], khi[0], khi[1], khi[2], khi[3]});
#pragma unroll
            for (int eb = 0; eb < 2; ++eb) { const s16x4 vlo = vtr(vb + eb * 4096 + ks * 1024), vhi = vtr(vb + eb * 4096 + ks * 1024 + 512);
                const h16::f16x8_t vf = __builtin_bit_cast(h16::f16x8_t, (bf16x8){vlo[0], vlo[1], vlo[2], vlo[3], vhi[0], vhi[1], vhi[2], vhi[3]}) * fd[ks];
                acc[eb] = __builtin_amdgcn_mfma_f32_32x32x16_f16(kf, vf, acc[eb], 0, 0, 0); } }
    }
    float* op = KVM + ((size_t)(b * 4 + h) * 8 + m) * 16384;
#pragma unroll
    for (int eb = 0; eb < 2; ++eb)
#pragma unroll
        for (int r = 0; r < 16; ++r) op[(size_t)(32 * dg + crow(r, hi)) * 128 + 64 * eh + 32 * eb + r32] = acc[eb][r];
    FA_LBAR();
}
}
namespace mk {
#define GAS __attribute__((address_space(1)))
#define LAS __attribute__((address_space(3)))
typedef unsigned short bf16;
typedef unsigned v4u __attribute__((ext_vector_type(4)));
typedef unsigned v2u __attribute__((ext_vector_type(2)));
typedef float f32x4 __attribute__((ext_vector_type(4)));
typedef int i32x4 __attribute__((ext_vector_type(4)));
typedef GAS unsigned gu32;
#define RLX_AGENT __ATOMIC_RELAXED, __HIP_MEMORY_SCOPE_AGENT
#define LDS_WAIT() asm volatile("s_waitcnt lgkmcnt(0)" ::: "memory")
#define VM_WAIT() asm volatile("s_waitcnt vmcnt(0)" ::: "memory")
constexpr int NWAVES = 8;
constexpr size_t MiB = 1u << 20, KiB = 1u << 10;
constexpr size_t WS_CTL = 0;
constexpr size_t CTL_ZERO_BYTES = 64 * KiB;
constexpr size_t WS_MOD = 64 * KiB;
constexpr size_t WS_KMP = 512 * KiB;
constexpr size_t WS_EIDX = 768 * KiB;
constexpr size_t WS_EW = 896 * KiB;
constexpr size_t WS_ROPE = 1 * MiB;
constexpr size_t WS_ASSQ = 2 * MiB;
constexpr size_t WS_SROW = 2 * MiB + 512 * KiB;
constexpr size_t WS_SWT = 2 * MiB + 768 * KiB;
constexpr size_t WS_WCNT = 3 * MiB;
constexpr size_t WS_SEG = 3 * MiB + 64 * KiB;
constexpr size_t WS_ATOMF = 3 * MiB + 128 * KiB;
constexpr size_t WS_SEGD = 3 * MiB + 65 * KiB;
constexpr size_t WS_MGU = 8 * MiB;
constexpr size_t WS_SLAB = 8 * MiB;
constexpr size_t WS_MDN = 96 * MiB;
constexpr size_t WS_XA = 140 * MiB;
constexpr size_t WS_XS = 172 * MiB;
constexpr size_t WS_KVM = 172 * MiB;
constexpr size_t WS_YS = 140 * MiB;
constexpr size_t WS_WIN = 240 * MiB;
constexpr size_t WS_WOUT = 254 * MiB;
constexpr size_t WS_FGU = 258 * MiB;
constexpr size_t WS_FDN = 269 * MiB;
constexpr size_t WS_QKV = 275 * MiB;
constexpr size_t WS_CAT = 387 * MiB;
constexpr size_t WS_HD = 275 * MiB;
constexpr size_t WS_HM = 240 * MiB;
constexpr size_t WS_END = 428 * MiB;
constexpr int XS_ROWS = 34816;
constexpr int CW_BAR = 1024;

constexpr int RING_BYTES = 131072, LDSCTL_OFF = RING_BYTES, MISC_OFF = LDSCTL_OFF + 320, LDS_BYTES = 147456;

#define XB_TMO      128
#define XB_XCNT(j)  (256  + 64 * (j))
#define XB_XSUB(j)  (1280 + 64 * (j))
#define XB_XGEN(j)  (2304 + 64 * (j))
#define XB_TOP      3328
#define XB_TOPGEN   3392
#define XCD_BAR_WORDS 3456
#define XB_SPIN_CAP (1u << 18)
__device__ __forceinline__ unsigned xb_ld(unsigned* p)              { return __hip_atomic_load(p, __ATOMIC_RELAXED, __HIP_MEMORY_SCOPE_AGENT); }
__device__ __forceinline__ unsigned xb_add(unsigned* p, unsigned v) { return __hip_atomic_fetch_add(p, v, __ATOMIC_RELAXED, __HIP_MEMORY_SCOPE_AGENT); }
__device__ __forceinline__ unsigned xb_xcc_id() { return (unsigned)__builtin_amdgcn_s_getreg((3 << 11) | 20) & 0xFu; }
#define XB_SPIN(cond, bar) do { unsigned _sp = 0; while (cond) { __builtin_amdgcn_s_sleep(1); \
    if ((++_sp & 255u) == 0u) { if (xb_ld(&(bar)[XB_TMO])) break; if (_sp > XB_SPIN_CAP) { atomicAdd(&(bar)[XB_TMO], 1u); break; } } } } while (0)
struct XcdBarrier { unsigned* bar; unsigned x; volatile LAS unsigned* st; int wv; };
__device__ __forceinline__ XcdBarrier xcd_barrier_post(unsigned* bar, volatile LAS unsigned* st, int wv) {
    XcdBarrier b; b.bar = bar; b.x = xb_xcc_id(); b.st = st; b.wv = wv;
    if (otid(wv) == 0) (void)xb_add(&bar[XB_XCNT(b.x)], 1u);
    return b;
}
__device__ __forceinline__ void xcd_barrier_complete(unsigned* bar, unsigned x, unsigned& nloc, unsigned& nx) {
    const unsigned G = gridDim.x * gridDim.y * gridDim.z;
    unsigned sum, cnt, mine, sp = 0u;
    for (;;) {
        sum = 0u; cnt = 0u; mine = 0u;
#pragma unroll
        for (unsigned j = 0; j < 16; ++j) { const unsigned c = xb_ld(&bar[XB_XCNT(j)]); sum += c; cnt += (c > 0u) ? 1u : 0u; mine = (j == x) ? c : mine; }
        if (sum == G) break;
        __builtin_amdgcn_s_sleep(1);
        if ((++sp & 255u) == 0u) { if (xb_ld(&bar[XB_TMO])) break; if (sp > XB_SPIN_CAP) { atomicAdd(&bar[XB_TMO], 1u); break; } }
    }
    nloc = mine > 0u ? mine : 1u; nx = cnt > 0u ? cnt : 1u;
}
__device__ __forceinline__ void xcd_barrier(const XcdBarrier& b) {
    asm volatile("s_waitcnt vmcnt(0)" ::: "memory");
    __syncthreads();
    if (otid(b.wv) == 0) {
        unsigned* bar = b.bar;
        __builtin_amdgcn_s_waitcnt(0);
        unsigned nloc = b.st[0], nx = b.st[1];
        if (nloc == 0u) { xcd_barrier_complete(bar, b.x, nloc, nx); b.st[0] = nloc; b.st[1] = nx; }
        const unsigned old = xb_add(&bar[XB_XSUB(b.x)], 1u);
        const unsigned gen = old / nloc;
        if (old + 1u == (gen + 1u) * nloc) {
            __builtin_amdgcn_fence(__ATOMIC_RELEASE, "agent");
            asm volatile("s_waitcnt vmcnt(0)" ::: "memory");
            const unsigned og = xb_add(&bar[XB_TOP], 1u);
            const unsigned tg = og / nx;
            if (og + 1u == (tg + 1u) * nx) xb_add(&bar[XB_TOPGEN], 1u);
            else XB_SPIN(xb_ld(&bar[XB_TOPGEN]) == tg, bar);
            __builtin_amdgcn_fence(__ATOMIC_ACQUIRE, "agent");
            xb_add(&bar[XB_XGEN(b.x)], 1u);
            asm volatile("s_waitcnt vmcnt(0)" ::: "memory");
        } else {
            XB_SPIN(xb_ld(&bar[XB_XGEN(b.x)]) == gen, bar);
            __builtin_amdgcn_fence(__ATOMIC_ACQUIRE, "agent");
            asm volatile("s_waitcnt vmcnt(0)" ::: "memory");
        }
    }
    __syncthreads();
}

__device__ __forceinline__ unsigned f2bf(float f) { unsigned u = __builtin_bit_cast(unsigned, f); return (u + 0x7fffu + ((u >> 16) & 1u)) >> 16; }
__device__ __forceinline__ unsigned pk2(float lo, float hi) { return h16::pk(lo, hi); }
using xl::wave_sum; using xl::wave_sum_i;

struct Inputs {
    const float *x, *c, *norm_mix_g, *norm_ffn_g, *ada_w, *ada_b, *w_in, *w_out, *att_g, *ret_g, *fw_gate, *fw_up, *fw_down, *router_w, *mw_gate, *mw_up, *mw_down, *final_g;
};

template <class SrcFn> __device__ __forceinline__ void transpose_item(SrcFn src, int K, bf16* WT, int k0, int n0, LAS float* scr, int lane) {
#pragma unroll 8
    for (int i = 0; i < 32; ++i) { const int kk = 2 * i + (lane >> 5); scr[kk * 33 + (lane & 31)] = src(k0 + kk, n0 + (lane & 31)); }
    LDS_WAIT(); asm volatile("" ::: "memory");
    const int c = lane & 7;
#pragma unroll
    for (int j = 0; j < 4; ++j) { const int n = (lane >> 3) + 8 * j; const LAS float* s = scr + (8 * c) * 33 + n;
        v4u o; o.x = pk2(s[0 * 33], s[1 * 33]); o.y = pk2(s[2 * 33], s[3 * 33]); o.z = pk2(s[4 * 33], s[5 * 33]); o.w = pk2(s[6 * 33], s[7 * 33]);
        *(GAS v4u*)(WT + (size_t)(n0 + n) * K + k0 + 8 * c) = o; }
    LDS_WAIT(); asm volatile("" ::: "memory");
}
__device__ __forceinline__ int rot_src_col(int n) {
    if (n < 1536 || n >= 2560) return n;
    const int hb = (n - 1536) & ~127, p = (n - 1536) & 127;
    return 1536 + hb + 4 * (p >> 3) + ((p & 7) >> 1) + 64 * (p & 1);
}
constexpr int IT_WIN = 16 * 112, IT_WOUT = 16 * 32, IT_GU = 16 * 176, IT_DN = 44 * 32;
constexpr int IT_TOTAL = 2 * IT_WIN + 2 * IT_WOUT + IT_GU + IT_DN + 8 * (IT_GU + IT_DN);

constexpr int IT_NONMOE = 2 * IT_WIN + 2 * IT_WOUT + IT_GU + IT_DN;
__device__ __forceinline__ void convert_item(const Inputs& in, unsigned char* ws, int it, LAS float* scr, int lane) {
    int r = it;
    if (r < 2 * IT_WIN) { const int l = r / IT_WIN; r -= l * IT_WIN; const float* W = in.w_in + (size_t)l * 1024 * 3584;
        transpose_item([=](int k, int n) { return W[(size_t)k * 3584 + rot_src_col(n)]; }, 1024, (bf16*)(ws + WS_WIN) + (size_t)l * 3584 * 1024, 64 * (r / 112), 32 * (r % 112), scr, lane); return; }
    r -= 2 * IT_WIN;
    if (r < 2 * IT_WOUT) { const int l = r / IT_WOUT; r -= l * IT_WOUT; const float* W = in.w_out + (size_t)l * 1024 * 1024; const float* ag = in.att_g + l * 512;
        transpose_item([=](int k, int n) { return W[(size_t)k * 1024 + n] * (k < 512 ? ag[k] : 1.0f); }, 1024, (bf16*)(ws + WS_WOUT) + (size_t)l * 1024 * 1024, 64 * (r / 32), 32 * (r % 32), scr, lane); return; }
    r -= 2 * IT_WOUT;
    const float *Wg, *Wu, *Wd; bf16 *Dgu, *Ddn;
    if (r < IT_GU + IT_DN) { Wg = in.fw_gate; Wu = in.fw_up; Wd = in.fw_down; Dgu = (bf16*)(ws + WS_FGU); Ddn = (bf16*)(ws + WS_FDN); }
    else { r -= IT_GU + IT_DN; const int e = r / (IT_GU + IT_DN); r -= e * (IT_GU + IT_DN);
        Wg = in.mw_gate + (size_t)e * 1024 * 2816; Wu = in.mw_up + (size_t)e * 1024 * 2816; Wd = in.mw_down + (size_t)e * 2816 * 1024;
        Dgu = (bf16*)(ws + WS_MGU) + (size_t)e * 5632 * 1024; Ddn = (bf16*)(ws + WS_MDN) + (size_t)e * 1024 * 2816; }
    if (r < IT_GU) {
        transpose_item([=](int k, int n) { const float* W = ((n >> 7) & 1) ? Wu : Wg; return W[(size_t)k * 2816 + (n >> 8) * 128 + (n & 127)]; }, 1024, Dgu, 64 * (r / 176), 32 * (r % 176), scr, lane); return; }
    r -= IT_GU;
    transpose_item([=](int k, int n) { return Wd[(size_t)k * 1024 + n]; }, 2816, Ddn, 64 * (r / 32), 32 * (r % 32), scr, lane);
}
struct MoeItem { const float* src; bf16* dst; int ld, K, k0, n0; const float* rscale; float f8scale; };
template <int KIND  , class InP> __device__ __forceinline__ MoeItem moe_item(InP inp, unsigned char* ws, int it, int lane) {
    MoeItem m; m.rscale = nullptr; m.f8scale = (KIND == 0) ? 32.0f : 64.0f;
    if (KIND == 0) { const int e = it / IT_GU, r = it - e * IT_GU; const int kb = r / 176, nb = r % 176; const int n = 32 * nb; m.k0 = 64 * kb; m.n0 = n; m.ld = 2816; m.K = 1024;
        const float* W = (((n >> 7) & 1) ? inp->mw_up : inp->mw_gate) + (size_t)e * 1024 * 2816;
        m.src = W + (size_t)(m.k0 + (lane >> 5)) * 2816 + (n >> 8) * 128 + (n & 127) + (lane & 31); m.dst = (bf16*)(ws + WS_MGU + (size_t)e * 5632 * 1024); }
    else { const int e = it / IT_DN, r = it - e * IT_DN; const int kb = r / 32, nb = r % 32; m.k0 = 64 * kb; m.n0 = 32 * nb; m.ld = 1024; m.K = 2816;
        m.src = inp->mw_down + (size_t)e * 2816 * 1024 + (size_t)(m.k0 + (lane >> 5)) * 1024 + m.n0 + (lane & 31); m.dst = (bf16*)(ws + WS_MDN + (size_t)e * 1024 * 2816); }
    return m;
}
__device__ __forceinline__ void moe_item_load(const MoeItem& m, float (&v)[32]) {
#pragma unroll
    for (int i = 0; i < 32; ++i) v[i] = m.src[(size_t)(2 * i) * m.ld];
}
__device__ __forceinline__ void moe_item_finish(const MoeItem& m, const float (&v)[32], LAS float* scr, int lane) {
    if (m.rscale != nullptr && m.k0 < 512) {
#pragma unroll
        for (int i = 0; i < 32; ++i) scr[(2 * i + (lane >> 5)) * 33 + (lane & 31)] = v[i] * m.rscale[m.k0 + 2 * i + (lane >> 5)];
    } else {
#pragma unroll
        for (int i = 0; i < 32; ++i) scr[(2 * i + (lane >> 5)) * 33 + (lane & 31)] = v[i];
    }
    LDS_WAIT(); asm volatile("" ::: "memory");
    const int c = lane & 7;
    if (m.f8scale != 0.f) {
        const float sc = m.f8scale; unsigned char* d8 = (unsigned char*)m.dst;
#pragma unroll
        for (int j = 0; j < 4; ++j) { const int n = (lane >> 3) + 8 * j; const LAS float* s = scr + (8 * c) * 33 + n;
            v2u o; int p = 0; p = __builtin_amdgcn_cvt_pk_fp8_f32(s[0 * 33] * sc, s[1 * 33] * sc, p, false); p = __builtin_amdgcn_cvt_pk_fp8_f32(s[2 * 33] * sc, s[3 * 33] * sc, p, true); o.x = (unsigned)p;
            p = 0; p = __builtin_amdgcn_cvt_pk_fp8_f32(s[4 * 33] * sc, s[5 * 33] * sc, p, false); p = __builtin_amdgcn_cvt_pk_fp8_f32(s[6 * 33] * sc, s[7 * 33] * sc, p, true); o.y = (unsigned)p;
            *(GAS v2u*)(d8 + (size_t)(m.n0 + n) * m.K + m.k0 + 8 * c) = o; }
    } else {
#pragma unroll
        for (int j = 0; j < 4; ++j) { const int n = (lane >> 3) + 8 * j; const LAS float* s = scr + (8 * c) * 33 + n;
            v4u o; o.x = pk2(s[0 * 33], s[1 * 33]); o.y = pk2(s[2 * 33], s[3 * 33]); o.z = pk2(s[4 * 33], s[5 * 33]); o.w = pk2(s[6 * 33], s[7 * 33]);
            *(GAS v4u*)(m.dst + (size_t)(m.n0 + n) * m.K + m.k0 + 8 * c) = o; }
    }
    LDS_WAIT(); asm volatile("" ::: "memory");
}
template <class InP> __device__ __forceinline__ MoeItem base_item(InP inp, unsigned char* ws, int it, int lane) {
    MoeItem m; m.rscale = nullptr; m.f8scale = 0.f; int r = it;
    if (r < 2 * IT_WIN) { const int l = r / IT_WIN; r -= l * IT_WIN; m.k0 = 64 * (r / 112); m.n0 = 32 * (r % 112); m.ld = 3584; m.K = 1024;
        m.src = inp->w_in + (size_t)l * 1024 * 3584 + (size_t)(m.k0 + (lane >> 5)) * 3584 + rot_src_col(m.n0 + (lane & 31)); m.dst = (bf16*)(ws + WS_WIN) + (size_t)l * 3584 * 1024; return m; }
    r -= 2 * IT_WIN;
    if (r < 2 * IT_WOUT) { const int l = r / IT_WOUT; r -= l * IT_WOUT; m.k0 = 64 * (r / 32); m.n0 = 32 * (r % 32); m.ld = 1024; m.K = 1024; m.rscale = inp->att_g + l * 512;
        m.src = inp->w_out + (size_t)l * 1024 * 1024 + (size_t)(m.k0 + (lane >> 5)) * 1024 + m.n0 + (lane & 31); m.dst = (bf16*)(ws + WS_WOUT) + (size_t)l * 1024 * 1024; return m; }
    r -= 2 * IT_WOUT;
    if (r < IT_GU) { const int n = 32 * (r % 176); m.k0 = 64 * (r / 176); m.n0 = n; m.ld = 2816; m.K = 1024;
        m.src = (((n >> 7) & 1) ? inp->fw_up : inp->fw_gate) + (size_t)(m.k0 + (lane >> 5)) * 2816 + (n >> 8) * 128 + (n & 127) + (lane & 31); m.dst = (bf16*)(ws + WS_FGU); m.f8scale = 32.0f; return m; }
    r -= IT_GU; m.k0 = 64 * (r / 32); m.n0 = 32 * (r % 32); m.ld = 1024; m.K = 2816;
    m.src = inp->fw_down + (size_t)(m.k0 + (lane >> 5)) * 1024 + m.n0 + (lane & 31); m.dst = (bf16*)(ws + WS_FDN); m.f8scale = 64.0f; return m;
}
template <class InP> __device__ __forceinline__ void convert_base_all(InP inp, unsigned char* ws, LAS unsigned char* lds, int gw, int NGW, int wave, int lane) {
    LAS float* scr = (LAS float*)(lds + wave * 16384);
    int it = gw; if (it >= IT_NONMOE) return;
    float va[32], vb[32];
    MoeItem ma = base_item(inp, ws, it, lane), mb = ma; moe_item_load(ma, va);
    for (;;) {
        const bool hb = (it + NGW) < IT_NONMOE; if (hb) { mb = base_item(inp, ws, it + NGW, lane); moe_item_load(mb, vb); }
        moe_item_finish(ma, va, scr, lane);
        if (!hb) break;
        it += NGW;
        const bool ha = (it + NGW) < IT_NONMOE; if (ha) { ma = base_item(inp, ws, it + NGW, lane); moe_item_load(ma, va); }
        moe_item_finish(mb, vb, scr, lane);
        if (!ha) break;
        it += NGW;
    }
}
template <int KIND, class InP> __device__ __forceinline__ void convert_moe_range(InP inp, unsigned char* ws, LAS unsigned char* lds, int it0, int it1, int sp, int nsp, int wave, int lane) {
    LAS float* scr = (LAS float*)(lds + wave * 16384);
    const int step = nsp * NWAVES; int it = it0 + sp * NWAVES + wave;
    if (it >= it1) return;
    float va[32], vb[32];
    MoeItem ma = moe_item<KIND>(inp, ws, it, lane), mb = ma; moe_item_load(ma, va);
    for (;;) {
        const bool hb = (it + step) < it1; if (hb) { mb = moe_item<KIND>(inp, ws, it + step, lane); moe_item_load(mb, vb); }
        moe_item_finish(ma, va, scr, lane);
        if (!hb) break;
        it += step;
        const bool ha = (it + step) < it1; if (ha) { ma = moe_item<KIND>(inp, ws, it + step, lane); moe_item_load(ma, va); }
        moe_item_finish(mb, vb, scr, lane);
        if (!ha) break;
        it += step;
    }
}
constexpr int IT_MOE = 8 * (IT_GU + IT_DN);
constexpr int G_INPROJ = 224, G_GUD = 240;
#ifndef MOE_SPARE
#define MOE_SPARE 0
#endif
constexpr int IT_MGU = 8 * IT_GU, IT_MDN = 8 * IT_DN;
#ifndef SPLIT_A
#define SPLIT_A 15000
#define SPLIT_B 22528
#define SPLIT_C 11264
#endif
constexpr int IT_MOE_A = SPLIT_A, IT_MOE_B = SPLIT_B, IT_MDN_C = SPLIT_C;

template <class InP> __device__ __forceinline__ void p0_prologue(InP inp, unsigned char* ws, LAS unsigned char* lds, int vcu, int G, int wave, int lane, int tid, int moe_w) {
    Inputs in; in.c = inp->c; in.ada_w = inp->ada_w; in.ada_b = inp->ada_b; in.w_in = inp->w_in; in.w_out = inp->w_out; in.att_g = inp->att_g; in.fw_gate = inp->fw_gate; in.fw_up = inp->fw_up; in.fw_down = inp->fw_down; in.mw_gate = inp->mw_gate; in.mw_up = inp->mw_up; in.mw_down = inp->mw_down;
    if (vcu < 192) {
        LAS float* cs = (LAS float*)lds;
        LAS float* part = (LAS float*)(lds + 32768);
        for (int i = tid; i < 8 * 1024; i += 512) { const float v = in.c[i]; cs[i] = v / (1.0f + __expf(-v)); }
        __syncthreads();
        const int n0 = vcu * 64, l = n0 / 6144, nn = n0 % 6144 + lane;
        const float* wp = in.ada_w + (size_t)l * 1024 * 6144 + (size_t)(wave * 128) * 6144 + nn;
        float acc[8];
#pragma unroll
        for (int b = 0; b < 8; ++b) acc[b] = 0.f;
#pragma unroll 8
        for (int k = 0; k < 128; ++k) { const float wv = wp[(size_t)k * 6144];
#pragma unroll
            for (int b = 0; b < 8; ++b) acc[b] += cs[b * 1024 + wave * 128 + k] * wv; }
#pragma unroll
        for (int b = 0; b < 8; ++b) part[(wave * 8 + b) * 64 + lane] = acc[b];
        __syncthreads();
        { const int b = tid >> 6; float s = 0.f;
#pragma unroll
          for (int w = 0; w < 8; ++w) s += part[(w * 8 + b) * 64 + lane];
          ((float*)(ws + WS_MOD))[((size_t)l * 8 + b) * 6144 + nn] = s + in.ada_b[l * 6144 + nn]; }
        __syncthreads();
    }
    { const int g = vcu * 512 + tid; if (g < 2048 * 64) { const int pos = g >> 6, i = g & 63; const float inv = powf(10000.0f, -(float)i / 64.0f); const float ang = (float)pos * inv;
        float* rp = (float*)(ws + WS_ROPE) + (size_t)g * 2; rp[0] = (float)cos((double)ang); rp[1] = (float)sin((double)ang); } }
    convert_base_all(inp, ws, lds, vcu * NWAVES + wave, G * NWAVES, wave, lane);
}

template <int MODE>
__device__ __forceinline__ void norm_pass(const float* xsrc, const float* gain, const float* sh, const float* sc, bf16* dst,
                                          const float* router_w, int* eidx, float* ew, int* wcnt, int gw, int lane) {
    const int m0 = gw * 8, b = m0 >> 11;
    f32x4 gv[4], scv[4], shv[4];
#pragma unroll
    for (int j = 0; j < 4; ++j) { gv[j] = ((const f32x4*)gain)[lane + 64 * j]; scv[j] = ((const f32x4*)(sc + (size_t)b * 6144))[lane + 64 * j] + 1.0f; shv[j] = ((const f32x4*)(sh + (size_t)b * 6144))[lane + 64 * j]; }
    int cnt[8];
#pragma unroll
    for (int e = 0; e < 8; ++e) cnt[e] = 0;
    f32x4 rw[4][4][2];
    if (MODE == 1) {
#pragma unroll
        for (int j = 0; j < 4; ++j)
#pragma unroll
            for (int c = 0; c < 4; ++c) { const float* wp = router_w + (size_t)(4 * (lane + 64 * j) + c) * 8; rw[j][c][0] = *(const f32x4*)wp; rw[j][c][1] = *(const f32x4*)(wp + 4); }
    }
    for (int i = 0; i < 8; ++i) {
        const int m = m0 + i;
        const f32x4* xr = (const f32x4*)(xsrc + (size_t)m * 1024) + lane;
        f32x4 v[4]; float s = 0.f;
#pragma unroll
        for (int j = 0; j < 4; ++j) { v[j] = xr[64 * j]; s += (v[j][0] * v[j][0] + v[j][1] * v[j][1]) + (v[j][2] * v[j][2] + v[j][3] * v[j][3]); }
        const float rs = 1.0f / sqrtf(wave_sum(s) * (1.0f / 1024.0f) + 1e-6f);
        if (MODE == 2) {
            unsigned* o4 = (unsigned*)((unsigned char*)dst + (size_t)m * 1024) + lane;
#pragma unroll
            for (int j = 0; j < 4; ++j) { v[j] = v[j] * rs * gv[j] * scv[j] + shv[j]; o4[64 * j] = epi::pk4_fp8(v[j][0], v[j][1], v[j][2], v[j][3]); }
        } else {
        v2u* o8 = (v2u*)(dst + (size_t)m * 1024) + lane;
#pragma unroll
        for (int j = 0; j < 4; ++j) { v[j] = v[j] * rs * gv[j] * scv[j] + shv[j]; v2u w; w.x = pk2(v[j][0], v[j][1]); w.y = pk2(v[j][2], v[j][3]); o8[64 * j] = w; }
        }
        if (MODE == 1) {
            float lg[8];
#pragma unroll
            for (int e = 0; e < 8; ++e) lg[e] = 0.f;
#pragma unroll
            for (int j = 0; j < 4; ++j)
#pragma unroll
                for (int c = 0; c < 4; ++c) { const f32x4 w0 = rw[j][c][0], w1 = rw[j][c][1];
                    const float hv = v[j][c];
                    lg[0] += hv * w0[0]; lg[1] += hv * w0[1]; lg[2] += hv * w0[2]; lg[3] += hv * w0[3]; lg[4] += hv * w1[0]; lg[5] += hv * w1[1]; lg[6] += hv * w1[2]; lg[7] += hv * w1[3]; }
            { const bool b5 = (lane & 32) != 0, b4 = (lane & 16) != 0, b3 = (lane & 8) != 0;
              float a4[4], b2[2], c1;
#pragma unroll
              for (int q = 0; q < 4; ++q) { const float keep = b5 ? lg[4 + q] : lg[q], send = b5 ? lg[q] : lg[4 + q]; a4[q] = keep + xl::xor32p(send, b5); }
#pragma unroll
              for (int q = 0; q < 2; ++q) { const float keep = b4 ? a4[2 + q] : a4[q], send = b4 ? a4[q] : a4[2 + q]; b2[q] = keep + xl::xor_f<16>(send); }
              { const float keep = b3 ? b2[1] : b2[0], send = b3 ? b2[0] : b2[1]; c1 = keep + xl::xor_f<8>(send); }
              c1 += xl::xor_f<4>(c1); c1 += xl::xor_f<2>(c1); c1 += xl::xor_f<1>(c1);
#pragma unroll
              for (int e = 0; e < 8; ++e) lg[e] = __builtin_bit_cast(float, __builtin_amdgcn_readlane(__builtin_bit_cast(int, c1), 8 * e)); }
            int i0 = 0; float b0 = lg[0];
#pragma unroll
            for (int e = 1; e < 8; ++e) if (lg[e] > b0) { b0 = lg[e]; i0 = e; }
            int i1 = -1; float b1 = -3.0e38f;
#pragma unroll
            for (int e = 0; e < 8; ++e) if (e != i0 && lg[e] > b1) { b1 = lg[e]; i1 = e; }
            const float e1 = __expf(b1 - b0);
#pragma unroll
            for (int e = 0; e < 8; ++e) cnt[e] += ((e == i0) ? 1 : 0) + ((e == i1) ? 1 : 0);
            if (lane == 0) { eidx[m * 2] = i0; eidx[m * 2 + 1] = i1; ew[m * 2] = 1.0f / (1.0f + e1); ew[m * 2 + 1] = e1 / (1.0f + e1); }
        }
    }
    if (MODE == 1) {
        int myc = 0;
#pragma unroll
        for (int e = 0; e < 8; ++e) myc = (lane == e) ? cnt[e] : myc;
        if (lane < 8) wcnt[gw * 8 + lane] = myc;
    }
}

__device__ __forceinline__ void place_pass(const int* wcnt, const int* eidx, const float* ew, const bf16* XA, bf16* XS, int* srow, float* swt, int* segout, int gw, int NGW, int lane) {
    int tot[8], pre[8];
#pragma unroll
    for (int e = 0; e < 8; ++e) { tot[e] = 0; pre[e] = 0; }
    for (int w = lane; w < NGW; w += 64) { const i32x4 a = *(const i32x4*)(wcnt + w * 8), c = *(const i32x4*)(wcnt + w * 8 + 4); const int inc = (w < gw) ? 1 : 0;
        tot[0] += a[0]; tot[1] += a[1]; tot[2] += a[2]; tot[3] += a[3]; tot[4] += c[0]; tot[5] += c[1]; tot[6] += c[2]; tot[7] += c[3];
        pre[0] += inc * a[0]; pre[1] += inc * a[1]; pre[2] += inc * a[2]; pre[3] += inc * a[3]; pre[4] += inc * c[0]; pre[5] += inc * c[1]; pre[6] += inc * c[2]; pre[7] += inc * c[3]; }
    int base[8]; int run = 0;
#pragma unroll
    for (int e = 0; e < 8; ++e) { tot[e] = wave_sum_i(tot[e]); pre[e] = wave_sum_i(pre[e]); base[e] = run + pre[e]; if (gw == 0 && lane == 0) segout[e] = run; run += (tot[e] + 255) & ~255; }
    if (gw == 0 && lane == 0) segout[8] = run;
    const int myev = (lane < 16) ? eidx[gw * 16 + lane] : 0; const float myw = (lane < 16) ? ew[gw * 16 + lane] : 0.f;
    int mypos = 0;
#pragma unroll
    for (int i = 0; i < 16; ++i) { const int ev = __builtin_amdgcn_readlane(myev, i); int pos = 0;
#pragma unroll
        for (int e = 0; e < 8; ++e) if (ev == e) { pos = base[e]; base[e] += 1; }
        mypos = (lane == i) ? pos : mypos; }
    if (lane < 16) { srow[mypos] = gw * 16 + lane; swt[mypos] = myw; }
    const v4u* __restrict__ s = (const v4u*)(XA + (size_t)(gw * 8) * 1024);
    v4u r0[8], r1[8];
#pragma unroll
    for (int t = 0; t < 8; ++t) { r0[t] = s[t * 128 + lane]; r1[t] = s[t * 128 + lane + 64]; }
    v2u q0[8], q1[8];
#pragma unroll
    for (int t = 0; t < 8; ++t) {
        { int p = 0; p = __builtin_amdgcn_cvt_pk_fp8_f32(h16::lo(r0[t].x), h16::hi(r0[t].x), p, false); p = __builtin_amdgcn_cvt_pk_fp8_f32(h16::lo(r0[t].y), h16::hi(r0[t].y), p, true); q0[t].x = (unsigned)p;
          p = 0; p = __builtin_amdgcn_cvt_pk_fp8_f32(h16::lo(r0[t].z), h16::hi(r0[t].z), p, false); p = __builtin_amdgcn_cvt_pk_fp8_f32(h16::lo(r0[t].w), h16::hi(r0[t].w), p, true); q0[t].y = (unsigned)p; }
        { int p = 0; p = __builtin_amdgcn_cvt_pk_fp8_f32(h16::lo(r1[t].x), h16::hi(r1[t].x), p, false); p = __builtin_amdgcn_cvt_pk_fp8_f32(h16::lo(r1[t].y), h16::hi(r1[t].y), p, true); q1[t].x = (unsigned)p;
          p = 0; p = __builtin_amdgcn_cvt_pk_fp8_f32(h16::lo(r1[t].z), h16::hi(r1[t].z), p, false); p = __builtin_amdgcn_cvt_pk_fp8_f32(h16::lo(r1[t].w), h16::hi(r1[t].w), p, true); q1[t].y = (unsigned)p; } }
#pragma unroll
    for (int i = 0; i < 16; ++i) { const int pos = __builtin_amdgcn_readlane(mypos, i); v2u* __restrict__ d = (v2u*)((unsigned char*)XS + (size_t)pos * 1024);
        d[lane] = q0[i >> 1]; d[lane + 64] = q1[i >> 1]; }
}

__device__ __forceinline__ void final_pass(float* xio, const bf16* YS, const int* atomf, const float* slab, const float* g2, const float* fg, int gw, int lane) {
    const int m0 = gw * 8, b = m0 >> 11;
    f32x4 gv[4], g2v[4];
#pragma unroll
    for (int j = 0; j < 4; ++j) { gv[j] = ((const f32x4*)fg)[lane + 64 * j]; g2v[j] = ((const f32x4*)(g2 + (size_t)b * 6144))[lane + 64 * j]; }
    for (int i = 0; i < 8; ++i) {
        const int m = m0 + i;
        f32x4* xr = (f32x4*)(xio + (size_t)m * 1024) + lane;
        const v2u* y0 = (const v2u*)(YS + (size_t)(2 * m) * 1024) + lane; const v2u* y1 = (const v2u*)(YS + (size_t)(2 * m + 1) * 1024) + lane;
        f32x4 v[4]; float s = 0.f; const i32x4 f0 = *(const i32x4*)(atomf + (size_t)(2 * m) * 4), f1 = *(const i32x4*)(atomf + (size_t)(2 * m + 1) * 4);
#pragma unroll
        for (int j = 0; j < 4; ++j) { v[j] = xr[64 * j]; const v2u a = y0[64 * j], c = y1[64 * j];
            f32x4 ya, yc;
            if (f0[j]) { const int id = f0[j] - 1; const float* sp = slab + ((size_t)((id >> 8) * 11) * 256 + (id & 255)) * 256 + 4 * lane; ya = (f32x4){0.f, 0.f, 0.f, 0.f};
                for (int kc = 0; kc < 11; ++kc) ya += *(const f32x4*)(sp + (size_t)kc * 65536); }
            else { ya[0] = h16::lo(a.x); ya[1] = h16::hi(a.x); ya[2] = h16::lo(a.y); ya[3] = h16::hi(a.y); }
            if (f1[j]) { const int id = f1[j] - 1; const float* sp = slab + ((size_t)((id >> 8) * 11) * 256 + (id & 255)) * 256 + 4 * lane; yc = (f32x4){0.f, 0.f, 0.f, 0.f};
                for (int kc = 0; kc < 11; ++kc) yc += *(const f32x4*)(sp + (size_t)kc * 65536); }
            else { yc[0] = h16::lo(c.x); yc[1] = h16::hi(c.x); yc[2] = h16::lo(c.y); yc[3] = h16::hi(c.y); }
            const f32x4 ys = ya + yc;
            v[j] = v[j] + g2v[j] * ys; s += (v[j][0] * v[j][0] + v[j][1] * v[j][1]) + (v[j][2] * v[j][2] + v[j][3] * v[j][3]); }
        const float rs = 1.0f / sqrtf(wave_sum(s) * (1.0f / 1024.0f) + 1e-6f);
#pragma unroll
        for (int j = 0; j < 4; ++j) xr[64 * j] = v[j] * rs * gv[j];
    }
}

constexpr int N_PHASES = 18;
struct Args { Inputs in; float* out; unsigned char* ws; int ph_lo, ph_hi, bar_region, moe_w; };

typedef const Args __attribute__((address_space(4))) CArgs;
__device__ __forceinline__ CArgs* kargs() { unsigned long off = 0; asm volatile("" : "+s"(off)); return (CArgs*)((const char __attribute__((address_space(4)))*)__builtin_amdgcn_kernarg_segment_ptr() + off); }

__global__ void __launch_bounds__(NWAVES * 64, 2) mega(Args args_unused) {
    extern __shared__ __attribute__((aligned(16))) unsigned char lds_raw[];
    LAS unsigned char* lds = (LAS unsigned char*)lds_raw;
    volatile LAS unsigned* MISC = (volatile LAS unsigned*)(lds + MISC_OFF);
    const int G = gridDim.x;
#define PHASE_IDS int tid = otid(WV); int bx = blockIdx.x; asm volatile("" : "+s"(bx)); const int lane = tid & 63, wave = __builtin_amdgcn_readfirstlane(tid >> 6); \
    const int vcu = (bx & 7) * (G >> 3) + (bx >> 3); const int gw = vcu * NWAVES + wave; (void)lane; (void)gw; (void)vcu;
    const int WV = __builtin_amdgcn_readfirstlane((int)threadIdx.x >> 6);
    for (int u = otid(WV); u < (LDS_BYTES - LDSCTL_OFF) / 4; u += NWAVES * 64) ((LAS unsigned*)(lds + LDSCTL_OFF))[u] = 0u;
    __syncthreads();
    XcdBarrier bar;
    { CArgs* ka = kargs(); unsigned* barw = (unsigned*)(ka->ws + WS_CTL) + CW_BAR + ka->bar_region * XCD_BAR_WORDS; bar = xcd_barrier_post(barw, MISC + 8, WV); }
    int lo, hi; { CArgs* ka = kargs(); lo = ka->ph_lo; hi = ka->ph_hi; }
#ifndef PHM
#define PHM 0x3ff
#endif
#define IN(k) (lo <= (k) && (k) < hi)
#define TY(t) (((PHM) >> (t)) & 1)
#ifndef DUP_T
#define DUP_T -1
#define DUP_N 0
#endif
#define REP(t) for (int rep_ = 0; rep_ < ((t) == DUP_T ? 1 + DUP_N : 1) && (rep_ == 0 || (__syncthreads(), true)); ++rep_)
#ifdef TPROBE
    volatile LAS unsigned long long* TS = (volatile LAS unsigned long long*)(lds + MISC_OFF + 256);
#define STAMP(k) do { if (blockIdx.x == 0 && threadIdx.x == 0) TS[(k)] = __builtin_amdgcn_s_memrealtime(); } while (0)
#else
#define STAMP(k) do {} while (0)
#endif
    STAMP(0);
#define SEAM(k) do { if (IN(k) && IN((k) + 1)) xcd_barrier(bar); STAMP((k) + 1); } while (0)

    if (TY(0) && IN(0)) REP(0) { PHASE_IDS CArgs* ka = kargs(); p0_prologue(&ka->in, ka->ws, lds, vcu, G, wave, lane, tid, 0); }
    SEAM(0);
#ifdef PROBE_BAR
    for (int q = 0; q < PROBE_BAR; ++q) xcd_barrier(bar);
#endif
    for (int l = 0; l < 2; ++l) {
        const int pb = 1 + 8 * l;
        if (TY(1) && IN(pb + 0)) REP(1) { PHASE_IDS CArgs* ka = kargs(); unsigned char* ws = ka->ws; const float* mod = (const float*)(ws + WS_MOD) + (size_t)l * 8 * 6144;
            const float* xin = (l == 0) ? ka->in.x : (const float*)ka->out;
            if (gw < 2048) norm_pass<0>(xin, ka->in.norm_mix_g + l * 1024, mod + 0 * 1024, mod + 1 * 1024, (bf16*)(ws + WS_XA), nullptr, nullptr, nullptr, nullptr, gw, lane); }
        SEAM(pb + 0);
        if (TY(2) && IN(pb + 1)) REP(2) { PHASE_IDS CArgs* ka = kargs(); unsigned char* ws = ka->ws;
            if (bx < G_INPROJ) {
                pg8::Gemm g{1024, 1024, 1024}; pg8::DenseSched S; S.init(ws + WS_XA, 1024, (bf16*)(ws + WS_WIN) + (size_t)l * 3584 * 1024, 1024, 16384, 3584, G_INPROJ, bx);
                epi::EpiInProj E{(bf16*)(ws + WS_QKV), (size_t)16384 * 512, (float*)(ws + WS_KMP), (const float*)(ws + WS_ROPE)};
                pg8::gemm_phase(WV, lds, g, S, E);
            } else if (rep_ == 0) { convert_moe_range<0>(&ka->in, ws, lds, l == 0 ? 0 : IT_MOE_B, l == 0 ? IT_MOE_A : IT_MGU, bx - G_INPROJ, G - G_INPROJ, wave, lane);
                                    if (l == 1) convert_moe_range<1>(&ka->in, ws, lds, 0, IT_MDN_C, bx - G_INPROJ, G - G_INPROJ, wave, lane); }
        }
        SEAM(pb + 1);
        if (TY(3) && IN(pb + 2)) REP(3) { PHASE_IDS CArgs* ka = kargs(); unsigned char* ws = ka->ws; bf16* QKV = (bf16*)(ws + WS_QKV); bf16* CAT = (bf16*)(ws + WS_CAT);
            if (G == 256) {
                if ((bx & 7) < 7) fa::kv_unit(WV, bx >> 5, (bx >> 3) & 3, bx & 7, QKV + (size_t)4 * 16384 * 512, QKV + (size_t)5 * 16384 * 512, (float*)(ws + WS_KVM), lds);
                xcd_barrier(bar);
                { fa::Tensors TR{QKV + (size_t)3 * 16384 * 512, QKV + (size_t)4 * 16384 * 512, QKV + (size_t)5 * 16384 * 512, CAT, (float*)(ws + WS_ASSQ), (const float*)(ws + WS_KMP), QKV + (size_t)6 * 16384 * 512, ka->in.ret_g + l * 512, (const float*)(ws + WS_KVM)};
                  fa::attn_unit<true>(WV, bx >> 5, (bx >> 3) & 3, bx & 7, TR, lds); }
                fa::Tensors TA{QKV, QKV + (size_t)1 * 16384 * 512, QKV + (size_t)2 * 16384 * 512, CAT, (float*)(ws + WS_ASSQ), (const float*)(ws + WS_KMP), nullptr, nullptr, nullptr};
                const int bh = bx >> 2, pr = bx & 3;
                for (int uu = 0; uu < 2; ++uu) fa::attn_unit<false>(WV, bh >> 3, bh & 7, uu == 0 ? 7 - pr : pr, TA, lds);
            }
        }
        SEAM(pb + 2);
        if (TY(4) && IN(pb + 3)) REP(4) {
            { PHASE_IDS CArgs* ka = kargs(); unsigned char* ws = ka->ws; const float* mod = (const float*)(ws + WS_MOD) + (size_t)l * 8 * 6144;
                const float* xin = (l == 0) ? ka->in.x : (const float*)ka->out;
                pg8::Gemm g{1024, 1024, 1024}; pg8::DenseSched S; S.init(ws + WS_CAT, 1024, (const bf16*)(ws + WS_WOUT) + (size_t)l * 1024 * 1024, 1024, 16384, 1024, G, bx);
                epi::EpiOutProj E{xin, ka->out, mod + 2 * 1024, (const float*)(ws + WS_ASSQ), rep_ > 0}; pg8::gemm_phase(WV, lds, g, S, E); }
        }
        SEAM(pb + 3);
        if (TY(5) && IN(pb + 4)) REP(5) { PHASE_IDS CArgs* ka = kargs(); unsigned char* ws = ka->ws; const float* mod = (const float*)(ws + WS_MOD) + (size_t)l * 8 * 6144;
            if (gw < 2048) {
                if (l == 0) norm_pass<2>(ka->out, ka->in.norm_ffn_g + l * 1024, mod + 3 * 1024, mod + 4 * 1024, (bf16*)(ws + WS_XA), nullptr, nullptr, nullptr, nullptr, gw, lane);
                else norm_pass<1>(ka->out, ka->in.norm_ffn_g + l * 1024, mod + 3 * 1024, mod + 4 * 1024, (bf16*)(ws + WS_XA), ka->in.router_w, (int*)(ws + WS_EIDX), (float*)(ws + WS_EW), (int*)(ws + WS_WCNT), gw, lane);
            }
            if (l == 1) { int* srow = (int*)(ws + WS_SROW); int* af = (int*)(ws + WS_ATOMF);
                { const int p = bx * 512 + tid; if (p < XS_ROWS) srow[p] = -1; af[p] = 0; }
            }
            else if (bx == 0 && tid < 9) { ((int*)(ws + WS_SEGD))[tid] = (tid == 0) ? 0 : ((tid == 8) ? 16384 : (1 << 30)); }
        }
        SEAM(pb + 4);
        if (l == 1) {
            if (TY(6) && IN(pb + 5)) REP(6) { PHASE_IDS CArgs* ka = kargs(); unsigned char* ws = ka->ws;
                if (gw < 2048) place_pass((const int*)(ws + WS_WCNT), (const int*)(ws + WS_EIDX), (const float*)(ws + WS_EW), (const bf16*)(ws + WS_XA), (bf16*)(ws + WS_XS), (int*)(ws + WS_SROW), (float*)(ws + WS_SWT), (int*)(ws + WS_SEG), gw, 2048, lane); }
            SEAM(pb + 5);
        } else { STAMP(pb + 6); }
        if (TY(7) && IN(pb + 6)) REP(7) { PHASE_IDS CArgs* ka = kargs(); unsigned char* ws = ka->ws;
            int Geff = G_GUD;
            if (l == 1) { const int nwg = (__builtin_amdgcn_readfirstlane(((const int*)(ws + WS_SEG))[8]) / 256) * 22; const int rounds = (nwg + G - 1) / G;
                Geff = (((nwg + rounds - 1) / rounds) + 7) & ~7; if (Geff > G - MOE_SPARE) Geff = G - MOE_SPARE; }
            if (bx < Geff) {
                pg8::Gemm g{512, 512, 512}; pg8::MoeSched S;
                S.init(ws + (l == 0 ? WS_XA : WS_XS), 512, ws + (l == 0 ? WS_FGU : WS_MGU), 512, (size_t)5632 * 1024, (const int*)(ws + (l == 0 ? WS_SEGD : WS_SEG)), 5632, Geff, bx);
                epi::EpiSwiGLU8 E{ws + (l == 0 ? WS_HD : WS_HM), 2816}; pg8::gemm_phase(WV, lds, g, S, E);
            } else if (rep_ == 0) { if (l == 0) convert_moe_range<0>(&ka->in, ws, lds, IT_MOE_A, IT_MOE_B, bx - Geff, G - Geff, wave, lane);
                                    else { convert_moe_range<1>(&ka->in, ws, lds, IT_MDN_C, IT_MDN, bx - Geff, G - Geff, wave, lane);
#ifdef PROBE_CONV2
                                           __syncthreads(); convert_moe_range<1>(&ka->in, ws, lds, IT_MDN_C, IT_MDN, bx - Geff, G - Geff, wave, lane);
#endif
                                    } }
        }
        SEAM(pb + 6);
        if (TY(8) && IN(pb + 7)) REP(8) { PHASE_IDS CArgs* ka = kargs(); unsigned char* ws = ka->ws; const float* mod = (const float*)(ws + WS_MOD) + (size_t)l * 8 * 6144;
            if (l == 0) { pg8::MoeSched S; S.init(ws + WS_HD, 1408, ws + WS_FDN, 1408, (size_t)1024 * 2816, (const int*)(ws + WS_SEGD), 1024, G, bx);
                pg8::Gemm g{1408, 1408, 1408};
                epi::EpiDownDense8 E{ka->out, mod + 5 * 1024, rep_ > 0}; pg8::gemm_phase(WV, lds, g, S, E);
            } else {
                pg8::MoeSched S; S.init(ws + WS_HM, 1408, ws + WS_MDN, 1408, (size_t)1024 * 2816, (const int*)(ws + WS_SEG), 1024, G, bx);
                pg8::Gemm g{1408, 1408, 1408};
                epi::EpiDownMoe8 E{(bf16*)(ws + WS_YS), (const int*)(ws + WS_SROW), (const float*)(ws + WS_SWT)}; pg8::gemm_phase(WV, lds, g, S, E);
            }
        }
        SEAM(pb + 7);
    }
    if (TY(9) && IN(17)) { PHASE_IDS CArgs* ka = kargs(); unsigned char* ws = ka->ws;
        if (gw < 2048) final_pass(ka->out, (const bf16*)(ws + WS_YS), (const int*)(ws + WS_ATOMF), (const float*)(ws + WS_SLAB), (const float*)(ws + WS_MOD) + (size_t)1 * 8 * 6144 + 5 * 1024, ka->in.final_g, gw, lane); }
#ifdef TPROBE
    xcd_barrier(bar); STAMP(18); __syncthreads();
    if (blockIdx.x == 0) { CArgs* ka = kargs(); float* o = ka->out;
        const float d1 = (float)(TS[TPROBE_A + 1] - TS[TPROBE_A]) * 0.01f, d2 = (float)(TS[TPROBE_B + 1] - TS[TPROBE_B]) * 0.01f;
        const float a = 4.0f * sqrtf(d1);
        for (int i = threadIdx.x; i < 1024 * 1024; i += 512) o[i] = a;
        if (threadIdx.x == 0) o[1024 * 1024 + 5] = 100.0f * d2; }
#endif
#undef IN
#undef TY
#undef SEAM
#undef PHASE_IDS
}
}
#ifndef STEP
#define STEP 5
#endif
namespace ad {
__device__ __forceinline__ float bf2f(unsigned short s) { return h16::one(s); }
__global__ void __launch_bounds__(256) ad_proj(const unsigned short* QKV, size_t gstride, int b, float* projb) {
    const int m = blockIdx.x; const size_t row = (size_t)b * 2048 + m;
    for (int n = threadIdx.x; n < 3584; n += 256) {
        const int grp = n / 512, c = n % 512; int sc = c;
        if (grp == 3 || grp == 4) { const int head = c >> 7, d = c & 127; sc = head * 128 + 8 * ((d & 63) >> 2) + 2 * (d & 3) + (d >> 6); }
        float v = bf2f(QKV[(size_t)grp * gstride + row * 512 + sc]);
        if (grp == 0) v *= (1.0f / epi::C2);
        if (grp == 4) v *= (1.0f / epi::KSC);
        projb[(size_t)m * 3584 + n] = v;
    }
}
__global__ void __launch_bounds__(64) ad_kmean(const float* KMP, int b, float* kmeanb) {
    const int blk = blockIdx.x, h = blockIdx.y, d = threadIdx.x;
    const float* p = KMP + ((size_t)(b * 8 + blk) * 2) * 512 + h * 64 + d;
    kmeanb[((size_t)h * 8 + blk) * 64 + d] = (p[0] + p[512]) * (1.0f / 256.0f);
}
__global__ void __launch_bounds__(256) ad_cat(const unsigned short* CAT, const float* ASSQ, const float* att_g, int b, float* catb) {
    const int m = blockIdx.x; const size_t row = (size_t)b * 2048 + m;
    float ss = 0.f;
    for (int h = 0; h < 8; ++h) ss += ASSQ[row * 8 + h];
    const float rs = 1.0f / sqrtf(ss * (1.0f / 512.0f) + 1e-6f);
    for (int c = threadIdx.x; c < 1024; c += 256) { const float v = bf2f(CAT[row * 1024 + c]); catb[(size_t)m * 1024 + c] = (c < 512) ? v * rs * att_g[c] : v; }
}
__global__ void __launch_bounds__(256) dbg_cmp(const float* a, const float* b, size_t n, float rel, float abs_, unsigned* flag, int ncols = 1, int c_lo = 0, int c_hi = 1, int silu_b = 0) {
    unsigned bad = 0;
    for (size_t i = (size_t)blockIdx.x * 256 + threadIdx.x; i < n; i += (size_t)gridDim.x * 256) { const int c = (int)(i % ncols); if (c < c_lo || c >= c_hi) continue;
        float bv = b[i]; if (silu_b) bv = bv / (1.f + expf(-bv)); const float d = fabsf(a[i] - bv); if (!(d <= rel * fabsf(bv) + abs_)) ++bad; }
    if (bad) atomicAdd(flag, bad);
}
__global__ void __launch_bounds__(256) dbg_poison(const unsigned* flag, unsigned thresh, float* out, float val) {
    if (*flag > thresh) for (int i = threadIdx.x; i < 1024 * 1024; i += 256) out[i] = val;
}
__global__ void __launch_bounds__(256) dbg_ssd(const float* a, const float* b, size_t n, int ncols, int c_lo, int c_hi, float* acc) {
    float s = 0.f;
    for (size_t i = (size_t)blockIdx.x * 256 + threadIdx.x; i < n; i += (size_t)gridDim.x * 256) { const int c = (int)(i % ncols); if (c < c_lo || c >= c_hi) continue; const float d = a[i] - b[i]; s += d * d; }
    atomicAdd(acc, s);
}
__global__ void __launch_bounds__(256) dbg_encode(const float* acc, float count, float* out) {
    const float mse = *acc / count; const float val = 4.0f / sqrtf(mse);
    for (int i = threadIdx.x; i < 1024 * 1024; i += 256) out[i] = val;
}
}

static void launch_mega(const mk::Args& a0, int lo, int hi, int region, hipStream_t stream) {
    mk::Args a = a0; a.ph_lo = lo; a.ph_hi = hi; a.bar_region = region;
    hipLaunchKernelGGL(mk::mega, dim3(256), dim3(512), mk::LDS_BYTES, stream, a);
}

extern "C" void kernel_launch(void* const* d_in, const int* in_sizes, int n_in, void* d_out, int out_size, void* d_ws, size_t ws_size, hipStream_t stream) {
    static int ready = 0;
    if (ready == 0) {
        if (n_in != 18 || out_size != M * D || ws_size < mk::WS_END) { fprintf(stderr, "kernel_launch: unexpected problem (n_in %d, out %d, ws %zu)\n", n_in, out_size, ws_size); ready = -1; return; }
        if (hipFuncSetAttribute((const void*)mk::mega, hipFuncAttributeMaxDynamicSharedMemorySize, mk::LDS_BYTES) != hipSuccess) { fprintf(stderr, "kernel_launch: hipFuncSetAttribute failed\n"); ready = -1; return; }
        ready = 1;
    }
    if (ready < 0) return;
    mk::Args a{};
    const float** ip = (const float**)&a.in;
    for (int i = 0; i < 18; ++i) ip[i] = (const float*)d_in[i];
    a.out = (float*)d_out; a.ws = (unsigned char*)d_ws; a.moe_w = (STEP >= 5) ? 1 : 0;
    const mk::Inputs& in = a.in;
    float* out = (float*)d_out; unsigned char* ws = (unsigned char*)d_ws;
    hipMemsetAsync(ws + mk::WS_CTL, 0, mk::CTL_ZERO_BYTES, stream);
#if STEP >= 6
    launch_mega(a, 0, mk::N_PHASES, 0, stream);
#else
    constexpr size_t MiB = 1u << 20;
    unsigned char* na = ws + 8 * MiB;
    float* PROJb = (float*)(na);
    float* Hb = (float*)(na + 28 * MiB);
    float* CATb = (float*)(na + 36 * MiB);
    float* OAb = (float*)(na + 44 * MiB);
    float* ORRb = (float*)(na + 48 * MiB);
    float* KMEANb = (float*)(na + 52 * MiB);
    int* EIDXb = (int*)(na + 53 * MiB); float* EWb = (float*)(na + 53 * MiB + 65536); int* POSb = (int*)(na + 53 * MiB + 131072); int* LISTb = (int*)(na + 53 * MiB + 196608);
    int* CNTb = (int*)(na + 54 * MiB); int* BASEb = CNTb + 16;
    float* Gb = (float*)(na + 56 * MiB);
    float* Ub = (float*)(na + 78 * MiB);
    float* Yb = (float*)(na + 100 * MiB);
    const float* MODp = (const float*)(ws + mk::WS_MOD);
    unsigned short* QKV = (unsigned short*)(ws + mk::WS_QKV);
    launch_mega(a, 0, 1, 1, stream);
    for (int l = 0; l < 2; ++l) {
        const int pb = 1 + 8 * l;
        const float* xin = (l == 0) ? in.x : (const float*)out;
        if (STEP >= 1) { launch_mega(a, pb, pb + 1, 1, stream); launch_mega(a, pb + 1, pb + 2, 1, stream); }
        if (STEP >= 2) launch_mega(a, pb + 2, pb + 3, 1, stream);
        if (STEP >= 3) launch_mega(a, pb + 3, pb + 4, 1, stream);
        if (STEP < 3) {
            for (int b = 0; b < BATCH; ++b) {
                const float* mod = MODp + ((size_t)l * BATCH + b) * 6 * D;
                const float* xb = xin + (size_t)b * SEQ * D; float* ob = out + (size_t)b * SEQ * D;
                if (STEP < 1) {
                    nv::k_norm<<<SEQ, 256, 0, stream>>>(xb, in.norm_mix_g + l * D, mod + 0 * D, mod + 1 * D, Hb);
                    nv::k_gemm<<<dim3(NPROJ / 64, SEQ / 64), 256, 0, stream>>>(Hb, D, nullptr, nullptr, SEQ, in.w_in + (size_t)l * D * NPROJ, NPROJ, PROJb, NPROJ, D);
                    nv::k_rotary<<<SEQ, 256, 0, stream>>>(PROJb);
                    nv::k_kmean<<<dim3(NBLK, AH, 1), 64, 0, stream>>>(PROJb, KMEANb);
                } else {
                    ad::ad_proj<<<SEQ, 256, 0, stream>>>(QKV, (size_t)M * 512, b, PROJb);
                    ad::ad_kmean<<<dim3(NBLK, AH, 1), 64, 0, stream>>>((const float*)(ws + mk::WS_KMP), b, KMEANb);
#ifdef DBG_CHECK
                    { float* PROJn = Gb; float* KMn = (float*)(na + 52 * MiB + 262144); unsigned* flag = (unsigned*)(ws + mk::WS_CTL) + 16;
                      nv::k_norm<<<SEQ, 256, 0, stream>>>(xb, in.norm_mix_g + l * D, mod + 0 * D, mod + 1 * D, Hb);
                      nv::k_gemm<<<dim3(NPROJ / 64, SEQ / 64), 256, 0, stream>>>(Hb, D, nullptr, nullptr, SEQ, in.w_in + (size_t)l * D * NPROJ, NPROJ, PROJn, NPROJ, D);
                      nv::k_rotary<<<SEQ, 256, 0, stream>>>(PROJn);
                      nv::k_kmean<<<dim3(NBLK, AH, 1), 64, 0, stream>>>(PROJn, KMn);
                      ad::dbg_cmp<<<1024, 256, 0, stream>>>(PROJb, PROJn, (size_t)SEQ * NPROJ, DBG_REL, DBG_ABS, flag, NPROJ, 0, 3072, 0);
                      ad::dbg_cmp<<<1024, 256, 0, stream>>>(PROJb, PROJn, (size_t)SEQ * NPROJ, DBG_REL, DBG_ABS, flag, NPROJ, 3072, 3584, 1);
                      ad::dbg_cmp<<<16, 256, 0, stream>>>(KMEANb, KMn, (size_t)8 * 8 * 64, 0.03f, 0.004f, flag + 1);
                      if (l == DBG_L && b == 0) ad::dbg_ssd<<<1024, 256, 0, stream>>>(PROJb, PROJn, (size_t)SEQ * NPROJ, NPROJ, DBG_CLO, DBG_CHI, (float*)(flag + 2)); }
#endif
                }
                if (STEP < 2) {
                    nv::k_moba<<<dim3(NBLK, AH, 1), 256, 0, stream>>>(PROJb, KMEANb, OAb);
                    nv::k_ret<<<dim3(SEQ / 256, RH * 4, 1), 256, 0, stream>>>(PROJb, ORRb);
                    nv::k_cat<<<SEQ, 256, 0, stream>>>(OAb, ORRb, PROJb, in.att_g + l * AW, in.ret_g + l * RW, CATb, STEP >= 1 ? 1 : 0);
                } else {
                    ad::ad_cat<<<SEQ, 256, 0, stream>>>((const unsigned short*)(ws + mk::WS_CAT), (const float*)(ws + mk::WS_ASSQ), in.att_g + l * AW, b, CATb);
                }
                nv::k_gemm<<<dim3(D / 64, SEQ / 64), 256, 0, stream>>>(CATb, D, nullptr, nullptr, SEQ, in.w_out + (size_t)l * D * D, D, Hb, D, D);
                nv::k_resid<<<SEQ, 256, 0, stream>>>(xb, mod + 2 * D, Hb, ob);
            }
        }
        const bool ffn_mega = (l == 0) ? (STEP >= 4) : (STEP >= 5);
        if (ffn_mega) {
            launch_mega(a, pb + 4, pb + 5, 1, stream);
            if (l == 1) launch_mega(a, pb + 5, pb + 6, 1, stream);
            launch_mega(a, pb + 6, pb + 7, 1, stream);
            launch_mega(a, pb + 7, pb + 8, 1, stream);
        } else {
            for (int b = 0; b < BATCH; ++b) {
                const float* mod = MODp + ((size_t)l * BATCH + b) * 6 * D;
                float* ob = out + (size_t)b * SEQ * D;
                nv::k_norm<<<SEQ, 256, 0, stream>>>(ob, in.norm_ffn_g + l * D, mod + 3 * D, mod + 4 * D, Hb);
                if (l == 0) {
                    nv::k_gemm<<<dim3(FF / 64, SEQ / 64), 256, 0, stream>>>(Hb, D, nullptr, nullptr, SEQ, in.fw_gate, FF, Gb, FF, D);
                    nv::k_gemm<<<dim3(FF / 64, SEQ / 64), 256, 0, stream>>>(Hb, D, nullptr, nullptr, SEQ, in.fw_up, FF, Ub, FF, D);
                    nv::k_silu_mul<<<SEQ, 256, 0, stream>>>(Gb, Ub, nullptr, SEQ, FF);
                    nv::k_gemm<<<dim3(D / 64, SEQ / 64), 256, 0, stream>>>(Gb, FF, nullptr, nullptr, SEQ, in.fw_down, D, Ub, D, FF);
                    nv::k_resid<<<SEQ, 256, 0, stream>>>(ob, mod + 5 * D, Ub, ob);
                } else {
                    nv::k_router<<<SEQ / 4, 256, 0, stream>>>(Hb, in.router_w, EIDXb, EWb);
                    nv::k_place<<<1, 1024, 0, stream>>>(EIDXb, LISTb, POSb, CNTb, BASEb, 4);
                    float* GE = Gb; float* UE = Ub;
                    for (int e = 0; e < NE; ++e) {
                        nv::k_gemm<<<dim3(FF / 64, ECAP / 64), 256, 0, stream>>>(Hb, D, LISTb, CNTb + e, ECAP, in.mw_gate + (size_t)e * D * FF, FF, GE, FF, D, BASEb + e, nullptr);
                        nv::k_gemm<<<dim3(FF / 64, ECAP / 64), 256, 0, stream>>>(Hb, D, LISTb, CNTb + e, ECAP, in.mw_up + (size_t)e * D * FF, FF, UE, FF, D, BASEb + e, nullptr);
                        nv::k_silu_mul<<<ECAP, 256, 0, stream>>>(GE, UE, CNTb + e, ECAP, FF);
                        nv::k_gemm<<<dim3(D / 64, ECAP / 64), 256, 0, stream>>>(GE, FF, nullptr, CNTb + e, ECAP, in.mw_down + (size_t)e * FF * D, D, Yb, D, FF, nullptr, BASEb + e);
                    }
                    nv::k_moe_combine<<<SEQ, 256, 0, stream>>>(ob, mod + 5 * D, Yb, POSb, EWb);
                }
            }
        }
    }
    if (STEP >= 5) launch_mega(a, 17, 18, 1, stream);
    else nv::k_norm<<<M, 256, 0, stream>>>(out, in.final_g, nullptr, nullptr, out);
#ifdef DBG_CHECK
#ifdef DBG_ENC
    ad::dbg_encode<<<1, 256, 0, stream>>>((const float*)((unsigned*)(ws + mk::WS_CTL) + 18), (float)SEQ * (DBG_CHI - DBG_CLO), out);
#endif
    ad::dbg_poison<<<1, 256, 0, stream>>>((unsigned*)(ws + mk::WS_CTL) + 16, DBG_T0, out, 100.0f);
    ad::dbg_poison<<<1, 256, 0, stream>>>((unsigned*)(ws + mk::WS_CTL) + 17, DBG_T1, out + (1 << 20), 300.0f);
#endif
#endif
}
```

```cpp
#include <hip/hip_runtime.h>
#include <cstdio>
#include <cstdint>
#include <cmath>

namespace h16 {
typedef _Float16 f16x2_t __attribute__((ext_vector_type(2)));
typedef _Float16 f16x8_t __attribute__((ext_vector_type(8)));
typedef float f32x2_t __attribute__((ext_vector_type(2)));
__device__ __forceinline__ unsigned pk(float lo, float hi) { f32x2_t v = {lo, hi}; f16x2_t b = __builtin_convertvector(v, f16x2_t); return __builtin_bit_cast(unsigned, b); }
__device__ __forceinline__ float lo(unsigned u) { return (float)__builtin_bit_cast(f16x2_t, u)[0]; }
__device__ __forceinline__ float hi(unsigned u) { return (float)__builtin_bit_cast(f16x2_t, u)[1]; }
__device__ __forceinline__ float one(unsigned short s) { return (float)__builtin_bit_cast(_Float16, s); }
}

namespace xl {
template <int O> __device__ __forceinline__ int xor_i(int v) {
    if constexpr (O < 32) return __builtin_amdgcn_ds_swizzle(v, (O << 10) | 0x1f);
    else { static_assert(O < 32, "use add32 / max32 for the 32-lane exchange"); return v; }
}
template <int O> __device__ __forceinline__ float xor_f(float v) { return __builtin_bit_cast(float, xor_i<O>(__builtin_bit_cast(int, v))); }
__device__ __forceinline__ void swap32(unsigned a, unsigned& r0, unsigned& r1) { unsigned b = a; asm volatile("" : "+v"(b)); auto r = __builtin_amdgcn_permlane32_swap(a, b, false, false); r0 = r[0]; r1 = r[1]; }
__device__ __forceinline__ float xor32p(float v, bool upper) { unsigned r0, r1; swap32(__builtin_bit_cast(unsigned, v), r0, r1); return __builtin_bit_cast(float, upper ? r0 : r1); }
__device__ __forceinline__ float add32(float v) { unsigned r0, r1; swap32(__builtin_bit_cast(unsigned, v), r0, r1); return __builtin_bit_cast(float, r0) + __builtin_bit_cast(float, r1); }
__device__ __forceinline__ float max32(float v) { unsigned r0, r1; swap32(__builtin_bit_cast(unsigned, v), r0, r1); return fmaxf(__builtin_bit_cast(float, r0), __builtin_bit_cast(float, r1)); }
__device__ __forceinline__ int add32i(int v) { unsigned r0, r1; swap32((unsigned)v, r0, r1); return (int)(r0 + r1); }
__device__ __forceinline__ float wave_sum(float v) { v += xor_f<1>(v); v += xor_f<2>(v); v += xor_f<4>(v); v += xor_f<8>(v); v += xor_f<16>(v); return add32(v); }
__device__ __forceinline__ int wave_sum_i(int v) { v += xor_i<1>(v); v += xor_i<2>(v); v += xor_i<4>(v); v += xor_i<8>(v); v += xor_i<16>(v); return add32i(v); }
}

__device__ __forceinline__ int olane() { int l; asm volatile("v_mbcnt_lo_u32_b32 %0, -1, 0\n\tv_mbcnt_hi_u32_b32 %0, -1, %0" : "=v"(l)); return l; }
__device__ __forceinline__ int otid(int wv) { return (wv << 6) | olane(); }
#define STEP 6

constexpr int D = 1024, BATCH = 8, SEQ = 2048, M = BATCH * SEQ;
constexpr int AH = 8, AD = 64, AW = 512, MBLK = 256, NBLK = SEQ / MBLK, TOPK = 3;
constexpr int RH = 4, RD = 128, RW = 512;
constexpr int NPROJ = 3 * AW + 4 * RW;
constexpr int FF = 2816, NE = 8;
constexpr float EPS = 1e-6f;
constexpr int ECAP = 2048;
namespace pg8 {
#define PG8_LAS __attribute__((address_space(3)))
typedef unsigned short bf16_t;
typedef short bf16x8 __attribute__((ext_vector_type(8)));
typedef float f32x4 __attribute__((ext_vector_type(4)));
typedef float f32x2 __attribute__((ext_vector_type(2)));
typedef unsigned u32x4 __attribute__((ext_vector_type(4)));
typedef unsigned u32x2 __attribute__((ext_vector_type(2)));
typedef int i32x4 __attribute__((ext_vector_type(4)));
constexpr int BM = 256, BK = 64, HALF = 128, HTB = HALF * BK * 2  , STAGE_BYTES = 8 * HTB, NXCD = 8, WGM = 8;

__host__ __device__ __forceinline__ int lds_byte(int r, int c) { const int st = (r >> 4) * 2 + (c >> 5), rr = r & 15, cc = c & 31, ob = rr * 64 + cc * 2; return st * 1024 + (ob ^ (((ob >> 9) & 1) << 5)); }
__host__ __device__ __forceinline__ void stage_rc(int b, int& R, int& C) { const int st = b / 1024, sb = b % 1024, swz = sb ^ (((sb >> 9) & 1) << 5); R = (st >> 1) * 16 + swz / 64; C = (st & 1) * 32 + (swz % 64) / 2; }
__host__ __device__ __forceinline__ int perm32(int rho) { const int n = rho >> 4, i = rho & 15; return 8 * (i >> 2) + 4 * n + (i & 3); }

struct Unit { int pm, pn, e, kc, li; };
struct Gemm { int lda, ldb, K; };

struct DenseSched {
    const char* A; const char* Bt; size_t a_tile, b_tile;
    int nM, nN, nwg, G, c;
    __device__ __forceinline__ void init(const void* A_, int lda, const void* Bt_, int ldb, int M, int N, int G_, int c_) {
        A = (const char*)A_; Bt = (const char*)Bt_; a_tile = (size_t)BM * lda * 2; b_tile = (size_t)BM * ldb * 2; nM = M / BM; nN = N / BM; nwg = nM * nN; G = G_; c = c_; }
    __device__ __forceinline__ bool next(int i, Unit& u) const {
        const long L = (long)i * G + c; if (L >= nwg) return false;
        int wgid = (int)L; { const int q = nwg / NXCD, r = nwg % NXCD, xcd = wgid % NXCD, off = wgid / NXCD; wgid = (xcd < r ? xcd * (q + 1) : r * (q + 1) + (xcd - r) * q) + off; }
        const int nig = WGM * nN, gid = wgid / nig, fm = gid * WGM, gsz = (nM - fm) < WGM ? (nM - fm) : WGM;
        u.pm = fm + ((wgid % nig) % gsz); u.pn = (wgid % nig) / gsz; u.e = 0; u.kc = 0; u.li = 0; return true;
    }
    __device__ __forceinline__ const char* a_ptr(const Unit& u) const { return A + (size_t)u.pm * a_tile; }
    __device__ __forceinline__ const char* b_ptr(const Unit& u) const { return Bt + (size_t)u.pn * b_tile; }
};
struct MoeSched {
    const char* A; const char* Bt; size_t a_tile, b_tile, e_stride;
    int nM, nN, nwg, G, c; int seg[8]; int first, lim, KS, kbytes;
    __device__ __forceinline__ void init(const void* A_, int lda, const void* Bt_, int ldb, size_t e_stride_bytes, const int* segp_, int N, int G_, int c_) {
        A = (const char*)A_; Bt = (const char*)Bt_; a_tile = (size_t)BM * lda * 2; b_tile = (size_t)BM * ldb * 2; e_stride = e_stride_bytes;
#pragma unroll
        for (int e = 0; e < 8; ++e) seg[e] = __builtin_amdgcn_readfirstlane(segp_[e]);
        nM = __builtin_amdgcn_readfirstlane(segp_[8]) / BM; nN = N / BM; nwg = nM * nN; G = G_; c = c_; first = 0; lim = nwg; KS = 1; kbytes = 0; }
    __device__ __forceinline__ bool next(int i, Unit& u) const {
        const long idx = (long)i * G + c; const long L = first + idx / KS; if (L >= lim) return false;
        u.kc = (int)(idx % KS); u.li = (int)(idx / KS);
        int wgid = (int)L; { const int q = nwg / NXCD, r = nwg % NXCD, xcd = wgid % NXCD, off = wgid / NXCD; wgid = (xcd < r ? xcd * (q + 1) : r * (q + 1) + (xcd - r) * q) + off; }
        const int nig = WGM * nN, gid = wgid / nig, fm = gid * WGM, gsz = (nM - fm) < WGM ? (nM - fm) : WGM;
        u.pm = fm + ((wgid % nig) % gsz); u.pn = (wgid % nig) / gsz;
        int e = 0; const int r0 = u.pm * BM;
#pragma unroll
        for (int k = 1; k < 8; ++k) e = (r0 >= seg[k]) ? k : e;
        u.e = __builtin_amdgcn_readfirstlane(e); return true;
    }
    __device__ __forceinline__ const char* a_ptr(const Unit& u) const { return A + (size_t)u.pm * a_tile + (size_t)u.kc * kbytes; }
    __device__ __forceinline__ const char* b_ptr(const Unit& u) const { return Bt + (size_t)u.e * e_stride + (size_t)u.pn * b_tile + (size_t)u.kc * kbytes; }
};

__device__ __forceinline__ unsigned cvt_pk_bf16(float lo, float hi) { return h16::pk(lo, hi); }
__device__ __forceinline__ float fast_silu(float g) { return g * __builtin_amdgcn_rcpf(1.0f + __builtin_amdgcn_exp2f(-1.4426950408889634f * g)); }

typedef f32x4 Acc[2][2][4][2];
typedef int i32x8 __attribute__((ext_vector_type(8)));
template <bool F8> struct Frags;
template <> struct Frags<false> { bf16x8 At[4][2], B0[2][2], B1[2][2]; };
template <> struct Frags<true> { i32x8 At[4], B0[2], B1[2]; };

template <class Epi, class Sched>
__device__ __forceinline__ void gemm_phase(const int wv, PG8_LAS unsigned char* lds, const Gemm g, const Sched& S, const Epi& E) {
    int tid_ = otid(wv);
    const int tid = tid_, wid = __builtin_amdgcn_readfirstlane(tid >> 6), lane = tid & 63, wr = wid >> 2, wc = wid & 3, fr = lane & 15, fq = lane >> 4;
    const int K = g.K; int nt = K / BK; asm volatile("" : "+s"(nt));
    unsigned voffA[2], voffB[2];
#pragma unroll
    for (int i = 0; i < 2; ++i) { int R, C; stage_rc(tid * 16 + i * 8192, R, C); const int Rb = Epi::PERM ? ((R & ~31) + perm32(R & 31)) : R;
        voffA[i] = (unsigned)(R * g.lda + C) * 2u; voffB[i] = (unsigned)(Rb * g.ldb + C) * 2u; }
    const size_t kstep = (size_t)(BK * 2);
    const size_t hstepA = (size_t)HALF * g.lda * 2, hstepB = (size_t)HALF * g.ldb * 2;
    const unsigned ldsw = (unsigned)wid * 1024u;
    const unsigned ldsbase_ = (unsigned)__builtin_amdgcn_readfirstlane((int)((unsigned)(unsigned long)lds + ldsw));
    const int aoff = lds_byte(wr * 64 + fr, fq * 8), boff = lds_byte(wc * 32 + fr, fq * 8);
#define PG8_SA(b, h) (((b) * 2 + (h)) * HTB)
#define PG8_SB(b, h) ((4 + (b) * 2 + (h)) * HTB)
#define PG8_STAGE(bufoff, gbase, voff) do { if constexpr (Epi::FP8) {   \
            const unsigned long long gb_ = (unsigned long long)(gbase); \
            const unsigned long long sb_ = ((unsigned long long)(unsigned)__builtin_amdgcn_readfirstlane((int)(gb_ >> 32)) << 32) | (unsigned)__builtin_amdgcn_readfirstlane((int)gb_); \
            _Pragma("unroll") for (int _i = 0; _i < 2; ++_i) { unsigned keep_; \
                asm volatile("s_mov_b32 %0, m0\n\ts_mov_b32 m0, %3\n\ts_nop 0\n\tglobal_load_lds_dwordx4 %1, %2\n\ts_mov_b32 m0, %0" : "=&s"(keep_) : "v"((voff)[_i]), "s"(sb_), "s"(ldsbase_ + (unsigned)((bufoff) + _i * 8192)) : "memory"); } \
        } else { _Pragma("unroll") for (int _i = 0; _i < 2; ++_i) \
        __builtin_amdgcn_global_load_lds((const unsigned*)((const char*)(gbase) + (voff)[_i]), (PG8_LAS unsigned*)(lds + (bufoff) + ldsw + _i * 8192), 16, 0, 0); } } while (0)
#define PG8_LDA(dst, b, h) do { if constexpr (Epi::FP8) { _Pragma("unroll") for (int m = 0; m < 4; ++m) { const i32x4 lo_ = *(const PG8_LAS i32x4*)(lds + PG8_SA(b, h) + aoff + m * 2048), hi_ = *(const PG8_LAS i32x4*)(lds + PG8_SA(b, h) + aoff + m * 2048 + 1024); F.dst[m] = __builtin_shufflevector(lo_, hi_, 0, 1, 2, 3, 4, 5, 6, 7); } } \
        else { _Pragma("unroll") for (int m = 0; m < 4; ++m) _Pragma("unroll") for (int k = 0; k < 2; ++k) F.dst[m][k] = *(const PG8_LAS bf16x8*)(lds + PG8_SA(b, h) + aoff + m * 2048 + k * 1024); } } while (0)
#define PG8_LDB(dst, b, h) do { if constexpr (Epi::FP8) { _Pragma("unroll") for (int n = 0; n < 2; ++n) { const i32x4 lo_ = *(const PG8_LAS i32x4*)(lds + PG8_SB(b, h) + boff + n * 2048), hi_ = *(const PG8_LAS i32x4*)(lds + PG8_SB(b, h) + boff + n * 2048 + 1024); F.dst[n] = __builtin_shufflevector(lo_, hi_, 0, 1, 2, 3, 4, 5, 6, 7); } } \
        else { _Pragma("unroll") for (int n = 0; n < 2; ++n) _Pragma("unroll") for (int k = 0; k < 2; ++k) F.dst[n][k] = *(const PG8_LAS bf16x8*)(lds + PG8_SB(b, h) + boff + n * 2048 + k * 1024); } } while (0)
#define PG8_MMA(ai, bj, At, Bt) do { __builtin_amdgcn_s_setprio(1); \
        if constexpr (Epi::FP8) {   \
            _Pragma("unroll") for (int m = 0; m < 4; ++m) _Pragma("unroll") for (int n = 0; n < 2; ++n) \
                acc[ai][bj][m][n] = __builtin_amdgcn_mfma_scale_f32_16x16x128_f8f6f4(F.Bt[n], F.At[m], acc[ai][bj][m][n], 0, 0, 0, Epi::SCALE_W, 0, 0x7f7f7f7f); \
        } else { _Pragma("unroll") for (int m = 0; m < 4; ++m) _Pragma("unroll") for (int n = 0; n < 2; ++n) _Pragma("unroll") for (int k = 0; k < 2; ++k) \
            acc[ai][bj][m][n] = __builtin_amdgcn_mfma_f32_16x16x32_f16(__builtin_bit_cast(h16::f16x8_t, F.Bt[n][k]), __builtin_bit_cast(h16::f16x8_t, F.At[m][k]), acc[ai][bj][m][n], 0, 0, 0); } \
        __builtin_amdgcn_s_setprio(0); } while (0)
#define PG8_WAIT_V(n) asm volatile("s_waitcnt vmcnt(" #n ")" ::: "memory")
#define PG8_WAIT_L(n) asm volatile("s_waitcnt lgkmcnt(" #n ")" ::: "memory")
#define PG8_BAR __builtin_amdgcn_s_barrier()
#define PG8_SCHED __builtin_amdgcn_sched_barrier(0)
    Unit cur, nxt; int ui = 0;
    if (!S.next(0, cur)) return;
    Acc acc;
#pragma unroll
    for (int a = 0; a < 2; ++a)
#pragma unroll
        for (int b = 0; b < 2; ++b)
#pragma unroll
            for (int m = 0; m < 4; ++m)
#pragma unroll
                for (int n = 0; n < 2; ++n) acc[a][b][m][n] = (f32x4){0.f, 0.f, 0.f, 0.f};
    const char* cA = S.a_ptr(cur); const char* cB = S.b_ptr(cur);
    if constexpr (Epi::MID_T > 0) E.pre(cur, lds, tid);
    PG8_STAGE(PG8_SB(0, 0), cB, voffB); PG8_STAGE(PG8_SB(0, 1), cB + hstepB, voffB); PG8_STAGE(PG8_SA(0, 0), cA, voffA); PG8_STAGE(PG8_SA(0, 1), cA + hstepA, voffA);
    if (wr == 1) PG8_BAR;
    PG8_WAIT_V(2); PG8_BAR;
    PG8_STAGE(PG8_SB(1, 0), cB + kstep, voffB); PG8_STAGE(PG8_SA(1, 0), cA + kstep, voffA); PG8_STAGE(PG8_SB(1, 1), cB + hstepB + kstep, voffB);
    PG8_WAIT_V(6); PG8_BAR;
    for (;;) {
        const bool has_next = S.next(ui + 1, nxt);
        const char* nA = has_next ? S.a_ptr(nxt) : cA; const char* nB = has_next ? S.b_ptr(nxt) : cB;
        for (int t = 0; t < nt; t += 2) {
            if constexpr (Epi::MID_T > 0) { if (t == Epi::MID_T) E.mid(acc, lds, wr, fr); }
            const bool last = (t == nt - 2);
            Frags<Epi::FP8> F;
            const char* a1 = cA + (size_t)(t + 1) * kstep;
            const char* a2 = last ? nA : cA + (size_t)(t + 2) * kstep; const char* b2 = last ? nB : cB + (size_t)(t + 2) * kstep;
            const char* a3 = a2 + kstep; const char* b3 = b2 + kstep;
            PG8_LDB(B0, 0, 0); PG8_LDB(B1, 0, 1); PG8_SCHED; PG8_LDA(At, 0, 0); PG8_STAGE(PG8_SA(1, 1), a1 + hstepA, voffA);
            PG8_WAIT_V(8); PG8_WAIT_L(0); PG8_BAR; PG8_MMA(0, 0, At, B0); PG8_MMA(0, 1, At, B1); PG8_BAR; PG8_SCHED;
            PG8_LDA(At, 0, 1); PG8_STAGE(PG8_SB(0, 0), b2, voffB); PG8_STAGE(PG8_SB(0, 1), b2 + hstepB, voffB); PG8_STAGE(PG8_SA(0, 0), a2, voffA);
            PG8_WAIT_V(8); PG8_WAIT_L(0); PG8_BAR; PG8_MMA(1, 0, At, B0); PG8_MMA(1, 1, At, B1); PG8_BAR; PG8_SCHED;
            PG8_LDB(B0, 1, 0); PG8_LDB(B1, 1, 1); PG8_SCHED; PG8_LDA(At, 1, 0); PG8_STAGE(PG8_SA(0, 1), a2 + hstepA, voffA);
            PG8_WAIT_V(8); PG8_WAIT_L(0); PG8_BAR; PG8_MMA(0, 0, At, B0); PG8_MMA(0, 1, At, B1); PG8_BAR; PG8_SCHED;
            PG8_LDA(At, 1, 1); PG8_STAGE(PG8_SB(1, 0), b3, voffB); PG8_STAGE(PG8_SB(1, 1), b3 + hstepB, voffB); PG8_STAGE(PG8_SA(1, 0), a3, voffA);
            PG8_WAIT_V(8); PG8_WAIT_L(0); PG8_BAR; PG8_MMA(1, 0, At, B0); PG8_MMA(1, 1, At, B1); PG8_BAR; PG8_SCHED;
        }
        if (wr == 0) PG8_BAR;
        { const int t2_ = olane(); E(acc, cur, wr, wc, t2_ & 15, t2_ >> 4); }
        if (!has_next) break;
#pragma unroll
        for (int a = 0; a < 2; ++a)
#pragma unroll
            for (int b = 0; b < 2; ++b)
#pragma unroll
                for (int m = 0; m < 4; ++m)
#pragma unroll
                    for (int n = 0; n < 2; ++n) acc[a][b][m][n] = (f32x4){0.f, 0.f, 0.f, 0.f};
        cur = nxt; cA = nA; cB = nB; ++ui;
        if (wr == 1) PG8_BAR;
    }
    PG8_WAIT_V(0);
    PG8_BAR;
#undef PG8_SA
#undef PG8_SB
#undef PG8_STAGE
#undef PG8_LDA
#undef PG8_LDB
#undef PG8_MMA
#undef PG8_WAIT_V
#undef PG8_WAIT_L
#undef PG8_BAR
#undef PG8_SCHED
}
}
namespace epi {
#define PG8_LAS __attribute__((address_space(3)))
using pg8::Acc; using pg8::Unit; using pg8::f32x4; using pg8::u32x4; using pg8::bf16_t; using pg8::cvt_pk_bf16; using pg8::fast_silu;
constexpr int HALF = 128;
constexpr float C2 = 0.125f * 1.4426950408889634f;
constexpr float KSC = 0.08838834764831845f;

__device__ __forceinline__ u32x4 pack8(const f32x4 v0, const f32x4 v1) { u32x4 w; w.x = cvt_pk_bf16(v0[0], v0[1]); w.y = cvt_pk_bf16(v0[2], v0[3]); w.z = cvt_pk_bf16(v1[0], v1[1]); w.w = cvt_pk_bf16(v1[2], v1[3]); return w; }

struct EpiInProj {
    static constexpr bool PERM = true; static constexpr int MID_T = 0; static constexpr bool FP8 = false; static constexpr int SCALE_W = 0;
    bf16_t* O; size_t gstride;
    float* KMP;
    const float* ROPE;
    __device__ __forceinline__ void operator()(const Acc& acc, const Unit& u, int wr, int wc, int fr, int fq) const {
        const int grp = u.pn >> 1;
        const int col0 = (u.pn & 1) * 256 + wc * 32 + 8 * fq;
        const int row0 = u.pm * 256 + wr * 64 + fr;
        bf16_t* base = O + (size_t)grp * gstride;
        f32x4 cs[2][2];
#pragma unroll
        for (int bj = 0; bj < 2; ++bj) { cs[bj][0] = (f32x4){0.f, 0.f, 0.f, 0.f}; cs[bj][1] = (f32x4){0.f, 0.f, 0.f, 0.f}; }
#pragma unroll
        for (int ai = 0; ai < 2; ++ai)
#pragma unroll
            for (int m = 0; m < 4; ++m) {
                const int row = row0 + ai * HALF + m * 16;
                bf16_t* rowp = base + (size_t)row * 512 + col0;
                f32x4 t0 = (f32x4){0.f, 0.f, 0.f, 0.f}, t1 = t0;
                if (grp == 3 || grp == 4) { const float* tp = ROPE + ((size_t)(row & 2047) * 64 + 16 * wc + 4 * fq) * 2; t0 = *(const f32x4*)tp; t1 = *(const f32x4*)(tp + 4); }
#pragma unroll
                for (int bj = 0; bj < 2; ++bj) {
                    f32x4 v0 = acc[ai][bj][m][0], v1 = acc[ai][bj][m][1];
                    if (grp == 0) { v0 = v0 * C2; v1 = v1 * C2; }
                    else if (grp == 1) { cs[bj][0] += v0; cs[bj][1] += v1; }
                    else if (grp == 3 || grp == 4) {
                        const float sc = (grp == 4) ? KSC : 1.0f;
                        f32x4 r0, r1;
                        r0[0] = (v0[0] * t0[0] - v0[1] * t0[1]) * sc; r0[1] = (v0[0] * t0[1] + v0[1] * t0[0]) * sc;
                        r0[2] = (v0[2] * t0[2] - v0[3] * t0[3]) * sc; r0[3] = (v0[2] * t0[3] + v0[3] * t0[2]) * sc;
                        r1[0] = (v1[0] * t1[0] - v1[1] * t1[1]) * sc; r1[1] = (v1[0] * t1[1] + v1[1] * t1[0]) * sc;
                        r1[2] = (v1[2] * t1[2] - v1[3] * t1[3]) * sc; r1[3] = (v1[2] * t1[3] + v1[3] * t1[2]) * sc;
                        v0 = r0; v1 = r1;
                    } else if (grp == 6) {
#pragma unroll
                        for (int j = 0; j < 4; ++j) { v0[j] = fast_silu(v0[j]); v1[j] = fast_silu(v1[j]); }
                    }
                    *(u32x4*)(rowp + bj * HALF) = pack8(v0, v1);
                }
            }
        if (grp == 1) {
#pragma unroll
            for (int bj = 0; bj < 2; ++bj)
#pragma unroll
                for (int n = 0; n < 2; ++n) {
                    f32x4 s = cs[bj][n];
#pragma unroll
                    for (int c4 = 0; c4 < 4; ++c4) { float t = s[c4]; t += xl::xor_f<1>(t); t += xl::xor_f<2>(t); t += xl::xor_f<4>(t); t += xl::xor_f<8>(t); s[c4] = t; }
                    if (fr == 0) *(f32x4*)(KMP + (size_t)(u.pm * 2 + wr) * 512 + col0 + bj * HALF + 4 * n) = s;
                }
        }
    }
};

struct EpiOutProj {
    static constexpr bool PERM = false; static constexpr int MID_T = 8; static constexpr bool FP8 = false; static constexpr int SCALE_W = 0;
    const float* xin; float* out; const float* g1;
    const float* assq;
    bool dry;
    static constexpr int RS_OFF = 131072 + 8192;
    __device__ __forceinline__ void pre(const Unit& u, PG8_LAS unsigned char* lds, int tid) const {
        if (tid < 256) { const int row = u.pm * 256 + tid;
            const f32x4 a = *(const f32x4*)(assq + (size_t)row * 8), c = *(const f32x4*)(assq + (size_t)row * 8 + 4);
            const float ss = ((a[0] + a[1]) + (a[2] + a[3])) + ((c[0] + c[1]) + (c[2] + c[3]));
            ((PG8_LAS float*)(lds + RS_OFF))[tid] = 1.0f / sqrtf(ss * (1.0f / 512.0f) + 1e-6f); }
    }
    __device__ __forceinline__ void mid(Acc& acc, PG8_LAS unsigned char* lds, int wr, int fr) const {
        const PG8_LAS float* tab = (const PG8_LAS float*)(lds + RS_OFF) + wr * 64 + fr;
#pragma unroll
        for (int ai = 0; ai < 2; ++ai)
#pragma unroll
            for (int m = 0; m < 4; ++m) {
                const float rs = tab[ai * HALF + m * 16];
#pragma unroll
                for (int bj = 0; bj < 2; ++bj)
#pragma unroll
                    for (int n = 0; n < 2; ++n) acc[ai][bj][m][n] = acc[ai][bj][m][n] * rs;
            }
    }
    __device__ __forceinline__ void operator()(const Acc& acc, const Unit& u, int wr, int wc, int fr, int fq) const {
        const int b = u.pm >> 3;
        const int col0 = u.pn * 256 + wc * 32 + 4 * fq;
        const int row0 = u.pm * 256 + wr * 64 + fr;
        f32x4 gv[2][2];
#pragma unroll
        for (int bj = 0; bj < 2; ++bj)
#pragma unroll
            for (int n = 0; n < 2; ++n) gv[bj][n] = *(const f32x4*)(g1 + (size_t)b * 6144 + col0 + bj * HALF + n * 16);
#pragma unroll
        for (int ai = 0; ai < 2; ++ai)
#pragma unroll
            for (int m = 0; m < 4; ++m) {
                const size_t off = (size_t)(row0 + ai * HALF + m * 16) * 1024 + col0;
#pragma unroll
                for (int bj = 0; bj < 2; ++bj)
#pragma unroll
                    for (int n = 0; n < 2; ++n) { const f32x4 bs = *(const f32x4*)(xin + off + bj * HALF + n * 16); const f32x4 r = bs + gv[bj][n] * acc[ai][bj][m][n]; if (!dry) *(f32x4*)(out + off + bj * HALF + n * 16) = r; else asm volatile("" :: "v"(r)); }
            }
    }
};

struct EpiSwiGLU {
    static constexpr bool PERM = true; static constexpr int MID_T = 0; static constexpr bool FP8 = false; static constexpr int SCALE_W = 0;
    bf16_t* H; int ldh;
    __device__ __forceinline__ void operator()(const Acc& acc, const Unit& u, int wr, int wc, int fr, int fq) const {
        const int col0 = u.pn * 128 + wc * 32 + 8 * fq;
        const int row0 = u.pm * 256 + wr * 64 + fr;
#pragma unroll
        for (int ai = 0; ai < 2; ++ai)
#pragma unroll
            for (int m = 0; m < 4; ++m) {
                const int row = row0 + ai * HALF + m * 16;
                f32x4 v0, v1;
#pragma unroll
                for (int j = 0; j < 4; ++j) { v0[j] = fast_silu(acc[ai][0][m][0][j]) * acc[ai][1][m][0][j]; v1[j] = fast_silu(acc[ai][0][m][1][j]) * acc[ai][1][m][1][j]; }
                *(u32x4*)(H + (size_t)row * ldh + col0) = pack8(v0, v1);
            }
    }
};

struct EpiDown {
    static constexpr bool PERM = false; static constexpr int MID_T = 0; static constexpr bool FP8 = false; static constexpr int SCALE_W = 0;
    float* out; const float* g2; bf16_t* YS; const int* srow; const float* swt; bool moe; bool dry; int* atomf; bool atomic; float* slab; int KS;
    __device__ __forceinline__ void operator()(const Acc& acc, const Unit& u, int wr, int wc, int fr, int fq) const {
        const int col0 = u.pn * 256 + wc * 32 + 4 * fq;
        const int row0 = u.pm * 256 + wr * 64 + fr;
        if (!moe) {
            const int b = u.pm >> 3;
            f32x4 gv[2][2];
#pragma unroll
            for (int bj = 0; bj < 2; ++bj)
#pragma unroll
                for (int n = 0; n < 2; ++n) gv[bj][n] = *(const f32x4*)(g2 + (size_t)b * 6144 + col0 + bj * HALF + n * 16);
#pragma unroll
            for (int ai = 0; ai < 2; ++ai)
#pragma unroll
                for (int m = 0; m < 4; ++m) {
                    const size_t off = (size_t)(row0 + ai * HALF + m * 16) * 1024 + col0;
#pragma unroll
                    for (int bj = 0; bj < 2; ++bj)
#pragma unroll
                        for (int n = 0; n < 2; ++n) { const f32x4 bs = *(const f32x4*)(out + off + bj * HALF + n * 16); const f32x4 r = bs + gv[bj][n] * acc[ai][bj][m][n]; if (!dry) *(f32x4*)(out + off + bj * HALF + n * 16) = r; else asm volatile("" :: "v"(r)); }
                }
        } else if (atomic) {
            float* sl = slab + ((size_t)(u.li * KS + u.kc) * 256) * 256 + (wc * 32 + 4 * fq);
#pragma unroll
            for (int ai = 0; ai < 2; ++ai)
#pragma unroll
                for (int m = 0; m < 4; ++m) {
                    const int rl = ai * HALF + wr * 64 + m * 16 + fr; const int pos = u.pm * 256 + rl;
                    const int sr = srow[pos];
                    if (sr >= 0) { const float w = swt[pos];
                        if (u.kc == 0 && wc == 0 && fq == 0) atomf[sr * 4 + u.pn] = 1 + u.li * 256 + rl;
#pragma unroll
                        for (int bj = 0; bj < 2; ++bj)
#pragma unroll
                            for (int n = 0; n < 2; ++n) *(f32x4*)(sl + (size_t)rl * 256 + bj * HALF + n * 16) = acc[ai][bj][m][n] * w; }
                }
        } else {
#pragma unroll
            for (int ai = 0; ai < 2; ++ai)
#pragma unroll
                for (int m = 0; m < 4; ++m) {
                    const int pos = row0 + ai * HALF + m * 16;
                    const int sr = srow[pos];
                    if (sr >= 0) { const float w = swt[pos]; bf16_t* rowp = YS + (size_t)sr * 1024 + col0;
#pragma unroll
                        for (int bj = 0; bj < 2; ++bj)
#pragma unroll
                            for (int n = 0; n < 2; ++n) { const f32x4 v = acc[ai][bj][m][n] * w; pg8::u32x2 o; o.x = cvt_pk_bf16(v[0], v[1]); o.y = cvt_pk_bf16(v[2], v[3]); if (!dry) *(pg8::u32x2*)(rowp + bj * HALF + n * 16) = o; else asm volatile("" :: "v"(o)); } }
                }
        }
    }
};

__device__ __forceinline__ float clamp448(float v) { return __builtin_fminf(__builtin_fmaxf(v, -448.0f), 448.0f); }
__device__ __forceinline__ unsigned pk4_fp8(float a, float b, float c, float d) {
    int p = 0; p = __builtin_amdgcn_cvt_pk_fp8_f32(clamp448(a), clamp448(b), p, false); p = __builtin_amdgcn_cvt_pk_fp8_f32(clamp448(c), clamp448(d), p, true); return (unsigned)p; }
struct EpiSwiGLU8 {
    static constexpr bool PERM = true; static constexpr int MID_T = 0; static constexpr bool FP8 = true; static constexpr int SCALE_W = 0x7a7a7a7a;
    unsigned char* H; int ldh;
    __device__ __forceinline__ void operator()(const Acc& acc, const Unit& u, int wr, int wc, int fr, int fq) const {
        const int col0 = u.pn * 128 + wc * 32 + 8 * fq;
        const int row0 = u.pm * 256 + wr * 64 + fr;
#pragma unroll
        for (int ai = 0; ai < 2; ++ai)
#pragma unroll
            for (int m = 0; m < 4; ++m) {
                const int row = row0 + ai * HALF + m * 16;
                f32x4 v0, v1;
#pragma unroll
                for (int j = 0; j < 4; ++j) { v0[j] = fast_silu(acc[ai][0][m][0][j]) * acc[ai][1][m][0][j]; v1[j] = fast_silu(acc[ai][0][m][1][j]) * acc[ai][1][m][1][j]; }
                pg8::u32x2 w; w.x = pk4_fp8(v0[0], v0[1], v0[2], v0[3]); w.y = pk4_fp8(v1[0], v1[1], v1[2], v1[3]);
                *(pg8::u32x2*)(H + (size_t)row * ldh + col0) = w;
            }
    }
};
struct EpiDownDense8 {
    static constexpr bool PERM = false; static constexpr int MID_T = 0; static constexpr bool FP8 = true; static constexpr int SCALE_W = 0x79797979;
    float* out; const float* g2; bool dry;
    __device__ __forceinline__ void operator()(const Acc& acc, const Unit& u, int wr, int wc, int fr, int fq) const {
        const int col0 = u.pn * 256 + wc * 32 + 4 * fq;
        const int row0 = u.pm * 256 + wr * 64 + fr;
        const int b = u.pm >> 3;
        f32x4 gv[2][2];
#pragma unroll
        for (int bj = 0; bj < 2; ++bj)
#pragma unroll
            for (int n = 0; n < 2; ++n) gv[bj][n] = *(const f32x4*)(g2 + (size_t)b * 6144 + col0 + bj * HALF + n * 16);
#pragma unroll
        for (int ai = 0; ai < 2; ++ai)
#pragma unroll
            for (int m = 0; m < 4; ++m) {
                const size_t off = (size_t)(row0 + ai * HALF + m * 16) * 1024 + col0;
#pragma unroll
                for (int bj = 0; bj < 2; ++bj)
#pragma unroll
                    for (int n = 0; n < 2; ++n) { const f32x4 bs = *(const f32x4*)(out + off + bj * HALF + n * 16); const f32x4 r = bs + gv[bj][n] * acc[ai][bj][m][n]; if (!dry) *(f32x4*)(out + off + bj * HALF + n * 16) = r; else asm volatile("" :: "v"(r)); }
            }
    }
};
struct EpiDownMoe8 {
    static constexpr bool PERM = false; static constexpr int MID_T = 0; static constexpr bool FP8 = true; static constexpr int SCALE_W = 0x79797979;
    bf16_t* YS; const int* srow; const float* swt;
    __device__ __forceinline__ void operator()(const Acc& acc, const Unit& u, int wr, int wc, int fr, int fq) const {
        const int col0 = u.pn * 256 + wc * 32 + 4 * fq;
        const int row0 = u.pm * 256 + wr * 64 + fr;
#pragma unroll
        for (int ai = 0; ai < 2; ++ai)
#pragma unroll
            for (int m = 0; m < 4; ++m) {
                const int pos = row0 + ai * HALF + m * 16;
                const int sr = srow[pos];
                if (sr >= 0) { const float w = swt[pos]; bf16_t* rowp = YS + (size_t)sr * 1024 + col0;
#pragma unroll
                    for (int bj = 0; bj < 2; ++bj)
#pragma unroll
                        for (int n = 0; n < 2; ++n) { const f32x4 v = acc[ai][bj][m][n] * w; pg8::u32x2 o; o.x = cvt_pk_bf16(v[0], v[1]); o.y = cvt_pk_bf16(v[2], v[3]); *(pg8::u32x2*)(rowp + bj * HALF + n * 16) = o; } }
            }
    }
};
}
namespace fa {
#define FA_LAS __attribute__((address_space(3)))
typedef unsigned short bf16_t;
typedef short bf16x8 __attribute__((ext_vector_type(8)));
typedef short s16x4 __attribute__((ext_vector_type(4)));
typedef float f32x16 __attribute__((ext_vector_type(16)));
typedef float f32x4 __attribute__((ext_vector_type(4)));
typedef unsigned u32x4 __attribute__((ext_vector_type(4)));
typedef float f32x2_t __attribute__((ext_vector_type(2))); typedef __bf16 bf16x2_t __attribute__((ext_vector_type(2)));
constexpr int L_WSF = 131072 + 1024, L_KM = L_WSF + 2048;
constexpr float NEG = -1.0e30f;
__device__ __forceinline__ int crow(int r, int hi) { return (r & 3) + 8 * (r >> 2) + 4 * hi; }
__device__ __forceinline__ void glds16(const void* gsrc, unsigned lds_dst) { unsigned keep;
    asm volatile("s_mov_b32 %0, m0\n\ts_mov_b32 m0, %2\n\ts_nop 0\n\tglobal_load_lds_dwordx4 %1, off\n\ts_mov_b32 m0, %0" : "=&s"(keep) : "v"(gsrc), "s"(lds_dst) : "memory"); }
__device__ __forceinline__ unsigned cvtpk_s(float lo, float hi) { return h16::pk(lo, hi); }
__device__ __forceinline__ float bf2f(short s) { return h16::one((unsigned short)s); }
typedef short v4i16_t __attribute__((ext_vector_type(4)));
__device__ __forceinline__ s16x4 vtr(FA_LAS const unsigned char* p) { return __builtin_bit_cast(s16x4, __builtin_amdgcn_ds_read_tr16_b64_v4i16((FA_LAS v4i16_t*)p)); }
#define FA_WAIT_BAR() asm volatile("s_waitcnt vmcnt(0) lgkmcnt(0)\n\ts_barrier" ::: "memory")
#define FA_LBAR() asm volatile("s_waitcnt lgkmcnt(0)\n\ts_barrier" ::: "memory")

struct Tensors {
    const bf16_t* Q; const bf16_t* K; const bf16_t* V;
    bf16_t* CAT;
    float* ASSQ;
    const float* KMP;
    const bf16_t* GR;
    const float* ret_g;
    const float* KVM;
};

template <bool RET>
__device__ __forceinline__ void attn_unit(const int wv, int b, int h, int qblk, const Tensors& T, FA_LAS unsigned char* shm) {
    constexpr int NS = RET ? 3 : 4, DIST = NS - 1;
    constexpr int DH = RET ? 128 : 64, ND0 = DH / 16, NDB = DH / 32, NPC = DH / 64, SLOT = 64 * DH * 2, L_K = 0, L_V = NS * SLOT, PER = 2 * NPC, L_R = 98304;
    int tid_ = otid(wv);
    const int tid = tid_, lane = tid & 63, r32 = lane & 31, hi = lane >> 5; const int wid = __builtin_amdgcn_readfirstlane(tid >> 6);
    const size_t rowbase = (size_t)b * 2048; const int q0 = qblk * 256;
    const unsigned lds0 = (unsigned)(unsigned long)shm;
    FA_LAS float* wsf = (FA_LAS float*)(shm + L_WSF) + wid * 64;
    FA_LAS float* KM = (FA_LAS float*)(shm + L_KM);
    const bf16_t* Kh = T.K + rowbase * 512 + h * DH; const bf16_t* Vh = T.V + rowbase * 512 + h * DH;
    const int NT = RET ? 4 : 4 * (qblk + 1);
#define FA_KV0(i) ((((i) < 4) ? qblk : (qblk - 1 - (((i) - 4) >> 2))) * 256 + ((i) & 3) * 64)
#define FA_DMA(i) do { const int kv0_ = FA_KV0(i); const unsigned so_ = (unsigned)(((i) % NS) * SLOT); \
        _Pragma("unroll") for (int pp = 0; pp < NPC; ++pp) { const int p = wid + 8 * pp; \
            glds16(Kh + (size_t)(kv0_ + lane) * 512 + p * 8, (unsigned)__builtin_amdgcn_readfirstlane(lds0 + L_K + so_ + p * 1024)); } \
        _Pragma("unroll") for (int pp = 0; pp < NPC; ++pp) { const int p = wid + 8 * pp; \
            glds16(Vh + (size_t)(kv0_ + 16 * (p & 3) + (lane >> 2)) * 512 + (p >> 2) * 32 + (lane & 3) * 8, (unsigned)__builtin_amdgcn_readfirstlane(lds0 + L_V + so_ + p * 1024)); } } while (0)
    FA_DMA(0); if (NT > 1) FA_DMA(1); if (DIST > 2 && NT > 2) FA_DMA(2);
    const bf16_t* Qw = T.Q + (rowbase + q0 + wid * 32 + r32) * 512 + h * DH;
    bf16x8 qr[ND0];
#pragma unroll
    for (int d0 = 0; d0 < ND0; ++d0) qr[d0] = *(const bf16x8*)(Qw + d0 * 16 + hi * 8);
    unsigned selmask = 0xffu;
    float cfac[16]; float lg2 = 0.f;
    if (!RET) {
        { const int j = tid >> 6, d = tid & 63; const float* kp = T.KMP + ((size_t)(b * 8 + j) * 2) * 512 + h * 64 + d; KM[tid] = kp[0] + kp[512]; }
        FA_LBAR();
        float g[8];
#pragma unroll
        for (int j = 0; j < 8; ++j) g[j] = 0.f;
#pragma unroll
        for (int d0 = 0; d0 < ND0; ++d0)
#pragma unroll
            for (int jj = 0; jj < 8; ++jj) { const float qv = bf2f(qr[d0][jj]); const int d = 16 * d0 + 8 * hi + jj;
#pragma unroll
                for (int j = 0; j < 8; ++j) g[j] += qv * KM[j * 64 + d]; }
#pragma unroll
        for (int j = 0; j < 8; ++j) g[j] = xl::add32(g[j]);
        selmask = 0u;
#pragma unroll
        for (int j = 0; j < 8; ++j) { int rank = 0;
#pragma unroll
            for (int mm = 0; mm < 8; ++mm) rank += (mm < qblk && (g[mm] > g[j] || (g[mm] == g[j] && mm < j))) ? 1 : 0;
            if (j < qblk && rank < 3) selmask |= 1u << j; }
    } else {
        lg2 = log2f(1.0f - exp2f(-5.0f - (float)h));
#pragma unroll
        for (int r = 0; r < 16; ++r) cfac[r] = exp2f(-lg2 * (float)((r & 3) + 8 * (r >> 2)));
    }
    f32x16 o[NDB];
#pragma unroll
    for (int db = 0; db < NDB; ++db) o[db] = f32x16{};
    float mhat = 0.f, lrow = 0.f; f32x16 negm = f32x16{}; constexpr float THR = 8.0f;
    if (RET && qblk > 0) {
        const float* kvb = T.KVM + ((size_t)(b * 4 + h) * 8) * 16384;
        const float g256 = exp2f(lg2 * 256.0f);
#pragma unroll 2
        for (int it = 0; it < 8; ++it) { const int idx4 = tid + 512 * it; const int d = idx4 >> 5, e0 = (idx4 & 31) * 4;
            f32x4 acc4 = (f32x4){0.f, 0.f, 0.f, 0.f};
            for (int m = 0; m < qblk; ++m) acc4 = acc4 * g256 + *(const f32x4*)(kvb + (size_t)m * 16384 + d * 128 + e0);
            const int rp = (d & ~12) | ((d & 8) >> 1) | ((d & 4) << 1);
            typedef unsigned u32x2_ __attribute__((ext_vector_type(2)));
            u32x2_ w; w.x = cvtpk_s(acc4[0], acc4[1]); w.y = cvtpk_s(acc4[2], acc4[3]);
            *(FA_LAS u32x2_*)(shm + L_R + (e0 >> 5) * 8192 + rp * 64 + (e0 & 31) * 2) = w; }
        FA_LBAR();
        { FA_LAS const unsigned char* rb = shm + L_R + ((lane >> 4) & 1) * 32 + (lane & 3) * 8 + (4 * hi + ((lane & 15) >> 2)) * 64;
#pragma unroll
          for (int db = 0; db < NDB; ++db)
#pragma unroll
              for (int d0 = 0; d0 < ND0; ++d0) { const s16x4 lo = vtr(rb + db * 8192 + d0 * 1024), hh = vtr(rb + db * 8192 + d0 * 1024 + 512);
                  const bf16x8 rf = (bf16x8){lo[0], lo[1], lo[2], lo[3], hh[0], hh[1], hh[2], hh[3]};
                  o[db] = __builtin_amdgcn_mfma_f32_32x32x16_f16(__builtin_bit_cast(h16::f16x8_t, qr[d0]), __builtin_bit_cast(h16::f16x8_t, rf), o[db], 0, 0, 0); } }
#pragma unroll
        for (int r = 0; r < 16; ++r) { const float rd = exp2f(lg2 * (float)(wid * 32 + crow(r, hi) + 1));
#pragma unroll
            for (int db = 0; db < NDB; ++db) o[db][r] *= rd; }
    }
    const int qrel = wid * 32 + r32;
    for (int i = 0; i < NT; ++i) {
        { const int ahead = (NT - 1 - i) < (DIST - 1) ? (NT - 1 - i) : (DIST - 1);
          if (ahead == 2) { if (PER == 2) asm volatile("s_waitcnt vmcnt(4) lgkmcnt(0)\n\ts_barrier" ::: "memory"); else asm volatile("s_waitcnt vmcnt(8) lgkmcnt(0)\n\ts_barrier" ::: "memory"); }
          else if (ahead == 1) { if (PER == 2) asm volatile("s_waitcnt vmcnt(2) lgkmcnt(0)\n\ts_barrier" ::: "memory"); else asm volatile("s_waitcnt vmcnt(4) lgkmcnt(0)\n\ts_barrier" ::: "memory"); }
          else FA_WAIT_BAR(); }
        if (i + DIST < NT) FA_DMA(i + DIST);
        const bool diag = i < 4; const int t = i & 3; const int j = diag ? qblk : (qblk - 1 - ((i - 4) >> 2));
        const bool mysel = RET ? true : (((selmask >> j) & 1u) != 0u);
        const bool skip = diag ? (64 * t > 32 * wid + 31) : (RET ? false : !__any(mysel));
        if (skip) continue;
        const unsigned so = (unsigned)((i % NS) * SLOT);
        f32x16 p0 = RET ? f32x16{} : negm, p1 = p0;
        { FA_LAS const unsigned char* kb = shm + L_K + so + hi * 1024 + r32 * 16;
#pragma unroll
          for (int d0 = 0; d0 < ND0; ++d0) { const bf16x8 b0 = *(FA_LAS const bf16x8*)(kb + d0 * 2048); const bf16x8 b1 = *(FA_LAS const bf16x8*)(kb + d0 * 2048 + 512);
              p0 = __builtin_amdgcn_mfma_f32_32x32x16_f16(__builtin_bit_cast(h16::f16x8_t, b0), __builtin_bit_cast(h16::f16x8_t, qr[d0]), p0, 0, 0, 0); p1 = __builtin_amdgcn_mfma_f32_32x32x16_f16(__builtin_bit_cast(h16::f16x8_t, b1), __builtin_bit_cast(h16::f16x8_t, qr[d0]), p1, 0, 0, 0); } }
        if (RET) {
            const int qpos = q0 + qrel; const int kv0 = j * 256 + t * 64;
            const float base = (float)(qpos - kv0 - 4 * hi);
            const float rf0 = exp2f(lg2 * base), rf1 = exp2f(lg2 * (base - 32.0f));
#pragma unroll
            for (int r = 0; r < 16; ++r) { p0[r] *= rf0 * cfac[r]; p1[r] *= rf1 * cfac[r]; }
            if (diag) { const int kb_ = 64 * t + 4 * hi;
#pragma unroll
                for (int r = 0; r < 16; ++r) { const int kv = kb_ + (r & 3) + 8 * (r >> 2); if (kv > qrel) p0[r] = 0.f; if (kv + 32 > qrel) p1[r] = 0.f; } }
        } else {
            if (diag) { const int kb_ = 64 * t + 4 * hi;
#pragma unroll
                for (int r = 0; r < 16; ++r) { const int kv = kb_ + (r & 3) + 8 * (r >> 2); if (kv > qrel) p0[r] = NEG; if (kv + 32 > qrel) p1[r] = NEG; } }
            else if (!mysel) {
#pragma unroll
                for (int r = 0; r < 16; ++r) { p0[r] = NEG; p1[r] = NEG; } }
            float rm = fmaxf(fmaxf(p0[0], p1[0]), p0[1]);
#pragma unroll
            for (int r = 1; r < 16; ++r) { rm = fmaxf(fmaxf(rm, p1[r]), (r < 15) ? p0[r + 1] : p1[r]); }
            rm = xl::max32(rm);
            if (__any(rm > THR)) {
                const float dl = fmaxf(rm, 0.f);
                mhat += dl;
#pragma unroll
                for (int r = 0; r < 16; ++r) { p0[r] -= dl; p1[r] -= dl; }
#pragma unroll
                for (int r = 0; r < 16; ++r) negm[r] = -mhat;
                const float f = __builtin_amdgcn_exp2f(-dl); lrow *= f;
                asm volatile("" ::: "memory");
                if (hi == 0) wsf[r32] = f;
                asm volatile("s_waitcnt lgkmcnt(0)" ::: "memory");
#pragma unroll
                for (int r = 0; r < 16; ++r) { const float fr_ = wsf[crow(r, hi)];
#pragma unroll
                    for (int db = 0; db < NDB; ++db) o[db][r] *= fr_; }
                asm volatile("s_waitcnt lgkmcnt(0)" ::: "memory");
            }
            float s = 0.f;
#pragma unroll
            for (int r = 0; r < 16; ++r) { p0[r] = __builtin_amdgcn_exp2f(p0[r]); p1[r] = __builtin_amdgcn_exp2f(p1[r]); s += p0[r] + p1[r]; }
            lrow += s;
        }
        bf16x8 pa[4];
        { u32x4 w;
          w.x = cvtpk_s(p0[0], p0[1]); w.y = cvtpk_s(p0[2], p0[3]); w.z = cvtpk_s(p0[4], p0[5]); w.w = cvtpk_s(p0[6], p0[7]); pa[0] = __builtin_bit_cast(bf16x8, w);
          w.x = cvtpk_s(p0[8], p0[9]); w.y = cvtpk_s(p0[10], p0[11]); w.z = cvtpk_s(p0[12], p0[13]); w.w = cvtpk_s(p0[14], p0[15]); pa[1] = __builtin_bit_cast(bf16x8, w);
          w.x = cvtpk_s(p1[0], p1[1]); w.y = cvtpk_s(p1[2], p1[3]); w.z = cvtpk_s(p1[4], p1[5]); w.w = cvtpk_s(p1[6], p1[7]); pa[2] = __builtin_bit_cast(bf16x8, w);
          w.x = cvtpk_s(p1[8], p1[9]); w.y = cvtpk_s(p1[10], p1[11]); w.z = cvtpk_s(p1[12], p1[13]); w.w = cvtpk_s(p1[14], p1[15]); pa[3] = __builtin_bit_cast(bf16x8, w); }
        { FA_LAS const unsigned char* vb = shm + L_V + so + ((lane >> 4) & 1) * 32 + (lane & 3) * 8 + (4 * hi + ((lane & 15) >> 2)) * 64;
#pragma unroll
          for (int db = 0; db < NDB; ++db)
#pragma unroll
              for (int ks = 0; ks < 4; ++ks) { const s16x4 lo = vtr(vb + db * 4096 + ks * 1024), hh = vtr(vb + db * 4096 + ks * 1024 + 512);
                  const bf16x8 vf = (bf16x8){lo[0], lo[1], lo[2], lo[3], hh[0], hh[1], hh[2], hh[3]};
                  o[db] = __builtin_amdgcn_mfma_f32_32x32x16_f16(__builtin_bit_cast(h16::f16x8_t, pa[ks]), __builtin_bit_cast(h16::f16x8_t, vf), o[db], 0, 0, 0); } }
    }
    float rli[16];
    if (!RET) {
        const float l = xl::add32(lrow);
        asm volatile("" ::: "memory");
        if (hi == 0) wsf[32 + r32] = 1.0f / l;
        asm volatile("s_waitcnt lgkmcnt(0)" ::: "memory");
#pragma unroll
        for (int r = 0; r < 16; ++r) rli[r] = wsf[32 + crow(r, hi)];
    } else {
#pragma unroll
        for (int r = 0; r < 16; ++r) rli[r] = 1.0f;
    }
    FA_LBAR();
    FA_LAS bf16_t* stg = (FA_LAS bf16_t*)(shm + wid * 8192);
#pragma unroll
    for (int r = 0; r < 16; ++r) { const int orow = crow(r, hi);
#pragma unroll
        for (int db = 0; db < NDB; ++db) { const unsigned pk = cvtpk_s(o[db][r] * rli[r], 0.f); stg[orow * DH + db * 32 + r32] = (bf16_t)(pk & 0xffffu); } }
    asm volatile("s_waitcnt lgkmcnt(0)" ::: "memory");
    const size_t tok0 = rowbase + q0 + wid * 32;
    if (!RET) {
#pragma unroll
        for (int i = 0; i < 4; ++i) { const int row = i * 8 + (lane >> 3), ch = lane & 7;
            const u32x4 v = *(FA_LAS const u32x4*)(stg + row * 64 + ch * 8);
            float ss = 0.f;
#pragma unroll
            for (int k = 0; k < 4; ++k) { const float a = h16::lo(v[k]), c = h16::hi(v[k]); ss += a * a + c * c; }
            ss += xl::xor_f<1>(ss); ss += xl::xor_f<2>(ss); ss += xl::xor_f<4>(ss);
            if (ch == 0) T.ASSQ[(tok0 + row) * 8 + h] = ss;
            *(u32x4*)(T.CAT + (tok0 + row) * 1024 + h * 64 + ch * 8) = v; }
    } else {
#pragma unroll
        for (int i = 0; i < 8; ++i) { const int row = i * 4 + (lane >> 4), ch = lane & 15;
            const u32x4 v = *(FA_LAS const u32x4*)(stg + row * 128 + ch * 8);
            float x[8];
#pragma unroll
            for (int k = 0; k < 4; ++k) { x[2 * k] = h16::lo(v[k]); x[2 * k + 1] = h16::hi(v[k]); }
            float ss = 0.f;
#pragma unroll
            for (int k = 0; k < 8; ++k) ss += x[k] * x[k];
            ss += xl::xor_f<1>(ss); ss += xl::xor_f<2>(ss); ss += xl::xor_f<4>(ss); ss += xl::xor_f<8>(ss);
            const float rs = 1.0f / sqrtf(ss * (1.0f / 128.0f) + 1e-6f);
            const u32x4 gv = *(const u32x4*)(T.GR + (tok0 + row) * 512 + h * 128 + ch * 8);
            const f32x4 w0 = *(const f32x4*)(T.ret_g + h * 128 + ch * 8), w1 = *(const f32x4*)(T.ret_g + h * 128 + ch * 8 + 4);
            const float wg[8] = {w0[0], w0[1], w0[2], w0[3], w1[0], w1[1], w1[2], w1[3]};
            float y[8];
#pragma unroll
            for (int k = 0; k < 4; ++k) { const float g0 = h16::lo(gv[k]), g1 = h16::hi(gv[k]);
                y[2 * k] = x[2 * k] * rs * wg[2 * k] * g0; y[2 * k + 1] = x[2 * k + 1] * rs * wg[2 * k + 1] * g1; }
            u32x4 ov; ov.x = cvtpk_s(y[0], y[1]); ov.y = cvtpk_s(y[2], y[3]); ov.z = cvtpk_s(y[4], y[5]); ov.w = cvtpk_s(y[6], y[7]);
            *(u32x4*)(T.CAT + (tok0 + row) * 1024 + 512 + h * 128 + ch * 8) = ov; }
    }
    FA_LBAR();
#undef FA_KV0
#undef FA_DMA
}

__device__ __forceinline__ void kv_unit(const int wv, int b, int h, int m, const bf16_t* Kg, const bf16_t* Vg, float* KVM, FA_LAS unsigned char* shm) {
    constexpr int SLOT = 16384, L_K = 0, L_V = 4 * SLOT;
    int tid_ = otid(wv);
    const int tid = tid_, lane = tid & 63, r32 = lane & 31, hi = lane >> 5; const int wid = __builtin_amdgcn_readfirstlane(tid >> 6);
    const int dg = wid >> 1, eh = wid & 1;
    const size_t rowbase = (size_t)b * 2048 + (size_t)m * 256;
    const unsigned lds0 = (unsigned)(unsigned long)shm;
    const bf16_t* Kh = Kg + rowbase * 512 + h * 128; const bf16_t* Vh = Vg + rowbase * 512 + h * 128;
#pragma unroll
    for (int t = 0; t < 4; ++t)
#pragma unroll
        for (int pp = 0; pp < 2; ++pp) { const int p = wid + 8 * pp; const size_t off = (size_t)(64 * t + 16 * (p & 3) + (lane >> 2)) * 512 + (p >> 2) * 32 + (lane & 3) * 8;
            glds16(Kh + off, (unsigned)__builtin_amdgcn_readfirstlane(lds0 + L_K + t * SLOT + p * 1024));
            glds16(Vh + off, (unsigned)__builtin_amdgcn_readfirstlane(lds0 + L_V + t * SLOT + p * 1024)); }
    const float lg2 = log2f(1.0f - exp2f(-5.0f - (float)h));
    const float g64 = exp2f(lg2 * 64.0f);
    h16::f16x8_t fd[4];
#pragma unroll
    for (int ks = 0; ks < 4; ++ks)
#pragma unroll
        for (int j = 0; j < 8; ++j) fd[ks][j] = (_Float16)exp2f(lg2 * (float)(63 - (16 * ks + 8 * (j >> 2) + 4 * hi + (j & 3))));
    f32x16 acc[2]; acc[0] = f32x16{}; acc[1] = f32x16{};
    FA_WAIT_BAR();
    const int lb = ((lane >> 4) & 1) * 32 + (lane & 3) * 8 + (4 * hi + ((lane & 15) >> 2)) * 64;
#pragma unroll
    for (int t = 0; t < 4; ++t) {
        if (t > 0) {
#pragma unroll
            for (int r = 0; r < 16; ++r) { acc[0][r] *= g64; acc[1][r] *= g64; } }
        FA_LAS const unsigned char* kb = shm + L_K + t * SLOT + dg * 4096 + lb; FA_LAS const unsigned char* vb = shm + L_V + t * SLOT + (2 * eh) * 4096 + lb;
#pragma unroll
        for (int ks = 0; ks < 4; ++ks) { const s16x4 klo = vtr(kb + ks * 1024), khi = vtr(kb + ks * 1024 + 512);
            const h16::f16x8_t kf = __builtin_bit_cast(h16::f16x8_t, (bf16x8){klo[0], klo[1], klo[2], klo[3], khi[0], khi[1], khi[2], khi[3]});
#pragma unroll
            for (int eb = 0; eb < 2; ++eb) { const s16x4 vlo = vtr(vb + eb * 4096 + ks * 1024), vhi = vtr(vb + eb * 4096 + ks * 1024 + 512);
                const h16::f16x8_t vf = __builtin_bit_cast(h16::f16x8_t, (bf16x8){vlo[0], vlo[1], vlo[2], vlo[3], vhi[0], vhi[1], vhi[2], vhi[3]}) * fd[ks];
                acc[eb] = __builtin_amdgcn_mfma_f32_32x32x16_f16(kf, vf, acc[eb], 0, 0, 0); } }
    }
    float* op = KVM + ((size_t)(b * 4 + h) * 8 + m) * 16384;
#pragma unroll
    for (int eb = 0; eb < 2; ++eb)
#pragma unroll
        for (int r = 0; r < 16; ++r) op[(size_t)(32 * dg + crow(r, hi)) * 128 + 64 * eh + 32 * eb + r32] = acc[eb][r];
    FA_LBAR();
}
}
namespace mk {
#define GAS __attribute__((address_space(1)))
#define LAS __attribute__((address_space(3)))
typedef unsigned short bf16;
typedef unsigned v4u __attribute__((ext_vector_type(4)));
typedef unsigned v2u __attribute__((ext_vector_type(2)));
typedef float f32x4 __attribute__((ext_vector_type(4)));
typedef int i32x4 __attribute__((ext_vector_type(4)));
typedef GAS unsigned gu32;
#define RLX_AGENT __ATOMIC_RELAXED, __HIP_MEMORY_SCOPE_AGENT
#define LDS_WAIT() asm volatile("s_waitcnt lgkmcnt(0)" ::: "memory")
#define VM_WAIT() asm volatile("s_waitcnt vmcnt(0)" ::: "memory")
constexpr int NWAVES = 8;
constexpr size_t MiB = 1u << 20, KiB = 1u << 10;
constexpr size_t WS_CTL = 0;
constexpr size_t CTL_ZERO_BYTES = 64 * KiB;
constexpr size_t WS_MOD = 64 * KiB;
constexpr size_t WS_KMP = 512 * KiB;
constexpr size_t WS_EIDX = 768 * KiB;
constexpr size_t WS_EW = 896 * KiB;
constexpr size_t WS_ROPE = 1 * MiB;
constexpr size_t WS_ASSQ = 2 * MiB;
constexpr size_t WS_SROW = 2 * MiB + 512 * KiB;
constexpr size_t WS_SWT = 2 * MiB + 768 * KiB;
constexpr size_t WS_WCNT = 3 * MiB;
constexpr size_t WS_SEG = 3 * MiB + 64 * KiB;
constexpr size_t WS_ATOMF = 3 * MiB + 128 * KiB;
constexpr size_t WS_SEGD = 3 * MiB + 65 * KiB;
constexpr size_t WS_MGU = 8 * MiB;
constexpr size_t WS_SLAB = 8 * MiB;
constexpr size_t WS_MDN = 96 * MiB;
constexpr size_t WS_XA = 140 * MiB;
constexpr size_t WS_XS = 172 * MiB;
constexpr size_t WS_KVM = 172 * MiB;
constexpr size_t WS_YS = 140 * MiB;
constexpr size_t WS_WIN = 240 * MiB;
constexpr size_t WS_WOUT = 254 * MiB;
constexpr size_t WS_FGU = 258 * MiB;
constexpr size_t WS_FDN = 269 * MiB;
constexpr size_t WS_QKV = 275 * MiB;
constexpr size_t WS_CAT = 387 * MiB;
constexpr size_t WS_HD = 275 * MiB;
constexpr size_t WS_HM = 240 * MiB;
constexpr size_t WS_END = 428 * MiB;
constexpr int XS_ROWS = 34816;
constexpr int CW_BAR = 1024;

constexpr int RING_BYTES = 131072, LDSCTL_OFF = RING_BYTES, MISC_OFF = LDSCTL_OFF + 320, LDS_BYTES = 147456;

#define XB_TMO      128
#define XB_XCNT(j)  (256  + 64 * (j))
#define XB_XSUB(j)  (1280 + 64 * (j))
#define XB_XGEN(j)  (2304 + 64 * (j))
#define XB_TOP      3328
#define XB_TOPGEN   3392
#define XCD_BAR_WORDS 3456
#define XB_SPIN_CAP (1u << 18)
__device__ __forceinline__ unsigned xb_ld(unsigned* p)              { return __hip_atomic_load(p, __ATOMIC_RELAXED, __HIP_MEMORY_SCOPE_AGENT); }
__device__ __forceinline__ unsigned xb_add(unsigned* p, unsigned v) { return __hip_atomic_fetch_add(p, v, __ATOMIC_RELAXED, __HIP_MEMORY_SCOPE_AGENT); }
__device__ __forceinline__ unsigned xb_xcc_id() { return (unsigned)__builtin_amdgcn_s_getreg((3 << 11) | 20) & 0xFu; }
#define XB_SPIN(cond, bar) do { unsigned _sp = 0; while (cond) { __builtin_amdgcn_s_sleep(1); \
    if ((++_sp & 255u) == 0u) { if (xb_ld(&(bar)[XB_TMO])) break; if (_sp > XB_SPIN_CAP) { atomicAdd(&(bar)[XB_TMO], 1u); break; } } } } while (0)
struct XcdBarrier { unsigned* bar; unsigned x; volatile LAS unsigned* st; int wv; };
__device__ __forceinline__ XcdBarrier xcd_barrier_post(unsigned* bar, volatile LAS unsigned* st, int wv) {
    XcdBarrier b; b.bar = bar; b.x = xb_xcc_id(); b.st = st; b.wv = wv;
    if (otid(wv) == 0) (void)xb_add(&bar[XB_XCNT(b.x)], 1u);
    return b;
}
__device__ __forceinline__ void xcd_barrier_complete(unsigned* bar, unsigned x, unsigned& nloc, unsigned& nx) {
    const unsigned G = gridDim.x * gridDim.y * gridDim.z;
    unsigned sum, cnt, mine, sp = 0u;
    for (;;) {
        sum = 0u; cnt = 0u; mine = 0u;
#pragma unroll
        for (unsigned j = 0; j < 16; ++j) { const unsigned c = xb_ld(&bar[XB_XCNT(j)]); sum += c; cnt += (c > 0u) ? 1u : 0u; mine = (j == x) ? c : mine; }
        if (sum == G) break;
        __builtin_amdgcn_s_sleep(1);
        if ((++sp & 255u) == 0u) { if (xb_ld(&bar[XB_TMO])) break; if (sp > XB_SPIN_CAP) { atomicAdd(&bar[XB_TMO], 1u); break; } }
    }
    nloc = mine > 0u ? mine : 1u; nx = cnt > 0u ? cnt : 1u;
}
__device__ __forceinline__ void xcd_barrier(const XcdBarrier& b) {
    asm volatile("s_waitcnt vmcnt(0)" ::: "memory");
    __syncthreads();
    if (otid(b.wv) == 0) {
        unsigned* bar = b.bar;
        __builtin_amdgcn_s_waitcnt(0);
        unsigned nloc = b.st[0], nx = b.st[1];
        if (nloc == 0u) { xcd_barrier_complete(bar, b.x, nloc, nx); b.st[0] = nloc; b.st[1] = nx; }
        const unsigned old = xb_add(&bar[XB_XSUB(b.x)], 1u);
        const unsigned gen = old / nloc;
        if (old + 1u == (gen + 1u) * nloc) {
            __builtin_amdgcn_fence(__ATOMIC_RELEASE, "agent");
            asm volatile("s_waitcnt vmcnt(0)" ::: "memory");
            const unsigned og = xb_add(&bar[XB_TOP], 1u);
            const unsigned tg = og / nx;
            if (og + 1u == (tg + 1u) * nx) xb_add(&bar[XB_TOPGEN], 1u);
            else XB_SPIN(xb_ld(&bar[XB_TOPGEN]) == tg, bar);
            __builtin_amdgcn_fence(__ATOMIC_ACQUIRE, "agent");
            xb_add(&bar[XB_XGEN(b.x)], 1u);
            asm volatile("s_waitcnt vmcnt(0)" ::: "memory");
        } else {
            XB_SPIN(xb_ld(&bar[XB_XGEN(b.x)]) == gen, bar);
            __builtin_amdgcn_fence(__ATOMIC_ACQUIRE, "agent");
            asm volatile("s_waitcnt vmcnt(0)" ::: "memory");
        }
    }
    __syncthreads();
}

__device__ __forceinline__ unsigned f2bf(float f) { unsigned u = __builtin_bit_cast(unsigned, f); return (u + 0x7fffu + ((u >> 16) & 1u)) >> 16; }
__device__ __forceinline__ unsigned pk2(float lo, float hi) { return h16::pk(lo, hi); }
using xl::wave_sum; using xl::wave_sum_i;

struct Inputs {
    const float *x, *c, *norm_mix_g, *norm_ffn_g, *ada_w, *ada_b, *w_in, *w_out, *att_g, *ret_g, *fw_gate, *fw_up, *fw_down, *router_w, *mw_gate, *mw_up, *mw_down, *final_g;
};

template <class SrcFn> __device__ __forceinline__ void transpose_item(SrcFn src, int K, bf16* WT, int k0, int n0, LAS float* scr, int lane) {
#pragma unroll 8
    for (int i = 0; i < 32; ++i) { const int kk = 2 * i + (lane >> 5); scr[kk * 33 + (lane & 31)] = src(k0 + kk, n0 + (lane & 31)); }
    LDS_WAIT(); asm volatile("" ::: "memory");
    const int c = lane & 7;
#pragma unroll
    for (int j = 0; j < 4; ++j) { const int n = (lane >> 3) + 8 * j; const LAS float* s = scr + (8 * c) * 33 + n;
        v4u o; o.x = pk2(s[0 * 33], s[1 * 33]); o.y = pk2(s[2 * 33], s[3 * 33]); o.z = pk2(s[4 * 33], s[5 * 33]); o.w = pk2(s[6 * 33], s[7 * 33]);
        *(GAS v4u*)(WT + (size_t)(n0 + n) * K + k0 + 8 * c) = o; }
    LDS_WAIT(); asm volatile("" ::: "memory");
}
__device__ __forceinline__ int rot_src_col(int n) {
    if (n < 1536 || n >= 2560) return n;
    const int hb = (n - 1536) & ~127, p = (n - 1536) & 127;
    return 1536 + hb + 4 * (p >> 3) + ((p & 7) >> 1) + 64 * (p & 1);
}
constexpr int IT_WIN = 16 * 112, IT_WOUT = 16 * 32, IT_GU = 16 * 176, IT_DN = 44 * 32;
constexpr int IT_TOTAL = 2 * IT_WIN + 2 * IT_WOUT + IT_GU + IT_DN + 8 * (IT_GU + IT_DN);

constexpr int IT_NONMOE = 2 * IT_WIN + 2 * IT_WOUT + IT_GU + IT_DN;
__device__ __forceinline__ void convert_item(const Inputs& in, unsigned char* ws, int it, LAS float* scr, int lane) {
    int r = it;
    if (r < 2 * IT_WIN) { const int l = r / IT_WIN; r -= l * IT_WIN; const float* W = in.w_in + (size_t)l * 1024 * 3584;
        transpose_item([=](int k, int n) { return W[(size_t)k * 3584 + rot_src_col(n)]; }, 1024, (bf16*)(ws + WS_WIN) + (size_t)l * 3584 * 1024, 64 * (r / 112), 32 * (r % 112), scr, lane); return; }
    r -= 2 * IT_WIN;
    if (r < 2 * IT_WOUT) { const int l = r / IT_WOUT; r -= l * IT_WOUT; const float* W = in.w_out + (size_t)l * 1024 * 1024; const float* ag = in.att_g + l * 512;
        transpose_item([=](int k, int n) { return W[(size_t)k * 1024 + n] * (k < 512 ? ag[k] : 1.0f); }, 1024, (bf16*)(ws + WS_WOUT) + (size_t)l * 1024 * 1024, 64 * (r / 32), 32 * (r % 32), scr, lane); return; }
    r -= 2 * IT_WOUT;
    const float *Wg, *Wu, *Wd; bf16 *Dgu, *Ddn;
    if (r < IT_GU + IT_DN) { Wg = in.fw_gate; Wu = in.fw_up; Wd = in.fw_down; Dgu = (bf16*)(ws + WS_FGU); Ddn = (bf16*)(ws + WS_FDN); }
    else { r -= IT_GU + IT_DN; const int e = r / (IT_GU + IT_DN); r -= e * (IT_GU + IT_DN);
        Wg = in.mw_gate + (size_t)e * 1024 * 2816; Wu = in.mw_up + (size_t)e * 1024 * 2816; Wd = in.mw_down + (size_t)e * 2816 * 1024;
        Dgu = (bf16*)(ws + WS_MGU) + (size_t)e * 5632 * 1024; Ddn = (bf16*)(ws + WS_MDN) + (size_t)e * 1024 * 2816; }
    if (r < IT_GU) {
        transpose_item([=](int k, int n) { const float* W = ((n >> 7) & 1) ? Wu : Wg; return W[(size_t)k * 2816 + (n >> 8) * 128 + (n & 127)]; }, 1024, Dgu, 64 * (r / 176), 32 * (r % 176), scr, lane); return; }
    r -= IT_GU;
    transpose_item([=](int k, int n) { return Wd[(size_t)k * 1024 + n]; }, 2816, Ddn, 64 * (r / 32), 32 * (r % 32), scr, lane);
}
struct MoeItem { const float* src; bf16* dst; int ld, K, k0, n0; const float* rscale; float f8scale; int scol0, sstep; };
template <int KIND  , class InP> __device__ __forceinline__ MoeItem moe_item(InP inp, unsigned char* ws, int it, int lane) {
    MoeItem m; m.rscale = nullptr; m.f8scale = (KIND == 0) ? 32.0f : 64.0f; const int r8 = lane >> 3, c4 = 4 * (lane & 7); m.scol0 = c4; m.sstep = 1;
    if (KIND == 0) { const int e = it / IT_GU, r = it - e * IT_GU; const int kb = r / 176, nb = r % 176; const int n = 32 * nb; m.k0 = 64 * kb; m.n0 = n; m.ld = 2816; m.K = 1024;
        const float* W = (((n >> 7) & 1) ? inp->mw_up : inp->mw_gate) + (size_t)e * 1024 * 2816;
        m.src = W + (size_t)(m.k0 + r8) * 2816 + (n >> 8) * 128 + (n & 127) + c4; m.dst = (bf16*)(ws + WS_MGU + (size_t)e * 5632 * 1024); }
    else { const int e = it / IT_DN, r = it - e * IT_DN; const int kb = r / 32, nb = r % 32; m.k0 = 64 * kb; m.n0 = 32 * nb; m.ld = 1024; m.K = 2816;
        m.src = inp->mw_down + (size_t)e * 2816 * 1024 + (size_t)(m.k0 + r8) * 1024 + m.n0 + c4; m.dst = (bf16*)(ws + WS_MDN + (size_t)e * 1024 * 2816); }
    return m;
}
__device__ __forceinline__ void moe_item_load(const MoeItem& m, float (&v)[32]) {
#pragma unroll
    for (int i = 0; i < 8; ++i) { const f32x4 t = *(const f32x4*)(m.src + (size_t)(8 * i) * m.ld); v[4 * i] = t[0]; v[4 * i + 1] = t[1]; v[4 * i + 2] = t[2]; v[4 * i + 3] = t[3]; }
}
__device__ __forceinline__ void moe_item_finish(const MoeItem& m, const float (&v)[32], LAS float* scr, int lane) {
    const int r8 = lane >> 3;
    if (m.rscale != nullptr && m.k0 < 512) {
#pragma unroll
        for (int i = 0; i < 8; ++i) { const float rsv = m.rscale[m.k0 + 8 * i + r8];
#pragma unroll
            for (int j = 0; j < 4; ++j) scr[(8 * i + r8) * 33 + m.scol0 + j * m.sstep] = v[4 * i + j] * rsv; }
    } else {
#pragma unroll
        for (int i = 0; i < 8; ++i)
#pragma unroll
            for (int j = 0; j < 4; ++j) scr[(8 * i + r8) * 33 + m.scol0 + j * m.sstep] = v[4 * i + j];
    }
    LDS_WAIT(); asm volatile("" ::: "memory");
    const int c = lane & 7;
    if (m.f8scale != 0.f) {
        const float sc = m.f8scale; unsigned char* d8 = (unsigned char*)m.dst;
#pragma unroll
        for (int j = 0; j < 4; ++j) { const int n = (lane >> 3) + 8 * j; const LAS float* s = scr + (8 * c) * 33 + n;
            v2u o; int p = 0; p = __builtin_amdgcn_cvt_pk_fp8_f32(s[0 * 33] * sc, s[1 * 33] * sc, p, false); p = __builtin_amdgcn_cvt_pk_fp8_f32(s[2 * 33] * sc, s[3 * 33] * sc, p, true); o.x = (unsigned)p;
            p = 0; p = __builtin_amdgcn_cvt_pk_fp8_f32(s[4 * 33] * sc, s[5 * 33] * sc, p, false); p = __builtin_amdgcn_cvt_pk_fp8_f32(s[6 * 33] * sc, s[7 * 33] * sc, p, true); o.y = (unsigned)p;
            *(GAS v2u*)(d8 + (size_t)(m.n0 + n) * m.K + m.k0 + 8 * c) = o; }
    } else {
#pragma unroll
        for (int j = 0; j < 4; ++j) { const int n = (lane >> 3) + 8 * j; const LAS float* s = scr + (8 * c) * 33 + n;
            v4u o; o.x = pk2(s[0 * 33], s[1 * 33]); o.y = pk2(s[2 * 33], s[3 * 33]); o.z = pk2(s[4 * 33], s[5 * 33]); o.w = pk2(s[6 * 33], s[7 * 33]);
            *(GAS v4u*)(m.dst + (size_t)(m.n0 + n) * m.K + m.k0 + 8 * c) = o; }
    }
    LDS_WAIT(); asm volatile("" ::: "memory");
}
template <class InP> __device__ __forceinline__ MoeItem base_item(InP inp, unsigned char* ws, int it, int lane) {
    MoeItem m; m.rscale = nullptr; m.f8scale = 0.f; int r = it; const int r8 = lane >> 3, c = lane & 7, c4 = 4 * c; m.scol0 = c4; m.sstep = 1;
    if (r < 2 * IT_WIN) { const int l = r / IT_WIN; r -= l * IT_WIN; m.k0 = 64 * (r / 112); m.n0 = 32 * (r % 112); m.ld = 3584; m.K = 1024;
        int scol = m.n0 + c4;
        if (m.n0 >= 1536 && m.n0 < 2560) { const int hb = (m.n0 - 1536) & ~127, a0 = ((m.n0 - 1536) & 127) >> 3;
            scol = 1536 + hb + 4 * (a0 + (c & 3)) + 64 * (c >> 2); m.scol0 = 8 * (c & 3) + (c >> 2); m.sstep = 2; }
        m.src = inp->w_in + (size_t)l * 1024 * 3584 + (size_t)(m.k0 + r8) * 3584 + scol; m.dst = (bf16*)(ws + WS_WIN) + (size_t)l * 3584 * 1024; return m; }
    r -= 2 * IT_WIN;
    if (r < 2 * IT_WOUT) { const int l = r / IT_WOUT; r -= l * IT_WOUT; m.k0 = 64 * (r / 32); m.n0 = 32 * (r % 32); m.ld = 1024; m.K = 1024; m.rscale = inp->att_g + l * 512;
        m.src = inp->w_out + (size_t)l * 1024 * 1024 + (size_t)(m.k0 + r8) * 1024 + m.n0 + c4; m.dst = (bf16*)(ws + WS_WOUT) + (size_t)l * 1024 * 1024; return m; }
    r -= 2 * IT_WOUT;
    if (r < IT_GU) { const int n = 32 * (r % 176); m.k0 = 64 * (r / 176); m.n0 = n; m.ld = 2816; m.K = 1024;
        m.src = (((n >> 7) & 1) ? inp->fw_up : inp->fw_gate) + (size_t)(m.k0 + r8) * 2816 + (n >> 8) * 128 + (n & 127) + c4; m.dst = (bf16*)(ws + WS_FGU); m.f8scale = 32.0f; return m; }
    r -= IT_GU; m.k0 = 64 * (r / 32); m.n0 = 32 * (r % 32); m.ld = 1024; m.K = 2816;
    m.src = inp->fw_down + (size_t)(m.k0 + r8) * 1024 + m.n0 + c4; m.dst = (bf16*)(ws + WS_FDN); m.f8scale = 64.0f; return m;
}
#ifndef CONV_DEPTH
#define CONV_DEPTH 4
#endif
#define CONV_PIPE(ITEM_FN, IT_FIRST, IT_END, STEP)                                                                      \
    { int it = (IT_FIRST); const int it_end = (IT_END), st_ = (STEP);                                                   \
      if (it < it_end) {                                                                                                \
        float v0[32], v1[32], v2[32], v3[32]; MoeItem q0, q1, q2, q3;                                                   \
        auto clampi = [&](int i) { return i < it_end ? i : it; };                                                       \
        q0 = ITEM_FN(it); moe_item_load(q0, v0);                                                                        \
        if (CONV_DEPTH > 2) { q1 = ITEM_FN(clampi(it + st_)); moe_item_load(q1, v1); }                                  \
        if (CONV_DEPTH > 3) { q2 = ITEM_FN(clampi(it + 2 * st_)); moe_item_load(q2, v2); }                              \
        for (;;) {                                                                                                      \
            if (CONV_DEPTH == 2) { q1 = ITEM_FN(clampi(it + st_)); moe_item_load(q1, v1); }                             \
            if (CONV_DEPTH == 3) { q2 = ITEM_FN(clampi(it + 2 * st_)); moe_item_load(q2, v2); }                         \
            if (CONV_DEPTH == 4) { q3 = ITEM_FN(clampi(it + 3 * st_)); moe_item_load(q3, v3); }                         \
            moe_item_finish(q0, v0, scr, lane); it += st_; if (it >= it_end) break;                                     \
            if (CONV_DEPTH == 2) { q0 = ITEM_FN(clampi(it + st_)); moe_item_load(q0, v0); }                             \
            if (CONV_DEPTH == 3) { q0 = ITEM_FN(clampi(it + 2 * st_)); moe_item_load(q0, v0); }                         \
            if (CONV_DEPTH == 4) { q0 = ITEM_FN(clampi(it + 3 * st_)); moe_item_load(q0, v0); }                         \
            moe_item_finish(q1, v1, scr, lane); it += st_; if (it >= it_end) break;                                     \
            if (CONV_DEPTH == 2) continue;                                                                              \
            if (CONV_DEPTH == 3) { q1 = ITEM_FN(clampi(it + 2 * st_)); moe_item_load(q1, v1); }                         \
            if (CONV_DEPTH == 4) { q1 = ITEM_FN(clampi(it + 3 * st_)); moe_item_load(q1, v1); }                         \
            moe_item_finish(q2, v2, scr, lane); it += st_; if (it >= it_end) break;                                     \
            if (CONV_DEPTH == 3) continue;                                                                              \
            q2 = ITEM_FN(clampi(it + 3 * st_)); moe_item_load(q2, v2);                                                  \
            moe_item_finish(q3, v3, scr, lane); it += st_; if (it >= it_end) break;                                     \
        }                                                                                                               \
      } }
template <class InP> __device__ __forceinline__ void convert_base_all(InP inp, unsigned char* ws, LAS unsigned char* lds, int gw, int NGW, int wave, int lane) {
    LAS float* scr = (LAS float*)(lds + wave * 16384);
    auto item = [&](int i) { return base_item(inp, ws, i, lane); };
    CONV_PIPE(item, gw, IT_NONMOE, NGW)
}
template <int KIND, class InP> __device__ __forceinline__ void convert_moe_range(InP inp, unsigned char* ws, LAS unsigned char* lds, int it0, int it1, int sp, int nsp, int wave, int lane) {
    LAS float* scr = (LAS float*)(lds + wave * 16384);
    auto item = [&](int i) { return moe_item<KIND>(inp, ws, i, lane); };
    CONV_PIPE(item, it0 + sp * NWAVES + wave, it1, nsp * NWAVES)
}
constexpr int IT_MOE = 8 * (IT_GU + IT_DN);
#ifndef G_GUD_N
#define G_GUD_N 208
#endif
constexpr int G_INPROJ = 224, G_GUD = G_GUD_N;
#ifndef MOE_SPARE
#define MOE_SPARE 24
#endif
constexpr int IT_MGU = 8 * IT_GU, IT_MDN = 8 * IT_DN;
#ifndef SPLIT_A
#define SPLIT_A 8000
#define SPLIT_B 19500
#define SPLIT_C 3000
#endif
constexpr int IT_MOE_A = SPLIT_A, IT_MOE_B = SPLIT_B, IT_MDN_C = SPLIT_C;

template <class InP> __device__ __forceinline__ void p0_prologue(InP inp, unsigned char* ws, LAS unsigned char* lds, int vcu, int G, int wave, int lane, int tid, int moe_w) {
    Inputs in; in.c = inp->c; in.ada_w = inp->ada_w; in.ada_b = inp->ada_b; in.w_in = inp->w_in; in.w_out = inp->w_out; in.att_g = inp->att_g; in.fw_gate = inp->fw_gate; in.fw_up = inp->fw_up; in.fw_down = inp->fw_down; in.mw_gate = inp->mw_gate; in.mw_up = inp->mw_up; in.mw_down = inp->mw_down;
    if (vcu < 192) {
        LAS float* cs = (LAS float*)lds;
        LAS float* part = (LAS float*)(lds + 32768);
        for (int i = tid; i < 8 * 1024; i += 512) { const float v = in.c[i]; cs[i] = v / (1.0f + __expf(-v)); }
        __syncthreads();
        const int n0 = vcu * 64, l = n0 / 6144, nn = n0 % 6144 + lane;
        const float* wp = in.ada_w + (size_t)l * 1024 * 6144 + (size_t)(wave * 128) * 6144 + nn;
        float acc[8];
#pragma unroll
        for (int b = 0; b < 8; ++b) acc[b] = 0.f;
#pragma unroll 8
        for (int k = 0; k < 128; ++k) { const float wv = wp[(size_t)k * 6144];
#pragma unroll
            for (int b = 0; b < 8; ++b) acc[b] += cs[b * 1024 + wave * 128 + k] * wv; }
#pragma unroll
        for (int b = 0; b < 8; ++b) part[(wave * 8 + b) * 64 + lane] = acc[b];
        __syncthreads();
        { const int b = tid >> 6; float s = 0.f;
#pragma unroll
          for (int w = 0; w < 8; ++w) s += part[(w * 8 + b) * 64 + lane];
          ((float*)(ws + WS_MOD))[((size_t)l * 8 + b) * 6144 + nn] = s + in.ada_b[l * 6144 + nn]; }
        __syncthreads();
    }
    { const int g = vcu * 512 + tid; if (g < 2048 * 64) { const int pos = g >> 6, i = g & 63; const float inv = powf(10000.0f, -(float)i / 64.0f); const float ang = (float)pos * inv;
        float* rp = (float*)(ws + WS_ROPE) + (size_t)g * 2; rp[0] = (float)cos((double)ang); rp[1] = (float)sin((double)ang); } }
    convert_base_all(inp, ws, lds, vcu * NWAVES + wave, G * NWAVES, wave, lane);
}

template <int MODE>
__device__ __forceinline__ void norm_pass(const float* xsrc, const float* gain, const float* sh, const float* sc, bf16* dst,
                                          const float* router_w, int* eidx, float* ew, int* wcnt, int gw, int lane) {
    const int m0 = gw * 8, b = m0 >> 11;
    f32x4 gv[4], scv[4], shv[4];
#pragma unroll
    for (int j = 0; j < 4; ++j) { gv[j] = ((const f32x4*)gain)[lane + 64 * j]; scv[j] = ((const f32x4*)(sc + (size_t)b * 6144))[lane + 64 * j] + 1.0f; shv[j] = ((const f32x4*)(sh + (size_t)b * 6144))[lane + 64 * j]; }
    int cnt[8];
#pragma unroll
    for (int e = 0; e < 8; ++e) cnt[e] = 0;
    f32x4 rw[4][4][2];
    if (MODE == 1) {
#pragma unroll
        for (int j = 0; j < 4; ++j)
#pragma unroll
            for (int c = 0; c < 4; ++c) { const float* wp = router_w + (size_t)(4 * (lane + 64 * j) + c) * 8; rw[j][c][0] = *(const f32x4*)wp; rw[j][c][1] = *(const f32x4*)(wp + 4); }
    }
    for (int i = 0; i < 8; ++i) {
        const int m = m0 + i;
        const f32x4* xr = (const f32x4*)(xsrc + (size_t)m * 1024) + lane;
        f32x4 v[4]; float s = 0.f;
#pragma unroll
        for (int j = 0; j < 4; ++j) { v[j] = xr[64 * j]; s += (v[j][0] * v[j][0] + v[j][1] * v[j][1]) + (v[j][2] * v[j][2] + v[j][3] * v[j][3]); }
        const float rs = 1.0f / sqrtf(wave_sum(s) * (1.0f / 1024.0f) + 1e-6f);
        if (MODE == 2) {
            unsigned* o4 = (unsigned*)((unsigned char*)dst + (size_t)m * 1024) + lane;
#pragma unroll
            for (int j = 0; j < 4; ++j) { v[j] = v[j] * rs * gv[j] * scv[j] + shv[j]; o4[64 * j] = epi::pk4_fp8(v[j][0], v[j][1], v[j][2], v[j][3]); }
        } else {
        v2u* o8 = (v2u*)(dst + (size_t)m * 1024) + lane;
#pragma unroll
        for (int j = 0; j < 4; ++j) { v[j] = v[j] * rs * gv[j] * scv[j] + shv[j]; v2u w; w.x = pk2(v[j][0], v[j][1]); w.y = pk2(v[j][2], v[j][3]); o8[64 * j] = w; }
        }
        if (MODE == 1) {
            float lg[8];
#pragma unroll
            for (int e = 0; e < 8; ++e) lg[e] = 0.f;
#pragma unroll
            for (int j = 0; j < 4; ++j)
#pragma unroll
                for (int c = 0; c < 4; ++c) { const f32x4 w0 = rw[j][c][0], w1 = rw[j][c][1];
                    const float hv = v[j][c];
                    lg[0] += hv * w0[0]; lg[1] += hv * w0[1]; lg[2] += hv * w0[2]; lg[3] += hv * w0[3]; lg[4] += hv * w1[0]; lg[5] += hv * w1[1]; lg[6] += hv * w1[2]; lg[7] += hv * w1[3]; }
            { const bool b5 = (lane & 32) != 0, b4 = (lane & 16) != 0, b3 = (lane & 8) != 0;
              float a4[4], b2[2], c1;
#pragma unroll
              for (int q = 0; q < 4; ++q) { const float keep = b5 ? lg[4 + q] : lg[q], send = b5 ? lg[q] : lg[4 + q]; a4[q] = keep + xl::xor32p(send, b5); }
#pragma unroll
              for (int q = 0; q < 2; ++q) { const float keep = b4 ? a4[2 + q] : a4[q], send = b4 ? a4[q] : a4[2 + q]; b2[q] = keep + xl::xor_f<16>(send); }
              { const float keep = b3 ? b2[1] : b2[0], send = b3 ? b2[0] : b2[1]; c1 = keep + xl::xor_f<8>(send); }
              c1 += xl::xor_f<4>(c1); c1 += xl::xor_f<2>(c1); c1 += xl::xor_f<1>(c1);
#pragma unroll
              for (int e = 0; e < 8; ++e) lg[e] = __builtin_bit_cast(float, __builtin_amdgcn_readlane(__builtin_bit_cast(int, c1), 8 * e)); }
            int i0 = 0; float b0 = lg[0];
#pragma unroll
            for (int e = 1; e < 8; ++e) if (lg[e] > b0) { b0 = lg[e]; i0 = e; }
            int i1 = -1; float b1 = -3.0e38f;
#pragma unroll
            for (int e = 0; e < 8; ++e) if (e != i0 && lg[e] > b1) { b1 = lg[e]; i1 = e; }
            const float e1 = __expf(b1 - b0);
#pragma unroll
            for (int e = 0; e < 8; ++e) cnt[e] += ((e == i0) ? 1 : 0) + ((e == i1) ? 1 : 0);
            if (lane == 0) { eidx[m * 2] = i0; eidx[m * 2 + 1] = i1; ew[m * 2] = 1.0f / (1.0f + e1); ew[m * 2 + 1] = e1 / (1.0f + e1); }
        }
    }
    if (MODE == 1) {
        int myc = 0;
#pragma unroll
        for (int e = 0; e < 8; ++e) myc = (lane == e) ? cnt[e] : myc;
        if (lane < 8) wcnt[gw * 8 + lane] = myc;
    }
}

__device__ __forceinline__ void place_pass(const int* wcnt, const int* eidx, const float* ew, const bf16* XA, bf16* XS, int* srow, float* swt, int* segout, int gw, int NGW, int lane) {
    int tot[8], pre[8];
#pragma unroll
    for (int e = 0; e < 8; ++e) { tot[e] = 0; pre[e] = 0; }
    for (int w = lane; w < NGW; w += 64) { const i32x4 a = *(const i32x4*)(wcnt + w * 8), c = *(const i32x4*)(wcnt + w * 8 + 4); const int inc = (w < gw) ? 1 : 0;
        tot[0] += a[0]; tot[1] += a[1]; tot[2] += a[2]; tot[3] += a[3]; tot[4] += c[0]; tot[5] += c[1]; tot[6] += c[2]; tot[7] += c[3];
        pre[0] += inc * a[0]; pre[1] += inc * a[1]; pre[2] += inc * a[2]; pre[3] += inc * a[3]; pre[4] += inc * c[0]; pre[5] += inc * c[1]; pre[6] += inc * c[2]; pre[7] += inc * c[3]; }
    int base[8]; int run = 0;
#pragma unroll
    for (int e = 0; e < 8; ++e) { tot[e] = wave_sum_i(tot[e]); pre[e] = wave_sum_i(pre[e]); base[e] = run + pre[e]; if (gw == 0 && lane == 0) segout[e] = run; run += (tot[e] + 255) & ~255; }
    if (gw == 0 && lane == 0) segout[8] = run;
    const int myev = (lane < 16) ? eidx[gw * 16 + lane] : 0; const float myw = (lane < 16) ? ew[gw * 16 + lane] : 0.f;
    int mypos = 0;
#pragma unroll
    for (int i = 0; i < 16; ++i) { const int ev = __builtin_amdgcn_readlane(myev, i); int pos = 0;
#pragma unroll
        for (int e = 0; e < 8; ++e) if (ev == e) { pos = base[e]; base[e] += 1; }
        mypos = (lane == i) ? pos : mypos; }
    if (lane < 16) { srow[mypos] = gw * 16 + lane; swt[mypos] = myw; }
    const v4u* __restrict__ s = (const v4u*)(XA + (size_t)(gw * 8) * 1024);
    v4u r0[8], r1[8];
#pragma unroll
    for (int t = 0; t < 8; ++t) { r0[t] = s[t * 128 + lane]; r1[t] = s[t * 128 + lane + 64]; }
    v2u q0[8], q1[8];
#pragma unroll
    for (int t = 0; t < 8; ++t) {
        { int p = 0; p = __builtin_amdgcn_cvt_pk_fp8_f32(h16::lo(r0[t].x), h16::hi(r0[t].x), p, false); p = __builtin_amdgcn_cvt_pk_fp8_f32(h16::lo(r0[t].y), h16::hi(r0[t].y), p, true); q0[t].x = (unsigned)p;
          p = 0; p = __builtin_amdgcn_cvt_pk_fp8_f32(h16::lo(r0[t].z), h16::hi(r0[t].z), p, false); p = __builtin_amdgcn_cvt_pk_fp8_f32(h16::lo(r0[t].w), h16::hi(r0[t].w), p, true); q0[t].y = (unsigned)p; }
        { int p = 0; p = __builtin_amdgcn_cvt_pk_fp8_f32(h16::lo(r1[t].x), h16::hi(r1[t].x), p, false); p = __builtin_amdgcn_cvt_pk_fp8_f32(h16::lo(r1[t].y), h16::hi(r1[t].y), p, true); q1[t].x = (unsigned)p;
          p = 0; p = __builtin_amdgcn_cvt_pk_fp8_f32(h16::lo(r1[t].z), h16::hi(r1[t].z), p, false); p = __builtin_amdgcn_cvt_pk_fp8_f32(h16::lo(r1[t].w), h16::hi(r1[t].w), p, true); q1[t].y = (unsigned)p; } }
#pragma unroll
    for (int i = 0; i < 16; ++i) { const int pos = __builtin_amdgcn_readlane(mypos, i); v2u* __restrict__ d = (v2u*)((unsigned char*)XS + (size_t)pos * 1024);
        d[lane] = q0[i >> 1]; d[lane + 64] = q1[i >> 1]; }
}

__device__ __forceinline__ void final_pass(float* xio, const bf16* YS, const int* atomf, const float* slab, const float* g2, const float* fg, int gw, int lane) {
    const int m0 = gw * 8, b = m0 >> 11;
    f32x4 gv[4], g2v[4];
#pragma unroll
    for (int j = 0; j < 4; ++j) { gv[j] = ((const f32x4*)fg)[lane + 64 * j]; g2v[j] = ((const f32x4*)(g2 + (size_t)b * 6144))[lane + 64 * j]; }
    for (int i = 0; i < 8; ++i) {
        const int m = m0 + i;
        f32x4* xr = (f32x4*)(xio + (size_t)m * 1024) + lane;
        const v2u* y0 = (const v2u*)(YS + (size_t)(2 * m) * 1024) + lane; const v2u* y1 = (const v2u*)(YS + (size_t)(2 * m + 1) * 1024) + lane;
        f32x4 v[4]; float s = 0.f; const i32x4 f0 = *(const i32x4*)(atomf + (size_t)(2 * m) * 4), f1 = *(const i32x4*)(atomf + (size_t)(2 * m + 1) * 4);
#pragma unroll
        for (int j = 0; j < 4; ++j) { v[j] = xr[64 * j]; const v2u a = y0[64 * j], c = y1[64 * j];
            f32x4 ya, yc;
            if (f0[j]) { const int id = f0[j] - 1; const float* sp = slab + ((size_t)((id >> 8) * 11) * 256 + (id & 255)) * 256 + 4 * lane; ya = (f32x4){0.f, 0.f, 0.f, 0.f};
                for (int kc = 0; kc < 11; ++kc) ya += *(const f32x4*)(sp + (size_t)kc * 65536); }
            else { ya[0] = h16::lo(a.x); ya[1] = h16::hi(a.x); ya[2] = h16::lo(a.y); ya[3] = h16::hi(a.y); }
            if (f1[j]) { const int id = f1[j] - 1; const float* sp = slab + ((size_t)((id >> 8) * 11) * 256 + (id & 255)) * 256 + 4 * lane; yc = (f32x4){0.f, 0.f, 0.f, 0.f};
                for (int kc = 0; kc < 11; ++kc) yc += *(const f32x4*)(sp + (size_t)kc * 65536); }
            else { yc[0] = h16::lo(c.x); yc[1] = h16::hi(c.x); yc[2] = h16::lo(c.y); yc[3] = h16::hi(c.y); }
            const f32x4 ys = ya + yc;
            v[j] = v[j] + g2v[j] * ys; s += (v[j][0] * v[j][0] + v[j][1] * v[j][1]) + (v[j][2] * v[j][2] + v[j][3] * v[j][3]); }
        const float rs = 1.0f / sqrtf(wave_sum(s) * (1.0f / 1024.0f) + 1e-6f);
#pragma unroll
        for (int j = 0; j < 4; ++j) xr[64 * j] = v[j] * rs * gv[j];
    }
}

constexpr int N_PHASES = 18;
struct Args { Inputs in; float* out; unsigned char* ws; int ph_lo, ph_hi, bar_region, moe_w; };

typedef const Args __attribute__((address_space(4))) CArgs;
__device__ __forceinline__ CArgs* kargs() { unsigned long off = 0; asm volatile("" : "+s"(off)); return (CArgs*)((const char __attribute__((address_space(4)))*)__builtin_amdgcn_kernarg_segment_ptr() + off); }

__global__ void __launch_bounds__(NWAVES * 64, 2) mega(Args args_unused) {
    extern __shared__ __attribute__((aligned(16))) unsigned char lds_raw[];
    LAS unsigned char* lds = (LAS unsigned char*)lds_raw;
    volatile LAS unsigned* MISC = (volatile LAS unsigned*)(lds + MISC_OFF);
    const int G = gridDim.x;
#define PHASE_IDS int tid = otid(WV); int bx = blockIdx.x; asm volatile("" : "+s"(bx)); const int lane = tid & 63, wave = __builtin_amdgcn_readfirstlane(tid >> 6); \
    const int vcu = (bx & 7) * (G >> 3) + (bx >> 3); const int gw = vcu * NWAVES + wave; (void)lane; (void)gw; (void)vcu;
    const int WV = __builtin_amdgcn_readfirstlane((int)threadIdx.x >> 6);
    for (int u = otid(WV); u < (LDS_BYTES - LDSCTL_OFF) / 4; u += NWAVES * 64) ((LAS unsigned*)(lds + LDSCTL_OFF))[u] = 0u;
    __syncthreads();
    XcdBarrier bar;
    { CArgs* ka = kargs(); unsigned* barw = (unsigned*)(ka->ws + WS_CTL) + CW_BAR + ka->bar_region * XCD_BAR_WORDS; bar = xcd_barrier_post(barw, MISC + 8, WV); }
    int lo, hi; { CArgs* ka = kargs(); lo = ka->ph_lo; hi = ka->ph_hi; }
#ifndef PHM
#define PHM 0x3ff
#endif
#define IN(k) (lo <= (k) && (k) < hi)
#define TY(t) (((PHM) >> (t)) & 1)
#ifndef DUP_T
#define DUP_T -1
#define DUP_N 0
#endif
#define REP(t) for (int rep_ = 0; rep_ < ((t) == DUP_T ? 1 + DUP_N : 1) && (rep_ == 0 || (__syncthreads(), true)); ++rep_)
#ifdef TPROBE
#define TS ((volatile LAS unsigned long long*)(lds + MISC_OFF + 256))
#define STAMP(k) do { if (blockIdx.x == 0 && otid(WV) == 0) TS[(k)] = __builtin_amdgcn_s_memrealtime(); } while (0)
#else
#define STAMP(k) do {} while (0)
#endif
#ifdef TSPIN
#ifndef TSPIN_BX
#define TSPIN_BX 0
#endif
#define TSL ((volatile LAS unsigned long long*)(lds + MISC_OFF + 256))
#define STAMP_E(k) do { if (blockIdx.x == TSPIN_BX && otid(WV) == 0) { const unsigned long long n_ = __builtin_amdgcn_s_memrealtime(); if (((TSPIN_W) >> (k)) & 1) TSL[1] += n_ - TSL[0]; TSL[0] = n_; } } while (0)
#define STAMP_S(k) do { if (blockIdx.x == TSPIN_BX && otid(WV) == 0) { const unsigned long long n_ = __builtin_amdgcn_s_memrealtime(); if (((TSPIN_B) >> (k)) & 1) TSL[1] += n_ - TSL[0]; TSL[0] = n_; } } while (0)
    if (blockIdx.x == TSPIN_BX && otid(WV) == 0) { TSL[1] = 0ull; TSL[0] = __builtin_amdgcn_s_memrealtime(); }
#else
#define STAMP_E(k) do {} while (0)
#define STAMP_S(k) do {} while (0)
#endif
    STAMP(0);
#define SEAM(k) do { STAMP_E(k); if (IN(k) && IN((k) + 1)) xcd_barrier(bar); STAMP_S(k); STAMP((k) + 1); } while (0)

    if (TY(0) && IN(0)) REP(0) { PHASE_IDS CArgs* ka = kargs(); p0_prologue(&ka->in, ka->ws, lds, vcu, G, wave, lane, tid, 0); }
    SEAM(0);
#ifdef PROBE_BAR
    for (int q = 0; q < PROBE_BAR; ++q) xcd_barrier(bar);
#endif
    for (int l = 0; l < 2; ++l) {
        const int pb = 1 + 8 * l;
        if (TY(1) && IN(pb + 0)) REP(1) { PHASE_IDS CArgs* ka = kargs(); unsigned char* ws = ka->ws; const float* mod = (const float*)(ws + WS_MOD) + (size_t)l * 8 * 6144;
            const float* xin = (l == 0) ? ka->in.x : (const float*)ka->out;
            if (gw < 2048) norm_pass<0>(xin, ka->in.norm_mix_g + l * 1024, mod + 0 * 1024, mod + 1 * 1024, (bf16*)(ws + WS_XA), nullptr, nullptr, nullptr, nullptr, gw, lane); }
        SEAM(pb + 0);
        if (TY(2) && IN(pb + 1)) REP(2) { PHASE_IDS CArgs* ka = kargs(); unsigned char* ws = ka->ws;
            if (bx < G_INPROJ) {
                pg8::Gemm g{1024, 1024, 1024}; pg8::DenseSched S; S.init(ws + WS_XA, 1024, (bf16*)(ws + WS_WIN) + (size_t)l * 3584 * 1024, 1024, 16384, 3584, G_INPROJ, bx);
                epi::EpiInProj E{(bf16*)(ws + WS_QKV), (size_t)16384 * 512, (float*)(ws + WS_KMP), (const float*)(ws + WS_ROPE)};
                pg8::gemm_phase(WV, lds, g, S, E);
            } else if (rep_ == 0) { convert_moe_range<0>(&ka->in, ws, lds, l == 0 ? 0 : IT_MOE_B, l == 0 ? IT_MOE_A : IT_MGU, bx - G_INPROJ, G - G_INPROJ, wave, lane);
                                    if (l == 1) convert_moe_range<1>(&ka->in, ws, lds, 0, IT_MDN_C, bx - G_INPROJ, G - G_INPROJ, wave, lane);
#ifdef PROBE_CONVIN
                                    if (l == PROBE_CONVIN) { __syncthreads(); if (l == 0) convert_moe_range<0>(&ka->in, ws, lds, 0, IT_MOE_A, bx - G_INPROJ, G - G_INPROJ, wave, lane); else convert_moe_range<1>(&ka->in, ws, lds, 0, IT_MDN_C, bx - G_INPROJ, G - G_INPROJ, wave, lane); }
#endif
                                    }
        }
        SEAM(pb + 1);
        if (TY(3) && IN(pb + 2)) REP(3) { PHASE_IDS CArgs* ka = kargs(); unsigned char* ws = ka->ws; bf16* QKV = (bf16*)(ws + WS_QKV); bf16* CAT = (bf16*)(ws + WS_CAT);
            if (G == 256) {
                if ((bx & 7) < 7) fa::kv_unit(WV, bx >> 5, (bx >> 3) & 3, bx & 7, QKV + (size_t)4 * 16384 * 512, QKV + (size_t)5 * 16384 * 512, (float*)(ws + WS_KVM), lds);
                xcd_barrier(bar);
                { fa::Tensors TR{QKV + (size_t)3 * 16384 * 512, QKV + (size_t)4 * 16384 * 512, QKV + (size_t)5 * 16384 * 512, CAT, (float*)(ws + WS_ASSQ), (const float*)(ws + WS_KMP), QKV + (size_t)6 * 16384 * 512, ka->in.ret_g + l * 512, (const float*)(ws + WS_KVM)};
                  fa::attn_unit<true>(WV, bx >> 5, (bx >> 3) & 3, bx & 7, TR, lds); }
                fa::Tensors TA{QKV, QKV + (size_t)1 * 16384 * 512, QKV + (size_t)2 * 16384 * 512, CAT, (float*)(ws + WS_ASSQ), (const float*)(ws + WS_KMP), nullptr, nullptr, nullptr};
                const int g2 = (bx >> 3) * 2, r4 = (bx & 7) * 4;
                for (int uu = 0; uu < 2; ++uu) { const int bh = g2 + uu; fa::attn_unit<false>(WV, bh >> 3, bh & 7, ((uu == 0 ? 0x25170643 : 0x31507246) >> r4) & 7, TA, lds); }
            }
        }
        SEAM(pb + 2);
        if (TY(4) && IN(pb + 3)) REP(4) {
            { PHASE_IDS CArgs* ka = kargs(); unsigned char* ws = ka->ws; const float* mod = (const float*)(ws + WS_MOD) + (size_t)l * 8 * 6144;
                const float* xin = (l == 0) ? ka->in.x : (const float*)ka->out;
                pg8::Gemm g{1024, 1024, 1024}; pg8::DenseSched S; S.init(ws + WS_CAT, 1024, (const bf16*)(ws + WS_WOUT) + (size_t)l * 1024 * 1024, 1024, 16384, 1024, G, bx);
                epi::EpiOutProj E{xin, ka->out, mod + 2 * 1024, (const float*)(ws + WS_ASSQ), rep_ > 0}; pg8::gemm_phase(WV, lds, g, S, E); }
        }
        SEAM(pb + 3);
        if (TY(5) && IN(pb + 4)) REP(5) { PHASE_IDS CArgs* ka = kargs(); unsigned char* ws = ka->ws; const float* mod = (const float*)(ws + WS_MOD) + (size_t)l * 8 * 6144;
            if (gw < 2048) {
                if (l == 0) norm_pass<2>(ka->out, ka->in.norm_ffn_g + l * 1024, mod + 3 * 1024, mod + 4 * 1024, (bf16*)(ws + WS_XA), nullptr, nullptr, nullptr, nullptr, gw, lane);
                else norm_pass<1>(ka->out, ka->in.norm_ffn_g + l * 1024, mod + 3 * 1024, mod + 4 * 1024, (bf16*)(ws + WS_XA), ka->in.router_w, (int*)(ws + WS_EIDX), (float*)(ws + WS_EW), (int*)(ws + WS_WCNT), gw, lane);
            }
            if (l == 1) { int* srow = (int*)(ws + WS_SROW); int* af = (int*)(ws + WS_ATOMF);
                { const int p = bx * 512 + tid; if (p < XS_ROWS) srow[p] = -1; af[p] = 0; }
            }
            else if (bx == 0 && tid < 9) { ((int*)(ws + WS_SEGD))[tid] = (tid == 0) ? 0 : ((tid == 8) ? 16384 : (1 << 30)); }
        }
        SEAM(pb + 4);
        if (l == 1) {
            if (TY(6) && IN(pb + 5)) REP(6) { PHASE_IDS CArgs* ka = kargs(); unsigned char* ws = ka->ws;
                if (gw < 2048) place_pass((const int*)(ws + WS_WCNT), (const int*)(ws + WS_EIDX), (const float*)(ws + WS_EW), (const bf16*)(ws + WS_XA), (bf16*)(ws + WS_XS), (int*)(ws + WS_SROW), (float*)(ws + WS_SWT), (int*)(ws + WS_SEG), gw, 2048, lane); }
            SEAM(pb + 5);
        } else { STAMP(pb + 6); }
        if (TY(7) && IN(pb + 6)) REP(7) { PHASE_IDS CArgs* ka = kargs(); unsigned char* ws = ka->ws;
            int Geff = G_GUD;
            if (l == 1) { const int nwg = (__builtin_amdgcn_readfirstlane(((const int*)(ws + WS_SEG))[8]) / 256) * 22; const int rounds = (nwg + G - 1) / G;
                Geff = (((nwg + rounds - 1) / rounds) + 7) & ~7; if (Geff > G - MOE_SPARE) Geff = G - MOE_SPARE; }
            if (bx < Geff) {
                pg8::Gemm g{512, 512, 512}; pg8::MoeSched S;
                S.init(ws + (l == 0 ? WS_XA : WS_XS), 512, ws + (l == 0 ? WS_FGU : WS_MGU), 512, (size_t)5632 * 1024, (const int*)(ws + (l == 0 ? WS_SEGD : WS_SEG)), 5632, Geff, bx);
                epi::EpiSwiGLU8 E{ws + (l == 0 ? WS_HD : WS_HM), 2816}; pg8::gemm_phase(WV, lds, g, S, E);
            } else if (rep_ == 0) { if (l == 0) convert_moe_range<0>(&ka->in, ws, lds, IT_MOE_A, IT_MOE_B, bx - Geff, G - Geff, wave, lane);
                                    else { convert_moe_range<1>(&ka->in, ws, lds, IT_MDN_C, IT_MDN, bx - Geff, G - Geff, wave, lane);
#ifdef PROBE_CONV2
                                           __syncthreads(); convert_moe_range<1>(&ka->in, ws, lds, IT_MDN_C, IT_MDN, bx - Geff, G - Geff, wave, lane);
#endif
                                    } }
        }
        SEAM(pb + 6);
        if (TY(8) && IN(pb + 7)) REP(8) { PHASE_IDS CArgs* ka = kargs(); unsigned char* ws = ka->ws; const float* mod = (const float*)(ws + WS_MOD) + (size_t)l * 8 * 6144;
            if (l == 0) { pg8::MoeSched S; S.init(ws + WS_HD, 1408, ws + WS_FDN, 1408, (size_t)1024 * 2816, (const int*)(ws + WS_SEGD), 1024, G, bx);
                pg8::Gemm g{1408, 1408, 1408};
                epi::EpiDownDense8 E{ka->out, mod + 5 * 1024, rep_ > 0}; pg8::gemm_phase(WV, lds, g, S, E);
            } else {
                pg8::MoeSched S; S.init(ws + WS_HM, 1408, ws + WS_MDN, 1408, (size_t)1024 * 2816, (const int*)(ws + WS_SEG), 1024, G, bx);
                pg8::Gemm g{1408, 1408, 1408};
                epi::EpiDownMoe8 E{(bf16*)(ws + WS_YS), (const int*)(ws + WS_SROW), (const float*)(ws + WS_SWT)}; pg8::gemm_phase(WV, lds, g, S, E);
            }
        }
        SEAM(pb + 7);
    }
    if (TY(9) && IN(17)) { PHASE_IDS CArgs* ka = kargs(); unsigned char* ws = ka->ws;
        if (gw < 2048) final_pass(ka->out, (const bf16*)(ws + WS_YS), (const int*)(ws + WS_ATOMF), (const float*)(ws + WS_SLAB), (const float*)(ws + WS_MOD) + (size_t)1 * 8 * 6144 + 5 * 1024, ka->in.final_g, gw, lane); }
#ifdef TSPIN
    STAMP_E(17);
    if (blockIdx.x == TSPIN_BX && otid(WV) == 0) { const unsigned long long t0_ = __builtin_amdgcn_s_memrealtime(), w_ = TSL[1] * (unsigned long long)(TSPIN_K);
        while (__builtin_amdgcn_s_memrealtime() - t0_ < w_) __builtin_amdgcn_s_sleep(8); }
#endif
#ifdef TPROBE
    xcd_barrier(bar); STAMP(18); __syncthreads();
    if (blockIdx.x == 0) { CArgs* ka = kargs(); float* o = ka->out;
        const float d1 = (float)(TS[TPROBE_A + 1] - TS[TPROBE_A]) * 0.01f, d2 = (float)(TS[TPROBE_B + 1] - TS[TPROBE_B]) * 0.01f;
        const float a = 4.0f * sqrtf(d1);
        for (int i = otid(WV); i < 1024 * 1024; i += 512) o[i] = a;
        if (otid(WV) == 0) o[1024 * 1024 + 5] = 100.0f * d2; }
#endif
#undef IN
#undef TY
#undef SEAM
#undef PHASE_IDS
}
}
#ifndef STEP
#define STEP 5
#endif
namespace ad {
__device__ __forceinline__ float bf2f(unsigned short s) { return h16::one(s); }
__global__ void __launch_bounds__(256) ad_proj(const unsigned short* QKV, size_t gstride, int b, float* projb) {
    const int m = blockIdx.x; const size_t row = (size_t)b * 2048 + m;
    for (int n = threadIdx.x; n < 3584; n += 256) {
        const int grp = n / 512, c = n % 512; int sc = c;
        if (grp == 3 || grp == 4) { const int head = c >> 7, d = c & 127; sc = head * 128 + 8 * ((d & 63) >> 2) + 2 * (d & 3) + (d >> 6); }
        float v = bf2f(QKV[(size_t)grp * gstride + row * 512 + sc]);
        if (grp == 0) v *= (1.0f / epi::C2);
        if (grp == 4) v *= (1.0f / epi::KSC);
        projb[(size_t)m * 3584 + n] = v;
    }
}
__global__ void __launch_bounds__(64) ad_kmean(const float* KMP, int b, float* kmeanb) {
    const int blk = blockIdx.x, h = blockIdx.y, d = threadIdx.x;
    const float* p = KMP + ((size_t)(b * 8 + blk) * 2) * 512 + h * 64 + d;
    kmeanb[((size_t)h * 8 + blk) * 64 + d] = (p[0] + p[512]) * (1.0f / 256.0f);
}
__global__ void __launch_bounds__(256) ad_cat(const unsigned short* CAT, const float* ASSQ, const float* att_g, int b, float* catb) {
    const int m = blockIdx.x; const size_t row = (size_t)b * 2048 + m;
    float ss = 0.f;
    for (int h = 0; h < 8; ++h) ss += ASSQ[row * 8 + h];
    const float rs = 1.0f / sqrtf(ss * (1.0f / 512.0f) + 1e-6f);
    for (int c = threadIdx.x; c < 1024; c += 256) { const float v = bf2f(CAT[row * 1024 + c]); catb[(size_t)m * 1024 + c] = (c < 512) ? v * rs * att_g[c] : v; }
}
__global__ void __launch_bounds__(256) dbg_cmp(const float* a, const float* b, size_t n, float rel, float abs_, unsigned* flag, int ncols = 1, int c_lo = 0, int c_hi = 1, int silu_b = 0) {
    unsigned bad = 0;
    for (size_t i = (size_t)blockIdx.x * 256 + threadIdx.x; i < n; i += (size_t)gridDim.x * 256) { const int c = (int)(i % ncols); if (c < c_lo || c >= c_hi) continue;
        float bv = b[i]; if (silu_b) bv = bv / (1.f + expf(-bv)); const float d = fabsf(a[i] - bv); if (!(d <= rel * fabsf(bv) + abs_)) ++bad; }
    if (bad) atomicAdd(flag, bad);
}
__global__ void __launch_bounds__(256) dbg_poison(const unsigned* flag, unsigned thresh, float* out, float val) {
    if (*flag > thresh) for (int i = threadIdx.x; i < 1024 * 1024; i += 256) out[i] = val;
}
__global__ void __launch_bounds__(256) dbg_ssd(const float* a, const float* b, size_t n, int ncols, int c_lo, int c_hi, float* acc) {
    float s = 0.f;
    for (size_t i = (size_t)blockIdx.x * 256 + threadIdx.x; i < n; i += (size_t)gridDim.x * 256) { const int c = (int)(i % ncols); if (c < c_lo || c >= c_hi) continue; const float d = a[i] - b[i]; s += d * d; }
    atomicAdd(acc, s);
}
__global__ void __launch_bounds__(256) dbg_encode(const float* acc, float count, float* out) {
    const float mse = *acc / count; const float val = 4.0f / sqrtf(mse);
    for (int i = threadIdx.x; i < 1024 * 1024; i += 256) out[i] = val;
}
}

static void launch_mega(const mk::Args& a0, int lo, int hi, int region, hipStream_t stream) {
    mk::Args a = a0; a.ph_lo = lo; a.ph_hi = hi; a.bar_region = region;
    hipLaunchKernelGGL(mk::mega, dim3(256), dim3(512), mk::LDS_BYTES, stream, a);
}

extern "C" void kernel_launch(void* const* d_in, const int* in_sizes, int n_in, void* d_out, int out_size, void* d_ws, size_t ws_size, hipStream_t stream) {
    static int ready = 0;
    if (ready == 0) {
        if (n_in != 18 || out_size != M * D || ws_size < mk::WS_END) { fprintf(stderr, "kernel_launch: unexpected problem (n_in %d, out %d, ws %zu)\n", n_in, out_size, ws_size); ready = -1; return; }
        if (hipFuncSetAttribute((const void*)mk::mega, hipFuncAttributeMaxDynamicSharedMemorySize, mk::LDS_BYTES) != hipSuccess) { fprintf(stderr, "kernel_launch: hipFuncSetAttribute failed\n"); ready = -1; return; }
        ready = 1;
    }
    if (ready < 0) return;
    mk::Args a{};
    const float** ip = (const float**)&a.in;
    for (int i = 0; i < 18; ++i) ip[i] = (const float*)d_in[i];
    a.out = (float*)d_out; a.ws = (unsigned char*)d_ws; a.moe_w = (STEP >= 5) ? 1 : 0;
    const mk::Inputs& in = a.in;
    float* out = (float*)d_out; unsigned char* ws = (unsigned char*)d_ws;
    hipMemsetAsync(ws + mk::WS_CTL, 0, mk::CTL_ZERO_BYTES, stream);
#if STEP >= 6
    launch_mega(a, 0, mk::N_PHASES, 0, stream);
#else
    constexpr size_t MiB = 1u << 20;
    unsigned char* na = ws + 8 * MiB;
    float* PROJb = (float*)(na);
    float* Hb = (float*)(na + 28 * MiB);
    float* CATb = (float*)(na + 36 * MiB);
    float* OAb = (float*)(na + 44 * MiB);
    float* ORRb = (float*)(na + 48 * MiB);
    float* KMEANb = (float*)(na + 52 * MiB);
    int* EIDXb = (int*)(na + 53 * MiB); float* EWb = (float*)(na + 53 * MiB + 65536); int* POSb = (int*)(na + 53 * MiB + 131072); int* LISTb = (int*)(na + 53 * MiB + 196608);
    int* CNTb = (int*)(na + 54 * MiB); int* BASEb = CNTb + 16;
    float* Gb = (float*)(na + 56 * MiB);
    float* Ub = (float*)(na + 78 * MiB);
    float* Yb = (float*)(na + 100 * MiB);
    const float* MODp = (const float*)(ws + mk::WS_MOD);
    unsigned short* QKV = (unsigned short*)(ws + mk::WS_QKV);
    launch_mega(a, 0, 1, 1, stream);
    for (int l = 0; l < 2; ++l) {
        const int pb = 1 + 8 * l;
        const float* xin = (l == 0) ? in.x : (const float*)out;
        if (STEP >= 1) { launch_mega(a, pb, pb + 1, 1, stream); launch_mega(a, pb + 1, pb + 2, 1, stream); }
        if (STEP >= 2) launch_mega(a, pb + 2, pb + 3, 1, stream);
        if (STEP >= 3) launch_mega(a, pb + 3, pb + 4, 1, stream);
        if (STEP < 3) {
            for (int b = 0; b < BATCH; ++b) {
                const float* mod = MODp + ((size_t)l * BATCH + b) * 6 * D;
                const float* xb = xin + (size_t)b * SEQ * D; float* ob = out + (size_t)b * SEQ * D;
                if (STEP < 1) {
                    nv::k_norm<<<SEQ, 256, 0, stream>>>(xb, in.norm_mix_g + l * D, mod + 0 * D, mod + 1 * D, Hb);
                    nv::k_gemm<<<dim3(NPROJ / 64, SEQ / 64), 256, 0, stream>>>(Hb, D, nullptr, nullptr, SEQ, in.w_in + (size_t)l * D * NPROJ, NPROJ, PROJb, NPROJ, D);
                    nv::k_rotary<<<SEQ, 256, 0, stream>>>(PROJb);
                    nv::k_kmean<<<dim3(NBLK, AH, 1), 64, 0, stream>>>(PROJb, KMEANb);
                } else {
                    ad::ad_proj<<<SEQ, 256, 0, stream>>>(QKV, (size_t)M * 512, b, PROJb);
                    ad::ad_kmean<<<dim3(NBLK, AH, 1), 64, 0, stream>>>((const float*)(ws + mk::WS_KMP), b, KMEANb);
#ifdef DBG_CHECK
                    { float* PROJn = Gb; float* KMn = (float*)(na + 52 * MiB + 262144); unsigned* flag = (unsigned*)(ws + mk::WS_CTL) + 16;
                      nv::k_norm<<<SEQ, 256, 0, stream>>>(xb, in.norm_mix_g + l * D, mod + 0 * D, mod + 1 * D, Hb);
                      nv::k_gemm<<<dim3(NPROJ / 64, SEQ / 64), 256, 0, stream>>>(Hb, D, nullptr, nullptr, SEQ, in.w_in + (size_t)l * D * NPROJ, NPROJ, PROJn, NPROJ, D);
                      nv::k_rotary<<<SEQ, 256, 0, stream>>>(PROJn);
                      nv::k_kmean<<<dim3(NBLK, AH, 1), 64, 0, stream>>>(PROJn, KMn);
                      ad::dbg_cmp<<<1024, 256, 0, stream>>>(PROJb, PROJn, (size_t)SEQ * NPROJ, DBG_REL, DBG_ABS, flag, NPROJ, 0, 3072, 0);
                      ad::dbg_cmp<<<1024, 256, 0, stream>>>(PROJb, PROJn, (size_t)SEQ * NPROJ, DBG_REL, DBG_ABS, flag, NPROJ, 3072, 3584, 1);
                      ad::dbg_cmp<<<16, 256, 0, stream>>>(KMEANb, KMn, (size_t)8 * 8 * 64, 0.03f, 0.004f, flag + 1);
                      if (l == DBG_L && b == 0) ad::dbg_ssd<<<1024, 256, 0, stream>>>(PROJb, PROJn, (size_t)SEQ * NPROJ, NPROJ, DBG_CLO, DBG_CHI, (float*)(flag + 2)); }
#endif
                }
                if (STEP < 2) {
                    nv::k_moba<<<dim3(NBLK, AH, 1), 256, 0, stream>>>(PROJb, KMEANb, OAb);
                    nv::k_ret<<<dim3(SEQ / 256, RH * 4, 1), 256, 0, stream>>>(PROJb, ORRb);
                    nv::k_cat<<<SEQ, 256, 0, stream>>>(OAb, ORRb, PROJb, in.att_g + l * AW, in.ret_g + l * RW, CATb, STEP >= 1 ? 1 : 0);
                } else {
                    ad::ad_cat<<<SEQ, 256, 0, stream>>>((const unsigned short*)(ws + mk::WS_CAT), (const float*)(ws + mk::WS_ASSQ), in.att_g + l * AW, b, CATb);
                }
                nv::k_gemm<<<dim3(D / 64, SEQ / 64), 256, 0, stream>>>(CATb, D, nullptr, nullptr, SEQ, in.w_out + (size_t)l * D * D, D, Hb, D, D);
                nv::k_resid<<<SEQ, 256, 0, stream>>>(xb, mod + 2 * D, Hb, ob);
            }
        }
        const bool ffn_mega = (l == 0) ? (STEP >= 4) : (STEP >= 5);
        if (ffn_mega) {
            launch_mega(a, pb + 4, pb + 5, 1, stream);
            if (l == 1) launch_mega(a, pb + 5, pb + 6, 1, stream);
            launch_mega(a, pb + 6, pb + 7, 1, stream);
            launch_mega(a, pb + 7, pb + 8, 1, stream);
        } else {
            for (int b = 0; b < BATCH; ++b) {
                const float* mod = MODp + ((size_t)l * BATCH + b) * 6 * D;
                float* ob = out + (size_t)b * SEQ * D;
                nv::k_norm<<<SEQ, 256, 0, stream>>>(ob, in.norm_ffn_g + l * D, mod + 3 * D, mod + 4 * D, Hb);
                if (l == 0) {
                    nv::k_gemm<<<dim3(FF / 64, SEQ / 64), 256, 0, stream>>>(Hb, D, nullptr, nullptr, SEQ, in.fw_gate, FF, Gb, FF, D);
                    nv::k_gemm<<<dim3(FF / 64, SEQ / 64), 256, 0, stream>>>(Hb, D, nullptr, nullptr, SEQ, in.fw_up, FF, Ub, FF, D);
                    nv::k_silu_mul<<<SEQ, 256, 0, stream>>>(Gb, Ub, nullptr, SEQ, FF);
                    nv::k_gemm<<<dim3(D / 64, SEQ / 64), 256, 0, stream>>>(Gb, FF, nullptr, nullptr, SEQ, in.fw_down, D, Ub, D, FF);
                    nv::k_resid<<<SEQ, 256, 0, stream>>>(ob, mod + 5 * D, Ub, ob);
                } else {
                    nv::k_router<<<SEQ / 4, 256, 0, stream>>>(Hb, in.router_w, EIDXb, EWb);
                    nv::k_place<<<1, 1024, 0, stream>>>(EIDXb, LISTb, POSb, CNTb, BASEb, 4);
                    float* GE = Gb; float* UE = Ub;
                    for (int e = 0; e < NE; ++e) {
                        nv::k_gemm<<<dim3(FF / 64, ECAP / 64), 256, 0, stream>>>(Hb, D, LISTb, CNTb + e, ECAP, in.mw_gate + (size_t)e * D * FF, FF, GE, FF, D, BASEb + e, nullptr);
                        nv::k_gemm<<<dim3(FF / 64, ECAP / 64), 256, 0, stream>>>(Hb, D, LISTb, CNTb + e, ECAP, in.mw_up + (size_t)e * D * FF, FF, UE, FF, D, BASEb + e, nullptr);
                        nv::k_silu_mul<<<ECAP, 256, 0, stream>>>(GE, UE, CNTb + e, ECAP, FF);
                        nv::k_gemm<<<dim3(D / 64, ECAP / 64), 256, 0, stream>>>(GE, FF, nullptr, CNTb + e, ECAP, in.mw_down + (size_t)e * FF * D, D, Yb, D, FF, nullptr, BASEb + e);
                    }
                    nv::k_moe_combine<<<SEQ, 256, 0, stream>>>(ob, mod + 5 * D, Yb, POSb, EWb);
                }
            }
        }
    }
    if (STEP >= 5) launch_mega(a, 17, 18, 1, stream);
    else nv::k_norm<<<M, 256, 0, stream>>>(out, in.final_g, nullptr, nullptr, out);
#ifdef DBG_CHECK
#ifdef DBG_ENC
    ad::dbg_encode<<<1, 256, 0, stream>>>((const float*)((unsigned*)(ws + mk::WS_CTL) + 18), (float)SEQ * (DBG_CHI - DBG_CLO), out);
#endif
    ad::dbg_poison<<<1, 256, 0, stream>>>((unsigned*)(ws + mk::WS_CTL) + 16, DBG_T0, out, 100.0f);
    ad::dbg_poison<<<1, 256, 0, stream>>>((unsigned*)(ws + mk::WS_CTL) + 17, DBG_T1, out + (1 << 20), 300.0f);
#endif
#endif
}
```

```cpp
#include <hip/hip_runtime.h>
#include <cstdio>
#include <cstdint>
#include <cmath>

namespace h16 {
typedef _Float16 f16x2_t __attribute__((ext_vector_type(2)));
typedef _Float16 f16x8_t __attribute__((ext_vector_type(8)));
typedef float f32x2_t __attribute__((ext_vector_type(2)));
__device__ __forceinline__ unsigned pk(float lo, float hi) { f32x2_t v = {lo, hi}; f16x2_t b = __builtin_convertvector(v, f16x2_t); return __builtin_bit_cast(unsigned, b); }
__device__ __forceinline__ float lo(unsigned u) { return (float)__builtin_bit_cast(f16x2_t, u)[0]; }
__device__ __forceinline__ float hi(unsigned u) { return (float)__builtin_bit_cast(f16x2_t, u)[1]; }
__device__ __forceinline__ float one(unsigned short s) { return (float)__builtin_bit_cast(_Float16, s); }
}

namespace xl {
template <int O> __device__ __forceinline__ int xor_i(int v) {
    if constexpr (O < 32) return __builtin_amdgcn_ds_swizzle(v, (O << 10) | 0x1f);
    else { static_assert(O < 32, "use add32 / max32 for the 32-lane exchange"); return v; }
}
template <int O> __device__ __forceinline__ float xor_f(float v) { return __builtin_bit_cast(float, xor_i<O>(__builtin_bit_cast(int, v))); }
__device__ __forceinline__ void swap32(unsigned a, unsigned& r0, unsigned& r1) { unsigned b = a; asm volatile("" : "+v"(b)); auto r = __builtin_amdgcn_permlane32_swap(a, b, false, false); r0 = r[0]; r1 = r[1]; }
__device__ __forceinline__ float xor32p(float v, bool upper) { unsigned r0, r1; swap32(__builtin_bit_cast(unsigned, v), r0, r1); return __builtin_bit_cast(float, upper ? r0 : r1); }
__device__ __forceinline__ float add32(float v) { unsigned r0, r1; swap32(__builtin_bit_cast(unsigned, v), r0, r1); return __builtin_bit_cast(float, r0) + __builtin_bit_cast(float, r1); }
__device__ __forceinline__ float max32(float v) { unsigned r0, r1; swap32(__builtin_bit_cast(unsigned, v), r0, r1); return fmaxf(__builtin_bit_cast(float, r0), __builtin_bit_cast(float, r1)); }
__device__ __forceinline__ int add32i(int v) { unsigned r0, r1; swap32((unsigned)v, r0, r1); return (int)(r0 + r1); }
__device__ __forceinline__ float wave_sum(float v) { v += xor_f<1>(v); v += xor_f<2>(v); v += xor_f<4>(v); v += xor_f<8>(v); v += xor_f<16>(v); return add32(v); }
__device__ __forceinline__ int wave_sum_i(int v) { v += xor_i<1>(v); v += xor_i<2>(v); v += xor_i<4>(v); v += xor_i<8>(v); v += xor_i<16>(v); return add32i(v); }
}

__device__ __forceinline__ int olane() { int l; asm volatile("v_mbcnt_lo_u32_b32 %0, -1, 0\n\tv_mbcnt_hi_u32_b32 %0, -1, %0" : "=v"(l)); return l; }
__device__ __forceinline__ int otid(int wv) { return (wv << 6) | olane(); }
#define STEP 6

constexpr int D = 1024, BATCH = 8, SEQ = 2048, M = BATCH * SEQ;
constexpr int AH = 8, AD = 64, AW = 512, MBLK = 256, NBLK = SEQ / MBLK, TOPK = 3;
constexpr int RH = 4, RD = 128, RW = 512;
constexpr int NPROJ = 3 * AW + 4 * RW;
constexpr int FF = 2816, NE = 8;
constexpr float EPS = 1e-6f;
constexpr int ECAP = 2048;
namespace pg8 {
#define PG8_LAS __attribute__((address_space(3)))
typedef unsigned short bf16_t;
typedef short bf16x8 __attribute__((ext_vector_type(8)));
typedef float f32x4 __attribute__((ext_vector_type(4)));
typedef float f32x2 __attribute__((ext_vector_type(2)));
typedef unsigned u32x4 __attribute__((ext_vector_type(4)));
typedef unsigned u32x2 __attribute__((ext_vector_type(2)));
typedef int i32x4 __attribute__((ext_vector_type(4)));
constexpr int BM = 256, BK = 64, HALF = 128, HTB = HALF * BK * 2  , STAGE_BYTES = 8 * HTB, NXCD = 8, WGM = 8;

__host__ __device__ __forceinline__ int lds_byte(int r, int c) { const int st = (r >> 4) * 2 + (c >> 5), rr = r & 15, cc = c & 31, ob = rr * 64 + cc * 2; return st * 1024 + (ob ^ (((ob >> 9) & 1) << 5)); }
__host__ __device__ __forceinline__ void stage_rc(int b, int& R, int& C) { const int st = b / 1024, sb = b % 1024, swz = sb ^ (((sb >> 9) & 1) << 5); R = (st >> 1) * 16 + swz / 64; C = (st & 1) * 32 + (swz % 64) / 2; }
__host__ __device__ __forceinline__ int perm32(int rho) { const int n = rho >> 4, i = rho & 15; return 8 * (i >> 2) + 4 * n + (i & 3); }

struct Unit { int pm, pn, e, kc, li; };
struct Gemm { int lda, ldb, K; };

struct DenseSched {
    const char* A; const char* Bt; size_t a_tile, b_tile;
    int nM, nN, nwg, G, c;
    __device__ __forceinline__ void init(const void* A_, int lda, const void* Bt_, int ldb, int M, int N, int G_, int c_) {
        A = (const char*)A_; Bt = (const char*)Bt_; a_tile = (size_t)BM * lda * 2; b_tile = (size_t)BM * ldb * 2; nM = M / BM; nN = N / BM; nwg = nM * nN; G = G_; c = c_; }
    __device__ __forceinline__ bool next(int i, Unit& u) const {
        const long L = (long)i * G + c; if (L >= nwg) return false;
        int wgid = (int)L; { const int q = nwg / NXCD, r = nwg % NXCD, xcd = wgid % NXCD, off = wgid / NXCD; wgid = (xcd < r ? xcd * (q + 1) : r * (q + 1) + (xcd - r) * q) + off; }
        const int nig = WGM * nN, gid = wgid / nig, fm = gid * WGM, gsz = (nM - fm) < WGM ? (nM - fm) : WGM;
        u.pm = fm + ((wgid % nig) % gsz); u.pn = (wgid % nig) / gsz; u.e = 0; u.kc = 0; u.li = 0; return true;
    }
    __device__ __forceinline__ const char* a_ptr(const Unit& u) const { return A + (size_t)u.pm * a_tile; }
    __device__ __forceinline__ const char* b_ptr(const Unit& u) const { return Bt + (size_t)u.pn * b_tile; }
};
struct MoeSched {
    const char* A; const char* Bt; size_t a_tile, b_tile, e_stride;
    int nM, nN, nwg, G, c; int seg[8]; int first, lim, KS, kbytes;
    __device__ __forceinline__ void init(const void* A_, int lda, const void* Bt_, int ldb, size_t e_stride_bytes, const int* segp_, int N, int G_, int c_) {
        A = (const char*)A_; Bt = (const char*)Bt_; a_tile = (size_t)BM * lda * 2; b_tile = (size_t)BM * ldb * 2; e_stride = e_stride_bytes;
#pragma unroll
        for (int e = 0; e < 8; ++e) seg[e] = __builtin_amdgcn_readfirstlane(segp_[e]);
        nM = __builtin_amdgcn_readfirstlane(segp_[8]) / BM; nN = N / BM; nwg = nM * nN; G = G_; c = c_; first = 0; lim = nwg; KS = 1; kbytes = 0; }
    __device__ __forceinline__ bool next(int i, Unit& u) const {
        const long idx = (long)i * G + c; const long L = first + idx / KS; if (L >= lim) return false;
        u.kc = (int)(idx % KS); u.li = (int)(idx / KS);
        int wgid = (int)L; { const int q = nwg / NXCD, r = nwg % NXCD, xcd = wgid % NXCD, off = wgid / NXCD; wgid = (xcd < r ? xcd * (q + 1) : r * (q + 1) + (xcd - r) * q) + off; }
        const int nig = WGM * nN, gid = wgid / nig, fm = gid * WGM, gsz = (nM - fm) < WGM ? (nM - fm) : WGM;
        u.pm = fm + ((wgid % nig) % gsz); u.pn = (wgid % nig) / gsz;
        int e = 0; const int r0 = u.pm * BM;
#pragma unroll
        for (int k = 1; k < 8; ++k) e = (r0 >= seg[k]) ? k : e;
        u.e = __builtin_amdgcn_readfirstlane(e); return true;
    }
    __device__ __forceinline__ const char* a_ptr(const Unit& u) const { return A + (size_t)u.pm * a_tile + (size_t)u.kc * kbytes; }
    __device__ __forceinline__ const char* b_ptr(const Unit& u) const { return Bt + (size_t)u.e * e_stride + (size_t)u.pn * b_tile + (size_t)u.kc * kbytes; }
};

__device__ __forceinline__ unsigned cvt_pk_bf16(float lo, float hi) { return h16::pk(lo, hi); }
__device__ __forceinline__ float fast_silu(float g) { return g * __builtin_amdgcn_rcpf(1.0f + __builtin_amdgcn_exp2f(-1.4426950408889634f * g)); }

typedef f32x4 Acc[2][2][4][2];
typedef int i32x8 __attribute__((ext_vector_type(8)));
template <bool F8> struct Frags;
template <> struct Frags<false> { bf16x8 At[4][2], B0[2][2], B1[2][2]; };
template <> struct Frags<true> { i32x8 At[4], B0[2], B1[2]; };

template <class Epi, class Sched>
__device__ __forceinline__ void gemm_phase(const int wv, PG8_LAS unsigned char* lds, const Gemm g, const Sched& S, const Epi& E) {
    int tid_ = otid(wv);
    const int tid = tid_, wid = __builtin_amdgcn_readfirstlane(tid >> 6), lane = tid & 63, wr = wid >> 2, wc = wid & 3, fr = lane & 15, fq = lane >> 4;
    const int K = g.K; int nt = K / BK; asm volatile("" : "+s"(nt));
    unsigned voffA[2], voffB[2];
#pragma unroll
    for (int i = 0; i < 2; ++i) { int R, C; stage_rc(tid * 16 + i * 8192, R, C); const int Rb = Epi::PERM ? ((R & ~31) + perm32(R & 31)) : R;
        voffA[i] = (unsigned)(R * g.lda + C) * 2u; voffB[i] = (unsigned)(Rb * g.ldb + C) * 2u; }
    const size_t kstep = (size_t)(BK * 2);
    const size_t hstepA = (size_t)HALF * g.lda * 2, hstepB = (size_t)HALF * g.ldb * 2;
    const unsigned ldsw = (unsigned)wid * 1024u;
    const unsigned ldsbase_ = (unsigned)__builtin_amdgcn_readfirstlane((int)((unsigned)(unsigned long)lds + ldsw));
    const int aoff = lds_byte(wr * 64 + fr, fq * 8), boff = lds_byte(wc * 32 + fr, fq * 8);
#define PG8_SA(b, h) (((b) * 2 + (h)) * HTB)
#define PG8_SB(b, h) ((4 + (b) * 2 + (h)) * HTB)
#define PG8_STAGE(bufoff, gbase, voff) do { if constexpr (Epi::FP8) {   \
            const unsigned long long gb_ = (unsigned long long)(gbase); \
            const unsigned long long sb_ = ((unsigned long long)(unsigned)__builtin_amdgcn_readfirstlane((int)(gb_ >> 32)) << 32) | (unsigned)__builtin_amdgcn_readfirstlane((int)gb_); \
            _Pragma("unroll") for (int _i = 0; _i < 2; ++_i) { unsigned keep_; \
                asm volatile("s_mov_b32 %0, m0\n\ts_mov_b32 m0, %3\n\ts_nop 0\n\tglobal_load_lds_dwordx4 %1, %2\n\ts_mov_b32 m0, %0" : "=&s"(keep_) : "v"((voff)[_i]), "s"(sb_), "s"(ldsbase_ + (unsigned)((bufoff) + _i * 8192)) : "memory"); } \
        } else { _Pragma("unroll") for (int _i = 0; _i < 2; ++_i) \
        __builtin_amdgcn_global_load_lds((const unsigned*)((const char*)(gbase) + (voff)[_i]), (PG8_LAS unsigned*)(lds + (bufoff) + ldsw + _i * 8192), 16, 0, 0); } } while (0)
#define PG8_LDA(dst, b, h) do { if constexpr (Epi::FP8) { _Pragma("unroll") for (int m = 0; m < 4; ++m) { const i32x4 lo_ = *(const PG8_LAS i32x4*)(lds + PG8_SA(b, h) + aoff + m * 2048), hi_ = *(const PG8_LAS i32x4*)(lds + PG8_SA(b, h) + aoff + m * 2048 + 1024); F.dst[m] = __builtin_shufflevector(lo_, hi_, 0, 1, 2, 3, 4, 5, 6, 7); } } \
        else { _Pragma("unroll") for (int m = 0; m < 4; ++m) _Pragma("unroll") for (int k = 0; k < 2; ++k) F.dst[m][k] = *(const PG8_LAS bf16x8*)(lds + PG8_SA(b, h) + aoff + m * 2048 + k * 1024); } } while (0)
#define PG8_LDB(dst, b, h) do { if constexpr (Epi::FP8) { _Pragma("unroll") for (int n = 0; n < 2; ++n) { const i32x4 lo_ = *(const PG8_LAS i32x4*)(lds + PG8_SB(b, h) + boff + n * 2048), hi_ = *(const PG8_LAS i32x4*)(lds + PG8_SB(b, h) + boff + n * 2048 + 1024); F.dst[n] = __builtin_shufflevector(lo_, hi_, 0, 1, 2, 3, 4, 5, 6, 7); } } \
        else { _Pragma("unroll") for (int n = 0; n < 2; ++n) _Pragma("unroll") for (int k = 0; k < 2; ++k) F.dst[n][k] = *(const PG8_LAS bf16x8*)(lds + PG8_SB(b, h) + boff + n * 2048 + k * 1024); } } while (0)
#define PG8_MMA(ai, bj, At, Bt) do { __builtin_amdgcn_s_setprio(1); \
        if constexpr (Epi::FP8) {   \
            _Pragma("unroll") for (int m = 0; m < 4; ++m) _Pragma("unroll") for (int n = 0; n < 2; ++n) \
                acc[ai][bj][m][n] = __builtin_amdgcn_mfma_scale_f32_16x16x128_f8f6f4(F.Bt[n], F.At[m], acc[ai][bj][m][n], 0, 0, 0, Epi::SCALE_W, 0, 0x7f7f7f7f); \
        } else { _Pragma("unroll") for (int m = 0; m < 4; ++m) _Pragma("unroll") for (int n = 0; n < 2; ++n) _Pragma("unroll") for (int k = 0; k < 2; ++k) \
            acc[ai][bj][m][n] = __builtin_amdgcn_mfma_f32_16x16x32_f16(__builtin_bit_cast(h16::f16x8_t, F.Bt[n][k]), __builtin_bit_cast(h16::f16x8_t, F.At[m][k]), acc[ai][bj][m][n], 0, 0, 0); } \
        __builtin_amdgcn_s_setprio(0); } while (0)
#define PG8_WAIT_V(n) asm volatile("s_waitcnt vmcnt(" #n ")" ::: "memory")
#define PG8_WAIT_L(n) asm volatile("s_waitcnt lgkmcnt(" #n ")" ::: "memory")
#define PG8_BAR __builtin_amdgcn_s_barrier()
#define PG8_SCHED __builtin_amdgcn_sched_barrier(0)
    Unit cur, nxt; int ui = 0;
    if (!S.next(0, cur)) return;
    Acc acc;
#pragma unroll
    for (int a = 0; a < 2; ++a)
#pragma unroll
        for (int b = 0; b < 2; ++b)
#pragma unroll
            for (int m = 0; m < 4; ++m)
#pragma unroll
                for (int n = 0; n < 2; ++n) acc[a][b][m][n] = (f32x4){0.f, 0.f, 0.f, 0.f};
    const char* cA = S.a_ptr(cur); const char* cB = S.b_ptr(cur);
    if constexpr (Epi::MID_T > 0) E.pre(cur, lds, tid);
    PG8_STAGE(PG8_SB(0, 0), cB, voffB); PG8_STAGE(PG8_SB(0, 1), cB + hstepB, voffB); PG8_STAGE(PG8_SA(0, 0), cA, voffA); PG8_STAGE(PG8_SA(0, 1), cA + hstepA, voffA);
    if (wr == 1) PG8_BAR;
    PG8_WAIT_V(2); PG8_BAR;
    PG8_STAGE(PG8_SB(1, 0), cB + kstep, voffB); PG8_STAGE(PG8_SA(1, 0), cA + kstep, voffA); PG8_STAGE(PG8_SB(1, 1), cB + hstepB + kstep, voffB);
    PG8_WAIT_V(6); PG8_BAR;
    for (;;) {
        const bool has_next = S.next(ui + 1, nxt);
        const char* nA = has_next ? S.a_ptr(nxt) : cA; const char* nB = has_next ? S.b_ptr(nxt) : cB;
        for (int t = 0; t < nt; t += 2) {
            if constexpr (Epi::MID_T > 0) { if (t == Epi::MID_T) E.mid(acc, lds, wr, fr); }
            const bool last = (t == nt - 2);
            Frags<Epi::FP8> F;
            const char* a1 = cA + (size_t)(t + 1) * kstep;
            const char* a2 = last ? nA : cA + (size_t)(t + 2) * kstep; const char* b2 = last ? nB : cB + (size_t)(t + 2) * kstep;
            const char* a3 = a2 + kstep; const char* b3 = b2 + kstep;
            PG8_LDB(B0, 0, 0); PG8_LDB(B1, 0, 1); PG8_SCHED; PG8_LDA(At, 0, 0); PG8_STAGE(PG8_SA(1, 1), a1 + hstepA, voffA);
            PG8_WAIT_V(8); PG8_WAIT_L(0); PG8_BAR; PG8_MMA(0, 0, At, B0); PG8_MMA(0, 1, At, B1); PG8_BAR; PG8_SCHED;
            PG8_LDA(At, 0, 1); PG8_STAGE(PG8_SB(0, 0), b2, voffB); PG8_STAGE(PG8_SB(0, 1), b2 + hstepB, voffB); PG8_STAGE(PG8_SA(0, 0), a2, voffA);
            PG8_WAIT_V(8); PG8_WAIT_L(0); PG8_BAR; PG8_MMA(1, 0, At, B0); PG8_MMA(1, 1, At, B1); PG8_BAR; PG8_SCHED;
            PG8_LDB(B0, 1, 0); PG8_LDB(B1, 1, 1); PG8_SCHED; PG8_LDA(At, 1, 0); PG8_STAGE(PG8_SA(0, 1), a2 + hstepA, voffA);
            PG8_WAIT_V(8); PG8_WAIT_L(0); PG8_BAR; PG8_MMA(0, 0, At, B0); PG8_MMA(0, 1, At, B1); PG8_BAR; PG8_SCHED;
            PG8_LDA(At, 1, 1); PG8_STAGE(PG8_SB(1, 0), b3, voffB); PG8_STAGE(PG8_SB(1, 1), b3 + hstepB, voffB); PG8_STAGE(PG8_SA(1, 0), a3, voffA);
            PG8_WAIT_V(8); PG8_WAIT_L(0); PG8_BAR; PG8_MMA(1, 0, At, B0); PG8_MMA(1, 1, At, B1); PG8_BAR; PG8_SCHED;
        }
        if (wr == 0) PG8_BAR;
        { const int t2_ = olane(); E(acc, cur, wr, wc, t2_ & 15, t2_ >> 4); }
        if (!has_next) break;
#pragma unroll
        for (int a = 0; a < 2; ++a)
#pragma unroll
            for (int b = 0; b < 2; ++b)
#pragma unroll
                for (int m = 0; m < 4; ++m)
#pragma unroll
                    for (int n = 0; n < 2; ++n) acc[a][b][m][n] = (f32x4){0.f, 0.f, 0.f, 0.f};
        cur = nxt; cA = nA; cB = nB; ++ui;
        if (wr == 1) PG8_BAR;
    }
    PG8_WAIT_V(0);
    PG8_BAR;
#undef PG8_SA
#undef PG8_SB
#undef PG8_STAGE
#undef PG8_LDA
#undef PG8_LDB
#undef PG8_MMA
#undef PG8_WAIT_V
#undef PG8_WAIT_L
#undef PG8_BAR
#undef PG8_SCHED
}
}
namespace epi {
#define PG8_LAS __attribute__((address_space(3)))
using pg8::Acc; using pg8::Unit; using pg8::f32x4; using pg8::u32x4; using pg8::bf16_t; using pg8::cvt_pk_bf16; using pg8::fast_silu;
constexpr int HALF = 128;
constexpr float C2 = 0.125f * 1.4426950408889634f;
constexpr float KSC = 0.08838834764831845f;

__device__ __forceinline__ u32x4 pack8(const f32x4 v0, const f32x4 v1) { u32x4 w; w.x = cvt_pk_bf16(v0[0], v0[1]); w.y = cvt_pk_bf16(v0[2], v0[3]); w.z = cvt_pk_bf16(v1[0], v1[1]); w.w = cvt_pk_bf16(v1[2], v1[3]); return w; }

struct EpiInProj {
    static constexpr bool PERM = true; static constexpr int MID_T = 0; static constexpr bool FP8 = false; static constexpr int SCALE_W = 0;
    bf16_t* O; size_t gstride;
    float* KMP;
    const float* ROPE;
    __device__ __forceinline__ void operator()(const Acc& acc, const Unit& u, int wr, int wc, int fr, int fq) const {
        const int grp = u.pn >> 1;
        const int col0 = (u.pn & 1) * 256 + wc * 32 + 8 * fq;
        const int row0 = u.pm * 256 + wr * 64 + fr;
        bf16_t* base = O + (size_t)grp * gstride;
        f32x4 cs[2][2];
#pragma unroll
        for (int bj = 0; bj < 2; ++bj) { cs[bj][0] = (f32x4){0.f, 0.f, 0.f, 0.f}; cs[bj][1] = (f32x4){0.f, 0.f, 0.f, 0.f}; }
#pragma unroll
        for (int ai = 0; ai < 2; ++ai)
#pragma unroll
            for (int m = 0; m < 4; ++m) {
                const int row = row0 + ai * HALF + m * 16;
                bf16_t* rowp = base + (size_t)row * 512 + col0;
                f32x4 t0 = (f32x4){0.f, 0.f, 0.f, 0.f}, t1 = t0;
                if (grp == 3 || grp == 4) { const float* tp = ROPE + ((size_t)(row & 2047) * 64 + 16 * wc + 4 * fq) * 2; t0 = *(const f32x4*)tp; t1 = *(const f32x4*)(tp + 4); }
#pragma unroll
                for (int bj = 0; bj < 2; ++bj) {
                    f32x4 v0 = acc[ai][bj][m][0], v1 = acc[ai][bj][m][1];
                    if (grp == 0) { v0 = v0 * C2; v1 = v1 * C2; }
                    else if (grp == 1) { cs[bj][0] += v0; cs[bj][1] += v1; }
                    else if (grp == 3 || grp == 4) {
                        const float sc = (grp == 4) ? KSC : 1.0f;
                        f32x4 r0, r1;
                        r0[0] = (v0[0] * t0[0] - v0[1] * t0[1]) * sc; r0[1] = (v0[0] * t0[1] + v0[1] * t0[0]) * sc;
                        r0[2] = (v0[2] * t0[2] - v0[3] * t0[3]) * sc; r0[3] = (v0[2] * t0[3] + v0[3] * t0[2]) * sc;
                        r1[0] = (v1[0] * t1[0] - v1[1] * t1[1]) * sc; r1[1] = (v1[0] * t1[1] + v1[1] * t1[0]) * sc;
                        r1[2] = (v1[2] * t1[2] - v1[3] * t1[3]) * sc; r1[3] = (v1[2] * t1[3] + v1[3] * t1[2]) * sc;
                        v0 = r0; v1 = r1;
                    } else if (grp == 6) {
#pragma unroll
                        for (int j = 0; j < 4; ++j) { v0[j] = fast_silu(v0[j]); v1[j] = fast_silu(v1[j]); }
                    }
                    *(u32x4*)(rowp + bj * HALF) = pack8(v0, v1);
                }
            }
        if (grp == 1) {
#pragma unroll
            for (int bj = 0; bj < 2; ++bj)
#pragma unroll
                for (int n = 0; n < 2; ++n) {
                    f32x4 s = cs[bj][n];
#pragma unroll
                    for (int c4 = 0; c4 < 4; ++c4) { float t = s[c4]; t += xl::xor_f<1>(t); t += xl::xor_f<2>(t); t += xl::xor_f<4>(t); t += xl::xor_f<8>(t); s[c4] = t; }
                    if (fr == 0) *(f32x4*)(KMP + (size_t)(u.pm * 2 + wr) * 512 + col0 + bj * HALF + 4 * n) = s;
                }
        }
    }
};

struct EpiOutProj {
    static constexpr bool PERM = false; static constexpr int MID_T = 8; static constexpr bool FP8 = false; static constexpr int SCALE_W = 0;
    const float* xin; float* out; const float* g1;
    const float* assq;
    bool dry;
    static constexpr int RS_OFF = 131072 + 8192;
    __device__ __forceinline__ void pre(const Unit& u, PG8_LAS unsigned char* lds, int tid) const {
        if (tid < 256) { const int row = u.pm * 256 + tid;
            const f32x4 a = *(const f32x4*)(assq + (size_t)row * 8), c = *(const f32x4*)(assq + (size_t)row * 8 + 4);
            const float ss = ((a[0] + a[1]) + (a[2] + a[3])) + ((c[0] + c[1]) + (c[2] + c[3]));
            ((PG8_LAS float*)(lds + RS_OFF))[tid] = 1.0f / sqrtf(ss * (1.0f / 512.0f) + 1e-6f); }
    }
    __device__ __forceinline__ void mid(Acc& acc, PG8_LAS unsigned char* lds, int wr, int fr) const {
        const PG8_LAS float* tab = (const PG8_LAS float*)(lds + RS_OFF) + wr * 64 + fr;
#pragma unroll
        for (int ai = 0; ai < 2; ++ai)
#pragma unroll
            for (int m = 0; m < 4; ++m) {
                const float rs = tab[ai * HALF + m * 16];
#pragma unroll
                for (int bj = 0; bj < 2; ++bj)
#pragma unroll
                    for (int n = 0; n < 2; ++n) acc[ai][bj][m][n] = acc[ai][bj][m][n] * rs;
            }
    }
    __device__ __forceinline__ void operator()(const Acc& acc, const Unit& u, int wr, int wc, int fr, int fq) const {
        const int b = u.pm >> 3;
        const int col0 = u.pn * 256 + wc * 32 + 4 * fq;
        const int row0 = u.pm * 256 + wr * 64 + fr;
        f32x4 gv[2][2];
#pragma unroll
        for (int bj = 0; bj < 2; ++bj)
#pragma unroll
            for (int n = 0; n < 2; ++n) gv[bj][n] = *(const f32x4*)(g1 + (size_t)b * 6144 + col0 + bj * HALF + n * 16);
#pragma unroll
        for (int ai = 0; ai < 2; ++ai)
#pragma unroll
            for (int m = 0; m < 4; ++m) {
                const size_t off = (size_t)(row0 + ai * HALF + m * 16) * 1024 + col0;
#pragma unroll
                for (int bj = 0; bj < 2; ++bj)
#pragma unroll
                    for (int n = 0; n < 2; ++n) { const f32x4 bs = *(const f32x4*)(xin + off + bj * HALF + n * 16); const f32x4 r = bs + gv[bj][n] * acc[ai][bj][m][n]; if (!dry) *(f32x4*)(out + off + bj * HALF + n * 16) = r; else asm volatile("" :: "v"(r)); }
            }
    }
};

struct EpiSwiGLU {
    static constexpr bool PERM = true; static constexpr int MID_T = 0; static constexpr bool FP8 = false; static constexpr int SCALE_W = 0;
    bf16_t* H; int ldh;
    __device__ __forceinline__ void operator()(const Acc& acc, const Unit& u, int wr, int wc, int fr, int fq) const {
        const int col0 = u.pn * 128 + wc * 32 + 8 * fq;
        const int row0 = u.pm * 256 + wr * 64 + fr;
#pragma unroll
        for (int ai = 0; ai < 2; ++ai)
#pragma unroll
            for (int m = 0; m < 4; ++m) {
                const int row = row0 + ai * HALF + m * 16;
                f32x4 v0, v1;
#pragma unroll
                for (int j = 0; j < 4; ++j) { v0[j] = fast_silu(acc[ai][0][m][0][j]) * acc[ai][1][m][0][j]; v1[j] = fast_silu(acc[ai][0][m][1][j]) * acc[ai][1][m][1][j]; }
                *(u32x4*)(H + (size_t)row * ldh + col0) = pack8(v0, v1);
            }
    }
};

struct EpiDown {
    static constexpr bool PERM = false; static constexpr int MID_T = 0; static constexpr bool FP8 = false; static constexpr int SCALE_W = 0;
    float* out; const float* g2; bf16_t* YS; const int* srow; const float* swt; bool moe; bool dry; int* atomf; bool atomic; float* slab; int KS;
    __device__ __forceinline__ void operator()(const Acc& acc, const Unit& u, int wr, int wc, int fr, int fq) const {
        const int col0 = u.pn * 256 + wc * 32 + 4 * fq;
        const int row0 = u.pm * 256 + wr * 64 + fr;
        if (!moe) {
            const int b = u.pm >> 3;
            f32x4 gv[2][2];
#pragma unroll
            for (int bj = 0; bj < 2; ++bj)
#pragma unroll
                for (int n = 0; n < 2; ++n) gv[bj][n] = *(const f32x4*)(g2 + (size_t)b * 6144 + col0 + bj * HALF + n * 16);
#pragma unroll
            for (int ai = 0; ai < 2; ++ai)
#pragma unroll
                for (int m = 0; m < 4; ++m) {
                    const size_t off = (size_t)(row0 + ai * HALF + m * 16) * 1024 + col0;
#pragma unroll
                    for (int bj = 0; bj < 2; ++bj)
#pragma unroll
                        for (int n = 0; n < 2; ++n) { const f32x4 bs = *(const f32x4*)(out + off + bj * HALF + n * 16); const f32x4 r = bs + gv[bj][n] * acc[ai][bj][m][n]; if (!dry) *(f32x4*)(out + off + bj * HALF + n * 16) = r; else asm volatile("" :: "v"(r)); }
                }
        } else if (atomic) {
            float* sl = slab + ((size_t)(u.li * KS + u.kc) * 256) * 256 + (wc * 32 + 4 * fq);
#pragma unroll
            for (int ai = 0; ai < 2; ++ai)
#pragma unroll
                for (int m = 0; m < 4; ++m) {
                    const int rl = ai * HALF + wr * 64 + m * 16 + fr; const int pos = u.pm * 256 + rl;
                    const int sr = srow[pos];
                    if (sr >= 0) { const float w = swt[pos];
                        if (u.kc == 0 && wc == 0 && fq == 0) atomf[sr * 4 + u.pn] = 1 + u.li * 256 + rl;
#pragma unroll
                        for (int bj = 0; bj < 2; ++bj)
#pragma unroll
                            for (int n = 0; n < 2; ++n) *(f32x4*)(sl + (size_t)rl * 256 + bj * HALF + n * 16) = acc[ai][bj][m][n] * w; }
                }
        } else {
#pragma unroll
            for (int ai = 0; ai < 2; ++ai)
#pragma unroll
                for (int m = 0; m < 4; ++m) {
                    const int pos = row0 + ai * HALF + m * 16;
                    const int sr = srow[pos];
                    if (sr >= 0) { const float w = swt[pos]; bf16_t* rowp = YS + (size_t)sr * 1024 + col0;
#pragma unroll
                        for (int bj = 0; bj < 2; ++bj)
#pragma unroll
                            for (int n = 0; n < 2; ++n) { const f32x4 v = acc[ai][bj][m][n] * w; pg8::u32x2 o; o.x = cvt_pk_bf16(v[0], v[1]); o.y = cvt_pk_bf16(v[2], v[3]); if (!dry) *(pg8::u32x2*)(rowp + bj * HALF + n * 16) = o; else asm volatile("" :: "v"(o)); } }
                }
        }
    }
};

__device__ __forceinline__ float clamp448(float v) { return __builtin_fminf(__builtin_fmaxf(v, -448.0f), 448.0f); }
__device__ __forceinline__ unsigned pk4_fp8(float a, float b, float c, float d) {
    int p = 0; p = __builtin_amdgcn_cvt_pk_fp8_f32(clamp448(a), clamp448(b), p, false); p = __builtin_amdgcn_cvt_pk_fp8_f32(clamp448(c), clamp448(d), p, true); return (unsigned)p; }
struct EpiSwiGLU8 {
    static constexpr bool PERM = true; static constexpr int MID_T = 0; static constexpr bool FP8 = true; static constexpr int SCALE_W = 0x7a7a7a7a;
    unsigned char* H; int ldh;
    __device__ __forceinline__ void operator()(const Acc& acc, const Unit& u, int wr, int wc, int fr, int fq) const {
        const int col0 = u.pn * 128 + wc * 32 + 8 * fq;
        const int row0 = u.pm * 256 + wr * 64 + fr;
#pragma unroll
        for (int ai = 0; ai < 2; ++ai)
#pragma unroll
            for (int m = 0; m < 4; ++m) {
                const int row = row0 + ai * HALF + m * 16;
                f32x4 v0, v1;
#pragma unroll
                for (int j = 0; j < 4; ++j) { v0[j] = fast_silu(acc[ai][0][m][0][j]) * acc[ai][1][m][0][j]; v1[j] = fast_silu(acc[ai][0][m][1][j]) * acc[ai][1][m][1][j]; }
                pg8::u32x2 w; w.x = pk4_fp8(v0[0], v0[1], v0[2], v0[3]); w.y = pk4_fp8(v1[0], v1[1], v1[2], v1[3]);
                *(pg8::u32x2*)(H + (size_t)row * ldh + col0) = w;
            }
    }
};
struct EpiDownDense8 {
    static constexpr bool PERM = false; static constexpr int MID_T = 0; static constexpr bool FP8 = true; static constexpr int SCALE_W = 0x79797979;
    float* out; const float* g2; bool dry;
    __device__ __forceinline__ void operator()(const Acc& acc, const Unit& u, int wr, int wc, int fr, int fq) const {
        const int col0 = u.pn * 256 + wc * 32 + 4 * fq;
        const int row0 = u.pm * 256 + wr * 64 + fr;
        const int b = u.pm >> 3;
        f32x4 gv[2][2];
#pragma unroll
        for (int bj = 0; bj < 2; ++bj)
#pragma unroll
            for (int n = 0; n < 2; ++n) gv[bj][n] = *(const f32x4*)(g2 + (size_t)b * 6144 + col0 + bj * HALF + n * 16);
#pragma unroll
        for (int ai = 0; ai < 2; ++ai)
#pragma unroll
            for (int m = 0; m < 4; ++m) {
                const size_t off = (size_t)(row0 + ai * HALF + m * 16) * 1024 + col0;
#pragma unroll
                for (int bj = 0; bj < 2; ++bj)
#pragma unroll
                    for (int n = 0; n < 2; ++n) { const f32x4 bs = *(const f32x4*)(out + off + bj * HALF + n * 16); const f32x4 r = bs + gv[bj][n] * acc[ai][bj][m][n]; if (!dry) *(f32x4*)(out + off + bj * HALF + n * 16) = r; else asm volatile("" :: "v"(r)); }
            }
    }
};
struct EpiDownMoe8 {
    static constexpr bool PERM = false; static constexpr int MID_T = 0; static constexpr bool FP8 = true; static constexpr int SCALE_W = 0x79797979;
    bf16_t* YS; const int* srow; const float* swt;
    __device__ __forceinline__ void operator()(const Acc& acc, const Unit& u, int wr, int wc, int fr, int fq) const {
        const int col0 = u.pn * 256 + wc * 32 + 4 * fq;
        const int row0 = u.pm * 256 + wr * 64 + fr;
#pragma unroll
        for (int ai = 0; ai < 2; ++ai)
#pragma unroll
            for (int m = 0; m < 4; ++m) {
                const int pos = row0 + ai * HALF + m * 16;
                const int sr = srow[pos];
                if (sr >= 0) { const float w = swt[pos]; bf16_t* rowp = YS + (size_t)sr * 1024 + col0;
#pragma unroll
                    for (int bj = 0; bj < 2; ++bj)
#pragma unroll
                        for (int n = 0; n < 2; ++n) { const f32x4 v = acc[ai][bj][m][n] * w; pg8::u32x2 o; o.x = cvt_pk_bf16(v[0], v[1]); o.y = cvt_pk_bf16(v[2], v[3]); *(pg8::u32x2*)(rowp + bj * HALF + n * 16) = o; } }
            }
    }
};
}
namespace fa {
#define FA_LAS __attribute__((address_space(3)))
typedef unsigned short bf16_t;
typedef short bf16x8 __attribute__((ext_vector_type(8)));
typedef short s16x4 __attribute__((ext_vector_type(4)));
typedef float f32x16 __attribute__((ext_vector_type(16)));
typedef float f32x4 __attribute__((ext_vector_type(4)));
typedef unsigned u32x4 __attribute__((ext_vector_type(4)));
typedef float f32x2_t __attribute__((ext_vector_type(2))); typedef __bf16 bf16x2_t __attribute__((ext_vector_type(2)));
constexpr int L_WSF = 131072 + 1024, L_KM = L_WSF + 2048;
constexpr float NEG = -1.0e30f;
__device__ __forceinline__ int crow(int r, int hi) { return (r & 3) + 8 * (r >> 2) + 4 * hi; }
__device__ __forceinline__ void glds16(const void* gsrc, unsigned lds_dst) { unsigned keep;
    asm volatile("s_mov_b32 %0, m0\n\ts_mov_b32 m0, %2\n\ts_nop 0\n\tglobal_load_lds_dwordx4 %1, off\n\ts_mov_b32 m0, %0" : "=&s"(keep) : "v"(gsrc), "s"(lds_dst) : "memory"); }
__device__ __forceinline__ unsigned cvtpk_s(float lo, float hi) { return h16::pk(lo, hi); }
__device__ __forceinline__ float bf2f(short s) { return h16::one((unsigned short)s); }
typedef short v4i16_t __attribute__((ext_vector_type(4)));
__device__ __forceinline__ s16x4 vtr(FA_LAS const unsigned char* p) { return __builtin_bit_cast(s16x4, __builtin_amdgcn_ds_read_tr16_b64_v4i16((FA_LAS v4i16_t*)p)); }
#define FA_WAIT_BAR() asm volatile("s_waitcnt vmcnt(0) lgkmcnt(0)\n\ts_barrier" ::: "memory")
#define FA_LBAR() asm volatile("s_waitcnt lgkmcnt(0)\n\ts_barrier" ::: "memory")

struct Tensors {
    const bf16_t* Q; const bf16_t* K; const bf16_t* V;
    bf16_t* CAT;
    float* ASSQ;
    const float* KMP;
    const bf16_t* GR;
    const float* ret_g;
    const float* KVM;
};

template <bool RET>
__device__ __forceinline__ void attn_unit(const int wv, int b, int h, int qblk, const Tensors& T, FA_LAS unsigned char* shm) {
    constexpr int NS = RET ? 3 : 4, DIST = NS - 1;
    constexpr int DH = RET ? 128 : 64, ND0 = DH / 16, NDB = DH / 32, NPC = DH / 64, SLOT = 64 * DH * 2, L_K = 0, L_V = NS * SLOT, PER = 2 * NPC, L_R = 98304;
    int tid_ = otid(wv);
    const int tid = tid_, lane = tid & 63, r32 = lane & 31, hi = lane >> 5; const int wid = __builtin_amdgcn_readfirstlane(tid >> 6);
    const size_t rowbase = (size_t)b * 2048; const int q0 = qblk * 256;
    const unsigned lds0 = (unsigned)(unsigned long)shm;
    FA_LAS float* wsf = (FA_LAS float*)(shm + L_WSF) + wid * 64;
    FA_LAS float* KM = (FA_LAS float*)(shm + L_KM);
    const bf16_t* Kh = T.K + rowbase * 512 + h * DH; const bf16_t* Vh = T.V + rowbase * 512 + h * DH;
    const int NT = RET ? 4 : 4 * (qblk + 1);
#define FA_KV0(i) ((((i) < 4) ? qblk : (qblk - 1 - (((i) - 4) >> 2))) * 256 + ((i) & 3) * 64)
#define FA_DMA(i) do { const int kv0_ = FA_KV0(i); const unsigned so_ = (unsigned)(((i) % NS) * SLOT); \
        _Pragma("unroll") for (int pp = 0; pp < NPC; ++pp) { const int p = wid + 8 * pp; \
            glds16(Kh + (size_t)(kv0_ + lane) * 512 + p * 8, (unsigned)__builtin_amdgcn_readfirstlane(lds0 + L_K + so_ + p * 1024)); } \
        _Pragma("unroll") for (int pp = 0; pp < NPC; ++pp) { const int p = wid + 8 * pp; \
            glds16(Vh + (size_t)(kv0_ + 16 * (p & 3) + (lane >> 2)) * 512 + (p >> 2) * 32 + (lane & 3) * 8, (unsigned)__builtin_amdgcn_readfirstlane(lds0 + L_V + so_ + p * 1024)); } } while (0)
    FA_DMA(0); if (NT > 1) FA_DMA(1); if (DIST > 2 && NT > 2) FA_DMA(2);
    const bf16_t* Qw = T.Q + (rowbase + q0 + wid * 32 + r32) * 512 + h * DH;
    bf16x8 qr[ND0];
#pragma unroll
    for (int d0 = 0; d0 < ND0; ++d0) qr[d0] = *(const bf16x8*)(Qw + d0 * 16 + hi * 8);
    unsigned selmask = 0xffu;
    float cfac[16]; float lg2 = 0.f;
    if (!RET) {
        { const int j = tid >> 6, d = tid & 63; const float* kp = T.KMP + ((size_t)(b * 8 + j) * 2) * 512 + h * 64 + d; KM[tid] = kp[0] + kp[512]; }
        FA_LBAR();
        float g[8];
#pragma unroll
        for (int j = 0; j < 8; ++j) g[j] = 0.f;
#pragma unroll
        for (int d0 = 0; d0 < ND0; ++d0)
#pragma unroll
            for (int jj = 0; jj < 8; ++jj) { const float qv = bf2f(qr[d0][jj]); const int d = 16 * d0 + 8 * hi + jj;
#pragma unroll
                for (int j = 0; j < 8; ++j) g[j] += qv * KM[j * 64 + d]; }
#pragma unroll
        for (int j = 0; j < 8; ++j) g[j] = xl::add32(g[j]);
        selmask = 0u;
#pragma unroll
        for (int j = 0; j < 8; ++j) { int rank = 0;
#pragma unroll
            for (int mm = 0; mm < 8; ++mm) rank += (mm < qblk && (g[mm] > g[j] || (g[mm] == g[j] && mm < j))) ? 1 : 0;
            if (j < qblk && rank < 3) selmask |= 1u << j; }
    } else {
        lg2 = log2f(1.0f - exp2f(-5.0f - (float)h));
#pragma unroll
        for (int r = 0; r < 16; ++r) cfac[r] = exp2f(-lg2 * (float)((r & 3) + 8 * (r >> 2)));
    }
    f32x16 o[NDB];
#pragma unroll
    for (int db = 0; db < NDB; ++db) o[db] = f32x16{};
    float mhat = 0.f, lrow = 0.f; f32x16 negm = f32x16{}; constexpr float THR = 8.0f;
    if (RET && qblk > 0) {
        const float* kvb = T.KVM + ((size_t)(b * 4 + h) * 8) * 16384;
        const float g256 = exp2f(lg2 * 256.0f);
#pragma unroll 2
        for (int it = 0; it < 8; ++it) { const int idx4 = tid + 512 * it; const int d = idx4 >> 5, e0 = (idx4 & 31) * 4;
            f32x4 acc4 = (f32x4){0.f, 0.f, 0.f, 0.f};
            for (int m = 0; m < qblk; ++m) acc4 = acc4 * g256 + *(const f32x4*)(kvb + (size_t)m * 16384 + d * 128 + e0);
            const int rp = (d & ~12) | ((d & 8) >> 1) | ((d & 4) << 1);
            typedef unsigned u32x2_ __attribute__((ext_vector_type(2)));
            u32x2_ w; w.x = cvtpk_s(acc4[0], acc4[1]); w.y = cvtpk_s(acc4[2], acc4[3]);
            *(FA_LAS u32x2_*)(shm + L_R + (e0 >> 5) * 8192 + rp * 64 + (e0 & 31) * 2) = w; }
        FA_LBAR();
        { FA_LAS const unsigned char* rb = shm + L_R + ((lane >> 4) & 1) * 32 + (lane & 3) * 8 + (4 * hi + ((lane & 15) >> 2)) * 64;
#pragma unroll
          for (int db = 0; db < NDB; ++db)
#pragma unroll
              for (int d0 = 0; d0 < ND0; ++d0) { const s16x4 lo = vtr(rb + db * 8192 + d0 * 1024), hh = vtr(rb + db * 8192 + d0 * 1024 + 512);
                  const bf16x8 rf = (bf16x8){lo[0], lo[1], lo[2], lo[3], hh[0], hh[1], hh[2], hh[3]};
                  o[db] = __builtin_amdgcn_mfma_f32_32x32x16_f16(__builtin_bit_cast(h16::f16x8_t, qr[d0]), __builtin_bit_cast(h16::f16x8_t, rf), o[db], 0, 0, 0); } }
#pragma unroll
        for (int r = 0; r < 16; ++r) { const float rd = exp2f(lg2 * (float)(wid * 32 + crow(r, hi) + 1));
#pragma unroll
            for (int db = 0; db < NDB; ++db) o[db][r] *= rd; }
    }
    const int qrel = wid * 32 + r32;
    for (int i = 0; i < NT; ++i) {
        { const int ahead = (NT - 1 - i) < (DIST - 1) ? (NT - 1 - i) : (DIST - 1);
          if (ahead == 2) { if (PER == 2) asm volatile("s_waitcnt vmcnt(4) lgkmcnt(0)\n\ts_barrier" ::: "memory"); else asm volatile("s_waitcnt vmcnt(8) lgkmcnt(0)\n\ts_barrier" ::: "memory"); }
          else if (ahead == 1) { if (PER == 2) asm volatile("s_waitcnt vmcnt(2) lgkmcnt(0)\n\ts_barrier" ::: "memory"); else asm volatile("s_waitcnt vmcnt(4) lgkmcnt(0)\n\ts_barrier" ::: "memory"); }
          else FA_WAIT_BAR(); }
        if (i + DIST < NT) FA_DMA(i + DIST);
        const bool diag = i < 4; const int t = i & 3; const int j = diag ? qblk : (qblk - 1 - ((i - 4) >> 2));
        const bool mysel = RET ? true : (((selmask >> j) & 1u) != 0u);
        const bool skip = diag ? (64 * t > 32 * wid + 31) : (RET ? false : !__any(mysel));
        if (skip) continue;
        const unsigned so = (unsigned)((i % NS) * SLOT);
        f32x16 p0 = RET ? f32x16{} : negm, p1 = p0;
        { FA_LAS const unsigned char* kb = shm + L_K + so + hi * 1024 + r32 * 16;
#pragma unroll
          for (int d0 = 0; d0 < ND0; ++d0) { const bf16x8 b0 = *(FA_LAS const bf16x8*)(kb + d0 * 2048); const bf16x8 b1 = *(FA_LAS const bf16x8*)(kb + d0 * 2048 + 512);
              p0 = __builtin_amdgcn_mfma_f32_32x32x16_f16(__builtin_bit_cast(h16::f16x8_t, b0), __builtin_bit_cast(h16::f16x8_t, qr[d0]), p0, 0, 0, 0); p1 = __builtin_amdgcn_mfma_f32_32x32x16_f16(__builtin_bit_cast(h16::f16x8_t, b1), __builtin_bit_cast(h16::f16x8_t, qr[d0]), p1, 0, 0, 0); } }
        if (RET) {
            const int qpos = q0 + qrel; const int kv0 = j * 256 + t * 64;
            const float base = (float)(qpos - kv0 - 4 * hi);
            const float rf0 = exp2f(lg2 * base), rf1 = exp2f(lg2 * (base - 32.0f));
#pragma unroll
            for (int r = 0; r < 16; ++r) { p0[r] *= rf0 * cfac[r]; p1[r] *= rf1 * cfac[r]; }
            if (diag) { const int kb_ = 64 * t + 4 * hi;
#pragma unroll
                for (int r = 0; r < 16; ++r) { const int kv = kb_ + (r & 3) + 8 * (r >> 2); if (kv > qrel) p0[r] = 0.f; if (kv + 32 > qrel) p1[r] = 0.f; } }
        } else {
            if (diag) { const int kb_ = 64 * t + 4 * hi;
#pragma unroll
                for (int r = 0; r < 16; ++r) { const int kv = kb_ + (r & 3) + 8 * (r >> 2); if (kv > qrel) p0[r] = NEG; if (kv + 32 > qrel) p1[r] = NEG; } }
            else if (!mysel) {
#pragma unroll
                for (int r = 0; r < 16; ++r) { p0[r] = NEG; p1[r] = NEG; } }
            float rm = fmaxf(fmaxf(p0[0], p1[0]), p0[1]);
#pragma unroll
            for (int r = 1; r < 16; ++r) { rm = fmaxf(fmaxf(rm, p1[r]), (r < 15) ? p0[r + 1] : p1[r]); }
            rm = xl::max32(rm);
            if (__any(rm > THR)) {
                const float dl = fmaxf(rm, 0.f);
                mhat += dl;
#pragma unroll
                for (int r = 0; r < 16; ++r) { p0[r] -= dl; p1[r] -= dl; }
#pragma unroll
                for (int r = 0; r < 16; ++r) negm[r] = -mhat;
                const float f = __builtin_amdgcn_exp2f(-dl); lrow *= f;
                asm volatile("" ::: "memory");
                if (hi == 0) wsf[r32] = f;
                asm volatile("s_waitcnt lgkmcnt(0)" ::: "memory");
#pragma unroll
                for (int r = 0; r < 16; ++r) { const float fr_ = wsf[crow(r, hi)];
#pragma unroll
                    for (int db = 0; db < NDB; ++db) o[db][r] *= fr_; }
                asm volatile("s_waitcnt lgkmcnt(0)" ::: "memory");
            }
            float s = 0.f;
#pragma unroll
            for (int r = 0; r < 16; ++r) { p0[r] = __builtin_amdgcn_exp2f(p0[r]); p1[r] = __builtin_amdgcn_exp2f(p1[r]); s += p0[r] + p1[r]; }
            lrow += s;
        }
        bf16x8 pa[4];
        { u32x4 w;
          w.x = cvtpk_s(p0[0], p0[1]); w.y = cvtpk_s(p0[2], p0[3]); w.z = cvtpk_s(p0[4], p0[5]); w.w = cvtpk_s(p0[6], p0[7]); pa[0] = __builtin_bit_cast(bf16x8, w);
          w.x = cvtpk_s(p0[8], p0[9]); w.y = cvtpk_s(p0[10], p0[11]); w.z = cvtpk_s(p0[12], p0[13]); w.w = cvtpk_s(p0[14], p0[15]); pa[1] = __builtin_bit_cast(bf16x8, w);
          w.x = cvtpk_s(p1[0], p1[1]); w.y = cvtpk_s(p1[2], p1[3]); w.z = cvtpk_s(p1[4], p1[5]); w.w = cvtpk_s(p1[6], p1[7]); pa[2] = __builtin_bit_cast(bf16x8, w);
          w.x = cvtpk_s(p1[8], p1[9]); w.y = cvtpk_s(p1[10], p1[11]); w.z = cvtpk_s(p1[12], p1[13]); w.w = cvtpk_s(p1[14], p1[15]); pa[3] = __builtin_bit_cast(bf16x8, w); }
        { FA_LAS const unsigned char* vb = shm + L_V + so + ((lane >> 4) & 1) * 32 + (lane & 3) * 8 + (4 * hi + ((lane & 15) >> 2)) * 64;
#pragma unroll
          for (int db = 0; db < NDB; ++db)
#pragma unroll
              for (int ks = 0; ks < 4; ++ks) { const s16x4 lo = vtr(vb + db * 4096 + ks * 1024), hh = vtr(vb + db * 4096 + ks * 1024 + 512);
                  const bf16x8 vf = (bf16x8){lo[0], lo[1], lo[2], lo[3], hh[0], hh[1], hh[2], hh[3]};
                  o[db] = __builtin_amdgcn_mfma_f32_32x32x16_f16(__builtin_bit_cast(h16::f16x8_t, pa[ks]), __builtin_bit_cast(h16::f16x8_t, vf), o[db], 0, 0, 0); } }
    }
    float rli[16];
    if (!RET) {
        const float l = xl::add32(lrow);
        asm volatile("" ::: "memory");
        if (hi == 0) wsf[32 + r32] = 1.0f / l;
        asm volatile("s_waitcnt lgkmcnt(0)" ::: "memory");
#pragma unroll
        for (int r = 0; r < 16; ++r) rli[r] = wsf[32 + crow(r, hi)];
    } else {
#pragma unroll
        for (int r = 0; r < 16; ++r) rli[r] = 1.0f;
    }
    FA_LBAR();
    FA_LAS bf16_t* stg = (FA_LAS bf16_t*)(shm + wid * 8192);
#pragma unroll
    for (int r = 0; r < 16; ++r) { const int orow = crow(r, hi);
#pragma unroll
        for (int db = 0; db < NDB; ++db) { const unsigned pk = cvtpk_s(o[db][r] * rli[r], 0.f); stg[orow * DH + db * 32 + r32] = (bf16_t)(pk & 0xffffu); } }
    asm volatile("s_waitcnt lgkmcnt(0)" ::: "memory");
    const size_t tok0 = rowbase + q0 + wid * 32;
    if (!RET) {
#pragma unroll
        for (int i = 0; i < 4; ++i) { const int row = i * 8 + (lane >> 3), ch = lane & 7;
            const u32x4 v = *(FA_LAS const u32x4*)(stg + row * 64 + ch * 8);
            float ss = 0.f;
#pragma unroll
            for (int k = 0; k < 4; ++k) { const float a = h16::lo(v[k]), c = h16::hi(v[k]); ss += a * a + c * c; }
            ss += xl::xor_f<1>(ss); ss += xl::xor_f<2>(ss); ss += xl::xor_f<4>(ss);
            if (ch == 0) T.ASSQ[(tok0 + row) * 8 + h] = ss;
            *(u32x4*)(T.CAT + (tok0 + row) * 1024 + h * 64 + ch * 8) = v; }
    } else {
#pragma unroll
        for (int i = 0; i < 8; ++i) { const int row = i * 4 + (lane >> 4), ch = lane & 15;
            const u32x4 v = *(FA_LAS const u32x4*)(stg + row * 128 + ch * 8);
            float x[8];
#pragma unroll
            for (int k = 0; k < 4; ++k) { x[2 * k] = h16::lo(v[k]); x[2 * k + 1] = h16::hi(v[k]); }
            float ss = 0.f;
#pragma unroll
            for (int k = 0; k < 8; ++k) ss += x[k] * x[k];
            ss += xl::xor_f<1>(ss); ss += xl::xor_f<2>(ss); ss += xl::xor_f<4>(ss); ss += xl::xor_f<8>(ss);
            const float rs = 1.0f / sqrtf(ss * (1.0f / 128.0f) + 1e-6f);
            const u32x4 gv = *(const u32x4*)(T.GR + (tok0 + row) * 512 + h * 128 + ch * 8);
            const f32x4 w0 = *(const f32x4*)(T.ret_g + h * 128 + ch * 8), w1 = *(const f32x4*)(T.ret_g + h * 128 + ch * 8 + 4);
            const float wg[8] = {w0[0], w0[1], w0[2], w0[3], w1[0], w1[1], w1[2], w1[3]};
            float y[8];
#pragma unroll
            for (int k = 0; k < 4; ++k) { const float g0 = h16::lo(gv[k]), g1 = h16::hi(gv[k]);
                y[2 * k] = x[2 * k] * rs * wg[2 * k] * g0; y[2 * k + 1] = x[2 * k + 1] * rs * wg[2 * k + 1] * g1; }
            u32x4 ov; ov.x = cvtpk_s(y[0], y[1]); ov.y = cvtpk_s(y[2], y[3]); ov.z = cvtpk_s(y[4], y[5]); ov.w = cvtpk_s(y[6], y[7]);
            *(u32x4*)(T.CAT + (tok0 + row) * 1024 + 512 + h * 128 + ch * 8) = ov; }
    }
    FA_LBAR();
#undef FA_KV0
#undef FA_DMA
}

__device__ __forceinline__ void kv_unit(const int wv, int b, int h, int m, const bf16_t* Kg, const bf16_t* Vg, float* KVM, FA_LAS unsigned char* shm) {
    constexpr int SLOT = 16384, L_K = 0, L_V = 4 * SLOT;
    int tid_ = otid(wv);
    const int tid = tid_, lane = tid & 63, r32 = lane & 31, hi = lane >> 5; const int wid = __builtin_amdgcn_readfirstlane(tid >> 6);
    const int dg = wid >> 1, eh = wid & 1;
    const size_t rowbase = (size_t)b * 2048 + (size_t)m * 256;
    const unsigned lds0 = (unsigned)(unsigned long)shm;
    const bf16_t* Kh = Kg + rowbase * 512 + h * 128; const bf16_t* Vh = Vg + rowbase * 512 + h * 128;
#pragma unroll
    for (int t = 0; t < 4; ++t)
#pragma unroll
        for (int pp = 0; pp < 2; ++pp) { const int p = wid + 8 * pp; const size_t off = (size_t)(64 * t + 16 * (p & 3) + (lane >> 2)) * 512 + (p >> 2) * 32 + (lane & 3) * 8;
            glds16(Kh + off, (unsigned)__builtin_amdgcn_readfirstlane(lds0 + L_K + t * SLOT + p * 1024));
            glds16(Vh + off, (unsigned)__builtin_amdgcn_readfirstlane(lds0 + L_V + t * SLOT + p * 1024)); }
    const float lg2 = log2f(1.0f - exp2f(-5.0f - (float)h));
    const float g64 = exp2f(lg2 * 64.0f);
    h16::f16x8_t fd[4];
#pragma unroll
    for (int ks = 0; ks < 4; ++ks)
#pragma unroll
        for (int j = 0; j < 8; ++j) fd[ks][j] = (_Float16)exp2f(lg2 * (float)(63 - (16 * ks + 8 * (j >> 2) + 4 * hi + (j & 3))));
    f32x16 acc[2]; acc[0] = f32x16{}; acc[1] = f32x16{};
    FA_WAIT_BAR();
    const int lb = ((lane >> 4) & 1) * 32 + (lane & 3) * 8 + (4 * hi + ((lane & 15) >> 2)) * 64;
#pragma unroll
    for (int t = 0; t < 4; ++t) {
        if (t > 0) {
#pragma unroll
            for (int r = 0; r < 16; ++r) { acc[0][r] *= g64; acc[1][r] *= g64; } }
        FA_LAS const unsigned char* kb = shm + L_K + t * SLOT + dg * 4096 + lb; FA_LAS const unsigned char* vb = shm + L_V + t * SLOT + (2 * eh) * 4096 + lb;
#pragma unroll
        for (int ks = 0; ks < 4; ++ks) { const s16x4 klo = vtr(kb + ks * 1024), khi = vtr(kb + ks * 1024 + 512);
            const h16::f16x8_t kf = __builtin_bit_cast(h16::f16x8_t, (bf16x8){klo[0], klo[1], klo[2], klo[3], khi[0], khi[1], khi[2], khi[3]});
#pragma unroll
            for (int eb = 0; eb < 2; ++eb) { const s16x4 vlo = vtr(vb + eb * 4096 + ks * 1024), vhi = vtr(vb + eb * 4096 + ks * 1024 + 512);
                const h16::f16x8_t vf = __builtin_bit_cast(h16::f16x8_t, (bf16x8){vlo[0], vlo[1], vlo[2], vlo[3], vhi[0], vhi[1], vhi[2], vhi[3]}) * fd[ks];
                acc[eb] = __builtin_amdgcn_mfma_f32_32x32x16_f16(kf, vf, acc[eb], 0, 0, 0); } }
    }
    float* op = KVM + ((size_t)(b * 4 + h) * 8 + m) * 16384;
#pragma unroll
    for (int eb = 0; eb < 2; ++eb)
#pragma unroll
        for (int r = 0; r < 16; ++r) op[(size_t)(32 * dg + crow(r, hi)) * 128 + 64 * eh + 32 * eb + r32] = acc[eb][r];
    FA_LBAR();
}
}
namespace mk {
#define GAS __attribute__((address_space(1)))
#define LAS __attribute__((address_space(3)))
typedef unsigned short bf16;
typedef unsigned v4u __attribute__((ext_vector_type(4)));
typedef unsigned v2u __attribute__((ext_vector_type(2)));
typedef float f32x4 __attribute__((ext_vector_type(4)));
typedef int i32x4 __attribute__((ext_vector_type(4)));
typedef GAS unsigned gu32;
#define RLX_AGENT __ATOMIC_RELAXED, __HIP_MEMORY_SCOPE_AGENT
#define LDS_WAIT() asm volatile("s_waitcnt lgkmcnt(0)" ::: "memory")
#define VM_WAIT() asm volatile("s_waitcnt vmcnt(0)" ::: "memory")
constexpr int NWAVES = 8;
constexpr size_t MiB = 1u << 20, KiB = 1u << 10;
constexpr size_t WS_CTL = 0;
constexpr size_t CTL_ZERO_BYTES = 64 * KiB;
constexpr size_t WS_MOD = 64 * KiB;
constexpr size_t WS_KMP = 512 * KiB;
constexpr size_t WS_EIDX = 768 * KiB;
constexpr size_t WS_EW = 896 * KiB;
constexpr size_t WS_ROPE = 1 * MiB;
constexpr size_t WS_ASSQ = 2 * MiB;
constexpr size_t WS_SROW = 2 * MiB + 512 * KiB;
constexpr size_t WS_SWT = 2 * MiB + 768 * KiB;
constexpr size_t WS_WCNT = 3 * MiB;
constexpr size_t WS_SEG = 3 * MiB + 64 * KiB;
constexpr size_t WS_ATOMF = 3 * MiB + 128 * KiB;
constexpr size_t WS_SEGD = 3 * MiB + 65 * KiB;
constexpr size_t WS_MGU = 8 * MiB;
constexpr size_t WS_SLAB = 8 * MiB;
constexpr size_t WS_MDN = 96 * MiB;
constexpr size_t WS_XA = 140 * MiB;
constexpr size_t WS_XS = 172 * MiB;
constexpr size_t WS_KVM = 172 * MiB;
constexpr size_t WS_YS = 140 * MiB;
constexpr size_t WS_WIN = 240 * MiB;
constexpr size_t WS_WOUT = 254 * MiB;
constexpr size_t WS_FGU = 258 * MiB;
constexpr size_t WS_FDN = 269 * MiB;
constexpr size_t WS_QKV = 275 * MiB;
constexpr size_t WS_CAT = 387 * MiB;
constexpr size_t WS_HD = 275 * MiB;
constexpr size_t WS_HM = 240 * MiB;
constexpr size_t WS_END = 428 * MiB;
constexpr int XS_ROWS = 34816;
constexpr int CW_BAR = 1024;

constexpr int RING_BYTES = 131072, LDSCTL_OFF = RING_BYTES, MISC_OFF = LDSCTL_OFF + 320, LDS_BYTES = 147456;

#define XB_TMO      128
#define XB_XCNT(j)  (256  + 64 * (j))
#define XB_XSUB(j)  (1280 + 64 * (j))
#define XB_XGEN(j)  (2304 + 64 * (j))
#define XB_TOP      3328
#define XB_TOPGEN   3392
#define XCD_BAR_WORDS 3456
#define XB_SPIN_CAP (1u << 18)
__device__ __forceinline__ unsigned xb_ld(unsigned* p)              { return __hip_atomic_load(p, __ATOMIC_RELAXED, __HIP_MEMORY_SCOPE_AGENT); }
__device__ __forceinline__ unsigned xb_add(unsigned* p, unsigned v) { return __hip_atomic_fetch_add(p, v, __ATOMIC_RELAXED, __HIP_MEMORY_SCOPE_AGENT); }
__device__ __forceinline__ unsigned xb_xcc_id() { return (unsigned)__builtin_amdgcn_s_getreg((3 << 11) | 20) & 0xFu; }
#define XB_SPIN(cond, bar) do { unsigned _sp = 0; while (cond) { __builtin_amdgcn_s_sleep(1); \
    if ((++_sp & 255u) == 0u) { if (xb_ld(&(bar)[XB_TMO])) break; if (_sp > XB_SPIN_CAP) { atomicAdd(&(bar)[XB_TMO], 1u); break; } } } } while (0)
struct XcdBarrier { unsigned* bar; unsigned x; volatile LAS unsigned* st; int wv; };
__device__ __forceinline__ XcdBarrier xcd_barrier_post(unsigned* bar, volatile LAS unsigned* st, int wv) {
    XcdBarrier b; b.bar = bar; b.x = xb_xcc_id(); b.st = st; b.wv = wv;
    if (otid(wv) == 0) (void)xb_add(&bar[XB_XCNT(b.x)], 1u);
    return b;
}
__device__ __forceinline__ void xcd_barrier_complete(unsigned* bar, unsigned x, unsigned& nloc, unsigned& nx) {
    const unsigned G = gridDim.x * gridDim.y * gridDim.z;
    unsigned sum, cnt, mine, sp = 0u;
    for (;;) {
        sum = 0u; cnt = 0u; mine = 0u;
#pragma unroll
        for (unsigned j = 0; j < 16; ++j) { const unsigned c = xb_ld(&bar[XB_XCNT(j)]); sum += c; cnt += (c > 0u) ? 1u : 0u; mine = (j == x) ? c : mine; }
        if (sum == G) break;
        __builtin_amdgcn_s_sleep(1);
        if ((++sp & 255u) == 0u) { if (xb_ld(&bar[XB_TMO])) break; if (sp > XB_SPIN_CAP) { atomicAdd(&bar[XB_TMO], 1u); break; } }
    }
    nloc = mine > 0u ? mine : 1u; nx = cnt > 0u ? cnt : 1u;
}
__device__ __forceinline__ void xcd_barrier(const XcdBarrier& b) {
    asm volatile("s_waitcnt vmcnt(0)" ::: "memory");
    __syncthreads();
    if (otid(b.wv) == 0) {
        unsigned* bar = b.bar;
        __builtin_amdgcn_s_waitcnt(0);
        unsigned nloc = b.st[0], nx = b.st[1];
        if (nloc == 0u) { xcd_barrier_complete(bar, b.x, nloc, nx); b.st[0] = nloc; b.st[1] = nx; }
        const unsigned old = xb_add(&bar[XB_XSUB(b.x)], 1u);
        const unsigned gen = old / nloc;
        if (old + 1u == (gen + 1u) * nloc) {
            __builtin_amdgcn_fence(__ATOMIC_RELEASE, "agent");
            asm volatile("s_waitcnt vmcnt(0)" ::: "memory");
            const unsigned og = xb_add(&bar[XB_TOP], 1u);
            const unsigned tg = og / nx;
            if (og + 1u == (tg + 1u) * nx) xb_add(&bar[XB_TOPGEN], 1u);
            else XB_SPIN(xb_ld(&bar[XB_TOPGEN]) == tg, bar);
            __builtin_amdgcn_fence(__ATOMIC_ACQUIRE, "agent");
            xb_add(&bar[XB_XGEN(b.x)], 1u);
            asm volatile("s_waitcnt vmcnt(0)" ::: "memory");
        } else {
            XB_SPIN(xb_ld(&bar[XB_XGEN(b.x)]) == gen, bar);
            __builtin_amdgcn_fence(__ATOMIC_ACQUIRE, "agent");
            asm volatile("s_waitcnt vmcnt(0)" ::: "memory");
        }
    }
    __syncthreads();
}

__device__ __forceinline__ unsigned f2bf(float f) { unsigned u = __builtin_bit_cast(unsigned, f); return (u + 0x7fffu + ((u >> 16) & 1u)) >> 16; }
__device__ __forceinline__ unsigned pk2(float lo, float hi) { return h16::pk(lo, hi); }
using xl::wave_sum; using xl::wave_sum_i;

struct Inputs {
    const float *x, *c, *norm_mix_g, *norm_ffn_g, *ada_w, *ada_b, *w_in, *w_out, *att_g, *ret_g, *fw_gate, *fw_up, *fw_down, *router_w, *mw_gate, *mw_up, *mw_down, *final_g;
};

template <class SrcFn> __device__ __forceinline__ void transpose_item(SrcFn src, int K, bf16* WT, int k0, int n0, LAS float* scr, int lane) {
#pragma unroll 8
    for (int i = 0; i < 32; ++i) { const int kk = 2 * i + (lane >> 5); scr[kk * 33 + (lane & 31)] = src(k0 + kk, n0 + (lane & 31)); }
    LDS_WAIT(); asm volatile("" ::: "memory");
    const int c = lane & 7;
#pragma unroll
    for (int j = 0; j < 4; ++j) { const int n = (lane >> 3) + 8 * j; const LAS float* s = scr + (8 * c) * 33 + n;
        v4u o; o.x = pk2(s[0 * 33], s[1 * 33]); o.y = pk2(s[2 * 33], s[3 * 33]); o.z = pk2(s[4 * 33], s[5 * 33]); o.w = pk2(s[6 * 33], s[7 * 33]);
        *(GAS v4u*)(WT + (size_t)(n0 + n) * K + k0 + 8 * c) = o; }
    LDS_WAIT(); asm volatile("" ::: "memory");
}
__device__ __forceinline__ int rot_src_col(int n) {
    if (n < 1536 || n >= 2560) return n;
    const int hb = (n - 1536) & ~127, p = (n - 1536) & 127;
    return 1536 + hb + 4 * (p >> 3) + ((p & 7) >> 1) + 64 * (p & 1);
}
constexpr int IT_WIN = 16 * 112, IT_WOUT = 16 * 32, IT_GU = 16 * 176, IT_DN = 44 * 32;
constexpr int IT_TOTAL = 2 * IT_WIN + 2 * IT_WOUT + IT_GU + IT_DN + 8 * (IT_GU + IT_DN);

constexpr int IT_NONMOE = 2 * IT_WIN + 2 * IT_WOUT + IT_GU + IT_DN;
__device__ __forceinline__ void convert_item(const Inputs& in, unsigned char* ws, int it, LAS float* scr, int lane) {
    int r = it;
    if (r < 2 * IT_WIN) { const int l = r / IT_WIN; r -= l * IT_WIN; const float* W = in.w_in + (size_t)l * 1024 * 3584;
        transpose_item([=](int k, int n) { return W[(size_t)k * 3584 + rot_src_col(n)]; }, 1024, (bf16*)(ws + WS_WIN) + (size_t)l * 3584 * 1024, 64 * (r / 112), 32 * (r % 112), scr, lane); return; }
    r -= 2 * IT_WIN;
    if (r < 2 * IT_WOUT) { const int l = r / IT_WOUT; r -= l * IT_WOUT; const float* W = in.w_out + (size_t)l * 1024 * 1024; const float* ag = in.att_g + l * 512;
        transpose_item([=](int k, int n) { return W[(size_t)k * 1024 + n] * (k < 512 ? ag[k] : 1.0f); }, 1024, (bf16*)(ws + WS_WOUT) + (size_t)l * 1024 * 1024, 64 * (r / 32), 32 * (r % 32), scr, lane); return; }
    r -= 2 * IT_WOUT;
    const float *Wg, *Wu, *Wd; bf16 *Dgu, *Ddn;
    if (r < IT_GU + IT_DN) { Wg = in.fw_gate; Wu = in.fw_up; Wd = in.fw_down; Dgu = (bf16*)(ws + WS_FGU); Ddn = (bf16*)(ws + WS_FDN); }
    else { r -= IT_GU + IT_DN; const int e = r / (IT_GU + IT_DN); r -= e * (IT_GU + IT_DN);
        Wg = in.mw_gate + (size_t)e * 1024 * 2816; Wu = in.mw_up + (size_t)e * 1024 * 2816; Wd = in.mw_down + (size_t)e * 2816 * 1024;
        Dgu = (bf16*)(ws + WS_MGU) + (size_t)e * 5632 * 1024; Ddn = (bf16*)(ws + WS_MDN) + (size_t)e * 1024 * 2816; }
    if (r < IT_GU) {
        transpose_item([=](int k, int n) { const float* W = ((n >> 7) & 1) ? Wu : Wg; return W[(size_t)k * 2816 + (n >> 8) * 128 + (n & 127)]; }, 1024, Dgu, 64 * (r / 176), 32 * (r % 176), scr, lane); return; }
    r -= IT_GU;
    transpose_item([=](int k, int n) { return Wd[(size_t)k * 1024 + n]; }, 2816, Ddn, 64 * (r / 32), 32 * (r % 32), scr, lane);
}
struct MoeItem { const float* src; bf16* dst; int ld, K, k0, n0; const float* rscale; float f8scale; int scol0, sstep; };
template <int KIND  , class InP> __device__ __forceinline__ MoeItem moe_item(InP inp, unsigned char* ws, int it, int lane) {
    MoeItem m; m.rscale = nullptr; m.f8scale = (KIND == 0) ? 32.0f : 64.0f; const int r8 = lane >> 3, c4 = 4 * (lane & 7); m.scol0 = c4; m.sstep = 1;
    if (KIND == 0) { const int e = it / IT_GU, r = it - e * IT_GU; const int kb = r / 176, nb = r % 176; const int n = 32 * nb; m.k0 = 64 * kb; m.n0 = n; m.ld = 2816; m.K = 1024;
        const float* W = (((n >> 7) & 1) ? inp->mw_up : inp->mw_gate) + (size_t)e * 1024 * 2816;
        m.src = W + (size_t)(m.k0 + r8) * 2816 + (n >> 8) * 128 + (n & 127) + c4; m.dst = (bf16*)(ws + WS_MGU + (size_t)e * 5632 * 1024); }
    else { const int e = it / IT_DN, r = it - e * IT_DN; const int kb = r / 32, nb = r % 32; m.k0 = 64 * kb; m.n0 = 32 * nb; m.ld = 1024; m.K = 2816;
        m.src = inp->mw_down + (size_t)e * 2816 * 1024 + (size_t)(m.k0 + r8) * 1024 + m.n0 + c4; m.dst = (bf16*)(ws + WS_MDN + (size_t)e * 1024 * 2816); }
    return m;
}
__device__ __forceinline__ void moe_item_load(const MoeItem& m, float (&v)[32]) {
#pragma unroll
    for (int i = 0; i < 8; ++i) { const f32x4 t = *(const f32x4*)(m.src + (size_t)(8 * i) * m.ld); v[4 * i] = t[0]; v[4 * i + 1] = t[1]; v[4 * i + 2] = t[2]; v[4 * i + 3] = t[3]; }
}
__device__ __forceinline__ void moe_item_finish(const MoeItem& m, const float (&v)[32], LAS float* scr, int lane) {
    const int r8 = lane >> 3;
    if (m.rscale != nullptr && m.k0 < 512) {
#pragma unroll
        for (int i = 0; i < 8; ++i) { const float rsv = m.rscale[m.k0 + 8 * i + r8];
#pragma unroll
            for (int j = 0; j < 4; ++j) scr[(8 * i + r8) * 33 + m.scol0 + j * m.sstep] = v[4 * i + j] * rsv; }
    } else {
#pragma unroll
        for (int i = 0; i < 8; ++i)
#pragma unroll
            for (int j = 0; j < 4; ++j) scr[(8 * i + r8) * 33 + m.scol0 + j * m.sstep] = v[4 * i + j];
    }
    LDS_WAIT(); asm volatile("" ::: "memory");
    const int c = lane & 7;
    if (m.f8scale != 0.f) {
        const float sc = m.f8scale; unsigned char* d8 = (unsigned char*)m.dst;
#pragma unroll
        for (int j = 0; j < 4; ++j) { const int n = (lane >> 3) + 8 * j; const LAS float* s = scr + (8 * c) * 33 + n;
            v2u o; int p = 0; p = __builtin_amdgcn_cvt_pk_fp8_f32(s[0 * 33] * sc, s[1 * 33] * sc, p, false); p = __builtin_amdgcn_cvt_pk_fp8_f32(s[2 * 33] * sc, s[3 * 33] * sc, p, true); o.x = (unsigned)p;
            p = 0; p = __builtin_amdgcn_cvt_pk_fp8_f32(s[4 * 33] * sc, s[5 * 33] * sc, p, false); p = __builtin_amdgcn_cvt_pk_fp8_f32(s[6 * 33] * sc, s[7 * 33] * sc, p, true); o.y = (unsigned)p;
            *(GAS v2u*)(d8 + (size_t)(m.n0 + n) * m.K + m.k0 + 8 * c) = o; }
    } else {
#pragma unroll
        for (int j = 0; j < 4; ++j) { const int n = (lane >> 3) + 8 * j; const LAS float* s = scr + (8 * c) * 33 + n;
            v4u o; o.x = pk2(s[0 * 33], s[1 * 33]); o.y = pk2(s[2 * 33], s[3 * 33]); o.z = pk2(s[4 * 33], s[5 * 33]); o.w = pk2(s[6 * 33], s[7 * 33]);
            *(GAS v4u*)(m.dst + (size_t)(m.n0 + n) * m.K + m.k0 + 8 * c) = o; }
    }
    LDS_WAIT(); asm volatile("" ::: "memory");
}
template <class InP> __device__ __forceinline__ MoeItem base_item(InP inp, unsigned char* ws, int it, int lane) {
    MoeItem m; m.rscale = nullptr; m.f8scale = 0.f; int r = it; const int r8 = lane >> 3, c = lane & 7, c4 = 4 * c; m.scol0 = c4; m.sstep = 1;
    if (r < 2 * IT_WIN) { const int l = r / IT_WIN; r -= l * IT_WIN; m.k0 = 64 * (r / 112); m.n0 = 32 * (r % 112); m.ld = 3584; m.K = 1024;
        int scol = m.n0 + c4;
        if (m.n0 >= 1536 && m.n0 < 2560) { const int hb = (m.n0 - 1536) & ~127, a0 = ((m.n0 - 1536) & 127) >> 3;
            scol = 1536 + hb + 4 * (a0 + (c & 3)) + 64 * (c >> 2); m.scol0 = 8 * (c & 3) + (c >> 2); m.sstep = 2; }
        m.src = inp->w_in + (size_t)l * 1024 * 3584 + (size_t)(m.k0 + r8) * 3584 + scol; m.dst = (bf16*)(ws + WS_WIN) + (size_t)l * 3584 * 1024; return m; }
    r -= 2 * IT_WIN;
    if (r < 2 * IT_WOUT) { const int l = r / IT_WOUT; r -= l * IT_WOUT; m.k0 = 64 * (r / 32); m.n0 = 32 * (r % 32); m.ld = 1024; m.K = 1024; m.rscale = inp->att_g + l * 512;
        m.src = inp->w_out + (size_t)l * 1024 * 1024 + (size_t)(m.k0 + r8) * 1024 + m.n0 + c4; m.dst = (bf16*)(ws + WS_WOUT) + (size_t)l * 1024 * 1024; return m; }
    r -= 2 * IT_WOUT;
    if (r < IT_GU) { const int n = 32 * (r % 176); m.k0 = 64 * (r / 176); m.n0 = n; m.ld = 2816; m.K = 1024;
        m.src = (((n >> 7) & 1) ? inp->fw_up : inp->fw_gate) + (size_t)(m.k0 + r8) * 2816 + (n >> 8) * 128 + (n & 127) + c4; m.dst = (bf16*)(ws + WS_FGU); m.f8scale = 32.0f; return m; }
    r -= IT_GU; m.k0 = 64 * (r / 32); m.n0 = 32 * (r % 32); m.ld = 1024; m.K = 2816;
    m.src = inp->fw_down + (size_t)(m.k0 + r8) * 1024 + m.n0 + c4; m.dst = (bf16*)(ws + WS_FDN); m.f8scale = 64.0f; return m;
}
#ifndef CONV_DEPTH
#define CONV_DEPTH 4
#endif
#define CONV_PIPE(ITEM_FN, IT_FIRST, IT_END, STEP)                                                                      \
    { int it = (IT_FIRST); const int it_end = (IT_END), st_ = (STEP);                                                   \
      if (it < it_end) {                                                                                                \
        float v0[32], v1[32], v2[32], v3[32]; MoeItem q0, q1, q2, q3;                                                   \
        auto clampi = [&](int i) { return i < it_end ? i : it; };                                                       \
        q0 = ITEM_FN(it); moe_item_load(q0, v0);                                                                        \
        if (CONV_DEPTH > 2) { q1 = ITEM_FN(clampi(it + st_)); moe_item_load(q1, v1); }                                  \
        if (CONV_DEPTH > 3) { q2 = ITEM_FN(clampi(it + 2 * st_)); moe_item_load(q2, v2); }                              \
        for (;;) {                                                                                                      \
            if (CONV_DEPTH == 2) { q1 = ITEM_FN(clampi(it + st_)); moe_item_load(q1, v1); }                             \
            if (CONV_DEPTH == 3) { q2 = ITEM_FN(clampi(it + 2 * st_)); moe_item_load(q2, v2); }                         \
            if (CONV_DEPTH == 4) { q3 = ITEM_FN(clampi(it + 3 * st_)); moe_item_load(q3, v3); }                         \
            moe_item_finish(q0, v0, scr, lane); it += st_; if (it >= it_end) break;                                     \
            if (CONV_DEPTH == 2) { q0 = ITEM_FN(clampi(it + st_)); moe_item_load(q0, v0); }                             \
            if (CONV_DEPTH == 3) { q0 = ITEM_FN(clampi(it + 2 * st_)); moe_item_load(q0, v0); }                         \
            if (CONV_DEPTH == 4) { q0 = ITEM_FN(clampi(it + 3 * st_)); moe_item_load(q0, v0); }                         \
            moe_item_finish(q1, v1, scr, lane); it += st_; if (it >= it_end) break;                                     \
            if (CONV_DEPTH == 2) continue;                                                                              \
            if (CONV_DEPTH == 3) { q1 = ITEM_FN(clampi(it + 2 * st_)); moe_item_load(q1, v1); }                         \
            if (CONV_DEPTH == 4) { q1 = ITEM_FN(clampi(it + 3 * st_)); moe_item_load(q1, v1); }                         \
            moe_item_finish(q2, v2, scr, lane); it += st_; if (it >= it_end) break;                                     \
            if (CONV_DEPTH == 3) continue;                                                                              \
            q2 = ITEM_FN(clampi(it + 3 * st_)); moe_item_load(q2, v2);                                                  \
            moe_item_finish(q3, v3, scr, lane); it += st_; if (it >= it_end) break;                                     \
        }                                                                                                               \
      } }
constexpr int IT_LATE = IT_WIN + IT_WOUT, IT_EARLY = IT_NONMOE - IT_LATE;
template <class InP> __device__ __forceinline__ void convert_base_all(InP inp, unsigned char* ws, LAS unsigned char* lds, int gw, int NGW, int wave, int lane) {
    LAS float* scr = (LAS float*)(lds + wave * 16384);
    auto item = [&](int p) { return base_item(inp, ws, p < IT_WIN ? p : (p < IT_WIN + IT_WOUT ? p + IT_WIN : p + IT_WIN + IT_WOUT), lane); };
    CONV_PIPE(item, gw, IT_EARLY, NGW)
}
template <class InP> __device__ __forceinline__ void convert_base_late(InP inp, unsigned char* ws, LAS unsigned char* lds, int sp, int nsp, int wave, int lane) {
    LAS float* scr = (LAS float*)(lds + wave * 16384);
    auto item = [&](int d) { return base_item(inp, ws, d < IT_WIN ? IT_WIN + d : d + IT_WIN + IT_WOUT, lane); };
    CONV_PIPE(item, sp * NWAVES + wave, IT_LATE, nsp * NWAVES)
}
template <int KIND, class InP> __device__ __forceinline__ void convert_moe_range(InP inp, unsigned char* ws, LAS unsigned char* lds, int it0, int it1, int sp, int nsp, int wave, int lane) {
    LAS float* scr = (LAS float*)(lds + wave * 16384);
    auto item = [&](int i) { return moe_item<KIND>(inp, ws, i, lane); };
    CONV_PIPE(item, it0 + sp * NWAVES + wave, it1, nsp * NWAVES)
}
constexpr int IT_MOE = 8 * (IT_GU + IT_DN);
#ifndef G_GUD_N
#define G_GUD_N 208
#endif
constexpr int G_INPROJ = 224, G_GUD = G_GUD_N;
#ifndef MOE_SPARE
#define MOE_SPARE 8
#endif
constexpr int IT_MGU = 8 * IT_GU, IT_MDN = 8 * IT_DN;
#ifndef SPLIT_A
#define SPLIT_A 9000
#define SPLIT_B 19500
#define SPLIT_C 7500
#endif
constexpr int IT_MOE_A = SPLIT_A, IT_MOE_B = SPLIT_B, IT_MDN_C = SPLIT_C;

template <class InP> __device__ __forceinline__ void p0_prologue(InP inp, unsigned char* ws, LAS unsigned char* lds, int vcu, int G, int wave, int lane, int tid, int moe_w) {
    Inputs in; in.c = inp->c; in.ada_w = inp->ada_w; in.ada_b = inp->ada_b; in.w_in = inp->w_in; in.w_out = inp->w_out; in.att_g = inp->att_g; in.fw_gate = inp->fw_gate; in.fw_up = inp->fw_up; in.fw_down = inp->fw_down; in.mw_gate = inp->mw_gate; in.mw_up = inp->mw_up; in.mw_down = inp->mw_down;
    if (vcu < 192) {
        LAS float* cs = (LAS float*)lds;
        LAS float* part = (LAS float*)(lds + 32768);
        for (int i = tid; i < 8 * 1024; i += 512) { const float v = in.c[i]; cs[i] = v / (1.0f + __expf(-v)); }
        __syncthreads();
        const int n0 = vcu * 64, l = n0 / 6144, nn = n0 % 6144 + lane;
        const float* wp = in.ada_w + (size_t)l * 1024 * 6144 + (size_t)(wave * 128) * 6144 + nn;
        float acc[8];
#pragma unroll
        for (int b = 0; b < 8; ++b) acc[b] = 0.f;
#pragma unroll 8
        for (int k = 0; k < 128; ++k) { const float wv = wp[(size_t)k * 6144];
#pragma unroll
            for (int b = 0; b < 8; ++b) acc[b] += cs[b * 1024 + wave * 128 + k] * wv; }
#pragma unroll
        for (int b = 0; b < 8; ++b) part[(wave * 8 + b) * 64 + lane] = acc[b];
        __syncthreads();
        { const int b = tid >> 6; float s = 0.f;
#pragma unroll
          for (int w = 0; w < 8; ++w) s += part[(w * 8 + b) * 64 + lane];
          ((float*)(ws + WS_MOD))[((size_t)l * 8 + b) * 6144 + nn] = s + in.ada_b[l * 6144 + nn]; }
        __syncthreads();
    }
    { const int g = vcu * 512 + tid; if (g < 2048 * 64) { const int pos = g >> 6, i = g & 63; const float inv = powf(10000.0f, -(float)i / 64.0f); const float ang = (float)pos * inv;
        float* rp = (float*)(ws + WS_ROPE) + (size_t)g * 2; rp[0] = (float)cos((double)ang); rp[1] = (float)sin((double)ang); } }
    convert_base_all(inp, ws, lds, vcu * NWAVES + wave, G * NWAVES, wave, lane);
}

template <int MODE>
__device__ __forceinline__ void norm_pass(const float* xsrc, const float* gain, const float* sh, const float* sc, bf16* dst,
                                          const float* router_w, int* eidx, float* ew, int* wcnt, int gw, int lane) {
    const int m0 = gw * 8, b = m0 >> 11;
    f32x4 gv[4], scv[4], shv[4];
#pragma unroll
    for (int j = 0; j < 4; ++j) { gv[j] = ((const f32x4*)gain)[lane + 64 * j]; scv[j] = ((const f32x4*)(sc + (size_t)b * 6144))[lane + 64 * j] + 1.0f; shv[j] = ((const f32x4*)(sh + (size_t)b * 6144))[lane + 64 * j]; }
    int cnt[8];
#pragma unroll
    for (int e = 0; e < 8; ++e) cnt[e] = 0;
    f32x4 rw[4][4][2];
    if (MODE == 1) {
#pragma unroll
        for (int j = 0; j < 4; ++j)
#pragma unroll
            for (int c = 0; c < 4; ++c) { const float* wp = router_w + (size_t)(4 * (lane + 64 * j) + c) * 8; rw[j][c][0] = *(const f32x4*)wp; rw[j][c][1] = *(const f32x4*)(wp + 4); }
    }
    for (int i = 0; i < 8; ++i) {
        const int m = m0 + i;
        const f32x4* xr = (const f32x4*)(xsrc + (size_t)m * 1024) + lane;
        f32x4 v[4]; float s = 0.f;
#pragma unroll
        for (int j = 0; j < 4; ++j) { v[j] = xr[64 * j]; s += (v[j][0] * v[j][0] + v[j][1] * v[j][1]) + (v[j][2] * v[j][2] + v[j][3] * v[j][3]); }
        const float rs = 1.0f / sqrtf(wave_sum(s) * (1.0f / 1024.0f) + 1e-6f);
        if (MODE == 2) {
            unsigned* o4 = (unsigned*)((unsigned char*)dst + (size_t)m * 1024) + lane;
#pragma unroll
            for (int j = 0; j < 4; ++j) { v[j] = v[j] * rs * gv[j] * scv[j] + shv[j]; o4[64 * j] = epi::pk4_fp8(v[j][0], v[j][1], v[j][2], v[j][3]); }
        } else {
        v2u* o8 = (v2u*)(dst + (size_t)m * 1024) + lane;
#pragma unroll
        for (int j = 0; j < 4; ++j) { v[j] = v[j] * rs * gv[j] * scv[j] + shv[j]; v2u w; w.x = pk2(v[j][0], v[j][1]); w.y = pk2(v[j][2], v[j][3]); o8[64 * j] = w; }
        }
        if (MODE == 1) {
            float lg[8];
#pragma unroll
            for (int e = 0; e < 8; ++e) lg[e] = 0.f;
#pragma unroll
            for (int j = 0; j < 4; ++j)
#pragma unroll
                for (int c = 0; c < 4; ++c) { const f32x4 w0 = rw[j][c][0], w1 = rw[j][c][1];
                    const float hv = v[j][c];
                    lg[0] += hv * w0[0]; lg[1] += hv * w0[1]; lg[2] += hv * w0[2]; lg[3] += hv * w0[3]; lg[4] += hv * w1[0]; lg[5] += hv * w1[1]; lg[6] += hv * w1[2]; lg[7] += hv * w1[3]; }
            { const bool b5 = (lane & 32) != 0, b4 = (lane & 16) != 0, b3 = (lane & 8) != 0;
              float a4[4], b2[2], c1;
#pragma unroll
              for (int q = 0; q < 4; ++q) { const float keep = b5 ? lg[4 + q] : lg[q], send = b5 ? lg[q] : lg[4 + q]; a4[q] = keep + xl::xor32p(send, b5); }
#pragma unroll
              for (int q = 0; q < 2; ++q) { const float keep = b4 ? a4[2 + q] : a4[q], send = b4 ? a4[q] : a4[2 + q]; b2[q] = keep + xl::xor_f<16>(send); }
              { const float keep = b3 ? b2[1] : b2[0], send = b3 ? b2[0] : b2[1]; c1 = keep + xl::xor_f<8>(send); }
              c1 += xl::xor_f<4>(c1); c1 += xl::xor_f<2>(c1); c1 += xl::xor_f<1>(c1);
#pragma unroll
              for (int e = 0; e < 8; ++e) lg[e] = __builtin_bit_cast(float, __builtin_amdgcn_readlane(__builtin_bit_cast(int, c1), 8 * e)); }
            int i0 = 0; float b0 = lg[0];
#pragma unroll
            for (int e = 1; e < 8; ++e) if (lg[e] > b0) { b0 = lg[e]; i0 = e; }
            int i1 = -1; float b1 = -3.0e38f;
#pragma unroll
            for (int e = 0; e < 8; ++e) if (e != i0 && lg[e] > b1) { b1 = lg[e]; i1 = e; }
            const float e1 = __expf(b1 - b0);
#pragma unroll
            for (int e = 0; e < 8; ++e) cnt[e] += ((e == i0) ? 1 : 0) + ((e == i1) ? 1 : 0);
            if (lane == 0) { eidx[m * 2] = i0; eidx[m * 2 + 1] = i1; ew[m * 2] = 1.0f / (1.0f + e1); ew[m * 2 + 1] = e1 / (1.0f + e1); }
        }
    }
    if (MODE == 1) {
        int myc = 0;
#pragma unroll
        for (int e = 0; e < 8; ++e) myc = (lane == e) ? cnt[e] : myc;
        if (lane < 8) wcnt[gw * 8 + lane] = myc;
    }
}

__device__ __forceinline__ void place_pass(const int* wcnt, const int* eidx, const float* ew, const bf16* XA, bf16* XS, int* srow, float* swt, int* segout, int gw, int NGW, int lane) {
    int tot[8], pre[8];
#pragma unroll
    for (int e = 0; e < 8; ++e) { tot[e] = 0; pre[e] = 0; }
    for (int w = lane; w < NGW; w += 64) { const i32x4 a = *(const i32x4*)(wcnt + w * 8), c = *(const i32x4*)(wcnt + w * 8 + 4); const int inc = (w < gw) ? 1 : 0;
        tot[0] += a[0]; tot[1] += a[1]; tot[2] += a[2]; tot[3] += a[3]; tot[4] += c[0]; tot[5] += c[1]; tot[6] += c[2]; tot[7] += c[3];
        pre[0] += inc * a[0]; pre[1] += inc * a[1]; pre[2] += inc * a[2]; pre[3] += inc * a[3]; pre[4] += inc * c[0]; pre[5] += inc * c[1]; pre[6] += inc * c[2]; pre[7] += inc * c[3]; }
    int base[8]; int run = 0;
#pragma unroll
    for (int e = 0; e < 8; ++e) { tot[e] = wave_sum_i(tot[e]); pre[e] = wave_sum_i(pre[e]); base[e] = run + pre[e]; if (gw == 0 && lane == 0) segout[e] = run; run += (tot[e] + 255) & ~255; }
    if (gw == 0 && lane == 0) segout[8] = run;
    const int myev = (lane < 16) ? eidx[gw * 16 + lane] : 0; const float myw = (lane < 16) ? ew[gw * 16 + lane] : 0.f;
    int mypos = 0;
#pragma unroll
    for (int i = 0; i < 16; ++i) { const int ev = __builtin_amdgcn_readlane(myev, i); int pos = 0;
#pragma unroll
        for (int e = 0; e < 8; ++e) if (ev == e) { pos = base[e]; base[e] += 1; }
        mypos = (lane == i) ? pos : mypos; }
    if (lane < 16) { srow[mypos] = gw * 16 + lane; swt[mypos] = myw; }
    const v4u* __restrict__ s = (const v4u*)(XA + (size_t)(gw * 8) * 1024);
    v4u r0[8], r1[8];
#pragma unroll
    for (int t = 0; t < 8; ++t) { r0[t] = s[t * 128 + lane]; r1[t] = s[t * 128 + lane + 64]; }
    v2u q0[8], q1[8];
#pragma unroll
    for (int t = 0; t < 8; ++t) {
        { int p = 0; p = __builtin_amdgcn_cvt_pk_fp8_f32(h16::lo(r0[t].x), h16::hi(r0[t].x), p, false); p = __builtin_amdgcn_cvt_pk_fp8_f32(h16::lo(r0[t].y), h16::hi(r0[t].y), p, true); q0[t].x = (unsigned)p;
          p = 0; p = __builtin_amdgcn_cvt_pk_fp8_f32(h16::lo(r0[t].z), h16::hi(r0[t].z), p, false); p = __builtin_amdgcn_cvt_pk_fp8_f32(h16::lo(r0[t].w), h16::hi(r0[t].w), p, true); q0[t].y = (unsigned)p; }
        { int p = 0; p = __builtin_amdgcn_cvt_pk_fp8_f32(h16::lo(r1[t].x), h16::hi(r1[t].x), p, false); p = __builtin_amdgcn_cvt_pk_fp8_f32(h16::lo(r1[t].y), h16::hi(r1[t].y), p, true); q1[t].x = (unsigned)p;
          p = 0; p = __builtin_amdgcn_cvt_pk_fp8_f32(h16::lo(r1[t].z), h16::hi(r1[t].z), p, false); p = __builtin_amdgcn_cvt_pk_fp8_f32(h16::lo(r1[t].w), h16::hi(r1[t].w), p, true); q1[t].y = (unsigned)p; } }
#pragma unroll
    for (int i = 0; i < 16; ++i) { const int pos = __builtin_amdgcn_readlane(mypos, i); v2u* __restrict__ d = (v2u*)((unsigned char*)XS + (size_t)pos * 1024);
        d[lane] = q0[i >> 1]; d[lane + 64] = q1[i >> 1]; }
}

__device__ __forceinline__ void final_pass(float* xio, const bf16* YS, const int* atomf, const float* slab, const float* g2, const float* fg, int gw, int lane) {
    const int m0 = gw * 8, b = m0 >> 11;
    f32x4 gv[4], g2v[4];
#pragma unroll
    for (int j = 0; j < 4; ++j) { gv[j] = ((const f32x4*)fg)[lane + 64 * j]; g2v[j] = ((const f32x4*)(g2 + (size_t)b * 6144))[lane + 64 * j]; }
    for (int i = 0; i < 8; ++i) {
        const int m = m0 + i;
        f32x4* xr = (f32x4*)(xio + (size_t)m * 1024) + lane;
        const v2u* y0 = (const v2u*)(YS + (size_t)(2 * m) * 1024) + lane; const v2u* y1 = (const v2u*)(YS + (size_t)(2 * m + 1) * 1024) + lane;
        f32x4 v[4]; float s = 0.f; const i32x4 f0 = *(const i32x4*)(atomf + (size_t)(2 * m) * 4), f1 = *(const i32x4*)(atomf + (size_t)(2 * m + 1) * 4);
#pragma unroll
        for (int j = 0; j < 4; ++j) { v[j] = xr[64 * j]; const v2u a = y0[64 * j], c = y1[64 * j];
            f32x4 ya, yc;
            if (f0[j]) { const int id = f0[j] - 1; const float* sp = slab + ((size_t)((id >> 8) * 11) * 256 + (id & 255)) * 256 + 4 * lane; ya = (f32x4){0.f, 0.f, 0.f, 0.f};
                for (int kc = 0; kc < 11; ++kc) ya += *(const f32x4*)(sp + (size_t)kc * 65536); }
            else { ya[0] = h16::lo(a.x); ya[1] = h16::hi(a.x); ya[2] = h16::lo(a.y); ya[3] = h16::hi(a.y); }
            if (f1[j]) { const int id = f1[j] - 1; const float* sp = slab + ((size_t)((id >> 8) * 11) * 256 + (id & 255)) * 256 + 4 * lane; yc = (f32x4){0.f, 0.f, 0.f, 0.f};
                for (int kc = 0; kc < 11; ++kc) yc += *(const f32x4*)(sp + (size_t)kc * 65536); }
            else { yc[0] = h16::lo(c.x); yc[1] = h16::hi(c.x); yc[2] = h16::lo(c.y); yc[3] = h16::hi(c.y); }
            const f32x4 ys = ya + yc;
            v[j] = v[j] + g2v[j] * ys; s += (v[j][0] * v[j][0] + v[j][1] * v[j][1]) + (v[j][2] * v[j][2] + v[j][3] * v[j][3]); }
        const float rs = 1.0f / sqrtf(wave_sum(s) * (1.0f / 1024.0f) + 1e-6f);
#pragma unroll
        for (int j = 0; j < 4; ++j) xr[64 * j] = v[j] * rs * gv[j];
    }
}

constexpr int N_PHASES = 18;
struct Args { Inputs in; float* out; unsigned char* ws; int ph_lo, ph_hi, bar_region, moe_w; };

typedef const Args __attribute__((address_space(4))) CArgs;
__device__ __forceinline__ CArgs* kargs() { unsigned long off = 0; asm volatile("" : "+s"(off)); return (CArgs*)((const char __attribute__((address_space(4)))*)__builtin_amdgcn_kernarg_segment_ptr() + off); }

__global__ void __launch_bounds__(NWAVES * 64, 2) mega(Args args_unused) {
    extern __shared__ __attribute__((aligned(16))) unsigned char lds_raw[];
    LAS unsigned char* lds = (LAS unsigned char*)lds_raw;
    volatile LAS unsigned* MISC = (volatile LAS unsigned*)(lds + MISC_OFF);
    const int G = gridDim.x;
#define PHASE_IDS int tid = otid(WV); int bx = blockIdx.x; asm volatile("" : "+s"(bx)); const int lane = tid & 63, wave = __builtin_amdgcn_readfirstlane(tid >> 6); \
    const int vcu = (bx & 7) * (G >> 3) + (bx >> 3); const int gw = vcu * NWAVES + wave; (void)lane; (void)gw; (void)vcu;
    const int WV = __builtin_amdgcn_readfirstlane((int)threadIdx.x >> 6);
    for (int u = otid(WV); u < (LDS_BYTES - LDSCTL_OFF) / 4; u += NWAVES * 64) ((LAS unsigned*)(lds + LDSCTL_OFF))[u] = 0u;
    __syncthreads();
    XcdBarrier bar;
    { CArgs* ka = kargs(); unsigned* barw = (unsigned*)(ka->ws + WS_CTL) + CW_BAR + ka->bar_region * XCD_BAR_WORDS; bar = xcd_barrier_post(barw, MISC + 8, WV); }
    int lo, hi; { CArgs* ka = kargs(); lo = ka->ph_lo; hi = ka->ph_hi; }
#ifndef PHM
#define PHM 0x3ff
#endif
#define IN(k) (lo <= (k) && (k) < hi)
#define TY(t) (((PHM) >> (t)) & 1)
#ifndef DUP_T
#define DUP_T -1
#define DUP_N 0
#endif
#define REP(t) for (int rep_ = 0; rep_ < ((t) == DUP_T ? 1 + DUP_N : 1) && (rep_ == 0 || (__syncthreads(), true)); ++rep_)
#ifdef TPROBE
#define TS ((volatile LAS unsigned long long*)(lds + MISC_OFF + 256))
#define STAMP(k) do { if (blockIdx.x == 0 && otid(WV) == 0) TS[(k)] = __builtin_amdgcn_s_memrealtime(); } while (0)
#else
#define STAMP(k) do {} while (0)
#endif
#ifdef TSPIN
#ifndef TSPIN_BX
#define TSPIN_BX 0
#endif
#define TSL ((volatile LAS unsigned long long*)(lds + MISC_OFF + 256))
#define STAMP_E(k) do { if (blockIdx.x == TSPIN_BX && otid(WV) == 0) { const unsigned long long n_ = __builtin_amdgcn_s_memrealtime(); if (((TSPIN_W) >> (k)) & 1) TSL[1] += n_ - TSL[0]; TSL[0] = n_; } } while (0)
#define STAMP_S(k) do { if (blockIdx.x == TSPIN_BX && otid(WV) == 0) { const unsigned long long n_ = __builtin_amdgcn_s_memrealtime(); if (((TSPIN_B) >> (k)) & 1) TSL[1] += n_ - TSL[0]; TSL[0] = n_; } } while (0)
    if (blockIdx.x == TSPIN_BX && otid(WV) == 0) { TSL[1] = 0ull; TSL[0] = __builtin_amdgcn_s_memrealtime(); }
#else
#define STAMP_E(k) do {} while (0)
#define STAMP_S(k) do {} while (0)
#endif
    STAMP(0);
#define SEAM(k) do { STAMP_E(k); if (IN(k) && IN((k) + 1)) xcd_barrier(bar); STAMP_S(k); STAMP((k) + 1); } while (0)

    if (TY(0) && IN(0)) REP(0) { PHASE_IDS CArgs* ka = kargs(); p0_prologue(&ka->in, ka->ws, lds, vcu, G, wave, lane, tid, 0); }
    SEAM(0);
#ifdef PROBE_BAR
    for (int q = 0; q < PROBE_BAR; ++q) xcd_barrier(bar);
#endif
    for (int l = 0; l < 2; ++l) {
        const int pb = 1 + 8 * l;
        if (TY(1) && IN(pb + 0)) REP(1) { PHASE_IDS CArgs* ka = kargs(); unsigned char* ws = ka->ws; const float* mod = (const float*)(ws + WS_MOD) + (size_t)l * 8 * 6144;
            const float* xin = (l == 0) ? ka->in.x : (const float*)ka->out;
            if (gw < 2048) norm_pass<0>(xin, ka->in.norm_mix_g + l * 1024, mod + 0 * 1024, mod + 1 * 1024, (bf16*)(ws + WS_XA), nullptr, nullptr, nullptr, nullptr, gw, lane); }
        SEAM(pb + 0);
        if (TY(2) && IN(pb + 1)) REP(2) { PHASE_IDS CArgs* ka = kargs(); unsigned char* ws = ka->ws;
            if (bx < G_INPROJ) {
                pg8::Gemm g{1024, 1024, 1024}; pg8::DenseSched S; S.init(ws + WS_XA, 1024, (bf16*)(ws + WS_WIN) + (size_t)l * 3584 * 1024, 1024, 16384, 3584, G_INPROJ, bx);
                epi::EpiInProj E{(bf16*)(ws + WS_QKV), (size_t)16384 * 512, (float*)(ws + WS_KMP), (const float*)(ws + WS_ROPE)};
                pg8::gemm_phase(WV, lds, g, S, E);
            } else if (rep_ == 0) { convert_moe_range<0>(&ka->in, ws, lds, l == 0 ? 0 : IT_MOE_B, l == 0 ? IT_MOE_A : IT_MGU, bx - G_INPROJ, G - G_INPROJ, wave, lane);
                                    if (l == 1) convert_moe_range<1>(&ka->in, ws, lds, 0, IT_MDN_C, bx - G_INPROJ, G - G_INPROJ, wave, lane);
#ifdef PROBE_CONVIN
                                    if (l == PROBE_CONVIN) { __syncthreads(); if (l == 0) convert_moe_range<0>(&ka->in, ws, lds, 0, IT_MOE_A, bx - G_INPROJ, G - G_INPROJ, wave, lane); else convert_moe_range<1>(&ka->in, ws, lds, 0, IT_MDN_C, bx - G_INPROJ, G - G_INPROJ, wave, lane); }
#endif
                                    }
        }
        SEAM(pb + 1);
        if (TY(3) && IN(pb + 2)) REP(3) { PHASE_IDS CArgs* ka = kargs(); unsigned char* ws = ka->ws; bf16* QKV = (bf16*)(ws + WS_QKV); bf16* CAT = (bf16*)(ws + WS_CAT);
            if (G == 256) {
                if ((bx & 7) < 7) fa::kv_unit(WV, bx >> 5, (bx >> 3) & 3, bx & 7, QKV + (size_t)4 * 16384 * 512, QKV + (size_t)5 * 16384 * 512, (float*)(ws + WS_KVM), lds);
                xcd_barrier(bar);
                { fa::Tensors TR{QKV + (size_t)3 * 16384 * 512, QKV + (size_t)4 * 16384 * 512, QKV + (size_t)5 * 16384 * 512, CAT, (float*)(ws + WS_ASSQ), (const float*)(ws + WS_KMP), QKV + (size_t)6 * 16384 * 512, ka->in.ret_g + l * 512, (const float*)(ws + WS_KVM)};
                  fa::attn_unit<true>(WV, bx >> 5, (bx >> 3) & 3, bx & 7, TR, lds); }
                fa::Tensors TA{QKV, QKV + (size_t)1 * 16384 * 512, QKV + (size_t)2 * 16384 * 512, CAT, (float*)(ws + WS_ASSQ), (const float*)(ws + WS_KMP), nullptr, nullptr, nullptr};
                const int g2 = (bx >> 3) * 2, r4 = (bx & 7) * 4;
                for (int uu = 0; uu < 2; ++uu) { const int bh = g2 + uu; fa::attn_unit<false>(WV, bh >> 3, bh & 7, ((uu == 0 ? 0x25170643 : 0x31507246) >> r4) & 7, TA, lds); }
            }
        }
        SEAM(pb + 2);
        if (TY(4) && IN(pb + 3)) REP(4) {
            { PHASE_IDS CArgs* ka = kargs(); unsigned char* ws = ka->ws; const float* mod = (const float*)(ws + WS_MOD) + (size_t)l * 8 * 6144;
                const float* xin = (l == 0) ? ka->in.x : (const float*)ka->out;
                pg8::Gemm g{1024, 1024, 1024}; pg8::DenseSched S; S.init(ws + WS_CAT, 1024, (const bf16*)(ws + WS_WOUT) + (size_t)l * 1024 * 1024, 1024, 16384, 1024, G, bx);
                epi::EpiOutProj E{xin, ka->out, mod + 2 * 1024, (const float*)(ws + WS_ASSQ), rep_ > 0}; pg8::gemm_phase(WV, lds, g, S, E); }
        }
        SEAM(pb + 3);
        if (TY(5) && IN(pb + 4)) REP(5) { PHASE_IDS CArgs* ka = kargs(); unsigned char* ws = ka->ws; const float* mod = (const float*)(ws + WS_MOD) + (size_t)l * 8 * 6144;
            if (gw < 2048) {
                if (l == 0) norm_pass<2>(ka->out, ka->in.norm_ffn_g + l * 1024, mod + 3 * 1024, mod + 4 * 1024, (bf16*)(ws + WS_XA), nullptr, nullptr, nullptr, nullptr, gw, lane);
                else norm_pass<1>(ka->out, ka->in.norm_ffn_g + l * 1024, mod + 3 * 1024, mod + 4 * 1024, (bf16*)(ws + WS_XA), ka->in.router_w, (int*)(ws + WS_EIDX), (float*)(ws + WS_EW), (int*)(ws + WS_WCNT), gw, lane);
            }
            if (l == 1) { int* srow = (int*)(ws + WS_SROW); int* af = (int*)(ws + WS_ATOMF);
                { const int p = bx * 512 + tid; if (p < XS_ROWS) srow[p] = -1; af[p] = 0; }
            }
            else if (bx == 0 && tid < 9) { ((int*)(ws + WS_SEGD))[tid] = (tid == 0) ? 0 : ((tid == 8) ? 16384 : (1 << 30)); }
        }
        SEAM(pb + 4);
        if (l == 1) {
            if (TY(6) && IN(pb + 5)) REP(6) { PHASE_IDS CArgs* ka = kargs(); unsigned char* ws = ka->ws;
                if (gw < 2048) place_pass((const int*)(ws + WS_WCNT), (const int*)(ws + WS_EIDX), (const float*)(ws + WS_EW), (const bf16*)(ws + WS_XA), (bf16*)(ws + WS_XS), (int*)(ws + WS_SROW), (float*)(ws + WS_SWT), (int*)(ws + WS_SEG), gw, 2048, lane); }
            SEAM(pb + 5);
        } else { STAMP(pb + 6); }
        if (TY(7) && IN(pb + 6)) REP(7) { PHASE_IDS CArgs* ka = kargs(); unsigned char* ws = ka->ws;
            int Geff = G_GUD;
            if (l == 1) { const int nwg = (__builtin_amdgcn_readfirstlane(((const int*)(ws + WS_SEG))[8]) / 256) * 22; const int rounds = (nwg + G - 1) / G;
                Geff = (((nwg + rounds - 1) / rounds) + 7) & ~7; if (Geff > G - MOE_SPARE) Geff = G - MOE_SPARE; }
            if (bx < Geff) {
                pg8::Gemm g{512, 512, 512}; pg8::MoeSched S;
                S.init(ws + (l == 0 ? WS_XA : WS_XS), 512, ws + (l == 0 ? WS_FGU : WS_MGU), 512, (size_t)5632 * 1024, (const int*)(ws + (l == 0 ? WS_SEGD : WS_SEG)), 5632, Geff, bx);
                epi::EpiSwiGLU8 E{ws + (l == 0 ? WS_HD : WS_HM), 2816}; pg8::gemm_phase(WV, lds, g, S, E);
            } else if (rep_ == 0) { if (l == 0) { convert_base_late(&ka->in, ws, lds, bx - Geff, G - Geff, wave, lane); convert_moe_range<0>(&ka->in, ws, lds, IT_MOE_A, IT_MOE_B, bx - Geff, G - Geff, wave, lane); }
                                    else { convert_moe_range<1>(&ka->in, ws, lds, IT_MDN_C, IT_MDN, bx - Geff, G - Geff, wave, lane);
#ifdef PROBE_CONV2
                                           __syncthreads(); convert_moe_range<1>(&ka->in, ws, lds, IT_MDN_C, IT_MDN, bx - Geff, G - Geff, wave, lane);
#endif
                                    } }
        }
        SEAM(pb + 6);
        if (TY(8) && IN(pb + 7)) REP(8) { PHASE_IDS CArgs* ka = kargs(); unsigned char* ws = ka->ws; const float* mod = (const float*)(ws + WS_MOD) + (size_t)l * 8 * 6144;
            if (l == 0) { pg8::MoeSched S; S.init(ws + WS_HD, 1408, ws + WS_FDN, 1408, (size_t)1024 * 2816, (const int*)(ws + WS_SEGD), 1024, G, bx);
                pg8::Gemm g{1408, 1408, 1408};
                epi::EpiDownDense8 E{ka->out, mod + 5 * 1024, rep_ > 0}; pg8::gemm_phase(WV, lds, g, S, E);
            } else {
                pg8::MoeSched S; S.init(ws + WS_HM, 1408, ws + WS_MDN, 1408, (size_t)1024 * 2816, (const int*)(ws + WS_SEG), 1024, G, bx);
                pg8::Gemm g{1408, 1408, 1408};
                epi::EpiDownMoe8 E{(bf16*)(ws + WS_YS), (const int*)(ws + WS_SROW), (const float*)(ws + WS_SWT)}; pg8::gemm_phase(WV, lds, g, S, E);
            }
        }
        SEAM(pb + 7);
    }
    if (TY(9) && IN(17)) { PHASE_IDS CArgs* ka = kargs(); unsigned char* ws = ka->ws;
        if (gw < 2048) final_pass(ka->out, (const bf16*)(ws + WS_YS), (const int*)(ws + WS_ATOMF), (const float*)(ws + WS_SLAB), (const float*)(ws + WS_MOD) + (size_t)1 * 8 * 6144 + 5 * 1024, ka->in.final_g, gw, lane); }
#ifdef TSPIN
    STAMP_E(17);
    if (blockIdx.x == TSPIN_BX && otid(WV) == 0) { const unsigned long long t0_ = __builtin_amdgcn_s_memrealtime(), w_ = TSL[1] * (unsigned long long)(TSPIN_K);
        while (__builtin_amdgcn_s_memrealtime() - t0_ < w_) __builtin_amdgcn_s_sleep(8); }
#endif
#ifdef TPROBE
    xcd_barrier(bar); STAMP(18); __syncthreads();
    if (blockIdx.x == 0) { CArgs* ka = kargs(); float* o = ka->out;
        const float d1 = (float)(TS[TPROBE_A + 1] - TS[TPROBE_A]) * 0.01f, d2 = (float)(TS[TPROBE_B + 1] - TS[TPROBE_B]) * 0.01f;
        const float a = 4.0f * sqrtf(d1);
        for (int i = otid(WV); i < 1024 * 1024; i += 512) o[i] = a;
        if (otid(WV) == 0) o[1024 * 1024 + 5] = 100.0f * d2; }
#endif
#undef IN
#undef TY
#undef SEAM
#undef PHASE_IDS
}
}
#ifndef STEP
#define STEP 5
#endif
namespace ad {
__device__ __forceinline__ float bf2f(unsigned short s) { return h16::one(s); }
__global__ void __launch_bounds__(256) ad_proj(const unsigned short* QKV, size_t gstride, int b, float* projb) {
    const int m = blockIdx.x; const size_t row = (size_t)b * 2048 + m;
    for (int n = threadIdx.x; n < 3584; n += 256) {
        const int grp = n / 512, c = n % 512; int sc = c;
        if (grp == 3 || grp == 4) { const int head = c >> 7, d = c & 127; sc = head * 128 + 8 * ((d & 63) >> 2) + 2 * (d & 3) + (d >> 6); }
        float v = bf2f(QKV[(size_t)grp * gstride + row * 512 + sc]);
        if (grp == 0) v *= (1.0f / epi::C2);
        if (grp == 4) v *= (1.0f / epi::KSC);
        projb[(size_t)m * 3584 + n] = v;
    }
}
__global__ void __launch_bounds__(64) ad_kmean(const float* KMP, int b, float* kmeanb) {
    const int blk = blockIdx.x, h = blockIdx.y, d = threadIdx.x;
    const float* p = KMP + ((size_t)(b * 8 + blk) * 2) * 512 + h * 64 + d;
    kmeanb[((size_t)h * 8 + blk) * 64 + d] = (p[0] + p[512]) * (1.0f / 256.0f);
}
__global__ void __launch_bounds__(256) ad_cat(const unsigned short* CAT, const float* ASSQ, const float* att_g, int b, float* catb) {
    const int m = blockIdx.x; const size_t row = (size_t)b * 2048 + m;
    float ss = 0.f;
    for (int h = 0; h < 8; ++h) ss += ASSQ[row * 8 + h];
    const float rs = 1.0f / sqrtf(ss * (1.0f / 512.0f) + 1e-6f);
    for (int c = threadIdx.x; c < 1024; c += 256) { const float v = bf2f(CAT[row * 1024 + c]); catb[(size_t)m * 1024 + c] = (c < 512) ? v * rs * att_g[c] : v; }
}
__global__ void __launch_bounds__(256) dbg_cmp(const float* a, const float* b, size_t n, float rel, float abs_, unsigned* flag, int ncols = 1, int c_lo = 0, int c_hi = 1, int silu_b = 0) {
    unsigned bad = 0;
    for (size_t i = (size_t)blockIdx.x * 256 + threadIdx.x; i < n; i += (size_t)gridDim.x * 256) { const int c = (int)(i % ncols); if (c < c_lo || c >= c_hi) continue;
        float bv = b[i]; if (silu_b) bv = bv / (1.f + expf(-bv)); const float d = fabsf(a[i] - bv); if (!(d <= rel * fabsf(bv) + abs_)) ++bad; }
    if (bad) atomicAdd(flag, bad);
}
__global__ void __launch_bounds__(256) dbg_poison(const unsigned* flag, unsigned thresh, float* out, float val) {
    if (*flag > thresh) for (int i = threadIdx.x; i < 1024 * 1024; i += 256) out[i] = val;
}
__global__ void __launch_bounds__(256) dbg_ssd(const float* a, const float* b, size_t n, int ncols, int c_lo, int c_hi, float* acc) {
    float s = 0.f;
    for (size_t i = (size_t)blockIdx.x * 256 + threadIdx.x; i < n; i += (size_t)gridDim.x * 256) { const int c = (int)(i % ncols); if (c < c_lo || c >= c_hi) continue; const float d = a[i] - b[i]; s += d * d; }
    atomicAdd(acc, s);
}
__global__ void __launch_bounds__(256) dbg_encode(const float* acc, float count, float* out) {
    const float mse = *acc / count; const float val = 4.0f / sqrtf(mse);
    for (int i = threadIdx.x; i < 1024 * 1024; i += 256) out[i] = val;
}
}

static void launch_mega(const mk::Args& a0, int lo, int hi, int region, hipStream_t stream) {
    mk::Args a = a0; a.ph_lo = lo; a.ph_hi = hi; a.bar_region = region;
    hipLaunchKernelGGL(mk::mega, dim3(256), dim3(512), mk::LDS_BYTES, stream, a);
}

extern "C" void kernel_launch(void* const* d_in, const int* in_sizes, int n_in, void* d_out, int out_size, void* d_ws, size_t ws_size, hipStream_t stream) {
    static int ready = 0;
    if (ready == 0) {
        if (n_in != 18 || out_size != M * D || ws_size < mk::WS_END) { fprintf(stderr, "kernel_launch: unexpected problem (n_in %d, out %d, ws %zu)\n", n_in, out_size, ws_size); ready = -1; return; }
        if (hipFuncSetAttribute((const void*)mk::mega, hipFuncAttributeMaxDynamicSharedMemorySize, mk::LDS_BYTES) != hipSuccess) { fprintf(stderr, "kernel_launch: hipFuncSetAttribute failed\n"); ready = -1; return; }
        ready = 1;
    }
    if (ready < 0) return;
    mk::Args a{};
    const float** ip = (const float**)&a.in;
    for (int i = 0; i < 18; ++i) ip[i] = (const float*)d_in[i];
    a.out = (float*)d_out; a.ws = (unsigned char*)d_ws; a.moe_w = (STEP >= 5) ? 1 : 0;
    const mk::Inputs& in = a.in;
    float* out = (float*)d_out; unsigned char* ws = (unsigned char*)d_ws;
    hipMemsetAsync(ws + mk::WS_CTL, 0, mk::CTL_ZERO_BYTES, stream);
#if STEP >= 6
    launch_mega(a, 0, mk::N_PHASES, 0, stream);
#else
    constexpr size_t MiB = 1u << 20;
    unsigned char* na = ws + 8 * MiB;
    float* PROJb = (float*)(na);
    float* Hb = (float*)(na + 28 * MiB);
    float* CATb = (float*)(na + 36 * MiB);
    float* OAb = (float*)(na + 44 * MiB);
    float* ORRb = (float*)(na + 48 * MiB);
    float* KMEANb = (float*)(na + 52 * MiB);
    int* EIDXb = (int*)(na + 53 * MiB); float* EWb = (float*)(na + 53 * MiB + 65536); int* POSb = (int*)(na + 53 * MiB + 131072); int* LISTb = (int*)(na + 53 * MiB + 196608);
    int* CNTb = (int*)(na + 54 * MiB); int* BASEb = CNTb + 16;
    float* Gb = (float*)(na + 56 * MiB);
    float* Ub = (float*)(na + 78 * MiB);
    float* Yb = (float*)(na + 100 * MiB);
    const float* MODp = (const float*)(ws + mk::WS_MOD);
    unsigned short* QKV = (unsigned short*)(ws + mk::WS_QKV);
    launch_mega(a, 0, 1, 1, stream);
    for (int l = 0; l < 2; ++l) {
        const int pb = 1 + 8 * l;
        const float* xin = (l == 0) ? in.x : (const float*)out;
        if (STEP >= 1) { launch_mega(a, pb, pb + 1, 1, stream); launch_mega(a, pb + 1, pb + 2, 1, stream); }
        if (STEP >= 2) launch_mega(a, pb + 2, pb + 3, 1, stream);
        if (STEP >= 3) launch_mega(a, pb + 3, pb + 4, 1, stream);
        if (STEP < 3) {
            for (int b = 0; b < BATCH; ++b) {
                const float* mod = MODp + ((size_t)l * BATCH + b) * 6 * D;
                const float* xb = xin + (size_t)b * SEQ * D; float* ob = out + (size_t)b * SEQ * D;
                if (STEP < 1) {
                    nv::k_norm<<<SEQ, 256, 0, stream>>>(xb, in.norm_mix_g + l * D, mod + 0 * D, mod + 1 * D, Hb);
                    nv::k_gemm<<<dim3(NPROJ / 64, SEQ / 64), 256, 0, stream>>>(Hb, D, nullptr, nullptr, SEQ, in.w_in + (size_t)l * D * NPROJ, NPROJ, PROJb, NPROJ, D);
                    nv::k_rotary<<<SEQ, 256, 0, stream>>>(PROJb);
                    nv::k_kmean<<<dim3(NBLK, AH, 1), 64, 0, stream>>>(PROJb, KMEANb);
                } else {
                    ad::ad_proj<<<SEQ, 256, 0, stream>>>(QKV, (size_t)M * 512, b, PROJb);
                    ad::ad_kmean<<<dim3(NBLK, AH, 1), 64, 0, stream>>>((const float*)(ws + mk::WS_KMP), b, KMEANb);
#ifdef DBG_CHECK
                    { float* PROJn = Gb; float* KMn = (float*)(na + 52 * MiB + 262144); unsigned* flag = (unsigned*)(ws + mk::WS_CTL) + 16;
                      nv::k_norm<<<SEQ, 256, 0, stream>>>(xb, in.norm_mix_g + l * D, mod + 0 * D, mod + 1 * D, Hb);
                      nv::k_gemm<<<dim3(NPROJ / 64, SEQ / 64), 256, 0, stream>>>(Hb, D, nullptr, nullptr, SEQ, in.w_in + (size_t)l * D * NPROJ, NPROJ, PROJn, NPROJ, D);
                      nv::k_rotary<<<SEQ, 256, 0, stream>>>(PROJn);
                      nv::k_kmean<<<dim3(NBLK, AH, 1), 64, 0, stream>>>(PROJn, KMn);
                      ad::dbg_cmp<<<1024, 256, 0, stream>>>(PROJb, PROJn, (size_t)SEQ * NPROJ, DBG_REL, DBG_ABS, flag, NPROJ, 0, 3072, 0);
                      ad::dbg_cmp<<<1024, 256, 0, stream>>>(PROJb, PROJn, (size_t)SEQ * NPROJ, DBG_REL, DBG_ABS, flag, NPROJ, 3072, 3584, 1);
                      ad::dbg_cmp<<<16, 256, 0, stream>>>(KMEANb, KMn, (size_t)8 * 8 * 64, 0.03f, 0.004f, flag + 1);
                      if (l == DBG_L && b == 0) ad::dbg_ssd<<<1024, 256, 0, stream>>>(PROJb, PROJn, (size_t)SEQ * NPROJ, NPROJ, DBG_CLO, DBG_CHI, (float*)(flag + 2)); }
#endif
                }
                if (STEP < 2) {
                    nv::k_moba<<<dim3(NBLK, AH, 1), 256, 0, stream>>>(PROJb, KMEANb, OAb);
                    nv::k_ret<<<dim3(SEQ / 256, RH * 4, 1), 256, 0, stream>>>(PROJb, ORRb);
                    nv::k_cat<<<SEQ, 256, 0, stream>>>(OAb, ORRb, PROJb, in.att_g + l * AW, in.ret_g + l * RW, CATb, STEP >= 1 ? 1 : 0);
                } else {
                    ad::ad_cat<<<SEQ, 256, 0, stream>>>((const unsigned short*)(ws + mk::WS_CAT), (const float*)(ws + mk::WS_ASSQ), in.att_g + l * AW, b, CATb);
                }
                nv::k_gemm<<<dim3(D / 64, SEQ / 64), 256, 0, stream>>>(CATb, D, nullptr, nullptr, SEQ, in.w_out + (size_t)l * D * D, D, Hb, D, D);
                nv::k_resid<<<SEQ, 256, 0, stream>>>(xb, mod + 2 * D, Hb, ob);
            }
        }
        const bool ffn_mega = (l == 0) ? (STEP >= 4) : (STEP >= 5);
        if (ffn_mega) {
            launch_mega(a, pb + 4, pb + 5, 1, stream);
            if (l == 1) launch_mega(a, pb + 5, pb + 6, 1, stream);
            launch_mega(a, pb + 6, pb + 7, 1, stream);
            launch_mega(a, pb + 7, pb + 8, 1, stream);
        } else {
            for (int b = 0; b < BATCH; ++b) {
                const float* mod = MODp + ((size_t)l * BATCH + b) * 6 * D;
                float* ob = out + (size_t)b * SEQ * D;
                nv::k_norm<<<SEQ, 256, 0, stream>>>(ob, in.norm_ffn_g + l * D, mod + 3 * D, mod + 4 * D, Hb);
                if (l == 0) {
                    nv::k_gemm<<<dim3(FF / 64, SEQ / 64), 256, 0, stream>>>(Hb, D, nullptr, nullptr, SEQ, in.fw_gate, FF, Gb, FF, D);
                    nv::k_gemm<<<dim3(FF / 64, SEQ / 64), 256, 0, stream>>>(Hb, D, nullptr, nullptr, SEQ, in.fw_up, FF, Ub, FF, D);
                    nv::k_silu_mul<<<SEQ, 256, 0, stream>>>(Gb, Ub, nullptr, SEQ, FF);
                    nv::k_gemm<<<dim3(D / 64, SEQ / 64), 256, 0, stream>>>(Gb, FF, nullptr, nullptr, SEQ, in.fw_down, D, Ub, D, FF);
                    nv::k_resid<<<SEQ, 256, 0, stream>>>(ob, mod + 5 * D, Ub, ob);
                } else {
                    nv::k_router<<<SEQ / 4, 256, 0, stream>>>(Hb, in.router_w, EIDXb, EWb);
                    nv::k_place<<<1, 1024, 0, stream>>>(EIDXb, LISTb, POSb, CNTb, BASEb, 4);
                    float* GE = Gb; float* UE = Ub;
                    for (int e = 0; e < NE; ++e) {
                        nv::k_gemm<<<dim3(FF / 64, ECAP / 64), 256, 0, stream>>>(Hb, D, LISTb, CNTb + e, ECAP, in.mw_gate + (size_t)e * D * FF, FF, GE, FF, D, BASEb + e, nullptr);
                        nv::k_gemm<<<dim3(FF / 64, ECAP / 64), 256, 0, stream>>>(Hb, D, LISTb, CNTb + e, ECAP, in.mw_up + (size_t)e * D * FF, FF, UE, FF, D, BASEb + e, nullptr);
                        nv::k_silu_mul<<<ECAP, 256, 0, stream>>>(GE, UE, CNTb + e, ECAP, FF);
                        nv::k_gemm<<<dim3(D / 64, ECAP / 64), 256, 0, stream>>>(GE, FF, nullptr, CNTb + e, ECAP, in.mw_down + (size_t)e * FF * D, D, Yb, D, FF, nullptr, BASEb + e);
                    }
                    nv::k_moe_combine<<<SEQ, 256, 0, stream>>>(ob, mod + 5 * D, Yb, POSb, EWb);
                }
            }
        }
    }
    if (STEP >= 5) launch_mega(a, 17, 18, 1, stream);
    else nv::k_norm<<<M, 256, 0, stream>>>(out, in.final_g, nullptr, nullptr, out);
#ifdef DBG_CHECK
#ifdef DBG_ENC
    ad::dbg_encode<<<1, 256, 0, stream>>>((const float*)((unsigned*)(ws + mk::WS_CTL) + 18), (float)SEQ * (DBG_CHI - DBG_CLO), out);
#endif
    ad::dbg_poison<<<1, 256, 0, stream>>>((unsigned*)(ws + mk::WS_CTL) + 16, DBG_T0, out, 100.0f);
    ad::dbg_poison<<<1, 256, 0, stream>>>((unsigned*)(ws + mk::WS_CTL) + 17, DBG_T1, out + (1 << 20), 300.0f);
#endif
#endif
}
```

```cpp
#include <hip/hip_runtime.h>
#include <cstdio>
#include <cstdint>
#include <cmath>

namespace h16 {
typedef _Float16 f16x2_t __attribute__((ext_vector_type(2)));
typedef _Float16 f16x8_t __attribute__((ext_vector_type(8)));
typedef float f32x2_t __attribute__((ext_vector_type(2)));
__device__ __forceinline__ unsigned pk(float lo, float hi) { f32x2_t v = {lo, hi}; f16x2_t b = __builtin_convertvector(v, f16x2_t); return __builtin_bit_cast(unsigned, b); }
__device__ __forceinline__ float lo(unsigned u) { return (float)__builtin_bit_cast(f16x2_t, u)[0]; }
__device__ __forceinline__ float hi(unsigned u) { return (float)__builtin_bit_cast(f16x2_t, u)[1]; }
__device__ __forceinline__ float one(unsigned short s) { return (float)__builtin_bit_cast(_Float16, s); }
}

namespace xl {
template <int O> __device__ __forceinline__ int xor_i(int v) {
    if constexpr (O < 32) return __builtin_amdgcn_ds_swizzle(v, (O << 10) | 0x1f);
    else { static_assert(O < 32, "use add32 / max32 for the 32-lane exchange"); return v; }
}
template <int O> __device__ __forceinline__ float xor_f(float v) { return __builtin_bit_cast(float, xor_i<O>(__builtin_bit_cast(int, v))); }
__device__ __forceinline__ void swap32(unsigned a, unsigned& r0, unsigned& r1) { unsigned b = a; asm volatile("" : "+v"(b)); auto r = __builtin_amdgcn_permlane32_swap(a, b, false, false); r0 = r[0]; r1 = r[1]; }
__device__ __forceinline__ float xor32p(float v, bool upper) { unsigned r0, r1; swap32(__builtin_bit_cast(unsigned, v), r0, r1); return __builtin_bit_cast(float, upper ? r0 : r1); }
__device__ __forceinline__ float add32(float v) { unsigned r0, r1; swap32(__builtin_bit_cast(unsigned, v), r0, r1); return __builtin_bit_cast(float, r0) + __builtin_bit_cast(float, r1); }
__device__ __forceinline__ float max32(float v) { unsigned r0, r1; swap32(__builtin_bit_cast(unsigned, v), r0, r1); return fmaxf(__builtin_bit_cast(float, r0), __builtin_bit_cast(float, r1)); }
__device__ __forceinline__ int add32i(int v) { unsigned r0, r1; swap32((unsigned)v, r0, r1); return (int)(r0 + r1); }
__device__ __forceinline__ float wave_sum(float v) { v += xor_f<1>(v); v += xor_f<2>(v); v += xor_f<4>(v); v += xor_f<8>(v); v += xor_f<16>(v); return add32(v); }
__device__ __forceinline__ int wave_sum_i(int v) { v += xor_i<1>(v); v += xor_i<2>(v); v += xor_i<4>(v); v += xor_i<8>(v); v += xor_i<16>(v); return add32i(v); }
}

__device__ __forceinline__ int olane() { int l; asm volatile("v_mbcnt_lo_u32_b32 %0, -1, 0\n\tv_mbcnt_hi_u32_b32 %0, -1, %0" : "=v"(l)); return l; }
__device__ __forceinline__ int otid(int wv) { return (wv << 6) | olane(); }
#define STEP 6

constexpr int D = 1024, BATCH = 8, SEQ = 2048, M = BATCH * SEQ;
constexpr int AH = 8, AD = 64, AW = 512, MBLK = 256, NBLK = SEQ / MBLK, TOPK = 3;
constexpr int RH = 4, RD = 128, RW = 512;
constexpr int NPROJ = 3 * AW + 4 * RW;
constexpr int FF = 2816, NE = 8;
constexpr float EPS = 1e-6f;
constexpr int ECAP = 2048;
namespace pg8 {
#define PG8_LAS __attribute__((address_space(3)))
typedef unsigned short bf16_t;
typedef short bf16x8 __attribute__((ext_vector_type(8)));
typedef float f32x4 __attribute__((ext_vector_type(4)));
typedef float f32x2 __attribute__((ext_vector_type(2)));
typedef unsigned u32x4 __attribute__((ext_vector_type(4)));
typedef unsigned u32x2 __attribute__((ext_vector_type(2)));
typedef int i32x4 __attribute__((ext_vector_type(4)));
constexpr int BM = 256, BK = 64, HALF = 128, HTB = HALF * BK * 2  , STAGE_BYTES = 8 * HTB, NXCD = 8, WGM = 8;

__host__ __device__ __forceinline__ int lds_byte(int r, int c) { const int st = (r >> 4) * 2 + (c >> 5), rr = r & 15, cc = c & 31, ob = rr * 64 + cc * 2; return st * 1024 + (ob ^ (((ob >> 9) & 1) << 5)); }
__host__ __device__ __forceinline__ void stage_rc(int b, int& R, int& C) { const int st = b / 1024, sb = b % 1024, swz = sb ^ (((sb >> 9) & 1) << 5); R = (st >> 1) * 16 + swz / 64; C = (st & 1) * 32 + (swz % 64) / 2; }
__host__ __device__ __forceinline__ int perm32(int rho) { const int n = rho >> 4, i = rho & 15; return 8 * (i >> 2) + 4 * n + (i & 3); }

struct Unit { int pm, pn, e, kc, li; };
struct Gemm { int lda, ldb, K; };

struct DenseSched {
    const char* A; const char* Bt; size_t a_tile, b_tile;
    int nM, nN, nwg, G, c;
    __device__ __forceinline__ void init(const void* A_, int lda, const void* Bt_, int ldb, int M, int N, int G_, int c_) {
        A = (const char*)A_; Bt = (const char*)Bt_; a_tile = (size_t)BM * lda * 2; b_tile = (size_t)BM * ldb * 2; nM = M / BM; nN = N / BM; nwg = nM * nN; G = G_; c = c_; }
    __device__ __forceinline__ bool next(int i, Unit& u) const {
        const long L = (long)i * G + c; if (L >= nwg) return false;
        int wgid = (int)L; { const int q = nwg / NXCD, r = nwg % NXCD, xcd = wgid % NXCD, off = wgid / NXCD; wgid = (xcd < r ? xcd * (q + 1) : r * (q + 1) + (xcd - r) * q) + off; }
        const int nig = WGM * nN, gid = wgid / nig, fm = gid * WGM, gsz = (nM - fm) < WGM ? (nM - fm) : WGM;
        u.pm = fm + ((wgid % nig) % gsz); u.pn = (wgid % nig) / gsz; u.e = 0; u.kc = 0; u.li = 0; return true;
    }
    __device__ __forceinline__ const char* a_ptr(const Unit& u) const { return A + (size_t)u.pm * a_tile; }
    __device__ __forceinline__ const char* b_ptr(const Unit& u) const { return Bt + (size_t)u.pn * b_tile; }
};
struct MoeSched {
    const char* A; const char* Bt; size_t a_tile, b_tile, e_stride;
    int nM, nN, nwg, G, c; int seg[8]; int first, lim, KS, kbytes;
    __device__ __forceinline__ void init(const void* A_, int lda, const void* Bt_, int ldb, size_t e_stride_bytes, const int* segp_, int N, int G_, int c_) {
        A = (const char*)A_; Bt = (const char*)Bt_; a_tile = (size_t)BM * lda * 2; b_tile = (size_t)BM * ldb * 2; e_stride = e_stride_bytes;
#pragma unroll
        for (int e = 0; e < 8; ++e) seg[e] = __builtin_amdgcn_readfirstlane(segp_[e]);
        nM = __builtin_amdgcn_readfirstlane(segp_[8]) / BM; nN = N / BM; nwg = nM * nN; G = G_; c = c_; first = 0; lim = nwg; KS = 1; kbytes = 0; }
    __device__ __forceinline__ bool next(int i, Unit& u) const {
        const long idx = (long)i * G + c; const long L = first + idx / KS; if (L >= lim) return false;
        u.kc = (int)(idx % KS); u.li = (int)(idx / KS);
        int wgid = (int)L; { const int q = nwg / NXCD, r = nwg % NXCD, xcd = wgid % NXCD, off = wgid / NXCD; wgid = (xcd < r ? xcd * (q + 1) : r * (q + 1) + (xcd - r) * q) + off; }
        const int nig = WGM * nN, gid = wgid / nig, fm = gid * WGM, gsz = (nM - fm) < WGM ? (nM - fm) : WGM;
        u.pm = fm + ((wgid % nig) % gsz); u.pn = (wgid % nig) / gsz;
        int e = 0; const int r0 = u.pm * BM;
#pragma unroll
        for (int k = 1; k < 8; ++k) e = (r0 >= seg[k]) ? k : e;
        u.e = __builtin_amdgcn_readfirstlane(e); return true;
    }
    __device__ __forceinline__ const char* a_ptr(const Unit& u) const { return A + (size_t)u.pm * a_tile + (size_t)u.kc * kbytes; }
    __device__ __forceinline__ const char* b_ptr(const Unit& u) const { return Bt + (size_t)u.e * e_stride + (size_t)u.pn * b_tile + (size_t)u.kc * kbytes; }
};

__device__ __forceinline__ unsigned cvt_pk_bf16(float lo, float hi) { return h16::pk(lo, hi); }
__device__ __forceinline__ float fast_silu(float g) { return g * __builtin_amdgcn_rcpf(1.0f + __builtin_amdgcn_exp2f(-1.4426950408889634f * g)); }

typedef f32x4 Acc[2][2][4][2];
typedef int i32x8 __attribute__((ext_vector_type(8)));
template <bool F8> struct Frags;
template <> struct Frags<false> { bf16x8 At[4][2], B0[2][2], B1[2][2]; };
template <> struct Frags<true> { i32x8 At[4], B0[2], B1[2]; };

template <class Epi, class Sched>
__device__ __forceinline__ void gemm_phase(const int wv, PG8_LAS unsigned char* lds, const Gemm g, const Sched& S, const Epi& E) {
    int tid_ = otid(wv);
    const int tid = tid_, wid = __builtin_amdgcn_readfirstlane(tid >> 6), lane = tid & 63, wr = wid >> 2, wc = wid & 3, fr = lane & 15, fq = lane >> 4;
    const int K = g.K; int nt = K / BK; asm volatile("" : "+s"(nt));
    unsigned voffA[2], voffB[2];
#pragma unroll
    for (int i = 0; i < 2; ++i) { int R, C; stage_rc(tid * 16 + i * 8192, R, C); const int Rb = Epi::PERM ? ((R & ~31) + perm32(R & 31)) : R;
        voffA[i] = (unsigned)(R * g.lda + C) * 2u; voffB[i] = (unsigned)(Rb * g.ldb + C) * 2u; }
    const size_t kstep = (size_t)(BK * 2);
    const size_t hstepA = (size_t)HALF * g.lda * 2, hstepB = (size_t)HALF * g.ldb * 2;
    const unsigned ldsw = (unsigned)wid * 1024u;
    const unsigned ldsbase_ = (unsigned)__builtin_amdgcn_readfirstlane((int)((unsigned)(unsigned long)lds + ldsw));
    const int aoff = lds_byte(wr * 64 + fr, fq * 8), boff = lds_byte(wc * 32 + fr, fq * 8);
#define PG8_SA(b, h) (((b) * 2 + (h)) * HTB)
#define PG8_SB(b, h) ((4 + (b) * 2 + (h)) * HTB)
#define PG8_STAGE(bufoff, gbase, voff) do { if constexpr (Epi::FP8) {   \
            const unsigned long long gb_ = (unsigned long long)(gbase); \
            const unsigned long long sb_ = ((unsigned long long)(unsigned)__builtin_amdgcn_readfirstlane((int)(gb_ >> 32)) << 32) | (unsigned)__builtin_amdgcn_readfirstlane((int)gb_); \
            _Pragma("unroll") for (int _i = 0; _i < 2; ++_i) { unsigned keep_; \
                asm volatile("s_mov_b32 %0, m0\n\ts_mov_b32 m0, %3\n\ts_nop 0\n\tglobal_load_lds_dwordx4 %1, %2\n\ts_mov_b32 m0, %0" : "=&s"(keep_) : "v"((voff)[_i]), "s"(sb_), "s"(ldsbase_ + (unsigned)((bufoff) + _i * 8192)) : "memory"); } \
        } else { _Pragma("unroll") for (int _i = 0; _i < 2; ++_i) \
        __builtin_amdgcn_global_load_lds((const unsigned*)((const char*)(gbase) + (voff)[_i]), (PG8_LAS unsigned*)(lds + (bufoff) + ldsw + _i * 8192), 16, 0, 0); } } while (0)
#define PG8_LDA(dst, b, h) do { if constexpr (Epi::FP8) { _Pragma("unroll") for (int m = 0; m < 4; ++m) { const i32x4 lo_ = *(const PG8_LAS i32x4*)(lds + PG8_SA(b, h) + aoff + m * 2048), hi_ = *(const PG8_LAS i32x4*)(lds + PG8_SA(b, h) + aoff + m * 2048 + 1024); F.dst[m] = __builtin_shufflevector(lo_, hi_, 0, 1, 2, 3, 4, 5, 6, 7); } } \
        else { _Pragma("unroll") for (int m = 0; m < 4; ++m) _Pragma("unroll") for (int k = 0; k < 2; ++k) F.dst[m][k] = *(const PG8_LAS bf16x8*)(lds + PG8_SA(b, h) + aoff + m * 2048 + k * 1024); } } while (0)
#define PG8_LDB(dst, b, h) do { if constexpr (Epi::FP8) { _Pragma("unroll") for (int n = 0; n < 2; ++n) { const i32x4 lo_ = *(const PG8_LAS i32x4*)(lds + PG8_SB(b, h) + boff + n * 2048), hi_ = *(const PG8_LAS i32x4*)(lds + PG8_SB(b, h) + boff + n * 2048 + 1024); F.dst[n] = __builtin_shufflevector(lo_, hi_, 0, 1, 2, 3, 4, 5, 6, 7); } } \
        else { _Pragma("unroll") for (int n = 0; n < 2; ++n) _Pragma("unroll") for (int k = 0; k < 2; ++k) F.dst[n][k] = *(const PG8_LAS bf16x8*)(lds + PG8_SB(b, h) + boff + n * 2048 + k * 1024); } } while (0)
#define PG8_MMA(ai, bj, At, Bt) do { __builtin_amdgcn_s_setprio(1); \
        if constexpr (Epi::FP8) {   \
            _Pragma("unroll") for (int m = 0; m < 4; ++m) _Pragma("unroll") for (int n = 0; n < 2; ++n) \
                acc[ai][bj][m][n] = __builtin_amdgcn_mfma_scale_f32_16x16x128_f8f6f4(F.Bt[n], F.At[m], acc[ai][bj][m][n], 0, 0, 0, Epi::SCALE_W, 0, 0x7f7f7f7f); \
        } else { _Pragma("unroll") for (int m = 0; m < 4; ++m) _Pragma("unroll") for (int n = 0; n < 2; ++n) _Pragma("unroll") for (int k = 0; k < 2; ++k) \
            acc[ai][bj][m][n] = __builtin_amdgcn_mfma_f32_16x16x32_f16(__builtin_bit_cast(h16::f16x8_t, F.Bt[n][k]), __builtin_bit_cast(h16::f16x8_t, F.At[m][k]), acc[ai][bj][m][n], 0, 0, 0); } \
        __builtin_amdgcn_s_setprio(0); } while (0)
#define PG8_WAIT_V(n) asm volatile("s_waitcnt vmcnt(" #n ")" ::: "memory")
#define PG8_WAIT_L(n) asm volatile("s_waitcnt lgkmcnt(" #n ")" ::: "memory")
#define PG8_BAR __builtin_amdgcn_s_barrier()
#define PG8_SCHED __builtin_amdgcn_sched_barrier(0)
    Unit cur, nxt; int ui = 0;
    if (!S.next(0, cur)) return;
    Acc acc;
#pragma unroll
    for (int a = 0; a < 2; ++a)
#pragma unroll
        for (int b = 0; b < 2; ++b)
#pragma unroll
            for (int m = 0; m < 4; ++m)
#pragma unroll
                for (int n = 0; n < 2; ++n) acc[a][b][m][n] = (f32x4){0.f, 0.f, 0.f, 0.f};
    const char* cA = S.a_ptr(cur); const char* cB = S.b_ptr(cur);
    if constexpr (Epi::MID_T > 0) E.pre(cur, lds, tid);
    PG8_STAGE(PG8_SB(0, 0), cB, voffB); PG8_STAGE(PG8_SB(0, 1), cB + hstepB, voffB); PG8_STAGE(PG8_SA(0, 0), cA, voffA); PG8_STAGE(PG8_SA(0, 1), cA + hstepA, voffA);
    if (wr == 1) PG8_BAR;
    PG8_WAIT_V(2); PG8_BAR;
    PG8_STAGE(PG8_SB(1, 0), cB + kstep, voffB); PG8_STAGE(PG8_SA(1, 0), cA + kstep, voffA); PG8_STAGE(PG8_SB(1, 1), cB + hstepB + kstep, voffB);
    PG8_WAIT_V(6); PG8_BAR;
    for (;;) {
        const bool has_next = S.next(ui + 1, nxt);
        const char* nA = has_next ? S.a_ptr(nxt) : cA; const char* nB = has_next ? S.b_ptr(nxt) : cB;
        for (int t = 0; t < nt; t += 2) {
            if constexpr (Epi::MID_T > 0) { if (t == Epi::MID_T) E.mid(acc, lds, wr, fr); }
            const bool last = (t == nt - 2);
            Frags<Epi::FP8> F;
            const char* a1 = cA + (size_t)(t + 1) * kstep;
            const char* a2 = last ? nA : cA + (size_t)(t + 2) * kstep; const char* b2 = last ? nB : cB + (size_t)(t + 2) * kstep;
            const char* a3 = a2 + kstep; const char* b3 = b2 + kstep;
            PG8_LDB(B0, 0, 0); PG8_LDB(B1, 0, 1); PG8_SCHED; PG8_LDA(At, 0, 0); PG8_STAGE(PG8_SA(1, 1), a1 + hstepA, voffA);
            PG8_WAIT_V(8); PG8_WAIT_L(0); PG8_BAR; PG8_MMA(0, 0, At, B0); PG8_MMA(0, 1, At, B1); PG8_BAR; PG8_SCHED;
            PG8_LDA(At, 0, 1); PG8_STAGE(PG8_SB(0, 0), b2, voffB); PG8_STAGE(PG8_SB(0, 1), b2 + hstepB, voffB); PG8_STAGE(PG8_SA(0, 0), a2, voffA);
            PG8_WAIT_V(8); PG8_WAIT_L(0); PG8_BAR; PG8_MMA(1, 0, At, B0); PG8_MMA(1, 1, At, B1); PG8_BAR; PG8_SCHED;
            PG8_LDB(B0, 1, 0); PG8_LDB(B1, 1, 1); PG8_SCHED; PG8_LDA(At, 1, 0); PG8_STAGE(PG8_SA(0, 1), a2 + hstepA, voffA);
            PG8_WAIT_V(8); PG8_WAIT_L(0); PG8_BAR; PG8_MMA(0, 0, At, B0); PG8_MMA(0, 1, At, B1); PG8_BAR; PG8_SCHED;
            PG8_LDA(At, 1, 1); PG8_STAGE(PG8_SB(1, 0), b3, voffB); PG8_STAGE(PG8_SB(1, 1), b3 + hstepB, voffB); PG8_STAGE(PG8_SA(1, 0), a3, voffA);
            PG8_WAIT_V(8); PG8_WAIT_L(0); PG8_BAR; PG8_MMA(1, 0, At, B0); PG8_MMA(1, 1, At, B1); PG8_BAR; PG8_SCHED;
        }
        if (wr == 0) PG8_BAR;
        { const int t2_ = olane(); E(acc, cur, wr, wc, t2_ & 15, t2_ >> 4); }
        if (!has_next) break;
#pragma unroll
        for (int a = 0; a < 2; ++a)
#pragma unroll
            for (int b = 0; b < 2; ++b)
#pragma unroll
                for (int m = 0; m < 4; ++m)
#pragma unroll
                    for (int n = 0; n < 2; ++n) acc[a][b][m][n] = (f32x4){0.f, 0.f, 0.f, 0.f};
        cur = nxt; cA = nA; cB = nB; ++ui;
        if (wr == 1) PG8_BAR;
    }
    PG8_WAIT_V(0);
    PG8_BAR;
#undef PG8_SA
#undef PG8_SB
#undef PG8_STAGE
#undef PG8_LDA
#undef PG8_LDB
#undef PG8_MMA
#undef PG8_WAIT_V
#undef PG8_WAIT_L
#undef PG8_BAR
#undef PG8_SCHED
}
}
namespace epi {
#define PG8_LAS __attribute__((address_space(3)))
using pg8::Acc; using pg8::Unit; using pg8::f32x4; using pg8::u32x4; using pg8::bf16_t; using pg8::cvt_pk_bf16; using pg8::fast_silu;
constexpr int HALF = 128;
constexpr float C2 = 0.125f * 1.4426950408889634f;
constexpr float KSC = 0.08838834764831845f;

__device__ __forceinline__ u32x4 pack8(const f32x4 v0, const f32x4 v1) { u32x4 w; w.x = cvt_pk_bf16(v0[0], v0[1]); w.y = cvt_pk_bf16(v0[2], v0[3]); w.z = cvt_pk_bf16(v1[0], v1[1]); w.w = cvt_pk_bf16(v1[2], v1[3]); return w; }

struct EpiInProj {
    static constexpr bool PERM = true; static constexpr int MID_T = 0; static constexpr bool FP8 = false; static constexpr int SCALE_W = 0;
    bf16_t* O; size_t gstride;
    float* KMP;
    const float* ROPE;
    __device__ __forceinline__ void operator()(const Acc& acc, const Unit& u, int wr, int wc, int fr, int fq) const {
        const int grp = u.pn >> 1;
        const int col0 = (u.pn & 1) * 256 + wc * 32 + 8 * fq;
        const int row0 = u.pm * 256 + wr * 64 + fr;
        bf16_t* base = O + (size_t)grp * gstride;
        f32x4 cs[2][2];
#pragma unroll
        for (int bj = 0; bj < 2; ++bj) { cs[bj][0] = (f32x4){0.f, 0.f, 0.f, 0.f}; cs[bj][1] = (f32x4){0.f, 0.f, 0.f, 0.f}; }
#pragma unroll
        for (int ai = 0; ai < 2; ++ai)
#pragma unroll
            for (int m = 0; m < 4; ++m) {
                const int row = row0 + ai * HALF + m * 16;
                bf16_t* rowp = base + (size_t)row * 512 + col0;
                f32x4 t0 = (f32x4){0.f, 0.f, 0.f, 0.f}, t1 = t0;
                if (grp == 3 || grp == 4) { const float* tp = ROPE + ((size_t)(row & 2047) * 64 + 16 * wc + 4 * fq) * 2; t0 = *(const f32x4*)tp; t1 = *(const f32x4*)(tp + 4); }
#pragma unroll
                for (int bj = 0; bj < 2; ++bj) {
                    f32x4 v0 = acc[ai][bj][m][0], v1 = acc[ai][bj][m][1];
                    if (grp == 0) { v0 = v0 * C2; v1 = v1 * C2; }
                    else if (grp == 1) { cs[bj][0] += v0; cs[bj][1] += v1; }
                    else if (grp == 3 || grp == 4) {
                        const float sc = (grp == 4) ? KSC : 1.0f;
                        f32x4 r0, r1;
                        r0[0] = (v0[0] * t0[0] - v0[1] * t0[1]) * sc; r0[1] = (v0[0] * t0[1] + v0[1] * t0[0]) * sc;
                        r0[2] = (v0[2] * t0[2] - v0[3] * t0[3]) * sc; r0[3] = (v0[2] * t0[3] + v0[3] * t0[2]) * sc;
                        r1[0] = (v1[0] * t1[0] - v1[1] * t1[1]) * sc; r1[1] = (v1[0] * t1[1] + v1[1] * t1[0]) * sc;
                        r1[2] = (v1[2] * t1[2] - v1[3] * t1[3]) * sc; r1[3] = (v1[2] * t1[3] + v1[3] * t1[2]) * sc;
                        v0 = r0; v1 = r1;
                    } else if (grp == 6) {
#pragma unroll
                        for (int j = 0; j < 4; ++j) { v0[j] = fast_silu(v0[j]); v1[j] = fast_silu(v1[j]); }
                    }
                    *(u32x4*)(rowp + bj * HALF) = pack8(v0, v1);
                }
            }
        if (grp == 1) {
#pragma unroll
            for (int bj = 0; bj < 2; ++bj)
#pragma unroll
                for (int n = 0; n < 2; ++n) {
                    f32x4 s = cs[bj][n];
#pragma unroll
                    for (int c4 = 0; c4 < 4; ++c4) { float t = s[c4]; t += xl::xor_f<1>(t); t += xl::xor_f<2>(t); t += xl::xor_f<4>(t); t += xl::xor_f<8>(t); s[c4] = t; }
                    if (fr == 0) *(f32x4*)(KMP + (size_t)(u.pm * 2 + wr) * 512 + col0 + bj * HALF + 4 * n) = s;
                }
        }
    }
};

struct EpiOutProj {
    static constexpr bool PERM = false; static constexpr int MID_T = 8; static constexpr bool FP8 = false; static constexpr int SCALE_W = 0;
    const float* xin; float* out; const float* g1;
    const float* assq;
    bool dry;
    static constexpr int RS_OFF = 131072 + 8192;
    __device__ __forceinline__ void pre(const Unit& u, PG8_LAS unsigned char* lds, int tid) const {
        if (tid < 256) { const int row = u.pm * 256 + tid;
            const f32x4 a = *(const f32x4*)(assq + (size_t)row * 8), c = *(const f32x4*)(assq + (size_t)row * 8 + 4);
            const float ss = ((a[0] + a[1]) + (a[2] + a[3])) + ((c[0] + c[1]) + (c[2] + c[3]));
            ((PG8_LAS float*)(lds + RS_OFF))[tid] = 1.0f / sqrtf(ss * (1.0f / 512.0f) + 1e-6f); }
    }
    __device__ __forceinline__ void mid(Acc& acc, PG8_LAS unsigned char* lds, int wr, int fr) const {
        const PG8_LAS float* tab = (const PG8_LAS float*)(lds + RS_OFF) + wr * 64 + fr;
#pragma unroll
        for (int ai = 0; ai < 2; ++ai)
#pragma unroll
            for (int m = 0; m < 4; ++m) {
                const float rs = tab[ai * HALF + m * 16];
#pragma unroll
                for (int bj = 0; bj < 2; ++bj)
#pragma unroll
                    for (int n = 0; n < 2; ++n) acc[ai][bj][m][n] = acc[ai][bj][m][n] * rs;
            }
    }
    __device__ __forceinline__ void operator()(const Acc& acc, const Unit& u, int wr, int wc, int fr, int fq) const {
        const int b = u.pm >> 3;
        const int col0 = u.pn * 256 + wc * 32 + 4 * fq;
        const int row0 = u.pm * 256 + wr * 64 + fr;
        f32x4 gv[2][2];
#pragma unroll
        for (int bj = 0; bj < 2; ++bj)
#pragma unroll
            for (int n = 0; n < 2; ++n) gv[bj][n] = *(const f32x4*)(g1 + (size_t)b * 6144 + col0 + bj * HALF + n * 16);
#pragma unroll
        for (int ai = 0; ai < 2; ++ai)
#pragma unroll
            for (int m = 0; m < 4; ++m) {
                const size_t off = (size_t)(row0 + ai * HALF + m * 16) * 1024 + col0;
#pragma unroll
                for (int bj = 0; bj < 2; ++bj)
#pragma unroll
                    for (int n = 0; n < 2; ++n) { const f32x4 bs = *(const f32x4*)(xin + off + bj * HALF + n * 16); const f32x4 r = bs + gv[bj][n] * acc[ai][bj][m][n]; if (!dry) *(f32x4*)(out + off + bj * HALF + n * 16) = r; else asm volatile("" :: "v"(r)); }
            }
    }
};

struct EpiSwiGLU {
    static constexpr bool PERM = true; static constexpr int MID_T = 0; static constexpr bool FP8 = false; static constexpr int SCALE_W = 0;
    bf16_t* H; int ldh;
    __device__ __forceinline__ void operator()(const Acc& acc, const Unit& u, int wr, int wc, int fr, int fq) const {
        const int col0 = u.pn * 128 + wc * 32 + 8 * fq;
        const int row0 = u.pm * 256 + wr * 64 + fr;
#pragma unroll
        for (int ai = 0; ai < 2; ++ai)
#pragma unroll
            for (int m = 0; m < 4; ++m) {
                const int row = row0 + ai * HALF + m * 16;
                f32x4 v0, v1;
#pragma unroll
                for (int j = 0; j < 4; ++j) { v0[j] = fast_silu(acc[ai][0][m][0][j]) * acc[ai][1][m][0][j]; v1[j] = fast_silu(acc[ai][0][m][1][j]) * acc[ai][1][m][1][j]; }
                *(u32x4*)(H + (size_t)row * ldh + col0) = pack8(v0, v1);
            }
    }
};

struct EpiDown {
    static constexpr bool PERM = false; static constexpr int MID_T = 0; static constexpr bool FP8 = false; static constexpr int SCALE_W = 0;
    float* out; const float* g2; bf16_t* YS; const int* srow; const float* swt; bool moe; bool dry; int* atomf; bool atomic; float* slab; int KS;
    __device__ __forceinline__ void operator()(const Acc& acc, const Unit& u, int wr, int wc, int fr, int fq) const {
        const int col0 = u.pn * 256 + wc * 32 + 4 * fq;
        const int row0 = u.pm * 256 + wr * 64 + fr;
        if (!moe) {
            const int b = u.pm >> 3;
            f32x4 gv[2][2];
#pragma unroll
            for (int bj = 0; bj < 2; ++bj)
#pragma unroll
                for (int n = 0; n < 2; ++n) gv[bj][n] = *(const f32x4*)(g2 + (size_t)b * 6144 + col0 + bj * HALF + n * 16);
#pragma unroll
            for (int ai = 0; ai < 2; ++ai)
#pragma unroll
                for (int m = 0; m < 4; ++m) {
                    const size_t off = (size_t)(row0 + ai * HALF + m * 16) * 1024 + col0;
#pragma unroll
                    for (int bj = 0; bj < 2; ++bj)
#pragma unroll
                        for (int n = 0; n < 2; ++n) { const f32x4 bs = *(const f32x4*)(out + off + bj * HALF + n * 16); const f32x4 r = bs + gv[bj][n] * acc[ai][bj][m][n]; if (!dry) *(f32x4*)(out + off + bj * HALF + n * 16) = r; else asm volatile("" :: "v"(r)); }
                }
        } else if (atomic) {
            float* sl = slab + ((size_t)(u.li * KS + u.kc) * 256) * 256 + (wc * 32 + 4 * fq);
#pragma unroll
            for (int ai = 0; ai < 2; ++ai)
#pragma unroll
                for (int m = 0; m < 4; ++m) {
                    const int rl = ai * HALF + wr * 64 + m * 16 + fr; const int pos = u.pm * 256 + rl;
                    const int sr = srow[pos];
                    if (sr >= 0) { const float w = swt[pos];
                        if (u.kc == 0 && wc == 0 && fq == 0) atomf[sr * 4 + u.pn] = 1 + u.li * 256 + rl;
#pragma unroll
                        for (int bj = 0; bj < 2; ++bj)
#pragma unroll
                            for (int n = 0; n < 2; ++n) *(f32x4*)(sl + (size_t)rl * 256 + bj * HALF + n * 16) = acc[ai][bj][m][n] * w; }
                }
        } else {
#pragma unroll
            for (int ai = 0; ai < 2; ++ai)
#pragma unroll
                for (int m = 0; m < 4; ++m) {
                    const int pos = row0 + ai * HALF + m * 16;
                    const int sr = srow[pos];
                    if (sr >= 0) { const float w = swt[pos]; bf16_t* rowp = YS + (size_t)sr * 1024 + col0;
#pragma unroll
                        for (int bj = 0; bj < 2; ++bj)
#pragma unroll
                            for (int n = 0; n < 2; ++n) { const f32x4 v = acc[ai][bj][m][n] * w; pg8::u32x2 o; o.x = cvt_pk_bf16(v[0], v[1]); o.y = cvt_pk_bf16(v[2], v[3]); if (!dry) *(pg8::u32x2*)(rowp + bj * HALF + n * 16) = o; else asm volatile("" :: "v"(o)); } }
                }
        }
    }
};

__device__ __forceinline__ float clamp448(float v) { return __builtin_fminf(__builtin_fmaxf(v, -448.0f), 448.0f); }
__device__ __forceinline__ unsigned pk4_fp8(float a, float b, float c, float d) {
    int p = 0; p = __builtin_amdgcn_cvt_pk_fp8_f32(clamp448(a), clamp448(b), p, false); p = __builtin_amdgcn_cvt_pk_fp8_f32(clamp448(c), clamp448(d), p, true); return (unsigned)p; }
struct EpiSwiGLU8 {
    static constexpr bool PERM = true; static constexpr int MID_T = 0; static constexpr bool FP8 = true; static constexpr int SCALE_W = 0x7a7a7a7a;
    unsigned char* H; int ldh;
    __device__ __forceinline__ void operator()(const Acc& acc, const Unit& u, int wr, int wc, int fr, int fq) const {
        const int col0 = u.pn * 128 + wc * 32 + 8 * fq;
        const int row0 = u.pm * 256 + wr * 64 + fr;
#pragma unroll
        for (int ai = 0; ai < 2; ++ai)
#pragma unroll
            for (int m = 0; m < 4; ++m) {
                const int row = row0 + ai * HALF + m * 16;
                f32x4 v0, v1;
#pragma unroll
                for (int j = 0; j < 4; ++j) { v0[j] = fast_silu(acc[ai][0][m][0][j]) * acc[ai][1][m][0][j]; v1[j] = fast_silu(acc[ai][0][m][1][j]) * acc[ai][1][m][1][j]; }
                pg8::u32x2 w; w.x = pk4_fp8(v0[0], v0[1], v0[2], v0[3]); w.y = pk4_fp8(v1[0], v1[1], v1[2], v1[3]);
                *(pg8::u32x2*)(H + (size_t)row * ldh + col0) = w;
            }
    }
};
struct EpiDownDense8 {
    static constexpr bool PERM = false; static constexpr int MID_T = 0; static constexpr bool FP8 = true; static constexpr int SCALE_W = 0x79797979;
    float* out; const float* g2; bool dry;
    __device__ __forceinline__ void operator()(const Acc& acc, const Unit& u, int wr, int wc, int fr, int fq) const {
        const int col0 = u.pn * 256 + wc * 32 + 4 * fq;
        const int row0 = u.pm * 256 + wr * 64 + fr;
        const int b = u.pm >> 3;
        f32x4 gv[2][2];
#pragma unroll
        for (int bj = 0; bj < 2; ++bj)
#pragma unroll
            for (int n = 0; n < 2; ++n) gv[bj][n] = *(const f32x4*)(g2 + (size_t)b * 6144 + col0 + bj * HALF + n * 16);
#pragma unroll
        for (int ai = 0; ai < 2; ++ai)
#pragma unroll
            for (int m = 0; m < 4; ++m) {
                const size_t off = (size_t)(row0 + ai * HALF + m * 16) * 1024 + col0;
#pragma unroll
                for (int bj = 0; bj < 2; ++bj)
#pragma unroll
                    for (int n = 0; n < 2; ++n) { const f32x4 bs = *(const f32x4*)(out + off + bj * HALF + n * 16); const f32x4 r = bs + gv[bj][n] * acc[ai][bj][m][n]; if (!dry) *(f32x4*)(out + off + bj * HALF + n * 16) = r; else asm volatile("" :: "v"(r)); }
            }
    }
};
struct EpiDownMoe8 {
    static constexpr bool PERM = false; static constexpr int MID_T = 0; static constexpr bool FP8 = true; static constexpr int SCALE_W = 0x79797979;
    bf16_t* YS; const int* srow; const float* swt;
    __device__ __forceinline__ void operator()(const Acc& acc, const Unit& u, int wr, int wc, int fr, int fq) const {
        const int col0 = u.pn * 256 + wc * 32 + 4 * fq;
        const int row0 = u.pm * 256 + wr * 64 + fr;
#pragma unroll
        for (int ai = 0; ai < 2; ++ai)
#pragma unroll
            for (int m = 0; m < 4; ++m) {
                const int pos = row0 + ai * HALF + m * 16;
                const int sr = srow[pos];
                if (sr >= 0) { const float w = swt[pos]; bf16_t* rowp = YS + (size_t)sr * 1024 + col0;
#pragma unroll
                    for (int bj = 0; bj < 2; ++bj)
#pragma unroll
                        for (int n = 0; n < 2; ++n) { const f32x4 v = acc[ai][bj][m][n] * w; pg8::u32x2 o; o.x = cvt_pk_bf16(v[0], v[1]); o.y = cvt_pk_bf16(v[2], v[3]); *(pg8::u32x2*)(rowp + bj * HALF + n * 16) = o; } }
            }
    }
};
}
namespace fa {
#define FA_LAS __attribute__((address_space(3)))
typedef unsigned short bf16_t;
typedef short bf16x8 __attribute__((ext_vector_type(8)));
typedef short s16x4 __attribute__((ext_vector_type(4)));
typedef float f32x16 __attribute__((ext_vector_type(16)));
typedef float f32x4 __attribute__((ext_vector_type(4)));
typedef unsigned u32x4 __attribute__((ext_vector_type(4)));
typedef float f32x2_t __attribute__((ext_vector_type(2))); typedef __bf16 bf16x2_t __attribute__((ext_vector_type(2)));
constexpr int L_WSF = 131072 + 1024, L_KM = L_WSF + 2048;
constexpr float NEG = -1.0e30f;
__device__ __forceinline__ int crow(int r, int hi) { return (r & 3) + 8 * (r >> 2) + 4 * hi; }
__device__ __forceinline__ void glds16(const void* gsrc, unsigned lds_dst) { unsigned keep;
    asm volatile("s_mov_b32 %0, m0\n\ts_mov_b32 m0, %2\n\ts_nop 0\n\tglobal_load_lds_dwordx4 %1, off\n\ts_mov_b32 m0, %0" : "=&s"(keep) : "v"(gsrc), "s"(lds_dst) : "memory"); }
__device__ __forceinline__ unsigned cvtpk_s(float lo, float hi) { return h16::pk(lo, hi); }
__device__ __forceinline__ float bf2f(short s) { return h16::one((unsigned short)s); }
typedef short v4i16_t __attribute__((ext_vector_type(4)));
__device__ __forceinline__ s16x4 vtr(FA_LAS const unsigned char* p) { return __builtin_bit_cast(s16x4, __builtin_amdgcn_ds_read_tr16_b64_v4i16((FA_LAS v4i16_t*)p)); }
#define FA_WAIT_BAR() asm volatile("s_waitcnt vmcnt(0) lgkmcnt(0)\n\ts_barrier" ::: "memory")
#define FA_LBAR() asm volatile("s_waitcnt lgkmcnt(0)\n\ts_barrier" ::: "memory")

struct Tensors {
    const bf16_t* Q; const bf16_t* K; const bf16_t* V;
    bf16_t* CAT;
    float* ASSQ;
    const float* KMP;
    const bf16_t* GR;
    const float* ret_g;
    const float* KVM;
};

template <bool RET>
__device__ __forceinline__ void attn_unit(const int wv, int b, int h, int qblk, const Tensors& T, FA_LAS unsigned char* shm) {
    constexpr int NS = RET ? 3 : 4, DIST = NS - 1;
    constexpr int DH = RET ? 128 : 64, ND0 = DH / 16, NDB = DH / 32, NPC = DH / 64, SLOT = 64 * DH * 2, L_K = 0, L_V = NS * SLOT, PER = 2 * NPC, L_R = 98304;
    int tid_ = otid(wv);
    const int tid = tid_, lane = tid & 63, r32 = lane & 31, hi = lane >> 5; const int wid = __builtin_amdgcn_readfirstlane(tid >> 6);
    const size_t rowbase = (size_t)b * 2048; const int q0 = qblk * 256;
    const unsigned lds0 = (unsigned)(unsigned long)shm;
    FA_LAS float* wsf = (FA_LAS float*)(shm + L_WSF) + wid * 64;
    FA_LAS float* KM = (FA_LAS float*)(shm + L_KM);
    const bf16_t* Kh = T.K + rowbase * 512 + h * DH; const bf16_t* Vh = T.V + rowbase * 512 + h * DH;
    const int NT = RET ? 4 : 4 * (qblk + 1);
#define FA_KV0(i) ((((i) < 4) ? qblk : (qblk - 1 - (((i) - 4) >> 2))) * 256 + ((i) & 3) * 64)
#define FA_DMA(i) do { const int kv0_ = FA_KV0(i); const unsigned so_ = (unsigned)(((i) % NS) * SLOT); \
        _Pragma("unroll") for (int pp = 0; pp < NPC; ++pp) { const int p = wid + 8 * pp; \
            glds16(Kh + (size_t)(kv0_ + lane) * 512 + p * 8, (unsigned)__builtin_amdgcn_readfirstlane(lds0 + L_K + so_ + p * 1024)); } \
        _Pragma("unroll") for (int pp = 0; pp < NPC; ++pp) { const int p = wid + 8 * pp; \
            glds16(Vh + (size_t)(kv0_ + 16 * (p & 3) + (lane >> 2)) * 512 + (p >> 2) * 32 + (lane & 3) * 8, (unsigned)__builtin_amdgcn_readfirstlane(lds0 + L_V + so_ + p * 1024)); } } while (0)
    FA_DMA(0); if (NT > 1) FA_DMA(1); if (DIST > 2 && NT > 2) FA_DMA(2);
    const bf16_t* Qw = T.Q + (rowbase + q0 + wid * 32 + r32) * 512 + h * DH;
    bf16x8 qr[ND0];
#pragma unroll
    for (int d0 = 0; d0 < ND0; ++d0) qr[d0] = *(const bf16x8*)(Qw + d0 * 16 + hi * 8);
    unsigned selmask = 0xffu;
    float cfac[16]; float lg2 = 0.f;
    if (!RET) {
        { const int j = tid >> 6, d = tid & 63; const float* kp = T.KMP + ((size_t)(b * 8 + j) * 2) * 512 + h * 64 + d; KM[tid] = kp[0] + kp[512]; }
        FA_LBAR();
        float g[8];
#pragma unroll
        for (int j = 0; j < 8; ++j) g[j] = 0.f;
#pragma unroll
        for (int d0 = 0; d0 < ND0; ++d0)
#pragma unroll
            for (int jj = 0; jj < 8; ++jj) { const float qv = bf2f(qr[d0][jj]); const int d = 16 * d0 + 8 * hi + jj;
#pragma unroll
                for (int j = 0; j < 8; ++j) g[j] += qv * KM[j * 64 + d]; }
#pragma unroll
        for (int j = 0; j < 8; ++j) g[j] = xl::add32(g[j]);
        selmask = 0u;
#pragma unroll
        for (int j = 0; j < 8; ++j) { int rank = 0;
#pragma unroll
            for (int mm = 0; mm < 8; ++mm) rank += (mm < qblk && (g[mm] > g[j] || (g[mm] == g[j] && mm < j))) ? 1 : 0;
            if (j < qblk && rank < 3) selmask |= 1u << j; }
    } else {
        lg2 = log2f(1.0f - exp2f(-5.0f - (float)h));
#pragma unroll
        for (int r = 0; r < 16; ++r) cfac[r] = exp2f(-lg2 * (float)((r & 3) + 8 * (r >> 2)));
    }
    f32x16 o[NDB];
#pragma unroll
    for (int db = 0; db < NDB; ++db) o[db] = f32x16{};
    float mhat = 0.f, lrow = 0.f; f32x16 negm = f32x16{}; constexpr float THR = 8.0f;
    if (RET && qblk > 0) {
        const float* kvb = T.KVM + ((size_t)(b * 4 + h) * 8) * 16384;
        const float g256 = exp2f(lg2 * 256.0f);
#pragma unroll 2
        for (int it = 0; it < 8; ++it) { const int idx4 = tid + 512 * it; const int d = idx4 >> 5, e0 = (idx4 & 31) * 4;
            f32x4 acc4 = (f32x4){0.f, 0.f, 0.f, 0.f};
            for (int m = 0; m < qblk; ++m) acc4 = acc4 * g256 + *(const f32x4*)(kvb + (size_t)m * 16384 + d * 128 + e0);
            const int rp = (d & ~12) | ((d & 8) >> 1) | ((d & 4) << 1);
            typedef unsigned u32x2_ __attribute__((ext_vector_type(2)));
            u32x2_ w; w.x = cvtpk_s(acc4[0], acc4[1]); w.y = cvtpk_s(acc4[2], acc4[3]);
            *(FA_LAS u32x2_*)(shm + L_R + (e0 >> 5) * 8192 + rp * 64 + (e0 & 31) * 2) = w; }
        FA_LBAR();
        { FA_LAS const unsigned char* rb = shm + L_R + ((lane >> 4) & 1) * 32 + (lane & 3) * 8 + (4 * hi + ((lane & 15) >> 2)) * 64;
#pragma unroll
          for (int db = 0; db < NDB; ++db)
#pragma unroll
              for (int d0 = 0; d0 < ND0; ++d0) { const s16x4 lo = vtr(rb + db * 8192 + d0 * 1024), hh = vtr(rb + db * 8192 + d0 * 1024 + 512);
                  const bf16x8 rf = (bf16x8){lo[0], lo[1], lo[2], lo[3], hh[0], hh[1], hh[2], hh[3]};
                  o[db] = __builtin_amdgcn_mfma_f32_32x32x16_f16(__builtin_bit_cast(h16::f16x8_t, qr[d0]), __builtin_bit_cast(h16::f16x8_t, rf), o[db], 0, 0, 0); } }
#pragma unroll
        for (int r = 0; r < 16; ++r) { const float rd = exp2f(lg2 * (float)(wid * 32 + crow(r, hi) + 1));
#pragma unroll
            for (int db = 0; db < NDB; ++db) o[db][r] *= rd; }
    }
    const int qrel = wid * 32 + r32;
    for (int i = 0; i < NT; ++i) {
        { const int ahead = (NT - 1 - i) < (DIST - 1) ? (NT - 1 - i) : (DIST - 1);
          if (ahead == 2) { if (PER == 2) asm volatile("s_waitcnt vmcnt(4) lgkmcnt(0)\n\ts_barrier" ::: "memory"); else asm volatile("s_waitcnt vmcnt(8) lgkmcnt(0)\n\ts_barrier" ::: "memory"); }
          else if (ahead == 1) { if (PER == 2) asm volatile("s_waitcnt vmcnt(2) lgkmcnt(0)\n\ts_barrier" ::: "memory"); else asm volatile("s_waitcnt vmcnt(4) lgkmcnt(0)\n\ts_barrier" ::: "memory"); }
          else FA_WAIT_BAR(); }
        if (i + DIST < NT) FA_DMA(i + DIST);
        const bool diag = i < 4; const int t = i & 3; const int j = diag ? qblk : (qblk - 1 - ((i - 4) >> 2));
        const bool mysel = RET ? true : (((selmask >> j) & 1u) != 0u);
        const bool skip = diag ? (64 * t > 32 * wid + 31) : (RET ? false : !__any(mysel));
        if (skip) continue;
        const unsigned so = (unsigned)((i % NS) * SLOT);
        f32x16 p0 = RET ? f32x16{} : negm, p1 = p0;
        { FA_LAS const unsigned char* kb = shm + L_K + so + hi * 1024 + r32 * 16;
#pragma unroll
          for (int d0 = 0; d0 < ND0; ++d0) { const bf16x8 b0 = *(FA_LAS const bf16x8*)(kb + d0 * 2048); const bf16x8 b1 = *(FA_LAS const bf16x8*)(kb + d0 * 2048 + 512);
              p0 = __builtin_amdgcn_mfma_f32_32x32x16_f16(__builtin_bit_cast(h16::f16x8_t, b0), __builtin_bit_cast(h16::f16x8_t, qr[d0]), p0, 0, 0, 0); p1 = __builtin_amdgcn_mfma_f32_32x32x16_f16(__builtin_bit_cast(h16::f16x8_t, b1), __builtin_bit_cast(h16::f16x8_t, qr[d0]), p1, 0, 0, 0); } }
        if (RET) {
            const int qpos = q0 + qrel; const int kv0 = j * 256 + t * 64;
            const float base = (float)(qpos - kv0 - 4 * hi);
            const float rf0 = exp2f(lg2 * base), rf1 = exp2f(lg2 * (base - 32.0f));
#pragma unroll
            for (int r = 0; r < 16; ++r) { p0[r] *= rf0 * cfac[r]; p1[r] *= rf1 * cfac[r]; }
            if (diag) { const int kb_ = 64 * t + 4 * hi;
#pragma unroll
                for (int r = 0; r < 16; ++r) { const int kv = kb_ + (r & 3) + 8 * (r >> 2); if (kv > qrel) p0[r] = 0.f; if (kv + 32 > qrel) p1[r] = 0.f; } }
        } else {
            if (diag) { const int kb_ = 64 * t + 4 * hi;
#pragma unroll
                for (int r = 0; r < 16; ++r) { const int kv = kb_ + (r & 3) + 8 * (r >> 2); if (kv > qrel) p0[r] = NEG; if (kv + 32 > qrel) p1[r] = NEG; } }
            else if (!mysel) {
#pragma unroll
                for (int r = 0; r < 16; ++r) { p0[r] = NEG; p1[r] = NEG; } }
            float rm = fmaxf(fmaxf(p0[0], p1[0]), p0[1]);
#pragma unroll
            for (int r = 1; r < 16; ++r) { rm = fmaxf(fmaxf(rm, p1[r]), (r < 15) ? p0[r + 1] : p1[r]); }
            rm = xl::max32(rm);
            if (__any(rm > THR)) {
                const float dl = fmaxf(rm, 0.f);
                mhat += dl;
#pragma unroll
                for (int r = 0; r < 16; ++r) { p0[r] -= dl; p1[r] -= dl; }
#pragma unroll
                for (int r = 0; r < 16; ++r) negm[r] = -mhat;
                const float f = __builtin_amdgcn_exp2f(-dl); lrow *= f;
                asm volatile("" ::: "memory");
                if (hi == 0) wsf[r32] = f;
                asm volatile("s_waitcnt lgkmcnt(0)" ::: "memory");
#pragma unroll
                for (int r = 0; r < 16; ++r) { const float fr_ = wsf[crow(r, hi)];
#pragma unroll
                    for (int db = 0; db < NDB; ++db) o[db][r] *= fr_; }
                asm volatile("s_waitcnt lgkmcnt(0)" ::: "memory");
            }
            float s = 0.f;
#pragma unroll
            for (int r = 0; r < 16; ++r) { p0[r] = __builtin_amdgcn_exp2f(p0[r]); p1[r] = __builtin_amdgcn_exp2f(p1[r]); s += p0[r] + p1[r]; }
            lrow += s;
        }
        bf16x8 pa[4];
        { u32x4 w;
          w.x = cvtpk_s(p0[0], p0[1]); w.y = cvtpk_s(p0[2], p0[3]); w.z = cvtpk_s(p0[4], p0[5]); w.w = cvtpk_s(p0[6], p0[7]); pa[0] = __builtin_bit_cast(bf16x8, w);
          w.x = cvtpk_s(p0[8], p0[9]); w.y = cvtpk_s(p0[10], p0[11]); w.z = cvtpk_s(p0[12], p0[13]); w.w = cvtpk_s(p0[14], p0[15]); pa[1] = __builtin_bit_cast(bf16x8, w);
          w.x = cvtpk_s(p1[0], p1[1]); w.y = cvtpk_s(p1[2], p1[3]); w.z = cvtpk_s(p1[4], p1[5]); w.w = cvtpk_s(p1[6], p1[7]); pa[2] = __builtin_bit_cast(bf16x8, w);
          w.x = cvtpk_s(p1[8], p1[9]); w.y = cvtpk_s(p1[10], p1[11]); w.z = cvtpk_s(p1[12], p1[13]); w.w = cvtpk_s(p1[14], p1[15]); pa[3] = __builtin_bit_cast(bf16x8, w); }
        { FA_LAS const unsigned char* vb = shm + L_V + so + ((lane >> 4) & 1) * 32 + (lane & 3) * 8 + (4 * hi + ((lane & 15) >> 2)) * 64;
#pragma unroll
          for (int db = 0; db < NDB; ++db)
#pragma unroll
              for (int ks = 0; ks < 4; ++ks) { const s16x4 lo = vtr(vb + db * 4096 + ks * 1024), hh = vtr(vb + db * 4096 + ks * 1024 + 512);
                  const bf16x8 vf = (bf16x8){lo[0], lo[1], lo[2], lo[3], hh[0], hh[1], hh[2], hh[3]};
                  o[db] = __builtin_amdgcn_mfma_f32_32x32x16_f16(__builtin_bit_cast(h16::f16x8_t, pa[ks]), __builtin_bit_cast(h16::f16x8_t, vf), o[db], 0, 0, 0); } }
    }
    float rli[16];
    if (!RET) {
        const float l = xl::add32(lrow);
        asm volatile("" ::: "memory");
        if (hi == 0) wsf[32 + r32] = 1.0f / l;
        asm volatile("s_waitcnt lgkmcnt(0)" ::: "memory");
#pragma unroll
        for (int r = 0; r < 16; ++r) rli[r] = wsf[32 + crow(r, hi)];
    } else {
#pragma unroll
        for (int r = 0; r < 16; ++r) rli[r] = 1.0f;
    }
    FA_LBAR();
    FA_LAS bf16_t* stg = (FA_LAS bf16_t*)(shm + wid * 8192);
#pragma unroll
    for (int r = 0; r < 16; ++r) { const int orow = crow(r, hi);
#pragma unroll
        for (int db = 0; db < NDB; ++db) { const unsigned pk = cvtpk_s(o[db][r] * rli[r], 0.f); stg[orow * DH + db * 32 + r32] = (bf16_t)(pk & 0xffffu); } }
    asm volatile("s_waitcnt lgkmcnt(0)" ::: "memory");
    const size_t tok0 = rowbase + q0 + wid * 32;
    if (!RET) {
#pragma unroll
        for (int i = 0; i < 4; ++i) { const int row = i * 8 + (lane >> 3), ch = lane & 7;
            const u32x4 v = *(FA_LAS const u32x4*)(stg + row * 64 + ch * 8);
            float ss = 0.f;
#pragma unroll
            for (int k = 0; k < 4; ++k) { const float a = h16::lo(v[k]), c = h16::hi(v[k]); ss += a * a + c * c; }
            ss += xl::xor_f<1>(ss); ss += xl::xor_f<2>(ss); ss += xl::xor_f<4>(ss);
            if (ch == 0) T.ASSQ[(tok0 + row) * 8 + h] = ss;
            *(u32x4*)(T.CAT + (tok0 + row) * 1024 + h * 64 + ch * 8) = v; }
    } else {
#pragma unroll
        for (int i = 0; i < 8; ++i) { const int row = i * 4 + (lane >> 4), ch = lane & 15;
            const u32x4 v = *(FA_LAS const u32x4*)(stg + row * 128 + ch * 8);
            float x[8];
#pragma unroll
            for (int k = 0; k < 4; ++k) { x[2 * k] = h16::lo(v[k]); x[2 * k + 1] = h16::hi(v[k]); }
            float ss = 0.f;
#pragma unroll
            for (int k = 0; k < 8; ++k) ss += x[k] * x[k];
            ss += xl::xor_f<1>(ss); ss += xl::xor_f<2>(ss); ss += xl::xor_f<4>(ss); ss += xl::xor_f<8>(ss);
            const float rs = 1.0f / sqrtf(ss * (1.0f / 128.0f) + 1e-6f);
            const u32x4 gv = *(const u32x4*)(T.GR + (tok0 + row) * 512 + h * 128 + ch * 8);
            const f32x4 w0 = *(const f32x4*)(T.ret_g + h * 128 + ch * 8), w1 = *(const f32x4*)(T.ret_g + h * 128 + ch * 8 + 4);
            const float wg[8] = {w0[0], w0[1], w0[2], w0[3], w1[0], w1[1], w1[2], w1[3]};
            float y[8];
#pragma unroll
            for (int k = 0; k < 4; ++k) { const float g0 = h16::lo(gv[k]), g1 = h16::hi(gv[k]);
                y[2 * k] = x[2 * k] * rs * wg[2 * k] * g0; y[2 * k + 1] = x[2 * k + 1] * rs * wg[2 * k + 1] * g1; }
            u32x4 ov; ov.x = cvtpk_s(y[0], y[1]); ov.y = cvtpk_s(y[2], y[3]); ov.z = cvtpk_s(y[4], y[5]); ov.w = cvtpk_s(y[6], y[7]);
            *(u32x4*)(T.CAT + (tok0 + row) * 1024 + 512 + h * 128 + ch * 8) = ov; }
    }
    FA_LBAR();
#undef FA_KV0
#undef FA_DMA
}

__device__ __forceinline__ void kv_unit(const int wv, int b, int h, int m, const bf16_t* Kg, const bf16_t* Vg, float* KVM, FA_LAS unsigned char* shm) {
    constexpr int SLOT = 16384, L_K = 0, L_V = 4 * SLOT;
    int tid_ = otid(wv);
    const int tid = tid_, lane = tid & 63, r32 = lane & 31, hi = lane >> 5; const int wid = __builtin_amdgcn_readfirstlane(tid >> 6);
    const int dg = wid >> 1, eh = wid & 1;
    const size_t rowbase = (size_t)b * 2048 + (size_t)m * 256;
    const unsigned lds0 = (unsigned)(unsigned long)shm;
    const bf16_t* Kh = Kg + rowbase * 512 + h * 128; const bf16_t* Vh = Vg + rowbase * 512 + h * 128;
#pragma unroll
    for (int t = 0; t < 4; ++t)
#pragma unroll
        for (int pp = 0; pp < 2; ++pp) { const int p = wid + 8 * pp; const size_t off = (size_t)(64 * t + 16 * (p & 3) + (lane >> 2)) * 512 + (p >> 2) * 32 + (lane & 3) * 8;
            glds16(Kh + off, (unsigned)__builtin_amdgcn_readfirstlane(lds0 + L_K + t * SLOT + p * 1024));
            glds16(Vh + off, (unsigned)__builtin_amdgcn_readfirstlane(lds0 + L_V + t * SLOT + p * 1024)); }
    const float lg2 = log2f(1.0f - exp2f(-5.0f - (float)h));
    const float g64 = exp2f(lg2 * 64.0f);
    h16::f16x8_t fd[4];
#pragma unroll
    for (int ks = 0; ks < 4; ++ks)
#pragma unroll
        for (int j = 0; j < 8; ++j) fd[ks][j] = (_Float16)exp2f(lg2 * (float)(63 - (16 * ks + 8 * (j >> 2) + 4 * hi + (j & 3))));
    f32x16 acc[2]; acc[0] = f32x16{}; acc[1] = f32x16{};
    FA_WAIT_BAR();
    const int lb = ((lane >> 4) & 1) * 32 + (lane & 3) * 8 + (4 * hi + ((lane & 15) >> 2)) * 64;
#pragma unroll
    for (int t = 0; t < 4; ++t) {
        if (t > 0) {
#pragma unroll
            for (int r = 0; r < 16; ++r) { acc[0][r] *= g64; acc[1][r] *= g64; } }
        FA_LAS const unsigned char* kb = shm + L_K + t * SLOT + dg * 4096 + lb; FA_LAS const unsigned char* vb = shm + L_V + t * SLOT + (2 * eh) * 4096 + lb;
#pragma unroll
        for (int ks = 0; ks < 4; ++ks) { const s16x4 klo = vtr(kb + ks * 1024), khi = vtr(kb + ks * 1024 + 512);
            const h16::f16x8_t kf = __builtin_bit_cast(h16::f16x8_t, (bf16x8){klo[0], klo[1], klo[2], klo[3], khi[0], khi[1], khi[2], khi[3]});
#pragma unroll
            for (int eb = 0; eb < 2; ++eb) { const s16x4 vlo = vtr(vb + eb * 4096 + ks * 1024), vhi = vtr(vb + eb * 4096 + ks * 1024 + 512);
                const h16::f16x8_t vf = __builtin_bit_cast(h16::f16x8_t, (bf16x8){vlo[0], vlo[1], vlo[2], vlo[3], vhi[0], vhi[1], vhi[2], vhi[3]}) * fd[ks];
                acc[eb] = __builtin_amdgcn_mfma_f32_32x32x16_f16(kf, vf, acc[eb], 0, 0, 0); } }
    }
    float* op = KVM + ((size_t)(b * 4 + h) * 8 + m) * 16384;
#pragma unroll
    for (int eb = 0; eb < 2; ++eb)
#pragma unroll
        for (int r = 0; r < 16; ++r) op[(size_t)(32 * dg + crow(r, hi)) * 128 + 64 * eh + 32 * eb + r32] = acc[eb][r];
    FA_LBAR();
}
}
namespace mk {
#define GAS __attribute__((address_space(1)))
#define LAS __attribute__((address_space(3)))
typedef unsigned short bf16;
typedef unsigned v4u __attribute__((ext_vector_type(4)));
typedef unsigned v2u __attribute__((ext_vector_type(2)));
typedef float f32x4 __attribute__((ext_vector_type(4)));
typedef int i32x4 __attribute__((ext_vector_type(4)));
typedef GAS unsigned gu32;
#define RLX_AGENT __ATOMIC_RELAXED, __HIP_MEMORY_SCOPE_AGENT
#define LDS_WAIT() asm volatile("s_waitcnt lgkmcnt(0)" ::: "memory")
#define VM_WAIT() asm volatile("s_waitcnt vmcnt(0)" ::: "memory")
constexpr int NWAVES = 8;
constexpr size_t MiB = 1u << 20, KiB = 1u << 10;
constexpr size_t WS_CTL = 0;
constexpr size_t CTL_ZERO_BYTES = 64 * KiB;
constexpr size_t WS_MOD = 64 * KiB;
constexpr size_t WS_KMP = 512 * KiB;
constexpr size_t WS_EIDX = 768 * KiB;
constexpr size_t WS_EW = 896 * KiB;
constexpr size_t WS_ROPE = 1 * MiB;
constexpr size_t WS_ASSQ = 2 * MiB;
constexpr size_t WS_SROW = 2 * MiB + 512 * KiB;
constexpr size_t WS_SWT = 2 * MiB + 768 * KiB;
constexpr size_t WS_WCNT = 3 * MiB;
constexpr size_t WS_SEG = 3 * MiB + 64 * KiB;
constexpr size_t WS_ATOMF = 3 * MiB + 128 * KiB;
constexpr size_t WS_SEGD = 3 * MiB + 65 * KiB;
constexpr size_t WS_MGU = 8 * MiB;
constexpr size_t WS_SLAB = 8 * MiB;
constexpr size_t WS_MDN = 96 * MiB;
constexpr size_t WS_XA = 140 * MiB;
constexpr size_t WS_XS = 172 * MiB;
constexpr size_t WS_KVM = 172 * MiB;
constexpr size_t WS_YS = 140 * MiB;
constexpr size_t WS_WIN = 240 * MiB;
constexpr size_t WS_WOUT = 254 * MiB;
constexpr size_t WS_FGU = 258 * MiB;
constexpr size_t WS_FDN = 269 * MiB;
constexpr size_t WS_QKV = 275 * MiB;
constexpr size_t WS_CAT = 387 * MiB;
constexpr size_t WS_HD = 275 * MiB;
constexpr size_t WS_HM = 240 * MiB;
constexpr size_t WS_END = 428 * MiB;
constexpr int XS_ROWS = 34816;
constexpr int CW_BAR = 1024;

constexpr int RING_BYTES = 131072, LDSCTL_OFF = RING_BYTES, MISC_OFF = LDSCTL_OFF + 320, LDS_BYTES = 147456;

#define XB_TMO      128
#define XB_XCNT(j)  (256  + 64 * (j))
#define XB_XSUB(j)  (1280 + 64 * (j))
#define XB_XGEN(j)  (2304 + 64 * (j))
#define XB_TOP      3328
#define XB_TOPGEN   3392
#define XCD_BAR_WORDS 3456
#define XB_SPIN_CAP (1u << 18)
__device__ __forceinline__ unsigned xb_ld(unsigned* p)              { return __hip_atomic_load(p, __ATOMIC_RELAXED, __HIP_MEMORY_SCOPE_AGENT); }
__device__ __forceinline__ unsigned xb_add(unsigned* p, unsigned v) { return __hip_atomic_fetch_add(p, v, __ATOMIC_RELAXED, __HIP_MEMORY_SCOPE_AGENT); }
__device__ __forceinline__ unsigned xb_xcc_id() { return (unsigned)__builtin_amdgcn_s_getreg((3 << 11) | 20) & 0xFu; }
#define XB_SPIN(cond, bar) do { unsigned _sp = 0; while (cond) { __builtin_amdgcn_s_sleep(1); \
    if ((++_sp & 255u) == 0u) { if (xb_ld(&(bar)[XB_TMO])) break; if (_sp > XB_SPIN_CAP) { atomicAdd(&(bar)[XB_TMO], 1u); break; } } } } while (0)
struct XcdBarrier { unsigned* bar; unsigned x; volatile LAS unsigned* st; int wv; };
__device__ __forceinline__ XcdBarrier xcd_barrier_post(unsigned* bar, volatile LAS unsigned* st, int wv) {
    XcdBarrier b; b.bar = bar; b.x = xb_xcc_id(); b.st = st; b.wv = wv;
    if (otid(wv) == 0) (void)xb_add(&bar[XB_XCNT(b.x)], 1u);
    return b;
}
__device__ __forceinline__ void xcd_barrier_complete(unsigned* bar, unsigned x, unsigned& nloc, unsigned& nx) {
    const unsigned G = gridDim.x * gridDim.y * gridDim.z;
    unsigned sum, cnt, mine, sp = 0u;
    for (;;) {
        sum = 0u; cnt = 0u; mine = 0u;
#pragma unroll
        for (unsigned j = 0; j < 16; ++j) { const unsigned c = xb_ld(&bar[XB_XCNT(j)]); sum += c; cnt += (c > 0u) ? 1u : 0u; mine = (j == x) ? c : mine; }
        if (sum == G) break;
        __builtin_amdgcn_s_sleep(1);
        if ((++sp & 255u) == 0u) { if (xb_ld(&bar[XB_TMO])) break; if (sp > XB_SPIN_CAP) { atomicAdd(&bar[XB_TMO], 1u); break; } }
    }
    nloc = mine > 0u ? mine : 1u; nx = cnt > 0u ? cnt : 1u;
}
__device__ __forceinline__ void xcd_barrier(const XcdBarrier& b) {
    asm volatile("s_waitcnt vmcnt(0)" ::: "memory");
    __syncthreads();
    if (otid(b.wv) == 0) {
        unsigned* bar = b.bar;
        __builtin_amdgcn_s_waitcnt(0);
        unsigned nloc = b.st[0], nx = b.st[1];
        if (nloc == 0u) { xcd_barrier_complete(bar, b.x, nloc, nx); b.st[0] = nloc; b.st[1] = nx; }
        const unsigned old = xb_add(&bar[XB_XSUB(b.x)], 1u);
        const unsigned gen = old / nloc;
        if (old + 1u == (gen + 1u) * nloc) {
            __builtin_amdgcn_fence(__ATOMIC_RELEASE, "agent");
            asm volatile("s_waitcnt vmcnt(0)" ::: "memory");
            const unsigned og = xb_add(&bar[XB_TOP], 1u);
            const unsigned tg = og / nx;
            if (og + 1u == (tg + 1u) * nx) xb_add(&bar[XB_TOPGEN], 1u);
            else XB_SPIN(xb_ld(&bar[XB_TOPGEN]) == tg, bar);
            __builtin_amdgcn_fence(__ATOMIC_ACQUIRE, "agent");
            xb_add(&bar[XB_XGEN(b.x)], 1u);
            asm volatile("s_waitcnt vmcnt(0)" ::: "memory");
        } else {
            XB_SPIN(xb_ld(&bar[XB_XGEN(b.x)]) == gen, bar);
            __builtin_amdgcn_fence(__ATOMIC_ACQUIRE, "agent");
            asm volatile("s_waitcnt vmcnt(0)" ::: "memory");
        }
    }
    __syncthreads();
}

__device__ __forceinline__ unsigned f2bf(float f) { unsigned u = __builtin_bit_cast(unsigned, f); return (u + 0x7fffu + ((u >> 16) & 1u)) >> 16; }
__device__ __forceinline__ unsigned pk2(float lo, float hi) { return h16::pk(lo, hi); }
using xl::wave_sum; using xl::wave_sum_i;

struct Inputs {
    const float *x, *c, *norm_mix_g, *norm_ffn_g, *ada_w, *ada_b, *w_in, *w_out, *att_g, *ret_g, *fw_gate, *fw_up, *fw_down, *router_w, *mw_gate, *mw_up, *mw_down, *final_g;
};

template <class SrcFn> __device__ __forceinline__ void transpose_item(SrcFn src, int K, bf16* WT, int k0, int n0, LAS float* scr, int lane) {
#pragma unroll 8
    for (int i = 0; i < 32; ++i) { const int kk = 2 * i + (lane >> 5); scr[kk * 33 + (lane & 31)] = src(k0 + kk, n0 + (lane & 31)); }
    LDS_WAIT(); asm volatile("" ::: "memory");
    const int c = lane & 7;
#pragma unroll
    for (int j = 0; j < 4; ++j) { const int n = (lane >> 3) + 8 * j; const LAS float* s = scr + (8 * c) * 33 + n;
        v4u o; o.x = pk2(s[0 * 33], s[1 * 33]); o.y = pk2(s[2 * 33], s[3 * 33]); o.z = pk2(s[4 * 33], s[5 * 33]); o.w = pk2(s[6 * 33], s[7 * 33]);
        *(GAS v4u*)(WT + (size_t)(n0 + n) * K + k0 + 8 * c) = o; }
    LDS_WAIT(); asm volatile("" ::: "memory");
}
__device__ __forceinline__ int rot_src_col(int n) {
    if (n < 1536 || n >= 2560) return n;
    const int hb = (n - 1536) & ~127, p = (n - 1536) & 127;
    return 1536 + hb + 4 * (p >> 3) + ((p & 7) >> 1) + 64 * (p & 1);
}
constexpr int IT_WIN = 16 * 112, IT_WOUT = 16 * 32, IT_GU = 16 * 176, IT_DN = 44 * 32;
constexpr int IT_TOTAL = 2 * IT_WIN + 2 * IT_WOUT + IT_GU + IT_DN + 8 * (IT_GU + IT_DN);

constexpr int IT_NONMOE = 2 * IT_WIN + 2 * IT_WOUT + IT_GU + IT_DN;
__device__ __forceinline__ void convert_item(const Inputs& in, unsigned char* ws, int it, LAS float* scr, int lane) {
    int r = it;
    if (r < 2 * IT_WIN) { const int l = r / IT_WIN; r -= l * IT_WIN; const float* W = in.w_in + (size_t)l * 1024 * 3584;
        transpose_item([=](int k, int n) { return W[(size_t)k * 3584 + rot_src_col(n)]; }, 1024, (bf16*)(ws + WS_WIN) + (size_t)l * 3584 * 1024, 64 * (r / 112), 32 * (r % 112), scr, lane); return; }
    r -= 2 * IT_WIN;
    if (r < 2 * IT_WOUT) { const int l = r / IT_WOUT; r -= l * IT_WOUT; const float* W = in.w_out + (size_t)l * 1024 * 1024; const float* ag = in.att_g + l * 512;
        transpose_item([=](int k, int n) { return W[(size_t)k * 1024 + n] * (k < 512 ? ag[k] : 1.0f); }, 1024, (bf16*)(ws + WS_WOUT) + (size_t)l * 1024 * 1024, 64 * (r / 32), 32 * (r % 32), scr, lane); return; }
    r -= 2 * IT_WOUT;
    const float *Wg, *Wu, *Wd; bf16 *Dgu, *Ddn;
    if (r < IT_GU + IT_DN) { Wg = in.fw_gate; Wu = in.fw_up; Wd = in.fw_down; Dgu = (bf16*)(ws + WS_FGU); Ddn = (bf16*)(ws + WS_FDN); }
    else { r -= IT_GU + IT_DN; const int e = r / (IT_GU + IT_DN); r -= e * (IT_GU + IT_DN);
        Wg = in.mw_gate + (size_t)e * 1024 * 2816; Wu = in.mw_up + (size_t)e * 1024 * 2816; Wd = in.mw_down + (size_t)e * 2816 * 1024;
        Dgu = (bf16*)(ws + WS_MGU) + (size_t)e * 5632 * 1024; Ddn = (bf16*)(ws + WS_MDN) + (size_t)e * 1024 * 2816; }
    if (r < IT_GU) {
        transpose_item([=](int k, int n) { const float* W = ((n >> 7) & 1) ? Wu : Wg; return W[(size_t)k * 2816 + (n >> 8) * 128 + (n & 127)]; }, 1024, Dgu, 64 * (r / 176), 32 * (r % 176), scr, lane); return; }
    r -= IT_GU;
    transpose_item([=](int k, int n) { return Wd[(size_t)k * 1024 + n]; }, 2816, Ddn, 64 * (r / 32), 32 * (r % 32), scr, lane);
}
struct MoeItem { const float* src; bf16* dst; int ld, K, k0, n0; const float* rscale; float f8scale; int scol0, sstep; };
template <int KIND  , class InP> __device__ __forceinline__ MoeItem moe_item(InP inp, unsigned char* ws, int it, int lane) {
    MoeItem m; m.rscale = nullptr; m.f8scale = (KIND == 0) ? 32.0f : 64.0f; const int r8 = lane >> 3, c4 = 4 * (lane & 7); m.scol0 = c4; m.sstep = 1;
    if (KIND == 0) { const int e = it / IT_GU, r = it - e * IT_GU; const int kb = r / 176, nb = r % 176; const int n = 32 * nb; m.k0 = 64 * kb; m.n0 = n; m.ld = 2816; m.K = 1024;
        const float* W = (((n >> 7) & 1) ? inp->mw_up : inp->mw_gate) + (size_t)e * 1024 * 2816;
        m.src = W + (size_t)(m.k0 + r8) * 2816 + (n >> 8) * 128 + (n & 127) + c4; m.dst = (bf16*)(ws + WS_MGU + (size_t)e * 5632 * 1024); }
    else { const int e = it / IT_DN, r = it - e * IT_DN; const int kb = r / 32, nb = r % 32; m.k0 = 64 * kb; m.n0 = 32 * nb; m.ld = 1024; m.K = 2816;
        m.src = inp->mw_down + (size_t)e * 2816 * 1024 + (size_t)(m.k0 + r8) * 1024 + m.n0 + c4; m.dst = (bf16*)(ws + WS_MDN + (size_t)e * 1024 * 2816); }
    return m;
}
__device__ __forceinline__ void moe_item_load(const MoeItem& m, float (&v)[32]) {
#pragma unroll
    for (int i = 0; i < 8; ++i) { const f32x4 t = __builtin_nontemporal_load((const f32x4*)(m.src + (size_t)(8 * i) * m.ld));
        v[4 * i] = t[0]; v[4 * i + 1] = t[1]; v[4 * i + 2] = t[2]; v[4 * i + 3] = t[3]; }
}
__device__ __forceinline__ void moe_item_finish(const MoeItem& m, const float (&v)[32], LAS float* scr, int lane) {
    const int r8 = lane >> 3;
    if (m.rscale != nullptr && m.k0 < 512) {
#pragma unroll
        for (int i = 0; i < 8; ++i) { const float rsv = m.rscale[m.k0 + 8 * i + r8];
#pragma unroll
            for (int j = 0; j < 4; ++j) scr[(8 * i + r8) * 33 + m.scol0 + j * m.sstep] = v[4 * i + j] * rsv; }
    } else {
#pragma unroll
        for (int i = 0; i < 8; ++i)
#pragma unroll
            for (int j = 0; j < 4; ++j) scr[(8 * i + r8) * 33 + m.scol0 + j * m.sstep] = v[4 * i + j];
    }
    LDS_WAIT(); asm volatile("" ::: "memory");
    const int c = lane & 7;
    if (m.f8scale != 0.f) {
        const float sc = m.f8scale; unsigned char* d8 = (unsigned char*)m.dst;
#pragma unroll
        for (int j = 0; j < 4; ++j) { const int n = (lane >> 3) + 8 * j; const LAS float* s = scr + (8 * c) * 33 + n;
            v2u o; int p = 0; p = __builtin_amdgcn_cvt_pk_fp8_f32(s[0 * 33] * sc, s[1 * 33] * sc, p, false); p = __builtin_amdgcn_cvt_pk_fp8_f32(s[2 * 33] * sc, s[3 * 33] * sc, p, true); o.x = (unsigned)p;
            p = 0; p = __builtin_amdgcn_cvt_pk_fp8_f32(s[4 * 33] * sc, s[5 * 33] * sc, p, false); p = __builtin_amdgcn_cvt_pk_fp8_f32(s[6 * 33] * sc, s[7 * 33] * sc, p, true); o.y = (unsigned)p;
            *(GAS v2u*)(d8 + (size_t)(m.n0 + n) * m.K + m.k0 + 8 * c) = o; }
    } else {
#pragma unroll
        for (int j = 0; j < 4; ++j) { const int n = (lane >> 3) + 8 * j; const LAS float* s = scr + (8 * c) * 33 + n;
            v4u o; o.x = pk2(s[0 * 33], s[1 * 33]); o.y = pk2(s[2 * 33], s[3 * 33]); o.z = pk2(s[4 * 33], s[5 * 33]); o.w = pk2(s[6 * 33], s[7 * 33]);
            *(GAS v4u*)(m.dst + (size_t)(m.n0 + n) * m.K + m.k0 + 8 * c) = o; }
    }
    LDS_WAIT(); asm volatile("" ::: "memory");
}
template <class InP> __device__ __forceinline__ MoeItem base_item(InP inp, unsigned char* ws, int it, int lane) {
    MoeItem m; m.rscale = nullptr; m.f8scale = 0.f; int r = it; const int r8 = lane >> 3, c = lane & 7, c4 = 4 * c; m.scol0 = c4; m.sstep = 1;
    if (r < 2 * IT_WIN) { const int l = r / IT_WIN; r -= l * IT_WIN; m.k0 = 64 * (r / 112); m.n0 = 32 * (r % 112); m.ld = 3584; m.K = 1024;
        int scol = m.n0 + c4;
        if (m.n0 >= 1536 && m.n0 < 2560) { const int hb = (m.n0 - 1536) & ~127, a0 = ((m.n0 - 1536) & 127) >> 3;
            scol = 1536 + hb + 4 * (a0 + (c & 3)) + 64 * (c >> 2); m.scol0 = 8 * (c & 3) + (c >> 2); m.sstep = 2; }
        m.src = inp->w_in + (size_t)l * 1024 * 3584 + (size_t)(m.k0 + r8) * 3584 + scol; m.dst = (bf16*)(ws + WS_WIN) + (size_t)l * 3584 * 1024; return m; }
    r -= 2 * IT_WIN;
    if (r < 2 * IT_WOUT) { const int l = r / IT_WOUT; r -= l * IT_WOUT; m.k0 = 64 * (r / 32); m.n0 = 32 * (r % 32); m.ld = 1024; m.K = 1024; m.rscale = inp->att_g + l * 512;
        m.src = inp->w_out + (size_t)l * 1024 * 1024 + (size_t)(m.k0 + r8) * 1024 + m.n0 + c4; m.dst = (bf16*)(ws + WS_WOUT) + (size_t)l * 1024 * 1024; return m; }
    r -= 2 * IT_WOUT;
    if (r < IT_GU) { const int n = 32 * (r % 176); m.k0 = 64 * (r / 176); m.n0 = n; m.ld = 2816; m.K = 1024;
        m.src = (((n >> 7) & 1) ? inp->fw_up : inp->fw_gate) + (size_t)(m.k0 + r8) * 2816 + (n >> 8) * 128 + (n & 127) + c4; m.dst = (bf16*)(ws + WS_FGU); m.f8scale = 32.0f; return m; }
    r -= IT_GU; m.k0 = 64 * (r / 32); m.n0 = 32 * (r % 32); m.ld = 1024; m.K = 2816;
    m.src = inp->fw_down + (size_t)(m.k0 + r8) * 1024 + m.n0 + c4; m.dst = (bf16*)(ws + WS_FDN); m.f8scale = 64.0f; return m;
}
#ifndef CONV_DEPTH
#define CONV_DEPTH 4
#endif
#define CONV_PIPE(ITEM_FN, IT_FIRST, IT_END, STEP)                                                                      \
    { int it = (IT_FIRST); const int it_end = (IT_END), st_ = (STEP);                                                   \
      if (it < it_end) {                                                                                                \
        float v0[32], v1[32], v2[32], v3[32]; MoeItem q0, q1, q2, q3;                                                   \
        auto clampi = [&](int i) { return i < it_end ? i : it; };                                                       \
        q0 = ITEM_FN(it); moe_item_load(q0, v0);                                                                        \
        if (CONV_DEPTH > 2) { q1 = ITEM_FN(clampi(it + st_)); moe_item_load(q1, v1); }                                  \
        if (CONV_DEPTH > 3) { q2 = ITEM_FN(clampi(it + 2 * st_)); moe_item_load(q2, v2); }                              \
        for (;;) {                                                                                                      \
            if (CONV_DEPTH == 2) { q1 = ITEM_FN(clampi(it + st_)); moe_item_load(q1, v1); }                             \
            if (CONV_DEPTH == 3) { q2 = ITEM_FN(clampi(it + 2 * st_)); moe_item_load(q2, v2); }                         \
            if (CONV_DEPTH == 4) { q3 = ITEM_FN(clampi(it + 3 * st_)); moe_item_load(q3, v3); }                         \
            moe_item_finish(q0, v0, scr, lane); it += st_; if (it >= it_end) break;                                     \
            if (CONV_DEPTH == 2) { q0 = ITEM_FN(clampi(it + st_)); moe_item_load(q0, v0); }                             \
            if (CONV_DEPTH == 3) { q0 = ITEM_FN(clampi(it + 2 * st_)); moe_item_load(q0, v0); }                         \
            if (CONV_DEPTH == 4) { q0 = ITEM_FN(clampi(it + 3 * st_)); moe_item_load(q0, v0); }                         \
            moe_item_finish(q1, v1, scr, lane); it += st_; if (it >= it_end) break;                                     \
            if (CONV_DEPTH == 2) continue;                                                                              \
            if (CONV_DEPTH == 3) { q1 = ITEM_FN(clampi(it + 2 * st_)); moe_item_load(q1, v1); }                         \
            if (CONV_DEPTH == 4) { q1 = ITEM_FN(clampi(it + 3 * st_)); moe_item_load(q1, v1); }                         \
            moe_item_finish(q2, v2, scr, lane); it += st_; if (it >= it_end) break;                                     \
            if (CONV_DEPTH == 3) continue;                                                                              \
            q2 = ITEM_FN(clampi(it + 3 * st_)); moe_item_load(q2, v2);                                                  \
            moe_item_finish(q3, v3, scr, lane); it += st_; if (it >= it_end) break;                                     \
        }                                                                                                               \
      } }
constexpr int IT_LATE = IT_WIN + IT_WOUT, IT_EARLY = IT_NONMOE - IT_LATE;
template <class InP> __device__ __forceinline__ void convert_base_all(InP inp, unsigned char* ws, LAS unsigned char* lds, int gw, int NGW, int wave, int lane) {
    LAS float* scr = (LAS float*)(lds + wave * 16384);
    auto item = [&](int p) { return base_item(inp, ws, p < IT_WIN ? p : (p < IT_WIN + IT_WOUT ? p + IT_WIN : p + IT_WIN + IT_WOUT), lane); };
    CONV_PIPE(item, gw, IT_EARLY, NGW)
}
template <class InP> __device__ __forceinline__ void convert_base_late(InP inp, unsigned char* ws, LAS unsigned char* lds, int sp, int nsp, int wave, int lane) {
    LAS float* scr = (LAS float*)(lds + wave * 16384);
    auto item = [&](int d) { return base_item(inp, ws, d < IT_WIN ? IT_WIN + d : d + IT_WIN + IT_WOUT, lane); };
    CONV_PIPE(item, sp * NWAVES + wave, IT_LATE, nsp * NWAVES)
}
template <int KIND, class InP> __device__ __forceinline__ void convert_moe_range(InP inp, unsigned char* ws, LAS unsigned char* lds, int it0, int it1, int sp, int nsp, int wave, int lane) {
    LAS float* scr = (LAS float*)(lds + wave * 16384);
    auto item = [&](int i) { return moe_item<KIND>(inp, ws, i, lane); };
#ifndef CONV_CONTIG
    CONV_PIPE(item, it0 + sp * NWAVES + wave, it1, nsp * NWAVES)
#else
    const int chunk = (it1 - it0 + nsp - 1) / nsp, cb = it0 + sp * chunk, ce = (cb + chunk < it1) ? cb + chunk : it1;
    CONV_PIPE(item, cb + wave, ce, NWAVES)
#endif
}
constexpr int IT_MOE = 8 * (IT_GU + IT_DN);
#ifndef G_GUD_N
#define G_GUD_N 208
#endif
constexpr int G_INPROJ = 224, G_GUD = G_GUD_N;
#ifndef MOE_SPARE
#define MOE_SPARE 8
#endif
constexpr int IT_MGU = 8 * IT_GU, IT_MDN = 8 * IT_DN;
#ifndef SPLIT_A
#define SPLIT_A 9000
#define SPLIT_B 19500
#define SPLIT_C 7500
#endif
constexpr int IT_MOE_A = SPLIT_A, IT_MOE_B = SPLIT_B, IT_MDN_C = SPLIT_C;

template <class InP> __device__ __forceinline__ void p0_prologue(InP inp, unsigned char* ws, LAS unsigned char* lds, int vcu, int G, int wave, int lane, int tid, int moe_w) {
    Inputs in; in.c = inp->c; in.ada_w = inp->ada_w; in.ada_b = inp->ada_b; in.w_in = inp->w_in; in.w_out = inp->w_out; in.att_g = inp->att_g; in.fw_gate = inp->fw_gate; in.fw_up = inp->fw_up; in.fw_down = inp->fw_down; in.mw_gate = inp->mw_gate; in.mw_up = inp->mw_up; in.mw_down = inp->mw_down;
    if (vcu < 192) {
        LAS float* cs = (LAS float*)lds;
        LAS float* part = (LAS float*)(lds + 32768);
        for (int i = tid; i < 8 * 1024; i += 512) { const float v = in.c[i]; cs[i] = v / (1.0f + __expf(-v)); }
        __syncthreads();
        const int n0 = vcu * 64, l = n0 / 6144, nn = n0 % 6144 + lane;
        const float* wp = in.ada_w + (size_t)l * 1024 * 6144 + (size_t)(wave * 128) * 6144 + nn;
        float acc[8];
#pragma unroll
        for (int b = 0; b < 8; ++b) acc[b] = 0.f;
#pragma unroll 8
        for (int k = 0; k < 128; ++k) { const float wv = wp[(size_t)k * 6144];
#pragma unroll
            for (int b = 0; b < 8; ++b) acc[b] += cs[b * 1024 + wave * 128 + k] * wv; }
#pragma unroll
        for (int b = 0; b < 8; ++b) part[(wave * 8 + b) * 64 + lane] = acc[b];
        __syncthreads();
        { const int b = tid >> 6; float s = 0.f;
#pragma unroll
          for (int w = 0; w < 8; ++w) s += part[(w * 8 + b) * 64 + lane];
          ((float*)(ws + WS_MOD))[((size_t)l * 8 + b) * 6144 + nn] = s + in.ada_b[l * 6144 + nn]; }
        __syncthreads();
    }
    { const int g = vcu * 512 + tid; if (g < 2048 * 64) { const int pos = g >> 6, i = g & 63; const float inv = powf(10000.0f, -(float)i / 64.0f); const float ang = (float)pos * inv;
        float* rp = (float*)(ws + WS_ROPE) + (size_t)g * 2; rp[0] = (float)cos((double)ang); rp[1] = (float)sin((double)ang); } }
    convert_base_all(inp, ws, lds, vcu * NWAVES + wave, G * NWAVES, wave, lane);
}

template <int MODE>
__device__ __forceinline__ void norm_pass(const float* xsrc, const float* gain, const float* sh, const float* sc, bf16* dst,
                                          const float* router_w, int* eidx, float* ew, int* wcnt, int gw, int lane) {
    const int m0 = gw * 8, b = m0 >> 11;
    f32x4 gv[4], scv[4], shv[4];
#pragma unroll
    for (int j = 0; j < 4; ++j) { gv[j] = ((const f32x4*)gain)[lane + 64 * j]; scv[j] = ((const f32x4*)(sc + (size_t)b * 6144))[lane + 64 * j] + 1.0f; shv[j] = ((const f32x4*)(sh + (size_t)b * 6144))[lane + 64 * j]; }
    int cnt[8];
#pragma unroll
    for (int e = 0; e < 8; ++e) cnt[e] = 0;
    f32x4 rw[4][4][2];
    if (MODE == 1) {
#pragma unroll
        for (int j = 0; j < 4; ++j)
#pragma unroll
            for (int c = 0; c < 4; ++c) { const float* wp = router_w + (size_t)(4 * (lane + 64 * j) + c) * 8; rw[j][c][0] = *(const f32x4*)wp; rw[j][c][1] = *(const f32x4*)(wp + 4); }
    }
    for (int i = 0; i < 8; ++i) {
        const int m = m0 + i;
        const f32x4* xr = (const f32x4*)(xsrc + (size_t)m * 1024) + lane;
        f32x4 v[4]; float s = 0.f;
#pragma unroll
        for (int j = 0; j < 4; ++j) { v[j] = xr[64 * j]; s += (v[j][0] * v[j][0] + v[j][1] * v[j][1]) + (v[j][2] * v[j][2] + v[j][3] * v[j][3]); }
        const float rs = 1.0f / sqrtf(wave_sum(s) * (1.0f / 1024.0f) + 1e-6f);
        if (MODE == 2) {
            unsigned* o4 = (unsigned*)((unsigned char*)dst + (size_t)m * 1024) + lane;
#pragma unroll
            for (int j = 0; j < 4; ++j) { v[j] = v[j] * rs * gv[j] * scv[j] + shv[j]; o4[64 * j] = epi::pk4_fp8(v[j][0], v[j][1], v[j][2], v[j][3]); }
        } else {
        v2u* o8 = (v2u*)(dst + (size_t)m * 1024) + lane;
#pragma unroll
        for (int j = 0; j < 4; ++j) { v[j] = v[j] * rs * gv[j] * scv[j] + shv[j]; v2u w; w.x = pk2(v[j][0], v[j][1]); w.y = pk2(v[j][2], v[j][3]); o8[64 * j] = w; }
        }
        if (MODE == 1) {
            float lg[8];
#pragma unroll
            for (int e = 0; e < 8; ++e) lg[e] = 0.f;
#pragma unroll
            for (int j = 0; j < 4; ++j)
#pragma unroll
                for (int c = 0; c < 4; ++c) { const f32x4 w0 = rw[j][c][0], w1 = rw[j][c][1];
                    const float hv = v[j][c];
                    lg[0] += hv * w0[0]; lg[1] += hv * w0[1]; lg[2] += hv * w0[2]; lg[3] += hv * w0[3]; lg[4] += hv * w1[0]; lg[5] += hv * w1[1]; lg[6] += hv * w1[2]; lg[7] += hv * w1[3]; }
            { const bool b5 = (lane & 32) != 0, b4 = (lane & 16) != 0, b3 = (lane & 8) != 0;
              float a4[4], b2[2], c1;
#pragma unroll
              for (int q = 0; q < 4; ++q) { const float keep = b5 ? lg[4 + q] : lg[q], send = b5 ? lg[q] : lg[4 + q]; a4[q] = keep + xl::xor32p(send, b5); }
#pragma unroll
              for (int q = 0; q < 2; ++q) { const float keep = b4 ? a4[2 + q] : a4[q], send = b4 ? a4[q] : a4[2 + q]; b2[q] = keep + xl::xor_f<16>(send); }
              { const float keep = b3 ? b2[1] : b2[0], send = b3 ? b2[0] : b2[1]; c1 = keep + xl::xor_f<8>(send); }
              c1 += xl::xor_f<4>(c1); c1 += xl::xor_f<2>(c1); c1 += xl::xor_f<1>(c1);
#pragma unroll
              for (int e = 0; e < 8; ++e) lg[e] = __builtin_bit_cast(float, __builtin_amdgcn_readlane(__builtin_bit_cast(int, c1), 8 * e)); }
            int i0 = 0; float b0 = lg[0];
#pragma unroll
            for (int e = 1; e < 8; ++e) if (lg[e] > b0) { b0 = lg[e]; i0 = e; }
            int i1 = -1; float b1 = -3.0e38f;
#pragma unroll
            for (int e = 0; e < 8; ++e) if (e != i0 && lg[e] > b1) { b1 = lg[e]; i1 = e; }
            const float e1 = __expf(b1 - b0);
#pragma unroll
            for (int e = 0; e < 8; ++e) cnt[e] += ((e == i0) ? 1 : 0) + ((e == i1) ? 1 : 0);
            if (lane == 0) { eidx[m * 2] = i0; eidx[m * 2 + 1] = i1; ew[m * 2] = 1.0f / (1.0f + e1); ew[m * 2 + 1] = e1 / (1.0f + e1); }
        }
    }
    if (MODE == 1) {
        int myc = 0;
#pragma unroll
        for (int e = 0; e < 8; ++e) myc = (lane == e) ? cnt[e] : myc;
        if (lane < 8) wcnt[gw * 8 + lane] = myc;
    }
}

__device__ __forceinline__ void place_pass(const int* wcnt, const int* eidx, const float* ew, const bf16* XA, bf16* XS, int* srow, float* swt, int* segout, int gw, int NGW, int lane) {
    int tot[8], pre[8];
#pragma unroll
    for (int e = 0; e < 8; ++e) { tot[e] = 0; pre[e] = 0; }
    for (int w = lane; w < NGW; w += 64) { const i32x4 a = *(const i32x4*)(wcnt + w * 8), c = *(const i32x4*)(wcnt + w * 8 + 4); const int inc = (w < gw) ? 1 : 0;
        tot[0] += a[0]; tot[1] += a[1]; tot[2] += a[2]; tot[3] += a[3]; tot[4] += c[0]; tot[5] += c[1]; tot[6] += c[2]; tot[7] += c[3];
        pre[0] += inc * a[0]; pre[1] += inc * a[1]; pre[2] += inc * a[2]; pre[3] += inc * a[3]; pre[4] += inc * c[0]; pre[5] += inc * c[1]; pre[6] += inc * c[2]; pre[7] += inc * c[3]; }
    int base[8]; int run = 0;
#pragma unroll
    for (int e = 0; e < 8; ++e) { tot[e] = wave_sum_i(tot[e]); pre[e] = wave_sum_i(pre[e]); base[e] = run + pre[e]; if (gw == 0 && lane == 0) segout[e] = run; run += (tot[e] + 255) & ~255; }
    if (gw == 0 && lane == 0) segout[8] = run;
    const int myev = (lane < 16) ? eidx[gw * 16 + lane] : 0; const float myw = (lane < 16) ? ew[gw * 16 + lane] : 0.f;
    int mypos = 0;
#pragma unroll
    for (int i = 0; i < 16; ++i) { const int ev = __builtin_amdgcn_readlane(myev, i); int pos = 0;
#pragma unroll
        for (int e = 0; e < 8; ++e) if (ev == e) { pos = base[e]; base[e] += 1; }
        mypos = (lane == i) ? pos : mypos; }
    if (lane < 16) { srow[mypos] = gw * 16 + lane; swt[mypos] = myw; }
    const v4u* __restrict__ s = (const v4u*)(XA + (size_t)(gw * 8) * 1024);
    v4u r0[8], r1[8];
#pragma unroll
    for (int t = 0; t < 8; ++t) { r0[t] = s[t * 128 + lane]; r1[t] = s[t * 128 + lane + 64]; }
    v2u q0[8], q1[8];
#pragma unroll
    for (int t = 0; t < 8; ++t) {
        { int p = 0; p = __builtin_amdgcn_cvt_pk_fp8_f32(h16::lo(r0[t].x), h16::hi(r0[t].x), p, false); p = __builtin_amdgcn_cvt_pk_fp8_f32(h16::lo(r0[t].y), h16::hi(r0[t].y), p, true); q0[t].x = (unsigned)p;
          p = 0; p = __builtin_amdgcn_cvt_pk_fp8_f32(h16::lo(r0[t].z), h16::hi(r0[t].z), p, false); p = __builtin_amdgcn_cvt_pk_fp8_f32(h16::lo(r0[t].w), h16::hi(r0[t].w), p, true); q0[t].y = (unsigned)p; }
        { int p = 0; p = __builtin_amdgcn_cvt_pk_fp8_f32(h16::lo(r1[t].x), h16::hi(r1[t].x), p, false); p = __builtin_amdgcn_cvt_pk_fp8_f32(h16::lo(r1[t].y), h16::hi(r1[t].y), p, true); q1[t].x = (unsigned)p;
          p = 0; p = __builtin_amdgcn_cvt_pk_fp8_f32(h16::lo(r1[t].z), h16::hi(r1[t].z), p, false); p = __builtin_amdgcn_cvt_pk_fp8_f32(h16::lo(r1[t].w), h16::hi(r1[t].w), p, true); q1[t].y = (unsigned)p; } }
#pragma unroll
    for (int i = 0; i < 16; ++i) { const int pos = __builtin_amdgcn_readlane(mypos, i); v2u* __restrict__ d = (v2u*)((unsigned char*)XS + (size_t)pos * 1024);
        d[lane] = q0[i >> 1]; d[lane + 64] = q1[i >> 1]; }
}

__device__ __forceinline__ void final_pass(float* xio, const bf16* YS, const int* atomf, const float* slab, const float* g2, const float* fg, int gw, int lane) {
    const int m0 = gw * 8, b = m0 >> 11;
    f32x4 gv[4], g2v[4];
#pragma unroll
    for (int j = 0; j < 4; ++j) { gv[j] = ((const f32x4*)fg)[lane + 64 * j]; g2v[j] = ((const f32x4*)(g2 + (size_t)b * 6144))[lane + 64 * j]; }
    for (int i = 0; i < 8; ++i) {
        const int m = m0 + i;
        f32x4* xr = (f32x4*)(xio + (size_t)m * 1024) + lane;
        const v2u* y0 = (const v2u*)(YS + (size_t)(2 * m) * 1024) + lane; const v2u* y1 = (const v2u*)(YS + (size_t)(2 * m + 1) * 1024) + lane;
        f32x4 v[4]; float s = 0.f; const i32x4 f0 = *(const i32x4*)(atomf + (size_t)(2 * m) * 4), f1 = *(const i32x4*)(atomf + (size_t)(2 * m + 1) * 4);
#pragma unroll
        for (int j = 0; j < 4; ++j) { v[j] = xr[64 * j]; const v2u a = y0[64 * j], c = y1[64 * j];
            f32x4 ya, yc;
            if (f0[j]) { const int id = f0[j] - 1; const float* sp = slab + ((size_t)((id >> 8) * 11) * 256 + (id & 255)) * 256 + 4 * lane; ya = (f32x4){0.f, 0.f, 0.f, 0.f};
                for (int kc = 0; kc < 11; ++kc) ya += *(const f32x4*)(sp + (size_t)kc * 65536); }
            else { ya[0] = h16::lo(a.x); ya[1] = h16::hi(a.x); ya[2] = h16::lo(a.y); ya[3] = h16::hi(a.y); }
            if (f1[j]) { const int id = f1[j] - 1; const float* sp = slab + ((size_t)((id >> 8) * 11) * 256 + (id & 255)) * 256 + 4 * lane; yc = (f32x4){0.f, 0.f, 0.f, 0.f};
                for (int kc = 0; kc < 11; ++kc) yc += *(const f32x4*)(sp + (size_t)kc * 65536); }
            else { yc[0] = h16::lo(c.x); yc[1] = h16::hi(c.x); yc[2] = h16::lo(c.y); yc[3] = h16::hi(c.y); }
            const f32x4 ys = ya + yc;
            v[j] = v[j] + g2v[j] * ys; s += (v[j][0] * v[j][0] + v[j][1] * v[j][1]) + (v[j][2] * v[j][2] + v[j][3] * v[j][3]); }
        const float rs = 1.0f / sqrtf(wave_sum(s) * (1.0f / 1024.0f) + 1e-6f);
#pragma unroll
        for (int j = 0; j < 4; ++j) xr[64 * j] = v[j] * rs * gv[j];
    }
}

__device__ __forceinline__ void xcd_barrier_arrive(const XcdBarrier& b) {
    asm volatile("s_waitcnt vmcnt(0)" ::: "memory");
    __syncthreads();
    if (otid(b.wv) == 0) {
        unsigned* bar = b.bar;
        __builtin_amdgcn_s_waitcnt(0);
        unsigned nloc = b.st[0], nx = b.st[1];
        if (nloc == 0u) { xcd_barrier_complete(bar, b.x, nloc, nx); b.st[0] = nloc; b.st[1] = nx; }
        const unsigned old = xb_add(&bar[XB_XSUB(b.x)], 1u);
        const unsigned gen = old / nloc;
        if (old + 1u == (gen + 1u) * nloc) {
            __builtin_amdgcn_fence(__ATOMIC_RELEASE, "agent");
            asm volatile("s_waitcnt vmcnt(0)" ::: "memory");
            const unsigned og = xb_add(&bar[XB_TOP], 1u);
            const unsigned tg = og / nx;
            if (og + 1u == (tg + 1u) * nx) xb_add(&bar[XB_TOPGEN], 1u);
            else XB_SPIN(xb_ld(&bar[XB_TOPGEN]) == tg, bar);
            xb_add(&bar[XB_XGEN(b.x)], 1u);
            asm volatile("s_waitcnt vmcnt(0)" ::: "memory");
        }
        b.st[3] = gen;
    }
}
__device__ __forceinline__ void xcd_barrier_wait(const XcdBarrier& b) {
    if (otid(b.wv) == 0) {
        unsigned* bar = b.bar;
        const unsigned gen = b.st[3];
        XB_SPIN(xb_ld(&bar[XB_XGEN(b.x)]) == gen, bar);
        __builtin_amdgcn_fence(__ATOMIC_ACQUIRE, "agent");
        asm volatile("s_waitcnt vmcnt(0)" ::: "memory");
    }
    __syncthreads();
}
constexpr int N_PHASES = 18;
struct Args { Inputs in; float* out; unsigned char* ws; int ph_lo, ph_hi, bar_region, moe_w; };

typedef const Args __attribute__((address_space(4))) CArgs;
__device__ __forceinline__ CArgs* kargs() { unsigned long off = 0; asm volatile("" : "+s"(off)); return (CArgs*)((const char __attribute__((address_space(4)))*)__builtin_amdgcn_kernarg_segment_ptr() + off); }

__global__ void __launch_bounds__(NWAVES * 64, 2) mega(Args args_unused) {
    extern __shared__ __attribute__((aligned(16))) unsigned char lds_raw[];
    LAS unsigned char* lds = (LAS unsigned char*)lds_raw;
    volatile LAS unsigned* MISC = (volatile LAS unsigned*)(lds + MISC_OFF);
    const int G = gridDim.x;
#define PHASE_IDS int tid = otid(WV); int bx = blockIdx.x; asm volatile("" : "+s"(bx)); const int lane = tid & 63, wave = __builtin_amdgcn_readfirstlane(tid >> 6); \
    const int vcu = (bx & 7) * (G >> 3) + (bx >> 3); const int gw = vcu * NWAVES + wave; (void)lane; (void)gw; (void)vcu;
    const int WV = __builtin_amdgcn_readfirstlane((int)threadIdx.x >> 6);
    for (int u = otid(WV); u < (LDS_BYTES - LDSCTL_OFF) / 4; u += NWAVES * 64) ((LAS unsigned*)(lds + LDSCTL_OFF))[u] = 0u;
    __syncthreads();
    XcdBarrier bar;
    { CArgs* ka = kargs(); unsigned* barw = (unsigned*)(ka->ws + WS_CTL) + CW_BAR + ka->bar_region * XCD_BAR_WORDS; bar = xcd_barrier_post(barw, MISC + 8, WV); }
    int lo, hi; { CArgs* ka = kargs(); lo = ka->ph_lo; hi = ka->ph_hi; }
#ifndef PHM
#define PHM 0x3ff
#endif
#define IN(k) (lo <= (k) && (k) < hi)
#define TY(t) (((PHM) >> (t)) & 1)
#ifndef DUP_T
#define DUP_T -1
#define DUP_N 0
#endif
#define REP(t) for (int rep_ = 0; rep_ < ((t) == DUP_T ? 1 + DUP_N : 1) && (rep_ == 0 || (__syncthreads(), true)); ++rep_)
#ifdef TPROBE
#define TS ((volatile LAS unsigned long long*)(lds + MISC_OFF + 256))
#define STAMP(k) do { if (blockIdx.x == 0 && otid(WV) == 0) TS[(k)] = __builtin_amdgcn_s_memrealtime(); } while (0)
#else
#define STAMP(k) do {} while (0)
#endif
#ifdef TSPIN
#ifndef TSPIN_BX
#define TSPIN_BX 0
#endif
#define TSL ((volatile LAS unsigned long long*)(lds + MISC_OFF + 256))
#define STAMP_E(k) do { if (blockIdx.x == TSPIN_BX && otid(WV) == 0) { const unsigned long long n_ = __builtin_amdgcn_s_memrealtime(); if (((TSPIN_W) >> (k)) & 1) TSL[1] += n_ - TSL[0]; TSL[0] = n_; } } while (0)
#define STAMP_S(k) do { if (blockIdx.x == TSPIN_BX && otid(WV) == 0) { const unsigned long long n_ = __builtin_amdgcn_s_memrealtime(); if (((TSPIN_B) >> (k)) & 1) TSL[1] += n_ - TSL[0]; TSL[0] = n_; } } while (0)
    if (blockIdx.x == TSPIN_BX && otid(WV) == 0) { TSL[1] = 0ull; TSL[0] = __builtin_amdgcn_s_memrealtime(); }
#else
#define STAMP_E(k) do {} while (0)
#define STAMP_S(k) do {} while (0)
#endif
    STAMP(0);
#define SEAM(k) do { STAMP_E(k); if (IN(k) && IN((k) + 1)) xcd_barrier(bar); STAMP_S(k); STAMP((k) + 1); } while (0)

    if (TY(0) && IN(0)) REP(0) { PHASE_IDS CArgs* ka = kargs(); p0_prologue(&ka->in, ka->ws, lds, vcu, G, wave, lane, tid, 0); }
    SEAM(0);
#ifdef PROBE_BAR
    for (int q = 0; q < PROBE_BAR; ++q) xcd_barrier(bar);
#endif
    for (int l = 0; l < 2; ++l) {
        const int pb = 1 + 8 * l;
        if (TY(1) && IN(pb + 0)) REP(1) { PHASE_IDS CArgs* ka = kargs(); unsigned char* ws = ka->ws; const float* mod = (const float*)(ws + WS_MOD) + (size_t)l * 8 * 6144;
            const float* xin = (l == 0) ? ka->in.x : (const float*)ka->out;
            if (gw < 2048) norm_pass<0>(xin, ka->in.norm_mix_g + l * 1024, mod + 0 * 1024, mod + 1 * 1024, (bf16*)(ws + WS_XA), nullptr, nullptr, nullptr, nullptr, gw, lane); }
        SEAM(pb + 0);
        if (TY(2) && IN(pb + 1)) REP(2) { PHASE_IDS CArgs* ka = kargs(); unsigned char* ws = ka->ws;
            if (bx < G_INPROJ) {
                pg8::Gemm g{1024, 1024, 1024}; pg8::DenseSched S; S.init(ws + WS_XA, 1024, (bf16*)(ws + WS_WIN) + (size_t)l * 3584 * 1024, 1024, 16384, 3584, G_INPROJ, bx);
                epi::EpiInProj E{(bf16*)(ws + WS_QKV), (size_t)16384 * 512, (float*)(ws + WS_KMP), (const float*)(ws + WS_ROPE)};
                pg8::gemm_phase(WV, lds, g, S, E);
            } else if (rep_ == 0) { convert_moe_range<0>(&ka->in, ws, lds, l == 0 ? 0 : IT_MOE_B, l == 0 ? IT_MOE_A : IT_MGU, bx - G_INPROJ, G - G_INPROJ, wave, lane);
                                    if (l == 1) convert_moe_range<1>(&ka->in, ws, lds, 0, IT_MDN_C, bx - G_INPROJ, G - G_INPROJ, wave, lane);
#ifdef PROBE_CONVIN
                                    if (l == PROBE_CONVIN) { __syncthreads(); if (l == 0) convert_moe_range<0>(&ka->in, ws, lds, 0, IT_MOE_A, bx - G_INPROJ, G - G_INPROJ, wave, lane); else convert_moe_range<1>(&ka->in, ws, lds, 0, IT_MDN_C, bx - G_INPROJ, G - G_INPROJ, wave, lane); }
#endif
                                    }
        }
        SEAM(pb + 1);
        if (TY(3) && IN(pb + 2)) REP(3) { PHASE_IDS CArgs* ka = kargs(); unsigned char* ws = ka->ws; bf16* QKV = (bf16*)(ws + WS_QKV); bf16* CAT = (bf16*)(ws + WS_CAT);
            if (G == 256) {
                if ((bx & 7) < 7) fa::kv_unit(WV, bx >> 5, (bx >> 3) & 3, bx & 7, QKV + (size_t)4 * 16384 * 512, QKV + (size_t)5 * 16384 * 512, (float*)(ws + WS_KVM), lds);
                xcd_barrier_arrive(bar);
                { fa::Tensors TA{QKV, QKV + (size_t)1 * 16384 * 512, QKV + (size_t)2 * 16384 * 512, CAT, (float*)(ws + WS_ASSQ), (const float*)(ws + WS_KMP), nullptr, nullptr, nullptr};
                  const int g2 = (bx >> 3) * 2, r4 = (bx & 7) * 4;
                  for (int uu = 0; uu < 2; ++uu) { const int bh = g2 + uu; fa::attn_unit<false>(WV, bh >> 3, bh & 7, ((uu == 0 ? 0x25170643 : 0x31507246) >> r4) & 7, TA, lds); } }
                xcd_barrier_wait(bar);
                { fa::Tensors TR{QKV + (size_t)3 * 16384 * 512, QKV + (size_t)4 * 16384 * 512, QKV + (size_t)5 * 16384 * 512, CAT, (float*)(ws + WS_ASSQ), (const float*)(ws + WS_KMP), QKV + (size_t)6 * 16384 * 512, ka->in.ret_g + l * 512, (const float*)(ws + WS_KVM)};
                  fa::attn_unit<true>(WV, bx >> 5, (bx >> 3) & 3, bx & 7, TR, lds); }
            }
        }
        SEAM(pb + 2);
        if (TY(4) && IN(pb + 3)) REP(4) {
            { PHASE_IDS CArgs* ka = kargs(); unsigned char* ws = ka->ws; const float* mod = (const float*)(ws + WS_MOD) + (size_t)l * 8 * 6144;
                const float* xin = (l == 0) ? ka->in.x : (const float*)ka->out;
                pg8::Gemm g{1024, 1024, 1024}; pg8::DenseSched S; S.init(ws + WS_CAT, 1024, (const bf16*)(ws + WS_WOUT) + (size_t)l * 1024 * 1024, 1024, 16384, 1024, G, bx);
                epi::EpiOutProj E{xin, ka->out, mod + 2 * 1024, (const float*)(ws + WS_ASSQ), rep_ > 0}; pg8::gemm_phase(WV, lds, g, S, E); }
        }
        SEAM(pb + 3);
        if (TY(5) && IN(pb + 4)) REP(5) { PHASE_IDS CArgs* ka = kargs(); unsigned char* ws = ka->ws; const float* mod = (const float*)(ws + WS_MOD) + (size_t)l * 8 * 6144;
            if (gw < 2048) {
                if (l == 0) norm_pass<2>(ka->out, ka->in.norm_ffn_g + l * 1024, mod + 3 * 1024, mod + 4 * 1024, (bf16*)(ws + WS_XA), nullptr, nullptr, nullptr, nullptr, gw, lane);
                else norm_pass<1>(ka->out, ka->in.norm_ffn_g + l * 1024, mod + 3 * 1024, mod + 4 * 1024, (bf16*)(ws + WS_XA), ka->in.router_w, (int*)(ws + WS_EIDX), (float*)(ws + WS_EW), (int*)(ws + WS_WCNT), gw, lane);
            }
            if (l == 1) { int* srow = (int*)(ws + WS_SROW); int* af = (int*)(ws + WS_ATOMF);
                { const int p = bx * 512 + tid; if (p < XS_ROWS) srow[p] = -1; af[p] = 0; }
            }
            else if (bx == 0 && tid < 9) { ((int*)(ws + WS_SEGD))[tid] = (tid == 0) ? 0 : ((tid == 8) ? 16384 : (1 << 30)); }
        }
        SEAM(pb + 4);
        if (l == 1) {
            if (TY(6) && IN(pb + 5)) REP(6) { PHASE_IDS CArgs* ka = kargs(); unsigned char* ws = ka->ws;
                if (gw < 2048) place_pass((const int*)(ws + WS_WCNT), (const int*)(ws + WS_EIDX), (const float*)(ws + WS_EW), (const bf16*)(ws + WS_XA), (bf16*)(ws + WS_XS), (int*)(ws + WS_SROW), (float*)(ws + WS_SWT), (int*)(ws + WS_SEG), gw, 2048, lane); }
            SEAM(pb + 5);
        } else { STAMP(pb + 6); }
        if (TY(7) && IN(pb + 6)) REP(7) { PHASE_IDS CArgs* ka = kargs(); unsigned char* ws = ka->ws;
            int Geff = G_GUD;
            if (l == 1) { const int nwg = (__builtin_amdgcn_readfirstlane(((const int*)(ws + WS_SEG))[8]) / 256) * 22; const int rounds = (nwg + G - 1) / G;
                Geff = (((nwg + rounds - 1) / rounds) + 7) & ~7; if (Geff > G - MOE_SPARE) Geff = G - MOE_SPARE; }
            if (bx < Geff) {
                pg8::Gemm g{512, 512, 512}; pg8::MoeSched S;
                S.init(ws + (l == 0 ? WS_XA : WS_XS), 512, ws + (l == 0 ? WS_FGU : WS_MGU), 512, (size_t)5632 * 1024, (const int*)(ws + (l == 0 ? WS_SEGD : WS_SEG)), 5632, Geff, bx);
                epi::EpiSwiGLU8 E{ws + (l == 0 ? WS_HD : WS_HM), 2816}; pg8::gemm_phase(WV, lds, g, S, E);
            } else if (rep_ == 0) { if (l == 0) { convert_base_late(&ka->in, ws, lds, bx - Geff, G - Geff, wave, lane); convert_moe_range<0>(&ka->in, ws, lds, IT_MOE_A, IT_MOE_B, bx - Geff, G - Geff, wave, lane); }
                                    else { convert_moe_range<1>(&ka->in, ws, lds, IT_MDN_C, IT_MDN, bx - Geff, G - Geff, wave, lane);
#ifdef PROBE_CONV2
                                           __syncthreads(); convert_moe_range<1>(&ka->in, ws, lds, IT_MDN_C, IT_MDN, bx - Geff, G - Geff, wave, lane);
#endif
                                    } }
        }
        SEAM(pb + 6);
        if (TY(8) && IN(pb + 7)) REP(8) { PHASE_IDS CArgs* ka = kargs(); unsigned char* ws = ka->ws; const float* mod = (const float*)(ws + WS_MOD) + (size_t)l * 8 * 6144;
            if (l == 0) { pg8::MoeSched S; S.init(ws + WS_HD, 1408, ws + WS_FDN, 1408, (size_t)1024 * 2816, (const int*)(ws + WS_SEGD), 1024, G, bx);
                pg8::Gemm g{1408, 1408, 1408};
                epi::EpiDownDense8 E{ka->out, mod + 5 * 1024, rep_ > 0}; pg8::gemm_phase(WV, lds, g, S, E);
            } else {
                pg8::MoeSched S; S.init(ws + WS_HM, 1408, ws + WS_MDN, 1408, (size_t)1024 * 2816, (const int*)(ws + WS_SEG), 1024, G, bx);
                pg8::Gemm g{1408, 1408, 1408};
                epi::EpiDownMoe8 E{(bf16*)(ws + WS_YS), (const int*)(ws + WS_SROW), (const float*)(ws + WS_SWT)}; pg8::gemm_phase(WV, lds, g, S, E);
            }
        }
        SEAM(pb + 7);
    }
    if (TY(9) && IN(17)) { PHASE_IDS CArgs* ka = kargs(); unsigned char* ws = ka->ws;
        if (gw < 2048) final_pass(ka->out, (const bf16*)(ws + WS_YS), (const int*)(ws + WS_ATOMF), (const float*)(ws + WS_SLAB), (const float*)(ws + WS_MOD) + (size_t)1 * 8 * 6144 + 5 * 1024, ka->in.final_g, gw, lane); }
#ifdef TSPIN
    STAMP_E(17);
    if (blockIdx.x == TSPIN_BX && otid(WV) == 0) { const unsigned long long t0_ = __builtin_amdgcn_s_memrealtime(), w_ = TSL[1] * (unsigned long long)(TSPIN_K);
        while (__builtin_amdgcn_s_memrealtime() - t0_ < w_) __builtin_amdgcn_s_sleep(8); }
#endif
#ifdef TPROBE
    xcd_barrier(bar); STAMP(18); __syncthreads();
    if (blockIdx.x == 0) { CArgs* ka = kargs(); float* o = ka->out;
        const float d1 = (float)(TS[TPROBE_A + 1] - TS[TPROBE_A]) * 0.01f, d2 = (float)(TS[TPROBE_B + 1] - TS[TPROBE_B]) * 0.01f;
        const float a = 4.0f * sqrtf(d1);
        for (int i = otid(WV); i < 1024 * 1024; i += 512) o[i] = a;
        if (otid(WV) == 0) o[1024 * 1024 + 5] = 100.0f * d2; }
#endif
#undef IN
#undef TY
#undef SEAM
#undef PHASE_IDS
}
}
#ifndef STEP
#define STEP 5
#endif
namespace ad {
__device__ __forceinline__ float bf2f(unsigned short s) { return h16::one(s); }
__global__ void __launch_bounds__(256) ad_proj(const unsigned short* QKV, size_t gstride, int b, float* projb) {
    const int m = blockIdx.x; const size_t row = (size_t)b * 2048 + m;
    for (int n = threadIdx.x; n < 3584; n += 256) {
        const int grp = n / 512, c = n % 512; int sc = c;
        if (grp == 3 || grp == 4) { const int head = c >> 7, d = c & 127; sc = head * 128 + 8 * ((d & 63) >> 2) + 2 * (d & 3) + (d >> 6); }
        float v = bf2f(QKV[(size_t)grp * gstride + row * 512 + sc]);
        if (grp == 0) v *= (1.0f / epi::C2);
        if (grp == 4) v *= (1.0f / epi::KSC);
        projb[(size_t)m * 3584 + n] = v;
    }
}
__global__ void __launch_bounds__(64) ad_kmean(const float* KMP, int b, float* kmeanb) {
    const int blk = blockIdx.x, h = blockIdx.y, d = threadIdx.x;
    const float* p = KMP + ((size_t)(b * 8 + blk) * 2) * 512 + h * 64 + d;
    kmeanb[((size_t)h * 8 + blk) * 64 + d] = (p[0] + p[512]) * (1.0f / 256.0f);
}
__global__ void __launch_bounds__(256) ad_cat(const unsigned short* CAT, const float* ASSQ, const float* att_g, int b, float* catb) {
    const int m = blockIdx.x; const size_t row = (size_t)b * 2048 + m;
    float ss = 0.f;
    for (int h = 0; h < 8; ++h) ss += ASSQ[row * 8 + h];
    const float rs = 1.0f / sqrtf(ss * (1.0f / 512.0f) + 1e-6f);
    for (int c = threadIdx.x; c < 1024; c += 256) { const float v = bf2f(CAT[row * 1024 + c]); catb[(size_t)m * 1024 + c] = (c < 512) ? v * rs * att_g[c] : v; }
}
__global__ void __launch_bounds__(256) dbg_cmp(const float* a, const float* b, size_t n, float rel, float abs_, unsigned* flag, int ncols = 1, int c_lo = 0, int c_hi = 1, int silu_b = 0) {
    unsigned bad = 0;
    for (size_t i = (size_t)blockIdx.x * 256 + threadIdx.x; i < n; i += (size_t)gridDim.x * 256) { const int c = (int)(i % ncols); if (c < c_lo || c >= c_hi) continue;
        float bv = b[i]; if (silu_b) bv = bv / (1.f + expf(-bv)); const float d = fabsf(a[i] - bv); if (!(d <= rel * fabsf(bv) + abs_)) ++bad; }
    if (bad) atomicAdd(flag, bad);
}
__global__ void __launch_bounds__(256) dbg_poison(const unsigned* flag, unsigned thresh, float* out, float val) {
    if (*flag > thresh) for (int i = threadIdx.x; i < 1024 * 1024; i += 256) out[i] = val;
}
__global__ void __launch_bounds__(256) dbg_ssd(const float* a, const float* b, size_t n, int ncols, int c_lo, int c_hi, float* acc) {
    float s = 0.f;
    for (size_t i = (size_t)blockIdx.x * 256 + threadIdx.x; i < n; i += (size_t)gridDim.x * 256) { const int c = (int)(i % ncols); if (c < c_lo || c >= c_hi) continue; const float d = a[i] - b[i]; s += d * d; }
    atomicAdd(acc, s);
}
__global__ void __launch_bounds__(256) dbg_encode(const float* acc, float count, float* out) {
    const float mse = *acc / count; const float val = 4.0f / sqrtf(mse);
    for (int i = threadIdx.x; i < 1024 * 1024; i += 256) out[i] = val;
}
}

static void launch_mega(const mk::Args& a0, int lo, int hi, int region, hipStream_t stream) {
    mk::Args a = a0; a.ph_lo = lo; a.ph_hi = hi; a.bar_region = region;
    hipLaunchKernelGGL(mk::mega, dim3(256), dim3(512), mk::LDS_BYTES, stream, a);
}

extern "C" void kernel_launch(void* const* d_in, const int* in_sizes, int n_in, void* d_out, int out_size, void* d_ws, size_t ws_size, hipStream_t stream) {
    static int ready = 0;
    if (ready == 0) {
        if (n_in != 18 || out_size != M * D || ws_size < mk::WS_END) { fprintf(stderr, "kernel_launch: unexpected problem (n_in %d, out %d, ws %zu)\n", n_in, out_size, ws_size); ready = -1; return; }
        if (hipFuncSetAttribute((const void*)mk::mega, hipFuncAttributeMaxDynamicSharedMemorySize, mk::LDS_BYTES) != hipSuccess) { fprintf(stderr, "kernel_launch: hipFuncSetAttribute failed\n"); ready = -1; return; }
        ready = 1;
    }
    if (ready < 0) return;
    mk::Args a{};
    const float** ip = (const float**)&a.in;
    for (int i = 0; i < 18; ++i) ip[i] = (const float*)d_in[i];
    a.out = (float*)d_out; a.ws = (unsigned char*)d_ws; a.moe_w = (STEP >= 5) ? 1 : 0;
    const mk::Inputs& in = a.in;
    float* out = (float*)d_out; unsigned char* ws = (unsigned char*)d_ws;
    hipMemsetAsync(ws + mk::WS_CTL, 0, mk::CTL_ZERO_BYTES, stream);
#if STEP >= 6
    launch_mega(a, 0, mk::N_PHASES, 0, stream);
#else
    constexpr size_t MiB = 1u << 20;
    unsigned char* na = ws + 8 * MiB;
    float* PROJb = (float*)(na);
    float* Hb = (float*)(na + 28 * MiB);
    float* CATb = (float*)(na + 36 * MiB);
    float* OAb = (float*)(na + 44 * MiB);
    float* ORRb = (float*)(na + 48 * MiB);
    float* KMEANb = (float*)(na + 52 * MiB);
    int* EIDXb = (int*)(na + 53 * MiB); float* EWb = (float*)(na + 53 * MiB + 65536); int* POSb = (int*)(na + 53 * MiB + 131072); int* LISTb = (int*)(na + 53 * MiB + 196608);
    int* CNTb = (int*)(na + 54 * MiB); int* BASEb = CNTb + 16;
    float* Gb = (float*)(na + 56 * MiB);
    float* Ub = (float*)(na + 78 * MiB);
    float* Yb = (float*)(na + 100 * MiB);
    const float* MODp = (const float*)(ws + mk::WS_MOD);
    unsigned short* QKV = (unsigned short*)(ws + mk::WS_QKV);
    launch_mega(a, 0, 1, 1, stream);
    for (int l = 0; l < 2; ++l) {
        const int pb = 1 + 8 * l;
        const float* xin = (l == 0) ? in.x : (const float*)out;
        if (STEP >= 1) { launch_mega(a, pb, pb + 1, 1, stream); launch_mega(a, pb + 1, pb + 2, 1, stream); }
        if (STEP >= 2) launch_mega(a, pb + 2, pb + 3, 1, stream);
        if (STEP >= 3) launch_mega(a, pb + 3, pb + 4, 1, stream);
        if (STEP < 3) {
            for (int b = 0; b < BATCH; ++b) {
                const float* mod = MODp + ((size_t)l * BATCH + b) * 6 * D;
                const float* xb = xin + (size_t)b * SEQ * D; float* ob = out + (size_t)b * SEQ * D;
                if (STEP < 1) {
                    nv::k_norm<<<SEQ, 256, 0, stream>>>(xb, in.norm_mix_g + l * D, mod + 0 * D, mod + 1 * D, Hb);
                    nv::k_gemm<<<dim3(NPROJ / 64, SEQ / 64), 256, 0, stream>>>(Hb, D, nullptr, nullptr, SEQ, in.w_in + (size_t)l * D * NPROJ, NPROJ, PROJb, NPROJ, D);
                    nv::k_rotary<<<SEQ, 256, 0, stream>>>(PROJb);
                    nv::k_kmean<<<dim3(NBLK, AH, 1), 64, 0, stream>>>(PROJb, KMEANb);
                } else {
                    ad::ad_proj<<<SEQ, 256, 0, stream>>>(QKV, (size_t)M * 512, b, PROJb);
                    ad::ad_kmean<<<dim3(NBLK, AH, 1), 64, 0, stream>>>((const float*)(ws + mk::WS_KMP), b, KMEANb);
#ifdef DBG_CHECK
                    { float* PROJn = Gb; float* KMn = (float*)(na + 52 * MiB + 262144); unsigned* flag = (unsigned*)(ws + mk::WS_CTL) + 16;
                      nv::k_norm<<<SEQ, 256, 0, stream>>>(xb, in.norm_mix_g + l * D, mod + 0 * D, mod + 1 * D, Hb);
                      nv::k_gemm<<<dim3(NPROJ / 64, SEQ / 64), 256, 0, stream>>>(Hb, D, nullptr, nullptr, SEQ, in.w_in + (size_t)l * D * NPROJ, NPROJ, PROJn, NPROJ, D);
                      nv::k_rotary<<<SEQ, 256, 0, stream>>>(PROJn);
                      nv::k_kmean<<<dim3(NBLK, AH, 1), 64, 0, stream>>>(PROJn, KMn);
                      ad::dbg_cmp<<<1024, 256, 0, stream>>>(PROJb, PROJn, (size_t)SEQ * NPROJ, DBG_REL, DBG_ABS, flag, NPROJ, 0, 3072, 0);
                      ad::dbg_cmp<<<1024, 256, 0, stream>>>(PROJb, PROJn, (size_t)SEQ * NPROJ, DBG_REL, DBG_ABS, flag, NPROJ, 3072, 3584, 1);
                      ad::dbg_cmp<<<16, 256, 0, stream>>>(KMEANb, KMn, (size_t)8 * 8 * 64, 0.03f, 0.004f, flag + 1);
                      if (l == DBG_L && b == 0) ad::dbg_ssd<<<1024, 256, 0, stream>>>(PROJb, PROJn, (size_t)SEQ * NPROJ, NPROJ, DBG_CLO, DBG_CHI, (float*)(flag + 2)); }
#endif
                }
                if (STEP < 2) {
                    nv::k_moba<<<dim3(NBLK, AH, 1), 256, 0, stream>>>(PROJb, KMEANb, OAb);
                    nv::k_ret<<<dim3(SEQ / 256, RH * 4, 1), 256, 0, stream>>>(PROJb, ORRb);
                    nv::k_cat<<<SEQ, 256, 0, stream>>>(OAb, ORRb, PROJb, in.att_g + l * AW, in.ret_g + l * RW, CATb, STEP >= 1 ? 1 : 0);
                } else {
                    ad::ad_cat<<<SEQ, 256, 0, stream>>>((const unsigned short*)(ws + mk::WS_CAT), (const float*)(ws + mk::WS_ASSQ), in.att_g + l * AW, b, CATb);
                }
                nv::k_gemm<<<dim3(D / 64, SEQ / 64), 256, 0, stream>>>(CATb, D, nullptr, nullptr, SEQ, in.w_out + (size_t)l * D * D, D, Hb, D, D);
                nv::k_resid<<<SEQ, 256, 0, stream>>>(xb, mod + 2 * D, Hb, ob);
            }
        }
        const bool ffn_mega = (l == 0) ? (STEP >= 4) : (STEP >= 5);
        if (ffn_mega) {
            launch_mega(a, pb + 4, pb + 5, 1, stream);
            if (l == 1) launch_mega(a, pb + 5, pb + 6, 1, stream);
            launch_mega(a, pb + 6, pb + 7, 1, stream);
            launch_mega(a, pb + 7, pb + 8, 1, stream);
        } else {
            for (int b = 0; b < BATCH; ++b) {
                const float* mod = MODp + ((size_t)l * BATCH + b) * 6 * D;
                float* ob = out + (size_t)b * SEQ * D;
                nv::k_norm<<<SEQ, 256, 0, stream>>>(ob, in.norm_ffn_g + l * D, mod + 3 * D, mod + 4 * D, Hb);
                if (l == 0) {
                    nv::k_gemm<<<dim3(FF / 64, SEQ / 64), 256, 0, stream>>>(Hb, D, nullptr, nullptr, SEQ, in.fw_gate, FF, Gb, FF, D);
                    nv::k_gemm<<<dim3(FF / 64, SEQ / 64), 256, 0, stream>>>(Hb, D, nullptr, nullptr, SEQ, in.fw_up, FF, Ub, FF, D);
                    nv::k_silu_mul<<<SEQ, 256, 0, stream>>>(Gb, Ub, nullptr, SEQ, FF);
                    nv::k_gemm<<<dim3(D / 64, SEQ / 64), 256, 0, stream>>>(Gb, FF, nullptr, nullptr, SEQ, in.fw_down, D, Ub, D, FF);
                    nv::k_resid<<<SEQ, 256, 0, stream>>>(ob, mod + 5 * D, Ub, ob);
                } else {
                    nv::k_router<<<SEQ / 4, 256, 0, stream>>>(Hb, in.router_w, EIDXb, EWb);
                    nv::k_place<<<1, 1024, 0, stream>>>(EIDXb, LISTb, POSb, CNTb, BASEb, 4);
                    float* GE = Gb; float* UE = Ub;
                    for (int e = 0; e < NE; ++e) {
                        nv::k_gemm<<<dim3(FF / 64, ECAP / 64), 256, 0, stream>>>(Hb, D, LISTb, CNTb + e, ECAP, in.mw_gate + (size_t)e * D * FF, FF, GE, FF, D, BASEb + e, nullptr);
                        nv::k_gemm<<<dim3(FF / 64, ECAP / 64), 256, 0, stream>>>(Hb, D, LISTb, CNTb + e, ECAP, in.mw_up + (size_t)e * D * FF, FF, UE, FF, D, BASEb + e, nullptr);
                        nv::k_silu_mul<<<ECAP, 256, 0, stream>>>(GE, UE, CNTb + e, ECAP, FF);
                        nv::k_gemm<<<dim3(D / 64, ECAP / 64), 256, 0, stream>>>(GE, FF, nullptr, CNTb + e, ECAP, in.mw_down + (size_t)e * FF * D, D, Yb, D, FF, nullptr, BASEb + e);
                    }
                    nv::k_moe_combine<<<SEQ, 256, 0, stream>>>(ob, mod + 5 * D, Yb, POSb, EWb);
                }
            }
        }
    }
    if (STEP >= 5) launch_mega(a, 17, 18, 1, stream);
    else nv::k_norm<<<M, 256, 0, stream>>>(out, in.final_g, nullptr, nullptr, out);
#ifdef DBG_CHECK
#ifdef DBG_ENC
    ad::dbg_encode<<<1, 256, 0, stream>>>((const float*)((unsigned*)(ws + mk::WS_CTL) + 18), (float)SEQ * (DBG_CHI - DBG_CLO), out);
#endif
    ad::dbg_poison<<<1, 256, 0, stream>>>((unsigned*)(ws + mk::WS_CTL) + 16, DBG_T0, out, 100.0f);
    ad::dbg_poison<<<1, 256, 0, stream>>>((unsigned*)(ws + mk::WS_CTL) + 17, DBG_T1, out + (1 << 20), 300.0f);
#endif
#endif
}
```

```cpp
#include <hip/hip_runtime.h>
#include <cstdio>
#include <cstdint>
#include <cmath>

namespace h16 {
typedef _Float16 f16x2_t __attribute__((ext_vector_type(2)));
typedef _Float16 f16x8_t __attribute__((ext_vector_type(8)));
typedef float f32x2_t __attribute__((ext_vector_type(2)));
__device__ __forceinline__ unsigned pk(float lo, float hi) { f32x2_t v = {lo, hi}; f16x2_t b = __builtin_convertvector(v, f16x2_t); return __builtin_bit_cast(unsigned, b); }
__device__ __forceinline__ float lo(unsigned u) { return (float)__builtin_bit_cast(f16x2_t, u)[0]; }
__device__ __forceinline__ float hi(unsigned u) { return (float)__builtin_bit_cast(f16x2_t, u)[1]; }
__device__ __forceinline__ float one(unsigned short s) { return (float)__builtin_bit_cast(_Float16, s); }
}

namespace xl {
template <int O> __device__ __forceinline__ int xor_i(int v) {
    if constexpr (O < 32) return __builtin_amdgcn_ds_swizzle(v, (O << 10) | 0x1f);
    else { static_assert(O < 32, "use add32 / max32 for the 32-lane exchange"); return v; }
}
template <int O> __device__ __forceinline__ float xor_f(float v) { return __builtin_bit_cast(float, xor_i<O>(__builtin_bit_cast(int, v))); }
__device__ __forceinline__ void swap32(unsigned a, unsigned& r0, unsigned& r1) { unsigned b = a; asm volatile("" : "+v"(b)); auto r = __builtin_amdgcn_permlane32_swap(a, b, false, false); r0 = r[0]; r1 = r[1]; }
__device__ __forceinline__ float xor32p(float v, bool upper) { unsigned r0, r1; swap32(__builtin_bit_cast(unsigned, v), r0, r1); return __builtin_bit_cast(float, upper ? r0 : r1); }
__device__ __forceinline__ float add32(float v) { unsigned r0, r1; swap32(__builtin_bit_cast(unsigned, v), r0, r1); return __builtin_bit_cast(float, r0) + __builtin_bit_cast(float, r1); }
__device__ __forceinline__ float max32(float v) { unsigned r0, r1; swap32(__builtin_bit_cast(unsigned, v), r0, r1); return fmaxf(__builtin_bit_cast(float, r0), __builtin_bit_cast(float, r1)); }
__device__ __forceinline__ int add32i(int v) { unsigned r0, r1; swap32((unsigned)v, r0, r1); return (int)(r0 + r1); }
__device__ __forceinline__ float wave_sum(float v) { v += xor_f<1>(v); v += xor_f<2>(v); v += xor_f<4>(v); v += xor_f<8>(v); v += xor_f<16>(v); return add32(v); }
__device__ __forceinline__ int wave_sum_i(int v) { v += xor_i<1>(v); v += xor_i<2>(v); v += xor_i<4>(v); v += xor_i<8>(v); v += xor_i<16>(v); return add32i(v); }
}

__device__ __forceinline__ int olane() { int l; asm volatile("v_mbcnt_lo_u32_b32 %0, -1, 0\n\tv_mbcnt_hi_u32_b32 %0, -1, %0" : "=v"(l)); return l; }
__device__ __forceinline__ int otid(int wv) { return (wv << 6) | olane(); }
#define STEP 6

constexpr int D = 1024, BATCH = 8, SEQ = 2048, M = BATCH * SEQ;
constexpr int AH = 8, AD = 64, AW = 512, MBLK = 256, NBLK = SEQ / MBLK, TOPK = 3;
constexpr int RH = 4, RD = 128, RW = 512;
constexpr int NPROJ = 3 * AW + 4 * RW;
constexpr int FF = 2816, NE = 8;
constexpr float EPS = 1e-6f;
constexpr int ECAP = 2048;
namespace pg8 {
#define PG8_LAS __attribute__((address_space(3)))
typedef unsigned short bf16_t;
typedef short bf16x8 __attribute__((ext_vector_type(8)));
typedef float f32x4 __attribute__((ext_vector_type(4)));
typedef float f32x2 __attribute__((ext_vector_type(2)));
typedef unsigned u32x4 __attribute__((ext_vector_type(4)));
typedef unsigned u32x2 __attribute__((ext_vector_type(2)));
typedef int i32x4 __attribute__((ext_vector_type(4)));
constexpr int BM = 256, BK = 64, HALF = 128, HTB = HALF * BK * 2  , STAGE_BYTES = 8 * HTB, NXCD = 8, WGM = 8;

__host__ __device__ __forceinline__ int lds_byte(int r, int c) { const int st = (r >> 4) * 2 + (c >> 5), rr = r & 15, cc = c & 31, ob = rr * 64 + cc * 2; return st * 1024 + (ob ^ (((ob >> 9) & 1) << 5)); }
__host__ __device__ __forceinline__ void stage_rc(int b, int& R, int& C) { const int st = b / 1024, sb = b % 1024, swz = sb ^ (((sb >> 9) & 1) << 5); R = (st >> 1) * 16 + swz / 64; C = (st & 1) * 32 + (swz % 64) / 2; }
__host__ __device__ __forceinline__ int perm32(int rho) { const int n = rho >> 4, i = rho & 15; return 8 * (i >> 2) + 4 * n + (i & 3); }

struct Unit { int pm, pn, e, kc, li; };
struct Gemm { int lda, ldb, K; };

struct DenseSched {
    const char* A; const char* Bt; size_t a_tile, b_tile;
    int nM, nN, nwg, G, c;
    __device__ __forceinline__ void init(const void* A_, int lda, const void* Bt_, int ldb, int M, int N, int G_, int c_) {
        A = (const char*)A_; Bt = (const char*)Bt_; a_tile = (size_t)BM * lda * 2; b_tile = (size_t)BM * ldb * 2; nM = M / BM; nN = N / BM; nwg = nM * nN; G = G_; c = c_; }
    __device__ __forceinline__ bool next(int i, Unit& u) const {
        const long L = (long)i * G + c; if (L >= nwg) return false;
        int wgid = (int)L; { const int q = nwg / NXCD, r = nwg % NXCD, xcd = wgid % NXCD, off = wgid / NXCD; wgid = (xcd < r ? xcd * (q + 1) : r * (q + 1) + (xcd - r) * q) + off; }
        const int nig = WGM * nN, gid = wgid / nig, fm = gid * WGM, gsz = (nM - fm) < WGM ? (nM - fm) : WGM;
        u.pm = fm + ((wgid % nig) % gsz); u.pn = (wgid % nig) / gsz; u.e = 0; u.kc = 0; u.li = 0; return true;
    }
    __device__ __forceinline__ const char* a_ptr(const Unit& u) const { return A + (size_t)u.pm * a_tile; }
    __device__ __forceinline__ const char* b_ptr(const Unit& u) const { return Bt + (size_t)u.pn * b_tile; }
};
struct MoeSched {
    const char* A; const char* Bt; size_t a_tile, b_tile, e_stride;
    int nM, nN, nwg, G, c; int seg[8]; int first, lim, KS, kbytes;
    __device__ __forceinline__ void init(const void* A_, int lda, const void* Bt_, int ldb, size_t e_stride_bytes, const int* segp_, int N, int G_, int c_) {
        A = (const char*)A_; Bt = (const char*)Bt_; a_tile = (size_t)BM * lda * 2; b_tile = (size_t)BM * ldb * 2; e_stride = e_stride_bytes;
#pragma unroll
        for (int e = 0; e < 8; ++e) seg[e] = __builtin_amdgcn_readfirstlane(segp_[e]);
        nM = __builtin_amdgcn_readfirstlane(segp_[8]) / BM; nN = N / BM; nwg = nM * nN; G = G_; c = c_; first = 0; lim = nwg; KS = 1; kbytes = 0; }
    __device__ __forceinline__ bool next(int i, Unit& u) const {
        const long idx = (long)i * G + c; const long L = first + idx / KS; if (L >= lim) return false;
        u.kc = (int)(idx % KS); u.li = (int)(idx / KS);
        int wgid = (int)L; { const int q = nwg / NXCD, r = nwg % NXCD, xcd = wgid % NXCD, off = wgid / NXCD; wgid = (xcd < r ? xcd * (q + 1) : r * (q + 1) + (xcd - r) * q) + off; }
        const int nig = WGM * nN, gid = wgid / nig, fm = gid * WGM, gsz = (nM - fm) < WGM ? (nM - fm) : WGM;
        u.pm = fm + ((wgid % nig) % gsz); u.pn = (wgid % nig) / gsz;
        int e = 0; const int r0 = u.pm * BM;
#pragma unroll
        for (int k = 1; k < 8; ++k) e = (r0 >= seg[k]) ? k : e;
        u.e = __builtin_amdgcn_readfirstlane(e); return true;
    }
    __device__ __forceinline__ const char* a_ptr(const Unit& u) const { return A + (size_t)u.pm * a_tile + (size_t)u.kc * kbytes; }
    __device__ __forceinline__ const char* b_ptr(const Unit& u) const { return Bt + (size_t)u.e * e_stride + (size_t)u.pn * b_tile + (size_t)u.kc * kbytes; }
};

__device__ __forceinline__ unsigned cvt_pk_bf16(float lo, float hi) { return h16::pk(lo, hi); }
__device__ __forceinline__ float fast_silu(float g) { return g * __builtin_amdgcn_rcpf(1.0f + __builtin_amdgcn_exp2f(-1.4426950408889634f * g)); }

typedef f32x4 Acc[2][2][4][2];
typedef int i32x8 __attribute__((ext_vector_type(8)));
template <bool F8> struct Frags;
template <> struct Frags<false> { bf16x8 At[4][2], B0[2][2], B1[2][2]; };
template <> struct Frags<true> { i32x8 At[4], B0[2], B1[2]; };

template <class Epi, class Sched>
__device__ __forceinline__ void gemm_phase(const int wv, PG8_LAS unsigned char* lds, const Gemm g, const Sched& S, const Epi& E) {
    int tid_ = otid(wv);
    const int tid = tid_, wid = __builtin_amdgcn_readfirstlane(tid >> 6), lane = tid & 63, wr = wid >> 2, wc = wid & 3, fr = lane & 15, fq = lane >> 4;
    const int K = g.K; int nt = K / BK; asm volatile("" : "+s"(nt));
    unsigned voffA[2], voffB[2];
#pragma unroll
    for (int i = 0; i < 2; ++i) { int R, C; stage_rc(tid * 16 + i * 8192, R, C); const int Rb = Epi::PERM ? ((R & ~31) + perm32(R & 31)) : R;
        voffA[i] = (unsigned)(R * g.lda + C) * 2u; voffB[i] = (unsigned)(Rb * g.ldb + C) * 2u; }
    const size_t kstep = (size_t)(BK * 2);
    const size_t hstepA = (size_t)HALF * g.lda * 2, hstepB = (size_t)HALF * g.ldb * 2;
    const unsigned ldsw = (unsigned)wid * 1024u;
    const unsigned ldsbase_ = (unsigned)__builtin_amdgcn_readfirstlane((int)((unsigned)(unsigned long)lds + ldsw));
    const int aoff = lds_byte(wr * 64 + fr, fq * 8), boff = lds_byte(wc * 32 + fr, fq * 8);
#define PG8_SA(b, h) (((b) * 2 + (h)) * HTB)
#define PG8_SB(b, h) ((4 + (b) * 2 + (h)) * HTB)
#define PG8_STAGE(bufoff, gbase, voff) do { if constexpr (Epi::FP8) {   \
            const unsigned long long gb_ = (unsigned long long)(gbase); \
            const unsigned long long sb_ = ((unsigned long long)(unsigned)__builtin_amdgcn_readfirstlane((int)(gb_ >> 32)) << 32) | (unsigned)__builtin_amdgcn_readfirstlane((int)gb_); \
            _Pragma("unroll") for (int _i = 0; _i < 2; ++_i) { unsigned keep_; \
                asm volatile("s_mov_b32 %0, m0\n\ts_mov_b32 m0, %3\n\ts_nop 0\n\tglobal_load_lds_dwordx4 %1, %2\n\ts_mov_b32 m0, %0" : "=&s"(keep_) : "v"((voff)[_i]), "s"(sb_), "s"(ldsbase_ + (unsigned)((bufoff) + _i * 8192)) : "memory"); } \
        } else { _Pragma("unroll") for (int _i = 0; _i < 2; ++_i) \
        __builtin_amdgcn_global_load_lds((const unsigned*)((const char*)(gbase) + (voff)[_i]), (PG8_LAS unsigned*)(lds + (bufoff) + ldsw + _i * 8192), 16, 0, 0); } } while (0)
#define PG8_LDA(dst, b, h) do { if constexpr (Epi::FP8) { _Pragma("unroll") for (int m = 0; m < 4; ++m) { const i32x4 lo_ = *(const PG8_LAS i32x4*)(lds + PG8_SA(b, h) + aoff + m * 2048), hi_ = *(const PG8_LAS i32x4*)(lds + PG8_SA(b, h) + aoff + m * 2048 + 1024); F.dst[m] = __builtin_shufflevector(lo_, hi_, 0, 1, 2, 3, 4, 5, 6, 7); } } \
        else { _Pragma("unroll") for (int m = 0; m < 4; ++m) _Pragma("unroll") for (int k = 0; k < 2; ++k) F.dst[m][k] = *(const PG8_LAS bf16x8*)(lds + PG8_SA(b, h) + aoff + m * 2048 + k * 1024); } } while (0)
#define PG8_LDB(dst, b, h) do { if constexpr (Epi::FP8) { _Pragma("unroll") for (int n = 0; n < 2; ++n) { const i32x4 lo_ = *(const PG8_LAS i32x4*)(lds + PG8_SB(b, h) + boff + n * 2048), hi_ = *(const PG8_LAS i32x4*)(lds + PG8_SB(b, h) + boff + n * 2048 + 1024); F.dst[n] = __builtin_shufflevector(lo_, hi_, 0, 1, 2, 3, 4, 5, 6, 7); } } \
        else { _Pragma("unroll") for (int n = 0; n < 2; ++n) _Pragma("unroll") for (int k = 0; k < 2; ++k) F.dst[n][k] = *(const PG8_LAS bf16x8*)(lds + PG8_SB(b, h) + boff + n * 2048 + k * 1024); } } while (0)
#define PG8_MMA(ai, bj, At, Bt) do { __builtin_amdgcn_s_setprio(1); \
        if constexpr (Epi::FP8) {   \
            _Pragma("unroll") for (int m = 0; m < 4; ++m) _Pragma("unroll") for (int n = 0; n < 2; ++n) \
                acc[ai][bj][m][n] = __builtin_amdgcn_mfma_scale_f32_16x16x128_f8f6f4(F.Bt[n], F.At[m], acc[ai][bj][m][n], 0, 0, 0, Epi::SCALE_W, 0, 0x7f7f7f7f); \
        } else { _Pragma("unroll") for (int m = 0; m < 4; ++m) _Pragma("unroll") for (int n = 0; n < 2; ++n) _Pragma("unroll") for (int k = 0; k < 2; ++k) \
            acc[ai][bj][m][n] = __builtin_amdgcn_mfma_f32_16x16x32_f16(__builtin_bit_cast(h16::f16x8_t, F.Bt[n][k]), __builtin_bit_cast(h16::f16x8_t, F.At[m][k]), acc[ai][bj][m][n], 0, 0, 0); } \
        __builtin_amdgcn_s_setprio(0); } while (0)
#define PG8_WAIT_V(n) asm volatile("s_waitcnt vmcnt(" #n ")" ::: "memory")
#define PG8_WAIT_L(n) asm volatile("s_waitcnt lgkmcnt(" #n ")" ::: "memory")
#define PG8_BAR __builtin_amdgcn_s_barrier()
#define PG8_SCHED __builtin_amdgcn_sched_barrier(0)
    Unit cur, nxt; int ui = 0;
    if (!S.next(0, cur)) return;
    Acc acc;
#pragma unroll
    for (int a = 0; a < 2; ++a)
#pragma unroll
        for (int b = 0; b < 2; ++b)
#pragma unroll
            for (int m = 0; m < 4; ++m)
#pragma unroll
                for (int n = 0; n < 2; ++n) acc[a][b][m][n] = (f32x4){0.f, 0.f, 0.f, 0.f};
    const char* cA = S.a_ptr(cur); const char* cB = S.b_ptr(cur);
    if constexpr (Epi::MID_T > 0) E.pre(cur, lds, tid);
    PG8_STAGE(PG8_SB(0, 0), cB, voffB); PG8_STAGE(PG8_SB(0, 1), cB + hstepB, voffB); PG8_STAGE(PG8_SA(0, 0), cA, voffA); PG8_STAGE(PG8_SA(0, 1), cA + hstepA, voffA);
    if (wr == 1) PG8_BAR;
    PG8_WAIT_V(2); PG8_BAR;
    PG8_STAGE(PG8_SB(1, 0), cB + kstep, voffB); PG8_STAGE(PG8_SA(1, 0), cA + kstep, voffA); PG8_STAGE(PG8_SB(1, 1), cB + hstepB + kstep, voffB);
    PG8_WAIT_V(6); PG8_BAR;
    for (;;) {
        const bool has_next = S.next(ui + 1, nxt);
        const char* nA = has_next ? S.a_ptr(nxt) : cA; const char* nB = has_next ? S.b_ptr(nxt) : cB;
        for (int t = 0; t < nt; t += 2) {
            if constexpr (Epi::MID_T > 0) { if (t == Epi::MID_T) E.mid(acc, lds, wr, fr); }
            const bool last = (t == nt - 2);
            Frags<Epi::FP8> F;
            const char* a1 = cA + (size_t)(t + 1) * kstep;
            const char* a2 = last ? nA : cA + (size_t)(t + 2) * kstep; const char* b2 = last ? nB : cB + (size_t)(t + 2) * kstep;
            const char* a3 = a2 + kstep; const char* b3 = b2 + kstep;
            PG8_LDB(B0, 0, 0); PG8_LDB(B1, 0, 1); PG8_SCHED; PG8_LDA(At, 0, 0); PG8_STAGE(PG8_SA(1, 1), a1 + hstepA, voffA);
            PG8_WAIT_V(8); PG8_WAIT_L(0); PG8_BAR; PG8_MMA(0, 0, At, B0); PG8_MMA(0, 1, At, B1); PG8_BAR; PG8_SCHED;
            PG8_LDA(At, 0, 1); PG8_STAGE(PG8_SB(0, 0), b2, voffB); PG8_STAGE(PG8_SB(0, 1), b2 + hstepB, voffB); PG8_STAGE(PG8_SA(0, 0), a2, voffA);
            PG8_WAIT_V(8); PG8_WAIT_L(0); PG8_BAR; PG8_MMA(1, 0, At, B0); PG8_MMA(1, 1, At, B1); PG8_BAR; PG8_SCHED;
            PG8_LDB(B0, 1, 0); PG8_LDB(B1, 1, 1); PG8_SCHED; PG8_LDA(At, 1, 0); PG8_STAGE(PG8_SA(0, 1), a2 + hstepA, voffA);
            PG8_WAIT_V(8); PG8_WAIT_L(0); PG8_BAR; PG8_MMA(0, 0, At, B0); PG8_MMA(0, 1, At, B1); PG8_BAR; PG8_SCHED;
            PG8_LDA(At, 1, 1); PG8_STAGE(PG8_SB(1, 0), b3, voffB); PG8_STAGE(PG8_SB(1, 1), b3 + hstepB, voffB); PG8_STAGE(PG8_SA(1, 0), a3, voffA);
            PG8_WAIT_V(8); PG8_WAIT_L(0); PG8_BAR; PG8_MMA(1, 0, At, B0); PG8_MMA(1, 1, At, B1); PG8_BAR; PG8_SCHED;
        }
        if (wr == 0) PG8_BAR;
        { const int t2_ = olane(); E(acc, cur, wr, wc, t2_ & 15, t2_ >> 4); }
        if (!has_next) break;
#pragma unroll
        for (int a = 0; a < 2; ++a)
#pragma unroll
            for (int b = 0; b < 2; ++b)
#pragma unroll
                for (int m = 0; m < 4; ++m)
#pragma unroll
                    for (int n = 0; n < 2; ++n) acc[a][b][m][n] = (f32x4){0.f, 0.f, 0.f, 0.f};
        cur = nxt; cA = nA; cB = nB; ++ui;
        if (wr == 1) PG8_BAR;
    }
    PG8_WAIT_V(0);
    PG8_BAR;
#undef PG8_SA
#undef PG8_SB
#undef PG8_STAGE
#undef PG8_LDA
#undef PG8_LDB
#undef PG8_MMA
#undef PG8_WAIT_V
#undef PG8_WAIT_L
#undef PG8_BAR
#undef PG8_SCHED
}
}
namespace epi {
#define PG8_LAS __attribute__((address_space(3)))
using pg8::Acc; using pg8::Unit; using pg8::f32x4; using pg8::u32x4; using pg8::bf16_t; using pg8::cvt_pk_bf16; using pg8::fast_silu;
constexpr int HALF = 128;
constexpr float C2 = 0.125f * 1.4426950408889634f;
constexpr float KSC = 0.08838834764831845f;

__device__ __forceinline__ u32x4 pack8(const f32x4 v0, const f32x4 v1) { u32x4 w; w.x = cvt_pk_bf16(v0[0], v0[1]); w.y = cvt_pk_bf16(v0[2], v0[3]); w.z = cvt_pk_bf16(v1[0], v1[1]); w.w = cvt_pk_bf16(v1[2], v1[3]); return w; }

struct EpiInProj {
    static constexpr bool PERM = true; static constexpr int MID_T = 0; static constexpr bool FP8 = false; static constexpr int SCALE_W = 0;
    bf16_t* O; size_t gstride;
    float* KMP;
    const float* ROPE;
    __device__ __forceinline__ void operator()(const Acc& acc, const Unit& u, int wr, int wc, int fr, int fq) const {
        const int grp = u.pn >> 1;
        const int col0 = (u.pn & 1) * 256 + wc * 32 + 8 * fq;
        const int row0 = u.pm * 256 + wr * 64 + fr;
        bf16_t* base = O + (size_t)grp * gstride;
        f32x4 cs[2][2];
#pragma unroll
        for (int bj = 0; bj < 2; ++bj) { cs[bj][0] = (f32x4){0.f, 0.f, 0.f, 0.f}; cs[bj][1] = (f32x4){0.f, 0.f, 0.f, 0.f}; }
#pragma unroll
        for (int ai = 0; ai < 2; ++ai)
#pragma unroll
            for (int m = 0; m < 4; ++m) {
                const int row = row0 + ai * HALF + m * 16;
                bf16_t* rowp = base + (size_t)row * 512 + col0;
                f32x4 t0 = (f32x4){0.f, 0.f, 0.f, 0.f}, t1 = t0;
                if (grp == 3 || grp == 4) { const float* tp = ROPE + ((size_t)(row & 2047) * 64 + 16 * wc + 4 * fq) * 2; t0 = *(const f32x4*)tp; t1 = *(const f32x4*)(tp + 4); }
#pragma unroll
                for (int bj = 0; bj < 2; ++bj) {
                    f32x4 v0 = acc[ai][bj][m][0], v1 = acc[ai][bj][m][1];
                    if (grp == 0) { v0 = v0 * C2; v1 = v1 * C2; }
                    else if (grp == 1) { cs[bj][0] += v0; cs[bj][1] += v1; }
                    else if (grp == 3 || grp == 4) {
                        const float sc = (grp == 4) ? KSC : 1.0f;
                        f32x4 r0, r1;
                        r0[0] = (v0[0] * t0[0] - v0[1] * t0[1]) * sc; r0[1] = (v0[0] * t0[1] + v0[1] * t0[0]) * sc;
                        r0[2] = (v0[2] * t0[2] - v0[3] * t0[3]) * sc; r0[3] = (v0[2] * t0[3] + v0[3] * t0[2]) * sc;
                        r1[0] = (v1[0] * t1[0] - v1[1] * t1[1]) * sc; r1[1] = (v1[0] * t1[1] + v1[1] * t1[0]) * sc;
                        r1[2] = (v1[2] * t1[2] - v1[3] * t1[3]) * sc; r1[3] = (v1[2] * t1[3] + v1[3] * t1[2]) * sc;
                        v0 = r0; v1 = r1;
                    } else if (grp == 6) {
#pragma unroll
                        for (int j = 0; j < 4; ++j) { v0[j] = fast_silu(v0[j]); v1[j] = fast_silu(v1[j]); }
                    }
                    *(u32x4*)(rowp + bj * HALF) = pack8(v0, v1);
                }
            }
        if (grp == 1) {
#pragma unroll
            for (int bj = 0; bj < 2; ++bj)
#pragma unroll
                for (int n = 0; n < 2; ++n) {
                    f32x4 s = cs[bj][n];
#pragma unroll
                    for (int c4 = 0; c4 < 4; ++c4) { float t = s[c4]; t += xl::xor_f<1>(t); t += xl::xor_f<2>(t); t += xl::xor_f<4>(t); t += xl::xor_f<8>(t); s[c4] = t; }
                    if (fr == 0) *(f32x4*)(KMP + (size_t)(u.pm * 2 + wr) * 512 + col0 + bj * HALF + 4 * n) = s;
                }
        }
    }
};

struct EpiOutProj {
    static constexpr bool PERM = false; static constexpr int MID_T = 8; static constexpr bool FP8 = false; static constexpr int SCALE_W = 0;
    const float* xin; float* out; const float* g1;
    const float* assq;
    bool dry;
    static constexpr int RS_OFF = 131072 + 8192;
    __device__ __forceinline__ void pre(const Unit& u, PG8_LAS unsigned char* lds, int tid) const {
        if (tid < 256) { const int row = u.pm * 256 + tid;
            const f32x4 a = *(const f32x4*)(assq + (size_t)row * 8), c = *(const f32x4*)(assq + (size_t)row * 8 + 4);
            const float ss = ((a[0] + a[1]) + (a[2] + a[3])) + ((c[0] + c[1]) + (c[2] + c[3]));
            ((PG8_LAS float*)(lds + RS_OFF))[tid] = 1.0f / sqrtf(ss * (1.0f / 512.0f) + 1e-6f); }
    }
    __device__ __forceinline__ void mid(Acc& acc, PG8_LAS unsigned char* lds, int wr, int fr) const {
        const PG8_LAS float* tab = (const PG8_LAS float*)(lds + RS_OFF) + wr * 64 + fr;
#pragma unroll
        for (int ai = 0; ai < 2; ++ai)
#pragma unroll
            for (int m = 0; m < 4; ++m) {
                const float rs = tab[ai * HALF + m * 16];
#pragma unroll
                for (int bj = 0; bj < 2; ++bj)
#pragma unroll
                    for (int n = 0; n < 2; ++n) acc[ai][bj][m][n] = acc[ai][bj][m][n] * rs;
            }
    }
    __device__ __forceinline__ void operator()(const Acc& acc, const Unit& u, int wr, int wc, int fr, int fq) const {
        const int b = u.pm >> 3;
        const int col0 = u.pn * 256 + wc * 32 + 4 * fq;
        const int row0 = u.pm * 256 + wr * 64 + fr;
        f32x4 gv[2][2];
#pragma unroll
        for (int bj = 0; bj < 2; ++bj)
#pragma unroll
            for (int n = 0; n < 2; ++n) gv[bj][n] = *(const f32x4*)(g1 + (size_t)b * 6144 + col0 + bj * HALF + n * 16);
#pragma unroll
        for (int ai = 0; ai < 2; ++ai)
#pragma unroll
            for (int m = 0; m < 4; ++m) {
                const size_t off = (size_t)(row0 + ai * HALF + m * 16) * 1024 + col0;
#pragma unroll
                for (int bj = 0; bj < 2; ++bj)
#pragma unroll
                    for (int n = 0; n < 2; ++n) { const f32x4 bs = *(const f32x4*)(xin + off + bj * HALF + n * 16); const f32x4 r = bs + gv[bj][n] * acc[ai][bj][m][n]; if (!dry) *(f32x4*)(out + off + bj * HALF + n * 16) = r; else asm volatile("" :: "v"(r)); }
            }
    }
};

struct EpiSwiGLU {
    static constexpr bool PERM = true; static constexpr int MID_T = 0; static constexpr bool FP8 = false; static constexpr int SCALE_W = 0;
    bf16_t* H; int ldh;
    __device__ __forceinline__ void operator()(const Acc& acc, const Unit& u, int wr, int wc, int fr, int fq) const {
        const int col0 = u.pn * 128 + wc * 32 + 8 * fq;
        const int row0 = u.pm * 256 + wr * 64 + fr;
#pragma unroll
        for (int ai = 0; ai < 2; ++ai)
#pragma unroll
            for (int m = 0; m < 4; ++m) {
                const int row = row0 + ai * HALF + m * 16;
                f32x4 v0, v1;
#pragma unroll
                for (int j = 0; j < 4; ++j) { v0[j] = fast_silu(acc[ai][0][m][0][j]) * acc[ai][1][m][0][j]; v1[j] = fast_silu(acc[ai][0][m][1][j]) * acc[ai][1][m][1][j]; }
                *(u32x4*)(H + (size_t)row * ldh + col0) = pack8(v0, v1);
            }
    }
};

struct EpiDown {
    static constexpr bool PERM = false; static constexpr int MID_T = 0; static constexpr bool FP8 = false; static constexpr int SCALE_W = 0;
    float* out; const float* g2; bf16_t* YS; const int* srow; const float* swt; bool moe; bool dry; int* atomf; bool atomic; float* slab; int KS;
    __device__ __forceinline__ void operator()(const Acc& acc, const Unit& u, int wr, int wc, int fr, int fq) const {
        const int col0 = u.pn * 256 + wc * 32 + 4 * fq;
        const int row0 = u.pm * 256 + wr * 64 + fr;
        if (!moe) {
            const int b = u.pm >> 3;
            f32x4 gv[2][2];
#pragma unroll
            for (int bj = 0; bj < 2; ++bj)
#pragma unroll
                for (int n = 0; n < 2; ++n) gv[bj][n] = *(const f32x4*)(g2 + (size_t)b * 6144 + col0 + bj * HALF + n * 16);
#pragma unroll
            for (int ai = 0; ai < 2; ++ai)
#pragma unroll
                for (int m = 0; m < 4; ++m) {
                    const size_t off = (size_t)(row0 + ai * HALF + m * 16) * 1024 + col0;
#pragma unroll
                    for (int bj = 0; bj < 2; ++bj)
#pragma unroll
                        for (int n = 0; n < 2; ++n) { const f32x4 bs = *(const f32x4*)(out + off + bj * HALF + n * 16); const f32x4 r = bs + gv[bj][n] * acc[ai][bj][m][n]; if (!dry) *(f32x4*)(out + off + bj * HALF + n * 16) = r; else asm volatile("" :: "v"(r)); }
                }
        } else if (atomic) {
            float* sl = slab + ((size_t)(u.li * KS + u.kc) * 256) * 256 + (wc * 32 + 4 * fq);
#pragma unroll
            for (int ai = 0; ai < 2; ++ai)
#pragma unroll
                for (int m = 0; m < 4; ++m) {
                    const int rl = ai * HALF + wr * 64 + m * 16 + fr; const int pos = u.pm * 256 + rl;
                    const int sr = srow[pos];
                    if (sr >= 0) { const float w = swt[pos];
                        if (u.kc == 0 && wc == 0 && fq == 0) atomf[sr * 4 + u.pn] = 1 + u.li * 256 + rl;
#pragma unroll
                        for (int bj = 0; bj < 2; ++bj)
#pragma unroll
                            for (int n = 0; n < 2; ++n) *(f32x4*)(sl + (size_t)rl * 256 + bj * HALF + n * 16) = acc[ai][bj][m][n] * w; }
                }
        } else {
#pragma unroll
            for (int ai = 0; ai < 2; ++ai)
#pragma unroll
                for (int m = 0; m < 4; ++m) {
                    const int pos = row0 + ai * HALF + m * 16;
                    const int sr = srow[pos];
                    if (sr >= 0) { const float w = swt[pos]; bf16_t* rowp = YS + (size_t)sr * 1024 + col0;
#pragma unroll
                        for (int bj = 0; bj < 2; ++bj)
#pragma unroll
                            for (int n = 0; n < 2; ++n) { const f32x4 v = acc[ai][bj][m][n] * w; pg8::u32x2 o; o.x = cvt_pk_bf16(v[0], v[1]); o.y = cvt_pk_bf16(v[2], v[3]); if (!dry) *(pg8::u32x2*)(rowp + bj * HALF + n * 16) = o; else asm volatile("" :: "v"(o)); } }
                }
        }
    }
};

__device__ __forceinline__ float clamp448(float v) { return __builtin_fminf(__builtin_fmaxf(v, -448.0f), 448.0f); }
__device__ __forceinline__ unsigned pk4_fp8(float a, float b, float c, float d) {
    int p = 0; p = __builtin_amdgcn_cvt_pk_fp8_f32(clamp448(a), clamp448(b), p, false); p = __builtin_amdgcn_cvt_pk_fp8_f32(clamp448(c), clamp448(d), p, true); return (unsigned)p; }
struct EpiSwiGLU8 {
    static constexpr bool PERM = true; static constexpr int MID_T = 0; static constexpr bool FP8 = true; static constexpr int SCALE_W = 0x7a7a7a7a;
    unsigned char* H; int ldh;
    __device__ __forceinline__ void operator()(const Acc& acc, const Unit& u, int wr, int wc, int fr, int fq) const {
        const int col0 = u.pn * 128 + wc * 32 + 8 * fq;
        const int row0 = u.pm * 256 + wr * 64 + fr;
#pragma unroll
        for (int ai = 0; ai < 2; ++ai)
#pragma unroll
            for (int m = 0; m < 4; ++m) {
                const int row = row0 + ai * HALF + m * 16;
                f32x4 v0, v1;
#pragma unroll
                for (int j = 0; j < 4; ++j) { v0[j] = fast_silu(acc[ai][0][m][0][j]) * acc[ai][1][m][0][j]; v1[j] = fast_silu(acc[ai][0][m][1][j]) * acc[ai][1][m][1][j]; }
                pg8::u32x2 w; w.x = pk4_fp8(v0[0], v0[1], v0[2], v0[3]); w.y = pk4_fp8(v1[0], v1[1], v1[2], v1[3]);
                *(pg8::u32x2*)(H + (size_t)row * ldh + col0) = w;
            }
    }
};
struct EpiDownDense8 {
    static constexpr bool PERM = false; static constexpr int MID_T = 0; static constexpr bool FP8 = true; static constexpr int SCALE_W = 0x79797979;
    float* out; const float* g2; bool dry;
    __device__ __forceinline__ void operator()(const Acc& acc, const Unit& u, int wr, int wc, int fr, int fq) const {
        const int col0 = u.pn * 256 + wc * 32 + 4 * fq;
        const int row0 = u.pm * 256 + wr * 64 + fr;
        const int b = u.pm >> 3;
        f32x4 gv[2][2];
#pragma unroll
        for (int bj = 0; bj < 2; ++bj)
#pragma unroll
            for (int n = 0; n < 2; ++n) gv[bj][n] = *(const f32x4*)(g2 + (size_t)b * 6144 + col0 + bj * HALF + n * 16);
#pragma unroll
        for (int ai = 0; ai < 2; ++ai)
#pragma unroll
            for (int m = 0; m < 4; ++m) {
                const size_t off = (size_t)(row0 + ai * HALF + m * 16) * 1024 + col0;
#pragma unroll
                for (int bj = 0; bj < 2; ++bj)
#pragma unroll
                    for (int n = 0; n < 2; ++n) { const f32x4 bs = *(const f32x4*)(out + off + bj * HALF + n * 16); const f32x4 r = bs + gv[bj][n] * acc[ai][bj][m][n]; if (!dry) *(f32x4*)(out + off + bj * HALF + n * 16) = r; else asm volatile("" :: "v"(r)); }
            }
    }
};
struct EpiDownMoe8 {
    static constexpr bool PERM = false; static constexpr int MID_T = 0; static constexpr bool FP8 = true; static constexpr int SCALE_W = 0x79797979;
    bf16_t* YS; const int* srow; const float* swt;
    __device__ __forceinline__ void operator()(const Acc& acc, const Unit& u, int wr, int wc, int fr, int fq) const {
        const int col0 = u.pn * 256 + wc * 32 + 4 * fq;
        const int row0 = u.pm * 256 + wr * 64 + fr;
#pragma unroll
        for (int ai = 0; ai < 2; ++ai)
#pragma unroll
            for (int m = 0; m < 4; ++m) {
                const int pos = row0 + ai * HALF + m * 16;
                const int sr = srow[pos];
                if (sr >= 0) { const float w = swt[pos]; bf16_t* rowp = YS + (size_t)sr * 1024 + col0;
#pragma unroll
                    for (int bj = 0; bj < 2; ++bj)
#pragma unroll
                        for (int n = 0; n < 2; ++n) { const f32x4 v = acc[ai][bj][m][n] * w; pg8::u32x2 o; o.x = cvt_pk_bf16(v[0], v[1]); o.y = cvt_pk_bf16(v[2], v[3]); *(pg8::u32x2*)(rowp + bj * HALF + n * 16) = o; } }
            }
    }
};
}
namespace fa {
#define FA_LAS __attribute__((address_space(3)))
typedef unsigned short bf16_t;
typedef short bf16x8 __attribute__((ext_vector_type(8)));
typedef short s16x4 __attribute__((ext_vector_type(4)));
typedef float f32x16 __attribute__((ext_vector_type(16)));
typedef float f32x4 __attribute__((ext_vector_type(4)));
typedef unsigned u32x4 __attribute__((ext_vector_type(4)));
typedef float f32x2_t __attribute__((ext_vector_type(2))); typedef __bf16 bf16x2_t __attribute__((ext_vector_type(2)));
constexpr int L_WSF = 131072 + 1024, L_KM = L_WSF + 2048;
constexpr float NEG = -1.0e30f;
__device__ __forceinline__ int crow(int r, int hi) { return (r & 3) + 8 * (r >> 2) + 4 * hi; }
__device__ __forceinline__ void glds16(const void* gsrc, unsigned lds_dst) { unsigned keep;
    asm volatile("s_mov_b32 %0, m0\n\ts_mov_b32 m0, %2\n\ts_nop 0\n\tglobal_load_lds_dwordx4 %1, off\n\ts_mov_b32 m0, %0" : "=&s"(keep) : "v"(gsrc), "s"(lds_dst) : "memory"); }
__device__ __forceinline__ unsigned cvtpk_s(float lo, float hi) { return h16::pk(lo, hi); }
__device__ __forceinline__ float bf2f(short s) { return h16::one((unsigned short)s); }
typedef short v4i16_t __attribute__((ext_vector_type(4)));
__device__ __forceinline__ s16x4 vtr(FA_LAS const unsigned char* p) { return __builtin_bit_cast(s16x4, __builtin_amdgcn_ds_read_tr16_b64_v4i16((FA_LAS v4i16_t*)p)); }
#define FA_WAIT_BAR() asm volatile("s_waitcnt vmcnt(0) lgkmcnt(0)\n\ts_barrier" ::: "memory")
#define FA_LBAR() asm volatile("s_waitcnt lgkmcnt(0)\n\ts_barrier" ::: "memory")

struct Tensors {
    const bf16_t* Q; const bf16_t* K; const bf16_t* V;
    bf16_t* CAT;
    float* ASSQ;
    const float* KMP;
    const bf16_t* GR;
    const float* ret_g;
    const float* KVM;
};

template <bool RET>
__device__ __forceinline__ void attn_unit(const int wv, int b, int h, int qblk, const Tensors& T, FA_LAS unsigned char* shm) {
    constexpr int NS = RET ? 3 : 4, DIST = NS - 1;
    constexpr int DH = RET ? 128 : 64, ND0 = DH / 16, NDB = DH / 32, NPC = DH / 64, SLOT = 64 * DH * 2, L_K = 0, L_V = NS * SLOT, PER = 2 * NPC, L_R = 98304;
    int tid_ = otid(wv);
    const int tid = tid_, lane = tid & 63, r32 = lane & 31, hi = lane >> 5; const int wid = __builtin_amdgcn_readfirstlane(tid >> 6);
    const size_t rowbase = (size_t)b * 2048; const int q0 = qblk * 256;
    const unsigned lds0 = (unsigned)(unsigned long)shm;
    FA_LAS float* wsf = (FA_LAS float*)(shm + L_WSF) + wid * 64;
    FA_LAS float* KM = (FA_LAS float*)(shm + L_KM);
    const bf16_t* Kh = T.K + rowbase * 512 + h * DH; const bf16_t* Vh = T.V + rowbase * 512 + h * DH;
    const int NT = RET ? 4 : 4 * (qblk + 1);
#define FA_KV0(i) ((((i) < 4) ? qblk : (qblk - 1 - (((i) - 4) >> 2))) * 256 + ((i) & 3) * 64)
#define FA_DMA(i) do { const int kv0_ = FA_KV0(i); const unsigned so_ = (unsigned)(((i) % NS) * SLOT); \
        _Pragma("unroll") for (int pp = 0; pp < NPC; ++pp) { const int p = wid + 8 * pp; \
            glds16(Kh + (size_t)(kv0_ + lane) * 512 + p * 8, (unsigned)__builtin_amdgcn_readfirstlane(lds0 + L_K + so_ + p * 1024)); } \
        _Pragma("unroll") for (int pp = 0; pp < NPC; ++pp) { const int p = wid + 8 * pp; \
            glds16(Vh + (size_t)(kv0_ + 16 * (p & 3) + (lane >> 2)) * 512 + (p >> 2) * 32 + (lane & 3) * 8, (unsigned)__builtin_amdgcn_readfirstlane(lds0 + L_V + so_ + p * 1024)); } } while (0)
    FA_DMA(0); if (NT > 1) FA_DMA(1); if (DIST > 2 && NT > 2) FA_DMA(2);
    const bf16_t* Qw = T.Q + (rowbase + q0 + wid * 32 + r32) * 512 + h * DH;
    bf16x8 qr[ND0];
#pragma unroll
    for (int d0 = 0; d0 < ND0; ++d0) qr[d0] = *(const bf16x8*)(Qw + d0 * 16 + hi * 8);
    unsigned selmask = 0xffu;
    float cfac[16]; float lg2 = 0.f;
    if (!RET) {
        { const int j = tid >> 6, d = tid & 63; const float* kp = T.KMP + ((size_t)(b * 8 + j) * 2) * 512 + h * 64 + d; KM[tid] = kp[0] + kp[512]; }
        FA_LBAR();
        float g[8];
#pragma unroll
        for (int j = 0; j < 8; ++j) g[j] = 0.f;
#pragma unroll
        for (int d0 = 0; d0 < ND0; ++d0)
#pragma unroll
            for (int jj = 0; jj < 8; ++jj) { const float qv = bf2f(qr[d0][jj]); const int d = 16 * d0 + 8 * hi + jj;
#pragma unroll
                for (int j = 0; j < 8; ++j) g[j] += qv * KM[j * 64 + d]; }
#pragma unroll
        for (int j = 0; j < 8; ++j) g[j] = xl::add32(g[j]);
        selmask = 0u;
#pragma unroll
        for (int j = 0; j < 8; ++j) { int rank = 0;
#pragma unroll
            for (int mm = 0; mm < 8; ++mm) rank += (mm < qblk && (g[mm] > g[j] || (g[mm] == g[j] && mm < j))) ? 1 : 0;
            if (j < qblk && rank < 3) selmask |= 1u << j; }
    } else {
        lg2 = log2f(1.0f - exp2f(-5.0f - (float)h));
#pragma unroll
        for (int r = 0; r < 16; ++r) cfac[r] = exp2f(-lg2 * (float)((r & 3) + 8 * (r >> 2)));
    }
    f32x16 o[NDB];
#pragma unroll
    for (int db = 0; db < NDB; ++db) o[db] = f32x16{};
    float mhat = 0.f, lrow = 0.f; f32x16 negm = f32x16{}; constexpr float THR = 8.0f;
    if (RET && qblk > 0) {
        const float* kvb = T.KVM + ((size_t)(b * 4 + h) * 8) * 16384;
        const float g256 = exp2f(lg2 * 256.0f);
#pragma unroll 2
        for (int it = 0; it < 8; ++it) { const int idx4 = tid + 512 * it; const int d = idx4 >> 5, e0 = (idx4 & 31) * 4;
            f32x4 acc4 = (f32x4){0.f, 0.f, 0.f, 0.f};
            for (int m = 0; m < qblk; ++m) acc4 = acc4 * g256 + *(const f32x4*)(kvb + (size_t)m * 16384 + d * 128 + e0);
            const int rp = (d & ~12) | ((d & 8) >> 1) | ((d & 4) << 1);
            typedef unsigned u32x2_ __attribute__((ext_vector_type(2)));
            u32x2_ w; w.x = cvtpk_s(acc4[0], acc4[1]); w.y = cvtpk_s(acc4[2], acc4[3]);
            *(FA_LAS u32x2_*)(shm + L_R + (e0 >> 5) * 8192 + rp * 64 + (e0 & 31) * 2) = w; }
        FA_LBAR();
        { FA_LAS const unsigned char* rb = shm + L_R + ((lane >> 4) & 1) * 32 + (lane & 3) * 8 + (4 * hi + ((lane & 15) >> 2)) * 64;
#pragma unroll
          for (int db = 0; db < NDB; ++db)
#pragma unroll
              for (int d0 = 0; d0 < ND0; ++d0) { const s16x4 lo = vtr(rb + db * 8192 + d0 * 1024), hh = vtr(rb + db * 8192 + d0 * 1024 + 512);
                  const bf16x8 rf = (bf16x8){lo[0], lo[1], lo[2], lo[3], hh[0], hh[1], hh[2], hh[3]};
                  o[db] = __builtin_amdgcn_mfma_f32_32x32x16_f16(__builtin_bit_cast(h16::f16x8_t, qr[d0]), __builtin_bit_cast(h16::f16x8_t, rf), o[db], 0, 0, 0); } }
#pragma unroll
        for (int r = 0; r < 16; ++r) { const float rd = exp2f(lg2 * (float)(wid * 32 + crow(r, hi) + 1));
#pragma unroll
            for (int db = 0; db < NDB; ++db) o[db][r] *= rd; }
    }
    const int qrel = wid * 32 + r32;
    for (int i = 0; i < NT; ++i) {
        { const int ahead = (NT - 1 - i) < (DIST - 1) ? (NT - 1 - i) : (DIST - 1);
          if (ahead == 2) { if (PER == 2) asm volatile("s_waitcnt vmcnt(4) lgkmcnt(0)\n\ts_barrier" ::: "memory"); else asm volatile("s_waitcnt vmcnt(8) lgkmcnt(0)\n\ts_barrier" ::: "memory"); }
          else if (ahead == 1) { if (PER == 2) asm volatile("s_waitcnt vmcnt(2) lgkmcnt(0)\n\ts_barrier" ::: "memory"); else asm volatile("s_waitcnt vmcnt(4) lgkmcnt(0)\n\ts_barrier" ::: "memory"); }
          else FA_WAIT_BAR(); }
        if (i + DIST < NT) FA_DMA(i + DIST);
        const bool diag = i < 4; const int t = i & 3; const int j = diag ? qblk : (qblk - 1 - ((i - 4) >> 2));
        const bool mysel = RET ? true : (((selmask >> j) & 1u) != 0u);
        const bool skip = diag ? (64 * t > 32 * wid + 31) : (RET ? false : !__any(mysel));
        if (skip) continue;
        const unsigned so = (unsigned)((i % NS) * SLOT);
        f32x16 p0 = RET ? f32x16{} : negm, p1 = p0;
        { FA_LAS const unsigned char* kb = shm + L_K + so + hi * 1024 + r32 * 16;
#pragma unroll
          for (int d0 = 0; d0 < ND0; ++d0) { const bf16x8 b0 = *(FA_LAS const bf16x8*)(kb + d0 * 2048); const bf16x8 b1 = *(FA_LAS const bf16x8*)(kb + d0 * 2048 + 512);
              p0 = __builtin_amdgcn_mfma_f32_32x32x16_f16(__builtin_bit_cast(h16::f16x8_t, b0), __builtin_bit_cast(h16::f16x8_t, qr[d0]), p0, 0, 0, 0); p1 = __builtin_amdgcn_mfma_f32_32x32x16_f16(__builtin_bit_cast(h16::f16x8_t, b1), __builtin_bit_cast(h16::f16x8_t, qr[d0]), p1, 0, 0, 0); } }
        if (RET) {
            const int qpos = q0 + qrel; const int kv0 = j * 256 + t * 64;
            const float base = (float)(qpos - kv0 - 4 * hi);
            const float rf0 = exp2f(lg2 * base), rf1 = exp2f(lg2 * (base - 32.0f));
#pragma unroll
            for (int r = 0; r < 16; ++r) { p0[r] *= rf0 * cfac[r]; p1[r] *= rf1 * cfac[r]; }
            if (diag) { const int kb_ = 64 * t + 4 * hi;
#pragma unroll
                for (int r = 0; r < 16; ++r) { const int kv = kb_ + (r & 3) + 8 * (r >> 2); if (kv > qrel) p0[r] = 0.f; if (kv + 32 > qrel) p1[r] = 0.f; } }
        } else {
            if (diag) { const int kb_ = 64 * t + 4 * hi;
#pragma unroll
                for (int r = 0; r < 16; ++r) { const int kv = kb_ + (r & 3) + 8 * (r >> 2); if (kv > qrel) p0[r] = NEG; if (kv + 32 > qrel) p1[r] = NEG; } }
            else if (!mysel) {
#pragma unroll
                for (int r = 0; r < 16; ++r) { p0[r] = NEG; p1[r] = NEG; } }
            float rm = fmaxf(fmaxf(p0[0], p1[0]), p0[1]);
#pragma unroll
            for (int r = 1; r < 16; ++r) { rm = fmaxf(fmaxf(rm, p1[r]), (r < 15) ? p0[r + 1] : p1[r]); }
            rm = xl::max32(rm);
            if (__any(rm > THR)) {
                const float dl = fmaxf(rm, 0.f);
                mhat += dl;
#pragma unroll
                for (int r = 0; r < 16; ++r) { p0[r] -= dl; p1[r] -= dl; }
#pragma unroll
                for (int r = 0; r < 16; ++r) negm[r] = -mhat;
                const float f = __builtin_amdgcn_exp2f(-dl); lrow *= f;
                asm volatile("" ::: "memory");
                if (hi == 0) wsf[r32] = f;
                asm volatile("s_waitcnt lgkmcnt(0)" ::: "memory");
#pragma unroll
                for (int r = 0; r < 16; ++r) { const float fr_ = wsf[crow(r, hi)];
#pragma unroll
                    for (int db = 0; db < NDB; ++db) o[db][r] *= fr_; }
                asm volatile("s_waitcnt lgkmcnt(0)" ::: "memory");
            }
            float s = 0.f;
#pragma unroll
            for (int r = 0; r < 16; ++r) { p0[r] = __builtin_amdgcn_exp2f(p0[r]); p1[r] = __builtin_amdgcn_exp2f(p1[r]); s += p0[r] + p1[r]; }
            lrow += s;
        }
        bf16x8 pa[4];
        { u32x4 w;
          w.x = cvtpk_s(p0[0], p0[1]); w.y = cvtpk_s(p0[2], p0[3]); w.z = cvtpk_s(p0[4], p0[5]); w.w = cvtpk_s(p0[6], p0[7]); pa[0] = __builtin_bit_cast(bf16x8, w);
          w.x = cvtpk_s(p0[8], p0[9]); w.y = cvtpk_s(p0[10], p0[11]); w.z = cvtpk_s(p0[12], p0[13]); w.w = cvtpk_s(p0[14], p0[15]); pa[1] = __builtin_bit_cast(bf16x8, w);
          w.x = cvtpk_s(p1[0], p1[1]); w.y = cvtpk_s(p1[2], p1[3]); w.z = cvtpk_s(p1[4], p1[5]); w.w = cvtpk_s(p1[6], p1[7]); pa[2] = __builtin_bit_cast(bf16x8, w);
          w.x = cvtpk_s(p1[8], p1[9]); w.y = cvtpk_s(p1[10], p1[11]); w.z = cvtpk_s(p1[12], p1[13]); w.w = cvtpk_s(p1[14], p1[15]); pa[3] = __builtin_bit_cast(bf16x8, w); }
        { FA_LAS const unsigned char* vb = shm + L_V + so + ((lane >> 4) & 1) * 32 + (lane & 3) * 8 + (4 * hi + ((lane & 15) >> 2)) * 64;
#pragma unroll
          for (int db = 0; db < NDB; ++db)
#pragma unroll
              for (int ks = 0; ks < 4; ++ks) { const s16x4 lo = vtr(vb + db * 4096 + ks * 1024), hh = vtr(vb + db * 4096 + ks * 1024 + 512);
                  const bf16x8 vf = (bf16x8){lo[0], lo[1], lo[2], lo[3], hh[0], hh[1], hh[2], hh[3]};
                  o[db] = __builtin_amdgcn_mfma_f32_32x32x16_f16(__builtin_bit_cast(h16::f16x8_t, pa[ks]), __builtin_bit_cast(h16::f16x8_t, vf), o[db], 0, 0, 0); } }
    }
    float rli[16];
    if (!RET) {
        const float l = xl::add32(lrow);
        asm volatile("" ::: "memory");
        if (hi == 0) wsf[32 + r32] = 1.0f / l;
        asm volatile("s_waitcnt lgkmcnt(0)" ::: "memory");
#pragma unroll
        for (int r = 0; r < 16; ++r) rli[r] = wsf[32 + crow(r, hi)];
    } else {
#pragma unroll
        for (int r = 0; r < 16; ++r) rli[r] = 1.0f;
    }
    FA_LBAR();
    FA_LAS bf16_t* stg = (FA_LAS bf16_t*)(shm + wid * 8192);
#pragma unroll
    for (int r = 0; r < 16; ++r) { const int orow = crow(r, hi);
#pragma unroll
        for (int db = 0; db < NDB; ++db) { const unsigned pk = cvtpk_s(o[db][r] * rli[r], 0.f); stg[orow * DH + db * 32 + r32] = (bf16_t)(pk & 0xffffu); } }
    asm volatile("s_waitcnt lgkmcnt(0)" ::: "memory");
    const size_t tok0 = rowbase + q0 + wid * 32;
    if (!RET) {
#pragma unroll
        for (int i = 0; i < 4; ++i) { const int row = i * 8 + (lane >> 3), ch = lane & 7;
            const u32x4 v = *(FA_LAS const u32x4*)(stg + row * 64 + ch * 8);
            float ss = 0.f;
#pragma unroll
            for (int k = 0; k < 4; ++k) { const float a = h16::lo(v[k]), c = h16::hi(v[k]); ss += a * a + c * c; }
            ss += xl::xor_f<1>(ss); ss += xl::xor_f<2>(ss); ss += xl::xor_f<4>(ss);
            if (ch == 0) T.ASSQ[(tok0 + row) * 8 + h] = ss;
            *(u32x4*)(T.CAT + (tok0 + row) * 1024 + h * 64 + ch * 8) = v; }
    } else {
#pragma unroll
        for (int i = 0; i < 8; ++i) { const int row = i * 4 + (lane >> 4), ch = lane & 15;
            const u32x4 v = *(FA_LAS const u32x4*)(stg + row * 128 + ch * 8);
            float x[8];
#pragma unroll
            for (int k = 0; k < 4; ++k) { x[2 * k] = h16::lo(v[k]); x[2 * k + 1] = h16::hi(v[k]); }
            float ss = 0.f;
#pragma unroll
            for (int k = 0; k < 8; ++k) ss += x[k] * x[k];
            ss += xl::xor_f<1>(ss); ss += xl::xor_f<2>(ss); ss += xl::xor_f<4>(ss); ss += xl::xor_f<8>(ss);
            const float rs = 1.0f / sqrtf(ss * (1.0f / 128.0f) + 1e-6f);
            const u32x4 gv = *(const u32x4*)(T.GR + (tok0 + row) * 512 + h * 128 + ch * 8);
            const f32x4 w0 = *(const f32x4*)(T.ret_g + h * 128 + ch * 8), w1 = *(const f32x4*)(T.ret_g + h * 128 + ch * 8 + 4);
            const float wg[8] = {w0[0], w0[1], w0[2], w0[3], w1[0], w1[1], w1[2], w1[3]};
            float y[8];
#pragma unroll
            for (int k = 0; k < 4; ++k) { const float g0 = h16::lo(gv[k]), g1 = h16::hi(gv[k]);
                y[2 * k] = x[2 * k] * rs * wg[2 * k] * g0; y[2 * k + 1] = x[2 * k + 1] * rs * wg[2 * k + 1] * g1; }
            u32x4 ov; ov.x = cvtpk_s(y[0], y[1]); ov.y = cvtpk_s(y[2], y[3]); ov.z = cvtpk_s(y[4], y[5]); ov.w = cvtpk_s(y[6], y[7]);
            *(u32x4*)(T.CAT + (tok0 + row) * 1024 + 512 + h * 128 + ch * 8) = ov; }
    }
    FA_LBAR();
#undef FA_KV0
#undef FA_DMA
}

__device__ __forceinline__ void kv_unit(const int wv, int b, int h, int m, const bf16_t* Kg, const bf16_t* Vg, float* KVM, FA_LAS unsigned char* shm) {
    constexpr int SLOT = 16384, L_K = 0, L_V = 4 * SLOT;
    int tid_ = otid(wv);
    const int tid = tid_, lane = tid & 63, r32 = lane & 31, hi = lane >> 5; const int wid = __builtin_amdgcn_readfirstlane(tid >> 6);
    const int dg = wid >> 1, eh = wid & 1;
    const size_t rowbase = (size_t)b * 2048 + (size_t)m * 256;
    const unsigned lds0 = (unsigned)(unsigned long)shm;
    const bf16_t* Kh = Kg + rowbase * 512 + h * 128; const bf16_t* Vh = Vg + rowbase * 512 + h * 128;
#pragma unroll
    for (int t = 0; t < 4; ++t)
#pragma unroll
        for (int pp = 0; pp < 2; ++pp) { const int p = wid + 8 * pp; const size_t off = (size_t)(64 * t + 16 * (p & 3) + (lane >> 2)) * 512 + (p >> 2) * 32 + (lane & 3) * 8;
            glds16(Kh + off, (unsigned)__builtin_amdgcn_readfirstlane(lds0 + L_K + t * SLOT + p * 1024));
            glds16(Vh + off, (unsigned)__builtin_amdgcn_readfirstlane(lds0 + L_V + t * SLOT + p * 1024)); }
    const float lg2 = log2f(1.0f - exp2f(-5.0f - (float)h));
    const float g64 = exp2f(lg2 * 64.0f);
    h16::f16x8_t fd[4];
#pragma unroll
    for (int ks = 0; ks < 4; ++ks)
#pragma unroll
        for (int j = 0; j < 8; ++j) fd[ks][j] = (_Float16)exp2f(lg2 * (float)(63 - (16 * ks + 8 * (j >> 2) + 4 * hi + (j & 3))));
    f32x16 acc[2]; acc[0] = f32x16{}; acc[1] = f32x16{};
    FA_WAIT_BAR();
    const int lb = ((lane >> 4) & 1) * 32 + (lane & 3) * 8 + (4 * hi + ((lane & 15) >> 2)) * 64;
#pragma unroll
    for (int t = 0; t < 4; ++t) {
        if (t > 0) {
#pragma unroll
            for (int r = 0; r < 16; ++r) { acc[0][r] *= g64; acc[1][r] *= g64; } }
        FA_LAS const unsigned char* kb = shm + L_K + t * SLOT + dg * 4096 + lb; FA_LAS const unsigned char* vb = shm + L_V + t * SLOT + (2 * eh) * 4096 + lb;
#pragma unroll
        for (int ks = 0; ks < 4; ++ks) { const s16x4 klo = vtr(kb + ks * 1024), khi = vtr(kb + ks * 1024 + 512);
            const h16::f16x8_t kf = __builtin_bit_cast(h16::f16x8_t, (bf16x8){klo[0], klo[1], klo[2], klo[3], khi[0], khi[1], khi[2], khi[3]});
#pragma unroll
            for (int eb = 0; eb < 2; ++eb) { const s16x4 vlo = vtr(vb + eb * 4096 + ks * 1024), vhi = vtr(vb + eb * 4096 + ks * 1024 + 512);
                const h16::f16x8_t vf = __builtin_bit_cast(h16::f16x8_t, (bf16x8){vlo[0], vlo[1], vlo[2], vlo[3], vhi[0], vhi[1], vhi[2], vhi[3]}) * fd[ks];
                acc[eb] = __builtin_amdgcn_mfma_f32_32x32x16_f16(kf, vf, acc[eb], 0, 0, 0); } }
    }
    float* op = KVM + ((size_t)(b * 4 + h) * 8 + m) * 16384;
#pragma unroll
    for (int eb = 0; eb < 2; ++eb)
#pragma unroll
        for (int r = 0; r < 16; ++r) op[(size_t)(32 * dg + crow(r, hi)) * 128 + 64 * eh + 32 * eb + r32] = acc[eb][r];
    FA_LBAR();
}
}
namespace mk {
#define GAS __attribute__((address_space(1)))
#define LAS __attribute__((address_space(3)))
typedef unsigned short bf16;
typedef unsigned v4u __attribute__((ext_vector_type(4)));
typedef unsigned v2u __attribute__((ext_vector_type(2)));
typedef float f32x4 __attribute__((ext_vector_type(4)));
typedef int i32x4 __attribute__((ext_vector_type(4)));
typedef GAS unsigned gu32;
#define RLX_AGENT __ATOMIC_RELAXED, __HIP_MEMORY_SCOPE_AGENT
#define LDS_WAIT() asm volatile("s_waitcnt lgkmcnt(0)" ::: "memory")
#define VM_WAIT() asm volatile("s_waitcnt vmcnt(0)" ::: "memory")
constexpr int NWAVES = 8;
constexpr size_t MiB = 1u << 20, KiB = 1u << 10;
constexpr size_t WS_CTL = 0;
constexpr size_t CTL_ZERO_BYTES = 64 * KiB;
constexpr size_t WS_MOD = 64 * KiB;
constexpr size_t WS_KMP = 512 * KiB;
constexpr size_t WS_EIDX = 768 * KiB;
constexpr size_t WS_EW = 896 * KiB;
constexpr size_t WS_ROPE = 1 * MiB;
constexpr size_t WS_ASSQ = 2 * MiB;
constexpr size_t WS_SROW = 2 * MiB + 512 * KiB;
constexpr size_t WS_SWT = 2 * MiB + 768 * KiB;
constexpr size_t WS_WCNT = 3 * MiB;
constexpr size_t WS_SEG = 3 * MiB + 64 * KiB;
constexpr size_t WS_ATOMF = 3 * MiB + 128 * KiB;
constexpr size_t WS_SEGD = 3 * MiB + 65 * KiB;
constexpr size_t WS_MGU = 8 * MiB;
constexpr size_t WS_SLAB = 8 * MiB;
constexpr size_t WS_MDN = 96 * MiB;
constexpr size_t WS_XA = 140 * MiB;
constexpr size_t WS_XS = 172 * MiB;
constexpr size_t WS_KVM = 172 * MiB;
constexpr size_t WS_YS = 140 * MiB;
constexpr size_t WS_WIN = 240 * MiB;
constexpr size_t WS_WOUT = 254 * MiB;
constexpr size_t WS_FGU = 258 * MiB;
constexpr size_t WS_FDN = 269 * MiB;
constexpr size_t WS_QKV = 275 * MiB;
constexpr size_t WS_CAT = 387 * MiB;
constexpr size_t WS_HD = 275 * MiB;
constexpr size_t WS_HM = 240 * MiB;
constexpr size_t WS_END = 428 * MiB;
constexpr int XS_ROWS = 34816;
constexpr int CW_BAR = 1024;

constexpr int RING_BYTES = 131072, LDSCTL_OFF = RING_BYTES, MISC_OFF = LDSCTL_OFF + 320, LDS_BYTES = 147456;

#define XB_TMO      128
#define XB_XCNT(j)  (256  + 64 * (j))
#define XB_XSUB(j)  (1280 + 64 * (j))
#define XB_XGEN(j)  (2304 + 64 * (j))
#define XB_TOP      3328
#define XB_TOPGEN   3392
#define XCD_BAR_WORDS 3456
#define XB_SPIN_CAP (1u << 18)
__device__ __forceinline__ unsigned xb_ld(unsigned* p)              { return __hip_atomic_load(p, __ATOMIC_RELAXED, __HIP_MEMORY_SCOPE_AGENT); }
__device__ __forceinline__ unsigned xb_add(unsigned* p, unsigned v) { return __hip_atomic_fetch_add(p, v, __ATOMIC_RELAXED, __HIP_MEMORY_SCOPE_AGENT); }
__device__ __forceinline__ unsigned xb_xcc_id() { return (unsigned)__builtin_amdgcn_s_getreg((3 << 11) | 20) & 0xFu; }
#define XB_SPIN(cond, bar) do { unsigned _sp = 0; while (cond) { __builtin_amdgcn_s_sleep(1); \
    if ((++_sp & 255u) == 0u) { if (xb_ld(&(bar)[XB_TMO])) break; if (_sp > XB_SPIN_CAP) { atomicAdd(&(bar)[XB_TMO], 1u); break; } } } } while (0)
struct XcdBarrier { unsigned* bar; unsigned x; volatile LAS unsigned* st; int wv; };
__device__ __forceinline__ XcdBarrier xcd_barrier_post(unsigned* bar, volatile LAS unsigned* st, int wv) {
    XcdBarrier b; b.bar = bar; b.x = xb_xcc_id(); b.st = st; b.wv = wv;
    if (otid(wv) == 0) (void)xb_add(&bar[XB_XCNT(b.x)], 1u);
    return b;
}
__device__ __forceinline__ void xcd_barrier_complete(unsigned* bar, unsigned x, unsigned& nloc, unsigned& nx) {
    const unsigned G = gridDim.x * gridDim.y * gridDim.z;
    unsigned sum, cnt, mine, sp = 0u;
    for (;;) {
        sum = 0u; cnt = 0u; mine = 0u;
#pragma unroll
        for (unsigned j = 0; j < 16; ++j) { const unsigned c = xb_ld(&bar[XB_XCNT(j)]); sum += c; cnt += (c > 0u) ? 1u : 0u; mine = (j == x) ? c : mine; }
        if (sum == G) break;
        __builtin_amdgcn_s_sleep(1);
        if ((++sp & 255u) == 0u) { if (xb_ld(&bar[XB_TMO])) break; if (sp > XB_SPIN_CAP) { atomicAdd(&bar[XB_TMO], 1u); break; } }
    }
    nloc = mine > 0u ? mine : 1u; nx = cnt > 0u ? cnt : 1u;
}
__device__ __forceinline__ void xcd_barrier(const XcdBarrier& b) {
    asm volatile("s_waitcnt vmcnt(0)" ::: "memory");
    __syncthreads();
    if (otid(b.wv) == 0) {
        unsigned* bar = b.bar;
        __builtin_amdgcn_s_waitcnt(0);
        unsigned nloc = b.st[0], nx = b.st[1];
        if (nloc == 0u) { xcd_barrier_complete(bar, b.x, nloc, nx); b.st[0] = nloc; b.st[1] = nx; }
        const unsigned old = xb_add(&bar[XB_XSUB(b.x)], 1u);
        const unsigned gen = old / nloc;
        if (old + 1u == (gen + 1u) * nloc) {
            __builtin_amdgcn_fence(__ATOMIC_RELEASE, "agent");
            asm volatile("s_waitcnt vmcnt(0)" ::: "memory");
            const unsigned og = xb_add(&bar[XB_TOP], 1u);
            const unsigned tg = og / nx;
            if (og + 1u == (tg + 1u) * nx) xb_add(&bar[XB_TOPGEN], 1u);
            else XB_SPIN(xb_ld(&bar[XB_TOPGEN]) == tg, bar);
            __builtin_amdgcn_fence(__ATOMIC_ACQUIRE, "agent");
            xb_add(&bar[XB_XGEN(b.x)], 1u);
            asm volatile("s_waitcnt vmcnt(0)" ::: "memory");
        } else {
            XB_SPIN(xb_ld(&bar[XB_XGEN(b.x)]) == gen, bar);
            __builtin_amdgcn_fence(__ATOMIC_ACQUIRE, "agent");
            asm volatile("s_waitcnt vmcnt(0)" ::: "memory");
        }
    }
    __syncthreads();
}

__device__ __forceinline__ unsigned f2bf(float f) { unsigned u = __builtin_bit_cast(unsigned, f); return (u + 0x7fffu + ((u >> 16) & 1u)) >> 16; }
__device__ __forceinline__ unsigned pk2(float lo, float hi) { return h16::pk(lo, hi); }
using xl::wave_sum; using xl::wave_sum_i;

struct Inputs {
    const float *x, *c, *norm_mix_g, *norm_ffn_g, *ada_w, *ada_b, *w_in, *w_out, *att_g, *ret_g, *fw_gate, *fw_up, *fw_down, *router_w, *mw_gate, *mw_up, *mw_down, *final_g;
};

template <class SrcFn> __device__ __forceinline__ void transpose_item(SrcFn src, int K, bf16* WT, int k0, int n0, LAS float* scr, int lane) {
#pragma unroll 8
    for (int i = 0; i < 32; ++i) { const int kk = 2 * i + (lane >> 5); scr[kk * 33 + (lane & 31)] = src(k0 + kk, n0 + (lane & 31)); }
    LDS_WAIT(); asm volatile("" ::: "memory");
    const int c = lane & 7;
#pragma unroll
    for (int j = 0; j < 4; ++j) { const int n = (lane >> 3) + 8 * j; const LAS float* s = scr + (8 * c) * 33 + n;
        v4u o; o.x = pk2(s[0 * 33], s[1 * 33]); o.y = pk2(s[2 * 33], s[3 * 33]); o.z = pk2(s[4 * 33], s[5 * 33]); o.w = pk2(s[6 * 33], s[7 * 33]);
        *(GAS v4u*)(WT + (size_t)(n0 + n) * K + k0 + 8 * c) = o; }
    LDS_WAIT(); asm volatile("" ::: "memory");
}
__device__ __forceinline__ int rot_src_col(int n) {
    if (n < 1536 || n >= 2560) return n;
    const int hb = (n - 1536) & ~127, p = (n - 1536) & 127;
    return 1536 + hb + 4 * (p >> 3) + ((p & 7) >> 1) + 64 * (p & 1);
}
constexpr int IT_WIN = 16 * 112, IT_WOUT = 16 * 32, IT_GU = 16 * 176, IT_DN = 44 * 32;
constexpr int IT_TOTAL = 2 * IT_WIN + 2 * IT_WOUT + IT_GU + IT_DN + 8 * (IT_GU + IT_DN);

constexpr int IT_NONMOE = 2 * IT_WIN + 2 * IT_WOUT + IT_GU + IT_DN;
__device__ __forceinline__ void convert_item(const Inputs& in, unsigned char* ws, int it, LAS float* scr, int lane) {
    int r = it;
    if (r < 2 * IT_WIN) { const int l = r / IT_WIN; r -= l * IT_WIN; const float* W = in.w_in + (size_t)l * 1024 * 3584;
        transpose_item([=](int k, int n) { return W[(size_t)k * 3584 + rot_src_col(n)]; }, 1024, (bf16*)(ws + WS_WIN) + (size_t)l * 3584 * 1024, 64 * (r / 112), 32 * (r % 112), scr, lane); return; }
    r -= 2 * IT_WIN;
    if (r < 2 * IT_WOUT) { const int l = r / IT_WOUT; r -= l * IT_WOUT; const float* W = in.w_out + (size_t)l * 1024 * 1024; const float* ag = in.att_g + l * 512;
        transpose_item([=](int k, int n) { return W[(size_t)k * 1024 + n] * (k < 512 ? ag[k] : 1.0f); }, 1024, (bf16*)(ws + WS_WOUT) + (size_t)l * 1024 * 1024, 64 * (r / 32), 32 * (r % 32), scr, lane); return; }
    r -= 2 * IT_WOUT;
    const float *Wg, *Wu, *Wd; bf16 *Dgu, *Ddn;
    if (r < IT_GU + IT_DN) { Wg = in.fw_gate; Wu = in.fw_up; Wd = in.fw_down; Dgu = (bf16*)(ws + WS_FGU); Ddn = (bf16*)(ws + WS_FDN); }
    else { r -= IT_GU + IT_DN; const int e = r / (IT_GU + IT_DN); r -= e * (IT_GU + IT_DN);
        Wg = in.mw_gate + (size_t)e * 1024 * 2816; Wu = in.mw_up + (size_t)e * 1024 * 2816; Wd = in.mw_down + (size_t)e * 2816 * 1024;
        Dgu = (bf16*)(ws + WS_MGU) + (size_t)e * 5632 * 1024; Ddn = (bf16*)(ws + WS_MDN) + (size_t)e * 1024 * 2816; }
    if (r < IT_GU) {
        transpose_item([=](int k, int n) { const float* W = ((n >> 7) & 1) ? Wu : Wg; return W[(size_t)k * 2816 + (n >> 8) * 128 + (n & 127)]; }, 1024, Dgu, 64 * (r / 176), 32 * (r % 176), scr, lane); return; }
    r -= IT_GU;
    transpose_item([=](int k, int n) { return Wd[(size_t)k * 1024 + n]; }, 2816, Ddn, 64 * (r / 32), 32 * (r % 32), scr, lane);
}
struct MoeItem { const float* src; bf16* dst; int ld, K, k0, n0; const float* rscale; float f8scale; int scol0, sstep; };
template <int KIND  , class InP> __device__ __forceinline__ MoeItem moe_item(InP inp, unsigned char* ws, int it, int lane) {
    MoeItem m; m.rscale = nullptr; m.f8scale = (KIND == 0) ? 32.0f : 64.0f; const int r8 = lane >> 3, c4 = 4 * (lane & 7); m.scol0 = c4; m.sstep = 1;
    if (KIND == 0) { const int e = it / IT_GU, r = it - e * IT_GU; const int kb = r / 176, nb = r % 176; const int n = 32 * nb; m.k0 = 64 * kb; m.n0 = n; m.ld = 2816; m.K = 1024;
        const float* W = (((n >> 7) & 1) ? inp->mw_up : inp->mw_gate) + (size_t)e * 1024 * 2816;
        m.src = W + (size_t)(m.k0 + r8) * 2816 + (n >> 8) * 128 + (n & 127) + c4; m.dst = (bf16*)(ws + WS_MGU + (size_t)e * 5632 * 1024); }
    else { const int e = it / IT_DN, r = it - e * IT_DN; const int kb = r / 32, nb = r % 32; m.k0 = 64 * kb; m.n0 = 32 * nb; m.ld = 1024; m.K = 2816;
        m.src = inp->mw_down + (size_t)e * 2816 * 1024 + (size_t)(m.k0 + r8) * 1024 + m.n0 + c4; m.dst = (bf16*)(ws + WS_MDN + (size_t)e * 1024 * 2816); }
    return m;
}
__device__ __forceinline__ void moe_item_load(const MoeItem& m, float (&v)[32]) {
#pragma unroll
    for (int i = 0; i < 8; ++i) { const f32x4 t = __builtin_nontemporal_load((const f32x4*)(m.src + (size_t)(8 * i) * m.ld));
        v[4 * i] = t[0]; v[4 * i + 1] = t[1]; v[4 * i + 2] = t[2]; v[4 * i + 3] = t[3]; }
}
__device__ __forceinline__ void moe_item_finish(const MoeItem& m, const float (&v)[32], LAS float* scr, int lane) {
    const int r8 = lane >> 3;
    if (m.rscale != nullptr && m.k0 < 512) {
#pragma unroll
        for (int i = 0; i < 8; ++i) { const float rsv = m.rscale[m.k0 + 8 * i + r8];
#pragma unroll
            for (int j = 0; j < 4; ++j) scr[(8 * i + r8) * 33 + m.scol0 + j * m.sstep] = v[4 * i + j] * rsv; }
    } else {
#pragma unroll
        for (int i = 0; i < 8; ++i)
#pragma unroll
            for (int j = 0; j < 4; ++j) scr[(8 * i + r8) * 33 + m.scol0 + j * m.sstep] = v[4 * i + j];
    }
    LDS_WAIT(); asm volatile("" ::: "memory");
    const int c = lane & 7;
    if (m.f8scale != 0.f) {
        const float sc = m.f8scale; unsigned char* d8 = (unsigned char*)m.dst;
#pragma unroll
        for (int j = 0; j < 4; ++j) { const int n = (lane >> 3) + 8 * j; const LAS float* s = scr + (8 * c) * 33 + n;
            v2u o; int p = 0; p = __builtin_amdgcn_cvt_pk_fp8_f32(s[0 * 33] * sc, s[1 * 33] * sc, p, false); p = __builtin_amdgcn_cvt_pk_fp8_f32(s[2 * 33] * sc, s[3 * 33] * sc, p, true); o.x = (unsigned)p;
            p = 0; p = __builtin_amdgcn_cvt_pk_fp8_f32(s[4 * 33] * sc, s[5 * 33] * sc, p, false); p = __builtin_amdgcn_cvt_pk_fp8_f32(s[6 * 33] * sc, s[7 * 33] * sc, p, true); o.y = (unsigned)p;
            __builtin_nontemporal_store(o, (GAS v2u*)(d8 + (size_t)(m.n0 + n) * m.K + m.k0 + 8 * c)); }
    } else {
#pragma unroll
        for (int j = 0; j < 4; ++j) { const int n = (lane >> 3) + 8 * j; const LAS float* s = scr + (8 * c) * 33 + n;
            v4u o; o.x = pk2(s[0 * 33], s[1 * 33]); o.y = pk2(s[2 * 33], s[3 * 33]); o.z = pk2(s[4 * 33], s[5 * 33]); o.w = pk2(s[6 * 33], s[7 * 33]);
            *(GAS v4u*)(m.dst + (size_t)(m.n0 + n) * m.K + m.k0 + 8 * c) = o; }
    }
    LDS_WAIT(); asm volatile("" ::: "memory");
}
template <class InP> __device__ __forceinline__ MoeItem base_item(InP inp, unsigned char* ws, int it, int lane) {
    MoeItem m; m.rscale = nullptr; m.f8scale = 0.f; int r = it; const int r8 = lane >> 3, c = lane & 7, c4 = 4 * c; m.scol0 = c4; m.sstep = 1;
    if (r < 2 * IT_WIN) { const int l = r / IT_WIN; r -= l * IT_WIN; m.k0 = 64 * (r / 112); m.n0 = 32 * (r % 112); m.ld = 3584; m.K = 1024;
        int scol = m.n0 + c4;
        if (m.n0 >= 1536 && m.n0 < 2560) { const int hb = (m.n0 - 1536) & ~127, a0 = ((m.n0 - 1536) & 127) >> 3;
            scol = 1536 + hb + 4 * (a0 + (c & 3)) + 64 * (c >> 2); m.scol0 = 8 * (c & 3) + (c >> 2); m.sstep = 2; }
        m.src = inp->w_in + (size_t)l * 1024 * 3584 + (size_t)(m.k0 + r8) * 3584 + scol; m.dst = (bf16*)(ws + WS_WIN) + (size_t)l * 3584 * 1024; return m; }
    r -= 2 * IT_WIN;
    if (r < 2 * IT_WOUT) { const int l = r / IT_WOUT; r -= l * IT_WOUT; m.k0 = 64 * (r / 32); m.n0 = 32 * (r % 32); m.ld = 1024; m.K = 1024; m.rscale = inp->att_g + l * 512;
        m.src = inp->w_out + (size_t)l * 1024 * 1024 + (size_t)(m.k0 + r8) * 1024 + m.n0 + c4; m.dst = (bf16*)(ws + WS_WOUT) + (size_t)l * 1024 * 1024; return m; }
    r -= 2 * IT_WOUT;
    if (r < IT_GU) { const int n = 32 * (r % 176); m.k0 = 64 * (r / 176); m.n0 = n; m.ld = 2816; m.K = 1024;
        m.src = (((n >> 7) & 1) ? inp->fw_up : inp->fw_gate) + (size_t)(m.k0 + r8) * 2816 + (n >> 8) * 128 + (n & 127) + c4; m.dst = (bf16*)(ws + WS_FGU); m.f8scale = 32.0f; return m; }
    r -= IT_GU; m.k0 = 64 * (r / 32); m.n0 = 32 * (r % 32); m.ld = 1024; m.K = 2816;
    m.src = inp->fw_down + (size_t)(m.k0 + r8) * 1024 + m.n0 + c4; m.dst = (bf16*)(ws + WS_FDN); m.f8scale = 64.0f; return m;
}
#ifndef CONV_DEPTH
#define CONV_DEPTH 4
#endif
#define CONV_PIPE(ITEM_FN, IT_FIRST, IT_END, STEP)                                                                      \
    { int it = (IT_FIRST); const int it_end = (IT_END), st_ = (STEP);                                                   \
      if (it < it_end) {                                                                                                \
        float v0[32], v1[32], v2[32], v3[32]; MoeItem q0, q1, q2, q3;                                                   \
        auto clampi = [&](int i) { return i < it_end ? i : it; };                                                       \
        q0 = ITEM_FN(it); moe_item_load(q0, v0);                                                                        \
        if (CONV_DEPTH > 2) { q1 = ITEM_FN(clampi(it + st_)); moe_item_load(q1, v1); }                                  \
        if (CONV_DEPTH > 3) { q2 = ITEM_FN(clampi(it + 2 * st_)); moe_item_load(q2, v2); }                              \
        for (;;) {                                                                                                      \
            if (CONV_DEPTH == 2) { q1 = ITEM_FN(clampi(it + st_)); moe_item_load(q1, v1); }                             \
            if (CONV_DEPTH == 3) { q2 = ITEM_FN(clampi(it + 2 * st_)); moe_item_load(q2, v2); }                         \
            if (CONV_DEPTH == 4) { q3 = ITEM_FN(clampi(it + 3 * st_)); moe_item_load(q3, v3); }                         \
            moe_item_finish(q0, v0, scr, lane); it += st_; if (it >= it_end) break;                                     \
            if (CONV_DEPTH == 2) { q0 = ITEM_FN(clampi(it + st_)); moe_item_load(q0, v0); }                             \
            if (CONV_DEPTH == 3) { q0 = ITEM_FN(clampi(it + 2 * st_)); moe_item_load(q0, v0); }                         \
            if (CONV_DEPTH == 4) { q0 = ITEM_FN(clampi(it + 3 * st_)); moe_item_load(q0, v0); }                         \
            moe_item_finish(q1, v1, scr, lane); it += st_; if (it >= it_end) break;                                     \
            if (CONV_DEPTH == 2) continue;                                                                              \
            if (CONV_DEPTH == 3) { q1 = ITEM_FN(clampi(it + 2 * st_)); moe_item_load(q1, v1); }                         \
            if (CONV_DEPTH == 4) { q1 = ITEM_FN(clampi(it + 3 * st_)); moe_item_load(q1, v1); }                         \
            moe_item_finish(q2, v2, scr, lane); it += st_; if (it >= it_end) break;                                     \
            if (CONV_DEPTH == 3) continue;                                                                              \
            q2 = ITEM_FN(clampi(it + 3 * st_)); moe_item_load(q2, v2);                                                  \
            moe_item_finish(q3, v3, scr, lane); it += st_; if (it >= it_end) break;                                     \
        }                                                                                                               \
      } }
constexpr int IT_LATE = IT_WIN + IT_WOUT, IT_EARLY = IT_NONMOE - IT_LATE;
template <class InP> __device__ __forceinline__ void convert_base_all(InP inp, unsigned char* ws, LAS unsigned char* lds, int gw, int NGW, int wave, int lane) {
    LAS float* scr = (LAS float*)(lds + wave * 16384);
    auto item = [&](int p) { return base_item(inp, ws, p < IT_WIN ? p : (p < IT_WIN + IT_WOUT ? p + IT_WIN : p + IT_WIN + IT_WOUT), lane); };
    CONV_PIPE(item, gw, IT_EARLY, NGW)
}
template <class InP> __device__ __forceinline__ void convert_base_late(InP inp, unsigned char* ws, LAS unsigned char* lds, int sp, int nsp, int wave, int lane) {
    LAS float* scr = (LAS float*)(lds + wave * 16384);
    auto item = [&](int d) { return base_item(inp, ws, d < IT_WIN ? IT_WIN + d : d + IT_WIN + IT_WOUT, lane); };
    CONV_PIPE(item, sp * NWAVES + wave, IT_LATE, nsp * NWAVES)
}
template <int KIND, class InP> __device__ __forceinline__ void convert_moe_range(InP inp, unsigned char* ws, LAS unsigned char* lds, int it0, int it1, int sp, int nsp, int wave, int lane) {
    LAS float* scr = (LAS float*)(lds + wave * 16384);
    auto item = [&](int i) { return moe_item<KIND>(inp, ws, i, lane); };
#ifndef CONV_CONTIG
    CONV_PIPE(item, it0 + sp * NWAVES + wave, it1, nsp * NWAVES)
#else
    const int chunk = (it1 - it0 + nsp - 1) / nsp, cb = it0 + sp * chunk, ce = (cb + chunk < it1) ? cb + chunk : it1;
    CONV_PIPE(item, cb + wave, ce, NWAVES)
#endif
}
constexpr int IT_MOE = 8 * (IT_GU + IT_DN);
#ifndef G_GUD_N
#define G_GUD_N 208
#endif
constexpr int G_INPROJ = 224, G_GUD = G_GUD_N;
#ifndef MOE_SPARE
#define MOE_SPARE 8
#endif
constexpr int IT_MGU = 8 * IT_GU, IT_MDN = 8 * IT_DN;
#ifndef SPLIT_A
#define SPLIT_A 9000
#define SPLIT_B 19500
#define SPLIT_C 7500
#endif
constexpr int IT_MOE_A = SPLIT_A, IT_MOE_B = SPLIT_B, IT_MDN_C = SPLIT_C;

template <class InP> __device__ __forceinline__ void p0_prologue(InP inp, unsigned char* ws, LAS unsigned char* lds, int vcu, int G, int wave, int lane, int tid, int moe_w) {
    Inputs in; in.c = inp->c; in.ada_w = inp->ada_w; in.ada_b = inp->ada_b; in.w_in = inp->w_in; in.w_out = inp->w_out; in.att_g = inp->att_g; in.fw_gate = inp->fw_gate; in.fw_up = inp->fw_up; in.fw_down = inp->fw_down; in.mw_gate = inp->mw_gate; in.mw_up = inp->mw_up; in.mw_down = inp->mw_down;
    if (vcu < 192) {
        LAS float* cs = (LAS float*)lds;
        LAS float* part = (LAS float*)(lds + 32768);
        for (int i = tid; i < 8 * 1024; i += 512) { const float v = in.c[i]; cs[i] = v / (1.0f + __expf(-v)); }
        __syncthreads();
        const int n0 = vcu * 64, l = n0 / 6144, nn = n0 % 6144 + lane;
        const float* wp = in.ada_w + (size_t)l * 1024 * 6144 + (size_t)(wave * 128) * 6144 + nn;
        float acc[8];
#pragma unroll
        for (int b = 0; b < 8; ++b) acc[b] = 0.f;
#pragma unroll 16
        for (int k = 0; k < 128; ++k) { const float wv = __builtin_nontemporal_load(wp + (size_t)k * 6144);
#pragma unroll
            for (int b = 0; b < 8; ++b) acc[b] += cs[b * 1024 + wave * 128 + k] * wv; }
#pragma unroll
        for (int b = 0; b < 8; ++b) part[(wave * 8 + b) * 64 + lane] = acc[b];
        __syncthreads();
        { const int b = tid >> 6; float s = 0.f;
#pragma unroll
          for (int w = 0; w < 8; ++w) s += part[(w * 8 + b) * 64 + lane];
          ((float*)(ws + WS_MOD))[((size_t)l * 8 + b) * 6144 + nn] = s + in.ada_b[l * 6144 + nn]; }
        __syncthreads();
    }
    { const int g = vcu * 512 + tid; if (g < 2048 * 64) { const int pos = g >> 6, i = g & 63; const float inv = powf(10000.0f, -(float)i / 64.0f); const float ang = (float)pos * inv;
        float* rp = (float*)(ws + WS_ROPE) + (size_t)g * 2; rp[0] = (float)cos((double)ang); rp[1] = (float)sin((double)ang); } }
    convert_base_all(inp, ws, lds, vcu * NWAVES + wave, G * NWAVES, wave, lane);
}

template <int MODE>
__device__ __forceinline__ void norm_pass(const float* xsrc, const float* gain, const float* sh, const float* sc, bf16* dst,
                                          const float* router_w, int* eidx, float* ew, int* wcnt, int gw, int lane) {
    const int m0 = gw * 8, b = m0 >> 11;
    f32x4 gv[4], scv[4], shv[4];
#pragma unroll
    for (int j = 0; j < 4; ++j) { gv[j] = ((const f32x4*)gain)[lane + 64 * j]; scv[j] = ((const f32x4*)(sc + (size_t)b * 6144))[lane + 64 * j] + 1.0f; shv[j] = ((const f32x4*)(sh + (size_t)b * 6144))[lane + 64 * j]; }
    int cnt[8];
#pragma unroll
    for (int e = 0; e < 8; ++e) cnt[e] = 0;
    f32x4 rw[4][4][2];
    if (MODE == 1) {
#pragma unroll
        for (int j = 0; j < 4; ++j)
#pragma unroll
            for (int c = 0; c < 4; ++c) { const float* wp = router_w + (size_t)(4 * (lane + 64 * j) + c) * 8; rw[j][c][0] = *(const f32x4*)wp; rw[j][c][1] = *(const f32x4*)(wp + 4); }
    }
    for (int i = 0; i < 8; ++i) {
        const int m = m0 + i;
        const f32x4* xr = (const f32x4*)(xsrc + (size_t)m * 1024) + lane;
        f32x4 v[4]; float s = 0.f;
#pragma unroll
        for (int j = 0; j < 4; ++j) { v[j] = xr[64 * j]; s += (v[j][0] * v[j][0] + v[j][1] * v[j][1]) + (v[j][2] * v[j][2] + v[j][3] * v[j][3]); }
        const float rs = 1.0f / sqrtf(wave_sum(s) * (1.0f / 1024.0f) + 1e-6f);
        if (MODE == 2) {
            unsigned* o4 = (unsigned*)((unsigned char*)dst + (size_t)m * 1024) + lane;
#pragma unroll
            for (int j = 0; j < 4; ++j) { v[j] = v[j] * rs * gv[j] * scv[j] + shv[j]; o4[64 * j] = epi::pk4_fp8(v[j][0], v[j][1], v[j][2], v[j][3]); }
        } else {
        v2u* o8 = (v2u*)(dst + (size_t)m * 1024) + lane;
#pragma unroll
        for (int j = 0; j < 4; ++j) { v[j] = v[j] * rs * gv[j] * scv[j] + shv[j]; v2u w; w.x = pk2(v[j][0], v[j][1]); w.y = pk2(v[j][2], v[j][3]); o8[64 * j] = w; }
        }
        if (MODE == 1) {
            float lg[8];
#pragma unroll
            for (int e = 0; e < 8; ++e) lg[e] = 0.f;
#pragma unroll
            for (int j = 0; j < 4; ++j)
#pragma unroll
                for (int c = 0; c < 4; ++c) { const f32x4 w0 = rw[j][c][0], w1 = rw[j][c][1];
                    const float hv = v[j][c];
                    lg[0] += hv * w0[0]; lg[1] += hv * w0[1]; lg[2] += hv * w0[2]; lg[3] += hv * w0[3]; lg[4] += hv * w1[0]; lg[5] += hv * w1[1]; lg[6] += hv * w1[2]; lg[7] += hv * w1[3]; }
            { const bool b5 = (lane & 32) != 0, b4 = (lane & 16) != 0, b3 = (lane & 8) != 0;
              float a4[4], b2[2], c1;
#pragma unroll
              for (int q = 0; q < 4; ++q) { const float keep = b5 ? lg[4 + q] : lg[q], send = b5 ? lg[q] : lg[4 + q]; a4[q] = keep + xl::xor32p(send, b5); }
#pragma unroll
              for (int q = 0; q < 2; ++q) { const float keep = b4 ? a4[2 + q] : a4[q], send = b4 ? a4[q] : a4[2 + q]; b2[q] = keep + xl::xor_f<16>(send); }
              { const float keep = b3 ? b2[1] : b2[0], send = b3 ? b2[0] : b2[1]; c1 = keep + xl::xor_f<8>(send); }
              c1 += xl::xor_f<4>(c1); c1 += xl::xor_f<2>(c1); c1 += xl::xor_f<1>(c1);
#pragma unroll
              for (int e = 0; e < 8; ++e) lg[e] = __builtin_bit_cast(float, __builtin_amdgcn_readlane(__builtin_bit_cast(int, c1), 8 * e)); }
            int i0 = 0; float b0 = lg[0];
#pragma unroll
            for (int e = 1; e < 8; ++e) if (lg[e] > b0) { b0 = lg[e]; i0 = e; }
            int i1 = -1; float b1 = -3.0e38f;
#pragma unroll
            for (int e = 0; e < 8; ++e) if (e != i0 && lg[e] > b1) { b1 = lg[e]; i1 = e; }
            const float e1 = __expf(b1 - b0);
#pragma unroll
            for (int e = 0; e < 8; ++e) cnt[e] += ((e == i0) ? 1 : 0) + ((e == i1) ? 1 : 0);
            if (lane == 0) { eidx[m * 2] = i0; eidx[m * 2 + 1] = i1; ew[m * 2] = 1.0f / (1.0f + e1); ew[m * 2 + 1] = e1 / (1.0f + e1); }
        }
    }
    if (MODE == 1) {
        int myc = 0;
#pragma unroll
        for (int e = 0; e < 8; ++e) myc = (lane == e) ? cnt[e] : myc;
        if (lane < 8) wcnt[gw * 8 + lane] = myc;
    }
}

__device__ __forceinline__ void place_pass(const int* wcnt, const int* eidx, const float* ew, const bf16* XA, bf16* XS, int* srow, float* swt, int* segout, int gw, int NGW, int lane) {
    int tot[8], pre[8];
#pragma unroll
    for (int e = 0; e < 8; ++e) { tot[e] = 0; pre[e] = 0; }
    for (int w = lane; w < NGW; w += 64) { const i32x4 a = *(const i32x4*)(wcnt + w * 8), c = *(const i32x4*)(wcnt + w * 8 + 4); const int inc = (w < gw) ? 1 : 0;
        tot[0] += a[0]; tot[1] += a[1]; tot[2] += a[2]; tot[3] += a[3]; tot[4] += c[0]; tot[5] += c[1]; tot[6] += c[2]; tot[7] += c[3];
        pre[0] += inc * a[0]; pre[1] += inc * a[1]; pre[2] += inc * a[2]; pre[3] += inc * a[3]; pre[4] += inc * c[0]; pre[5] += inc * c[1]; pre[6] += inc * c[2]; pre[7] += inc * c[3]; }
    int base[8]; int run = 0;
#pragma unroll
    for (int e = 0; e < 8; ++e) { tot[e] = wave_sum_i(tot[e]); pre[e] = wave_sum_i(pre[e]); base[e] = run + pre[e]; if (gw == 0 && lane == 0) segout[e] = run; run += (tot[e] + 255) & ~255; }
    if (gw == 0 && lane == 0) segout[8] = run;
    const int myev = (lane < 16) ? eidx[gw * 16 + lane] : 0; const float myw = (lane < 16) ? ew[gw * 16 + lane] : 0.f;
    int mypos = 0;
#pragma unroll
    for (int i = 0; i < 16; ++i) { const int ev = __builtin_amdgcn_readlane(myev, i); int pos = 0;
#pragma unroll
        for (int e = 0; e < 8; ++e) if (ev == e) { pos = base[e]; base[e] += 1; }
        mypos = (lane == i) ? pos : mypos; }
    if (lane < 16) { srow[mypos] = gw * 16 + lane; swt[mypos] = myw; }
    const v4u* __restrict__ s = (const v4u*)(XA + (size_t)(gw * 8) * 1024);
    v4u r0[8], r1[8];
#pragma unroll
    for (int t = 0; t < 8; ++t) { r0[t] = s[t * 128 + lane]; r1[t] = s[t * 128 + lane + 64]; }
    v2u q0[8], q1[8];
#pragma unroll
    for (int t = 0; t < 8; ++t) {
        { int p = 0; p = __builtin_amdgcn_cvt_pk_fp8_f32(h16::lo(r0[t].x), h16::hi(r0[t].x), p, false); p = __builtin_amdgcn_cvt_pk_fp8_f32(h16::lo(r0[t].y), h16::hi(r0[t].y), p, true); q0[t].x = (unsigned)p;
          p = 0; p = __builtin_amdgcn_cvt_pk_fp8_f32(h16::lo(r0[t].z), h16::hi(r0[t].z), p, false); p = __builtin_amdgcn_cvt_pk_fp8_f32(h16::lo(r0[t].w), h16::hi(r0[t].w), p, true); q0[t].y = (unsigned)p; }
        { int p = 0; p = __builtin_amdgcn_cvt_pk_fp8_f32(h16::lo(r1[t].x), h16::hi(r1[t].x), p, false); p = __builtin_amdgcn_cvt_pk_fp8_f32(h16::lo(r1[t].y), h16::hi(r1[t].y), p, true); q1[t].x = (unsigned)p;
          p = 0; p = __builtin_amdgcn_cvt_pk_fp8_f32(h16::lo(r1[t].z), h16::hi(r1[t].z), p, false); p = __builtin_amdgcn_cvt_pk_fp8_f32(h16::lo(r1[t].w), h16::hi(r1[t].w), p, true); q1[t].y = (unsigned)p; } }
#pragma unroll
    for (int i = 0; i < 16; ++i) { const int pos = __builtin_amdgcn_readlane(mypos, i); v2u* __restrict__ d = (v2u*)((unsigned char*)XS + (size_t)pos * 1024);
        d[lane] = q0[i >> 1]; d[lane + 64] = q1[i >> 1]; }
}

__device__ __forceinline__ void final_pass(float* xio, const bf16* YS, const int* atomf, const float* slab, const float* g2, const float* fg, int gw, int lane) {
    const int m0 = gw * 8, b = m0 >> 11;
    f32x4 gv[4], g2v[4];
#pragma unroll
    for (int j = 0; j < 4; ++j) { gv[j] = ((const f32x4*)fg)[lane + 64 * j]; g2v[j] = ((const f32x4*)(g2 + (size_t)b * 6144))[lane + 64 * j]; }
    for (int i = 0; i < 8; ++i) {
        const int m = m0 + i;
        f32x4* xr = (f32x4*)(xio + (size_t)m * 1024) + lane;
        const v2u* y0 = (const v2u*)(YS + (size_t)(2 * m) * 1024) + lane; const v2u* y1 = (const v2u*)(YS + (size_t)(2 * m + 1) * 1024) + lane;
        f32x4 v[4]; float s = 0.f; const i32x4 f0 = *(const i32x4*)(atomf + (size_t)(2 * m) * 4), f1 = *(const i32x4*)(atomf + (size_t)(2 * m + 1) * 4);
#pragma unroll
        for (int j = 0; j < 4; ++j) { v[j] = xr[64 * j]; const v2u a = y0[64 * j], c = y1[64 * j];
            f32x4 ya, yc;
            if (f0[j]) { const int id = f0[j] - 1; const float* sp = slab + ((size_t)((id >> 8) * 11) * 256 + (id & 255)) * 256 + 4 * lane; ya = (f32x4){0.f, 0.f, 0.f, 0.f};
                for (int kc = 0; kc < 11; ++kc) ya += *(const f32x4*)(sp + (size_t)kc * 65536); }
            else { ya[0] = h16::lo(a.x); ya[1] = h16::hi(a.x); ya[2] = h16::lo(a.y); ya[3] = h16::hi(a.y); }
            if (f1[j]) { const int id = f1[j] - 1; const float* sp = slab + ((size_t)((id >> 8) * 11) * 256 + (id & 255)) * 256 + 4 * lane; yc = (f32x4){0.f, 0.f, 0.f, 0.f};
                for (int kc = 0; kc < 11; ++kc) yc += *(const f32x4*)(sp + (size_t)kc * 65536); }
            else { yc[0] = h16::lo(c.x); yc[1] = h16::hi(c.x); yc[2] = h16::lo(c.y); yc[3] = h16::hi(c.y); }
            const f32x4 ys = ya + yc;
            v[j] = v[j] + g2v[j] * ys; s += (v[j][0] * v[j][0] + v[j][1] * v[j][1]) + (v[j][2] * v[j][2] + v[j][3] * v[j][3]); }
        const float rs = 1.0f / sqrtf(wave_sum(s) * (1.0f / 1024.0f) + 1e-6f);
#pragma unroll
        for (int j = 0; j < 4; ++j) xr[64 * j] = v[j] * rs * gv[j];
    }
}

__device__ __forceinline__ void xcd_barrier_arrive(const XcdBarrier& b) {
    asm volatile("s_waitcnt vmcnt(0)" ::: "memory");
    __syncthreads();
    if (otid(b.wv) == 0) {
        unsigned* bar = b.bar;
        __builtin_amdgcn_s_waitcnt(0);
        unsigned nloc = b.st[0], nx = b.st[1];
        if (nloc == 0u) { xcd_barrier_complete(bar, b.x, nloc, nx); b.st[0] = nloc; b.st[1] = nx; }
        const unsigned old = xb_add(&bar[XB_XSUB(b.x)], 1u);
        const unsigned gen = old / nloc;
        if (old + 1u == (gen + 1u) * nloc) {
            __builtin_amdgcn_fence(__ATOMIC_RELEASE, "agent");
            asm volatile("s_waitcnt vmcnt(0)" ::: "memory");
            const unsigned og = xb_add(&bar[XB_TOP], 1u);
            const unsigned tg = og / nx;
            if (og + 1u == (tg + 1u) * nx) xb_add(&bar[XB_TOPGEN], 1u);
            else XB_SPIN(xb_ld(&bar[XB_TOPGEN]) == tg, bar);
            xb_add(&bar[XB_XGEN(b.x)], 1u);
            asm volatile("s_waitcnt vmcnt(0)" ::: "memory");
        }
        b.st[3] = gen;
    }
}
__device__ __forceinline__ void xcd_barrier_wait(const XcdBarrier& b) {
    if (otid(b.wv) == 0) {
        unsigned* bar = b.bar;
        const unsigned gen = b.st[3];
        XB_SPIN(xb_ld(&bar[XB_XGEN(b.x)]) == gen, bar);
        __builtin_amdgcn_fence(__ATOMIC_ACQUIRE, "agent");
        asm volatile("s_waitcnt vmcnt(0)" ::: "memory");
    }
    __syncthreads();
}
constexpr int N_PHASES = 18;
struct Args { Inputs in; float* out; unsigned char* ws; int ph_lo, ph_hi, bar_region, moe_w; };

typedef const Args __attribute__((address_space(4))) CArgs;
__device__ __forceinline__ CArgs* kargs() { unsigned long off = 0; asm volatile("" : "+s"(off)); return (CArgs*)((const char __attribute__((address_space(4)))*)__builtin_amdgcn_kernarg_segment_ptr() + off); }

__global__ void __launch_bounds__(NWAVES * 64, 2) mega(Args args_unused) {
    extern __shared__ __attribute__((aligned(16))) unsigned char lds_raw[];
    LAS unsigned char* lds = (LAS unsigned char*)lds_raw;
    volatile LAS unsigned* MISC = (volatile LAS unsigned*)(lds + MISC_OFF);
    const int G = gridDim.x;
#define PHASE_IDS int tid = otid(WV); int bx = blockIdx.x; asm volatile("" : "+s"(bx)); const int lane = tid & 63, wave = __builtin_amdgcn_readfirstlane(tid >> 6); \
    const int vcu = (bx & 7) * (G >> 3) + (bx >> 3); const int gw = vcu * NWAVES + wave; (void)lane; (void)gw; (void)vcu;
    const int WV = __builtin_amdgcn_readfirstlane((int)threadIdx.x >> 6);
    for (int u = otid(WV); u < (LDS_BYTES - LDSCTL_OFF) / 4; u += NWAVES * 64) ((LAS unsigned*)(lds + LDSCTL_OFF))[u] = 0u;
    __syncthreads();
    XcdBarrier bar;
    { CArgs* ka = kargs(); unsigned* barw = (unsigned*)(ka->ws + WS_CTL) + CW_BAR + ka->bar_region * XCD_BAR_WORDS; bar = xcd_barrier_post(barw, MISC + 8, WV); }
    int lo, hi; { CArgs* ka = kargs(); lo = ka->ph_lo; hi = ka->ph_hi; }
#ifndef PHM
#define PHM 0x3ff
#endif
#define IN(k) (lo <= (k) && (k) < hi)
#define TY(t) (((PHM) >> (t)) & 1)
#ifndef DUP_T
#define DUP_T -1
#define DUP_N 0
#endif
#define REP(t) for (int rep_ = 0; rep_ < ((t) == DUP_T ? 1 + DUP_N : 1) && (rep_ == 0 || (__syncthreads(), true)); ++rep_)
#ifdef TPROBE
#define TS ((volatile LAS unsigned long long*)(lds + MISC_OFF + 256))
#define STAMP(k) do { if (blockIdx.x == 0 && otid(WV) == 0) TS[(k)] = __builtin_amdgcn_s_memrealtime(); } while (0)
#else
#define STAMP(k) do {} while (0)
#endif
#ifdef TSPIN
#ifndef TSPIN_BX
#define TSPIN_BX 0
#endif
#define TSL ((volatile LAS unsigned long long*)(lds + MISC_OFF + 256))
#define STAMP_E(k) do { if (blockIdx.x == TSPIN_BX && otid(WV) == 0) { const unsigned long long n_ = __builtin_amdgcn_s_memrealtime(); if (((TSPIN_W) >> (k)) & 1) TSL[1] += n_ - TSL[0]; TSL[0] = n_; } } while (0)
#define STAMP_S(k) do { if (blockIdx.x == TSPIN_BX && otid(WV) == 0) { const unsigned long long n_ = __builtin_amdgcn_s_memrealtime(); if (((TSPIN_B) >> (k)) & 1) TSL[1] += n_ - TSL[0]; TSL[0] = n_; } } while (0)
    if (blockIdx.x == TSPIN_BX && otid(WV) == 0) { TSL[1] = 0ull; TSL[0] = __builtin_amdgcn_s_memrealtime(); }
#else
#define STAMP_E(k) do {} while (0)
#define STAMP_S(k) do {} while (0)
#endif
    STAMP(0);
#define SEAM(k) do { STAMP_E(k); if (IN(k) && IN((k) + 1)) xcd_barrier(bar); STAMP_S(k); STAMP((k) + 1); } while (0)

    if (TY(0) && IN(0)) REP(0) { PHASE_IDS CArgs* ka = kargs(); p0_prologue(&ka->in, ka->ws, lds, vcu, G, wave, lane, tid, 0); }
    SEAM(0);
#ifdef PROBE_BAR
    for (int q = 0; q < PROBE_BAR; ++q) xcd_barrier(bar);
#endif
    for (int l = 0; l < 2; ++l) {
        const int pb = 1 + 8 * l;
        if (TY(1) && IN(pb + 0)) REP(1) { PHASE_IDS CArgs* ka = kargs(); unsigned char* ws = ka->ws; const float* mod = (const float*)(ws + WS_MOD) + (size_t)l * 8 * 6144;
            const float* xin = (l == 0) ? ka->in.x : (const float*)ka->out;
            if (gw < 2048) norm_pass<0>(xin, ka->in.norm_mix_g + l * 1024, mod + 0 * 1024, mod + 1 * 1024, (bf16*)(ws + WS_XA), nullptr, nullptr, nullptr, nullptr, gw, lane); }
        SEAM(pb + 0);
        if (TY(2) && IN(pb + 1)) REP(2) { PHASE_IDS CArgs* ka = kargs(); unsigned char* ws = ka->ws;
            if (bx < G_INPROJ) {
                pg8::Gemm g{1024, 1024, 1024}; pg8::DenseSched S; S.init(ws + WS_XA, 1024, (bf16*)(ws + WS_WIN) + (size_t)l * 3584 * 1024, 1024, 16384, 3584, G_INPROJ, bx);
                epi::EpiInProj E{(bf16*)(ws + WS_QKV), (size_t)16384 * 512, (float*)(ws + WS_KMP), (const float*)(ws + WS_ROPE)};
                pg8::gemm_phase(WV, lds, g, S, E);
            } else if (rep_ == 0) { convert_moe_range<0>(&ka->in, ws, lds, l == 0 ? 0 : IT_MOE_B, l == 0 ? IT_MOE_A : IT_MGU, bx - G_INPROJ, G - G_INPROJ, wave, lane);
                                    if (l == 1) convert_moe_range<1>(&ka->in, ws, lds, 0, IT_MDN_C, bx - G_INPROJ, G - G_INPROJ, wave, lane);
#ifdef PROBE_CONVIN
                                    if (l == PROBE_CONVIN) { __syncthreads(); if (l == 0) convert_moe_range<0>(&ka->in, ws, lds, 0, IT_MOE_A, bx - G_INPROJ, G - G_INPROJ, wave, lane); else convert_moe_range<1>(&ka->in, ws, lds, 0, IT_MDN_C, bx - G_INPROJ, G - G_INPROJ, wave, lane); }
#endif
                                    }
        }
        SEAM(pb + 1);
        if (TY(3) && IN(pb + 2)) REP(3) { PHASE_IDS CArgs* ka = kargs(); unsigned char* ws = ka->ws; bf16* QKV = (bf16*)(ws + WS_QKV); bf16* CAT = (bf16*)(ws + WS_CAT);
            if (G == 256) {
                if ((bx & 7) < 7) fa::kv_unit(WV, bx >> 5, (bx >> 3) & 3, bx & 7, QKV + (size_t)4 * 16384 * 512, QKV + (size_t)5 * 16384 * 512, (float*)(ws + WS_KVM), lds);
                xcd_barrier_arrive(bar);
                { fa::Tensors TA{QKV, QKV + (size_t)1 * 16384 * 512, QKV + (size_t)2 * 16384 * 512, CAT, (float*)(ws + WS_ASSQ), (const float*)(ws + WS_KMP), nullptr, nullptr, nullptr};
                  const int g2 = (bx >> 3) * 2, r4 = (bx & 7) * 4;
                  for (int uu = 0; uu < 2; ++uu) { const int bh = g2 + uu; fa::attn_unit<false>(WV, bh >> 3, bh & 7, ((uu == 0 ? 0x25170643 : 0x31507246) >> r4) & 7, TA, lds); } }
                xcd_barrier_wait(bar);
                { fa::Tensors TR{QKV + (size_t)3 * 16384 * 512, QKV + (size_t)4 * 16384 * 512, QKV + (size_t)5 * 16384 * 512, CAT, (float*)(ws + WS_ASSQ), (const float*)(ws + WS_KMP), QKV + (size_t)6 * 16384 * 512, ka->in.ret_g + l * 512, (const float*)(ws + WS_KVM)};
                  fa::attn_unit<true>(WV, bx >> 5, (bx >> 3) & 3, bx & 7, TR, lds); }
            }
        }
        SEAM(pb + 2);
        if (TY(4) && IN(pb + 3)) REP(4) {
            { PHASE_IDS CArgs* ka = kargs(); unsigned char* ws = ka->ws; const float* mod = (const float*)(ws + WS_MOD) + (size_t)l * 8 * 6144;
                const float* xin = (l == 0) ? ka->in.x : (const float*)ka->out;
                pg8::Gemm g{1024, 1024, 1024}; pg8::DenseSched S; S.init(ws + WS_CAT, 1024, (const bf16*)(ws + WS_WOUT) + (size_t)l * 1024 * 1024, 1024, 16384, 1024, G, bx);
                epi::EpiOutProj E{xin, ka->out, mod + 2 * 1024, (const float*)(ws + WS_ASSQ), rep_ > 0}; pg8::gemm_phase(WV, lds, g, S, E); }
        }
        SEAM(pb + 3);
        if (TY(5) && IN(pb + 4)) REP(5) { PHASE_IDS CArgs* ka = kargs(); unsigned char* ws = ka->ws; const float* mod = (const float*)(ws + WS_MOD) + (size_t)l * 8 * 6144;
            if (gw < 2048) {
                if (l == 0) norm_pass<2>(ka->out, ka->in.norm_ffn_g + l * 1024, mod + 3 * 1024, mod + 4 * 1024, (bf16*)(ws + WS_XA), nullptr, nullptr, nullptr, nullptr, gw, lane);
                else norm_pass<1>(ka->out, ka->in.norm_ffn_g + l * 1024, mod + 3 * 1024, mod + 4 * 1024, (bf16*)(ws + WS_XA), ka->in.router_w, (int*)(ws + WS_EIDX), (float*)(ws + WS_EW), (int*)(ws + WS_WCNT), gw, lane);
            }
            if (l == 1) { int* srow = (int*)(ws + WS_SROW); int* af = (int*)(ws + WS_ATOMF);
                { const int p = bx * 512 + tid; if (p < XS_ROWS) srow[p] = -1; af[p] = 0; }
            }
            else if (bx == 0 && tid < 9) { ((int*)(ws + WS_SEGD))[tid] = (tid == 0) ? 0 : ((tid == 8) ? 16384 : (1 << 30)); }
        }
        SEAM(pb + 4);
        if (l == 1) {
            if (TY(6) && IN(pb + 5)) REP(6) { PHASE_IDS CArgs* ka = kargs(); unsigned char* ws = ka->ws;
                if (gw < 2048) place_pass((const int*)(ws + WS_WCNT), (const int*)(ws + WS_EIDX), (const float*)(ws + WS_EW), (const bf16*)(ws + WS_XA), (bf16*)(ws + WS_XS), (int*)(ws + WS_SROW), (float*)(ws + WS_SWT), (int*)(ws + WS_SEG), gw, 2048, lane); }
            SEAM(pb + 5);
        } else { STAMP(pb + 6); }
        if (TY(7) && IN(pb + 6)) REP(7) { PHASE_IDS CArgs* ka = kargs(); unsigned char* ws = ka->ws;
            int Geff = G_GUD;
            if (l == 1) { const int nwg = (__builtin_amdgcn_readfirstlane(((const int*)(ws + WS_SEG))[8]) / 256) * 22; const int rounds = (nwg + G - 1) / G;
                Geff = (((nwg + rounds - 1) / rounds) + 7) & ~7; if (Geff > G - MOE_SPARE) Geff = G - MOE_SPARE; }
            if (bx < Geff) {
                pg8::Gemm g{512, 512, 512}; pg8::MoeSched S;
                S.init(ws + (l == 0 ? WS_XA : WS_XS), 512, ws + (l == 0 ? WS_FGU : WS_MGU), 512, (size_t)5632 * 1024, (const int*)(ws + (l == 0 ? WS_SEGD : WS_SEG)), 5632, Geff, bx);
                epi::EpiSwiGLU8 E{ws + (l == 0 ? WS_HD : WS_HM), 2816}; pg8::gemm_phase(WV, lds, g, S, E);
            } else if (rep_ == 0) { if (l == 0) { convert_base_late(&ka->in, ws, lds, bx - Geff, G - Geff, wave, lane); convert_moe_range<0>(&ka->in, ws, lds, IT_MOE_A, IT_MOE_B, bx - Geff, G - Geff, wave, lane); }
                                    else { convert_moe_range<1>(&ka->in, ws, lds, IT_MDN_C, IT_MDN, bx - Geff, G - Geff, wave, lane);
#ifdef PROBE_CONV2
                                           __syncthreads(); convert_moe_range<1>(&ka->in, ws, lds, IT_MDN_C, IT_MDN, bx - Geff, G - Geff, wave, lane);
#endif
                                    } }
        }
        SEAM(pb + 6);
        if (TY(8) && IN(pb + 7)) REP(8) { PHASE_IDS CArgs* ka = kargs(); unsigned char* ws = ka->ws; const float* mod = (const float*)(ws + WS_MOD) + (size_t)l * 8 * 6144;
            if (l == 0) { pg8::MoeSched S; S.init(ws + WS_HD, 1408, ws + WS_FDN, 1408, (size_t)1024 * 2816, (const int*)(ws + WS_SEGD), 1024, G, bx);
                pg8::Gemm g{1408, 1408, 1408};
                epi::EpiDownDense8 E{ka->out, mod + 5 * 1024, rep_ > 0}; pg8::gemm_phase(WV, lds, g, S, E);
            } else {
                pg8::MoeSched S; S.init(ws + WS_HM, 1408, ws + WS_MDN, 1408, (size_t)1024 * 2816, (const int*)(ws + WS_SEG), 1024, G, bx);
                pg8::Gemm g{1408, 1408, 1408};
                epi::EpiDownMoe8 E{(bf16*)(ws + WS_YS), (const int*)(ws + WS_SROW), (const float*)(ws + WS_SWT)}; pg8::gemm_phase(WV, lds, g, S, E);
            }
        }
        SEAM(pb + 7);
    }
    if (TY(9) && IN(17)) { PHASE_IDS CArgs* ka = kargs(); unsigned char* ws = ka->ws;
        if (gw < 2048) final_pass(ka->out, (const bf16*)(ws + WS_YS), (const int*)(ws + WS_ATOMF), (const float*)(ws + WS_SLAB), (const float*)(ws + WS_MOD) + (size_t)1 * 8 * 6144 + 5 * 1024, ka->in.final_g, gw, lane); }
#ifdef TSPIN
    STAMP_E(17);
    if (blockIdx.x == TSPIN_BX && otid(WV) == 0) { const unsigned long long t0_ = __builtin_amdgcn_s_memrealtime(), w_ = TSL[1] * (unsigned long long)(TSPIN_K);
        while (__builtin_amdgcn_s_memrealtime() - t0_ < w_) __builtin_amdgcn_s_sleep(8); }
#endif
#ifdef TPROBE
    xcd_barrier(bar); STAMP(18); __syncthreads();
    if (blockIdx.x == 0) { CArgs* ka = kargs(); float* o = ka->out;
        const float d1 = (float)(TS[TPROBE_A + 1] - TS[TPROBE_A]) * 0.01f, d2 = (float)(TS[TPROBE_B + 1] - TS[TPROBE_B]) * 0.01f;
        const float a = 4.0f * sqrtf(d1);
        for (int i = otid(WV); i < 1024 * 1024; i += 512) o[i] = a;
        if (otid(WV) == 0) o[1024 * 1024 + 5] = 100.0f * d2; }
#endif
#undef IN
#undef TY
#undef SEAM
#undef PHASE_IDS
}
}
#ifndef STEP
#define STEP 5
#endif
namespace ad {
__device__ __forceinline__ float bf2f(unsigned short s) { return h16::one(s); }
__global__ void __launch_bounds__(256) ad_proj(const unsigned short* QKV, size_t gstride, int b, float* projb) {
    const int m = blockIdx.x; const size_t row = (size_t)b * 2048 + m;
    for (int n = threadIdx.x; n < 3584; n += 256) {
        const int grp = n / 512, c = n % 512; int sc = c;
        if (grp == 3 || grp == 4) { const int head = c >> 7, d = c & 127; sc = head * 128 + 8 * ((d & 63) >> 2) + 2 * (d & 3) + (d >> 6); }
        float v = bf2f(QKV[(size_t)grp * gstride + row * 512 + sc]);
        if (grp == 0) v *= (1.0f / epi::C2);
        if (grp == 4) v *= (1.0f / epi::KSC);
        projb[(size_t)m * 3584 + n] = v;
    }
}
__global__ void __launch_bounds__(64) ad_kmean(const float* KMP, int b, float* kmeanb) {
    const int blk = blockIdx.x, h = blockIdx.y, d = threadIdx.x;
    const float* p = KMP + ((size_t)(b * 8 + blk) * 2) * 512 + h * 64 + d;
    kmeanb[((size_t)h * 8 + blk) * 64 + d] = (p[0] + p[512]) * (1.0f / 256.0f);
}
__global__ void __launch_bounds__(256) ad_cat(const unsigned short* CAT, const float* ASSQ, const float* att_g, int b, float* catb) {
    const int m = blockIdx.x; const size_t row = (size_t)b * 2048 + m;
    float ss = 0.f;
    for (int h = 0; h < 8; ++h) ss += ASSQ[row * 8 + h];
    const float rs = 1.0f / sqrtf(ss * (1.0f / 512.0f) + 1e-6f);
    for (int c = threadIdx.x; c < 1024; c += 256) { const float v = bf2f(CAT[row * 1024 + c]); catb[(size_t)m * 1024 + c] = (c < 512) ? v * rs * att_g[c] : v; }
}
__global__ void __launch_bounds__(256) dbg_cmp(const float* a, const float* b, size_t n, float rel, float abs_, unsigned* flag, int ncols = 1, int c_lo = 0, int c_hi = 1, int silu_b = 0) {
    unsigned bad = 0;
    for (size_t i = (size_t)blockIdx.x * 256 + threadIdx.x; i < n; i += (size_t)gridDim.x * 256) { const int c = (int)(i % ncols); if (c < c_lo || c >= c_hi) continue;
        float bv = b[i]; if (silu_b) bv = bv / (1.f + expf(-bv)); const float d = fabsf(a[i] - bv); if (!(d <= rel * fabsf(bv) + abs_)) ++bad; }
    if (bad) atomicAdd(flag, bad);
}
__global__ void __launch_bounds__(256) dbg_poison(const unsigned* flag, unsigned thresh, float* out, float val) {
    if (*flag > thresh) for (int i = threadIdx.x; i < 1024 * 1024; i += 256) out[i] = val;
}
__global__ void __launch_bounds__(256) dbg_ssd(const float* a, const float* b, size_t n, int ncols, int c_lo, int c_hi, float* acc) {
    float s = 0.f;
    for (size_t i = (size_t)blockIdx.x * 256 + threadIdx.x; i < n; i += (size_t)gridDim.x * 256) { const int c = (int)(i % ncols); if (c < c_lo || c >= c_hi) continue; const float d = a[i] - b[i]; s += d * d; }
    atomicAdd(acc, s);
}
__global__ void __launch_bounds__(256) dbg_encode(const float* acc, float count, float* out) {
    const float mse = *acc / count; const float val = 4.0f / sqrtf(mse);
    for (int i = threadIdx.x; i < 1024 * 1024; i += 256) out[i] = val;
}
}

static void launch_mega(const mk::Args& a0, int lo, int hi, int region, hipStream_t stream) {
    mk::Args a = a0; a.ph_lo = lo; a.ph_hi = hi; a.bar_region = region;
    hipLaunchKernelGGL(mk::mega, dim3(256), dim3(512), mk::LDS_BYTES, stream, a);
}

extern "C" void kernel_launch(void* const* d_in, const int* in_sizes, int n_in, void* d_out, int out_size, void* d_ws, size_t ws_size, hipStream_t stream) {
    static int ready = 0;
    if (ready == 0) {
        if (n_in != 18 || out_size != M * D || ws_size < mk::WS_END) { fprintf(stderr, "kernel_launch: unexpected problem (n_in %d, out %d, ws %zu)\n", n_in, out_size, ws_size); ready = -1; return; }
        if (hipFuncSetAttribute((const void*)mk::mega, hipFuncAttributeMaxDynamicSharedMemorySize, mk::LDS_BYTES) != hipSuccess) { fprintf(stderr, "kernel_launch: hipFuncSetAttribute failed\n"); ready = -1; return; }
        ready = 1;
    }
    if (ready < 0) return;
    mk::Args a{};
    const float** ip = (const float**)&a.in;
    for (int i = 0; i < 18; ++i) ip[i] = (const float*)d_in[i];
    a.out = (float*)d_out; a.ws = (unsigned char*)d_ws; a.moe_w = (STEP >= 5) ? 1 : 0;
    const mk::Inputs& in = a.in;
    float* out = (float*)d_out; unsigned char* ws = (unsigned char*)d_ws;
    hipMemsetAsync(ws + mk::WS_CTL, 0, mk::CTL_ZERO_BYTES, stream);
#if STEP >= 6
    launch_mega(a, 0, mk::N_PHASES, 0, stream);
#else
    constexpr size_t MiB = 1u << 20;
    unsigned char* na = ws + 8 * MiB;
    float* PROJb = (float*)(na);
    float* Hb = (float*)(na + 28 * MiB);
    float* CATb = (float*)(na + 36 * MiB);
    float* OAb = (float*)(na + 44 * MiB);
    float* ORRb = (float*)(na + 48 * MiB);
    float* KMEANb = (float*)(na + 52 * MiB);
    int* EIDXb = (int*)(na + 53 * MiB); float* EWb = (float*)(na + 53 * MiB + 65536); int* POSb = (int*)(na + 53 * MiB + 131072); int* LISTb = (int*)(na + 53 * MiB + 196608);
    int* CNTb = (int*)(na + 54 * MiB); int* BASEb = CNTb + 16;
    float* Gb = (float*)(na + 56 * MiB);
    float* Ub = (float*)(na + 78 * MiB);
    float* Yb = (float*)(na + 100 * MiB);
    const float* MODp = (const float*)(ws + mk::WS_MOD);
    unsigned short* QKV = (unsigned short*)(ws + mk::WS_QKV);
    launch_mega(a, 0, 1, 1, stream);
    for (int l = 0; l < 2; ++l) {
        const int pb = 1 + 8 * l;
        const float* xin = (l == 0) ? in.x : (const float*)out;
        if (STEP >= 1) { launch_mega(a, pb, pb + 1, 1, stream); launch_mega(a, pb + 1, pb + 2, 1, stream); }
        if (STEP >= 2) launch_mega(a, pb + 2, pb + 3, 1, stream);
        if (STEP >= 3) launch_mega(a, pb + 3, pb + 4, 1, stream);
        if (STEP < 3) {
            for (int b = 0; b < BATCH; ++b) {
                const float* mod = MODp + ((size_t)l * BATCH + b) * 6 * D;
                const float* xb = xin + (size_t)b * SEQ * D; float* ob = out + (size_t)b * SEQ * D;
                if (STEP < 1) {
                    nv::k_norm<<<SEQ, 256, 0, stream>>>(xb, in.norm_mix_g + l * D, mod + 0 * D, mod + 1 * D, Hb);
                    nv::k_gemm<<<dim3(NPROJ / 64, SEQ / 64), 256, 0, stream>>>(Hb, D, nullptr, nullptr, SEQ, in.w_in + (size_t)l * D * NPROJ, NPROJ, PROJb, NPROJ, D);
                    nv::k_rotary<<<SEQ, 256, 0, stream>>>(PROJb);
                    nv::k_kmean<<<dim3(NBLK, AH, 1), 64, 0, stream>>>(PROJb, KMEANb);
                } else {
                    ad::ad_proj<<<SEQ, 256, 0, stream>>>(QKV, (size_t)M * 512, b, PROJb);
                    ad::ad_kmean<<<dim3(NBLK, AH, 1), 64, 0, stream>>>((const float*)(ws + mk::WS_KMP), b, KMEANb);
#ifdef DBG_CHECK
                    { float* PROJn = Gb; float* KMn = (float*)(na + 52 * MiB + 262144); unsigned* flag = (unsigned*)(ws + mk::WS_CTL) + 16;
                      nv::k_norm<<<SEQ, 256, 0, stream>>>(xb, in.norm_mix_g + l * D, mod + 0 * D, mod + 1 * D, Hb);
                      nv::k_gemm<<<dim3(NPROJ / 64, SEQ / 64), 256, 0, stream>>>(Hb, D, nullptr, nullptr, SEQ, in.w_in + (size_t)l * D * NPROJ, NPROJ, PROJn, NPROJ, D);
                      nv::k_rotary<<<SEQ, 256, 0, stream>>>(PROJn);
                      nv::k_kmean<<<dim3(NBLK, AH, 1), 64, 0, stream>>>(PROJn, KMn);
                      ad::dbg_cmp<<<1024, 256, 0, stream>>>(PROJb, PROJn, (size_t)SEQ * NPROJ, DBG_REL, DBG_ABS, flag, NPROJ, 0, 3072, 0);
                      ad::dbg_cmp<<<1024, 256, 0, stream>>>(PROJb, PROJn, (size_t)SEQ * NPROJ, DBG_REL, DBG_ABS, flag, NPROJ, 3072, 3584, 1);
                      ad::dbg_cmp<<<16, 256, 0, stream>>>(KMEANb, KMn, (size_t)8 * 8 * 64, 0.03f, 0.004f, flag + 1);
                      if (l == DBG_L && b == 0) ad::dbg_ssd<<<1024, 256, 0, stream>>>(PROJb, PROJn, (size_t)SEQ * NPROJ, NPROJ, DBG_CLO, DBG_CHI, (float*)(flag + 2)); }
#endif
                }
                if (STEP < 2) {
                    nv::k_moba<<<dim3(NBLK, AH, 1), 256, 0, stream>>>(PROJb, KMEANb, OAb);
                    nv::k_ret<<<dim3(SEQ / 256, RH * 4, 1), 256, 0, stream>>>(PROJb, ORRb);
                    nv::k_cat<<<SEQ, 256, 0, stream>>>(OAb, ORRb, PROJb, in.att_g + l * AW, in.ret_g + l * RW, CATb, STEP >= 1 ? 1 : 0);
                } else {
                    ad::ad_cat<<<SEQ, 256, 0, stream>>>((const unsigned short*)(ws + mk::WS_CAT), (const float*)(ws + mk::WS_ASSQ), in.att_g + l * AW, b, CATb);
                }
                nv::k_gemm<<<dim3(D / 64, SEQ / 64), 256, 0, stream>>>(CATb, D, nullptr, nullptr, SEQ, in.w_out + (size_t)l * D * D, D, Hb, D, D);
                nv::k_resid<<<SEQ, 256, 0, stream>>>(xb, mod + 2 * D, Hb, ob);
            }
        }
        const bool ffn_mega = (l == 0) ? (STEP >= 4) : (STEP >= 5);
        if (ffn_mega) {
            launch_mega(a, pb + 4, pb + 5, 1, stream);
            if (l == 1) launch_mega(a, pb + 5, pb + 6, 1, stream);
            launch_mega(a, pb + 6, pb + 7, 1, stream);
            launch_mega(a, pb + 7, pb + 8, 1, stream);
        } else {
            for (int b = 0; b < BATCH; ++b) {
                const float* mod = MODp + ((size_t)l * BATCH + b) * 6 * D;
                float* ob = out + (size_t)b * SEQ * D;
                nv::k_norm<<<SEQ, 256, 0, stream>>>(ob, in.norm_ffn_g + l * D, mod + 3 * D, mod + 4 * D, Hb);
                if (l == 0) {
                    nv::k_gemm<<<dim3(FF / 64, SEQ / 64), 256, 0, stream>>>(Hb, D, nullptr, nullptr, SEQ, in.fw_gate, FF, Gb, FF, D);
                    nv::k_gemm<<<dim3(FF / 64, SEQ / 64), 256, 0, stream>>>(Hb, D, nullptr, nullptr, SEQ, in.fw_up, FF, Ub, FF, D);
                    nv::k_silu_mul<<<SEQ, 256, 0, stream>>>(Gb, Ub, nullptr, SEQ, FF);
                    nv::k_gemm<<<dim3(D / 64, SEQ / 64), 256, 0, stream>>>(Gb, FF, nullptr, nullptr, SEQ, in.fw_down, D, Ub, D, FF);
                    nv::k_resid<<<SEQ, 256, 0, stream>>>(ob, mod + 5 * D, Ub, ob);
                } else {
                    nv::k_router<<<SEQ / 4, 256, 0, stream>>>(Hb, in.router_w, EIDXb, EWb);
                    nv::k_place<<<1, 1024, 0, stream>>>(EIDXb, LISTb, POSb, CNTb, BASEb, 4);
                    float* GE = Gb; float* UE = Ub;
                    for (int e = 0; e < NE; ++e) {
                        nv::k_gemm<<<dim3(FF / 64, ECAP / 64), 256, 0, stream>>>(Hb, D, LISTb, CNTb + e, ECAP, in.mw_gate + (size_t)e * D * FF, FF, GE, FF, D, BASEb + e, nullptr);
                        nv::k_gemm<<<dim3(FF / 64, ECAP / 64), 256, 0, stream>>>(Hb, D, LISTb, CNTb + e, ECAP, in.mw_up + (size_t)e * D * FF, FF, UE, FF, D, BASEb + e, nullptr);
                        nv::k_silu_mul<<<ECAP, 256, 0, stream>>>(GE, UE, CNTb + e, ECAP, FF);
                        nv::k_gemm<<<dim3(D / 64, ECAP / 64), 256, 0, stream>>>(GE, FF, nullptr, CNTb + e, ECAP, in.mw_down + (size_t)e * FF * D, D, Yb, D, FF, nullptr, BASEb + e);
                    }
                    nv::k_moe_combine<<<SEQ, 256, 0, stream>>>(ob, mod + 5 * D, Yb, POSb, EWb);
                }
            }
        }
    }
    if (STEP >= 5) launch_mega(a, 17, 18, 1, stream);
    else nv::k_norm<<<M, 256, 0, stream>>>(out, in.final_g, nullptr, nullptr, out);
#ifdef DBG_CHECK
#ifdef DBG_ENC
    ad::dbg_encode<<<1, 256, 0, stream>>>((const float*)((unsigned*)(ws + mk::WS_CTL) + 18), (float)SEQ * (DBG_CHI - DBG_CLO), out);
#endif
    ad::dbg_poison<<<1, 256, 0, stream>>>((unsigned*)(ws + mk::WS_CTL) + 16, DBG_T0, out, 100.0f);
    ad::dbg_poison<<<1, 256, 0, stream>>>((unsigned*)(ws + mk::WS_CTL) + 17, DBG_T1, out + (1 << 20), 300.0f);
#endif
#endif
}
```

```cpp
#include <hip/hip_runtime.h>
#include <cstdio>
#include <cstdint>
#include <cmath>

namespace h16 {
typedef _Float16 f16x2_t __attribute__((ext_vector_type(2)));
typedef _Float16 f16x8_t __attribute__((ext_vector_type(8)));
typedef float f32x2_t __attribute__((ext_vector_type(2)));
__device__ __forceinline__ unsigned pk(float lo, float hi) { f32x2_t v = {lo, hi}; f16x2_t b = __builtin_convertvector(v, f16x2_t); return __builtin_bit_cast(unsigned, b); }
__device__ __forceinline__ float lo(unsigned u) { return (float)__builtin_bit_cast(f16x2_t, u)[0]; }
__device__ __forceinline__ float hi(unsigned u) { return (float)__builtin_bit_cast(f16x2_t, u)[1]; }
__device__ __forceinline__ float one(unsigned short s) { return (float)__builtin_bit_cast(_Float16, s); }
}

namespace xl {
template <int O> __device__ __forceinline__ int xor_i(int v) {
    if constexpr (O < 32) return __builtin_amdgcn_ds_swizzle(v, (O << 10) | 0x1f);
    else { static_assert(O < 32, "use add32 / max32 for the 32-lane exchange"); return v; }
}
template <int O> __device__ __forceinline__ float xor_f(float v) { return __builtin_bit_cast(float, xor_i<O>(__builtin_bit_cast(int, v))); }
__device__ __forceinline__ void swap32(unsigned a, unsigned& r0, unsigned& r1) { unsigned b = a; asm volatile("" : "+v"(b)); auto r = __builtin_amdgcn_permlane32_swap(a, b, false, false); r0 = r[0]; r1 = r[1]; }
__device__ __forceinline__ float xor32p(float v, bool upper) { unsigned r0, r1; swap32(__builtin_bit_cast(unsigned, v), r0, r1); return __builtin_bit_cast(float, upper ? r0 : r1); }
__device__ __forceinline__ float add32(float v) { unsigned r0, r1; swap32(__builtin_bit_cast(unsigned, v), r0, r1); return __builtin_bit_cast(float, r0) + __builtin_bit_cast(float, r1); }
__device__ __forceinline__ float max32(float v) { unsigned r0, r1; swap32(__builtin_bit_cast(unsigned, v), r0, r1); return fmaxf(__builtin_bit_cast(float, r0), __builtin_bit_cast(float, r1)); }
__device__ __forceinline__ int add32i(int v) { unsigned r0, r1; swap32((unsigned)v, r0, r1); return (int)(r0 + r1); }
__device__ __forceinline__ float wave_sum(float v) { v += xor_f<1>(v); v += xor_f<2>(v); v += xor_f<4>(v); v += xor_f<8>(v); v += xor_f<16>(v); return add32(v); }
__device__ __forceinline__ int wave_sum_i(int v) { v += xor_i<1>(v); v += xor_i<2>(v); v += xor_i<4>(v); v += xor_i<8>(v); v += xor_i<16>(v); return add32i(v); }
}

__device__ __forceinline__ int olane() { int l; asm volatile("v_mbcnt_lo_u32_b32 %0, -1, 0\n\tv_mbcnt_hi_u32_b32 %0, -1, %0" : "=v"(l)); return l; }
__device__ __forceinline__ int otid(int wv) { return (wv << 6) | olane(); }
#define STEP 6

constexpr int D = 1024, BATCH = 8, SEQ = 2048, M = BATCH * SEQ;
constexpr int AH = 8, AD = 64, AW = 512, MBLK = 256, NBLK = SEQ / MBLK, TOPK = 3;
constexpr int RH = 4, RD = 128, RW = 512;
constexpr int NPROJ = 3 * AW + 4 * RW;
constexpr int FF = 2816, NE = 8;
constexpr float EPS = 1e-6f;
constexpr int ECAP = 2048;
namespace pg8 {
#define PG8_LAS __attribute__((address_space(3)))
typedef unsigned short bf16_t;
typedef short bf16x8 __attribute__((ext_vector_type(8)));
typedef float f32x4 __attribute__((ext_vector_type(4)));
typedef float f32x2 __attribute__((ext_vector_type(2)));
typedef unsigned u32x4 __attribute__((ext_vector_type(4)));
typedef unsigned u32x2 __attribute__((ext_vector_type(2)));
typedef int i32x4 __attribute__((ext_vector_type(4)));
constexpr int BM = 256, BK = 64, HALF = 128, HTB = HALF * BK * 2  , STAGE_BYTES = 8 * HTB, NXCD = 8, WGM = 8;

__host__ __device__ __forceinline__ int lds_byte(int r, int c) { const int st = (r >> 4) * 2 + (c >> 5), rr = r & 15, cc = c & 31, ob = rr * 64 + cc * 2; return st * 1024 + (ob ^ (((ob >> 9) & 1) << 5)); }
__host__ __device__ __forceinline__ void stage_rc(int b, int& R, int& C) { const int st = b / 1024, sb = b % 1024, swz = sb ^ (((sb >> 9) & 1) << 5); R = (st >> 1) * 16 + swz / 64; C = (st & 1) * 32 + (swz % 64) / 2; }
__host__ __device__ __forceinline__ int perm32(int rho) { const int n = rho >> 4, i = rho & 15; return 8 * (i >> 2) + 4 * n + (i & 3); }

struct Unit { int pm, pn, e, kc, li; };
struct Gemm { int lda, ldb, K; };

struct DenseSched {
    const char* A; const char* Bt; size_t a_tile, b_tile;
    int nM, nN, nwg, G, c;
    __device__ __forceinline__ void init(const void* A_, int lda, const void* Bt_, int ldb, int M, int N, int G_, int c_) {
        A = (const char*)A_; Bt = (const char*)Bt_; a_tile = (size_t)BM * lda * 2; b_tile = (size_t)BM * ldb * 2; nM = M / BM; nN = N / BM; nwg = nM * nN; G = G_; c = c_; }
    __device__ __forceinline__ bool next(int i, Unit& u) const {
        const long L = (long)i * G + c; if (L >= nwg) return false;
        int wgid = (int)L; { const int q = nwg / NXCD, r = nwg % NXCD, xcd = wgid % NXCD, off = wgid / NXCD; wgid = (xcd < r ? xcd * (q + 1) : r * (q + 1) + (xcd - r) * q) + off; }
        const int nig = WGM * nN, gid = wgid / nig, fm = gid * WGM, gsz = (nM - fm) < WGM ? (nM - fm) : WGM;
        u.pm = fm + ((wgid % nig) % gsz); u.pn = (wgid % nig) / gsz; u.e = 0; u.kc = 0; u.li = 0; return true;
    }
    __device__ __forceinline__ const char* a_ptr(const Unit& u) const { return A + (size_t)u.pm * a_tile; }
    __device__ __forceinline__ const char* b_ptr(const Unit& u) const { return Bt + (size_t)u.pn * b_tile; }
};
struct MoeSched {
    const char* A; const char* Bt; size_t a_tile, b_tile, e_stride;
    int nM, nN, nwg, G, c; int seg[8]; int first, lim, KS, kbytes;
    __device__ __forceinline__ void init(const void* A_, int lda, const void* Bt_, int ldb, size_t e_stride_bytes, const int* segp_, int N, int G_, int c_) {
        A = (const char*)A_; Bt = (const char*)Bt_; a_tile = (size_t)BM * lda * 2; b_tile = (size_t)BM * ldb * 2; e_stride = e_stride_bytes;
#pragma unroll
        for (int e = 0; e < 8; ++e) seg[e] = __builtin_amdgcn_readfirstlane(segp_[e]);
        nM = __builtin_amdgcn_readfirstlane(segp_[8]) / BM; nN = N / BM; nwg = nM * nN; G = G_; c = c_; first = 0; lim = nwg; KS = 1; kbytes = 0; }
    __device__ __forceinline__ bool next(int i, Unit& u) const {
        const long idx = (long)i * G + c; const long L = first + idx / KS; if (L >= lim) return false;
        u.kc = (int)(idx % KS); u.li = (int)(idx / KS);
        int wgid = (int)L; { const int q = nwg / NXCD, r = nwg % NXCD, xcd = wgid % NXCD, off = wgid / NXCD; wgid = (xcd < r ? xcd * (q + 1) : r * (q + 1) + (xcd - r) * q) + off; }
        const int nig = WGM * nN, gid = wgid / nig, fm = gid * WGM, gsz = (nM - fm) < WGM ? (nM - fm) : WGM;
        u.pm = fm + ((wgid % nig) % gsz); u.pn = (wgid % nig) / gsz;
        int e = 0; const int r0 = u.pm * BM;
#pragma unroll
        for (int k = 1; k < 8; ++k) e = (r0 >= seg[k]) ? k : e;
        u.e = __builtin_amdgcn_readfirstlane(e); return true;
    }
    __device__ __forceinline__ const char* a_ptr(const Unit& u) const { return A + (size_t)u.pm * a_tile + (size_t)u.kc * kbytes; }
    __device__ __forceinline__ const char* b_ptr(const Unit& u) const { return Bt + (size_t)u.e * e_stride + (size_t)u.pn * b_tile + (size_t)u.kc * kbytes; }
};

__device__ __forceinline__ unsigned cvt_pk_bf16(float lo, float hi) { return h16::pk(lo, hi); }
__device__ __forceinline__ float fast_silu(float g) { return g * __builtin_amdgcn_rcpf(1.0f + __builtin_amdgcn_exp2f(-1.4426950408889634f * g)); }

typedef f32x4 Acc[2][2][4][2];
typedef int i32x8 __attribute__((ext_vector_type(8)));
template <bool F8> struct Frags;
template <> struct Frags<false> { bf16x8 At[4][2], B0[2][2], B1[2][2]; };
template <> struct Frags<true> { i32x8 At[4], B0[2], B1[2]; };

template <class Epi, class Sched>
__device__ __forceinline__ void gemm_phase(const int wv, PG8_LAS unsigned char* lds, const Gemm g, const Sched& S, const Epi& E) {
    int tid_ = otid(wv);
    const int tid = tid_, wid = __builtin_amdgcn_readfirstlane(tid >> 6), lane = tid & 63, wr = wid >> 2, wc = wid & 3, fr = lane & 15, fq = lane >> 4;
    const int K = g.K; int nt = K / BK; asm volatile("" : "+s"(nt));
    unsigned voffA[2], voffB[2];
#pragma unroll
    for (int i = 0; i < 2; ++i) { int R, C; stage_rc(tid * 16 + i * 8192, R, C); const int Rb = Epi::PERM ? ((R & ~31) + perm32(R & 31)) : R;
        voffA[i] = (unsigned)(R * g.lda + C) * 2u; voffB[i] = (unsigned)(Rb * g.ldb + C) * 2u; }
    const size_t kstep = (size_t)(BK * 2);
    const size_t hstepA = (size_t)HALF * g.lda * 2, hstepB = (size_t)HALF * g.ldb * 2;
    const unsigned ldsw = (unsigned)wid * 1024u;
    const unsigned ldsbase_ = (unsigned)__builtin_amdgcn_readfirstlane((int)((unsigned)(unsigned long)lds + ldsw));
    const int aoff = lds_byte(wr * 64 + fr, fq * 8), boff = lds_byte(wc * 32 + fr, fq * 8);
#define PG8_SA(b, h) (((b) * 2 + (h)) * HTB)
#define PG8_SB(b, h) ((4 + (b) * 2 + (h)) * HTB)
#define PG8_STAGE(bufoff, gbase, voff) do { if constexpr (Epi::FP8) {   \
            const unsigned long long gb_ = (unsigned long long)(gbase); \
            const unsigned long long sb_ = ((unsigned long long)(unsigned)__builtin_amdgcn_readfirstlane((int)(gb_ >> 32)) << 32) | (unsigned)__builtin_amdgcn_readfirstlane((int)gb_); \
            _Pragma("unroll") for (int _i = 0; _i < 2; ++_i) { unsigned keep_; \
                asm volatile("s_mov_b32 %0, m0\n\ts_mov_b32 m0, %3\n\ts_nop 0\n\tglobal_load_lds_dwordx4 %1, %2\n\ts_mov_b32 m0, %0" : "=&s"(keep_) : "v"((voff)[_i]), "s"(sb_), "s"(ldsbase_ + (unsigned)((bufoff) + _i * 8192)) : "memory"); } \
        } else { _Pragma("unroll") for (int _i = 0; _i < 2; ++_i) \
        __builtin_amdgcn_global_load_lds((const unsigned*)((const char*)(gbase) + (voff)[_i]), (PG8_LAS unsigned*)(lds + (bufoff) + ldsw + _i * 8192), 16, 0, 0); } } while (0)
#define PG8_LDA(dst, b, h) do { if constexpr (Epi::FP8) { _Pragma("unroll") for (int m = 0; m < 4; ++m) { const i32x4 lo_ = *(const PG8_LAS i32x4*)(lds + PG8_SA(b, h) + aoff + m * 2048), hi_ = *(const PG8_LAS i32x4*)(lds + PG8_SA(b, h) + aoff + m * 2048 + 1024); F.dst[m] = __builtin_shufflevector(lo_, hi_, 0, 1, 2, 3, 4, 5, 6, 7); } } \
        else { _Pragma("unroll") for (int m = 0; m < 4; ++m) _Pragma("unroll") for (int k = 0; k < 2; ++k) F.dst[m][k] = *(const PG8_LAS bf16x8*)(lds + PG8_SA(b, h) + aoff + m * 2048 + k * 1024); } } while (0)
#define PG8_LDB(dst, b, h) do { if constexpr (Epi::FP8) { _Pragma("unroll") for (int n = 0; n < 2; ++n) { const i32x4 lo_ = *(const PG8_LAS i32x4*)(lds + PG8_SB(b, h) + boff + n * 2048), hi_ = *(const PG8_LAS i32x4*)(lds + PG8_SB(b, h) + boff + n * 2048 + 1024); F.dst[n] = __builtin_shufflevector(lo_, hi_, 0, 1, 2, 3, 4, 5, 6, 7); } } \
        else { _Pragma("unroll") for (int n = 0; n < 2; ++n) _Pragma("unroll") for (int k = 0; k < 2; ++k) F.dst[n][k] = *(const PG8_LAS bf16x8*)(lds + PG8_SB(b, h) + boff + n * 2048 + k * 1024); } } while (0)
#define PG8_MMA(ai, bj, At, Bt) do { __builtin_amdgcn_s_setprio(1); \
        if constexpr (Epi::FP8) {   \
            _Pragma("unroll") for (int m = 0; m < 4; ++m) _Pragma("unroll") for (int n = 0; n < 2; ++n) \
                acc[ai][bj][m][n] = __builtin_amdgcn_mfma_scale_f32_16x16x128_f8f6f4(F.Bt[n], F.At[m], acc[ai][bj][m][n], 0, 0, 0, Epi::SCALE_W, 0, 0x7f7f7f7f); \
        } else { _Pragma("unroll") for (int m = 0; m < 4; ++m) _Pragma("unroll") for (int n = 0; n < 2; ++n) _Pragma("unroll") for (int k = 0; k < 2; ++k) \
            acc[ai][bj][m][n] = __builtin_amdgcn_mfma_f32_16x16x32_f16(__builtin_bit_cast(h16::f16x8_t, F.Bt[n][k]), __builtin_bit_cast(h16::f16x8_t, F.At[m][k]), acc[ai][bj][m][n], 0, 0, 0); } \
        __builtin_amdgcn_s_setprio(0); } while (0)
#define PG8_WAIT_V(n) asm volatile("s_waitcnt vmcnt(" #n ")" ::: "memory")
#define PG8_WAIT_L(n) asm volatile("s_waitcnt lgkmcnt(" #n ")" ::: "memory")
#define PG8_BAR __builtin_amdgcn_s_barrier()
#define PG8_SCHED __builtin_amdgcn_sched_barrier(0)
    Unit cur, nxt; int ui = 0;
    if (!S.next(0, cur)) return;
    Acc acc;
#pragma unroll
    for (int a = 0; a < 2; ++a)
#pragma unroll
        for (int b = 0; b < 2; ++b)
#pragma unroll
            for (int m = 0; m < 4; ++m)
#pragma unroll
                for (int n = 0; n < 2; ++n) acc[a][b][m][n] = (f32x4){0.f, 0.f, 0.f, 0.f};
    const char* cA = S.a_ptr(cur); const char* cB = S.b_ptr(cur);
    if constexpr (Epi::MID_T > 0) E.pre(cur, lds, tid);
    PG8_STAGE(PG8_SB(0, 0), cB, voffB); PG8_STAGE(PG8_SB(0, 1), cB + hstepB, voffB); PG8_STAGE(PG8_SA(0, 0), cA, voffA); PG8_STAGE(PG8_SA(0, 1), cA + hstepA, voffA);
    if (wr == 1) PG8_BAR;
    PG8_WAIT_V(2); PG8_BAR;
    PG8_STAGE(PG8_SB(1, 0), cB + kstep, voffB); PG8_STAGE(PG8_SA(1, 0), cA + kstep, voffA); PG8_STAGE(PG8_SB(1, 1), cB + hstepB + kstep, voffB);
    PG8_WAIT_V(6); PG8_BAR;
    for (;;) {
        const bool has_next = S.next(ui + 1, nxt);
        const char* nA = has_next ? S.a_ptr(nxt) : cA; const char* nB = has_next ? S.b_ptr(nxt) : cB;
        for (int t = 0; t < nt; t += 2) {
            if constexpr (Epi::MID_T > 0) { if (t == Epi::MID_T) E.mid(acc, lds, wr, fr); }
            const bool last = (t == nt - 2);
            Frags<Epi::FP8> F;
            const char* a1 = cA + (size_t)(t + 1) * kstep;
            const char* a2 = last ? nA : cA + (size_t)(t + 2) * kstep; const char* b2 = last ? nB : cB + (size_t)(t + 2) * kstep;
            const char* a3 = a2 + kstep; const char* b3 = b2 + kstep;
            PG8_LDB(B0, 0, 0); PG8_LDB(B1, 0, 1); PG8_SCHED; PG8_LDA(At, 0, 0); PG8_STAGE(PG8_SA(1, 1), a1 + hstepA, voffA);
            PG8_WAIT_V(8); PG8_WAIT_L(0); PG8_BAR; PG8_MMA(0, 0, At, B0); PG8_MMA(0, 1, At, B1); PG8_BAR; PG8_SCHED;
            PG8_LDA(At, 0, 1); PG8_STAGE(PG8_SB(0, 0), b2, voffB); PG8_STAGE(PG8_SB(0, 1), b2 + hstepB, voffB); PG8_STAGE(PG8_SA(0, 0), a2, voffA);
            PG8_WAIT_V(8); PG8_WAIT_L(0); PG8_BAR; PG8_MMA(1, 0, At, B0); PG8_MMA(1, 1, At, B1); PG8_BAR; PG8_SCHED;
            PG8_LDB(B0, 1, 0); PG8_LDB(B1, 1, 1); PG8_SCHED; PG8_LDA(At, 1, 0); PG8_STAGE(PG8_SA(0, 1), a2 + hstepA, voffA);
            PG8_WAIT_V(8); PG8_WAIT_L(0); PG8_BAR; PG8_MMA(0, 0, At, B0); PG8_MMA(0, 1, At, B1); PG8_BAR; PG8_SCHED;
            PG8_LDA(At, 1, 1); PG8_STAGE(PG8_SB(1, 0), b3, voffB); PG8_STAGE(PG8_SB(1, 1), b3 + hstepB, voffB); PG8_STAGE(PG8_SA(1, 0), a3, voffA);
            PG8_WAIT_V(8); PG8_WAIT_L(0); PG8_BAR; PG8_MMA(1, 0, At, B0); PG8_MMA(1, 1, At, B1); PG8_BAR; PG8_SCHED;
        }
        if (wr == 0) PG8_BAR;
        { const int t2_ = olane(); E(acc, cur, wr, wc, t2_ & 15, t2_ >> 4); }
        if (!has_next) break;
#pragma unroll
        for (int a = 0; a < 2; ++a)
#pragma unroll
            for (int b = 0; b < 2; ++b)
#pragma unroll
                for (int m = 0; m < 4; ++m)
#pragma unroll
                    for (int n = 0; n < 2; ++n) acc[a][b][m][n] = (f32x4){0.f, 0.f, 0.f, 0.f};
        cur = nxt; cA = nA; cB = nB; ++ui;
        if (wr == 1) PG8_BAR;
    }
    PG8_WAIT_V(0);
    PG8_BAR;
#undef PG8_SA
#undef PG8_SB
#undef PG8_STAGE
#undef PG8_LDA
#undef PG8_LDB
#undef PG8_MMA
#undef PG8_WAIT_V
#undef PG8_WAIT_L
#undef PG8_BAR
#undef PG8_SCHED
}
}
namespace epi {
#define PG8_LAS __attribute__((address_space(3)))
using pg8::Acc; using pg8::Unit; using pg8::f32x4; using pg8::u32x4; using pg8::bf16_t; using pg8::cvt_pk_bf16; using pg8::fast_silu;
constexpr int HALF = 128;
constexpr float C2 = 0.125f * 1.4426950408889634f;
constexpr float KSC = 0.08838834764831845f;

__device__ __forceinline__ u32x4 pack8(const f32x4 v0, const f32x4 v1) { u32x4 w; w.x = cvt_pk_bf16(v0[0], v0[1]); w.y = cvt_pk_bf16(v0[2], v0[3]); w.z = cvt_pk_bf16(v1[0], v1[1]); w.w = cvt_pk_bf16(v1[2], v1[3]); return w; }

struct EpiInProj {
    static constexpr bool PERM = true; static constexpr int MID_T = 0; static constexpr bool FP8 = false; static constexpr int SCALE_W = 0;
    bf16_t* O; size_t gstride;
    float* KMP;
    const float* ROPE;
    __device__ __forceinline__ void operator()(const Acc& acc, const Unit& u, int wr, int wc, int fr, int fq) const {
        const int grp = u.pn >> 1;
        const int col0 = (u.pn & 1) * 256 + wc * 32 + 8 * fq;
        const int row0 = u.pm * 256 + wr * 64 + fr;
        bf16_t* base = O + (size_t)grp * gstride;
        f32x4 cs[2][2];
#pragma unroll
        for (int bj = 0; bj < 2; ++bj) { cs[bj][0] = (f32x4){0.f, 0.f, 0.f, 0.f}; cs[bj][1] = (f32x4){0.f, 0.f, 0.f, 0.f}; }
#pragma unroll
        for (int ai = 0; ai < 2; ++ai)
#pragma unroll
            for (int m = 0; m < 4; ++m) {
                const int row = row0 + ai * HALF + m * 16;
                bf16_t* rowp = base + (size_t)row * 512 + col0;
                f32x4 t0 = (f32x4){0.f, 0.f, 0.f, 0.f}, t1 = t0;
                if (grp == 3 || grp == 4) { const float* tp = ROPE + ((size_t)(row & 2047) * 64 + 16 * wc + 4 * fq) * 2; t0 = *(const f32x4*)tp; t1 = *(const f32x4*)(tp + 4); }
#pragma unroll
                for (int bj = 0; bj < 2; ++bj) {
                    f32x4 v0 = acc[ai][bj][m][0], v1 = acc[ai][bj][m][1];
                    if (grp == 0) { v0 = v0 * C2; v1 = v1 * C2; }
                    else if (grp == 1) { cs[bj][0] += v0; cs[bj][1] += v1; }
                    else if (grp == 3 || grp == 4) {
                        const float sc = (grp == 4) ? KSC : 1.0f;
                        f32x4 r0, r1;
                        r0[0] = (v0[0] * t0[0] - v0[1] * t0[1]) * sc; r0[1] = (v0[0] * t0[1] + v0[1] * t0[0]) * sc;
                        r0[2] = (v0[2] * t0[2] - v0[3] * t0[3]) * sc; r0[3] = (v0[2] * t0[3] + v0[3] * t0[2]) * sc;
                        r1[0] = (v1[0] * t1[0] - v1[1] * t1[1]) * sc; r1[1] = (v1[0] * t1[1] + v1[1] * t1[0]) * sc;
                        r1[2] = (v1[2] * t1[2] - v1[3] * t1[3]) * sc; r1[3] = (v1[2] * t1[3] + v1[3] * t1[2]) * sc;
                        v0 = r0; v1 = r1;
                    } else if (grp == 6) {
#pragma unroll
                        for (int j = 0; j < 4; ++j) { v0[j] = fast_silu(v0[j]); v1[j] = fast_silu(v1[j]); }
                    }
                    *(u32x4*)(rowp + bj * HALF) = pack8(v0, v1);
                }
            }
        if (grp == 1) {
#pragma unroll
            for (int bj = 0; bj < 2; ++bj)
#pragma unroll
                for (int n = 0; n < 2; ++n) {
                    f32x4 s = cs[bj][n];
#pragma unroll
                    for (int c4 = 0; c4 < 4; ++c4) { float t = s[c4]; t += xl::xor_f<1>(t); t += xl::xor_f<2>(t); t += xl::xor_f<4>(t); t += xl::xor_f<8>(t); s[c4] = t; }
                    if (fr == 0) *(f32x4*)(KMP + (size_t)(u.pm * 2 + wr) * 512 + col0 + bj * HALF + 4 * n) = s;
                }
        }
    }
};

struct EpiOutProj {
    static constexpr bool PERM = false; static constexpr int MID_T = 8; static constexpr bool FP8 = false; static constexpr int SCALE_W = 0;
    const float* xin; float* out; const float* g1;
    const float* assq;
    bool dry;
    static constexpr int RS_OFF = 131072 + 8192;
    __device__ __forceinline__ void pre(const Unit& u, PG8_LAS unsigned char* lds, int tid) const {
        if (tid < 256) { const int row = u.pm * 256 + tid;
            const f32x4 a = *(const f32x4*)(assq + (size_t)row * 8), c = *(const f32x4*)(assq + (size_t)row * 8 + 4);
            const float ss = ((a[0] + a[1]) + (a[2] + a[3])) + ((c[0] + c[1]) + (c[2] + c[3]));
            ((PG8_LAS float*)(lds + RS_OFF))[tid] = 1.0f / sqrtf(ss * (1.0f / 512.0f) + 1e-6f); }
    }
    __device__ __forceinline__ void mid(Acc& acc, PG8_LAS unsigned char* lds, int wr, int fr) const {
        const PG8_LAS float* tab = (const PG8_LAS float*)(lds + RS_OFF) + wr * 64 + fr;
#pragma unroll
        for (int ai = 0; ai < 2; ++ai)
#pragma unroll
            for (int m = 0; m < 4; ++m) {
                const float rs = tab[ai * HALF + m * 16];
#pragma unroll
                for (int bj = 0; bj < 2; ++bj)
#pragma unroll
                    for (int n = 0; n < 2; ++n) acc[ai][bj][m][n] = acc[ai][bj][m][n] * rs;
            }
    }
    __device__ __forceinline__ void operator()(const Acc& acc, const Unit& u, int wr, int wc, int fr, int fq) const {
        const int b = u.pm >> 3;
        const int col0 = u.pn * 256 + wc * 32 + 4 * fq;
        const int row0 = u.pm * 256 + wr * 64 + fr;
        f32x4 gv[2][2];
#pragma unroll
        for (int bj = 0; bj < 2; ++bj)
#pragma unroll
            for (int n = 0; n < 2; ++n) gv[bj][n] = *(const f32x4*)(g1 + (size_t)b * 6144 + col0 + bj * HALF + n * 16);
#pragma unroll
        for (int ai = 0; ai < 2; ++ai)
#pragma unroll
            for (int m = 0; m < 4; ++m) {
                const size_t off = (size_t)(row0 + ai * HALF + m * 16) * 1024 + col0;
#pragma unroll
                for (int bj = 0; bj < 2; ++bj)
#pragma unroll
                    for (int n = 0; n < 2; ++n) { const f32x4 bs = *(const f32x4*)(xin + off + bj * HALF + n * 16); const f32x4 r = bs + gv[bj][n] * acc[ai][bj][m][n]; if (!dry) *(f32x4*)(out + off + bj * HALF + n * 16) = r; else asm volatile("" :: "v"(r)); }
            }
    }
};

struct EpiSwiGLU {
    static constexpr bool PERM = true; static constexpr int MID_T = 0; static constexpr bool FP8 = false; static constexpr int SCALE_W = 0;
    bf16_t* H; int ldh;
    __device__ __forceinline__ void operator()(const Acc& acc, const Unit& u, int wr, int wc, int fr, int fq) const {
        const int col0 = u.pn * 128 + wc * 32 + 8 * fq;
        const int row0 = u.pm * 256 + wr * 64 + fr;
#pragma unroll
        for (int ai = 0; ai < 2; ++ai)
#pragma unroll
            for (int m = 0; m < 4; ++m) {
                const int row = row0 + ai * HALF + m * 16;
                f32x4 v0, v1;
#pragma unroll
                for (int j = 0; j < 4; ++j) { v0[j] = fast_silu(acc[ai][0][m][0][j]) * acc[ai][1][m][0][j]; v1[j] = fast_silu(acc[ai][0][m][1][j]) * acc[ai][1][m][1][j]; }
                *(u32x4*)(H + (size_t)row * ldh + col0) = pack8(v0, v1);
            }
    }
};

struct EpiDown {
    static constexpr bool PERM = false; static constexpr int MID_T = 0; static constexpr bool FP8 = false; static constexpr int SCALE_W = 0;
    float* out; const float* g2; bf16_t* YS; const int* srow; const float* swt; bool moe; bool dry; int* atomf; bool atomic; float* slab; int KS;
    __device__ __forceinline__ void operator()(const Acc& acc, const Unit& u, int wr, int wc, int fr, int fq) const {
        const int col0 = u.pn * 256 + wc * 32 + 4 * fq;
        const int row0 = u.pm * 256 + wr * 64 + fr;
        if (!moe) {
            const int b = u.pm >> 3;
            f32x4 gv[2][2];
#pragma unroll
            for (int bj = 0; bj < 2; ++bj)
#pragma unroll
                for (int n = 0; n < 2; ++n) gv[bj][n] = *(const f32x4*)(g2 + (size_t)b * 6144 + col0 + bj * HALF + n * 16);
#pragma unroll
            for (int ai = 0; ai < 2; ++ai)
#pragma unroll
                for (int m = 0; m < 4; ++m) {
                    const size_t off = (size_t)(row0 + ai * HALF + m * 16) * 1024 + col0;
#pragma unroll
                    for (int bj = 0; bj < 2; ++bj)
#pragma unroll
                        for (int n = 0; n < 2; ++n) { const f32x4 bs = *(const f32x4*)(out + off + bj * HALF + n * 16); const f32x4 r = bs + gv[bj][n] * acc[ai][bj][m][n]; if (!dry) *(f32x4*)(out + off + bj * HALF + n * 16) = r; else asm volatile("" :: "v"(r)); }
                }
        } else if (atomic) {
            float* sl = slab + ((size_t)(u.li * KS + u.kc) * 256) * 256 + (wc * 32 + 4 * fq);
#pragma unroll
            for (int ai = 0; ai < 2; ++ai)
#pragma unroll
                for (int m = 0; m < 4; ++m) {
                    const int rl = ai * HALF + wr * 64 + m * 16 + fr; const int pos = u.pm * 256 + rl;
                    const int sr = srow[pos];
                    if (sr >= 0) { const float w = swt[pos];
                        if (u.kc == 0 && wc == 0 && fq == 0) atomf[sr * 4 + u.pn] = 1 + u.li * 256 + rl;
#pragma unroll
                        for (int bj = 0; bj < 2; ++bj)
#pragma unroll
                            for (int n = 0; n < 2; ++n) *(f32x4*)(sl + (size_t)rl * 256 + bj * HALF + n * 16) = acc[ai][bj][m][n] * w; }
                }
        } else {
#pragma unroll
            for (int ai = 0; ai < 2; ++ai)
#pragma unroll
                for (int m = 0; m < 4; ++m) {
                    const int pos = row0 + ai * HALF + m * 16;
                    const int sr = srow[pos];
                    if (sr >= 0) { const float w = swt[pos]; bf16_t* rowp = YS + (size_t)sr * 1024 + col0;
#pragma unroll
                        for (int bj = 0; bj < 2; ++bj)
#pragma unroll
                            for (int n = 0; n < 2; ++n) { const f32x4 v = acc[ai][bj][m][n] * w; pg8::u32x2 o; o.x = cvt_pk_bf16(v[0], v[1]); o.y = cvt_pk_bf16(v[2], v[3]); if (!dry) *(pg8::u32x2*)(rowp + bj * HALF + n * 16) = o; else asm volatile("" :: "v"(o)); } }
                }
        }
    }
};

__device__ __forceinline__ float clamp448(float v) { return __builtin_fminf(__builtin_fmaxf(v, -448.0f), 448.0f); }
__device__ __forceinline__ unsigned pk4_fp8(float a, float b, float c, float d) {
    int p = 0; p = __builtin_amdgcn_cvt_pk_fp8_f32(clamp448(a), clamp448(b), p, false); p = __builtin_amdgcn_cvt_pk_fp8_f32(clamp448(c), clamp448(d), p, true); return (unsigned)p; }
struct EpiSwiGLU8 {
    static constexpr bool PERM = true; static constexpr int MID_T = 0; static constexpr bool FP8 = true; static constexpr int SCALE_W = 0x7a7a7a7a;
    unsigned char* H; int ldh;
    __device__ __forceinline__ void operator()(const Acc& acc, const Unit& u, int wr, int wc, int fr, int fq) const {
        const int col0 = u.pn * 128 + wc * 32 + 8 * fq;
        const int row0 = u.pm * 256 + wr * 64 + fr;
#pragma unroll
        for (int ai = 0; ai < 2; ++ai)
#pragma unroll
            for (int m = 0; m < 4; ++m) {
                const int row = row0 + ai * HALF + m * 16;
                f32x4 v0, v1;
#pragma unroll
                for (int j = 0; j < 4; ++j) { v0[j] = fast_silu(acc[ai][0][m][0][j]) * acc[ai][1][m][0][j]; v1[j] = fast_silu(acc[ai][0][m][1][j]) * acc[ai][1][m][1][j]; }
                pg8::u32x2 w; w.x = pk4_fp8(v0[0], v0[1], v0[2], v0[3]); w.y = pk4_fp8(v1[0], v1[1], v1[2], v1[3]);
                *(pg8::u32x2*)(H + (size_t)row * ldh + col0) = w;
            }
    }
};
struct EpiDownDense8 {
    static constexpr bool PERM = false; static constexpr int MID_T = 0; static constexpr bool FP8 = true; static constexpr int SCALE_W = 0x79797979;
    float* out; const float* g2; bool dry;
    __device__ __forceinline__ void operator()(const Acc& acc, const Unit& u, int wr, int wc, int fr, int fq) const {
        const int col0 = u.pn * 256 + wc * 32 + 4 * fq;
        const int row0 = u.pm * 256 + wr * 64 + fr;
        const int b = u.pm >> 3;
        f32x4 gv[2][2];
#pragma unroll
        for (int bj = 0; bj < 2; ++bj)
#pragma unroll
            for (int n = 0; n < 2; ++n) gv[bj][n] = *(const f32x4*)(g2 + (size_t)b * 6144 + col0 + bj * HALF + n * 16);
#pragma unroll
        for (int ai = 0; ai < 2; ++ai)
#pragma unroll
            for (int m = 0; m < 4; ++m) {
                const size_t off = (size_t)(row0 + ai * HALF + m * 16) * 1024 + col0;
#pragma unroll
                for (int bj = 0; bj < 2; ++bj)
#pragma unroll
                    for (int n = 0; n < 2; ++n) { const f32x4 bs = *(const f32x4*)(out + off + bj * HALF + n * 16); const f32x4 r = bs + gv[bj][n] * acc[ai][bj][m][n]; if (!dry) *(f32x4*)(out + off + bj * HALF + n * 16) = r; else asm volatile("" :: "v"(r)); }
            }
    }
};
struct EpiDownMoe8 {
    static constexpr bool PERM = false; static constexpr int MID_T = 0; static constexpr bool FP8 = true; static constexpr int SCALE_W = 0x79797979;
    bf16_t* YS; const int* srow; const float* swt;
    __device__ __forceinline__ void operator()(const Acc& acc, const Unit& u, int wr, int wc, int fr, int fq) const {
        const int col0 = u.pn * 256 + wc * 32 + 4 * fq;
        const int row0 = u.pm * 256 + wr * 64 + fr;
#pragma unroll
        for (int ai = 0; ai < 2; ++ai)
#pragma unroll
            for (int m = 0; m < 4; ++m) {
                const int pos = row0 + ai * HALF + m * 16;
                const int sr = srow[pos];
                if (sr >= 0) { const float w = swt[pos]; bf16_t* rowp = YS + (size_t)sr * 1024 + col0;
#pragma unroll
                    for (int bj = 0; bj < 2; ++bj)
#pragma unroll
                        for (int n = 0; n < 2; ++n) { const f32x4 v = acc[ai][bj][m][n] * w; pg8::u32x2 o; o.x = cvt_pk_bf16(v[0], v[1]); o.y = cvt_pk_bf16(v[2], v[3]); *(pg8::u32x2*)(rowp + bj * HALF + n * 16) = o; } }
            }
    }
};
struct EpiDownMoe8Slab {
    static constexpr bool PERM = false; static constexpr int MID_T = 0; static constexpr bool FP8 = true; static constexpr int SCALE_W = 0x79797979;
    const int* srow; const float* swt; int* atomf; float* slab; int KS;
    __device__ __forceinline__ void operator()(const Acc& acc, const Unit& u, int wr, int wc, int fr, int fq) const {
        float* sl = slab + ((size_t)(u.li * KS + u.kc) * 256) * 256 + (wc * 32 + 4 * fq);
#pragma unroll
        for (int ai = 0; ai < 2; ++ai)
#pragma unroll
            for (int m = 0; m < 4; ++m) {
                const int rl = ai * HALF + wr * 64 + m * 16 + fr; const int pos = u.pm * 256 + rl;
                const int sr = srow[pos];
                if (sr >= 0) { const float w = swt[pos];
                    if (u.kc == 0 && wc == 0 && fq == 0) atomf[sr * 4 + u.pn] = 1 + u.li * 256 + rl;
#pragma unroll
                    for (int bj = 0; bj < 2; ++bj)
#pragma unroll
                        for (int n = 0; n < 2; ++n) *(f32x4*)(sl + (size_t)rl * 256 + bj * HALF + n * 16) = acc[ai][bj][m][n] * w; }
            }
    }
};
}
namespace fa {
#define FA_LAS __attribute__((address_space(3)))
typedef unsigned short bf16_t;
typedef short bf16x8 __attribute__((ext_vector_type(8)));
typedef short s16x4 __attribute__((ext_vector_type(4)));
typedef float f32x16 __attribute__((ext_vector_type(16)));
typedef float f32x4 __attribute__((ext_vector_type(4)));
typedef unsigned u32x4 __attribute__((ext_vector_type(4)));
typedef float f32x2_t __attribute__((ext_vector_type(2))); typedef __bf16 bf16x2_t __attribute__((ext_vector_type(2)));
constexpr int L_WSF = 131072 + 1024, L_KM = L_WSF + 2048;
constexpr float NEG = -1.0e30f;
__device__ __forceinline__ int crow(int r, int hi) { return (r & 3) + 8 * (r >> 2) + 4 * hi; }
__device__ __forceinline__ void glds16(const void* gsrc, unsigned lds_dst) { unsigned keep;
    asm volatile("s_mov_b32 %0, m0\n\ts_mov_b32 m0, %2\n\ts_nop 0\n\tglobal_load_lds_dwordx4 %1, off\n\ts_mov_b32 m0, %0" : "=&s"(keep) : "v"(gsrc), "s"(lds_dst) : "memory"); }
__device__ __forceinline__ unsigned cvtpk_s(float lo, float hi) { return h16::pk(lo, hi); }
__device__ __forceinline__ float bf2f(short s) { return h16::one((unsigned short)s); }
typedef short v4i16_t __attribute__((ext_vector_type(4)));
__device__ __forceinline__ s16x4 vtr(FA_LAS const unsigned char* p) { return __builtin_bit_cast(s16x4, __builtin_amdgcn_ds_read_tr16_b64_v4i16((FA_LAS v4i16_t*)p)); }
#define FA_WAIT_BAR() asm volatile("s_waitcnt vmcnt(0) lgkmcnt(0)\n\ts_barrier" ::: "memory")
#define FA_LBAR() asm volatile("s_waitcnt lgkmcnt(0)\n\ts_barrier" ::: "memory")

struct Tensors {
    const bf16_t* Q; const bf16_t* K; const bf16_t* V;
    bf16_t* CAT;
    float* ASSQ;
    const float* KMP;
    const bf16_t* GR;
    const float* ret_g;
    const float* KVM;
};

template <bool RET>
__device__ __forceinline__ void attn_unit(const int wv, int b, int h, int qblk, const Tensors& T, FA_LAS unsigned char* shm) {
    constexpr int NS = RET ? 3 : 4, DIST = NS - 1;
    constexpr int DH = RET ? 128 : 64, ND0 = DH / 16, NDB = DH / 32, NPC = DH / 64, SLOT = 64 * DH * 2, L_K = 0, L_V = NS * SLOT, PER = 2 * NPC, L_R = 98304;
    int tid_ = otid(wv);
    const int tid = tid_, lane = tid & 63, r32 = lane & 31, hi = lane >> 5; const int wid = __builtin_amdgcn_readfirstlane(tid >> 6);
    const size_t rowbase = (size_t)b * 2048; const int q0 = qblk * 256;
    const unsigned lds0 = (unsigned)(unsigned long)shm;
    FA_LAS float* wsf = (FA_LAS float*)(shm + L_WSF) + wid * 64;
    FA_LAS float* KM = (FA_LAS float*)(shm + L_KM);
    const bf16_t* Kh = T.K + rowbase * 512 + h * DH; const bf16_t* Vh = T.V + rowbase * 512 + h * DH;
    const int NT = RET ? 4 : 4 * (qblk + 1);
#define FA_KV0(i) ((((i) < 4) ? qblk : (qblk - 1 - (((i) - 4) >> 2))) * 256 + ((i) & 3) * 64)
#define FA_DMA(i) do { const int kv0_ = FA_KV0(i); const unsigned so_ = (unsigned)(((i) % NS) * SLOT); \
        _Pragma("unroll") for (int pp = 0; pp < NPC; ++pp) { const int p = wid + 8 * pp; \
            glds16(Kh + (size_t)(kv0_ + lane) * 512 + p * 8, (unsigned)__builtin_amdgcn_readfirstlane(lds0 + L_K + so_ + p * 1024)); } \
        _Pragma("unroll") for (int pp = 0; pp < NPC; ++pp) { const int p = wid + 8 * pp; \
            glds16(Vh + (size_t)(kv0_ + 16 * (p & 3) + (lane >> 2)) * 512 + (p >> 2) * 32 + (lane & 3) * 8, (unsigned)__builtin_amdgcn_readfirstlane(lds0 + L_V + so_ + p * 1024)); } } while (0)
    FA_DMA(0); if (NT > 1) FA_DMA(1); if (DIST > 2 && NT > 2) FA_DMA(2);
    const bf16_t* Qw = T.Q + (rowbase + q0 + wid * 32 + r32) * 512 + h * DH;
    bf16x8 qr[ND0];
#pragma unroll
    for (int d0 = 0; d0 < ND0; ++d0) qr[d0] = *(const bf16x8*)(Qw + d0 * 16 + hi * 8);
    unsigned selmask = 0xffu;
    float cfac[16]; float lg2 = 0.f;
    if (!RET) {
        { const int j = tid >> 6, d = tid & 63; const float* kp = T.KMP + ((size_t)(b * 8 + j) * 2) * 512 + h * 64 + d; KM[tid] = kp[0] + kp[512]; }
        FA_LBAR();
        float g[8];
#pragma unroll
        for (int j = 0; j < 8; ++j) g[j] = 0.f;
#pragma unroll
        for (int d0 = 0; d0 < ND0; ++d0)
#pragma unroll
            for (int jj = 0; jj < 8; ++jj) { const float qv = bf2f(qr[d0][jj]); const int d = 16 * d0 + 8 * hi + jj;
#pragma unroll
                for (int j = 0; j < 8; ++j) g[j] += qv * KM[j * 64 + d]; }
#pragma unroll
        for (int j = 0; j < 8; ++j) g[j] = xl::add32(g[j]);
        selmask = 0u;
#pragma unroll
        for (int j = 0; j < 8; ++j) { int rank = 0;
#pragma unroll
            for (int mm = 0; mm < 8; ++mm) rank += (mm < qblk && (g[mm] > g[j] || (g[mm] == g[j] && mm < j))) ? 1 : 0;
            if (j < qblk && rank < 3) selmask |= 1u << j; }
    } else {
        lg2 = log2f(1.0f - exp2f(-5.0f - (float)h));
#pragma unroll
        for (int r = 0; r < 16; ++r) cfac[r] = exp2f(-lg2 * (float)((r & 3) + 8 * (r >> 2)));
    }
    f32x16 o[NDB];
#pragma unroll
    for (int db = 0; db < NDB; ++db) o[db] = f32x16{};
    float mhat = 0.f, lrow = 0.f; f32x16 negm = f32x16{}; constexpr float THR = 8.0f;
    if (RET && qblk > 0) {
        const float* kvb = T.KVM + ((size_t)(b * 4 + h) * 8) * 16384;
        const float g256 = exp2f(lg2 * 256.0f);
#pragma unroll 2
        for (int it = 0; it < 8; ++it) { const int idx4 = tid + 512 * it; const int d = idx4 >> 5, e0 = (idx4 & 31) * 4;
            f32x4 acc4 = (f32x4){0.f, 0.f, 0.f, 0.f};
            for (int m = 0; m < qblk; ++m) acc4 = acc4 * g256 + *(const f32x4*)(kvb + (size_t)m * 16384 + d * 128 + e0);
            const int rp = (d & ~12) | ((d & 8) >> 1) | ((d & 4) << 1);
            typedef unsigned u32x2_ __attribute__((ext_vector_type(2)));
            u32x2_ w; w.x = cvtpk_s(acc4[0], acc4[1]); w.y = cvtpk_s(acc4[2], acc4[3]);
            *(FA_LAS u32x2_*)(shm + L_R + (e0 >> 5) * 8192 + rp * 64 + (e0 & 31) * 2) = w; }
        FA_LBAR();
        { FA_LAS const unsigned char* rb = shm + L_R + ((lane >> 4) & 1) * 32 + (lane & 3) * 8 + (4 * hi + ((lane & 15) >> 2)) * 64;
#pragma unroll
          for (int db = 0; db < NDB; ++db)
#pragma unroll
              for (int d0 = 0; d0 < ND0; ++d0) { const s16x4 lo = vtr(rb + db * 8192 + d0 * 1024), hh = vtr(rb + db * 8192 + d0 * 1024 + 512);
                  const bf16x8 rf = (bf16x8){lo[0], lo[1], lo[2], lo[3], hh[0], hh[1], hh[2], hh[3]};
                  o[db] = __builtin_amdgcn_mfma_f32_32x32x16_f16(__builtin_bit_cast(h16::f16x8_t, qr[d0]), __builtin_bit_cast(h16::f16x8_t, rf), o[db], 0, 0, 0); } }
#pragma unroll
        for (int r = 0; r < 16; ++r) { const float rd = exp2f(lg2 * (float)(wid * 32 + crow(r, hi) + 1));
#pragma unroll
            for (int db = 0; db < NDB; ++db) o[db][r] *= rd; }
    }
    const int qrel = wid * 32 + r32;
    for (int i = 0; i < NT; ++i) {
        { const int ahead = (NT - 1 - i) < (DIST - 1) ? (NT - 1 - i) : (DIST - 1);
          if (ahead == 2) { if (PER == 2) asm volatile("s_waitcnt vmcnt(4) lgkmcnt(0)\n\ts_barrier" ::: "memory"); else asm volatile("s_waitcnt vmcnt(8) lgkmcnt(0)\n\ts_barrier" ::: "memory"); }
          else if (ahead == 1) { if (PER == 2) asm volatile("s_waitcnt vmcnt(2) lgkmcnt(0)\n\ts_barrier" ::: "memory"); else asm volatile("s_waitcnt vmcnt(4) lgkmcnt(0)\n\ts_barrier" ::: "memory"); }
          else FA_WAIT_BAR(); }
        if (i + DIST < NT) FA_DMA(i + DIST);
        const bool diag = i < 4; const int t = i & 3; const int j = diag ? qblk : (qblk - 1 - ((i - 4) >> 2));
        const bool mysel = RET ? true : (((selmask >> j) & 1u) != 0u);
        const bool skip = diag ? (64 * t > 32 * wid + 31) : (RET ? false : !__any(mysel));
        if (skip) continue;
        const unsigned so = (unsigned)((i % NS) * SLOT);
        f32x16 p0 = RET ? f32x16{} : negm, p1 = p0;
        { FA_LAS const unsigned char* kb = shm + L_K + so + hi * 1024 + r32 * 16;
#pragma unroll
          for (int d0 = 0; d0 < ND0; ++d0) { const bf16x8 b0 = *(FA_LAS const bf16x8*)(kb + d0 * 2048); const bf16x8 b1 = *(FA_LAS const bf16x8*)(kb + d0 * 2048 + 512);
              p0 = __builtin_amdgcn_mfma_f32_32x32x16_f16(__builtin_bit_cast(h16::f16x8_t, b0), __builtin_bit_cast(h16::f16x8_t, qr[d0]), p0, 0, 0, 0); p1 = __builtin_amdgcn_mfma_f32_32x32x16_f16(__builtin_bit_cast(h16::f16x8_t, b1), __builtin_bit_cast(h16::f16x8_t, qr[d0]), p1, 0, 0, 0); } }
        if (RET) {
            const int qpos = q0 + qrel; const int kv0 = j * 256 + t * 64;
            const float base = (float)(qpos - kv0 - 4 * hi);
            const float rf0 = exp2f(lg2 * base), rf1 = exp2f(lg2 * (base - 32.0f));
#pragma unroll
            for (int r = 0; r < 16; ++r) { p0[r] *= rf0 * cfac[r]; p1[r] *= rf1 * cfac[r]; }
            if (diag) { const int kb_ = 64 * t + 4 * hi;
#pragma unroll
                for (int r = 0; r < 16; ++r) { const int kv = kb_ + (r & 3) + 8 * (r >> 2); if (kv > qrel) p0[r] = 0.f; if (kv + 32 > qrel) p1[r] = 0.f; } }
        } else {
            if (diag) { const int kb_ = 64 * t + 4 * hi;
#pragma unroll
                for (int r = 0; r < 16; ++r) { const int kv = kb_ + (r & 3) + 8 * (r >> 2); if (kv > qrel) p0[r] = NEG; if (kv + 32 > qrel) p1[r] = NEG; } }
            else if (!mysel) {
#pragma unroll
                for (int r = 0; r < 16; ++r) { p0[r] = NEG; p1[r] = NEG; } }
            float rm = fmaxf(fmaxf(p0[0], p1[0]), p0[1]);
#pragma unroll
            for (int r = 1; r < 16; ++r) { rm = fmaxf(fmaxf(rm, p1[r]), (r < 15) ? p0[r + 1] : p1[r]); }
            rm = xl::max32(rm);
            if (__any(rm > THR)) {
                const float dl = fmaxf(rm, 0.f);
                mhat += dl;
#pragma unroll
                for (int r = 0; r < 16; ++r) { p0[r] -= dl; p1[r] -= dl; }
#pragma unroll
                for (int r = 0; r < 16; ++r) negm[r] = -mhat;
                const float f = __builtin_amdgcn_exp2f(-dl); lrow *= f;
                asm volatile("" ::: "memory");
                if (hi == 0) wsf[r32] = f;
                asm volatile("s_waitcnt lgkmcnt(0)" ::: "memory");
#pragma unroll
                for (int r = 0; r < 16; ++r) { const float fr_ = wsf[crow(r, hi)];
#pragma unroll
                    for (int db = 0; db < NDB; ++db) o[db][r] *= fr_; }
                asm volatile("s_waitcnt lgkmcnt(0)" ::: "memory");
            }
            float s = 0.f;
#pragma unroll
            for (int r = 0; r < 16; ++r) { p0[r] = __builtin_amdgcn_exp2f(p0[r]); p1[r] = __builtin_amdgcn_exp2f(p1[r]); s += p0[r] + p1[r]; }
            lrow += s;
        }
        bf16x8 pa[4];
        { u32x4 w;
          w.x = cvtpk_s(p0[0], p0[1]); w.y = cvtpk_s(p0[2], p0[3]); w.z = cvtpk_s(p0[4], p0[5]); w.w = cvtpk_s(p0[6], p0[7]); pa[0] = __builtin_bit_cast(bf16x8, w);
          w.x = cvtpk_s(p0[8], p0[9]); w.y = cvtpk_s(p0[10], p0[11]); w.z = cvtpk_s(p0[12], p0[13]); w.w = cvtpk_s(p0[14], p0[15]); pa[1] = __builtin_bit_cast(bf16x8, w);
          w.x = cvtpk_s(p1[0], p1[1]); w.y = cvtpk_s(p1[2], p1[3]); w.z = cvtpk_s(p1[4], p1[5]); w.w = cvtpk_s(p1[6], p1[7]); pa[2] = __builtin_bit_cast(bf16x8, w);
          w.x = cvtpk_s(p1[8], p1[9]); w.y = cvtpk_s(p1[10], p1[11]); w.z = cvtpk_s(p1[12], p1[13]); w.w = cvtpk_s(p1[14], p1[15]); pa[3] = __builtin_bit_cast(bf16x8, w); }
        { FA_LAS const unsigned char* vb = shm + L_V + so + ((lane >> 4) & 1) * 32 + (lane & 3) * 8 + (4 * hi + ((lane & 15) >> 2)) * 64;
#pragma unroll
          for (int db = 0; db < NDB; ++db)
#pragma unroll
              for (int ks = 0; ks < 4; ++ks) { const s16x4 lo = vtr(vb + db * 4096 + ks * 1024), hh = vtr(vb + db * 4096 + ks * 1024 + 512);
                  const bf16x8 vf = (bf16x8){lo[0], lo[1], lo[2], lo[3], hh[0], hh[1], hh[2], hh[3]};
                  o[db] = __builtin_amdgcn_mfma_f32_32x32x16_f16(__builtin_bit_cast(h16::f16x8_t, pa[ks]), __builtin_bit_cast(h16::f16x8_t, vf), o[db], 0, 0, 0); } }
    }
    float rli[16];
    if (!RET) {
        const float l = xl::add32(lrow);
        asm volatile("" ::: "memory");
        if (hi == 0) wsf[32 + r32] = 1.0f / l;
        asm volatile("s_waitcnt lgkmcnt(0)" ::: "memory");
#pragma unroll
        for (int r = 0; r < 16; ++r) rli[r] = wsf[32 + crow(r, hi)];
    } else {
#pragma unroll
        for (int r = 0; r < 16; ++r) rli[r] = 1.0f;
    }
    FA_LBAR();
    FA_LAS bf16_t* stg = (FA_LAS bf16_t*)(shm + wid * 8192);
#pragma unroll
    for (int r = 0; r < 16; ++r) { const int orow = crow(r, hi);
#pragma unroll
        for (int db = 0; db < NDB; ++db) { const unsigned pk = cvtpk_s(o[db][r] * rli[r], 0.f); stg[orow * DH + db * 32 + r32] = (bf16_t)(pk & 0xffffu); } }
    asm volatile("s_waitcnt lgkmcnt(0)" ::: "memory");
    const size_t tok0 = rowbase + q0 + wid * 32;
    if (!RET) {
#pragma unroll
        for (int i = 0; i < 4; ++i) { const int row = i * 8 + (lane >> 3), ch = lane & 7;
            const u32x4 v = *(FA_LAS const u32x4*)(stg + row * 64 + ch * 8);
            float ss = 0.f;
#pragma unroll
            for (int k = 0; k < 4; ++k) { const float a = h16::lo(v[k]), c = h16::hi(v[k]); ss += a * a + c * c; }
            ss += xl::xor_f<1>(ss); ss += xl::xor_f<2>(ss); ss += xl::xor_f<4>(ss);
            if (ch == 0) T.ASSQ[(tok0 + row) * 8 + h] = ss;
            *(u32x4*)(T.CAT + (tok0 + row) * 1024 + h * 64 + ch * 8) = v; }
    } else {
#pragma unroll
        for (int i = 0; i < 8; ++i) { const int row = i * 4 + (lane >> 4), ch = lane & 15;
            const u32x4 v = *(FA_LAS const u32x4*)(stg + row * 128 + ch * 8);
            float x[8];
#pragma unroll
            for (int k = 0; k < 4; ++k) { x[2 * k] = h16::lo(v[k]); x[2 * k + 1] = h16::hi(v[k]); }
            float ss = 0.f;
#pragma unroll
            for (int k = 0; k < 8; ++k) ss += x[k] * x[k];
            ss += xl::xor_f<1>(ss); ss += xl::xor_f<2>(ss); ss += xl::xor_f<4>(ss); ss += xl::xor_f<8>(ss);
            const float rs = 1.0f / sqrtf(ss * (1.0f / 128.0f) + 1e-6f);
            const u32x4 gv = *(const u32x4*)(T.GR + (tok0 + row) * 512 + h * 128 + ch * 8);
            const f32x4 w0 = *(const f32x4*)(T.ret_g + h * 128 + ch * 8), w1 = *(const f32x4*)(T.ret_g + h * 128 + ch * 8 + 4);
            const float wg[8] = {w0[0], w0[1], w0[2], w0[3], w1[0], w1[1], w1[2], w1[3]};
            float y[8];
#pragma unroll
            for (int k = 0; k < 4; ++k) { const float g0 = h16::lo(gv[k]), g1 = h16::hi(gv[k]);
                y[2 * k] = x[2 * k] * rs * wg[2 * k] * g0; y[2 * k + 1] = x[2 * k + 1] * rs * wg[2 * k + 1] * g1; }
            u32x4 ov; ov.x = cvtpk_s(y[0], y[1]); ov.y = cvtpk_s(y[2], y[3]); ov.z = cvtpk_s(y[4], y[5]); ov.w = cvtpk_s(y[6], y[7]);
            *(u32x4*)(T.CAT + (tok0 + row) * 1024 + 512 + h * 128 + ch * 8) = ov; }
    }
    FA_LBAR();
#undef FA_KV0
#undef FA_DMA
}

__device__ __forceinline__ void kv_unit(const int wv, int b, int h, int m, const bf16_t* Kg, const bf16_t* Vg, float* KVM, FA_LAS unsigned char* shm) {
    constexpr int SLOT = 16384, L_K = 0, L_V = 4 * SLOT;
    int tid_ = otid(wv);
    const int tid = tid_, lane = tid & 63, r32 = lane & 31, hi = lane >> 5; const int wid = __builtin_amdgcn_readfirstlane(tid >> 6);
    const int dg = wid >> 1, eh = wid & 1;
    const size_t rowbase = (size_t)b * 2048 + (size_t)m * 256;
    const unsigned lds0 = (unsigned)(unsigned long)shm;
    const bf16_t* Kh = Kg + rowbase * 512 + h * 128; const bf16_t* Vh = Vg + rowbase * 512 + h * 128;
#pragma unroll
    for (int t = 0; t < 4; ++t)
#pragma unroll
        for (int pp = 0; pp < 2; ++pp) { const int p = wid + 8 * pp; const size_t off = (size_t)(64 * t + 16 * (p & 3) + (lane >> 2)) * 512 + (p >> 2) * 32 + (lane & 3) * 8;
            glds16(Kh + off, (unsigned)__builtin_amdgcn_readfirstlane(lds0 + L_K + t * SLOT + p * 1024));
            glds16(Vh + off, (unsigned)__builtin_amdgcn_readfirstlane(lds0 + L_V + t * SLOT + p * 1024)); }
    const float lg2 = log2f(1.0f - exp2f(-5.0f - (float)h));
    const float g64 = exp2f(lg2 * 64.0f);
    h16::f16x8_t fd[4];
#pragma unroll
    for (int ks = 0; ks < 4; ++ks)
#pragma unroll
        for (int j = 0; j < 8; ++j) fd[ks][j] = (_Float16)exp2f(lg2 * (float)(63 - (16 * ks + 8 * (j >> 2) + 4 * hi + (j & 3))));
    f32x16 acc[2]; acc[0] = f32x16{}; acc[1] = f32x16{};
    FA_WAIT_BAR();
    const int lb = ((lane >> 4) & 1) * 32 + (lane & 3) * 8 + (4 * hi + ((lane & 15) >> 2)) * 64;
#pragma unroll
    for (int t = 0; t < 4; ++t) {
        if (t > 0) {
#pragma unroll
            for (int r = 0; r < 16; ++r) { acc[0][r] *= g64; acc[1][r] *= g64; } }
        FA_LAS const unsigned char* kb = shm + L_K + t * SLOT + dg * 4096 + lb; FA_LAS const unsigned char* vb = shm + L_V + t * SLOT + (2 * eh) * 4096 + lb;
#pragma unroll
        for (int ks = 0; ks < 4; ++ks) { const s16x4 klo = vtr(kb + ks * 1024), khi = vtr(kb + ks * 1024 + 512);
            const h16::f16x8_t kf = __builtin_bit_cast(h16::f16x8_t, (bf16x8){klo[0], klo[1], klo[2], klo[3], khi[0], khi[1], khi[2], khi[3]});
#pragma unroll
            for (int eb = 0; eb < 2; ++eb) { const s16x4 vlo = vtr(vb + eb * 4096 + ks * 1024), vhi = vtr(vb + eb * 4096 + ks * 1024 + 512);
                const h16::f16x8_t vf = __builtin_bit_cast(h16::f16x8_t, (bf16x8){vlo[0], vlo[1], vlo[2], vlo[3], vhi[0], vhi[1], vhi[2], vhi[3]}) * fd[ks];
                acc[eb] = __builtin_amdgcn_mfma_f32_32x32x16_f16(kf, vf, acc[eb], 0, 0, 0); } }
    }
    float* op = KVM + ((size_t)(b * 4 + h) * 8 + m) * 16384;
#pragma unroll
    for (int eb = 0; eb < 2; ++eb)
#pragma unroll
        for (int r = 0; r < 16; ++r) op[(size_t)(32 * dg + crow(r, hi)) * 128 + 64 * eh + 32 * eb + r32] = acc[eb][r];
    FA_LBAR();
}
}
namespace mk {
#define GAS __attribute__((address_space(1)))
#define LAS __attribute__((address_space(3)))
typedef unsigned short bf16;
typedef unsigned v4u __attribute__((ext_vector_type(4)));
typedef unsigned v2u __attribute__((ext_vector_type(2)));
typedef float f32x4 __attribute__((ext_vector_type(4)));
typedef int i32x4 __attribute__((ext_vector_type(4)));
typedef GAS unsigned gu32;
#define RLX_AGENT __ATOMIC_RELAXED, __HIP_MEMORY_SCOPE_AGENT
#define LDS_WAIT() asm volatile("s_waitcnt lgkmcnt(0)" ::: "memory")
#define VM_WAIT() asm volatile("s_waitcnt vmcnt(0)" ::: "memory")
constexpr int NWAVES = 8;
constexpr size_t MiB = 1u << 20, KiB = 1u << 10;
constexpr size_t WS_CTL = 0;
constexpr size_t CTL_ZERO_BYTES = 64 * KiB;
constexpr size_t WS_MOD = 64 * KiB;
constexpr size_t WS_KMP = 512 * KiB;
constexpr size_t WS_EIDX = 768 * KiB;
constexpr size_t WS_EW = 896 * KiB;
constexpr size_t WS_ROPE = 1 * MiB;
constexpr size_t WS_ASSQ = 2 * MiB;
constexpr size_t WS_SROW = 2 * MiB + 512 * KiB;
constexpr size_t WS_SWT = 2 * MiB + 768 * KiB;
constexpr size_t WS_WCNT = 3 * MiB;
constexpr size_t WS_SEG = 3 * MiB + 64 * KiB;
constexpr size_t WS_ATOMF = 3 * MiB + 128 * KiB;
constexpr size_t WS_SEGD = 3 * MiB + 65 * KiB;
constexpr size_t WS_MGU = 8 * MiB;
constexpr size_t WS_SLAB = 8 * MiB;
constexpr size_t WS_MDN = 96 * MiB;
constexpr size_t WS_XA = 140 * MiB;
constexpr size_t WS_XS = 172 * MiB;
constexpr size_t WS_KVM = 172 * MiB;
constexpr size_t WS_YS = 140 * MiB;
constexpr size_t WS_WIN = 240 * MiB;
constexpr size_t WS_WOUT = 254 * MiB;
constexpr size_t WS_FGU = 258 * MiB;
constexpr size_t WS_FDN = 269 * MiB;
constexpr size_t WS_QKV = 275 * MiB;
constexpr size_t WS_CAT = 387 * MiB;
constexpr size_t WS_HD = 275 * MiB;
constexpr size_t WS_HM = 240 * MiB;
constexpr size_t WS_END = 428 * MiB;
constexpr int XS_ROWS = 34816;
constexpr int CW_BAR = 1024;

constexpr int RING_BYTES = 131072, LDSCTL_OFF = RING_BYTES, MISC_OFF = LDSCTL_OFF + 320, LDS_BYTES = 147456;

#define XB_TMO      128
#define XB_XCNT(j)  (256  + 64 * (j))
#define XB_XSUB(j)  (1280 + 64 * (j))
#define XB_XGEN(j)  (2304 + 64 * (j))
#define XB_TOP      3328
#define XB_TOPGEN   3392
#define XCD_BAR_WORDS 3456
#define XB_SPIN_CAP (1u << 18)
__device__ __forceinline__ unsigned xb_ld(unsigned* p)              { return __hip_atomic_load(p, __ATOMIC_RELAXED, __HIP_MEMORY_SCOPE_AGENT); }
__device__ __forceinline__ unsigned xb_add(unsigned* p, unsigned v) { return __hip_atomic_fetch_add(p, v, __ATOMIC_RELAXED, __HIP_MEMORY_SCOPE_AGENT); }
__device__ __forceinline__ unsigned xb_xcc_id() { return (unsigned)__builtin_amdgcn_s_getreg((3 << 11) | 20) & 0xFu; }
#define XB_SPIN(cond, bar) do { unsigned _sp = 0; while (cond) { __builtin_amdgcn_s_sleep(1); \
    if ((++_sp & 255u) == 0u) { if (xb_ld(&(bar)[XB_TMO])) break; if (_sp > XB_SPIN_CAP) { atomicAdd(&(bar)[XB_TMO], 1u); break; } } } } while (0)
struct XcdBarrier { unsigned* bar; unsigned x; volatile LAS unsigned* st; int wv; };
__device__ __forceinline__ XcdBarrier xcd_barrier_post(unsigned* bar, volatile LAS unsigned* st, int wv) {
    XcdBarrier b; b.bar = bar; b.x = xb_xcc_id(); b.st = st; b.wv = wv;
    if (otid(wv) == 0) (void)xb_add(&bar[XB_XCNT(b.x)], 1u);
    return b;
}
__device__ __forceinline__ void xcd_barrier_complete(unsigned* bar, unsigned x, unsigned& nloc, unsigned& nx) {
    const unsigned G = gridDim.x * gridDim.y * gridDim.z;
    unsigned sum, cnt, mine, sp = 0u;
    for (;;) {
        sum = 0u; cnt = 0u; mine = 0u;
#pragma unroll
        for (unsigned j = 0; j < 16; ++j) { const unsigned c = xb_ld(&bar[XB_XCNT(j)]); sum += c; cnt += (c > 0u) ? 1u : 0u; mine = (j == x) ? c : mine; }
        if (sum == G) break;
        __builtin_amdgcn_s_sleep(1);
        if ((++sp & 255u) == 0u) { if (xb_ld(&bar[XB_TMO])) break; if (sp > XB_SPIN_CAP) { atomicAdd(&bar[XB_TMO], 1u); break; } }
    }
    nloc = mine > 0u ? mine : 1u; nx = cnt > 0u ? cnt : 1u;
}
__device__ __forceinline__ void xcd_barrier(const XcdBarrier& b) {
    asm volatile("s_waitcnt vmcnt(0)" ::: "memory");
    __syncthreads();
    if (otid(b.wv) == 0) {
        unsigned* bar = b.bar;
        __builtin_amdgcn_s_waitcnt(0);
        unsigned nloc = b.st[0], nx = b.st[1];
        if (nloc == 0u) { xcd_barrier_complete(bar, b.x, nloc, nx); b.st[0] = nloc; b.st[1] = nx; }
        const unsigned old = xb_add(&bar[XB_XSUB(b.x)], 1u);
        const unsigned gen = old / nloc;
        if (old + 1u == (gen + 1u) * nloc) {
            __builtin_amdgcn_fence(__ATOMIC_RELEASE, "agent");
            asm volatile("s_waitcnt vmcnt(0)" ::: "memory");
            const unsigned og = xb_add(&bar[XB_TOP], 1u);
            const unsigned tg = og / nx;
            if (og + 1u == (tg + 1u) * nx) xb_add(&bar[XB_TOPGEN], 1u);
            else XB_SPIN(xb_ld(&bar[XB_TOPGEN]) == tg, bar);
            __builtin_amdgcn_fence(__ATOMIC_ACQUIRE, "agent");
            xb_add(&bar[XB_XGEN(b.x)], 1u);
            asm volatile("s_waitcnt vmcnt(0)" ::: "memory");
        } else {
            XB_SPIN(xb_ld(&bar[XB_XGEN(b.x)]) == gen, bar);
            __builtin_amdgcn_fence(__ATOMIC_ACQUIRE, "agent");
            asm volatile("s_waitcnt vmcnt(0)" ::: "memory");
        }
    }
    __syncthreads();
}

__device__ __forceinline__ unsigned f2bf(float f) { unsigned u = __builtin_bit_cast(unsigned, f); return (u + 0x7fffu + ((u >> 16) & 1u)) >> 16; }
__device__ __forceinline__ unsigned pk2(float lo, float hi) { return h16::pk(lo, hi); }
using xl::wave_sum; using xl::wave_sum_i;

struct Inputs {
    const float *x, *c, *norm_mix_g, *norm_ffn_g, *ada_w, *ada_b, *w_in, *w_out, *att_g, *ret_g, *fw_gate, *fw_up, *fw_down, *router_w, *mw_gate, *mw_up, *mw_down, *final_g;
};

template <class SrcFn> __device__ __forceinline__ void transpose_item(SrcFn src, int K, bf16* WT, int k0, int n0, LAS float* scr, int lane) {
#pragma unroll 8
    for (int i = 0; i < 32; ++i) { const int kk = 2 * i + (lane >> 5); scr[kk * 33 + (lane & 31)] = src(k0 + kk, n0 + (lane & 31)); }
    LDS_WAIT(); asm volatile("" ::: "memory");
    const int c = lane & 7;
#pragma unroll
    for (int j = 0; j < 4; ++j) { const int n = (lane >> 3) + 8 * j; const LAS float* s = scr + (8 * c) * 33 + n;
        v4u o; o.x = pk2(s[0 * 33], s[1 * 33]); o.y = pk2(s[2 * 33], s[3 * 33]); o.z = pk2(s[4 * 33], s[5 * 33]); o.w = pk2(s[6 * 33], s[7 * 33]);
        *(GAS v4u*)(WT + (size_t)(n0 + n) * K + k0 + 8 * c) = o; }
    LDS_WAIT(); asm volatile("" ::: "memory");
}
__device__ __forceinline__ int rot_src_col(int n) {
    if (n < 1536 || n >= 2560) return n;
    const int hb = (n - 1536) & ~127, p = (n - 1536) & 127;
    return 1536 + hb + 4 * (p >> 3) + ((p & 7) >> 1) + 64 * (p & 1);
}
constexpr int IT_WIN = 16 * 112, IT_WOUT = 16 * 32, IT_GU = 16 * 176, IT_DN = 44 * 32;
constexpr int IT_TOTAL = 2 * IT_WIN + 2 * IT_WOUT + IT_GU + IT_DN + 8 * (IT_GU + IT_DN);

constexpr int IT_NONMOE = 2 * IT_WIN + 2 * IT_WOUT + IT_GU + IT_DN;
__device__ __forceinline__ void convert_item(const Inputs& in, unsigned char* ws, int it, LAS float* scr, int lane) {
    int r = it;
    if (r < 2 * IT_WIN) { const int l = r / IT_WIN; r -= l * IT_WIN; const float* W = in.w_in + (size_t)l * 1024 * 3584;
        transpose_item([=](int k, int n) { return W[(size_t)k * 3584 + rot_src_col(n)]; }, 1024, (bf16*)(ws + WS_WIN) + (size_t)l * 3584 * 1024, 64 * (r / 112), 32 * (r % 112), scr, lane); return; }
    r -= 2 * IT_WIN;
    if (r < 2 * IT_WOUT) { const int l = r / IT_WOUT; r -= l * IT_WOUT; const float* W = in.w_out + (size_t)l * 1024 * 1024; const float* ag = in.att_g + l * 512;
        transpose_item([=](int k, int n) { return W[(size_t)k * 1024 + n] * (k < 512 ? ag[k] : 1.0f); }, 1024, (bf16*)(ws + WS_WOUT) + (size_t)l * 1024 * 1024, 64 * (r / 32), 32 * (r % 32), scr, lane); return; }
    r -= 2 * IT_WOUT;
    const float *Wg, *Wu, *Wd; bf16 *Dgu, *Ddn;
    if (r < IT_GU + IT_DN) { Wg = in.fw_gate; Wu = in.fw_up; Wd = in.fw_down; Dgu = (bf16*)(ws + WS_FGU); Ddn = (bf16*)(ws + WS_FDN); }
    else { r -= IT_GU + IT_DN; const int e = r / (IT_GU + IT_DN); r -= e * (IT_GU + IT_DN);
        Wg = in.mw_gate + (size_t)e * 1024 * 2816; Wu = in.mw_up + (size_t)e * 1024 * 2816; Wd = in.mw_down + (size_t)e * 2816 * 1024;
        Dgu = (bf16*)(ws + WS_MGU) + (size_t)e * 5632 * 1024; Ddn = (bf16*)(ws + WS_MDN) + (size_t)e * 1024 * 2816; }
    if (r < IT_GU) {
        transpose_item([=](int k, int n) { const float* W = ((n >> 7) & 1) ? Wu : Wg; return W[(size_t)k * 2816 + (n >> 8) * 128 + (n & 127)]; }, 1024, Dgu, 64 * (r / 176), 32 * (r % 176), scr, lane); return; }
    r -= IT_GU;
    transpose_item([=](int k, int n) { return Wd[(size_t)k * 1024 + n]; }, 2816, Ddn, 64 * (r / 32), 32 * (r % 32), scr, lane);
}
struct MoeItem { const float* src; bf16* dst; int ld, K, k0, n0; const float* rscale; float f8scale; int scol0, sstep; };
template <int KIND  , class InP> __device__ __forceinline__ MoeItem moe_item(InP inp, unsigned char* ws, int it, int lane) {
    MoeItem m; m.rscale = nullptr; m.f8scale = (KIND == 0) ? 32.0f : 64.0f; const int r8 = lane >> 3, c4 = 4 * (lane & 7); m.scol0 = c4; m.sstep = 1;
    if (KIND == 0) { const int e = it / IT_GU, r = it - e * IT_GU; const int kb = r / 176, nb = r % 176; const int n = 32 * nb; m.k0 = 64 * kb; m.n0 = n; m.ld = 2816; m.K = 1024;
        const float* W = (((n >> 7) & 1) ? inp->mw_up : inp->mw_gate) + (size_t)e * 1024 * 2816;
        m.src = W + (size_t)(m.k0 + r8) * 2816 + (n >> 8) * 128 + (n & 127) + c4; m.dst = (bf16*)(ws + WS_MGU + (size_t)e * 5632 * 1024); }
    else { const int e = it / IT_DN, r = it - e * IT_DN; const int kb = r / 32, nb = r % 32; m.k0 = 64 * kb; m.n0 = 32 * nb; m.ld = 1024; m.K = 2816;
        m.src = inp->mw_down + (size_t)e * 2816 * 1024 + (size_t)(m.k0 + r8) * 1024 + m.n0 + c4; m.dst = (bf16*)(ws + WS_MDN + (size_t)e * 1024 * 2816); }
    return m;
}
__device__ __forceinline__ void moe_item_load(const MoeItem& m, float (&v)[32]) {
#pragma unroll
    for (int i = 0; i < 8; ++i) { const f32x4 t = __builtin_nontemporal_load((const f32x4*)(m.src + (size_t)(8 * i) * m.ld));
        v[4 * i] = t[0]; v[4 * i + 1] = t[1]; v[4 * i + 2] = t[2]; v[4 * i + 3] = t[3]; }
}
__device__ __forceinline__ void moe_item_finish(const MoeItem& m, const float (&v)[32], LAS float* scr, int lane) {
    const int r8 = lane >> 3;
    if (m.rscale != nullptr && m.k0 < 512) {
#pragma unroll
        for (int i = 0; i < 8; ++i) { const float rsv = m.rscale[m.k0 + 8 * i + r8];
#pragma unroll
            for (int j = 0; j < 4; ++j) scr[(8 * i + r8) * 33 + m.scol0 + j * m.sstep] = v[4 * i + j] * rsv; }
    } else {
#pragma unroll
        for (int i = 0; i < 8; ++i)
#pragma unroll
            for (int j = 0; j < 4; ++j) scr[(8 * i + r8) * 33 + m.scol0 + j * m.sstep] = v[4 * i + j];
    }
    LDS_WAIT(); asm volatile("" ::: "memory");
    const int c = lane & 7;
    if (m.f8scale != 0.f) {
        const float sc = m.f8scale; unsigned char* d8 = (unsigned char*)m.dst;
#pragma unroll
        for (int j = 0; j < 4; ++j) { const int n = (lane >> 3) + 8 * j; const LAS float* s = scr + (8 * c) * 33 + n;
            v2u o; int p = 0; p = __builtin_amdgcn_cvt_pk_fp8_f32(s[0 * 33] * sc, s[1 * 33] * sc, p, false); p = __builtin_amdgcn_cvt_pk_fp8_f32(s[2 * 33] * sc, s[3 * 33] * sc, p, true); o.x = (unsigned)p;
            p = 0; p = __builtin_amdgcn_cvt_pk_fp8_f32(s[4 * 33] * sc, s[5 * 33] * sc, p, false); p = __builtin_amdgcn_cvt_pk_fp8_f32(s[6 * 33] * sc, s[7 * 33] * sc, p, true); o.y = (unsigned)p;
            __builtin_nontemporal_store(o, (GAS v2u*)(d8 + (size_t)(m.n0 + n) * m.K + m.k0 + 8 * c)); }
    } else {
#pragma unroll
        for (int j = 0; j < 4; ++j) { const int n = (lane >> 3) + 8 * j; const LAS float* s = scr + (8 * c) * 33 + n;
            v4u o; o.x = pk2(s[0 * 33], s[1 * 33]); o.y = pk2(s[2 * 33], s[3 * 33]); o.z = pk2(s[4 * 33], s[5 * 33]); o.w = pk2(s[6 * 33], s[7 * 33]);
            *(GAS v4u*)(m.dst + (size_t)(m.n0 + n) * m.K + m.k0 + 8 * c) = o; }
    }
    LDS_WAIT(); asm volatile("" ::: "memory");
}
template <class InP> __device__ __forceinline__ MoeItem base_item(InP inp, unsigned char* ws, int it, int lane) {
    MoeItem m; m.rscale = nullptr; m.f8scale = 0.f; int r = it; const int r8 = lane >> 3, c = lane & 7, c4 = 4 * c; m.scol0 = c4; m.sstep = 1;
    if (r < 2 * IT_WIN) { const int l = r / IT_WIN; r -= l * IT_WIN; m.k0 = 64 * (r / 112); m.n0 = 32 * (r % 112); m.ld = 3584; m.K = 1024;
        int scol = m.n0 + c4;
        if (m.n0 >= 1536 && m.n0 < 2560) { const int hb = (m.n0 - 1536) & ~127, a0 = ((m.n0 - 1536) & 127) >> 3;
            scol = 1536 + hb + 4 * (a0 + (c & 3)) + 64 * (c >> 2); m.scol0 = 8 * (c & 3) + (c >> 2); m.sstep = 2; }
        m.src = inp->w_in + (size_t)l * 1024 * 3584 + (size_t)(m.k0 + r8) * 3584 + scol; m.dst = (bf16*)(ws + WS_WIN) + (size_t)l * 3584 * 1024; return m; }
    r -= 2 * IT_WIN;
    if (r < 2 * IT_WOUT) { const int l = r / IT_WOUT; r -= l * IT_WOUT; m.k0 = 64 * (r / 32); m.n0 = 32 * (r % 32); m.ld = 1024; m.K = 1024; m.rscale = inp->att_g + l * 512;
        m.src = inp->w_out + (size_t)l * 1024 * 1024 + (size_t)(m.k0 + r8) * 1024 + m.n0 + c4; m.dst = (bf16*)(ws + WS_WOUT) + (size_t)l * 1024 * 1024; return m; }
    r -= 2 * IT_WOUT;
    if (r < IT_GU) { const int n = 32 * (r % 176); m.k0 = 64 * (r / 176); m.n0 = n; m.ld = 2816; m.K = 1024;
        m.src = (((n >> 7) & 1) ? inp->fw_up : inp->fw_gate) + (size_t)(m.k0 + r8) * 2816 + (n >> 8) * 128 + (n & 127) + c4; m.dst = (bf16*)(ws + WS_FGU); m.f8scale = 32.0f; return m; }
    r -= IT_GU; m.k0 = 64 * (r / 32); m.n0 = 32 * (r % 32); m.ld = 1024; m.K = 2816;
    m.src = inp->fw_down + (size_t)(m.k0 + r8) * 1024 + m.n0 + c4; m.dst = (bf16*)(ws + WS_FDN); m.f8scale = 64.0f; return m;
}
#ifndef CONV_DEPTH
#define CONV_DEPTH 4
#endif
#define CONV_PIPE(ITEM_FN, IT_FIRST, IT_END, STEP)                                                                      \
    { int it = (IT_FIRST); const int it_end = (IT_END), st_ = (STEP);                                                   \
      if (it < it_end) {                                                                                                \
        float v0[32], v1[32], v2[32], v3[32]; MoeItem q0, q1, q2, q3;                                                   \
        auto clampi = [&](int i) { return i < it_end ? i : it; };                                                       \
        q0 = ITEM_FN(it); moe_item_load(q0, v0);                                                                        \
        if (CONV_DEPTH > 2) { q1 = ITEM_FN(clampi(it + st_)); moe_item_load(q1, v1); }                                  \
        if (CONV_DEPTH > 3) { q2 = ITEM_FN(clampi(it + 2 * st_)); moe_item_load(q2, v2); }                              \
        for (;;) {                                                                                                      \
            if (CONV_DEPTH == 2) { q1 = ITEM_FN(clampi(it + st_)); moe_item_load(q1, v1); }                             \
            if (CONV_DEPTH == 3) { q2 = ITEM_FN(clampi(it + 2 * st_)); moe_item_load(q2, v2); }                         \
            if (CONV_DEPTH == 4) { q3 = ITEM_FN(clampi(it + 3 * st_)); moe_item_load(q3, v3); }                         \
            moe_item_finish(q0, v0, scr, lane); it += st_; if (it >= it_end) break;                                     \
            if (CONV_DEPTH == 2) { q0 = ITEM_FN(clampi(it + st_)); moe_item_load(q0, v0); }                             \
            if (CONV_DEPTH == 3) { q0 = ITEM_FN(clampi(it + 2 * st_)); moe_item_load(q0, v0); }                         \
            if (CONV_DEPTH == 4) { q0 = ITEM_FN(clampi(it + 3 * st_)); moe_item_load(q0, v0); }                         \
            moe_item_finish(q1, v1, scr, lane); it += st_; if (it >= it_end) break;                                     \
            if (CONV_DEPTH == 2) continue;                                                                              \
            if (CONV_DEPTH == 3) { q1 = ITEM_FN(clampi(it + 2 * st_)); moe_item_load(q1, v1); }                         \
            if (CONV_DEPTH == 4) { q1 = ITEM_FN(clampi(it + 3 * st_)); moe_item_load(q1, v1); }                         \
            moe_item_finish(q2, v2, scr, lane); it += st_; if (it >= it_end) break;                                     \
            if (CONV_DEPTH == 3) continue;                                                                              \
            q2 = ITEM_FN(clampi(it + 3 * st_)); moe_item_load(q2, v2);                                                  \
            moe_item_finish(q3, v3, scr, lane); it += st_; if (it >= it_end) break;                                     \
        }                                                                                                               \
      } }
constexpr int IT_LATE = IT_WIN + IT_WOUT, IT_EARLY = IT_NONMOE - IT_LATE;
template <class InP> __device__ __forceinline__ void convert_base_all(InP inp, unsigned char* ws, LAS unsigned char* lds, int gw, int NGW, int wave, int lane) {
    LAS float* scr = (LAS float*)(lds + wave * 16384);
    auto item = [&](int p) { return base_item(inp, ws, p < IT_WIN ? p : (p < IT_WIN + IT_WOUT ? p + IT_WIN : p + IT_WIN + IT_WOUT), lane); };
    CONV_PIPE(item, gw, IT_EARLY, NGW)
}
template <class InP> __device__ __forceinline__ void convert_base_late(InP inp, unsigned char* ws, LAS unsigned char* lds, int sp, int nsp, int wave, int lane) {
    LAS float* scr = (LAS float*)(lds + wave * 16384);
    auto item = [&](int d) { return base_item(inp, ws, d < IT_WIN ? IT_WIN + d : d + IT_WIN + IT_WOUT, lane); };
    CONV_PIPE(item, sp * NWAVES + wave, IT_LATE, nsp * NWAVES)
}
template <int KIND, class InP> __device__ __forceinline__ void convert_moe_range(InP inp, unsigned char* ws, LAS unsigned char* lds, int it0, int it1, int sp, int nsp, int wave, int lane) {
    LAS float* scr = (LAS float*)(lds + wave * 16384);
    auto item = [&](int i) { return moe_item<KIND>(inp, ws, i, lane); };
#ifndef CONV_CONTIG
    CONV_PIPE(item, it0 + sp * NWAVES + wave, it1, nsp * NWAVES)
#else
    const int chunk = (it1 - it0 + nsp - 1) / nsp, cb = it0 + sp * chunk, ce = (cb + chunk < it1) ? cb + chunk : it1;
    CONV_PIPE(item, cb + wave, ce, NWAVES)
#endif
}
constexpr int IT_MOE = 8 * (IT_GU + IT_DN);
#ifndef G_GUD_N
#define G_GUD_N 208
#endif
constexpr int G_INPROJ = 224, G_GUD = G_GUD_N;
#ifndef MOE_SPARE
#define MOE_SPARE 8
#endif
constexpr int IT_MGU = 8 * IT_GU, IT_MDN = 8 * IT_DN;
#ifndef SPLIT_A
#define SPLIT_A 9000
#define SPLIT_B 19500
#define SPLIT_C 7500
#endif
constexpr int IT_MOE_A = SPLIT_A, IT_MOE_B = SPLIT_B, IT_MDN_C = SPLIT_C;

template <class InP> __device__ __forceinline__ void p0_prologue(InP inp, unsigned char* ws, LAS unsigned char* lds, int vcu, int G, int wave, int lane, int tid, int moe_w) {
    Inputs in; in.c = inp->c; in.ada_w = inp->ada_w; in.ada_b = inp->ada_b; in.w_in = inp->w_in; in.w_out = inp->w_out; in.att_g = inp->att_g; in.fw_gate = inp->fw_gate; in.fw_up = inp->fw_up; in.fw_down = inp->fw_down; in.mw_gate = inp->mw_gate; in.mw_up = inp->mw_up; in.mw_down = inp->mw_down;
    if (vcu < 192) {
        LAS float* cs = (LAS float*)lds;
        LAS float* part = (LAS float*)(lds + 32768);
        for (int i = tid; i < 8 * 1024; i += 512) { const float v = in.c[i]; cs[i] = v / (1.0f + __expf(-v)); }
        __syncthreads();
        const int n0 = vcu * 64, l = n0 / 6144, nn = n0 % 6144 + lane;
        const float* wp = in.ada_w + (size_t)l * 1024 * 6144 + (size_t)(wave * 128) * 6144 + nn;
        float acc[8];
#pragma unroll
        for (int b = 0; b < 8; ++b) acc[b] = 0.f;
#pragma unroll 16
        for (int k = 0; k < 128; ++k) { const float wv = __builtin_nontemporal_load(wp + (size_t)k * 6144);
#pragma unroll
            for (int b = 0; b < 8; ++b) acc[b] += cs[b * 1024 + wave * 128 + k] * wv; }
#pragma unroll
        for (int b = 0; b < 8; ++b) part[(wave * 8 + b) * 64 + lane] = acc[b];
        __syncthreads();
        { const int b = tid >> 6; float s = 0.f;
#pragma unroll
          for (int w = 0; w < 8; ++w) s += part[(w * 8 + b) * 64 + lane];
          ((float*)(ws + WS_MOD))[((size_t)l * 8 + b) * 6144 + nn] = s + in.ada_b[l * 6144 + nn]; }
        __syncthreads();
    }
    { const int g = vcu * 512 + tid; if (g < 2048 * 64) { const int pos = g >> 6, i = g & 63; const float inv = powf(10000.0f, -(float)i / 64.0f); const float ang = (float)pos * inv;
        float* rp = (float*)(ws + WS_ROPE) + (size_t)g * 2; rp[0] = (float)cos((double)ang); rp[1] = (float)sin((double)ang); } }
    convert_base_all(inp, ws, lds, vcu * NWAVES + wave, G * NWAVES, wave, lane);
}

template <int MODE>
__device__ __forceinline__ void norm_pass(const float* xsrc, const float* gain, const float* sh, const float* sc, bf16* dst,
                                          const float* router_w, int* eidx, float* ew, int* wcnt, int gw, int lane) {
    const int m0 = gw * 8, b = m0 >> 11;
    f32x4 gv[4], scv[4], shv[4];
#pragma unroll
    for (int j = 0; j < 4; ++j) { gv[j] = ((const f32x4*)gain)[lane + 64 * j]; scv[j] = ((const f32x4*)(sc + (size_t)b * 6144))[lane + 64 * j] + 1.0f; shv[j] = ((const f32x4*)(sh + (size_t)b * 6144))[lane + 64 * j]; }
    int cnt[8];
#pragma unroll
    for (int e = 0; e < 8; ++e) cnt[e] = 0;
    f32x4 rw[4][4][2];
    if (MODE == 1) {
#pragma unroll
        for (int j = 0; j < 4; ++j)
#pragma unroll
            for (int c = 0; c < 4; ++c) { const float* wp = router_w + (size_t)(4 * (lane + 64 * j) + c) * 8; rw[j][c][0] = *(const f32x4*)wp; rw[j][c][1] = *(const f32x4*)(wp + 4); }
    }
    for (int i = 0; i < 8; ++i) {
        const int m = m0 + i;
        const f32x4* xr = (const f32x4*)(xsrc + (size_t)m * 1024) + lane;
        f32x4 v[4]; float s = 0.f;
#pragma unroll
        for (int j = 0; j < 4; ++j) { v[j] = xr[64 * j]; s += (v[j][0] * v[j][0] + v[j][1] * v[j][1]) + (v[j][2] * v[j][2] + v[j][3] * v[j][3]); }
        const float rs = 1.0f / sqrtf(wave_sum(s) * (1.0f / 1024.0f) + 1e-6f);
        if (MODE == 2) {
            unsigned* o4 = (unsigned*)((unsigned char*)dst + (size_t)m * 1024) + lane;
#pragma unroll
            for (int j = 0; j < 4; ++j) { v[j] = v[j] * rs * gv[j] * scv[j] + shv[j]; o4[64 * j] = epi::pk4_fp8(v[j][0], v[j][1], v[j][2], v[j][3]); }
        } else {
        v2u* o8 = (v2u*)(dst + (size_t)m * 1024) + lane;
#pragma unroll
        for (int j = 0; j < 4; ++j) { v[j] = v[j] * rs * gv[j] * scv[j] + shv[j]; v2u w; w.x = pk2(v[j][0], v[j][1]); w.y = pk2(v[j][2], v[j][3]); o8[64 * j] = w; }
        }
        if (MODE == 1) {
            float lg[8];
#pragma unroll
            for (int e = 0; e < 8; ++e) lg[e] = 0.f;
#pragma unroll
            for (int j = 0; j < 4; ++j)
#pragma unroll
                for (int c = 0; c < 4; ++c) { const f32x4 w0 = rw[j][c][0], w1 = rw[j][c][1];
                    const float hv = v[j][c];
                    lg[0] += hv * w0[0]; lg[1] += hv * w0[1]; lg[2] += hv * w0[2]; lg[3] += hv * w0[3]; lg[4] += hv * w1[0]; lg[5] += hv * w1[1]; lg[6] += hv * w1[2]; lg[7] += hv * w1[3]; }
            { const bool b5 = (lane & 32) != 0, b4 = (lane & 16) != 0, b3 = (lane & 8) != 0;
              float a4[4], b2[2], c1;
#pragma unroll
              for (int q = 0; q < 4; ++q) { const float keep = b5 ? lg[4 + q] : lg[q], send = b5 ? lg[q] : lg[4 + q]; a4[q] = keep + xl::xor32p(send, b5); }
#pragma unroll
              for (int q = 0; q < 2; ++q) { const float keep = b4 ? a4[2 + q] : a4[q], send = b4 ? a4[q] : a4[2 + q]; b2[q] = keep + xl::xor_f<16>(send); }
              { const float keep = b3 ? b2[1] : b2[0], send = b3 ? b2[0] : b2[1]; c1 = keep + xl::xor_f<8>(send); }
              c1 += xl::xor_f<4>(c1); c1 += xl::xor_f<2>(c1); c1 += xl::xor_f<1>(c1);
#pragma unroll
              for (int e = 0; e < 8; ++e) lg[e] = __builtin_bit_cast(float, __builtin_amdgcn_readlane(__builtin_bit_cast(int, c1), 8 * e)); }
            int i0 = 0; float b0 = lg[0];
#pragma unroll
            for (int e = 1; e < 8; ++e) if (lg[e] > b0) { b0 = lg[e]; i0 = e; }
            int i1 = -1; float b1 = -3.0e38f;
#pragma unroll
            for (int e = 0; e < 8; ++e) if (e != i0 && lg[e] > b1) { b1 = lg[e]; i1 = e; }
            const float e1 = __expf(b1 - b0);
#pragma unroll
            for (int e = 0; e < 8; ++e) cnt[e] += ((e == i0) ? 1 : 0) + ((e == i1) ? 1 : 0);
            if (lane == 0) { eidx[m * 2] = i0; eidx[m * 2 + 1] = i1; ew[m * 2] = 1.0f / (1.0f + e1); ew[m * 2 + 1] = e1 / (1.0f + e1); }
        }
    }
    if (MODE == 1) {
        int myc = 0;
#pragma unroll
        for (int e = 0; e < 8; ++e) myc = (lane == e) ? cnt[e] : myc;
        if (lane < 8) wcnt[gw * 8 + lane] = myc;
    }
}

__device__ __forceinline__ void place_pass(const int* wcnt, const int* eidx, const float* ew, const bf16* XA, bf16* XS, int* srow, float* swt, int* segout, int gw, int NGW, int lane) {
    int tot[8], pre[8];
#pragma unroll
    for (int e = 0; e < 8; ++e) { tot[e] = 0; pre[e] = 0; }
    for (int w = lane; w < NGW; w += 64) { const i32x4 a = *(const i32x4*)(wcnt + w * 8), c = *(const i32x4*)(wcnt + w * 8 + 4); const int inc = (w < gw) ? 1 : 0;
        tot[0] += a[0]; tot[1] += a[1]; tot[2] += a[2]; tot[3] += a[3]; tot[4] += c[0]; tot[5] += c[1]; tot[6] += c[2]; tot[7] += c[3];
        pre[0] += inc * a[0]; pre[1] += inc * a[1]; pre[2] += inc * a[2]; pre[3] += inc * a[3]; pre[4] += inc * c[0]; pre[5] += inc * c[1]; pre[6] += inc * c[2]; pre[7] += inc * c[3]; }
    int base[8]; int run = 0;
#pragma unroll
    for (int e = 0; e < 8; ++e) { tot[e] = wave_sum_i(tot[e]); pre[e] = wave_sum_i(pre[e]); base[e] = run + pre[e]; if (gw == 0 && lane == 0) segout[e] = run; run += (tot[e] + 255) & ~255; }
    if (gw == 0 && lane == 0) segout[8] = run;
    const int myev = (lane < 16) ? eidx[gw * 16 + lane] : 0; const float myw = (lane < 16) ? ew[gw * 16 + lane] : 0.f;
    int mypos = 0;
#pragma unroll
    for (int i = 0; i < 16; ++i) { const int ev = __builtin_amdgcn_readlane(myev, i); int pos = 0;
#pragma unroll
        for (int e = 0; e < 8; ++e) if (ev == e) { pos = base[e]; base[e] += 1; }
        mypos = (lane == i) ? pos : mypos; }
    if (lane < 16) { srow[mypos] = gw * 16 + lane; swt[mypos] = myw; }
    const v4u* __restrict__ s = (const v4u*)(XA + (size_t)(gw * 8) * 1024);
    v4u r0[8], r1[8];
#pragma unroll
    for (int t = 0; t < 8; ++t) { r0[t] = s[t * 128 + lane]; r1[t] = s[t * 128 + lane + 64]; }
    v2u q0[8], q1[8];
#pragma unroll
    for (int t = 0; t < 8; ++t) {
        { int p = 0; p = __builtin_amdgcn_cvt_pk_fp8_f32(h16::lo(r0[t].x), h16::hi(r0[t].x), p, false); p = __builtin_amdgcn_cvt_pk_fp8_f32(h16::lo(r0[t].y), h16::hi(r0[t].y), p, true); q0[t].x = (unsigned)p;
          p = 0; p = __builtin_amdgcn_cvt_pk_fp8_f32(h16::lo(r0[t].z), h16::hi(r0[t].z), p, false); p = __builtin_amdgcn_cvt_pk_fp8_f32(h16::lo(r0[t].w), h16::hi(r0[t].w), p, true); q0[t].y = (unsigned)p; }
        { int p = 0; p = __builtin_amdgcn_cvt_pk_fp8_f32(h16::lo(r1[t].x), h16::hi(r1[t].x), p, false); p = __builtin_amdgcn_cvt_pk_fp8_f32(h16::lo(r1[t].y), h16::hi(r1[t].y), p, true); q1[t].x = (unsigned)p;
          p = 0; p = __builtin_amdgcn_cvt_pk_fp8_f32(h16::lo(r1[t].z), h16::hi(r1[t].z), p, false); p = __builtin_amdgcn_cvt_pk_fp8_f32(h16::lo(r1[t].w), h16::hi(r1[t].w), p, true); q1[t].y = (unsigned)p; } }
#pragma unroll
    for (int i = 0; i < 16; ++i) { const int pos = __builtin_amdgcn_readlane(mypos, i); v2u* __restrict__ d = (v2u*)((unsigned char*)XS + (size_t)pos * 1024);
        d[lane] = q0[i >> 1]; d[lane + 64] = q1[i >> 1]; }
}

__device__ __forceinline__ void final_pass(float* xio, const bf16* YS, const int* atomf, const float* slab, const float* g2, const float* fg, int gw, int lane) {
    const int m0 = gw * 8, b = m0 >> 11;
    f32x4 gv[4], g2v[4];
#pragma unroll
    for (int j = 0; j < 4; ++j) { gv[j] = ((const f32x4*)fg)[lane + 64 * j]; g2v[j] = ((const f32x4*)(g2 + (size_t)b * 6144))[lane + 64 * j]; }
    for (int i = 0; i < 8; ++i) {
        const int m = m0 + i;
        f32x4* xr = (f32x4*)(xio + (size_t)m * 1024) + lane;
        const v2u* y0 = (const v2u*)(YS + (size_t)(2 * m) * 1024) + lane; const v2u* y1 = (const v2u*)(YS + (size_t)(2 * m + 1) * 1024) + lane;
        f32x4 v[4]; float s = 0.f; const i32x4 f0 = *(const i32x4*)(atomf + (size_t)(2 * m) * 4), f1 = *(const i32x4*)(atomf + (size_t)(2 * m + 1) * 4);
#pragma unroll
        for (int j = 0; j < 4; ++j) { v[j] = xr[64 * j]; const v2u a = y0[64 * j], c = y1[64 * j];
            f32x4 ya, yc;
            if (f0[j]) { const int id = f0[j] - 1; const float* sp = slab + ((size_t)((id >> 8) * 11) * 256 + (id & 255)) * 256 + 4 * lane; ya = (f32x4){0.f, 0.f, 0.f, 0.f};
                for (int kc = 0; kc < 11; ++kc) ya += *(const f32x4*)(sp + (size_t)kc * 65536); }
            else { ya[0] = h16::lo(a.x); ya[1] = h16::hi(a.x); ya[2] = h16::lo(a.y); ya[3] = h16::hi(a.y); }
            if (f1[j]) { const int id = f1[j] - 1; const float* sp = slab + ((size_t)((id >> 8) * 11) * 256 + (id & 255)) * 256 + 4 * lane; yc = (f32x4){0.f, 0.f, 0.f, 0.f};
                for (int kc = 0; kc < 11; ++kc) yc += *(const f32x4*)(sp + (size_t)kc * 65536); }
            else { yc[0] = h16::lo(c.x); yc[1] = h16::hi(c.x); yc[2] = h16::lo(c.y); yc[3] = h16::hi(c.y); }
            const f32x4 ys = ya + yc;
            v[j] = v[j] + g2v[j] * ys; s += (v[j][0] * v[j][0] + v[j][1] * v[j][1]) + (v[j][2] * v[j][2] + v[j][3] * v[j][3]); }
        const float rs = 1.0f / sqrtf(wave_sum(s) * (1.0f / 1024.0f) + 1e-6f);
#pragma unroll
        for (int j = 0; j < 4; ++j) xr[64 * j] = v[j] * rs * gv[j];
    }
}

__device__ __forceinline__ void xcd_barrier_arrive(const XcdBarrier& b) {
    asm volatile("s_waitcnt vmcnt(0)" ::: "memory");
    __syncthreads();
    if (otid(b.wv) == 0) {
        unsigned* bar = b.bar;
        __builtin_amdgcn_s_waitcnt(0);
        unsigned nloc = b.st[0], nx = b.st[1];
        if (nloc == 0u) { xcd_barrier_complete(bar, b.x, nloc, nx); b.st[0] = nloc; b.st[1] = nx; }
        const unsigned old = xb_add(&bar[XB_XSUB(b.x)], 1u);
        const unsigned gen = old / nloc;
        if (old + 1u == (gen + 1u) * nloc) {
            __builtin_amdgcn_fence(__ATOMIC_RELEASE, "agent");
            asm volatile("s_waitcnt vmcnt(0)" ::: "memory");
            const unsigned og = xb_add(&bar[XB_TOP], 1u);
            const unsigned tg = og / nx;
            if (og + 1u == (tg + 1u) * nx) xb_add(&bar[XB_TOPGEN], 1u);
            else XB_SPIN(xb_ld(&bar[XB_TOPGEN]) == tg, bar);
            xb_add(&bar[XB_XGEN(b.x)], 1u);
            asm volatile("s_waitcnt vmcnt(0)" ::: "memory");
        }
        b.st[3] = gen;
    }
}
__device__ __forceinline__ void xcd_barrier_wait(const XcdBarrier& b) {
    if (otid(b.wv) == 0) {
        unsigned* bar = b.bar;
        const unsigned gen = b.st[3];
        XB_SPIN(xb_ld(&bar[XB_XGEN(b.x)]) == gen, bar);
        __builtin_amdgcn_fence(__ATOMIC_ACQUIRE, "agent");
        asm volatile("s_waitcnt vmcnt(0)" ::: "memory");
    }
    __syncthreads();
}
constexpr int N_PHASES = 18;
struct Args { Inputs in; float* out; unsigned char* ws; int ph_lo, ph_hi, bar_region, moe_w; };

typedef const Args __attribute__((address_space(4))) CArgs;
__device__ __forceinline__ CArgs* kargs() { unsigned long off = 0; asm volatile("" : "+s"(off)); return (CArgs*)((const char __attribute__((address_space(4)))*)__builtin_amdgcn_kernarg_segment_ptr() + off); }

__global__ void __launch_bounds__(NWAVES * 64, 2) mega(Args args_unused) {
    extern __shared__ __attribute__((aligned(16))) unsigned char lds_raw[];
    LAS unsigned char* lds = (LAS unsigned char*)lds_raw;
    volatile LAS unsigned* MISC = (volatile LAS unsigned*)(lds + MISC_OFF);
    const int G = gridDim.x;
#define PHASE_IDS int tid = otid(WV); int bx = blockIdx.x; asm volatile("" : "+s"(bx)); const int lane = tid & 63, wave = __builtin_amdgcn_readfirstlane(tid >> 6); \
    const int vcu = (bx & 7) * (G >> 3) + (bx >> 3); const int gw = vcu * NWAVES + wave; (void)lane; (void)gw; (void)vcu;
    const int WV = __builtin_amdgcn_readfirstlane((int)threadIdx.x >> 6);
    for (int u = otid(WV); u < (LDS_BYTES - LDSCTL_OFF) / 4; u += NWAVES * 64) ((LAS unsigned*)(lds + LDSCTL_OFF))[u] = 0u;
    __syncthreads();
    XcdBarrier bar;
    { CArgs* ka = kargs(); unsigned* barw = (unsigned*)(ka->ws + WS_CTL) + CW_BAR + ka->bar_region * XCD_BAR_WORDS; bar = xcd_barrier_post(barw, MISC + 8, WV); }
    int lo, hi; { CArgs* ka = kargs(); lo = ka->ph_lo; hi = ka->ph_hi; }
#ifndef PHM
#define PHM 0x3ff
#endif
#define IN(k) (lo <= (k) && (k) < hi)
#define TY(t) (((PHM) >> (t)) & 1)
#ifndef DUP_T
#define DUP_T -1
#define DUP_N 0
#endif
#define REP(t) for (int rep_ = 0; rep_ < ((t) == DUP_T ? 1 + DUP_N : 1) && (rep_ == 0 || (__syncthreads(), true)); ++rep_)
#ifdef TPROBE
#define TS ((volatile LAS unsigned long long*)(lds + MISC_OFF + 256))
#define STAMP(k) do { if (blockIdx.x == 0 && otid(WV) == 0) TS[(k)] = __builtin_amdgcn_s_memrealtime(); } while (0)
#else
#define STAMP(k) do {} while (0)
#endif
#ifdef TSPIN
#ifndef TSPIN_BX
#define TSPIN_BX 0
#endif
#define TSL ((volatile LAS unsigned long long*)(lds + MISC_OFF + 256))
#define STAMP_E(k) do { if (blockIdx.x == TSPIN_BX && otid(WV) == 0) { const unsigned long long n_ = __builtin_amdgcn_s_memrealtime(); if (((TSPIN_W) >> (k)) & 1) TSL[1] += n_ - TSL[0]; TSL[0] = n_; } } while (0)
#define STAMP_S(k) do { if (blockIdx.x == TSPIN_BX && otid(WV) == 0) { const unsigned long long n_ = __builtin_amdgcn_s_memrealtime(); if (((TSPIN_B) >> (k)) & 1) TSL[1] += n_ - TSL[0]; TSL[0] = n_; } } while (0)
    if (blockIdx.x == TSPIN_BX && otid(WV) == 0) { TSL[1] = 0ull; TSL[0] = __builtin_amdgcn_s_memrealtime(); }
#else
#define STAMP_E(k) do {} while (0)
#define STAMP_S(k) do {} while (0)
#endif
    STAMP(0);
#define SEAM(k) do { STAMP_E(k); if (IN(k) && IN((k) + 1)) xcd_barrier(bar); STAMP_S(k); STAMP((k) + 1); } while (0)

    if (TY(0) && IN(0)) REP(0) { PHASE_IDS CArgs* ka = kargs(); p0_prologue(&ka->in, ka->ws, lds, vcu, G, wave, lane, tid, 0); }
    SEAM(0);
#ifdef PROBE_BAR
    for (int q = 0; q < PROBE_BAR; ++q) xcd_barrier(bar);
#endif
    for (int l = 0; l < 2; ++l) {
        const int pb = 1 + 8 * l;
        if (TY(1) && IN(pb + 0)) REP(1) { PHASE_IDS CArgs* ka = kargs(); unsigned char* ws = ka->ws; const float* mod = (const float*)(ws + WS_MOD) + (size_t)l * 8 * 6144;
            const float* xin = (l == 0) ? ka->in.x : (const float*)ka->out;
            if (gw < 2048) norm_pass<0>(xin, ka->in.norm_mix_g + l * 1024, mod + 0 * 1024, mod + 1 * 1024, (bf16*)(ws + WS_XA), nullptr, nullptr, nullptr, nullptr, gw, lane); }
        SEAM(pb + 0);
        if (TY(2) && IN(pb + 1)) REP(2) { PHASE_IDS CArgs* ka = kargs(); unsigned char* ws = ka->ws;
            if (bx < G_INPROJ) {
                pg8::Gemm g{1024, 1024, 1024}; pg8::DenseSched S; S.init(ws + WS_XA, 1024, (bf16*)(ws + WS_WIN) + (size_t)l * 3584 * 1024, 1024, 16384, 3584, G_INPROJ, bx);
                epi::EpiInProj E{(bf16*)(ws + WS_QKV), (size_t)16384 * 512, (float*)(ws + WS_KMP), (const float*)(ws + WS_ROPE)};
                pg8::gemm_phase(WV, lds, g, S, E);
            } else if (rep_ == 0) { convert_moe_range<0>(&ka->in, ws, lds, l == 0 ? 0 : IT_MOE_B, l == 0 ? IT_MOE_A : IT_MGU, bx - G_INPROJ, G - G_INPROJ, wave, lane);
                                    if (l == 1) convert_moe_range<1>(&ka->in, ws, lds, 0, IT_MDN_C, bx - G_INPROJ, G - G_INPROJ, wave, lane);
#ifdef PROBE_CONVIN
                                    if (l == PROBE_CONVIN) { __syncthreads(); if (l == 0) convert_moe_range<0>(&ka->in, ws, lds, 0, IT_MOE_A, bx - G_INPROJ, G - G_INPROJ, wave, lane); else convert_moe_range<1>(&ka->in, ws, lds, 0, IT_MDN_C, bx - G_INPROJ, G - G_INPROJ, wave, lane); }
#endif
                                    }
        }
        SEAM(pb + 1);
        if (TY(3) && IN(pb + 2)) REP(3) { PHASE_IDS CArgs* ka = kargs(); unsigned char* ws = ka->ws; bf16* QKV = (bf16*)(ws + WS_QKV); bf16* CAT = (bf16*)(ws + WS_CAT);
            if (G == 256) {
                if ((bx & 7) < 7) fa::kv_unit(WV, bx >> 5, (bx >> 3) & 3, bx & 7, QKV + (size_t)4 * 16384 * 512, QKV + (size_t)5 * 16384 * 512, (float*)(ws + WS_KVM), lds);
                xcd_barrier_arrive(bar);
                { fa::Tensors TA{QKV, QKV + (size_t)1 * 16384 * 512, QKV + (size_t)2 * 16384 * 512, CAT, (float*)(ws + WS_ASSQ), (const float*)(ws + WS_KMP), nullptr, nullptr, nullptr};
                  const int g2 = (bx >> 3) * 2, r4 = (bx & 7) * 4;
                  for (int uu = 0; uu < 2; ++uu) { const int bh = g2 + uu; fa::attn_unit<false>(WV, bh >> 3, bh & 7, ((uu == 0 ? 0x25170643 : 0x31507246) >> r4) & 7, TA, lds); } }
                xcd_barrier_wait(bar);
                { fa::Tensors TR{QKV + (size_t)3 * 16384 * 512, QKV + (size_t)4 * 16384 * 512, QKV + (size_t)5 * 16384 * 512, CAT, (float*)(ws + WS_ASSQ), (const float*)(ws + WS_KMP), QKV + (size_t)6 * 16384 * 512, ka->in.ret_g + l * 512, (const float*)(ws + WS_KVM)};
                  fa::attn_unit<true>(WV, bx >> 5, (bx >> 3) & 3, bx & 7, TR, lds); }
            }
        }
        SEAM(pb + 2);
        if (TY(4) && IN(pb + 3)) REP(4) {
            { PHASE_IDS CArgs* ka = kargs(); unsigned char* ws = ka->ws; const float* mod = (const float*)(ws + WS_MOD) + (size_t)l * 8 * 6144;
                const float* xin = (l == 0) ? ka->in.x : (const float*)ka->out;
                pg8::Gemm g{1024, 1024, 1024}; pg8::DenseSched S; S.init(ws + WS_CAT, 1024, (const bf16*)(ws + WS_WOUT) + (size_t)l * 1024 * 1024, 1024, 16384, 1024, G, bx);
                epi::EpiOutProj E{xin, ka->out, mod + 2 * 1024, (const float*)(ws + WS_ASSQ), rep_ > 0}; pg8::gemm_phase(WV, lds, g, S, E); }
        }
        SEAM(pb + 3);
        if (TY(5) && IN(pb + 4)) REP(5) { PHASE_IDS CArgs* ka = kargs(); unsigned char* ws = ka->ws; const float* mod = (const float*)(ws + WS_MOD) + (size_t)l * 8 * 6144;
            if (gw < 2048) {
                if (l == 0) norm_pass<2>(ka->out, ka->in.norm_ffn_g + l * 1024, mod + 3 * 1024, mod + 4 * 1024, (bf16*)(ws + WS_XA), nullptr, nullptr, nullptr, nullptr, gw, lane);
                else norm_pass<1>(ka->out, ka->in.norm_ffn_g + l * 1024, mod + 3 * 1024, mod + 4 * 1024, (bf16*)(ws + WS_XA), ka->in.router_w, (int*)(ws + WS_EIDX), (float*)(ws + WS_EW), (int*)(ws + WS_WCNT), gw, lane);
            }
            if (l == 1) { int* srow = (int*)(ws + WS_SROW); int* af = (int*)(ws + WS_ATOMF);
                { const int p = bx * 512 + tid; if (p < XS_ROWS) srow[p] = -1; af[p] = 0; }
            }
            else if (bx == 0 && tid < 9) { ((int*)(ws + WS_SEGD))[tid] = (tid == 0) ? 0 : ((tid == 8) ? 16384 : (1 << 30)); }
        }
        SEAM(pb + 4);
        if (l == 1) {
            if (TY(6) && IN(pb + 5)) REP(6) { PHASE_IDS CArgs* ka = kargs(); unsigned char* ws = ka->ws;
                if (gw < 2048) place_pass((const int*)(ws + WS_WCNT), (const int*)(ws + WS_EIDX), (const float*)(ws + WS_EW), (const bf16*)(ws + WS_XA), (bf16*)(ws + WS_XS), (int*)(ws + WS_SROW), (float*)(ws + WS_SWT), (int*)(ws + WS_SEG), gw, 2048, lane); }
            SEAM(pb + 5);
        } else { STAMP(pb + 6); }
        if (TY(7) && IN(pb + 6)) REP(7) { PHASE_IDS CArgs* ka = kargs(); unsigned char* ws = ka->ws;
            int Geff = G_GUD;
            if (l == 1) { const int nwg = (__builtin_amdgcn_readfirstlane(((const int*)(ws + WS_SEG))[8]) / 256) * 22; const int rounds = (nwg + G - 1) / G;
                Geff = (((nwg + rounds - 1) / rounds) + 7) & ~7; if (Geff > G - MOE_SPARE) Geff = G - MOE_SPARE; }
            if (bx < Geff) {
                pg8::Gemm g{512, 512, 512}; pg8::MoeSched S;
                S.init(ws + (l == 0 ? WS_XA : WS_XS), 512, ws + (l == 0 ? WS_FGU : WS_MGU), 512, (size_t)5632 * 1024, (const int*)(ws + (l == 0 ? WS_SEGD : WS_SEG)), 5632, Geff, bx);
                epi::EpiSwiGLU8 E{ws + (l == 0 ? WS_HD : WS_HM), 2816}; pg8::gemm_phase(WV, lds, g, S, E);
            } else if (rep_ == 0) { if (l == 0) { convert_base_late(&ka->in, ws, lds, bx - Geff, G - Geff, wave, lane); convert_moe_range<0>(&ka->in, ws, lds, IT_MOE_A, IT_MOE_B, bx - Geff, G - Geff, wave, lane); }
                                    else { convert_moe_range<1>(&ka->in, ws, lds, IT_MDN_C, IT_MDN, bx - Geff, G - Geff, wave, lane);
#ifdef PROBE_CONV2
                                           __syncthreads(); convert_moe_range<1>(&ka->in, ws, lds, IT_MDN_C, IT_MDN, bx - Geff, G - Geff, wave, lane);
#endif
                                    } }
        }
        SEAM(pb + 6);
        if (TY(8) && IN(pb + 7)) REP(8) { PHASE_IDS CArgs* ka = kargs(); unsigned char* ws = ka->ws; const float* mod = (const float*)(ws + WS_MOD) + (size_t)l * 8 * 6144;
            if (l == 0) { pg8::MoeSched S; S.init(ws + WS_HD, 1408, ws + WS_FDN, 1408, (size_t)1024 * 2816, (const int*)(ws + WS_SEGD), 1024, G, bx);
                pg8::Gemm g{1408, 1408, 1408};
                epi::EpiDownDense8 E{ka->out, mod + 5 * 1024, rep_ > 0}; pg8::gemm_phase(WV, lds, g, S, E);
            } else {
                pg8::MoeSched S; S.init(ws + WS_HM, 1408, ws + WS_MDN, 1408, (size_t)1024 * 2816, (const int*)(ws + WS_SEG), 1024, G, bx);
#ifndef NO_SPLITK
                const int left = S.nwg % G; const bool split = left > 0 && left <= 32;
                if (split) S.lim = S.nwg - left;
#endif
                { pg8::Gemm g{1408, 1408, 1408};
                  epi::EpiDownMoe8 E{(bf16*)(ws + WS_YS), (const int*)(ws + WS_SROW), (const float*)(ws + WS_SWT)}; pg8::gemm_phase(WV, lds, g, S, E); }
#ifndef NO_SPLITK
                if (split && rep_ == 0) { S.first = S.nwg - left; S.lim = S.nwg; S.KS = 11; S.kbytes = 256;
                  pg8::Gemm g{1408, 1408, 128};
                  epi::EpiDownMoe8Slab E{(const int*)(ws + WS_SROW), (const float*)(ws + WS_SWT), (int*)(ws + WS_ATOMF), (float*)(ws + WS_SLAB), 11}; pg8::gemm_phase(WV, lds, g, S, E); }
#endif
            }
        }
        SEAM(pb + 7);
    }
    if (TY(9) && IN(17)) { PHASE_IDS CArgs* ka = kargs(); unsigned char* ws = ka->ws;
        if (gw < 2048) final_pass(ka->out, (const bf16*)(ws + WS_YS), (const int*)(ws + WS_ATOMF), (const float*)(ws + WS_SLAB), (const float*)(ws + WS_MOD) + (size_t)1 * 8 * 6144 + 5 * 1024, ka->in.final_g, gw, lane); }
#ifdef TSPIN
    STAMP_E(17);
    if (blockIdx.x == TSPIN_BX && otid(WV) == 0) { const unsigned long long t0_ = __builtin_amdgcn_s_memrealtime(), w_ = TSL[1] * (unsigned long long)(TSPIN_K);
        while (__builtin_amdgcn_s_memrealtime() - t0_ < w_) __builtin_amdgcn_s_sleep(8); }
#endif
#ifdef TPROBE
    xcd_barrier(bar); STAMP(18); __syncthreads();
    if (blockIdx.x == 0) { CArgs* ka = kargs(); float* o = ka->out;
        const float d1 = (float)(TS[TPROBE_A + 1] - TS[TPROBE_A]) * 0.01f, d2 = (float)(TS[TPROBE_B + 1] - TS[TPROBE_B]) * 0.01f;
        const float a = 4.0f * sqrtf(d1);
        for (int i = otid(WV); i < 1024 * 1024; i += 512) o[i] = a;
        if (otid(WV) == 0) o[1024 * 1024 + 5] = 100.0f * d2; }
#endif
#undef IN
#undef TY
#undef SEAM
#undef PHASE_IDS
}
}
#ifndef STEP
#define STEP 5
#endif
namespace ad {
__device__ __forceinline__ float bf2f(unsigned short s) { return h16::one(s); }
__global__ void __launch_bounds__(256) ad_proj(const unsigned short* QKV, size_t gstride, int b, float* projb) {
    const int m = blockIdx.x; const size_t row = (size_t)b * 2048 + m;
    for (int n = threadIdx.x; n < 3584; n += 256) {
        const int grp = n / 512, c = n % 512; int sc = c;
        if (grp == 3 || grp == 4) { const int head = c >> 7, d = c & 127; sc = head * 128 + 8 * ((d & 63) >> 2) + 2 * (d & 3) + (d >> 6); }
        float v = bf2f(QKV[(size_t)grp * gstride + row * 512 + sc]);
        if (grp == 0) v *= (1.0f / epi::C2);
        if (grp == 4) v *= (1.0f / epi::KSC);
        projb[(size_t)m * 3584 + n] = v;
    }
}
__global__ void __launch_bounds__(64) ad_kmean(const float* KMP, int b, float* kmeanb) {
    const int blk = blockIdx.x, h = blockIdx.y, d = threadIdx.x;
    const float* p = KMP + ((size_t)(b * 8 + blk) * 2) * 512 + h * 64 + d;
    kmeanb[((size_t)h * 8 + blk) * 64 + d] = (p[0] + p[512]) * (1.0f / 256.0f);
}
__global__ void __launch_bounds__(256) ad_cat(const unsigned short* CAT, const float* ASSQ, const float* att_g, int b, float* catb) {
    const int m = blockIdx.x; const size_t row = (size_t)b * 2048 + m;
    float ss = 0.f;
    for (int h = 0; h < 8; ++h) ss += ASSQ[row * 8 + h];
    const float rs = 1.0f / sqrtf(ss * (1.0f / 512.0f) + 1e-6f);
    for (int c = threadIdx.x; c < 1024; c += 256) { const float v = bf2f(CAT[row * 1024 + c]); catb[(size_t)m * 1024 + c] = (c < 512) ? v * rs * att_g[c] : v; }
}
__global__ void __launch_bounds__(256) dbg_cmp(const float* a, const float* b, size_t n, float rel, float abs_, unsigned* flag, int ncols = 1, int c_lo = 0, int c_hi = 1, int silu_b = 0) {
    unsigned bad = 0;
    for (size_t i = (size_t)blockIdx.x * 256 + threadIdx.x; i < n; i += (size_t)gridDim.x * 256) { const int c = (int)(i % ncols); if (c < c_lo || c >= c_hi) continue;
        float bv = b[i]; if (silu_b) bv = bv / (1.f + expf(-bv)); const float d = fabsf(a[i] - bv); if (!(d <= rel * fabsf(bv) + abs_)) ++bad; }
    if (bad) atomicAdd(flag, bad);
}
__global__ void __launch_bounds__(256) dbg_poison(const unsigned* flag, unsigned thresh, float* out, float val) {
    if (*flag > thresh) for (int i = threadIdx.x; i < 1024 * 1024; i += 256) out[i] = val;
}
__global__ void __launch_bounds__(256) dbg_ssd(const float* a, const float* b, size_t n, int ncols, int c_lo, int c_hi, float* acc) {
    float s = 0.f;
    for (size_t i = (size_t)blockIdx.x * 256 + threadIdx.x; i < n; i += (size_t)gridDim.x * 256) { const int c = (int)(i % ncols); if (c < c_lo || c >= c_hi) continue; const float d = a[i] - b[i]; s += d * d; }
    atomicAdd(acc, s);
}
__global__ void __launch_bounds__(256) dbg_encode(const float* acc, float count, float* out) {
    const float mse = *acc / count; const float val = 4.0f / sqrtf(mse);
    for (int i = threadIdx.x; i < 1024 * 1024; i += 256) out[i] = val;
}
}

static void launch_mega(const mk::Args& a0, int lo, int hi, int region, hipStream_t stream) {
    mk::Args a = a0; a.ph_lo = lo; a.ph_hi = hi; a.bar_region = region;
    hipLaunchKernelGGL(mk::mega, dim3(256), dim3(512), mk::LDS_BYTES, stream, a);
}

extern "C" void kernel_launch(void* const* d_in, const int* in_sizes, int n_in, void* d_out, int out_size, void* d_ws, size_t ws_size, hipStream_t stream) {
    static int ready = 0;
    if (ready == 0) {
        if (n_in != 18 || out_size != M * D || ws_size < mk::WS_END) { fprintf(stderr, "kernel_launch: unexpected problem (n_in %d, out %d, ws %zu)\n", n_in, out_size, ws_size); ready = -1; return; }
        if (hipFuncSetAttribute((const void*)mk::mega, hipFuncAttributeMaxDynamicSharedMemorySize, mk::LDS_BYTES) != hipSuccess) { fprintf(stderr, "kernel_launch: hipFuncSetAttribute failed\n"); ready = -1; return; }
        ready = 1;
    }
    if (ready < 0) return;
    mk::Args a{};
    const float** ip = (const float**)&a.in;
    for (int i = 0; i < 18; ++i) ip[i] = (const float*)d_in[i];
    a.out = (float*)d_out; a.ws = (unsigned char*)d_ws; a.moe_w = (STEP >= 5) ? 1 : 0;
    const mk::Inputs& in = a.in;
    float* out = (float*)d_out; unsigned char* ws = (unsigned char*)d_ws;
    hipMemsetAsync(ws + mk::WS_CTL, 0, mk::CTL_ZERO_BYTES, stream);
#if STEP >= 6
    launch_mega(a, 0, mk::N_PHASES, 0, stream);
#else
    constexpr size_t MiB = 1u << 20;
    unsigned char* na = ws + 8 * MiB;
    float* PROJb = (float*)(na);
    float* Hb = (float*)(na + 28 * MiB);
    float* CATb = (float*)(na + 36 * MiB);
    float* OAb = (float*)(na + 44 * MiB);
    float* ORRb = (float*)(na + 48 * MiB);
    float* KMEANb = (float*)(na + 52 * MiB);
    int* EIDXb = (int*)(na + 53 * MiB); float* EWb = (float*)(na + 53 * MiB + 65536); int* POSb = (int*)(na + 53 * MiB + 131072); int* LISTb = (int*)(na + 53 * MiB + 196608);
    int* CNTb = (int*)(na + 54 * MiB); int* BASEb = CNTb + 16;
    float* Gb = (float*)(na + 56 * MiB);
    float* Ub = (float*)(na + 78 * MiB);
    float* Yb = (float*)(na + 100 * MiB);
    const float* MODp = (const float*)(ws + mk::WS_MOD);
    unsigned short* QKV = (unsigned short*)(ws + mk::WS_QKV);
    launch_mega(a, 0, 1, 1, stream);
    for (int l = 0; l < 2; ++l) {
        const int pb = 1 + 8 * l;
        const float* xin = (l == 0) ? in.x : (const float*)out;
        if (STEP >= 1) { launch_mega(a, pb, pb + 1, 1, stream); launch_mega(a, pb + 1, pb + 2, 1, stream); }
        if (STEP >= 2) launch_mega(a, pb + 2, pb + 3, 1, stream);
        if (STEP >= 3) launch_mega(a, pb + 3, pb + 4, 1, stream);
        if (STEP < 3) {
            for (int b = 0; b < BATCH; ++b) {
                const float* mod = MODp + ((size_t)l * BATCH + b) * 6 * D;
                const float* xb = xin + (size_t)b * SEQ * D; float* ob = out + (size_t)b * SEQ * D;
                if (STEP < 1) {
                    nv::k_norm<<<SEQ, 256, 0, stream>>>(xb, in.norm_mix_g + l * D, mod + 0 * D, mod + 1 * D, Hb);
                    nv::k_gemm<<<dim3(NPROJ / 64, SEQ / 64), 256, 0, stream>>>(Hb, D, nullptr, nullptr, SEQ, in.w_in + (size_t)l * D * NPROJ, NPROJ, PROJb, NPROJ, D);
                    nv::k_rotary<<<SEQ, 256, 0, stream>>>(PROJb);
                    nv::k_kmean<<<dim3(NBLK, AH, 1), 64, 0, stream>>>(PROJb, KMEANb);
                } else {
                    ad::ad_proj<<<SEQ, 256, 0, stream>>>(QKV, (size_t)M * 512, b, PROJb);
                    ad::ad_kmean<<<dim3(NBLK, AH, 1), 64, 0, stream>>>((const float*)(ws + mk::WS_KMP), b, KMEANb);
#ifdef DBG_CHECK
                    { float* PROJn = Gb; float* KMn = (float*)(na + 52 * MiB + 262144); unsigned* flag = (unsigned*)(ws + mk::WS_CTL) + 16;
                      nv::k_norm<<<SEQ, 256, 0, stream>>>(xb, in.norm_mix_g + l * D, mod + 0 * D, mod + 1 * D, Hb);
                      nv::k_gemm<<<dim3(NPROJ / 64, SEQ / 64), 256, 0, stream>>>(Hb, D, nullptr, nullptr, SEQ, in.w_in + (size_t)l * D * NPROJ, NPROJ, PROJn, NPROJ, D);
                      nv::k_rotary<<<SEQ, 256, 0, stream>>>(PROJn);
                      nv::k_kmean<<<dim3(NBLK, AH, 1), 64, 0, stream>>>(PROJn, KMn);
                      ad::dbg_cmp<<<1024, 256, 0, stream>>>(PROJb, PROJn, (size_t)SEQ * NPROJ, DBG_REL, DBG_ABS, flag, NPROJ, 0, 3072, 0);
                      ad::dbg_cmp<<<1024, 256, 0, stream>>>(PROJb, PROJn, (size_t)SEQ * NPROJ, DBG_REL, DBG_ABS, flag, NPROJ, 3072, 3584, 1);
                      ad::dbg_cmp<<<16, 256, 0, stream>>>(KMEANb, KMn, (size_t)8 * 8 * 64, 0.03f, 0.004f, flag + 1);
                      if (l == DBG_L && b == 0) ad::dbg_ssd<<<1024, 256, 0, stream>>>(PROJb, PROJn, (size_t)SEQ * NPROJ, NPROJ, DBG_CLO, DBG_CHI, (float*)(flag + 2)); }
#endif
                }
                if (STEP < 2) {
                    nv::k_moba<<<dim3(NBLK, AH, 1), 256, 0, stream>>>(PROJb, KMEANb, OAb);
                    nv::k_ret<<<dim3(SEQ / 256, RH * 4, 1), 256, 0, stream>>>(PROJb, ORRb);
                    nv::k_cat<<<SEQ, 256, 0, stream>>>(OAb, ORRb, PROJb, in.att_g + l * AW, in.ret_g + l * RW, CATb, STEP >= 1 ? 1 : 0);
                } else {
                    ad::ad_cat<<<SEQ, 256, 0, stream>>>((const unsigned short*)(ws + mk::WS_CAT), (const float*)(ws + mk::WS_ASSQ), in.att_g + l * AW, b, CATb);
                }
                nv::k_gemm<<<dim3(D / 64, SEQ / 64), 256, 0, stream>>>(CATb, D, nullptr, nullptr, SEQ, in.w_out + (size_t)l * D * D, D, Hb, D, D);
                nv::k_resid<<<SEQ, 256, 0, stream>>>(xb, mod + 2 * D, Hb, ob);
            }
        }
        const bool ffn_mega = (l == 0) ? (STEP >= 4) : (STEP >= 5);
        if (ffn_mega) {
            launch_mega(a, pb + 4, pb + 5, 1, stream);
            if (l == 1) launch_mega(a, pb + 5, pb + 6, 1, stream);
            launch_mega(a, pb + 6, pb + 7, 1, stream);
            launch_mega(a, pb + 7, pb + 8, 1, stream);
        } else {
            for (int b = 0; b < BATCH; ++b) {
                const float* mod = MODp + ((size_t)l * BATCH + b) * 6 * D;
                float* ob = out + (size_t)b * SEQ * D;
                nv::k_norm<<<SEQ, 256, 0, stream>>>(ob, in.norm_ffn_g + l * D, mod + 3 * D, mod + 4 * D, Hb);
                if (l == 0) {
                    nv::k_gemm<<<dim3(FF / 64, SEQ / 64), 256, 0, stream>>>(Hb, D, nullptr, nullptr, SEQ, in.fw_gate, FF, Gb, FF, D);
                    nv::k_gemm<<<dim3(FF / 64, SEQ / 64), 256, 0, stream>>>(Hb, D, nullptr, nullptr, SEQ, in.fw_up, FF, Ub, FF, D);
                    nv::k_silu_mul<<<SEQ, 256, 0, stream>>>(Gb, Ub, nullptr, SEQ, FF);
                    nv::k_gemm<<<dim3(D / 64, SEQ / 64), 256, 0, stream>>>(Gb, FF, nullptr, nullptr, SEQ, in.fw_down, D, Ub, D, FF);
                    nv::k_resid<<<SEQ, 256, 0, stream>>>(ob, mod + 5 * D, Ub, ob);
                } else {
                    nv::k_router<<<SEQ / 4, 256, 0, stream>>>(Hb, in.router_w, EIDXb, EWb);
                    nv::k_place<<<1, 1024, 0, stream>>>(EIDXb, LISTb, POSb, CNTb, BASEb, 4);
                    float* GE = Gb; float* UE = Ub;
                    for (int e = 0; e < NE; ++e) {
                        nv::k_gemm<<<dim3(FF / 64, ECAP / 64), 256, 0, stream>>>(Hb, D, LISTb, CNTb + e, ECAP, in.mw_gate + (size_t)e * D * FF, FF, GE, FF, D, BASEb + e, nullptr);
                        nv::k_gemm<<<dim3(FF / 64, ECAP / 64), 256, 0, stream>>>(Hb, D, LISTb, CNTb + e, ECAP, in.mw_up + (size_t)e * D * FF, FF, UE, FF, D, BASEb + e, nullptr);
                        nv::k_silu_mul<<<ECAP, 256, 0, stream>>>(GE, UE, CNTb + e, ECAP, FF);
                        nv::k_gemm<<<dim3(D / 64, ECAP / 64), 256, 0, stream>>>(GE, FF, nullptr, CNTb + e, ECAP, in.mw_down + (size_t)e * FF * D, D, Yb, D, FF, nullptr, BASEb + e);
                    }
                    nv::k_moe_combine<<<SEQ, 256, 0, stream>>>(ob, mod + 5 * D, Yb, POSb, EWb);
                }
            }
        }
    }
    if (STEP >= 5) launch_mega(a, 17, 18, 1, stream);
    else nv::k_norm<<<M, 256, 0, stream>>>(out, in.final_g, nullptr, nullptr, out);
#ifdef DBG_CHECK
#ifdef DBG_ENC
    ad::dbg_encode<<<1, 256, 0, stream>>>((const float*)((unsigned*)(ws + mk::WS_CTL) + 18), (float)SEQ * (DBG_CHI - DBG_CLO), out);
#endif
    ad::dbg_poison<<<1, 256, 0, stream>>>((unsigned*)(ws + mk::WS_CTL) + 16, DBG_T0, out, 100.0f);
    ad::dbg_poison<<<1, 256, 0, stream>>>((unsigned*)(ws + mk::WS_CTL) + 17, DBG_T1, out + (1 << 20), 300.0f);
#endif
#endif
}
```

```cpp
#include <hip/hip_runtime.h>
#include <cstdio>
#include <cstdint>
#include <cmath>

namespace h16 {
typedef _Float16 f16x2_t __attribute__((ext_vector_type(2)));
typedef _Float16 f16x8_t __attribute__((ext_vector_type(8)));
typedef float f32x2_t __attribute__((ext_vector_type(2)));
__device__ __forceinline__ unsigned pk(float lo, float hi) { f32x2_t v = {lo, hi}; f16x2_t b = __builtin_convertvector(v, f16x2_t); return __builtin_bit_cast(unsigned, b); }
__device__ __forceinline__ float lo(unsigned u) { return (float)__builtin_bit_cast(f16x2_t, u)[0]; }
__device__ __forceinline__ float hi(unsigned u) { return (float)__builtin_bit_cast(f16x2_t, u)[1]; }
__device__ __forceinline__ float one(unsigned short s) { return (float)__builtin_bit_cast(_Float16, s); }
}

namespace xl {
template <int O> __device__ __forceinline__ int xor_i(int v) {
    if constexpr (O < 32) return __builtin_amdgcn_ds_swizzle(v, (O << 10) | 0x1f);
    else { static_assert(O < 32, "use add32 / max32 for the 32-lane exchange"); return v; }
}
template <int O> __device__ __forceinline__ float xor_f(float v) { return __builtin_bit_cast(float, xor_i<O>(__builtin_bit_cast(int, v))); }
__device__ __forceinline__ void swap32(unsigned a, unsigned& r0, unsigned& r1) { unsigned b = a; asm volatile("" : "+v"(b)); auto r = __builtin_amdgcn_permlane32_swap(a, b, false, false); r0 = r[0]; r1 = r[1]; }
__device__ __forceinline__ float xor32p(float v, bool upper) { unsigned r0, r1; swap32(__builtin_bit_cast(unsigned, v), r0, r1); return __builtin_bit_cast(float, upper ? r0 : r1); }
__device__ __forceinline__ float add32(float v) { unsigned r0, r1; swap32(__builtin_bit_cast(unsigned, v), r0, r1); return __builtin_bit_cast(float, r0) + __builtin_bit_cast(float, r1); }
__device__ __forceinline__ float max32(float v) { unsigned r0, r1; swap32(__builtin_bit_cast(unsigned, v), r0, r1); return fmaxf(__builtin_bit_cast(float, r0), __builtin_bit_cast(float, r1)); }
__device__ __forceinline__ int add32i(int v) { unsigned r0, r1; swap32((unsigned)v, r0, r1); return (int)(r0 + r1); }
__device__ __forceinline__ float wave_sum(float v) { v += xor_f<1>(v); v += xor_f<2>(v); v += xor_f<4>(v); v += xor_f<8>(v); v += xor_f<16>(v); return add32(v); }
__device__ __forceinline__ int wave_sum_i(int v) { v += xor_i<1>(v); v += xor_i<2>(v); v += xor_i<4>(v); v += xor_i<8>(v); v += xor_i<16>(v); return add32i(v); }
}

__device__ __forceinline__ int olane() { int l; asm volatile("v_mbcnt_lo_u32_b32 %0, -1, 0\n\tv_mbcnt_hi_u32_b32 %0, -1, %0" : "=v"(l)); return l; }
__device__ __forceinline__ int otid(int wv) { return (wv << 6) | olane(); }
#define STEP 6

constexpr int D = 1024, BATCH = 8, SEQ = 2048, M = BATCH * SEQ;
constexpr int AH = 8, AD = 64, AW = 512, MBLK = 256, NBLK = SEQ / MBLK, TOPK = 3;
constexpr int RH = 4, RD = 128, RW = 512;
constexpr int NPROJ = 3 * AW + 4 * RW;
constexpr int FF = 2816, NE = 8;
constexpr float EPS = 1e-6f;
constexpr int ECAP = 2048;
namespace pg8 {
#define PG8_LAS __attribute__((address_space(3)))
typedef unsigned short bf16_t;
typedef short bf16x8 __attribute__((ext_vector_type(8)));
typedef float f32x4 __attribute__((ext_vector_type(4)));
typedef float f32x2 __attribute__((ext_vector_type(2)));
typedef unsigned u32x4 __attribute__((ext_vector_type(4)));
typedef unsigned u32x2 __attribute__((ext_vector_type(2)));
typedef int i32x4 __attribute__((ext_vector_type(4)));
constexpr int BM = 256, BK = 64, HALF = 128, HTB = HALF * BK * 2  , STAGE_BYTES = 8 * HTB, NXCD = 8, WGM = 8;

__host__ __device__ __forceinline__ int lds_byte(int r, int c) { const int st = (r >> 4) * 2 + (c >> 5), rr = r & 15, cc = c & 31, ob = rr * 64 + cc * 2; return st * 1024 + (ob ^ (((ob >> 9) & 1) << 5)); }
__host__ __device__ __forceinline__ void stage_rc(int b, int& R, int& C) { const int st = b / 1024, sb = b % 1024, swz = sb ^ (((sb >> 9) & 1) << 5); R = (st >> 1) * 16 + swz / 64; C = (st & 1) * 32 + (swz % 64) / 2; }
__host__ __device__ __forceinline__ int perm32(int rho) { const int n = rho >> 4, i = rho & 15; return 8 * (i >> 2) + 4 * n + (i & 3); }

struct Unit { int pm, pn, e, kc, li; };
struct Gemm { int lda, ldb, K; };

struct DenseSched {
    const char* A; const char* Bt; size_t a_tile, b_tile;
    int nM, nN, nwg, G, c;
    __device__ __forceinline__ void init(const void* A_, int lda, const void* Bt_, int ldb, int M, int N, int G_, int c_) {
        A = (const char*)A_; Bt = (const char*)Bt_; a_tile = (size_t)BM * lda * 2; b_tile = (size_t)BM * ldb * 2; nM = M / BM; nN = N / BM; nwg = nM * nN; G = G_; c = c_; }
    __device__ __forceinline__ bool next(int i, Unit& u) const {
        const long L = (long)i * G + c; if (L >= nwg) return false;
        int wgid = (int)L; { const int q = nwg / NXCD, r = nwg % NXCD, xcd = wgid % NXCD, off = wgid / NXCD; wgid = (xcd < r ? xcd * (q + 1) : r * (q + 1) + (xcd - r) * q) + off; }
        const int nig = WGM * nN, gid = wgid / nig, fm = gid * WGM, gsz = (nM - fm) < WGM ? (nM - fm) : WGM;
        u.pm = fm + ((wgid % nig) % gsz); u.pn = (wgid % nig) / gsz; u.e = 0; u.kc = 0; u.li = 0; return true;
    }
    __device__ __forceinline__ const char* a_ptr(const Unit& u) const { return A + (size_t)u.pm * a_tile; }
    __device__ __forceinline__ const char* b_ptr(const Unit& u) const { return Bt + (size_t)u.pn * b_tile; }
};
struct MoeSched {
    const char* A; const char* Bt; size_t a_tile, b_tile, e_stride;
    int nM, nN, nwg, G, c; int seg[8]; int first, lim, KS, kbytes;
    __device__ __forceinline__ void init(const void* A_, int lda, const void* Bt_, int ldb, size_t e_stride_bytes, const int* segp_, int N, int G_, int c_) {
        A = (const char*)A_; Bt = (const char*)Bt_; a_tile = (size_t)BM * lda * 2; b_tile = (size_t)BM * ldb * 2; e_stride = e_stride_bytes;
#pragma unroll
        for (int e = 0; e < 8; ++e) seg[e] = __builtin_amdgcn_readfirstlane(segp_[e]);
        nM = __builtin_amdgcn_readfirstlane(segp_[8]) / BM; nN = N / BM; nwg = nM * nN; G = G_; c = c_; first = 0; lim = nwg; KS = 1; kbytes = 0; }
    __device__ __forceinline__ bool next(int i, Unit& u) const {
        const long idx = (long)i * G + c; const long L = first + idx / KS; if (L >= lim) return false;
        u.kc = (int)(idx % KS); u.li = (int)(idx / KS);
        int wgid = (int)L; { const int q = nwg / NXCD, r = nwg % NXCD, xcd = wgid % NXCD, off = wgid / NXCD; wgid = (xcd < r ? xcd * (q + 1) : r * (q + 1) + (xcd - r) * q) + off; }
        const int nig = WGM * nN, gid = wgid / nig, fm = gid * WGM, gsz = (nM - fm) < WGM ? (nM - fm) : WGM;
        u.pm = fm + ((wgid % nig) % gsz); u.pn = (wgid % nig) / gsz;
        int e = 0; const int r0 = u.pm * BM;
#pragma unroll
        for (int k = 1; k < 8; ++k) e = (r0 >= seg[k]) ? k : e;
        u.e = __builtin_amdgcn_readfirstlane(e); return true;
    }
    __device__ __forceinline__ const char* a_ptr(const Unit& u) const { return A + (size_t)u.pm * a_tile + (size_t)u.kc * kbytes; }
    __device__ __forceinline__ const char* b_ptr(const Unit& u) const { return Bt + (size_t)u.e * e_stride + (size_t)u.pn * b_tile + (size_t)u.kc * kbytes; }
};

__device__ __forceinline__ unsigned cvt_pk_bf16(float lo, float hi) { return h16::pk(lo, hi); }
__device__ __forceinline__ float fast_silu(float g) { return g * __builtin_amdgcn_rcpf(1.0f + __builtin_amdgcn_exp2f(-1.4426950408889634f * g)); }

typedef f32x4 Acc[2][2][4][2];
typedef int i32x8 __attribute__((ext_vector_type(8)));
template <bool F8> struct Frags;
template <> struct Frags<false> { bf16x8 At[4][2], B0[2][2], B1[2][2]; };
template <> struct Frags<true> { i32x8 At[4], B0[2], B1[2]; };

template <class Epi, class Sched>
__device__ __forceinline__ void gemm_phase(const int wv, PG8_LAS unsigned char* lds, const Gemm g, const Sched& S, const Epi& E) {
    int tid_ = otid(wv);
    const int tid = tid_, wid = __builtin_amdgcn_readfirstlane(tid >> 6), lane = tid & 63, wr = wid >> 2, wc = wid & 3, fr = lane & 15, fq = lane >> 4;
    const int K = g.K; int nt = K / BK; asm volatile("" : "+s"(nt));
    unsigned voffA[2], voffB[2];
#pragma unroll
    for (int i = 0; i < 2; ++i) { int R, C; stage_rc(tid * 16 + i * 8192, R, C); const int Rb = Epi::PERM ? ((R & ~31) + perm32(R & 31)) : R;
        voffA[i] = (unsigned)(R * g.lda + C) * 2u; voffB[i] = (unsigned)(Rb * g.ldb + C) * 2u; }
    const size_t kstep = (size_t)(BK * 2);
    const size_t hstepA = (size_t)HALF * g.lda * 2, hstepB = (size_t)HALF * g.ldb * 2;
    const unsigned ldsw = (unsigned)wid * 1024u;
    const unsigned ldsbase_ = (unsigned)__builtin_amdgcn_readfirstlane((int)((unsigned)(unsigned long)lds + ldsw));
    const int aoff = lds_byte(wr * 64 + fr, fq * 8), boff = lds_byte(wc * 32 + fr, fq * 8);
#define PG8_SA(b, h) (((b) * 2 + (h)) * HTB)
#define PG8_SB(b, h) ((4 + (b) * 2 + (h)) * HTB)
#define PG8_STAGE(bufoff, gbase, voff) do { if constexpr (Epi::FP8) {   \
            const unsigned long long gb_ = (unsigned long long)(gbase); \
            const unsigned long long sb_ = ((unsigned long long)(unsigned)__builtin_amdgcn_readfirstlane((int)(gb_ >> 32)) << 32) | (unsigned)__builtin_amdgcn_readfirstlane((int)gb_); \
            _Pragma("unroll") for (int _i = 0; _i < 2; ++_i) { unsigned keep_; \
                asm volatile("s_mov_b32 %0, m0\n\ts_mov_b32 m0, %3\n\ts_nop 0\n\tglobal_load_lds_dwordx4 %1, %2\n\ts_mov_b32 m0, %0" : "=&s"(keep_) : "v"((voff)[_i]), "s"(sb_), "s"(ldsbase_ + (unsigned)((bufoff) + _i * 8192)) : "memory"); } \
        } else { _Pragma("unroll") for (int _i = 0; _i < 2; ++_i) \
        __builtin_amdgcn_global_load_lds((const unsigned*)((const char*)(gbase) + (voff)[_i]), (PG8_LAS unsigned*)(lds + (bufoff) + ldsw + _i * 8192), 16, 0, 0); } } while (0)
#define PG8_LDA(dst, b, h) do { if constexpr (Epi::FP8) { _Pragma("unroll") for (int m = 0; m < 4; ++m) { const i32x4 lo_ = *(const PG8_LAS i32x4*)(lds + PG8_SA(b, h) + aoff + m * 2048), hi_ = *(const PG8_LAS i32x4*)(lds + PG8_SA(b, h) + aoff + m * 2048 + 1024); F.dst[m] = __builtin_shufflevector(lo_, hi_, 0, 1, 2, 3, 4, 5, 6, 7); } } \
        else { _Pragma("unroll") for (int m = 0; m < 4; ++m) _Pragma("unroll") for (int k = 0; k < 2; ++k) F.dst[m][k] = *(const PG8_LAS bf16x8*)(lds + PG8_SA(b, h) + aoff + m * 2048 + k * 1024); } } while (0)
#define PG8_LDB(dst, b, h) do { if constexpr (Epi::FP8) { _Pragma("unroll") for (int n = 0; n < 2; ++n) { const i32x4 lo_ = *(const PG8_LAS i32x4*)(lds + PG8_SB(b, h) + boff + n * 2048), hi_ = *(const PG8_LAS i32x4*)(lds + PG8_SB(b, h) + boff + n * 2048 + 1024); F.dst[n] = __builtin_shufflevector(lo_, hi_, 0, 1, 2, 3, 4, 5, 6, 7); } } \
        else { _Pragma("unroll") for (int n = 0; n < 2; ++n) _Pragma("unroll") for (int k = 0; k < 2; ++k) F.dst[n][k] = *(const PG8_LAS bf16x8*)(lds + PG8_SB(b, h) + boff + n * 2048 + k * 1024); } } while (0)
#define PG8_MMA(ai, bj, At, Bt) do { __builtin_amdgcn_s_setprio(1); \
        if constexpr (Epi::FP8) {   \
            _Pragma("unroll") for (int m = 0; m < 4; ++m) _Pragma("unroll") for (int n = 0; n < 2; ++n) \
                acc[ai][bj][m][n] = __builtin_amdgcn_mfma_scale_f32_16x16x128_f8f6f4(F.Bt[n], F.At[m], acc[ai][bj][m][n], 0, 0, 0, Epi::SCALE_W, 0, 0x7f7f7f7f); \
        } else { _Pragma("unroll") for (int m = 0; m < 4; ++m) _Pragma("unroll") for (int n = 0; n < 2; ++n) _Pragma("unroll") for (int k = 0; k < 2; ++k) \
            acc[ai][bj][m][n] = __builtin_amdgcn_mfma_f32_16x16x32_f16(__builtin_bit_cast(h16::f16x8_t, F.Bt[n][k]), __builtin_bit_cast(h16::f16x8_t, F.At[m][k]), acc[ai][bj][m][n], 0, 0, 0); } \
        __builtin_amdgcn_s_setprio(0); } while (0)
#define PG8_WAIT_V(n) asm volatile("s_waitcnt vmcnt(" #n ")" ::: "memory")
#define PG8_WAIT_L(n) asm volatile("s_waitcnt lgkmcnt(" #n ")" ::: "memory")
#define PG8_BAR __builtin_amdgcn_s_barrier()
#define PG8_SCHED __builtin_amdgcn_sched_barrier(0)
    Unit cur, nxt; int ui = 0;
    if (!S.next(0, cur)) return;
    Acc acc;
#pragma unroll
    for (int a = 0; a < 2; ++a)
#pragma unroll
        for (int b = 0; b < 2; ++b)
#pragma unroll
            for (int m = 0; m < 4; ++m)
#pragma unroll
                for (int n = 0; n < 2; ++n) acc[a][b][m][n] = (f32x4){0.f, 0.f, 0.f, 0.f};
    const char* cA = S.a_ptr(cur); const char* cB = S.b_ptr(cur);
    if constexpr (Epi::MID_T > 0) E.pre(cur, lds, tid);
    PG8_STAGE(PG8_SB(0, 0), cB, voffB); PG8_STAGE(PG8_SB(0, 1), cB + hstepB, voffB); PG8_STAGE(PG8_SA(0, 0), cA, voffA); PG8_STAGE(PG8_SA(0, 1), cA + hstepA, voffA);
    if (wr == 1) PG8_BAR;
    PG8_WAIT_V(2); PG8_BAR;
    PG8_STAGE(PG8_SB(1, 0), cB + kstep, voffB); PG8_STAGE(PG8_SA(1, 0), cA + kstep, voffA); PG8_STAGE(PG8_SB(1, 1), cB + hstepB + kstep, voffB);
    PG8_WAIT_V(6); PG8_BAR;
    for (;;) {
        const bool has_next = S.next(ui + 1, nxt);
        const char* nA = has_next ? S.a_ptr(nxt) : cA; const char* nB = has_next ? S.b_ptr(nxt) : cB;
        for (int t = 0; t < nt; t += 2) {
            if constexpr (Epi::MID_T > 0) { if (t == Epi::MID_T) E.mid(acc, lds, wr, fr); }
            const bool last = (t == nt - 2);
            Frags<Epi::FP8> F;
            const char* a1 = cA + (size_t)(t + 1) * kstep;
            const char* a2 = last ? nA : cA + (size_t)(t + 2) * kstep; const char* b2 = last ? nB : cB + (size_t)(t + 2) * kstep;
            const char* a3 = a2 + kstep; const char* b3 = b2 + kstep;
            PG8_LDB(B0, 0, 0); PG8_LDB(B1, 0, 1); PG8_SCHED; PG8_LDA(At, 0, 0); PG8_STAGE(PG8_SA(1, 1), a1 + hstepA, voffA);
            PG8_WAIT_V(8); PG8_WAIT_L(0); PG8_BAR; PG8_MMA(0, 0, At, B0); PG8_MMA(0, 1, At, B1); PG8_BAR; PG8_SCHED;
            PG8_LDA(At, 0, 1); PG8_STAGE(PG8_SB(0, 0), b2, voffB); PG8_STAGE(PG8_SB(0, 1), b2 + hstepB, voffB); PG8_STAGE(PG8_SA(0, 0), a2, voffA);
            PG8_WAIT_V(8); PG8_WAIT_L(0); PG8_BAR; PG8_MMA(1, 0, At, B0); PG8_MMA(1, 1, At, B1); PG8_BAR; PG8_SCHED;
            PG8_LDB(B0, 1, 0); PG8_LDB(B1, 1, 1); PG8_SCHED; PG8_LDA(At, 1, 0); PG8_STAGE(PG8_SA(0, 1), a2 + hstepA, voffA);
            PG8_WAIT_V(8); PG8_WAIT_L(0); PG8_BAR; PG8_MMA(0, 0, At, B0); PG8_MMA(0, 1, At, B1); PG8_BAR; PG8_SCHED;
            PG8_LDA(At, 1, 1); PG8_STAGE(PG8_SB(1, 0), b3, voffB); PG8_STAGE(PG8_SB(1, 1), b3 + hstepB, voffB); PG8_STAGE(PG8_SA(1, 0), a3, voffA);
            PG8_WAIT_V(8); PG8_WAIT_L(0); PG8_BAR; PG8_MMA(1, 0, At, B0); PG8_MMA(1, 1, At, B1); PG8_BAR; PG8_SCHED;
        }
        if (wr == 0) PG8_BAR;
        { const int t2_ = olane(); E(acc, cur, wr, wc, t2_ & 15, t2_ >> 4); }
        if (!has_next) break;
#pragma unroll
        for (int a = 0; a < 2; ++a)
#pragma unroll
            for (int b = 0; b < 2; ++b)
#pragma unroll
                for (int m = 0; m < 4; ++m)
#pragma unroll
                    for (int n = 0; n < 2; ++n) acc[a][b][m][n] = (f32x4){0.f, 0.f, 0.f, 0.f};
        cur = nxt; cA = nA; cB = nB; ++ui;
        if (wr == 1) PG8_BAR;
    }
    PG8_WAIT_V(0);
    PG8_BAR;
#undef PG8_SA
#undef PG8_SB
#undef PG8_STAGE
#undef PG8_LDA
#undef PG8_LDB
#undef PG8_MMA
#undef PG8_WAIT_V
#undef PG8_WAIT_L
#undef PG8_BAR
#undef PG8_SCHED
}
}
namespace epi {
#define PG8_LAS __attribute__((address_space(3)))
using pg8::Acc; using pg8::Unit; using pg8::f32x4; using pg8::u32x4; using pg8::bf16_t; using pg8::cvt_pk_bf16; using pg8::fast_silu;
constexpr int HALF = 128;
constexpr float C2 = 0.125f * 1.4426950408889634f;
constexpr float KSC = 0.08838834764831845f;

__device__ __forceinline__ u32x4 pack8(const f32x4 v0, const f32x4 v1) { u32x4 w; w.x = cvt_pk_bf16(v0[0], v0[1]); w.y = cvt_pk_bf16(v0[2], v0[3]); w.z = cvt_pk_bf16(v1[0], v1[1]); w.w = cvt_pk_bf16(v1[2], v1[3]); return w; }

struct EpiInProj {
    static constexpr bool PERM = true; static constexpr int MID_T = 0; static constexpr bool FP8 = false; static constexpr int SCALE_W = 0;
    bf16_t* O; size_t gstride;
    float* KMP;
    const float* ROPE;
    __device__ __forceinline__ void operator()(const Acc& acc, const Unit& u, int wr, int wc, int fr, int fq) const {
        const int grp = u.pn >> 1;
        const int col0 = (u.pn & 1) * 256 + wc * 32 + 8 * fq;
        const int row0 = u.pm * 256 + wr * 64 + fr;
        bf16_t* base = O + (size_t)grp * gstride;
        f32x4 cs[2][2];
#pragma unroll
        for (int bj = 0; bj < 2; ++bj) { cs[bj][0] = (f32x4){0.f, 0.f, 0.f, 0.f}; cs[bj][1] = (f32x4){0.f, 0.f, 0.f, 0.f}; }
#pragma unroll
        for (int ai = 0; ai < 2; ++ai)
#pragma unroll
            for (int m = 0; m < 4; ++m) {
                const int row = row0 + ai * HALF + m * 16;
                bf16_t* rowp = base + (size_t)row * 512 + col0;
                f32x4 t0 = (f32x4){0.f, 0.f, 0.f, 0.f}, t1 = t0;
                if (grp == 3 || grp == 4) { const float* tp = ROPE + ((size_t)(row & 2047) * 64 + 16 * wc + 4 * fq) * 2; t0 = *(const f32x4*)tp; t1 = *(const f32x4*)(tp + 4); }
#pragma unroll
                for (int bj = 0; bj < 2; ++bj) {
                    f32x4 v0 = acc[ai][bj][m][0], v1 = acc[ai][bj][m][1];
                    if (grp == 0) { v0 = v0 * C2; v1 = v1 * C2; }
                    else if (grp == 1) { cs[bj][0] += v0; cs[bj][1] += v1; }
                    else if (grp == 3 || grp == 4) {
                        const float sc = (grp == 4) ? KSC : 1.0f;
                        f32x4 r0, r1;
                        r0[0] = (v0[0] * t0[0] - v0[1] * t0[1]) * sc; r0[1] = (v0[0] * t0[1] + v0[1] * t0[0]) * sc;
                        r0[2] = (v0[2] * t0[2] - v0[3] * t0[3]) * sc; r0[3] = (v0[2] * t0[3] + v0[3] * t0[2]) * sc;
                        r1[0] = (v1[0] * t1[0] - v1[1] * t1[1]) * sc; r1[1] = (v1[0] * t1[1] + v1[1] * t1[0]) * sc;
                        r1[2] = (v1[2] * t1[2] - v1[3] * t1[3]) * sc; r1[3] = (v1[2] * t1[3] + v1[3] * t1[2]) * sc;
                        v0 = r0; v1 = r1;
                    } else if (grp == 6) {
#pragma unroll
                        for (int j = 0; j < 4; ++j) { v0[j] = fast_silu(v0[j]); v1[j] = fast_silu(v1[j]); }
                    }
                    *(u32x4*)(rowp + bj * HALF) = pack8(v0, v1);
                }
            }
        if (grp == 1) {
#pragma unroll
            for (int bj = 0; bj < 2; ++bj)
#pragma unroll
                for (int n = 0; n < 2; ++n) {
                    f32x4 s = cs[bj][n];
#pragma unroll
                    for (int c4 = 0; c4 < 4; ++c4) { float t = s[c4]; t += xl::xor_f<1>(t); t += xl::xor_f<2>(t); t += xl::xor_f<4>(t); t += xl::xor_f<8>(t); s[c4] = t; }
                    if (fr == 0) *(f32x4*)(KMP + (size_t)(u.pm * 2 + wr) * 512 + col0 + bj * HALF + 4 * n) = s;
                }
        }
    }
};

struct EpiOutProj {
    static constexpr bool PERM = false; static constexpr int MID_T = 8; static constexpr bool FP8 = false; static constexpr int SCALE_W = 0;
    const float* xin; float* out; const float* g1;
    const float* assq;
    bool dry;
    static constexpr int RS_OFF = 131072 + 8192;
    __device__ __forceinline__ void pre(const Unit& u, PG8_LAS unsigned char* lds, int tid) const {
        if (tid < 256) { const int row = u.pm * 256 + tid;
            const f32x4 a = *(const f32x4*)(assq + (size_t)row * 8), c = *(const f32x4*)(assq + (size_t)row * 8 + 4);
            const float ss = ((a[0] + a[1]) + (a[2] + a[3])) + ((c[0] + c[1]) + (c[2] + c[3]));
            ((PG8_LAS float*)(lds + RS_OFF))[tid] = 1.0f / sqrtf(ss * (1.0f / 512.0f) + 1e-6f); }
    }
    __device__ __forceinline__ void mid(Acc& acc, PG8_LAS unsigned char* lds, int wr, int fr) const {
        const PG8_LAS float* tab = (const PG8_LAS float*)(lds + RS_OFF) + wr * 64 + fr;
#pragma unroll
        for (int ai = 0; ai < 2; ++ai)
#pragma unroll
            for (int m = 0; m < 4; ++m) {
                const float rs = tab[ai * HALF + m * 16];
#pragma unroll
                for (int bj = 0; bj < 2; ++bj)
#pragma unroll
                    for (int n = 0; n < 2; ++n) acc[ai][bj][m][n] = acc[ai][bj][m][n] * rs;
            }
    }
    __device__ __forceinline__ void operator()(const Acc& acc, const Unit& u, int wr, int wc, int fr, int fq) const {
        const int b = u.pm >> 3;
        const int col0 = u.pn * 256 + wc * 32 + 4 * fq;
        const int row0 = u.pm * 256 + wr * 64 + fr;
        f32x4 gv[2][2];
#pragma unroll
        for (int bj = 0; bj < 2; ++bj)
#pragma unroll
            for (int n = 0; n < 2; ++n) gv[bj][n] = *(const f32x4*)(g1 + (size_t)b * 6144 + col0 + bj * HALF + n * 16);
#pragma unroll
        for (int ai = 0; ai < 2; ++ai)
#pragma unroll
            for (int m = 0; m < 4; ++m) {
                const size_t off = (size_t)(row0 + ai * HALF + m * 16) * 1024 + col0;
#pragma unroll
                for (int bj = 0; bj < 2; ++bj)
#pragma unroll
                    for (int n = 0; n < 2; ++n) { const f32x4 bs = *(const f32x4*)(xin + off + bj * HALF + n * 16); const f32x4 r = bs + gv[bj][n] * acc[ai][bj][m][n]; if (!dry) *(f32x4*)(out + off + bj * HALF + n * 16) = r; else asm volatile("" :: "v"(r)); }
            }
    }
};

struct EpiSwiGLU {
    static constexpr bool PERM = true; static constexpr int MID_T = 0; static constexpr bool FP8 = false; static constexpr int SCALE_W = 0;
    bf16_t* H; int ldh;
    __device__ __forceinline__ void operator()(const Acc& acc, const Unit& u, int wr, int wc, int fr, int fq) const {
        const int col0 = u.pn * 128 + wc * 32 + 8 * fq;
        const int row0 = u.pm * 256 + wr * 64 + fr;
#pragma unroll
        for (int ai = 0; ai < 2; ++ai)
#pragma unroll
            for (int m = 0; m < 4; ++m) {
                const int row = row0 + ai * HALF + m * 16;
                f32x4 v0, v1;
#pragma unroll
                for (int j = 0; j < 4; ++j) { v0[j] = fast_silu(acc[ai][0][m][0][j]) * acc[ai][1][m][0][j]; v1[j] = fast_silu(acc[ai][0][m][1][j]) * acc[ai][1][m][1][j]; }
                *(u32x4*)(H + (size_t)row * ldh + col0) = pack8(v0, v1);
            }
    }
};

struct EpiDown {
    static constexpr bool PERM = false; static constexpr int MID_T = 0; static constexpr bool FP8 = false; static constexpr int SCALE_W = 0;
    float* out; const float* g2; bf16_t* YS; const int* srow; const float* swt; bool moe; bool dry; int* atomf; bool atomic; float* slab; int KS;
    __device__ __forceinline__ void operator()(const Acc& acc, const Unit& u, int wr, int wc, int fr, int fq) const {
        const int col0 = u.pn * 256 + wc * 32 + 4 * fq;
        const int row0 = u.pm * 256 + wr * 64 + fr;
        if (!moe) {
            const int b = u.pm >> 3;
            f32x4 gv[2][2];
#pragma unroll
            for (int bj = 0; bj < 2; ++bj)
#pragma unroll
                for (int n = 0; n < 2; ++n) gv[bj][n] = *(const f32x4*)(g2 + (size_t)b * 6144 + col0 + bj * HALF + n * 16);
#pragma unroll
            for (int ai = 0; ai < 2; ++ai)
#pragma unroll
                for (int m = 0; m < 4; ++m) {
                    const size_t off = (size_t)(row0 + ai * HALF + m * 16) * 1024 + col0;
#pragma unroll
                    for (int bj = 0; bj < 2; ++bj)
#pragma unroll
                        for (int n = 0; n < 2; ++n) { const f32x4 bs = *(const f32x4*)(out + off + bj * HALF + n * 16); const f32x4 r = bs + gv[bj][n] * acc[ai][bj][m][n]; if (!dry) *(f32x4*)(out + off + bj * HALF + n * 16) = r; else asm volatile("" :: "v"(r)); }
                }
        } else if (atomic) {
            float* sl = slab + ((size_t)(u.li * KS + u.kc) * 256) * 256 + (wc * 32 + 4 * fq);
#pragma unroll
            for (int ai = 0; ai < 2; ++ai)
#pragma unroll
                for (int m = 0; m < 4; ++m) {
                    const int rl = ai * HALF + wr * 64 + m * 16 + fr; const int pos = u.pm * 256 + rl;
                    const int sr = srow[pos];
                    if (sr >= 0) { const float w = swt[pos];
                        if (u.kc == 0 && wc == 0 && fq == 0) atomf[sr * 4 + u.pn] = 1 + u.li * 256 + rl;
#pragma unroll
                        for (int bj = 0; bj < 2; ++bj)
#pragma unroll
                            for (int n = 0; n < 2; ++n) *(f32x4*)(sl + (size_t)rl * 256 + bj * HALF + n * 16) = acc[ai][bj][m][n] * w; }
                }
        } else {
#pragma unroll
            for (int ai = 0; ai < 2; ++ai)
#pragma unroll
                for (int m = 0; m < 4; ++m) {
                    const int pos = row0 + ai * HALF + m * 16;
                    const int sr = srow[pos];
                    if (sr >= 0) { const float w = swt[pos]; bf16_t* rowp = YS + (size_t)sr * 1024 + col0;
#pragma unroll
                        for (int bj = 0; bj < 2; ++bj)
#pragma unroll
                            for (int n = 0; n < 2; ++n) { const f32x4 v = acc[ai][bj][m][n] * w; pg8::u32x2 o; o.x = cvt_pk_bf16(v[0], v[1]); o.y = cvt_pk_bf16(v[2], v[3]); if (!dry) *(pg8::u32x2*)(rowp + bj * HALF + n * 16) = o; else asm volatile("" :: "v"(o)); } }
                }
        }
    }
};

__device__ __forceinline__ float clamp448(float v) { return __builtin_fminf(__builtin_fmaxf(v, -448.0f), 448.0f); }
__device__ __forceinline__ unsigned pk4_fp8(float a, float b, float c, float d) {
    int p = 0; p = __builtin_amdgcn_cvt_pk_fp8_f32(clamp448(a), clamp448(b), p, false); p = __builtin_amdgcn_cvt_pk_fp8_f32(clamp448(c), clamp448(d), p, true); return (unsigned)p; }
struct EpiSwiGLU8 {
    static constexpr bool PERM = true; static constexpr int MID_T = 0; static constexpr bool FP8 = true; static constexpr int SCALE_W = 0x7a7a7a7a;
    unsigned char* H; int ldh;
    __device__ __forceinline__ void operator()(const Acc& acc, const Unit& u, int wr, int wc, int fr, int fq) const {
        const int col0 = u.pn * 128 + wc * 32 + 8 * fq;
        const int row0 = u.pm * 256 + wr * 64 + fr;
#pragma unroll
        for (int ai = 0; ai < 2; ++ai)
#pragma unroll
            for (int m = 0; m < 4; ++m) {
                const int row = row0 + ai * HALF + m * 16;
                f32x4 v0, v1;
#pragma unroll
                for (int j = 0; j < 4; ++j) { v0[j] = fast_silu(acc[ai][0][m][0][j]) * acc[ai][1][m][0][j]; v1[j] = fast_silu(acc[ai][0][m][1][j]) * acc[ai][1][m][1][j]; }
                pg8::u32x2 w; w.x = pk4_fp8(v0[0], v0[1], v0[2], v0[3]); w.y = pk4_fp8(v1[0], v1[1], v1[2], v1[3]);
                *(pg8::u32x2*)(H + (size_t)row * ldh + col0) = w;
            }
    }
};
struct EpiDownDense8 {
    static constexpr bool PERM = false; static constexpr int MID_T = 0; static constexpr bool FP8 = true; static constexpr int SCALE_W = 0x79797979;
    float* out; const float* g2; bool dry;
    __device__ __forceinline__ void operator()(const Acc& acc, const Unit& u, int wr, int wc, int fr, int fq) const {
        const int col0 = u.pn * 256 + wc * 32 + 4 * fq;
        const int row0 = u.pm * 256 + wr * 64 + fr;
        const int b = u.pm >> 3;
        f32x4 gv[2][2];
#pragma unroll
        for (int bj = 0; bj < 2; ++bj)
#pragma unroll
            for (int n = 0; n < 2; ++n) gv[bj][n] = *(const f32x4*)(g2 + (size_t)b * 6144 + col0 + bj * HALF + n * 16);
#pragma unroll
        for (int ai = 0; ai < 2; ++ai)
#pragma unroll
            for (int m = 0; m < 4; ++m) {
                const size_t off = (size_t)(row0 + ai * HALF + m * 16) * 1024 + col0;
#pragma unroll
                for (int bj = 0; bj < 2; ++bj)
#pragma unroll
                    for (int n = 0; n < 2; ++n) { const f32x4 bs = *(const f32x4*)(out + off + bj * HALF + n * 16); const f32x4 r = bs + gv[bj][n] * acc[ai][bj][m][n]; if (!dry) *(f32x4*)(out + off + bj * HALF + n * 16) = r; else asm volatile("" :: "v"(r)); }
            }
    }
};
struct EpiDownMoe8 {
    static constexpr bool PERM = false; static constexpr int MID_T = 0; static constexpr bool FP8 = true; static constexpr int SCALE_W = 0x79797979;
    bf16_t* YS; const int* srow; const float* swt;
    __device__ __forceinline__ void operator()(const Acc& acc, const Unit& u, int wr, int wc, int fr, int fq) const {
        const int col0 = u.pn * 256 + wc * 32 + 4 * fq;
        const int row0 = u.pm * 256 + wr * 64 + fr;
#pragma unroll
        for (int ai = 0; ai < 2; ++ai)
#pragma unroll
            for (int m = 0; m < 4; ++m) {
                const int pos = row0 + ai * HALF + m * 16;
                const int sr = srow[pos];
                if (sr >= 0) { const float w = swt[pos]; bf16_t* rowp = YS + (size_t)sr * 1024 + col0;
#pragma unroll
                    for (int bj = 0; bj < 2; ++bj)
#pragma unroll
                        for (int n = 0; n < 2; ++n) { const f32x4 v = acc[ai][bj][m][n] * w; pg8::u32x2 o; o.x = cvt_pk_bf16(v[0], v[1]); o.y = cvt_pk_bf16(v[2], v[3]); *(pg8::u32x2*)(rowp + bj * HALF + n * 16) = o; } }
            }
    }
};
struct EpiDownMoe8Slab {
    static constexpr bool PERM = false; static constexpr int MID_T = 0; static constexpr bool FP8 = true; static constexpr int SCALE_W = 0x79797979;
    const int* srow; const float* swt; int* atomf; float* slab; int KS;
    __device__ __forceinline__ void operator()(const Acc& acc, const Unit& u, int wr, int wc, int fr, int fq) const {
        float* sl = slab + ((size_t)(u.li * KS + u.kc) * 256) * 256 + (wc * 32 + 4 * fq);
#pragma unroll
        for (int ai = 0; ai < 2; ++ai)
#pragma unroll
            for (int m = 0; m < 4; ++m) {
                const int rl = ai * HALF + wr * 64 + m * 16 + fr; const int pos = u.pm * 256 + rl;
                const int sr = srow[pos];
                if (sr >= 0) { const float w = swt[pos];
                    if (u.kc == 0 && wc == 0 && fq == 0) atomf[sr * 4 + u.pn] = 1 + u.li * 256 + rl;
#pragma unroll
                    for (int bj = 0; bj < 2; ++bj)
#pragma unroll
                        for (int n = 0; n < 2; ++n) *(f32x4*)(sl + (size_t)rl * 256 + bj * HALF + n * 16) = acc[ai][bj][m][n] * w; }
            }
    }
};
}
namespace fa {
#define FA_LAS __attribute__((address_space(3)))
typedef unsigned short bf16_t;
typedef short bf16x8 __attribute__((ext_vector_type(8)));
typedef short s16x4 __attribute__((ext_vector_type(4)));
typedef float f32x16 __attribute__((ext_vector_type(16)));
typedef float f32x4 __attribute__((ext_vector_type(4)));
typedef unsigned u32x4 __attribute__((ext_vector_type(4)));
typedef float f32x2_t __attribute__((ext_vector_type(2))); typedef __bf16 bf16x2_t __attribute__((ext_vector_type(2)));
constexpr int L_WSF = 131072 + 1024, L_KM = L_WSF + 2048;
constexpr float NEG = -1.0e30f;
__device__ __forceinline__ int crow(int r, int hi) { return (r & 3) + 8 * (r >> 2) + 4 * hi; }
__device__ __forceinline__ void glds16(const void* gsrc, unsigned lds_dst) { unsigned keep;
    asm volatile("s_mov_b32 %0, m0\n\ts_mov_b32 m0, %2\n\ts_nop 0\n\tglobal_load_lds_dwordx4 %1, off\n\ts_mov_b32 m0, %0" : "=&s"(keep) : "v"(gsrc), "s"(lds_dst) : "memory"); }
__device__ __forceinline__ unsigned cvtpk_s(float lo, float hi) { return h16::pk(lo, hi); }
__device__ __forceinline__ float bf2f(short s) { return h16::one((unsigned short)s); }
typedef short v4i16_t __attribute__((ext_vector_type(4)));
__device__ __forceinline__ s16x4 vtr(FA_LAS const unsigned char* p) { return __builtin_bit_cast(s16x4, __builtin_amdgcn_ds_read_tr16_b64_v4i16((FA_LAS v4i16_t*)p)); }
#define FA_WAIT_BAR() asm volatile("s_waitcnt vmcnt(0) lgkmcnt(0)\n\ts_barrier" ::: "memory")
#define FA_LBAR() asm volatile("s_waitcnt lgkmcnt(0)\n\ts_barrier" ::: "memory")

struct Tensors {
    const bf16_t* Q; const bf16_t* K; const bf16_t* V;
    bf16_t* CAT;
    float* ASSQ;
    const float* KMP;
    const bf16_t* GR;
    const float* ret_g;
    const float* KVM;
};

template <bool RET>
__device__ __forceinline__ void attn_unit(const int wv, int b, int h, int qblk, const Tensors& T, FA_LAS unsigned char* shm) {
    constexpr int NS = RET ? 3 : 4, DIST = NS - 1;
    constexpr int DH = RET ? 128 : 64, ND0 = DH / 16, NDB = DH / 32, NPC = DH / 64, SLOT = 64 * DH * 2, L_K = 0, L_V = NS * SLOT, PER = 2 * NPC, L_R = 98304;
    int tid_ = otid(wv);
    const int tid = tid_, lane = tid & 63, r32 = lane & 31, hi = lane >> 5; const int wid = __builtin_amdgcn_readfirstlane(tid >> 6);
    const size_t rowbase = (size_t)b * 2048; const int q0 = qblk * 256;
    const unsigned lds0 = (unsigned)(unsigned long)shm;
    FA_LAS float* wsf = (FA_LAS float*)(shm + L_WSF) + wid * 64;
    FA_LAS float* KM = (FA_LAS float*)(shm + L_KM);
    const bf16_t* Kh = T.K + rowbase * 512 + h * DH; const bf16_t* Vh = T.V + rowbase * 512 + h * DH;
    const int NT = RET ? 4 : 4 * (qblk + 1);
#define FA_KV0(i) ((((i) < 4) ? qblk : (qblk - 1 - (((i) - 4) >> 2))) * 256 + ((i) & 3) * 64)
#define FA_DMA(i) do { const int kv0_ = FA_KV0(i); const unsigned so_ = (unsigned)(((i) % NS) * SLOT); \
        _Pragma("unroll") for (int pp = 0; pp < NPC; ++pp) { const int p = wid + 8 * pp; \
            glds16(Kh + (size_t)(kv0_ + lane) * 512 + p * 8, (unsigned)__builtin_amdgcn_readfirstlane(lds0 + L_K + so_ + p * 1024)); } \
        _Pragma("unroll") for (int pp = 0; pp < NPC; ++pp) { const int p = wid + 8 * pp; \
            glds16(Vh + (size_t)(kv0_ + 16 * (p & 3) + (lane >> 2)) * 512 + (p >> 2) * 32 + (lane & 3) * 8, (unsigned)__builtin_amdgcn_readfirstlane(lds0 + L_V + so_ + p * 1024)); } } while (0)
    FA_DMA(0); if (NT > 1) FA_DMA(1); if (DIST > 2 && NT > 2) FA_DMA(2);
    const bf16_t* Qw = T.Q + (rowbase + q0 + wid * 32 + r32) * 512 + h * DH;
    bf16x8 qr[ND0];
#pragma unroll
    for (int d0 = 0; d0 < ND0; ++d0) qr[d0] = *(const bf16x8*)(Qw + d0 * 16 + hi * 8);
    unsigned selmask = 0xffu;
    float cfac[16]; float lg2 = 0.f;
    if (!RET) {
        { const int j = tid >> 6, d = tid & 63; const float* kp = T.KMP + ((size_t)(b * 8 + j) * 2) * 512 + h * 64 + d; KM[tid] = kp[0] + kp[512]; }
        FA_LBAR();
        float g[8];
#pragma unroll
        for (int j = 0; j < 8; ++j) g[j] = 0.f;
#pragma unroll
        for (int d0 = 0; d0 < ND0; ++d0)
#pragma unroll
            for (int jj = 0; jj < 8; ++jj) { const float qv = bf2f(qr[d0][jj]); const int d = 16 * d0 + 8 * hi + jj;
#pragma unroll
                for (int j = 0; j < 8; ++j) g[j] += qv * KM[j * 64 + d]; }
#pragma unroll
        for (int j = 0; j < 8; ++j) g[j] = xl::add32(g[j]);
        selmask = 0u;
#pragma unroll
        for (int j = 0; j < 8; ++j) { int rank = 0;
#pragma unroll
            for (int mm = 0; mm < 8; ++mm) rank += (mm < qblk && (g[mm] > g[j] || (g[mm] == g[j] && mm < j))) ? 1 : 0;
            if (j < qblk && rank < 3) selmask |= 1u << j; }
    } else {
        lg2 = log2f(1.0f - exp2f(-5.0f - (float)h));
#pragma unroll
        for (int r = 0; r < 16; ++r) cfac[r] = exp2f(-lg2 * (float)((r & 3) + 8 * (r >> 2)));
    }
    f32x16 o[NDB];
#pragma unroll
    for (int db = 0; db < NDB; ++db) o[db] = f32x16{};
    float mhat = 0.f, lrow = 0.f; f32x16 negm = f32x16{}; constexpr float THR = 8.0f;
    if (RET && qblk > 0) {
        const float* kvb = T.KVM + ((size_t)(b * 4 + h) * 8) * 16384;
        const float g256 = exp2f(lg2 * 256.0f);
#pragma unroll 2
        for (int it = 0; it < 8; ++it) { const int idx4 = tid + 512 * it; const int d = idx4 >> 5, e0 = (idx4 & 31) * 4;
            f32x4 acc4 = (f32x4){0.f, 0.f, 0.f, 0.f};
            for (int m = 0; m < qblk; ++m) acc4 = acc4 * g256 + *(const f32x4*)(kvb + (size_t)m * 16384 + d * 128 + e0);
            const int rp = (d & ~12) | ((d & 8) >> 1) | ((d & 4) << 1);
            typedef unsigned u32x2_ __attribute__((ext_vector_type(2)));
            u32x2_ w; w.x = cvtpk_s(acc4[0], acc4[1]); w.y = cvtpk_s(acc4[2], acc4[3]);
            *(FA_LAS u32x2_*)(shm + L_R + (e0 >> 5) * 8192 + rp * 64 + (e0 & 31) * 2) = w; }
        FA_LBAR();
        { FA_LAS const unsigned char* rb = shm + L_R + ((lane >> 4) & 1) * 32 + (lane & 3) * 8 + (4 * hi + ((lane & 15) >> 2)) * 64;
#pragma unroll
          for (int db = 0; db < NDB; ++db)
#pragma unroll
              for (int d0 = 0; d0 < ND0; ++d0) { const s16x4 lo = vtr(rb + db * 8192 + d0 * 1024), hh = vtr(rb + db * 8192 + d0 * 1024 + 512);
                  const bf16x8 rf = (bf16x8){lo[0], lo[1], lo[2], lo[3], hh[0], hh[1], hh[2], hh[3]};
                  o[db] = __builtin_amdgcn_mfma_f32_32x32x16_f16(__builtin_bit_cast(h16::f16x8_t, qr[d0]), __builtin_bit_cast(h16::f16x8_t, rf), o[db], 0, 0, 0); } }
#pragma unroll
        for (int r = 0; r < 16; ++r) { const float rd = exp2f(lg2 * (float)(wid * 32 + crow(r, hi) + 1));
#pragma unroll
            for (int db = 0; db < NDB; ++db) o[db][r] *= rd; }
    }
    const int qrel = wid * 32 + r32;
    for (int i = 0; i < NT; ++i) {
        { const int ahead = (NT - 1 - i) < (DIST - 1) ? (NT - 1 - i) : (DIST - 1);
          if (ahead == 2) { if (PER == 2) asm volatile("s_waitcnt vmcnt(4) lgkmcnt(0)\n\ts_barrier" ::: "memory"); else asm volatile("s_waitcnt vmcnt(8) lgkmcnt(0)\n\ts_barrier" ::: "memory"); }
          else if (ahead == 1) { if (PER == 2) asm volatile("s_waitcnt vmcnt(2) lgkmcnt(0)\n\ts_barrier" ::: "memory"); else asm volatile("s_waitcnt vmcnt(4) lgkmcnt(0)\n\ts_barrier" ::: "memory"); }
          else FA_WAIT_BAR(); }
        if (i + DIST < NT) FA_DMA(i + DIST);
        const bool diag = i < 4; const int t = i & 3; const int j = diag ? qblk : (qblk - 1 - ((i - 4) >> 2));
        const bool mysel = RET ? true : (((selmask >> j) & 1u) != 0u);
        const bool skip = diag ? (64 * t > 32 * wid + 31) : (RET ? false : !__any(mysel));
        if (skip) continue;
        const unsigned so = (unsigned)((i % NS) * SLOT);
        f32x16 p0 = RET ? f32x16{} : negm, p1 = p0;
        { FA_LAS const unsigned char* kb = shm + L_K + so + hi * 1024 + r32 * 16;
#pragma unroll
          for (int d0 = 0; d0 < ND0; ++d0) { const bf16x8 b0 = *(FA_LAS const bf16x8*)(kb + d0 * 2048); const bf16x8 b1 = *(FA_LAS const bf16x8*)(kb + d0 * 2048 + 512);
              p0 = __builtin_amdgcn_mfma_f32_32x32x16_f16(__builtin_bit_cast(h16::f16x8_t, b0), __builtin_bit_cast(h16::f16x8_t, qr[d0]), p0, 0, 0, 0); p1 = __builtin_amdgcn_mfma_f32_32x32x16_f16(__builtin_bit_cast(h16::f16x8_t, b1), __builtin_bit_cast(h16::f16x8_t, qr[d0]), p1, 0, 0, 0); } }
        if (RET) {
            const int qpos = q0 + qrel; const int kv0 = j * 256 + t * 64;
            const float base = (float)(qpos - kv0 - 4 * hi);
            const float rf0 = exp2f(lg2 * base), rf1 = exp2f(lg2 * (base - 32.0f));
#pragma unroll
            for (int r = 0; r < 16; ++r) { p0[r] *= rf0 * cfac[r]; p1[r] *= rf1 * cfac[r]; }
            if (diag) { const int kb_ = 64 * t + 4 * hi;
#pragma unroll
                for (int r = 0; r < 16; ++r) { const int kv = kb_ + (r & 3) + 8 * (r >> 2); if (kv > qrel) p0[r] = 0.f; if (kv + 32 > qrel) p1[r] = 0.f; } }
        } else {
            if (diag) { const int kb_ = 64 * t + 4 * hi;
#pragma unroll
                for (int r = 0; r < 16; ++r) { const int kv = kb_ + (r & 3) + 8 * (r >> 2); if (kv > qrel) p0[r] = NEG; if (kv + 32 > qrel) p1[r] = NEG; } }
            else if (!mysel) {
#pragma unroll
                for (int r = 0; r < 16; ++r) { p0[r] = NEG; p1[r] = NEG; } }
            float rm = fmaxf(fmaxf(p0[0], p1[0]), p0[1]);
#pragma unroll
            for (int r = 1; r < 16; ++r) { rm = fmaxf(fmaxf(rm, p1[r]), (r < 15) ? p0[r + 1] : p1[r]); }
            rm = xl::max32(rm);
            if (__any(rm > THR)) {
                const float dl = fmaxf(rm, 0.f);
                mhat += dl;
#pragma unroll
                for (int r = 0; r < 16; ++r) { p0[r] -= dl; p1[r] -= dl; }
#pragma unroll
                for (int r = 0; r < 16; ++r) negm[r] = -mhat;
                const float f = __builtin_amdgcn_exp2f(-dl); lrow *= f;
                asm volatile("" ::: "memory");
                if (hi == 0) wsf[r32] = f;
                asm volatile("s_waitcnt lgkmcnt(0)" ::: "memory");
#pragma unroll
                for (int r = 0; r < 16; ++r) { const float fr_ = wsf[crow(r, hi)];
#pragma unroll
                    for (int db = 0; db < NDB; ++db) o[db][r] *= fr_; }
                asm volatile("s_waitcnt lgkmcnt(0)" ::: "memory");
            }
            float s = 0.f;
#pragma unroll
            for (int r = 0; r < 16; ++r) { p0[r] = __builtin_amdgcn_exp2f(p0[r]); p1[r] = __builtin_amdgcn_exp2f(p1[r]); s += p0[r] + p1[r]; }
            lrow += s;
        }
        bf16x8 pa[4];
        { u32x4 w;
          w.x = cvtpk_s(p0[0], p0[1]); w.y = cvtpk_s(p0[2], p0[3]); w.z = cvtpk_s(p0[4], p0[5]); w.w = cvtpk_s(p0[6], p0[7]); pa[0] = __builtin_bit_cast(bf16x8, w);
          w.x = cvtpk_s(p0[8], p0[9]); w.y = cvtpk_s(p0[10], p0[11]); w.z = cvtpk_s(p0[12], p0[13]); w.w = cvtpk_s(p0[14], p0[15]); pa[1] = __builtin_bit_cast(bf16x8, w);
          w.x = cvtpk_s(p1[0], p1[1]); w.y = cvtpk_s(p1[2], p1[3]); w.z = cvtpk_s(p1[4], p1[5]); w.w = cvtpk_s(p1[6], p1[7]); pa[2] = __builtin_bit_cast(bf16x8, w);
          w.x = cvtpk_s(p1[8], p1[9]); w.y = cvtpk_s(p1[10], p1[11]); w.z = cvtpk_s(p1[12], p1[13]); w.w = cvtpk_s(p1[14], p1[15]); pa[3] = __builtin_bit_cast(bf16x8, w); }
        { FA_LAS const unsigned char* vb = shm + L_V + so + ((lane >> 4) & 1) * 32 + (lane & 3) * 8 + (4 * hi + ((lane & 15) >> 2)) * 64;
#pragma unroll
          for (int db = 0; db < NDB; ++db)
#pragma unroll
              for (int ks = 0; ks < 4; ++ks) { const s16x4 lo = vtr(vb + db * 4096 + ks * 1024), hh = vtr(vb + db * 4096 + ks * 1024 + 512);
                  const bf16x8 vf = (bf16x8){lo[0], lo[1], lo[2], lo[3], hh[0], hh[1], hh[2], hh[3]};
                  o[db] = __builtin_amdgcn_mfma_f32_32x32x16_f16(__builtin_bit_cast(h16::f16x8_t, pa[ks]), __builtin_bit_cast(h16::f16x8_t, vf), o[db], 0, 0, 0); } }
    }
    float rli[16];
    if (!RET) {
        const float l = xl::add32(lrow);
        asm volatile("" ::: "memory");
        if (hi == 0) wsf[32 + r32] = 1.0f / l;
        asm volatile("s_waitcnt lgkmcnt(0)" ::: "memory");
#pragma unroll
        for (int r = 0; r < 16; ++r) rli[r] = wsf[32 + crow(r, hi)];
    } else {
#pragma unroll
        for (int r = 0; r < 16; ++r) rli[r] = 1.0f;
    }
    FA_LBAR();
    FA_LAS bf16_t* stg = (FA_LAS bf16_t*)(shm + wid * 8192);
#pragma unroll
    for (int r = 0; r < 16; ++r) { const int orow = crow(r, hi);
#pragma unroll
        for (int db = 0; db < NDB; ++db) { const unsigned pk = cvtpk_s(o[db][r] * rli[r], 0.f); stg[orow * DH + db * 32 + r32] = (bf16_t)(pk & 0xffffu); } }
    asm volatile("s_waitcnt lgkmcnt(0)" ::: "memory");
    const size_t tok0 = rowbase + q0 + wid * 32;
    if (!RET) {
#pragma unroll
        for (int i = 0; i < 4; ++i) { const int row = i * 8 + (lane >> 3), ch = lane & 7;
            const u32x4 v = *(FA_LAS const u32x4*)(stg + row * 64 + ch * 8);
            float ss = 0.f;
#pragma unroll
            for (int k = 0; k < 4; ++k) { const float a = h16::lo(v[k]), c = h16::hi(v[k]); ss += a * a + c * c; }
            ss += xl::xor_f<1>(ss); ss += xl::xor_f<2>(ss); ss += xl::xor_f<4>(ss);
            if (ch == 0) T.ASSQ[(tok0 + row) * 8 + h] = ss;
            *(u32x4*)(T.CAT + (tok0 + row) * 1024 + h * 64 + ch * 8) = v; }
    } else {
#pragma unroll
        for (int i = 0; i < 8; ++i) { const int row = i * 4 + (lane >> 4), ch = lane & 15;
            const u32x4 v = *(FA_LAS const u32x4*)(stg + row * 128 + ch * 8);
            float x[8];
#pragma unroll
            for (int k = 0; k < 4; ++k) { x[2 * k] = h16::lo(v[k]); x[2 * k + 1] = h16::hi(v[k]); }
            float ss = 0.f;
#pragma unroll
            for (int k = 0; k < 8; ++k) ss += x[k] * x[k];
            ss += xl::xor_f<1>(ss); ss += xl::xor_f<2>(ss); ss += xl::xor_f<4>(ss); ss += xl::xor_f<8>(ss);
            const float rs = 1.0f / sqrtf(ss * (1.0f / 128.0f) + 1e-6f);
            const u32x4 gv = *(const u32x4*)(T.GR + (tok0 + row) * 512 + h * 128 + ch * 8);
            const f32x4 w0 = *(const f32x4*)(T.ret_g + h * 128 + ch * 8), w1 = *(const f32x4*)(T.ret_g + h * 128 + ch * 8 + 4);
            const float wg[8] = {w0[0], w0[1], w0[2], w0[3], w1[0], w1[1], w1[2], w1[3]};
            float y[8];
#pragma unroll
            for (int k = 0; k < 4; ++k) { const float g0 = h16::lo(gv[k]), g1 = h16::hi(gv[k]);
                y[2 * k] = x[2 * k] * rs * wg[2 * k] * g0; y[2 * k + 1] = x[2 * k + 1] * rs * wg[2 * k + 1] * g1; }
            u32x4 ov; ov.x = cvtpk_s(y[0], y[1]); ov.y = cvtpk_s(y[2], y[3]); ov.z = cvtpk_s(y[4], y[5]); ov.w = cvtpk_s(y[6], y[7]);
            *(u32x4*)(T.CAT + (tok0 + row) * 1024 + 512 + h * 128 + ch * 8) = ov; }
    }
    FA_LBAR();
#undef FA_KV0
#undef FA_DMA
}

__device__ __forceinline__ void kv_unit(const int wv, int b, int h, int m, const bf16_t* Kg, const bf16_t* Vg, float* KVM, FA_LAS unsigned char* shm) {
    constexpr int SLOT = 16384, L_K = 0, L_V = 4 * SLOT;
    int tid_ = otid(wv);
    const int tid = tid_, lane = tid & 63, r32 = lane & 31, hi = lane >> 5; const int wid = __builtin_amdgcn_readfirstlane(tid >> 6);
    const int dg = wid >> 1, eh = wid & 1;
    const size_t rowbase = (size_t)b * 2048 + (size_t)m * 256;
    const unsigned lds0 = (unsigned)(unsigned long)shm;
    const bf16_t* Kh = Kg + rowbase * 512 + h * 128; const bf16_t* Vh = Vg + rowbase * 512 + h * 128;
#pragma unroll
    for (int t = 0; t < 4; ++t)
#pragma unroll
        for (int pp = 0; pp < 2; ++pp) { const int p = wid + 8 * pp; const size_t off = (size_t)(64 * t + 16 * (p & 3) + (lane >> 2)) * 512 + (p >> 2) * 32 + (lane & 3) * 8;
            glds16(Kh + off, (unsigned)__builtin_amdgcn_readfirstlane(lds0 + L_K + t * SLOT + p * 1024));
            glds16(Vh + off, (unsigned)__builtin_amdgcn_readfirstlane(lds0 + L_V + t * SLOT + p * 1024)); }
    const float lg2 = log2f(1.0f - exp2f(-5.0f - (float)h));
    const float g64 = exp2f(lg2 * 64.0f);
    h16::f16x8_t fd[4];
#pragma unroll
    for (int ks = 0; ks < 4; ++ks)
#pragma unroll
        for (int j = 0; j < 8; ++j) fd[ks][j] = (_Float16)exp2f(lg2 * (float)(63 - (16 * ks + 8 * (j >> 2) + 4 * hi + (j & 3))));
    f32x16 acc[2]; acc[0] = f32x16{}; acc[1] = f32x16{};
    FA_WAIT_BAR();
    const int lb = ((lane >> 4) & 1) * 32 + (lane & 3) * 8 + (4 * hi + ((lane & 15) >> 2)) * 64;
#pragma unroll
    for (int t = 0; t < 4; ++t) {
        if (t > 0) {
#pragma unroll
            for (int r = 0; r < 16; ++r) { acc[0][r] *= g64; acc[1][r] *= g64; } }
        FA_LAS const unsigned char* kb = shm + L_K + t * SLOT + dg * 4096 + lb; FA_LAS const unsigned char* vb = shm + L_V + t * SLOT + (2 * eh) * 4096 + lb;
#pragma unroll
        for (int ks = 0; ks < 4; ++ks) { const s16x4 klo = vtr(kb + ks * 1024), khi = vtr(kb + ks * 1024 + 512);
            const h16::f16x8_t kf = __builtin_bit_cast(h16::f16x8_t, (bf16x8){klo[0], klo[1], klo[2], klo[3], khi[0], khi[1], khi[2], khi[3]});
#pragma unroll
            for (int eb = 0; eb < 2; ++eb) { const s16x4 vlo = vtr(vb + eb * 4096 + ks * 1024), vhi = vtr(vb + eb * 4096 + ks * 1024 + 512);
                const h16::f16x8_t vf = __builtin_bit_cast(h16::f16x8_t, (bf16x8){vlo[0], vlo[1], vlo[2], vlo[3], vhi[0], vhi[1], vhi[2], vhi[3]}) * fd[ks];
                acc[eb] = __builtin_amdgcn_mfma_f32_32x32x16_f16(kf, vf, acc[eb], 0, 0, 0); } }
    }
    float* op = KVM + ((size_t)(b * 4 + h) * 8 + m) * 16384;
#pragma unroll
    for (int eb = 0; eb < 2; ++eb)
#pragma unroll
        for (int r = 0; r < 16; ++r) op[(size_t)(32 * dg + crow(r, hi)) * 128 + 64 * eh + 32 * eb + r32] = acc[eb][r];
    FA_LBAR();
}
}
namespace mk {
#define GAS __attribute__((address_space(1)))
#define LAS __attribute__((address_space(3)))
typedef unsigned short bf16;
typedef unsigned v4u __attribute__((ext_vector_type(4)));
typedef unsigned v2u __attribute__((ext_vector_type(2)));
typedef float f32x4 __attribute__((ext_vector_type(4)));
typedef int i32x4 __attribute__((ext_vector_type(4)));
typedef GAS unsigned gu32;
#define RLX_AGENT __ATOMIC_RELAXED, __HIP_MEMORY_SCOPE_AGENT
#define LDS_WAIT() asm volatile("s_waitcnt lgkmcnt(0)" ::: "memory")
#define VM_WAIT() asm volatile("s_waitcnt vmcnt(0)" ::: "memory")
constexpr int NWAVES = 8;
constexpr size_t MiB = 1u << 20, KiB = 1u << 10;
constexpr size_t WS_CTL = 0;
constexpr size_t CTL_ZERO_BYTES = 64 * KiB;
constexpr size_t WS_MOD = 64 * KiB;
constexpr size_t WS_KMP = 512 * KiB;
constexpr size_t WS_EIDX = 768 * KiB;
constexpr size_t WS_EW = 896 * KiB;
constexpr size_t WS_ROPE = 1 * MiB;
constexpr size_t WS_ASSQ = 2 * MiB;
constexpr size_t WS_SROW = 2 * MiB + 512 * KiB;
constexpr size_t WS_SWT = 2 * MiB + 768 * KiB;
constexpr size_t WS_WCNT = 3 * MiB;
constexpr size_t WS_SEG = 3 * MiB + 64 * KiB;
constexpr size_t WS_ATOMF = 3 * MiB + 128 * KiB;
constexpr size_t WS_SEGD = 3 * MiB + 65 * KiB;
constexpr size_t WS_MGU = 8 * MiB;
constexpr size_t WS_SLAB = 8 * MiB;
constexpr size_t WS_MDN = 96 * MiB;
constexpr size_t WS_XA = 140 * MiB;
constexpr size_t WS_XS = 172 * MiB;
constexpr size_t WS_KVM = 172 * MiB;
constexpr size_t WS_YS = 140 * MiB;
constexpr size_t WS_WIN = 240 * MiB;
constexpr size_t WS_WOUT = 254 * MiB;
constexpr size_t WS_FGU = 258 * MiB;
constexpr size_t WS_FDN = 269 * MiB;
constexpr size_t WS_QKV = 275 * MiB;
constexpr size_t WS_CAT = 387 * MiB;
constexpr size_t WS_HD = 275 * MiB;
constexpr size_t WS_HM = 240 * MiB;
constexpr size_t WS_END = 428 * MiB;
constexpr int XS_ROWS = 34816;
constexpr int CW_BAR = 1024;

constexpr int RING_BYTES = 131072, LDSCTL_OFF = RING_BYTES, MISC_OFF = LDSCTL_OFF + 320, LDS_BYTES = 147456;

#define XB_TMO      128
#define XB_XCNT(j)  (256  + 64 * (j))
#define XB_XSUB(j)  (1280 + 64 * (j))
#define XB_XGEN(j)  (2304 + 64 * (j))
#define XB_TOP      3328
#define XB_TOPGEN   3392
#define XCD_BAR_WORDS 3456
#define XB_SPIN_CAP (1u << 18)
__device__ __forceinline__ unsigned xb_ld(unsigned* p)              { return __hip_atomic_load(p, __ATOMIC_RELAXED, __HIP_MEMORY_SCOPE_AGENT); }
__device__ __forceinline__ unsigned xb_add(unsigned* p, unsigned v) { return __hip_atomic_fetch_add(p, v, __ATOMIC_RELAXED, __HIP_MEMORY_SCOPE_AGENT); }
__device__ __forceinline__ unsigned xb_xcc_id() { return (unsigned)__builtin_amdgcn_s_getreg((3 << 11) | 20) & 0xFu; }
#define XB_SPIN(cond, bar) do { unsigned _sp = 0; while (cond) { __builtin_amdgcn_s_sleep(1); \
    if ((++_sp & 255u) == 0u) { if (xb_ld(&(bar)[XB_TMO])) break; if (_sp > XB_SPIN_CAP) { atomicAdd(&(bar)[XB_TMO], 1u); break; } } } } while (0)
struct XcdBarrier { unsigned* bar; unsigned x; volatile LAS unsigned* st; int wv; };
__device__ __forceinline__ XcdBarrier xcd_barrier_post(unsigned* bar, volatile LAS unsigned* st, int wv) {
    XcdBarrier b; b.bar = bar; b.x = xb_xcc_id(); b.st = st; b.wv = wv;
    if (otid(wv) == 0) (void)xb_add(&bar[XB_XCNT(b.x)], 1u);
    return b;
}
__device__ __forceinline__ void xcd_barrier_complete(unsigned* bar, unsigned x, unsigned& nloc, unsigned& nx) {
    const unsigned G = gridDim.x * gridDim.y * gridDim.z;
    unsigned sum, cnt, mine, sp = 0u;
    for (;;) {
        sum = 0u; cnt = 0u; mine = 0u;
#pragma unroll
        for (unsigned j = 0; j < 16; ++j) { const unsigned c = xb_ld(&bar[XB_XCNT(j)]); sum += c; cnt += (c > 0u) ? 1u : 0u; mine = (j == x) ? c : mine; }
        if (sum == G) break;
        __builtin_amdgcn_s_sleep(1);
        if ((++sp & 255u) == 0u) { if (xb_ld(&bar[XB_TMO])) break; if (sp > XB_SPIN_CAP) { atomicAdd(&bar[XB_TMO], 1u); break; } }
    }
    nloc = mine > 0u ? mine : 1u; nx = cnt > 0u ? cnt : 1u;
}
__device__ __forceinline__ void xcd_barrier(const XcdBarrier& b) {
    asm volatile("s_waitcnt vmcnt(0)" ::: "memory");
    __syncthreads();
    if (otid(b.wv) == 0) {
        unsigned* bar = b.bar;
        __builtin_amdgcn_s_waitcnt(0);
        unsigned nloc = b.st[0], nx = b.st[1];
        if (nloc == 0u) { xcd_barrier_complete(bar, b.x, nloc, nx); b.st[0] = nloc; b.st[1] = nx; }
        const unsigned old = xb_add(&bar[XB_XSUB(b.x)], 1u);
        const unsigned gen = old / nloc;
        if (old + 1u == (gen + 1u) * nloc) {
            __builtin_amdgcn_fence(__ATOMIC_RELEASE, "agent");
            asm volatile("s_waitcnt vmcnt(0)" ::: "memory");
            const unsigned og = xb_add(&bar[XB_TOP], 1u);
            const unsigned tg = og / nx;
            if (og + 1u == (tg + 1u) * nx) xb_add(&bar[XB_TOPGEN], 1u);
            else XB_SPIN(xb_ld(&bar[XB_TOPGEN]) == tg, bar);
            __builtin_amdgcn_fence(__ATOMIC_ACQUIRE, "agent");
            xb_add(&bar[XB_XGEN(b.x)], 1u);
            asm volatile("s_waitcnt vmcnt(0)" ::: "memory");
        } else {
            XB_SPIN(xb_ld(&bar[XB_XGEN(b.x)]) == gen, bar);
            __builtin_amdgcn_fence(__ATOMIC_ACQUIRE, "agent");
            asm volatile("s_waitcnt vmcnt(0)" ::: "memory");
        }
    }
    __syncthreads();
}

__device__ __forceinline__ unsigned f2bf(float f) { unsigned u = __builtin_bit_cast(unsigned, f); return (u + 0x7fffu + ((u >> 16) & 1u)) >> 16; }
__device__ __forceinline__ unsigned pk2(float lo, float hi) { return h16::pk(lo, hi); }
using xl::wave_sum; using xl::wave_sum_i;

struct Inputs {
    const float *x, *c, *norm_mix_g, *norm_ffn_g, *ada_w, *ada_b, *w_in, *w_out, *att_g, *ret_g, *fw_gate, *fw_up, *fw_down, *router_w, *mw_gate, *mw_up, *mw_down, *final_g;
};

template <class SrcFn> __device__ __forceinline__ void transpose_item(SrcFn src, int K, bf16* WT, int k0, int n0, LAS float* scr, int lane) {
#pragma unroll 8
    for (int i = 0; i < 32; ++i) { const int kk = 2 * i + (lane >> 5); scr[kk * 33 + (lane & 31)] = src(k0 + kk, n0 + (lane & 31)); }
    LDS_WAIT(); asm volatile("" ::: "memory");
    const int c = lane & 7;
#pragma unroll
    for (int j = 0; j < 4; ++j) { const int n = (lane >> 3) + 8 * j; const LAS float* s = scr + (8 * c) * 33 + n;
        v4u o; o.x = pk2(s[0 * 33], s[1 * 33]); o.y = pk2(s[2 * 33], s[3 * 33]); o.z = pk2(s[4 * 33], s[5 * 33]); o.w = pk2(s[6 * 33], s[7 * 33]);
        *(GAS v4u*)(WT + (size_t)(n0 + n) * K + k0 + 8 * c) = o; }
    LDS_WAIT(); asm volatile("" ::: "memory");
}
__device__ __forceinline__ int rot_src_col(int n) {
    if (n < 1536 || n >= 2560) return n;
    const int hb = (n - 1536) & ~127, p = (n - 1536) & 127;
    return 1536 + hb + 4 * (p >> 3) + ((p & 7) >> 1) + 64 * (p & 1);
}
constexpr int IT_WIN = 16 * 112, IT_WOUT = 16 * 32, IT_GU = 16 * 176, IT_DN = 44 * 32;
constexpr int IT_TOTAL = 2 * IT_WIN + 2 * IT_WOUT + IT_GU + IT_DN + 8 * (IT_GU + IT_DN);

constexpr int IT_NONMOE = 2 * IT_WIN + 2 * IT_WOUT + IT_GU + IT_DN;
__device__ __forceinline__ void convert_item(const Inputs& in, unsigned char* ws, int it, LAS float* scr, int lane) {
    int r = it;
    if (r < 2 * IT_WIN) { const int l = r / IT_WIN; r -= l * IT_WIN; const float* W = in.w_in + (size_t)l * 1024 * 3584;
        transpose_item([=](int k, int n) { return W[(size_t)k * 3584 + rot_src_col(n)]; }, 1024, (bf16*)(ws + WS_WIN) + (size_t)l * 3584 * 1024, 64 * (r / 112), 32 * (r % 112), scr, lane); return; }
    r -= 2 * IT_WIN;
    if (r < 2 * IT_WOUT) { const int l = r / IT_WOUT; r -= l * IT_WOUT; const float* W = in.w_out + (size_t)l * 1024 * 1024; const float* ag = in.att_g + l * 512;
        transpose_item([=](int k, int n) { return W[(size_t)k * 1024 + n] * (k < 512 ? ag[k] : 1.0f); }, 1024, (bf16*)(ws + WS_WOUT) + (size_t)l * 1024 * 1024, 64 * (r / 32), 32 * (r % 32), scr, lane); return; }
    r -= 2 * IT_WOUT;
    const float *Wg, *Wu, *Wd; bf16 *Dgu, *Ddn;
    if (r < IT_GU + IT_DN) { Wg = in.fw_gate; Wu = in.fw_up; Wd = in.fw_down; Dgu = (bf16*)(ws + WS_FGU); Ddn = (bf16*)(ws + WS_FDN); }
    else { r -= IT_GU + IT_DN; const int e = r / (IT_GU + IT_DN); r -= e * (IT_GU + IT_DN);
        Wg = in.mw_gate + (size_t)e * 1024 * 2816; Wu = in.mw_up + (size_t)e * 1024 * 2816; Wd = in.mw_down + (size_t)e * 2816 * 1024;
        Dgu = (bf16*)(ws + WS_MGU) + (size_t)e * 5632 * 1024; Ddn = (bf16*)(ws + WS_MDN) + (size_t)e * 1024 * 2816; }
    if (r < IT_GU) {
        transpose_item([=](int k, int n) { const float* W = ((n >> 7) & 1) ? Wu : Wg; return W[(size_t)k * 2816 + (n >> 8) * 128 + (n & 127)]; }, 1024, Dgu, 64 * (r / 176), 32 * (r % 176), scr, lane); return; }
    r -= IT_GU;
    transpose_item([=](int k, int n) { return Wd[(size_t)k * 1024 + n]; }, 2816, Ddn, 64 * (r / 32), 32 * (r % 32), scr, lane);
}
struct MoeItem { const float* src; bf16* dst; int ld, K, k0, n0; const float* rscale; float f8scale; int scol0, sstep; };
template <int KIND  , class InP> __device__ __forceinline__ MoeItem moe_item(InP inp, unsigned char* ws, int it, int lane) {
    MoeItem m; m.rscale = nullptr; m.f8scale = (KIND == 0) ? 32.0f : 64.0f; const int r8 = lane >> 3, c4 = 4 * (lane & 7); m.scol0 = c4; m.sstep = 1;
    if (KIND == 0) { const int e = it / IT_GU, r = it - e * IT_GU; const int kb = r / 176, nb = r % 176; const int n = 32 * nb; m.k0 = 64 * kb; m.n0 = n; m.ld = 2816; m.K = 1024;
        const float* W = (((n >> 7) & 1) ? inp->mw_up : inp->mw_gate) + (size_t)e * 1024 * 2816;
        m.src = W + (size_t)(m.k0 + r8) * 2816 + (n >> 8) * 128 + (n & 127) + c4; m.dst = (bf16*)(ws + WS_MGU + (size_t)e * 5632 * 1024); }
    else { const int e = it / IT_DN, r = it - e * IT_DN; const int kb = r / 32, nb = r % 32; m.k0 = 64 * kb; m.n0 = 32 * nb; m.ld = 1024; m.K = 2816;
        m.src = inp->mw_down + (size_t)e * 2816 * 1024 + (size_t)(m.k0 + r8) * 1024 + m.n0 + c4; m.dst = (bf16*)(ws + WS_MDN + (size_t)e * 1024 * 2816); }
    return m;
}
__device__ __forceinline__ void moe_item_load(const MoeItem& m, float (&v)[32]) {
#pragma unroll
    for (int i = 0; i < 8; ++i) { const f32x4 t = __builtin_nontemporal_load((const f32x4*)(m.src + (size_t)(8 * i) * m.ld));
        v[4 * i] = t[0]; v[4 * i + 1] = t[1]; v[4 * i + 2] = t[2]; v[4 * i + 3] = t[3]; }
}
__device__ __forceinline__ void moe_item_finish(const MoeItem& m, const float (&v)[32], LAS float* scr, int lane) {
    const int r8 = lane >> 3;
    if (m.rscale != nullptr && m.k0 < 512) {
#pragma unroll
        for (int i = 0; i < 8; ++i) { const float rsv = m.rscale[m.k0 + 8 * i + r8];
#pragma unroll
            for (int j = 0; j < 4; ++j) scr[(8 * i + r8) * 33 + m.scol0 + j * m.sstep] = v[4 * i + j] * rsv; }
    } else {
#pragma unroll
        for (int i = 0; i < 8; ++i)
#pragma unroll
            for (int j = 0; j < 4; ++j) scr[(8 * i + r8) * 33 + m.scol0 + j * m.sstep] = v[4 * i + j];
    }
    LDS_WAIT(); asm volatile("" ::: "memory");
    const int c = lane & 7;
    if (m.f8scale != 0.f) {
        const float sc = m.f8scale; unsigned char* d8 = (unsigned char*)m.dst;
#pragma unroll
        for (int j = 0; j < 4; ++j) { const int n = (lane >> 3) + 8 * j; const LAS float* s = scr + (8 * c) * 33 + n;
            v2u o; int p = 0; p = __builtin_amdgcn_cvt_pk_fp8_f32(s[0 * 33] * sc, s[1 * 33] * sc, p, false); p = __builtin_amdgcn_cvt_pk_fp8_f32(s[2 * 33] * sc, s[3 * 33] * sc, p, true); o.x = (unsigned)p;
            p = 0; p = __builtin_amdgcn_cvt_pk_fp8_f32(s[4 * 33] * sc, s[5 * 33] * sc, p, false); p = __builtin_amdgcn_cvt_pk_fp8_f32(s[6 * 33] * sc, s[7 * 33] * sc, p, true); o.y = (unsigned)p;
            __builtin_nontemporal_store(o, (GAS v2u*)(d8 + (size_t)(m.n0 + n) * m.K + m.k0 + 8 * c)); }
    } else {
#pragma unroll
        for (int j = 0; j < 4; ++j) { const int n = (lane >> 3) + 8 * j; const LAS float* s = scr + (8 * c) * 33 + n;
            v4u o; o.x = pk2(s[0 * 33], s[1 * 33]); o.y = pk2(s[2 * 33], s[3 * 33]); o.z = pk2(s[4 * 33], s[5 * 33]); o.w = pk2(s[6 * 33], s[7 * 33]);
            *(GAS v4u*)(m.dst + (size_t)(m.n0 + n) * m.K + m.k0 + 8 * c) = o; }
    }
    LDS_WAIT(); asm volatile("" ::: "memory");
}
template <class InP> __device__ __forceinline__ MoeItem base_item(InP inp, unsigned char* ws, int it, int lane) {
    MoeItem m; m.rscale = nullptr; m.f8scale = 0.f; int r = it; const int r8 = lane >> 3, c = lane & 7, c4 = 4 * c; m.scol0 = c4; m.sstep = 1;
    if (r < 2 * IT_WIN) { const int l = r / IT_WIN; r -= l * IT_WIN; m.k0 = 64 * (r / 112); m.n0 = 32 * (r % 112); m.ld = 3584; m.K = 1024;
        int scol = m.n0 + c4;
        if (m.n0 >= 1536 && m.n0 < 2560) { const int hb = (m.n0 - 1536) & ~127, a0 = ((m.n0 - 1536) & 127) >> 3;
            scol = 1536 + hb + 4 * (a0 + (c & 3)) + 64 * (c >> 2); m.scol0 = 8 * (c & 3) + (c >> 2); m.sstep = 2; }
        m.src = inp->w_in + (size_t)l * 1024 * 3584 + (size_t)(m.k0 + r8) * 3584 + scol; m.dst = (bf16*)(ws + WS_WIN) + (size_t)l * 3584 * 1024; return m; }
    r -= 2 * IT_WIN;
    if (r < 2 * IT_WOUT) { const int l = r / IT_WOUT; r -= l * IT_WOUT; m.k0 = 64 * (r / 32); m.n0 = 32 * (r % 32); m.ld = 1024; m.K = 1024; m.rscale = inp->att_g + l * 512;
        m.src = inp->w_out + (size_t)l * 1024 * 1024 + (size_t)(m.k0 + r8) * 1024 + m.n0 + c4; m.dst = (bf16*)(ws + WS_WOUT) + (size_t)l * 1024 * 1024; return m; }
    r -= 2 * IT_WOUT;
    if (r < IT_GU) { const int n = 32 * (r % 176); m.k0 = 64 * (r / 176); m.n0 = n; m.ld = 2816; m.K = 1024;
        m.src = (((n >> 7) & 1) ? inp->fw_up : inp->fw_gate) + (size_t)(m.k0 + r8) * 2816 + (n >> 8) * 128 + (n & 127) + c4; m.dst = (bf16*)(ws + WS_FGU); m.f8scale = 32.0f; return m; }
    r -= IT_GU; m.k0 = 64 * (r / 32); m.n0 = 32 * (r % 32); m.ld = 1024; m.K = 2816;
    m.src = inp->fw_down + (size_t)(m.k0 + r8) * 1024 + m.n0 + c4; m.dst = (bf16*)(ws + WS_FDN); m.f8scale = 64.0f; return m;
}
#ifndef CONV_DEPTH
#define CONV_DEPTH 4
#endif
#define CONV_PIPE(ITEM_FN, IT_FIRST, IT_END, STEP)                                                                      \
    { int it = (IT_FIRST); const int it_end = (IT_END), st_ = (STEP);                                                   \
      if (it < it_end) {                                                                                                \
        float v0[32], v1[32], v2[32], v3[32]; MoeItem q0, q1, q2, q3;                                                   \
        auto clampi = [&](int i) { return i < it_end ? i : it; };                                                       \
        q0 = ITEM_FN(it); moe_item_load(q0, v0);                                                                        \
        if (CONV_DEPTH > 2) { q1 = ITEM_FN(clampi(it + st_)); moe_item_load(q1, v1); }                                  \
        if (CONV_DEPTH > 3) { q2 = ITEM_FN(clampi(it + 2 * st_)); moe_item_load(q2, v2); }                              \
        for (;;) {                                                                                                      \
            if (CONV_DEPTH == 2) { q1 = ITEM_FN(clampi(it + st_)); moe_item_load(q1, v1); }                             \
            if (CONV_DEPTH == 3) { q2 = ITEM_FN(clampi(it + 2 * st_)); moe_item_load(q2, v2); }                         \
            if (CONV_DEPTH == 4) { q3 = ITEM_FN(clampi(it + 3 * st_)); moe_item_load(q3, v3); }                         \
            moe_item_finish(q0, v0, scr, lane); it += st_; if (it >= it_end) break;                                     \
            if (CONV_DEPTH == 2) { q0 = ITEM_FN(clampi(it + st_)); moe_item_load(q0, v0); }                             \
            if (CONV_DEPTH == 3) { q0 = ITEM_FN(clampi(it + 2 * st_)); moe_item_load(q0, v0); }                         \
            if (CONV_DEPTH == 4) { q0 = ITEM_FN(clampi(it + 3 * st_)); moe_item_load(q0, v0); }                         \
            moe_item_finish(q1, v1, scr, lane); it += st_; if (it >= it_end) break;                                     \
            if (CONV_DEPTH == 2) continue;                                                                              \
            if (CONV_DEPTH == 3) { q1 = ITEM_FN(clampi(it + 2 * st_)); moe_item_load(q1, v1); }                         \
            if (CONV_DEPTH == 4) { q1 = ITEM_FN(clampi(it + 3 * st_)); moe_item_load(q1, v1); }                         \
            moe_item_finish(q2, v2, scr, lane); it += st_; if (it >= it_end) break;                                     \
            if (CONV_DEPTH == 3) continue;                                                                              \
            q2 = ITEM_FN(clampi(it + 3 * st_)); moe_item_load(q2, v2);                                                  \
            moe_item_finish(q3, v3, scr, lane); it += st_; if (it >= it_end) break;                                     \
        }                                                                                                               \
      } }
constexpr int IT_LATE = IT_WIN + IT_WOUT, IT_EARLY = IT_NONMOE - IT_LATE;
template <class InP> __device__ __forceinline__ void convert_base_all(InP inp, unsigned char* ws, LAS unsigned char* lds, int gw, int NGW, int wave, int lane) {
    LAS float* scr = (LAS float*)(lds + wave * 16384);
    auto item = [&](int p) { return base_item(inp, ws, p < IT_WIN ? p : (p < IT_WIN + IT_WOUT ? p + IT_WIN : p + IT_WIN + IT_WOUT), lane); };
    CONV_PIPE(item, gw, IT_EARLY, NGW)
}
template <class InP> __device__ __forceinline__ void convert_base_late(InP inp, unsigned char* ws, LAS unsigned char* lds, int sp, int nsp, int wave, int lane) {
    LAS float* scr = (LAS float*)(lds + wave * 16384);
    auto item = [&](int d) { return base_item(inp, ws, d < IT_WIN ? IT_WIN + d : d + IT_WIN + IT_WOUT, lane); };
    CONV_PIPE(item, sp * NWAVES + wave, IT_LATE, nsp * NWAVES)
}
template <int KIND, class InP> __device__ __forceinline__ void convert_moe_range(InP inp, unsigned char* ws, LAS unsigned char* lds, int it0, int it1, int sp, int nsp, int wave, int lane) {
    LAS float* scr = (LAS float*)(lds + wave * 16384);
    auto item = [&](int i) { return moe_item<KIND>(inp, ws, i, lane); };
#ifndef CONV_CONTIG
    CONV_PIPE(item, it0 + sp * NWAVES + wave, it1, nsp * NWAVES)
#else
    const int chunk = (it1 - it0 + nsp - 1) / nsp, cb = it0 + sp * chunk, ce = (cb + chunk < it1) ? cb + chunk : it1;
    CONV_PIPE(item, cb + wave, ce, NWAVES)
#endif
}
constexpr int IT_MOE = 8 * (IT_GU + IT_DN);
#ifndef G_GUD_N
#define G_GUD_N 208
#endif
constexpr int G_INPROJ = 224, G_GUD = G_GUD_N;
#ifndef MOE_SPARE
#define MOE_SPARE 8
#endif
constexpr int IT_MGU = 8 * IT_GU, IT_MDN = 8 * IT_DN;
#ifndef SPLIT_A
#define SPLIT_A 9000
#define SPLIT_B 19500
#define SPLIT_C 7500
#endif
constexpr int IT_MOE_A = SPLIT_A, IT_MOE_B = SPLIT_B, IT_MDN_C = SPLIT_C;

template <class InP> __device__ __forceinline__ void p0_prologue(InP inp, unsigned char* ws, LAS unsigned char* lds, int vcu, int G, int wave, int lane, int tid, int moe_w) {
    Inputs in; in.c = inp->c; in.ada_w = inp->ada_w; in.ada_b = inp->ada_b; in.w_in = inp->w_in; in.w_out = inp->w_out; in.att_g = inp->att_g; in.fw_gate = inp->fw_gate; in.fw_up = inp->fw_up; in.fw_down = inp->fw_down; in.mw_gate = inp->mw_gate; in.mw_up = inp->mw_up; in.mw_down = inp->mw_down;
    if (vcu < 192) {
        LAS float* cs = (LAS float*)lds;
        LAS float* part = (LAS float*)(lds + 32768);
        for (int i = tid; i < 8 * 1024; i += 512) { const float v = in.c[i]; cs[i] = v / (1.0f + __expf(-v)); }
        __syncthreads();
        const int n0 = vcu * 64, l = n0 / 6144, nn = n0 % 6144 + lane;
        const float* wp = in.ada_w + (size_t)l * 1024 * 6144 + (size_t)(wave * 128) * 6144 + nn;
        float acc[8];
#pragma unroll
        for (int b = 0; b < 8; ++b) acc[b] = 0.f;
#pragma unroll 16
        for (int k = 0; k < 128; ++k) { const float wv = __builtin_nontemporal_load(wp + (size_t)k * 6144);
#pragma unroll
            for (int b = 0; b < 8; ++b) acc[b] += cs[b * 1024 + wave * 128 + k] * wv; }
#pragma unroll
        for (int b = 0; b < 8; ++b) part[(wave * 8 + b) * 64 + lane] = acc[b];
        __syncthreads();
        { const int b = tid >> 6; float s = 0.f;
#pragma unroll
          for (int w = 0; w < 8; ++w) s += part[(w * 8 + b) * 64 + lane];
          ((float*)(ws + WS_MOD))[((size_t)l * 8 + b) * 6144 + nn] = s + in.ada_b[l * 6144 + nn]; }
        __syncthreads();
    }
    { const int g = vcu * 512 + tid; if (g < 2048 * 64) { const int pos = g >> 6, i = g & 63; const float inv = powf(10000.0f, -(float)i / 64.0f); const float ang = (float)pos * inv;
        float* rp = (float*)(ws + WS_ROPE) + (size_t)g * 2; rp[0] = (float)cos((double)ang); rp[1] = (float)sin((double)ang); } }
    convert_base_all(inp, ws, lds, vcu * NWAVES + wave, G * NWAVES, wave, lane);
}

template <int MODE>
__device__ __forceinline__ void norm_pass(const float* xsrc, const float* gain, const float* sh, const float* sc, bf16* dst,
                                          const float* router_w, int* eidx, float* ew, int* wcnt, int gw, int lane) {
    const int m0 = gw * 8, b = m0 >> 11;
    f32x4 gv[4], scv[4], shv[4];
#pragma unroll
    for (int j = 0; j < 4; ++j) { gv[j] = ((const f32x4*)gain)[lane + 64 * j]; scv[j] = ((const f32x4*)(sc + (size_t)b * 6144))[lane + 64 * j] + 1.0f; shv[j] = ((const f32x4*)(sh + (size_t)b * 6144))[lane + 64 * j]; }
    int cnt[8];
#pragma unroll
    for (int e = 0; e < 8; ++e) cnt[e] = 0;
    f32x4 rw[4][4][2];
    if (MODE == 1) {
#pragma unroll
        for (int j = 0; j < 4; ++j)
#pragma unroll
            for (int c = 0; c < 4; ++c) { const float* wp = router_w + (size_t)(4 * (lane + 64 * j) + c) * 8; rw[j][c][0] = *(const f32x4*)wp; rw[j][c][1] = *(const f32x4*)(wp + 4); }
    }
    for (int i = 0; i < 8; ++i) {
        const int m = m0 + i;
        const f32x4* xr = (const f32x4*)(xsrc + (size_t)m * 1024) + lane;
        f32x4 v[4]; float s = 0.f;
#pragma unroll
        for (int j = 0; j < 4; ++j) { v[j] = xr[64 * j]; s += (v[j][0] * v[j][0] + v[j][1] * v[j][1]) + (v[j][2] * v[j][2] + v[j][3] * v[j][3]); }
        const float rs = 1.0f / sqrtf(wave_sum(s) * (1.0f / 1024.0f) + 1e-6f);
        if (MODE >= 1) {
            unsigned* o4 = (unsigned*)((unsigned char*)dst + (size_t)m * 1024) + lane;
#pragma unroll
            for (int j = 0; j < 4; ++j) { v[j] = v[j] * rs * gv[j] * scv[j] + shv[j]; o4[64 * j] = epi::pk4_fp8(v[j][0], v[j][1], v[j][2], v[j][3]); }
        } else {
        v2u* o8 = (v2u*)(dst + (size_t)m * 1024) + lane;
#pragma unroll
        for (int j = 0; j < 4; ++j) { v[j] = v[j] * rs * gv[j] * scv[j] + shv[j]; v2u w; w.x = pk2(v[j][0], v[j][1]); w.y = pk2(v[j][2], v[j][3]); o8[64 * j] = w; }
        }
        if (MODE == 1) {
            float lg[8];
#pragma unroll
            for (int e = 0; e < 8; ++e) lg[e] = 0.f;
#pragma unroll
            for (int j = 0; j < 4; ++j)
#pragma unroll
                for (int c = 0; c < 4; ++c) { const f32x4 w0 = rw[j][c][0], w1 = rw[j][c][1];
                    const float hv = v[j][c];
                    lg[0] += hv * w0[0]; lg[1] += hv * w0[1]; lg[2] += hv * w0[2]; lg[3] += hv * w0[3]; lg[4] += hv * w1[0]; lg[5] += hv * w1[1]; lg[6] += hv * w1[2]; lg[7] += hv * w1[3]; }
            { const bool b5 = (lane & 32) != 0, b4 = (lane & 16) != 0, b3 = (lane & 8) != 0;
              float a4[4], b2[2], c1;
#pragma unroll
              for (int q = 0; q < 4; ++q) { const float keep = b5 ? lg[4 + q] : lg[q], send = b5 ? lg[q] : lg[4 + q]; a4[q] = keep + xl::xor32p(send, b5); }
#pragma unroll
              for (int q = 0; q < 2; ++q) { const float keep = b4 ? a4[2 + q] : a4[q], send = b4 ? a4[q] : a4[2 + q]; b2[q] = keep + xl::xor_f<16>(send); }
              { const float keep = b3 ? b2[1] : b2[0], send = b3 ? b2[0] : b2[1]; c1 = keep + xl::xor_f<8>(send); }
              c1 += xl::xor_f<4>(c1); c1 += xl::xor_f<2>(c1); c1 += xl::xor_f<1>(c1);
#pragma unroll
              for (int e = 0; e < 8; ++e) lg[e] = __builtin_bit_cast(float, __builtin_amdgcn_readlane(__builtin_bit_cast(int, c1), 8 * e)); }
            int i0 = 0; float b0 = lg[0];
#pragma unroll
            for (int e = 1; e < 8; ++e) if (lg[e] > b0) { b0 = lg[e]; i0 = e; }
            int i1 = -1; float b1 = -3.0e38f;
#pragma unroll
            for (int e = 0; e < 8; ++e) if (e != i0 && lg[e] > b1) { b1 = lg[e]; i1 = e; }
            const float e1 = __expf(b1 - b0);
#pragma unroll
            for (int e = 0; e < 8; ++e) cnt[e] += ((e == i0) ? 1 : 0) + ((e == i1) ? 1 : 0);
            if (lane == 0) { eidx[m * 2] = i0; eidx[m * 2 + 1] = i1; ew[m * 2] = 1.0f / (1.0f + e1); ew[m * 2 + 1] = e1 / (1.0f + e1); }
        }
    }
    if (MODE == 1) {
        int myc = 0;
#pragma unroll
        for (int e = 0; e < 8; ++e) myc = (lane == e) ? cnt[e] : myc;
        if (lane < 8) wcnt[gw * 8 + lane] = myc;
    }
}

__device__ __forceinline__ void place_pass(const int* wcnt, const int* eidx, const float* ew, const bf16* XA, bf16* XS, int* srow, float* swt, int* segout, int gw, int NGW, int lane, int wave, LAS unsigned char* lds) {
    int tot[8], pre[8];
#pragma unroll
    for (int e = 0; e < 8; ++e) { tot[e] = 0; pre[e] = 0; }
    const int cu0 = gw & ~7;
#pragma unroll
    for (int it = 0; it < 4; ++it) { const int w = wave * 256 + it * 64 + lane; const i32x4 a = *(const i32x4*)(wcnt + w * 8), c = *(const i32x4*)(wcnt + w * 8 + 4); const int inc = (w < cu0) ? 1 : 0;
        tot[0] += a[0]; tot[1] += a[1]; tot[2] += a[2]; tot[3] += a[3]; tot[4] += c[0]; tot[5] += c[1]; tot[6] += c[2]; tot[7] += c[3];
        pre[0] += inc * a[0]; pre[1] += inc * a[1]; pre[2] += inc * a[2]; pre[3] += inc * a[3]; pre[4] += inc * c[0]; pre[5] += inc * c[1]; pre[6] += inc * c[2]; pre[7] += inc * c[3]; }
    const int own = wcnt[cu0 * 8 + lane];
    LAS int* part = (LAS int*)lds;
#pragma unroll
    for (int e = 0; e < 8; ++e) { const int t = wave_sum_i(tot[e]), q = wave_sum_i(pre[e]); if (lane == 0) { part[wave * 16 + e] = t; part[wave * 16 + 8 + e] = q; } }
    __syncthreads();
    int base[8]; int run = 0;
#pragma unroll
    for (int e = 0; e < 8; ++e) { int t = 0, q = 0;
#pragma unroll
        for (int w = 0; w < 8; ++w) { t += part[w * 16 + e]; q += part[w * 16 + 8 + e]; }
        q += wave_sum_i(((lane & 7) == e && (lane >> 3) < wave) ? own : 0);
        tot[e] = t; base[e] = run + q; if (gw == 0 && lane == 0) segout[e] = run; run += (t + 255) & ~255; }
    if (gw == 0 && lane == 0) segout[8] = run;
    const int myev = (lane < 16) ? eidx[gw * 16 + lane] : 0; const float myw = (lane < 16) ? ew[gw * 16 + lane] : 0.f;
    int mypos = 0;
#pragma unroll
    for (int i = 0; i < 16; ++i) { const int ev = __builtin_amdgcn_readlane(myev, i); int pos = 0;
#pragma unroll
        for (int e = 0; e < 8; ++e) if (ev == e) { pos = base[e]; base[e] += 1; }
        mypos = (lane == i) ? pos : mypos; }
    if (lane < 16) { srow[mypos] = gw * 16 + lane; swt[mypos] = myw; }
    const v4u* __restrict__ s = (const v4u*)((const unsigned char*)XA + (size_t)(gw * 8) * 1024);
    v4u r0[8];
#pragma unroll
    for (int t = 0; t < 8; ++t) r0[t] = s[t * 64 + lane];
#pragma unroll
    for (int i = 0; i < 16; ++i) { const int pos = __builtin_amdgcn_readlane(mypos, i); v4u* __restrict__ d = (v4u*)((unsigned char*)XS + (size_t)pos * 1024);
        d[lane] = r0[i >> 1]; }
}

__device__ __forceinline__ void final_pass(float* xio, const bf16* YS, const int* atomf, const float* slab, const float* g2, const float* fg, int gw, int lane) {
    const int m0 = gw * 8, b = m0 >> 11;
    f32x4 gv[4], g2v[4];
#pragma unroll
    for (int j = 0; j < 4; ++j) { gv[j] = ((const f32x4*)fg)[lane + 64 * j]; g2v[j] = ((const f32x4*)(g2 + (size_t)b * 6144))[lane + 64 * j]; }
    for (int i = 0; i < 8; ++i) {
        const int m = m0 + i;
        f32x4* xr = (f32x4*)(xio + (size_t)m * 1024) + lane;
        const v2u* y0 = (const v2u*)(YS + (size_t)(2 * m) * 1024) + lane; const v2u* y1 = (const v2u*)(YS + (size_t)(2 * m + 1) * 1024) + lane;
        f32x4 v[4]; float s = 0.f; const i32x4 f0 = *(const i32x4*)(atomf + (size_t)(2 * m) * 4), f1 = *(const i32x4*)(atomf + (size_t)(2 * m + 1) * 4);
#pragma unroll
        for (int j = 0; j < 4; ++j) { v[j] = xr[64 * j]; const v2u a = y0[64 * j], c = y1[64 * j];
            f32x4 ya, yc;
            if (f0[j]) { const int id = f0[j] - 1; const float* sp = slab + ((size_t)((id >> 8) * 11) * 256 + (id & 255)) * 256 + 4 * lane; ya = (f32x4){0.f, 0.f, 0.f, 0.f};
                for (int kc = 0; kc < 11; ++kc) ya += *(const f32x4*)(sp + (size_t)kc * 65536); }
            else { ya[0] = h16::lo(a.x); ya[1] = h16::hi(a.x); ya[2] = h16::lo(a.y); ya[3] = h16::hi(a.y); }
            if (f1[j]) { const int id = f1[j] - 1; const float* sp = slab + ((size_t)((id >> 8) * 11) * 256 + (id & 255)) * 256 + 4 * lane; yc = (f32x4){0.f, 0.f, 0.f, 0.f};
                for (int kc = 0; kc < 11; ++kc) yc += *(const f32x4*)(sp + (size_t)kc * 65536); }
            else { yc[0] = h16::lo(c.x); yc[1] = h16::hi(c.x); yc[2] = h16::lo(c.y); yc[3] = h16::hi(c.y); }
            const f32x4 ys = ya + yc;
            v[j] = v[j] + g2v[j] * ys; s += (v[j][0] * v[j][0] + v[j][1] * v[j][1]) + (v[j][2] * v[j][2] + v[j][3] * v[j][3]); }
        const float rs = 1.0f / sqrtf(wave_sum(s) * (1.0f / 1024.0f) + 1e-6f);
#pragma unroll
        for (int j = 0; j < 4; ++j) xr[64 * j] = v[j] * rs * gv[j];
    }
}

__device__ __forceinline__ void xcd_barrier_arrive(const XcdBarrier& b) {
    asm volatile("s_waitcnt vmcnt(0)" ::: "memory");
    __syncthreads();
    if (otid(b.wv) == 0) {
        unsigned* bar = b.bar;
        __builtin_amdgcn_s_waitcnt(0);
        unsigned nloc = b.st[0], nx = b.st[1];
        if (nloc == 0u) { xcd_barrier_complete(bar, b.x, nloc, nx); b.st[0] = nloc; b.st[1] = nx; }
        const unsigned old = xb_add(&bar[XB_XSUB(b.x)], 1u);
        const unsigned gen = old / nloc;
        if (old + 1u == (gen + 1u) * nloc) {
            __builtin_amdgcn_fence(__ATOMIC_RELEASE, "agent");
            asm volatile("s_waitcnt vmcnt(0)" ::: "memory");
            const unsigned og = xb_add(&bar[XB_TOP], 1u);
            const unsigned tg = og / nx;
            if (og + 1u == (tg + 1u) * nx) xb_add(&bar[XB_TOPGEN], 1u);
            else XB_SPIN(xb_ld(&bar[XB_TOPGEN]) == tg, bar);
            xb_add(&bar[XB_XGEN(b.x)], 1u);
            asm volatile("s_waitcnt vmcnt(0)" ::: "memory");
        }
        b.st[3] = gen;
    }
}
__device__ __forceinline__ void xcd_barrier_wait(const XcdBarrier& b) {
    if (otid(b.wv) == 0) {
        unsigned* bar = b.bar;
        const unsigned gen = b.st[3];
        XB_SPIN(xb_ld(&bar[XB_XGEN(b.x)]) == gen, bar);
        __builtin_amdgcn_fence(__ATOMIC_ACQUIRE, "agent");
        asm volatile("s_waitcnt vmcnt(0)" ::: "memory");
    }
    __syncthreads();
}
constexpr int N_PHASES = 18;
struct Args { Inputs in; float* out; unsigned char* ws; int ph_lo, ph_hi, bar_region, moe_w; };

typedef const Args __attribute__((address_space(4))) CArgs;
__device__ __forceinline__ CArgs* kargs() { unsigned long off = 0; asm volatile("" : "+s"(off)); return (CArgs*)((const char __attribute__((address_space(4)))*)__builtin_amdgcn_kernarg_segment_ptr() + off); }

__global__ void __launch_bounds__(NWAVES * 64, 2) mega(Args args_unused) {
    extern __shared__ __attribute__((aligned(16))) unsigned char lds_raw[];
    LAS unsigned char* lds = (LAS unsigned char*)lds_raw;
    volatile LAS unsigned* MISC = (volatile LAS unsigned*)(lds + MISC_OFF);
    const int G = gridDim.x;
#define PHASE_IDS int tid = otid(WV); int bx = blockIdx.x; asm volatile("" : "+s"(bx)); const int lane = tid & 63, wave = __builtin_amdgcn_readfirstlane(tid >> 6); \
    const int vcu = (bx & 7) * (G >> 3) + (bx >> 3); const int gw = vcu * NWAVES + wave; (void)lane; (void)gw; (void)vcu;
    const int WV = __builtin_amdgcn_readfirstlane((int)threadIdx.x >> 6);
    for (int u = otid(WV); u < (LDS_BYTES - LDSCTL_OFF) / 4; u += NWAVES * 64) ((LAS unsigned*)(lds + LDSCTL_OFF))[u] = 0u;
    __syncthreads();
    XcdBarrier bar;
    { CArgs* ka = kargs(); unsigned* barw = (unsigned*)(ka->ws + WS_CTL) + CW_BAR + ka->bar_region * XCD_BAR_WORDS; bar = xcd_barrier_post(barw, MISC + 8, WV); }
    int lo, hi; { CArgs* ka = kargs(); lo = ka->ph_lo; hi = ka->ph_hi; }
#ifndef PHM
#define PHM 0x3ff
#endif
#define IN(k) (lo <= (k) && (k) < hi)
#define TY(t) (((PHM) >> (t)) & 1)
#ifndef DUP_T
#define DUP_T -1
#define DUP_N 0
#endif
#define REP(t) for (int rep_ = 0; rep_ < ((t) == DUP_T ? 1 + DUP_N : 1) && (rep_ == 0 || (__syncthreads(), true)); ++rep_)
#ifdef TPROBE
#define TS ((volatile LAS unsigned long long*)(lds + MISC_OFF + 256))
#define STAMP(k) do { if (blockIdx.x == 0 && otid(WV) == 0) TS[(k)] = __builtin_amdgcn_s_memrealtime(); } while (0)
#else
#define STAMP(k) do {} while (0)
#endif
#ifdef TSPIN
#ifndef TSPIN_BX
#define TSPIN_BX 0
#endif
#define TSL ((volatile LAS unsigned long long*)(lds + MISC_OFF + 256))
#define STAMP_E(k) do { if (blockIdx.x == TSPIN_BX && otid(WV) == 0) { const unsigned long long n_ = __builtin_amdgcn_s_memrealtime(); if (((TSPIN_W) >> (k)) & 1) TSL[1] += n_ - TSL[0]; TSL[0] = n_; } } while (0)
#define STAMP_S(k) do { if (blockIdx.x == TSPIN_BX && otid(WV) == 0) { const unsigned long long n_ = __builtin_amdgcn_s_memrealtime(); if (((TSPIN_B) >> (k)) & 1) TSL[1] += n_ - TSL[0]; TSL[0] = n_; } } while (0)
    if (blockIdx.x == TSPIN_BX && otid(WV) == 0) { TSL[1] = 0ull; TSL[0] = __builtin_amdgcn_s_memrealtime(); }
#else
#define STAMP_E(k) do {} while (0)
#define STAMP_S(k) do {} while (0)
#endif
    STAMP(0);
#define SEAM(k) do { STAMP_E(k); if (IN(k) && IN((k) + 1)) xcd_barrier(bar); STAMP_S(k); STAMP((k) + 1); } while (0)

    if (TY(0) && IN(0)) REP(0) { PHASE_IDS CArgs* ka = kargs(); p0_prologue(&ka->in, ka->ws, lds, vcu, G, wave, lane, tid, 0); }
    SEAM(0);
#ifdef PROBE_BAR
    for (int q = 0; q < PROBE_BAR; ++q) xcd_barrier(bar);
#endif
    for (int l = 0; l < 2; ++l) {
        const int pb = 1 + 8 * l;
        if (TY(1) && IN(pb + 0)) REP(1) { PHASE_IDS CArgs* ka = kargs(); unsigned char* ws = ka->ws; const float* mod = (const float*)(ws + WS_MOD) + (size_t)l * 8 * 6144;
            const float* xin = (l == 0) ? ka->in.x : (const float*)ka->out;
            if (gw < 2048) norm_pass<0>(xin, ka->in.norm_mix_g + l * 1024, mod + 0 * 1024, mod + 1 * 1024, (bf16*)(ws + WS_XA), nullptr, nullptr, nullptr, nullptr, gw, lane); }
        SEAM(pb + 0);
        if (TY(2) && IN(pb + 1)) REP(2) { PHASE_IDS CArgs* ka = kargs(); unsigned char* ws = ka->ws;
            if (bx < G_INPROJ) {
                pg8::Gemm g{1024, 1024, 1024}; pg8::DenseSched S; S.init(ws + WS_XA, 1024, (bf16*)(ws + WS_WIN) + (size_t)l * 3584 * 1024, 1024, 16384, 3584, G_INPROJ, bx);
                epi::EpiInProj E{(bf16*)(ws + WS_QKV), (size_t)16384 * 512, (float*)(ws + WS_KMP), (const float*)(ws + WS_ROPE)};
                pg8::gemm_phase(WV, lds, g, S, E);
            } else if (rep_ == 0) { convert_moe_range<0>(&ka->in, ws, lds, l == 0 ? 0 : IT_MOE_B, l == 0 ? IT_MOE_A : IT_MGU, bx - G_INPROJ, G - G_INPROJ, wave, lane);
                                    if (l == 1) convert_moe_range<1>(&ka->in, ws, lds, 0, IT_MDN_C, bx - G_INPROJ, G - G_INPROJ, wave, lane);
#ifdef PROBE_CONVIN
                                    if (l == PROBE_CONVIN) { __syncthreads(); if (l == 0) convert_moe_range<0>(&ka->in, ws, lds, 0, IT_MOE_A, bx - G_INPROJ, G - G_INPROJ, wave, lane); else convert_moe_range<1>(&ka->in, ws, lds, 0, IT_MDN_C, bx - G_INPROJ, G - G_INPROJ, wave, lane); }
#endif
                                    }
        }
        SEAM(pb + 1);
        if (TY(3) && IN(pb + 2)) REP(3) { PHASE_IDS CArgs* ka = kargs(); unsigned char* ws = ka->ws; bf16* QKV = (bf16*)(ws + WS_QKV); bf16* CAT = (bf16*)(ws + WS_CAT);
            if (G == 256) {
                if ((bx & 7) < 7) fa::kv_unit(WV, bx >> 5, (bx >> 3) & 3, bx & 7, QKV + (size_t)4 * 16384 * 512, QKV + (size_t)5 * 16384 * 512, (float*)(ws + WS_KVM), lds);
                xcd_barrier_arrive(bar);
                { fa::Tensors TA{QKV, QKV + (size_t)1 * 16384 * 512, QKV + (size_t)2 * 16384 * 512, CAT, (float*)(ws + WS_ASSQ), (const float*)(ws + WS_KMP), nullptr, nullptr, nullptr};
                  const int g2 = (bx >> 3) * 2, r4 = (bx & 7) * 4;
                  for (int uu = 0; uu < 2; ++uu) { const int bh = g2 + uu; fa::attn_unit<false>(WV, bh >> 3, bh & 7, ((uu == 0 ? 0x25170643 : 0x31507246) >> r4) & 7, TA, lds); } }
                xcd_barrier_wait(bar);
                { fa::Tensors TR{QKV + (size_t)3 * 16384 * 512, QKV + (size_t)4 * 16384 * 512, QKV + (size_t)5 * 16384 * 512, CAT, (float*)(ws + WS_ASSQ), (const float*)(ws + WS_KMP), QKV + (size_t)6 * 16384 * 512, ka->in.ret_g + l * 512, (const float*)(ws + WS_KVM)};
                  fa::attn_unit<true>(WV, bx >> 5, (bx >> 3) & 3, bx & 7, TR, lds); }
            }
        }
        SEAM(pb + 2);
        if (TY(4) && IN(pb + 3)) REP(4) {
            { PHASE_IDS CArgs* ka = kargs(); unsigned char* ws = ka->ws; const float* mod = (const float*)(ws + WS_MOD) + (size_t)l * 8 * 6144;
                const float* xin = (l == 0) ? ka->in.x : (const float*)ka->out;
                pg8::Gemm g{1024, 1024, 1024}; pg8::DenseSched S; S.init(ws + WS_CAT, 1024, (const bf16*)(ws + WS_WOUT) + (size_t)l * 1024 * 1024, 1024, 16384, 1024, G, bx);
                epi::EpiOutProj E{xin, ka->out, mod + 2 * 1024, (const float*)(ws + WS_ASSQ), rep_ > 0}; pg8::gemm_phase(WV, lds, g, S, E); }
        }
        SEAM(pb + 3);
        if (TY(5) && IN(pb + 4)) REP(5) { PHASE_IDS CArgs* ka = kargs(); unsigned char* ws = ka->ws; const float* mod = (const float*)(ws + WS_MOD) + (size_t)l * 8 * 6144;
            if (gw < 2048) {
                if (l == 0) norm_pass<2>(ka->out, ka->in.norm_ffn_g + l * 1024, mod + 3 * 1024, mod + 4 * 1024, (bf16*)(ws + WS_XA), nullptr, nullptr, nullptr, nullptr, gw, lane);
                else norm_pass<1>(ka->out, ka->in.norm_ffn_g + l * 1024, mod + 3 * 1024, mod + 4 * 1024, (bf16*)(ws + WS_XA), ka->in.router_w, (int*)(ws + WS_EIDX), (float*)(ws + WS_EW), (int*)(ws + WS_WCNT), gw, lane);
            }
            if (l == 1) { int* srow = (int*)(ws + WS_SROW); int* af = (int*)(ws + WS_ATOMF);
                { const int p = bx * 512 + tid; if (p < XS_ROWS) srow[p] = -1; af[p] = 0; }
            }
            else if (bx == 0 && tid < 9) { ((int*)(ws + WS_SEGD))[tid] = (tid == 0) ? 0 : ((tid == 8) ? 16384 : (1 << 30)); }
        }
        SEAM(pb + 4);
        if (l == 1) {
            if (TY(6) && IN(pb + 5)) REP(6) { PHASE_IDS CArgs* ka = kargs(); unsigned char* ws = ka->ws;
                if (gw < 2048) place_pass((const int*)(ws + WS_WCNT), (const int*)(ws + WS_EIDX), (const float*)(ws + WS_EW), (const bf16*)(ws + WS_XA), (bf16*)(ws + WS_XS), (int*)(ws + WS_SROW), (float*)(ws + WS_SWT), (int*)(ws + WS_SEG), gw, 2048, lane, wave, lds); }
            SEAM(pb + 5);
        } else { STAMP(pb + 6); }
        if (TY(7) && IN(pb + 6)) REP(7) { PHASE_IDS CArgs* ka = kargs(); unsigned char* ws = ka->ws;
            int Geff = G_GUD;
            if (l == 1) { const int nwg = (__builtin_amdgcn_readfirstlane(((const int*)(ws + WS_SEG))[8]) / 256) * 22; const int rounds = (nwg + G - 1) / G;
                Geff = (((nwg + rounds - 1) / rounds) + 7) & ~7; if (Geff > G - MOE_SPARE) Geff = G - MOE_SPARE; }
            if (bx < Geff) {
                pg8::Gemm g{512, 512, 512}; pg8::MoeSched S;
                S.init(ws + (l == 0 ? WS_XA : WS_XS), 512, ws + (l == 0 ? WS_FGU : WS_MGU), 512, (size_t)5632 * 1024, (const int*)(ws + (l == 0 ? WS_SEGD : WS_SEG)), 5632, Geff, bx);
                epi::EpiSwiGLU8 E{ws + (l == 0 ? WS_HD : WS_HM), 2816}; pg8::gemm_phase(WV, lds, g, S, E);
            } else if (rep_ == 0) { if (l == 0) { convert_base_late(&ka->in, ws, lds, bx - Geff, G - Geff, wave, lane); convert_moe_range<0>(&ka->in, ws, lds, IT_MOE_A, IT_MOE_B, bx - Geff, G - Geff, wave, lane); }
                                    else { convert_moe_range<1>(&ka->in, ws, lds, IT_MDN_C, IT_MDN, bx - Geff, G - Geff, wave, lane);
#ifdef PROBE_CONV2
                                           __syncthreads(); convert_moe_range<1>(&ka->in, ws, lds, IT_MDN_C, IT_MDN, bx - Geff, G - Geff, wave, lane);
#endif
                                    } }
        }
        SEAM(pb + 6);
        if (TY(8) && IN(pb + 7)) REP(8) { PHASE_IDS CArgs* ka = kargs(); unsigned char* ws = ka->ws; const float* mod = (const float*)(ws + WS_MOD) + (size_t)l * 8 * 6144;
            if (l == 0) { pg8::MoeSched S; S.init(ws + WS_HD, 1408, ws + WS_FDN, 1408, (size_t)1024 * 2816, (const int*)(ws + WS_SEGD), 1024, G, bx);
                pg8::Gemm g{1408, 1408, 1408};
                epi::EpiDownDense8 E{ka->out, mod + 5 * 1024, rep_ > 0}; pg8::gemm_phase(WV, lds, g, S, E);
            } else {
                pg8::MoeSched S; S.init(ws + WS_HM, 1408, ws + WS_MDN, 1408, (size_t)1024 * 2816, (const int*)(ws + WS_SEG), 1024, G, bx);
#ifndef NO_SPLITK
                const int left = S.nwg % G; const bool split = left > 0 && left <= 32;
                if (split) S.lim = S.nwg - left;
#endif
                { pg8::Gemm g{1408, 1408, 1408};
                  epi::EpiDownMoe8 E{(bf16*)(ws + WS_YS), (const int*)(ws + WS_SROW), (const float*)(ws + WS_SWT)}; pg8::gemm_phase(WV, lds, g, S, E); }
#ifndef NO_SPLITK
                if (split && rep_ == 0) { S.first = S.nwg - left; S.lim = S.nwg; S.KS = 11; S.kbytes = 256;
                  pg8::Gemm g{1408, 1408, 128};
                  epi::EpiDownMoe8Slab E{(const int*)(ws + WS_SROW), (const float*)(ws + WS_SWT), (int*)(ws + WS_ATOMF), (float*)(ws + WS_SLAB), 11}; pg8::gemm_phase(WV, lds, g, S, E); }
#endif
            }
        }
        SEAM(pb + 7);
    }
    if (TY(9) && IN(17)) { PHASE_IDS CArgs* ka = kargs(); unsigned char* ws = ka->ws;
        if (gw < 2048) final_pass(ka->out, (const bf16*)(ws + WS_YS), (const int*)(ws + WS_ATOMF), (const float*)(ws + WS_SLAB), (const float*)(ws + WS_MOD) + (size_t)1 * 8 * 6144 + 5 * 1024, ka->in.final_g, gw, lane); }
#ifdef TSPIN
    STAMP_E(17);
    if (blockIdx.x == TSPIN_BX && otid(WV) == 0) { const unsigned long long t0_ = __builtin_amdgcn_s_memrealtime(), w_ = TSL[1] * (unsigned long long)(TSPIN_K);
        while (__builtin_amdgcn_s_memrealtime() - t0_ < w_) __builtin_amdgcn_s_sleep(8); }
#endif
#ifdef TPROBE
    xcd_barrier(bar); STAMP(18); __syncthreads();
    if (blockIdx.x == 0) { CArgs* ka = kargs(); float* o = ka->out;
        const float d1 = (float)(TS[TPROBE_A + 1] - TS[TPROBE_A]) * 0.01f, d2 = (float)(TS[TPROBE_B + 1] - TS[TPROBE_B]) * 0.01f;
        const float a = 4.0f * sqrtf(d1);
        for (int i = otid(WV); i < 1024 * 1024; i += 512) o[i] = a;
        if (otid(WV) == 0) o[1024 * 1024 + 5] = 100.0f * d2; }
#endif
#undef IN
#undef TY
#undef SEAM
#undef PHASE_IDS
}
}
#ifndef STEP
#define STEP 5
#endif
namespace ad {
__device__ __forceinline__ float bf2f(unsigned short s) { return h16::one(s); }
__global__ void __launch_bounds__(256) ad_proj(const unsigned short* QKV, size_t gstride, int b, float* projb) {
    const int m = blockIdx.x; const size_t row = (size_t)b * 2048 + m;
    for (int n = threadIdx.x; n < 3584; n += 256) {
        const int grp = n / 512, c = n % 512; int sc = c;
        if (grp == 3 || grp == 4) { const int head = c >> 7, d = c & 127; sc = head * 128 + 8 * ((d & 63) >> 2) + 2 * (d & 3) + (d >> 6); }
        float v = bf2f(QKV[(size_t)grp * gstride + row * 512 + sc]);
        if (grp == 0) v *= (1.0f / epi::C2);
        if (grp == 4) v *= (1.0f / epi::KSC);
        projb[(size_t)m * 3584 + n] = v;
    }
}
__global__ void __launch_bounds__(64) ad_kmean(const float* KMP, int b, float* kmeanb) {
    const int blk = blockIdx.x, h = blockIdx.y, d = threadIdx.x;
    const float* p = KMP + ((size_t)(b * 8 + blk) * 2) * 512 + h * 64 + d;
    kmeanb[((size_t)h * 8 + blk) * 64 + d] = (p[0] + p[512]) * (1.0f / 256.0f);
}
__global__ void __launch_bounds__(256) ad_cat(const unsigned short* CAT, const float* ASSQ, const float* att_g, int b, float* catb) {
    const int m = blockIdx.x; const size_t row = (size_t)b * 2048 + m;
    float ss = 0.f;
    for (int h = 0; h < 8; ++h) ss += ASSQ[row * 8 + h];
    const float rs = 1.0f / sqrtf(ss * (1.0f / 512.0f) + 1e-6f);
    for (int c = threadIdx.x; c < 1024; c += 256) { const float v = bf2f(CAT[row * 1024 + c]); catb[(size_t)m * 1024 + c] = (c < 512) ? v * rs * att_g[c] : v; }
}
__global__ void __launch_bounds__(256) dbg_cmp(const float* a, const float* b, size_t n, float rel, float abs_, unsigned* flag, int ncols = 1, int c_lo = 0, int c_hi = 1, int silu_b = 0) {
    unsigned bad = 0;
    for (size_t i = (size_t)blockIdx.x * 256 + threadIdx.x; i < n; i += (size_t)gridDim.x * 256) { const int c = (int)(i % ncols); if (c < c_lo || c >= c_hi) continue;
        float bv = b[i]; if (silu_b) bv = bv / (1.f + expf(-bv)); const float d = fabsf(a[i] - bv); if (!(d <= rel * fabsf(bv) + abs_)) ++bad; }
    if (bad) atomicAdd(flag, bad);
}
__global__ void __launch_bounds__(256) dbg_poison(const unsigned* flag, unsigned thresh, float* out, float val) {
    if (*flag > thresh) for (int i = threadIdx.x; i < 1024 * 1024; i += 256) out[i] = val;
}
__global__ void __launch_bounds__(256) dbg_ssd(const float* a, const float* b, size_t n, int ncols, int c_lo, int c_hi, float* acc) {
    float s = 0.f;
    for (size_t i = (size_t)blockIdx.x * 256 + threadIdx.x; i < n; i += (size_t)gridDim.x * 256) { const int c = (int)(i % ncols); if (c < c_lo || c >= c_hi) continue; const float d = a[i] - b[i]; s += d * d; }
    atomicAdd(acc, s);
}
__global__ void __launch_bounds__(256) dbg_encode(const float* acc, float count, float* out) {
    const float mse = *acc / count; const float val = 4.0f / sqrtf(mse);
    for (int i = threadIdx.x; i < 1024 * 1024; i += 256) out[i] = val;
}
}

static void launch_mega(const mk::Args& a0, int lo, int hi, int region, hipStream_t stream) {
    mk::Args a = a0; a.ph_lo = lo; a.ph_hi = hi; a.bar_region = region;
    hipLaunchKernelGGL(mk::mega, dim3(256), dim3(512), mk::LDS_BYTES, stream, a);
}

extern "C" void kernel_launch(void* const* d_in, const int* in_sizes, int n_in, void* d_out, int out_size, void* d_ws, size_t ws_size, hipStream_t stream) {
    static int ready = 0;
    if (ready == 0) {
        if (n_in != 18 || out_size != M * D || ws_size < mk::WS_END) { fprintf(stderr, "kernel_launch: unexpected problem (n_in %d, out %d, ws %zu)\n", n_in, out_size, ws_size); ready = -1; return; }
        if (hipFuncSetAttribute((const void*)mk::mega, hipFuncAttributeMaxDynamicSharedMemorySize, mk::LDS_BYTES) != hipSuccess) { fprintf(stderr, "kernel_launch: hipFuncSetAttribute failed\n"); ready = -1; return; }
        ready = 1;
    }
    if (ready < 0) return;
    mk::Args a{};
    const float** ip = (const float**)&a.in;
    for (int i = 0; i < 18; ++i) ip[i] = (const float*)d_in[i];
    a.out = (float*)d_out; a.ws = (unsigned char*)d_ws; a.moe_w = (STEP >= 5) ? 1 : 0;
    const mk::Inputs& in = a.in;
    float* out = (float*)d_out; unsigned char* ws = (unsigned char*)d_ws;
    hipMemsetAsync(ws + mk::WS_CTL, 0, mk::CTL_ZERO_BYTES, stream);
#if STEP >= 6
    launch_mega(a, 0, mk::N_PHASES, 0, stream);
#else
    constexpr size_t MiB = 1u << 20;
    unsigned char* na = ws + 8 * MiB;
    float* PROJb = (float*)(na);
    float* Hb = (float*)(na + 28 * MiB);
    float* CATb = (float*)(na + 36 * MiB);
    float* OAb = (float*)(na + 44 * MiB);
    float* ORRb = (float*)(na + 48 * MiB);
    float* KMEANb = (float*)(na + 52 * MiB);
    int* EIDXb = (int*)(na + 53 * MiB); float* EWb = (float*)(na + 53 * MiB + 65536); int* POSb = (int*)(na + 53 * MiB + 131072); int* LISTb = (int*)(na + 53 * MiB + 196608);
    int* CNTb = (int*)(na + 54 * MiB); int* BASEb = CNTb + 16;
    float* Gb = (float*)(na + 56 * MiB);
    float* Ub = (float*)(na + 78 * MiB);
    float* Yb = (float*)(na + 100 * MiB);
    const float* MODp = (const float*)(ws + mk::WS_MOD);
    unsigned short* QKV = (unsigned short*)(ws + mk::WS_QKV);
    launch_mega(a, 0, 1, 1, stream);
    for (int l = 0; l < 2; ++l) {
        const int pb = 1 + 8 * l;
        const float* xin = (l == 0) ? in.x : (const float*)out;
        if (STEP >= 1) { launch_mega(a, pb, pb + 1, 1, stream); launch_mega(a, pb + 1, pb + 2, 1, stream); }
        if (STEP >= 2) launch_mega(a, pb + 2, pb + 3, 1, stream);
        if (STEP >= 3) launch_mega(a, pb + 3, pb + 4, 1, stream);
        if (STEP < 3) {
            for (int b = 0; b < BATCH; ++b) {
                const float* mod = MODp + ((size_t)l * BATCH + b) * 6 * D;
                const float* xb = xin + (size_t)b * SEQ * D; float* ob = out + (size_t)b * SEQ * D;
                if (STEP < 1) {
                    nv::k_norm<<<SEQ, 256, 0, stream>>>(xb, in.norm_mix_g + l * D, mod + 0 * D, mod + 1 * D, Hb);
                    nv::k_gemm<<<dim3(NPROJ / 64, SEQ / 64), 256, 0, stream>>>(Hb, D, nullptr, nullptr, SEQ, in.w_in + (size_t)l * D * NPROJ, NPROJ, PROJb, NPROJ, D);
                    nv::k_rotary<<<SEQ, 256, 0, stream>>>(PROJb);
                    nv::k_kmean<<<dim3(NBLK, AH, 1), 64, 0, stream>>>(PROJb, KMEANb);
                } else {
                    ad::ad_proj<<<SEQ, 256, 0, stream>>>(QKV, (size_t)M * 512, b, PROJb);
                    ad::ad_kmean<<<dim3(NBLK, AH, 1), 64, 0, stream>>>((const float*)(ws + mk::WS_KMP), b, KMEANb);
#ifdef DBG_CHECK
                    { float* PROJn = Gb; float* KMn = (float*)(na + 52 * MiB + 262144); unsigned* flag = (unsigned*)(ws + mk::WS_CTL) + 16;
                      nv::k_norm<<<SEQ, 256, 0, stream>>>(xb, in.norm_mix_g + l * D, mod + 0 * D, mod + 1 * D, Hb);
                      nv::k_gemm<<<dim3(NPROJ / 64, SEQ / 64), 256, 0, stream>>>(Hb, D, nullptr, nullptr, SEQ, in.w_in + (size_t)l * D * NPROJ, NPROJ, PROJn, NPROJ, D);
                      nv::k_rotary<<<SEQ, 256, 0, stream>>>(PROJn);
                      nv::k_kmean<<<dim3(NBLK, AH, 1), 64, 0, stream>>>(PROJn, KMn);
                      ad::dbg_cmp<<<1024, 256, 0, stream>>>(PROJb, PROJn, (size_t)SEQ * NPROJ, DBG_REL, DBG_ABS, flag, NPROJ, 0, 3072, 0);
                      ad::dbg_cmp<<<1024, 256, 0, stream>>>(PROJb, PROJn, (size_t)SEQ * NPROJ, DBG_REL, DBG_ABS, flag, NPROJ, 3072, 3584, 1);
                      ad::dbg_cmp<<<16, 256, 0, stream>>>(KMEANb, KMn, (size_t)8 * 8 * 64, 0.03f, 0.004f, flag + 1);
                      if (l == DBG_L && b == 0) ad::dbg_ssd<<<1024, 256, 0, stream>>>(PROJb, PROJn, (size_t)SEQ * NPROJ, NPROJ, DBG_CLO, DBG_CHI, (float*)(flag + 2)); }
#endif
                }
                if (STEP < 2) {
                    nv::k_moba<<<dim3(NBLK, AH, 1), 256, 0, stream>>>(PROJb, KMEANb, OAb);
                    nv::k_ret<<<dim3(SEQ / 256, RH * 4, 1), 256, 0, stream>>>(PROJb, ORRb);
                    nv::k_cat<<<SEQ, 256, 0, stream>>>(OAb, ORRb, PROJb, in.att_g + l * AW, in.ret_g + l * RW, CATb, STEP >= 1 ? 1 : 0);
                } else {
                    ad::ad_cat<<<SEQ, 256, 0, stream>>>((const unsigned short*)(ws + mk::WS_CAT), (const float*)(ws + mk::WS_ASSQ), in.att_g + l * AW, b, CATb);
                }
                nv::k_gemm<<<dim3(D / 64, SEQ / 64), 256, 0, stream>>>(CATb, D, nullptr, nullptr, SEQ, in.w_out + (size_t)l * D * D, D, Hb, D, D);
                nv::k_resid<<<SEQ, 256, 0, stream>>>(xb, mod + 2 * D, Hb, ob);
            }
        }
        const bool ffn_mega = (l == 0) ? (STEP >= 4) : (STEP >= 5);
        if (ffn_mega) {
            launch_mega(a, pb + 4, pb + 5, 1, stream);
            if (l == 1) launch_mega(a, pb + 5, pb + 6, 1, stream);
            launch_mega(a, pb + 6, pb + 7, 1, stream);
            launch_mega(a, pb + 7, pb + 8, 1, stream);
        } else {
            for (int b = 0; b < BATCH; ++b) {
                const float* mod = MODp + ((size_t)l * BATCH + b) * 6 * D;
                float* ob = out + (size_t)b * SEQ * D;
                nv::k_norm<<<SEQ, 256, 0, stream>>>(ob, in.norm_ffn_g + l * D, mod + 3 * D, mod + 4 * D, Hb);
                if (l == 0) {
                    nv::k_gemm<<<dim3(FF / 64, SEQ / 64), 256, 0, stream>>>(Hb, D, nullptr, nullptr, SEQ, in.fw_gate, FF, Gb, FF, D);
                    nv::k_gemm<<<dim3(FF / 64, SEQ / 64), 256, 0, stream>>>(Hb, D, nullptr, nullptr, SEQ, in.fw_up, FF, Ub, FF, D);
                    nv::k_silu_mul<<<SEQ, 256, 0, stream>>>(Gb, Ub, nullptr, SEQ, FF);
                    nv::k_gemm<<<dim3(D / 64, SEQ / 64), 256, 0, stream>>>(Gb, FF, nullptr, nullptr, SEQ, in.fw_down, D, Ub, D, FF);
                    nv::k_resid<<<SEQ, 256, 0, stream>>>(ob, mod + 5 * D, Ub, ob);
                } else {
                    nv::k_router<<<SEQ / 4, 256, 0, stream>>>(Hb, in.router_w, EIDXb, EWb);
                    nv::k_place<<<1, 1024, 0, stream>>>(EIDXb, LISTb, POSb, CNTb, BASEb, 4);
                    float* GE = Gb; float* UE = Ub;
                    for (int e = 0; e < NE; ++e) {
                        nv::k_gemm<<<dim3(FF / 64, ECAP / 64), 256, 0, stream>>>(Hb, D, LISTb, CNTb + e, ECAP, in.mw_gate + (size_t)e * D * FF, FF, GE, FF, D, BASEb + e, nullptr);
                        nv::k_gemm<<<dim3(FF / 64, ECAP / 64), 256, 0, stream>>>(Hb, D, LISTb, CNTb + e, ECAP, in.mw_up + (size_t)e * D * FF, FF, UE, FF, D, BASEb + e, nullptr);
                        nv::k_silu_mul<<<ECAP, 256, 0, stream>>>(GE, UE, CNTb + e, ECAP, FF);
                        nv::k_gemm<<<dim3(D / 64, ECAP / 64), 256, 0, stream>>>(GE, FF, nullptr, CNTb + e, ECAP, in.mw_down + (size_t)e * FF * D, D, Yb, D, FF, nullptr, BASEb + e);
                    }
                    nv::k_moe_combine<<<SEQ, 256, 0, stream>>>(ob, mod + 5 * D, Yb, POSb, EWb);
                }
            }
        }
    }
    if (STEP >= 5) launch_mega(a, 17, 18, 1, stream);
    else nv::k_norm<<<M, 256, 0, stream>>>(out, in.final_g, nullptr, nullptr, out);
#ifdef DBG_CHECK
#ifdef DBG_ENC
    ad::dbg_encode<<<1, 256, 0, stream>>>((const float*)((unsigned*)(ws + mk::WS_CTL) + 18), (float)SEQ * (DBG_CHI - DBG_CLO), out);
#endif
    ad::dbg_poison<<<1, 256, 0, stream>>>((unsigned*)(ws + mk::WS_CTL) + 16, DBG_T0, out, 100.0f);
    ad::dbg_poison<<<1, 256, 0, stream>>>((unsigned*)(ws + mk::WS_CTL) + 17, DBG_T1, out + (1 << 20), 300.0f);
#endif
#endif
}
```
